# Optimizing an MI355X kernel written in HIP

```python
import math
import jax, jax.numpy as jnp
from jax import lax
import numpy as np

D_MODEL = 2048
BATCH = 1
SEQ = 8192
DEPTH = 2

D_MIX = D_MODEL
D_FF = 4 * D_MODEL
CONV_W = 4
CHUNK = 64
EPS = 1e-6
ROPE_BASE = 10000.0
RWKV_LN_EPS = 64e-5

GDN_HEADS = 4
GDN_DK = D_MIX // 16
GDN_DV = D_MIX // 16
GDN_QK = GDN_HEADS * GDN_DK
GDN_V = GDN_HEADS * GDN_DV
GDN_PW = 2 * GDN_QK + 2 * GDN_V + 2 * GDN_HEADS
RET_HEADS = 4
RET_DV = D_MIX // 16
RET_DK = RET_DV // 2
RET_QK = RET_HEADS * RET_DK
RET_V = RET_HEADS * RET_DV
RET_PW = 2 * RET_QK + 2 * RET_V
M2_HEADS = 8
M2_HEADDIM = D_MIX // 32
M2_GROUPS = 2
M2_STATE = 128
M2_W = M2_HEADS * M2_HEADDIM
M2_BC = M2_GROUPS * M2_STATE
M2_PW = 2 * M2_W + 2 * M2_BC + M2_HEADS
RW_HEADS = 8
RW_N = D_MIX // 32
RW_W = RW_HEADS * RW_N
RW_W_LORA = 32
RW_A_LORA = 32
RW_G_LORA = 96
RW_PW = 3 * RW_W + RW_W_LORA + RW_A_LORA + RW_G_LORA

P_TOTAL = GDN_PW + RET_PW + M2_PW + RW_PW

kernel_name = 'hybrid_parallel_heads_block'


def _offsets(widths):
    return [int(o) for o in np.cumsum(widths)]


def _rmsnorm(x, w, eps=EPS):
    xf = x.astype(jnp.float32)
    y = xf * lax.rsqrt(jnp.mean(xf * xf, axis=-1, keepdims=True) + eps)
    return (y * w.astype(jnp.float32)).astype(x.dtype)


def _layernorm(x, w, eps):
    mu = jnp.mean(x, axis=-1, keepdims=True)
    xc = x - mu
    return xc * lax.rsqrt(jnp.mean(xc * xc, axis=-1, keepdims=True) + eps) * w


def _l2norm(x):
    return x * lax.rsqrt(jnp.sum(x * x, axis=-1, keepdims=True) + EPS)


def _causal_dwconv(x, w):
    T = x.shape[1]
    xp = jnp.pad(x, ((0, 0), (CONV_W - 1, 0), (0, 0)))
    return sum(xp[:, i:i + T] * w[i] for i in range(CONV_W))


def _to_chunks(t):
    Bsz, T = t.shape[:2]
    t = t.reshape(Bsz, T // CHUNK, CHUNK, *t.shape[2:])
    return jnp.moveaxis(t, 3, 1)


def _from_chunks(t):
    t = jnp.moveaxis(t, 1, 3)
    return t.reshape(t.shape[0], t.shape[1] * t.shape[2], *t.shape[3:])


def _rotary(x):
    T, D = x.shape[1], x.shape[-1]
    theta = 1.0 / (ROPE_BASE ** jnp.linspace(0.0, 1.0, D // 2, dtype=jnp.float32))
    ang = jnp.arange(T, dtype=jnp.float32)[:, None] * theta
    cos = jnp.cos(ang)[None, :, None, :]
    sin = jnp.sin(ang)[None, :, None, :]
    xp = x.reshape(*x.shape[:-1], D // 2, 2)
    x0, x1 = xp[..., 0], xp[..., 1]
    return jnp.stack([x0 * cos - x1 * sin, x1 * cos + x0 * sin], axis=-1).reshape(x.shape)


def _gated_deltanet(q, k, v, beta, log_a):
    Bsz, T, H, DK = q.shape
    DV = v.shape[-1]
    qc, kc, vc = _to_chunks(q), _to_chunks(k), _to_chunks(v)
    bc = _to_chunks(beta)
    g = jnp.cumsum(_to_chunks(log_a), axis=-1)
    idx = jnp.arange(CHUNK)
    causal = idx[:, None] >= idx[None, :]
    strict = idx[:, None] > idx[None, :]
    gamma = jnp.exp(jnp.where(causal, g[..., :, None] - g[..., None, :], -jnp.inf))
    kkt = jnp.einsum('bhncd,bhnmd->bhncm', kc, kc)
    lower = jnp.where(strict, kkt * gamma * bc[..., :, None], 0.0)
    m = lower + jnp.eye(CHUNK, dtype=lower.dtype)
    rhs = jnp.concatenate([vc * bc[..., None], kc * (bc * jnp.exp(g))[..., None]], axis=-1)
    sol = lax.linalg.triangular_solve(m, rhs, left_side=True, lower=True, unit_diagonal=True)
    u, w = sol[..., :DV], sol[..., DV:]
    qk = jnp.einsum('bhncd,bhnmd->bhncm', qc, kc) * gamma
    q_dec = qc * jnp.exp(g)[..., None]
    g_last = g[..., -1]
    k_tail = kc * jnp.exp(g_last[..., None] - g)[..., None]

    def step(S, inp):
        w_i, u_i, qk_i, qd_i, kt_i, gl_i = inp
        v_new = u_i - jnp.einsum('bhcd,bhde->bhce', w_i, S)
        o = jnp.einsum('bhcd,bhde->bhce', qd_i, S) + jnp.einsum('bhcm,bhme->bhce', qk_i, v_new)
        S = S * jnp.exp(gl_i)[..., None, None] + jnp.einsum('bhcd,bhce->bhde', kt_i, v_new)
        return S, o

    xs = tuple(jnp.moveaxis(t, 2, 0) for t in (w, u, qk, q_dec, k_tail, g_last))
    S0 = jnp.zeros((Bsz, H, DK, DV), jnp.float32)
    _, o = lax.scan(step, S0, xs)
    return _from_chunks(jnp.moveaxis(o, 0, 2))


def _retention(q, k, v):
    Bsz, T, H, DK = q.shape
    DV = v.shape[-1]
    lg = jnp.log1p(-jnp.exp2(-5.0 - jnp.arange(H, dtype=jnp.float32)))
    pos = jnp.arange(CHUNK, dtype=jnp.float32)
    causal = pos[:, None] >= pos[None, :]
    dmask = jnp.exp(jnp.where(causal, (pos[:, None] - pos[None, :]) * lg[:, None, None], -jnp.inf))
    qc, kc, vc = _to_chunks(q), _to_chunks(k), _to_chunks(v)
    scores = jnp.einsum('bhncd,bhnmd->bhncm', qc, kc) * dmask[:, None]
    o = jnp.einsum('bhncm,bhnme->bhnce', scores, vc)
    k_dec = jnp.exp((CHUNK - 1 - pos) * lg[:, None])
    states = jnp.einsum('bhncd,bhnce->bhnde', kc * k_dec[:, None, :, None], vc)
    chunk_decay = jnp.exp(CHUNK * lg)

    def step(R, s):
        return R * chunk_decay[:, None, None] + s, R

    _, r_prev = lax.scan(step, jnp.zeros((Bsz, H, DK, DV), jnp.float32), jnp.moveaxis(states, 2, 0))
    r_prev = jnp.moveaxis(r_prev, 0, 2)
    q_dec = jnp.exp((pos + 1.0) * lg[:, None])
    o = o + jnp.einsum('bhncd,bhnde->bhnce', qc * q_dec[:, None, :, None], r_prev)
    return _from_chunks(o)


def _ssd(x, dt, A, Bm, Cm):
    Bsz, T, H, P = x.shape
    G, N = Bm.shape[2], Bm.shape[3]
    Hg = H // G
    nc = T // CHUNK

    def grp(t):
        t = t.reshape(Bsz, nc, CHUNK, G, Hg, *t.shape[3:])
        return jnp.moveaxis(t, (3, 4), (1, 2))

    xc, dtc = grp(x), grp(dt)
    g = jnp.cumsum(grp(dt * A), axis=-1)
    Bc = jnp.moveaxis(Bm.reshape(Bsz, nc, CHUNK, G, N), 3, 1)
    Cc = jnp.moveaxis(Cm.reshape(Bsz, nc, CHUNK, G, N), 3, 1)
    idx = jnp.arange(CHUNK)
    causal = idx[:, None] >= idx[None, :]
    L = jnp.exp(jnp.where(causal, g[..., :, None] - g[..., None, :], -jnp.inf))
    cb = jnp.einsum('bgncs,bgnms->bgncm', Cc, Bc)
    y = jnp.einsum('bghncm,bghnmp->bghncp', cb[:, :, None] * L * dtc[..., None, :], xc)
    g_last = g[..., -1]
    states = jnp.einsum('bgncs,bghncp->bghnsp', Bc, xc * (jnp.exp(g_last[..., None] - g) * dtc)[..., None])

    def step(hs, inp):
        s, gl = inp
        return hs * jnp.exp(gl)[..., None, None] + s, hs

    _, h_prev = lax.scan(step, jnp.zeros((Bsz, G, Hg, N, P), jnp.float32),
                         (jnp.moveaxis(states, 3, 0), jnp.moveaxis(g_last, 3, 0)))
    h_prev = jnp.moveaxis(h_prev, 0, 3)
    y = y + jnp.einsum('bgncs,bghnsp->bghncp', Cc, h_prev) * jnp.exp(g)[..., None]
    return jnp.moveaxis(y, (1, 2), (3, 4)).reshape(Bsz, T, H, P)


def _rwkv7_scan(r, decay, k, v, kk, a):
    Bsz, T, H, N = r.shape

    def step(S, inp):
        r_t, d_t, k_t, v_t, kk_t, a_t = inp
        sa = jnp.einsum('bhvk,bhk->bhv', S, -kk_t)
        S = S * d_t[:, :, None, :] + sa[..., None] * (kk_t * a_t)[:, :, None, :] + v_t[..., None] * k_t[:, :, None, :]
        return S, jnp.einsum('bhvk,bhk->bhv', S, r_t)

    xs = tuple(jnp.moveaxis(t, 1, 0) for t in (r, decay, k, v, kk, a))
    _, y = lax.scan(step, jnp.zeros((Bsz, H, N, N), jnp.float32), xs)
    return jnp.moveaxis(y, 0, 1)


def _token_mix(h, w_in, gdn_conv_w, gdn_a_log, gdn_dt_bias, gdn_norm_w, ret_norm_w,
               m2_conv_w, m2_conv_b, m2_a_log, m2_dt_bias, m2_d, m2_norm_w,
               rw_mu, rw_w0, rw_w_up, rw_a0, rw_a_up, rw_g_up, rw_k_k, rw_k_a, rw_r_k,
               rw_ln_w, rw_ln_b, w_out):
    f32 = jnp.float32
    Bsz, T, _ = h.shape
    proj = jnp.einsum('btd,dp->btp', h, w_in).astype(f32)
    p_gdn, p_ret, p_m2, p_rw = jnp.split(proj, _offsets((GDN_PW, RET_PW, M2_PW)), axis=-1)

    gqkv, gz, gb, ga = jnp.split(p_gdn, _offsets((2 * GDN_QK + GDN_V, GDN_V, GDN_HEADS)), axis=-1)
    gqkv = jax.nn.silu(_causal_dwconv(gqkv, gdn_conv_w.astype(f32)))
    gq, gk, gv = jnp.split(gqkv, _offsets((GDN_QK, GDN_QK)), axis=-1)
    q = _l2norm(gq.reshape(Bsz, T, GDN_HEADS, GDN_DK)) * (GDN_DK ** -0.5)
    k = _l2norm(gk.reshape(Bsz, T, GDN_HEADS, GDN_DK))
    v = gv.reshape(Bsz, T, GDN_HEADS, GDN_DV)
    beta = jax.nn.sigmoid(gb)
    log_a = -jnp.exp(gdn_a_log.astype(f32)) * jax.nn.softplus(ga + gdn_dt_bias.astype(f32))
    o_a = _gated_deltanet(q, k, v, beta, log_a)
    o_a = _rmsnorm(o_a, gdn_norm_w) * jax.nn.silu(gz.reshape(Bsz, T, GDN_HEADS, GDN_DV))
    o_a = o_a.reshape(Bsz, T, GDN_V)

    rq, rk, rv, rg = jnp.split(p_ret, _offsets((RET_QK, RET_QK, RET_V)), axis=-1)
    q = _rotary(rq.reshape(Bsz, T, RET_HEADS, RET_DK))
    k = _rotary(rk.reshape(Bsz, T, RET_HEADS, RET_DK)) * (RET_DK ** -0.5)
    v = rv.reshape(Bsz, T, RET_HEADS, RET_DV)
    o_b = _retention(q, k, v)
    o_b = _layernorm(o_b, ret_norm_w.astype(f32).reshape(RET_HEADS, RET_DV), EPS)
    o_b = o_b.reshape(Bsz, T, RET_V) * jax.nn.silu(rg)

    mz, mxbc, mdt = jnp.split(p_m2, _offsets((M2_W, M2_W + 2 * M2_BC)), axis=-1)
    mxbc = jax.nn.silu(_causal_dwconv(mxbc, m2_conv_w.astype(f32)) + m2_conv_b.astype(f32))
    mx, mB, mC = jnp.split(mxbc, _offsets((M2_W, M2_BC)), axis=-1)
    xh = mx.reshape(Bsz, T, M2_HEADS, M2_HEADDIM)
    dt = jax.nn.softplus(mdt + m2_dt_bias.astype(f32))
    A = -jnp.exp(m2_a_log.astype(f32))
    y = _ssd(xh, dt, A, mB.reshape(Bsz, T, M2_GROUPS, M2_STATE), mC.reshape(Bsz, T, M2_GROUPS, M2_STATE))
    y = y + m2_d.astype(f32)[:, None] * xh
    y = y.reshape(Bsz, T, M2_W) * jax.nn.silu(mz)
    o_c = _rmsnorm(y.reshape(Bsz, T, M2_GROUPS, M2_W // M2_GROUPS),
                   m2_norm_w.reshape(M2_GROUPS, M2_W // M2_GROUPS)).reshape(Bsz, T, M2_W)

    p_prev = jnp.pad(p_rw, ((0, 0), (1, 0), (0, 0)))[:, :-1]
    mixed = p_rw + (p_prev - p_rw) * rw_mu.astype(f32)
    wr, wk, wv, wl, al, gl = jnp.split(mixed, _offsets((RW_W, RW_W, RW_W, RW_W_LORA, RW_A_LORA)), axis=-1)
    w_raw = -jax.nn.softplus(-(rw_w0.astype(f32) + jnp.tanh(wl) @ rw_w_up.astype(f32))) - 0.5
    decay = jnp.exp(-jnp.exp(w_raw))
    a = jax.nn.sigmoid(rw_a0.astype(f32) + al @ rw_a_up.astype(f32))
    g = jax.nn.sigmoid(gl) @ rw_g_up.astype(f32)
    hd = lambda t: t.reshape(Bsz, T, RW_HEADS, RW_N)
    r, k, v, a, decay = hd(wr), hd(wk), hd(wv), hd(a), hd(decay)
    kk = _l2norm(k * rw_k_k.astype(f32).reshape(RW_HEADS, RW_N))
    k = k * (1.0 + (a - 1.0) * rw_k_a.astype(f32).reshape(RW_HEADS, RW_N))
    y = _rwkv7_scan(r, decay, k, v, kk, a)
    y = _layernorm(y, rw_ln_w.astype(f32).reshape(RW_HEADS, RW_N), RWKV_LN_EPS) + rw_ln_b.astype(f32).reshape(RW_HEADS, RW_N)
    y = y + jnp.sum(r * k * rw_r_k.astype(f32), axis=-1, keepdims=True) * v
    o_d = y.reshape(Bsz, T, RW_W) * g

    o = jnp.concatenate([o_a, o_b, o_c, o_d], axis=-1)
    return jnp.einsum('btm,md->btd', o, w_out.astype(f32)).astype(h.dtype)


def _sq_relu_mlp(h, w_up, w_down):
    return jnp.square(jax.nn.relu(h @ w_up)) @ w_down


def setup_inputs(seed: int = 0) -> dict:
    key = jax.random.key(seed)
    ks = iter(jax.random.split(key, 32))
    L = DEPTH

    def nrm(shape, scale):
        return jax.random.normal(next(ks), shape, jnp.float32) * scale

    def unif(shape, lo, hi):
        return jax.random.uniform(next(ks), shape, jnp.float32, lo, hi)

    def dt_bias(shape):
        dt = jnp.exp(unif(shape, math.log(1e-3), math.log(1e-1)))
        return dt + jnp.log(-jnp.expm1(-dt))

    return {
        'x': nrm((BATCH, SEQ, D_MODEL), 1.0),
        'norm1_w': 1.0 + nrm((L, D_MODEL), 0.02),
        'w_in': nrm((L, D_MODEL, P_TOTAL), D_MODEL ** -0.5),
        'gdn_conv_w': nrm((L, CONV_W, 2 * GDN_QK + GDN_V), CONV_W ** -0.5),
        'gdn_a_log': jnp.log(unif((L, GDN_HEADS), 1.0, 16.0)),
        'gdn_dt_bias': dt_bias((L, GDN_HEADS)),
        'gdn_norm_w': 1.0 + nrm((L, GDN_DV), 0.02),
        'ret_norm_w': 1.0 + nrm((L, RET_V), 0.02),
        'm2_conv_w': nrm((L, CONV_W, M2_W + 2 * M2_BC), CONV_W ** -0.5),
        'm2_conv_b': nrm((L, M2_W + 2 * M2_BC), 0.1),
        'm2_a_log': jnp.log(unif((L, M2_HEADS), 1.0, 16.0)),
        'm2_dt_bias': dt_bias((L, M2_HEADS)),
        'm2_d': 1.0 + nrm((L, M2_HEADS), 0.1),
        'm2_norm_w': 1.0 + nrm((L, M2_W), 0.02),
        'rw_mu': unif((L, RW_PW), 0.0, 1.0),
        'rw_w0': unif((L, RW_W), -5.0, 1.0),
        'rw_w_up': nrm((L, RW_W_LORA, RW_W), 0.1),
        'rw_a0': nrm((L, RW_W), 0.1),
        'rw_a_up': nrm((L, RW_A_LORA, RW_W), 0.1),
        'rw_g_up': nrm((L, RW_G_LORA, RW_W), RW_G_LORA ** -0.5),
        'rw_k_k': 0.85 + nrm((L, RW_W), 0.05),
        'rw_k_a': 1.0 + nrm((L, RW_W), 0.05),
        'rw_r_k': nrm((L, RW_HEADS, RW_N), 0.1),
        'rw_ln_w': 1.0 + nrm((L, RW_W), 0.02),
        'rw_ln_b': nrm((L, RW_W), 0.02),
        'w_out': nrm((L, D_MIX, D_MODEL), D_MIX ** -0.5),
        'norm2_w': 1.0 + nrm((L, D_MODEL), 0.02),
        'w_ffn_up': nrm((L, D_MODEL, D_FF), D_MODEL ** -0.5),
        'w_ffn_down': nrm((L, D_FF, D_MODEL), D_FF ** -0.5),
        'final_norm_w': 1.0 + nrm((D_MODEL,), 0.02),
    }


def reference(x, norm1_w, w_in, gdn_conv_w, gdn_a_log, gdn_dt_bias, gdn_norm_w, ret_norm_w,
              m2_conv_w, m2_conv_b, m2_a_log, m2_dt_bias, m2_d, m2_norm_w,
              rw_mu, rw_w0, rw_w_up, rw_a0, rw_a_up, rw_g_up, rw_k_k, rw_k_a, rw_r_k,
              rw_ln_w, rw_ln_b, w_out, norm2_w, w_ffn_up, w_ffn_down, final_norm_w):
    h = x
    for l in range(DEPTH):
        a = _rmsnorm(h, norm1_w[l])
        h = h + _token_mix(a, w_in[l], gdn_conv_w[l], gdn_a_log[l], gdn_dt_bias[l], gdn_norm_w[l], ret_norm_w[l],
                           m2_conv_w[l], m2_conv_b[l], m2_a_log[l], m2_dt_bias[l], m2_d[l], m2_norm_w[l],
                           rw_mu[l], rw_w0[l], rw_w_up[l], rw_a0[l], rw_a_up[l], rw_g_up[l], rw_k_k[l], rw_k_a[l],
                           rw_r_k[l], rw_ln_w[l], rw_ln_b[l], w_out[l])
        m = _rmsnorm(h, norm2_w[l])
        h = h + _sq_relu_mlp(m, w_ffn_up[l], w_ffn_down[l])
    return _rmsnorm(h, final_norm_w)
```

```cpp
#ifndef HOST_TEST
#include <hip/hip_runtime.h>
#include <hip/hip_cooperative_groups.h>
#endif
#include <cstdio>
#include <cstdint>
#include <cmath>
#include <cstddef>

#ifndef SEQ_T
#define SEQ_T 8192
#endif
#ifndef N_LAUNCH_MODE
#define N_LAUNCH_MODE 0
#endif

constexpr int T = SEQ_T, D = 2048, NL = 2, FF = 8192, PT = 6832, PTP = 6912;
constexpr int C_GQ = 0, C_GK = 512, C_GV = 1024, C_GZ = 1536, C_GB = 2048, C_GA = 2052;
constexpr int C_RQ = 2056, C_RK = 2312, C_RV = 2568, C_RG = 3080;
constexpr int C_MZ = 3592, C_MXBC = 4104, C_MDT = 5128;
constexpr int C_RW = 5136;
enum { I_X = 0, I_N1, I_WIN, I_GCONV, I_GALOG, I_GDTB, I_GNORM, I_RNORM, I_MCONV, I_MCONVB, I_MALOG, I_MDTB, I_MD, I_MNORM, I_RWMU, I_RWW0, I_RWWUP, I_RWA0, I_RWAUP,
       I_RWGUP, I_RWKK, I_RWKA, I_RWRK, I_RWLNW, I_RWLNB, I_WOUT, I_N2, I_WUP, I_WDN, I_NF, N_IN };

constexpr size_t MiB = 1u << 20;
constexpr size_t SZ_WIN = (size_t)PTP * D * 2, SZ_WOUT = (size_t)D * D * 2, SZ_WUP = (size_t)FF * D * 2, SZ_WDN = (size_t)D * FF * 2;
constexpr size_t WS_CTL = 0, CTL_BYTES = 1 * MiB;
constexpr size_t WS_WIN = WS_CTL + CTL_BYTES;
constexpr size_t WS_WOUT = WS_WIN + SZ_WIN;
constexpr size_t WS_WUP = WS_WOUT + SZ_WOUT;
constexpr size_t WS_WDN = WS_WUP + SZ_WUP;
constexpr size_t WS_XN = WS_WDN + SZ_WDN;
constexpr size_t WS_O = WS_XN;
constexpr size_t WS_PROJ = WS_XN + (size_t)T * D * 2;
constexpr size_t WS_HID = WS_PROJ;
constexpr size_t SZ_T512 = (size_t)T * 512 * 4;
constexpr size_t WS_GQ = WS_PROJ + (size_t)T * PTP * 2;
constexpr size_t WS_GK = WS_GQ + SZ_T512, WS_GV = WS_GK + SZ_T512;
constexpr size_t WS_GAB = WS_GV + SZ_T512;
constexpr size_t WS_RQ = WS_GAB + (size_t)T * 8 * 4;
constexpr size_t WS_RK = WS_RQ + (size_t)T * 256 * 4;
constexpr size_t WS_MXBC = WS_RK + (size_t)T * 256 * 4;
constexpr size_t WS_MDT = WS_MXBC + (size_t)T * 1024 * 4;
constexpr size_t WS_RWR = WS_MDT + (size_t)T * 16 * 4;
constexpr size_t WS_RWKK = WS_RWR + SZ_T512, WS_RWBB = WS_RWKK + SZ_T512, WS_RWD = WS_RWBB + SZ_T512, WS_RWKT = WS_RWD + SZ_T512, WS_RWV = WS_RWKT + SZ_T512, WS_RWG = WS_RWV + SZ_T512;
constexpr size_t WS_RKS = WS_RWG + SZ_T512;
constexpr size_t WS_OR = WS_RKS + (size_t)T * 8 * 4;
constexpr size_t WS_OD = WS_OR + SZ_T512;
constexpr size_t WS_END = WS_OD + SZ_T512;
static_assert(WS_HID + (size_t)T * FF * 2 <= WS_END, "HID overlay");
static_assert(SEQ_T != 8192 || WS_END <= 512 * MiB, "d_ws budget (512 MiB)");

typedef unsigned short bf16_t;
#ifdef HOST_TEST
#define DEV static inline
#define HD static inline
typedef float f32x4 __attribute__((vector_size(16)));
constexpr int WAVE = 1, LPC = 1;
static inline float wave_sum(float v) { return v; }
static inline float group_sum(float v) { return v; }
#else
#define DEV __device__ __forceinline__
#define HD __host__ __device__ __forceinline__
typedef float f32x4 __attribute__((ext_vector_type(4)));
constexpr int WAVE = 64, LPC = 16;
DEV float wave_sum(float v) {
#pragma unroll
    for (int o = 1; o < 64; o <<= 1) v += __shfl_xor(v, o);
    return v;
}
DEV float group_sum(float v) {
#pragma unroll
    for (int o = 1; o < 16; o <<= 1) v += __shfl_xor(v, o);
    return v;
}
#endif
constexpr int CPW = WAVE / LPC;

HD unsigned f2bf(float f) { unsigned u; __builtin_memcpy(&u, &f, 4); return (u + 0x7fffu + ((u >> 16) & 1u)) >> 16; }
HD unsigned pk2(float lo, float hi) { return f2bf(lo) | (f2bf(hi) << 16); }
HD float bf2f(bf16_t b) { unsigned u = (unsigned)b << 16; float f; __builtin_memcpy(&f, &u, 4); return f; }
DEV float sigmoid_f(float x) { return 1.0f / (1.0f + expf(-x)); }
DEV float silu_f(float x) { return x / (1.0f + expf(-x)); }
DEV float softplus_f(float x) { return x > 20.f ? x : log1pf(expf(x)); }

struct Args { const float* in[N_IN]; float* out; unsigned char* ws; int ph_lo, ph_hi; };
#ifdef HOST_TEST
typedef const Args CArgs;
#else
typedef const __attribute__((address_space(4))) Args CArgs;
#endif
#define WSF(off) ((float*)(a.ws + (off)))
#define HRES (a.out)
#define PROJROW(t) ((const bf16_t*)(a.ws + WS_PROJ) + (size_t)(t) * PTP)
#define LP(idx, per) (a.in[idx] + (size_t)l * (per))

DEV void rms_row_bf16(const float* x, const float* w, bf16_t* o, int lane) {
    float ss = 0.f;
    for (int i = lane * 4; i < D; i += WAVE * 4) { const f32x4 v = *(const f32x4*)(x + i); ss += (v[0] * v[0] + v[1] * v[1]) + (v[2] * v[2] + v[3] * v[3]); }
    const float r = 1.0f / sqrtf(wave_sum(ss) * (1.0f / D) + 1e-6f);
    for (int i = lane * 4; i < D; i += WAVE * 4) { const f32x4 v = *(const f32x4*)(x + i), g = *(const f32x4*)(w + i);
        unsigned* op = (unsigned*)(o + i); op[0] = pk2(v[0] * r * g[0], v[1] * r * g[1]); op[1] = pk2(v[2] * r * g[2], v[3] * r * g[3]); }
}
DEV void rms_row_f32(const float* x, const float* w, float* o, int lane) {
    float ss = 0.f;
    for (int i = lane * 4; i < D; i += WAVE * 4) { const f32x4 v = *(const f32x4*)(x + i); ss += (v[0] * v[0] + v[1] * v[1]) + (v[2] * v[2] + v[3] * v[3]); }
    const float r = 1.0f / sqrtf(wave_sum(ss) * (1.0f / D) + 1e-6f);
    for (int i = lane * 4; i < D; i += WAVE * 4) { const f32x4 v = *(const f32x4*)(x + i), g = *(const f32x4*)(w + i);
        f32x4 y; y[0] = v[0] * r * g[0]; y[1] = v[1] * r * g[1]; y[2] = v[2] * r * g[2]; y[3] = v[3] * r * g[3]; *(f32x4*)(o + i) = y; }
}

DEV float conv4(const bf16_t* projrow_t, int col, const float* w, int c, int wstride, int t) {
    float acc = 0.f;
#pragma unroll
    for (int j = 0; j < 4; ++j) { const int tt = t - 3 + j; if (tt >= 0) acc += w[j * wstride + c] * bf2f(projrow_t[(ptrdiff_t)(j - 3) * PTP + col]); }
    return acc;
}

#ifdef HOST_TEST
static const float THETA[32] = {
#else
__device__ const float THETA[32] = {
#endif
    1.000000000e+00f, 7.429639101e-01f, 5.519954562e-01f, 4.101127088e-01f, 3.046989739e-01f, 2.263803482e-01f, 1.681924462e-01f, 1.249609292e-01f, 9.284145385e-02f, 6.897785515e-02f,
    5.124806613e-02f, 3.807546571e-02f, 2.828869782e-02f, 2.101748064e-02f, 1.561523322e-02f, 1.160155423e-02f, 8.619536646e-03f, 6.404003594e-03f, 4.757945426e-03f, 3.534980817e-03f,
    2.626363887e-03f, 1.951293205e-03f, 1.449740841e-03f, 1.077104942e-03f, 8.002503891e-04f, 5.945570301e-04f, 4.417345626e-04f, 3.281927784e-04f, 2.438354713e-04f, 1.811609109e-04f,
    1.345960627e-04f, 9.999999747e-05f };

DEV void prep_gdn(CArgs& a, int l, int t, int lane) {
    const bf16_t* pr = PROJROW(t);
    {
        const float* cw = LP(I_GCONV, 4 * 1536);
        constexpr int NE = 128 / WAVE;
#pragma unroll 1
        for (int h = 0; h < 4; ++h) {
#pragma unroll 1
            for (int which = 0; which < 2; ++which) {
                float x[NE]; float ss = 0.f;
#pragma unroll
                for (int e = 0; e < NE; ++e) { const int c = which * 512 + h * 128 + lane + e * WAVE; x[e] = silu_f(conv4(pr, C_GQ + c, cw, c, 1536, t)); ss += x[e] * x[e]; }
                const float sc = (1.0f / sqrtf(wave_sum(ss) + 1e-6f)) * (which == 0 ? 0.08838834764831845f : 1.0f);
                float* o = WSF(which == 0 ? WS_GQ : WS_GK) + (size_t)t * 512 + h * 128;
#pragma unroll
                for (int e = 0; e < NE; ++e) o[lane + e * WAVE] = x[e] * sc;
            }
#pragma unroll
            for (int e = 0; e < NE; ++e) { const int c = 1024 + h * 128 + lane + e * WAVE; WSF(WS_GV)[(size_t)t * 512 + h * 128 + lane + e * WAVE] = silu_f(conv4(pr, C_GQ + c, cw, c, 1536, t)); }
        }
        for (int h = lane; h < 4; h += WAVE) {
            const float beta = sigmoid_f(bf2f(pr[C_GB + h]));
            const float la = -expf(LP(I_GALOG, 4)[h]) * softplus_f(bf2f(pr[C_GA + h]) + LP(I_GDTB, 4)[h]);
            WSF(WS_GAB)[(size_t)t * 8 + h * 2] = expf(la); WSF(WS_GAB)[(size_t)t * 8 + h * 2 + 1] = beta;
        }
    }
}
DEV void prep_ret(CArgs& a, int l, int t, int lane) {
    const bf16_t* pr = PROJROW(t);
#pragma unroll 1
    for (int p = lane; p < 128; p += WAVE) {
        const int i = p & 31; const float ang = (float)t * THETA[i]; float sn, cs;
#ifdef HOST_TEST
        sn = sinf(ang); cs = cosf(ang);
#else
        sincosf(ang, &sn, &cs);
#endif
        const float q0 = bf2f(pr[C_RQ + 2 * p]), q1 = bf2f(pr[C_RQ + 2 * p + 1]), k0 = bf2f(pr[C_RK + 2 * p]), k1 = bf2f(pr[C_RK + 2 * p + 1]);
        float* oq = WSF(WS_RQ) + (size_t)t * 256 + 2 * p; float* ok = WSF(WS_RK) + (size_t)t * 256 + 2 * p;
        oq[0] = q0 * cs - q1 * sn; oq[1] = q1 * cs + q0 * sn;
        ok[0] = (k0 * cs - k1 * sn) * 0.125f; ok[1] = (k1 * cs + k0 * sn) * 0.125f;
    }
}
DEV void prep_ssd(CArgs& a, int l, int t, int lane) {
    const bf16_t* pr = PROJROW(t);
    {
        const float* cw = LP(I_MCONV, 4 * 1024); const float* cb = LP(I_MCONVB, 1024);
#pragma unroll 2
        for (int c = lane; c < 1024; c += WAVE) WSF(WS_MXBC)[(size_t)t * 1024 + c] = silu_f(conv4(pr, C_MXBC + c, cw, c, 1024, t) + cb[c]);
        for (int h = lane; h < 8; h += WAVE) {
            const float dt = softplus_f(bf2f(pr[C_MDT + h]) + LP(I_MDTB, 8)[h]); const float A = -expf(LP(I_MALOG, 8)[h]);
            WSF(WS_MDT)[(size_t)t * 16 + 2 * h] = dt; WSF(WS_MDT)[(size_t)t * 16 + 2 * h + 1] = expf(dt * A);
        }
    }
}
template <class SCR> DEV void prep_rwkv(CArgs& a, int l, int t, int lane, SCR scr) {
    const bf16_t* pr = PROJROW(t);
    {
        const float* mu = LP(I_RWMU, 1696); const bf16_t* p1 = pr + C_RW; const bf16_t* p0 = p1 - PTP;
        for (int j = lane; j < 160; j += WAVE) { const int c = 1536 + j; const float cur = bf2f(p1[c]), prev = t > 0 ? bf2f(p0[c]) : 0.f; const float m = cur + (prev - cur) * mu[c];
            scr[j] = j < 32 ? tanhf(m) : (j < 64 ? m : sigmoid_f(m)); }
#ifndef HOST_TEST
        asm volatile("s_waitcnt lgkmcnt(0)" ::: "memory");
#endif
        const float* wup = LP(I_RWWUP, 32 * 512); const float* aup = LP(I_RWAUP, 32 * 512); const float* gup = LP(I_RWGUP, 96 * 512);
        constexpr int NE = 64 / WAVE;
#pragma unroll 1
        for (int h = 0; h < 8; ++h) {
            float r_[NE], kt_[NE], kk_[NE], a_[NE]; float ss = 0.f, rk = 0.f;
#pragma unroll
            for (int e = 0; e < NE; ++e) {
                const int c = h * 64 + lane + e * WAVE;
                float lw = 0.f, la = 0.f, lg = 0.f;
#pragma unroll 8
                for (int j = 0; j < 32; ++j) { lw += scr[j] * wup[j * 512 + c]; la += scr[32 + j] * aup[j * 512 + c]; }
#pragma unroll 8
                for (int j = 0; j < 96; ++j) lg += scr[64 + j] * gup[j * 512 + c];
                const float cr = bf2f(p1[c]), ck = bf2f(p1[512 + c]), cv = bf2f(p1[1024 + c]);
                const float pr_ = t > 0 ? bf2f(p0[c]) : 0.f, pk_ = t > 0 ? bf2f(p0[512 + c]) : 0.f, pv_ = t > 0 ? bf2f(p0[1024 + c]) : 0.f;
                const float r = cr + (pr_ - cr) * mu[c], k = ck + (pk_ - ck) * mu[512 + c], v = cv + (pv_ - cv) * mu[1024 + c];
                const float wraw = -softplus_f(-(LP(I_RWW0, 512)[c] + lw)) - 0.5f;
                const float dec = expf(-expf(wraw));
                const float av = sigmoid_f(LP(I_RWA0, 512)[c] + la);
                const float kkr = k * LP(I_RWKK, 512)[c];
                const float kt = k * (1.0f + (av - 1.0f) * LP(I_RWKA, 512)[c]);
                r_[e] = r; kt_[e] = kt; kk_[e] = kkr; a_[e] = av; ss += kkr * kkr; rk += r * kt * LP(I_RWRK, 512)[c];
                const size_t o = (size_t)t * 512 + c;
                WSF(WS_RWR)[o] = r; WSF(WS_RWD)[o] = dec; WSF(WS_RWKT)[o] = kt; WSF(WS_RWV)[o] = v; WSF(WS_RWG)[o] = lg;
            }
            ss = wave_sum(ss); rk = wave_sum(rk);
            const float inv = 1.0f / sqrtf(ss + 1e-6f);
#pragma unroll
            for (int e = 0; e < NE; ++e) { const size_t o = (size_t)t * 512 + h * 64 + lane + e * WAVE; const float kk = kk_[e] * inv; WSF(WS_RWKK)[o] = kk; WSF(WS_RWBB)[o] = kk * a_[e]; }
            if (lane == 0) WSF(WS_RKS)[(size_t)t * 8 + h] = rk;
        }
    }
}

DEV void post_token(CArgs& a, int l, int t, int lane) {
    const bf16_t* pr = PROJROW(t); bf16_t* O = (bf16_t*)(a.ws + WS_O) + (size_t)t * D;
    {
        constexpr int NE = 128 / WAVE; const float* w = LP(I_GNORM, 128);
        for (int h = 0; h < 4; ++h) { float x[NE]; float ss = 0.f;
#pragma unroll
            for (int e = 0; e < NE; ++e) { x[e] = WSF(WS_GV)[(size_t)t * 512 + h * 128 + lane + e * WAVE]; ss += x[e] * x[e]; }
            const float r = 1.0f / sqrtf(wave_sum(ss) * (1.0f / 128) + 1e-6f);
#pragma unroll
            for (int e = 0; e < NE; ++e) { const int i = lane + e * WAVE; O[h * 128 + i] = (bf16_t)f2bf(x[e] * r * w[i] * silu_f(bf2f(pr[C_GZ + h * 128 + i]))); } }
    }
    {
        constexpr int NE = 128 / WAVE; const float* w = LP(I_RNORM, 512);
        for (int h = 0; h < 4; ++h) { float x[NE]; float s = 0.f;
#pragma unroll
            for (int e = 0; e < NE; ++e) { x[e] = WSF(WS_OR)[(size_t)t * 512 + h * 128 + lane + e * WAVE]; s += x[e]; }
            const float mu = wave_sum(s) * (1.0f / 128); float q = 0.f;
#pragma unroll
            for (int e = 0; e < NE; ++e) { x[e] -= mu; q += x[e] * x[e]; }
            const float r = 1.0f / sqrtf(wave_sum(q) * (1.0f / 128) + 1e-6f);
#pragma unroll
            for (int e = 0; e < NE; ++e) { const int c = h * 128 + lane + e * WAVE; O[512 + c] = (bf16_t)f2bf(x[e] * r * w[c] * silu_f(bf2f(pr[C_RG + c]))); } }
    }
    {
        constexpr int NE = 256 / WAVE; const float* w = LP(I_MNORM, 512);
        for (int g = 0; g < 2; ++g) { float x[NE]; float ss = 0.f;
#pragma unroll
            for (int e = 0; e < NE; ++e) { const int c = g * 256 + lane + e * WAVE;
                x[e] = WSF(WS_MXBC)[(size_t)t * 1024 + c] * silu_f(bf2f(pr[C_MZ + c])); ss += x[e] * x[e]; }
            const float r = 1.0f / sqrtf(wave_sum(ss) * (1.0f / 256) + 1e-6f);
#pragma unroll
            for (int e = 0; e < NE; ++e) { const int c = g * 256 + lane + e * WAVE; O[1024 + c] = (bf16_t)f2bf(x[e] * r * w[c]); } }
    }
    {
        constexpr int NE = 64 / WAVE; const float* w = LP(I_RWLNW, 512); const float* b = LP(I_RWLNB, 512);
        for (int h = 0; h < 8; ++h) { float x[NE]; float s = 0.f;
#pragma unroll
            for (int e = 0; e < NE; ++e) { x[e] = WSF(WS_OD)[(size_t)t * 512 + h * 64 + lane + e * WAVE]; s += x[e]; }
            const float mu = wave_sum(s) * (1.0f / 64); float q = 0.f;
#pragma unroll
            for (int e = 0; e < NE; ++e) { x[e] -= mu; q += x[e] * x[e]; }
            const float r = 1.0f / sqrtf(wave_sum(q) * (1.0f / 64) + 64e-5f); const float rks = WSF(WS_RKS)[(size_t)t * 8 + h];
#pragma unroll
            for (int e = 0; e < NE; ++e) { const int c = h * 64 + lane + e * WAVE; const size_t o = (size_t)t * 512 + c;
                const float y = x[e] * r * w[c] + b[c] + rks * WSF(WS_RWV)[o]; O[1536 + c] = (bf16_t)f2bf(y * WSF(WS_RWG)[o]); } }
    }
}

constexpr int SCAN_U = 4;
DEV void scan_gdn(CArgs& a, int wv, int lane) {
    constexpr int NS = 128 / LPC; const int sub = lane % LPC, col = wv * CPW + lane / LPC, h = col >> 7;
    const float* GK = WSF(WS_GK) + h * 128 + sub * NS; const float* GQ = WSF(WS_GQ) + h * 128 + sub * NS; float* GV = WSF(WS_GV) + col; const float* AB = WSF(WS_GAB) + h * 2; float* OG = GV;
    float s[NS];
#pragma unroll
    for (int i = 0; i < NS; ++i) s[i] = 0.f;
    for (int t0 = 0; t0 < T; t0 += SCAN_U) {
        float kb[SCAN_U][NS], qb[SCAN_U][NS], vb[SCAN_U], ab[SCAN_U], bb[SCAN_U];
#pragma unroll
        for (int u = 0; u < SCAN_U; ++u) { const size_t t = t0 + u;
#pragma unroll
            for (int i = 0; i < NS; i += 4) { const f32x4 kv = *(const f32x4*)(GK + t * 512 + i), qv = *(const f32x4*)(GQ + t * 512 + i);
                kb[u][i] = kv[0]; kb[u][i + 1] = kv[1]; kb[u][i + 2] = kv[2]; kb[u][i + 3] = kv[3]; qb[u][i] = qv[0]; qb[u][i + 1] = qv[1]; qb[u][i + 2] = qv[2]; qb[u][i + 3] = qv[3]; }
            vb[u] = GV[t * 512]; ab[u] = AB[t * 8]; bb[u] = AB[t * 8 + 1]; }
#pragma unroll
        for (int u = 0; u < SCAN_U; ++u) {
            float d = 0.f;
#pragma unroll
            for (int i = 0; i < NS; ++i) d += kb[u][i] * s[i];
            d = group_sum(d);
            const float c = bb[u] * (vb[u] - ab[u] * d); float o = 0.f;
#pragma unroll
            for (int i = 0; i < NS; ++i) { s[i] = ab[u] * s[i] + kb[u][i] * c; o += qb[u][i] * s[i]; }
            o = group_sum(o);
            if (sub == 0) OG[(size_t)(t0 + u) * 512] = o;
        }
    }
}
DEV void scan_ret(CArgs& a, int wv, int lane) {
    constexpr int NS = 64 / LPC; const int sub = lane % LPC, col = wv * CPW + lane / LPC, h = col >> 7;
    const float* RK = WSF(WS_RK) + h * 64 + sub * NS; const float* RQ = WSF(WS_RQ) + h * 64 + sub * NS; const bf16_t* RV = PROJROW(0) + C_RV + col; float* OR = WSF(WS_OR) + col;
    const float gam = 1.0f - exp2f(-5.0f - (float)h);
    float s[NS];
#pragma unroll
    for (int i = 0; i < NS; ++i) s[i] = 0.f;
    for (int t0 = 0; t0 < T; t0 += SCAN_U) {
        float kb[SCAN_U][NS], qb[SCAN_U][NS], vb[SCAN_U];
#pragma unroll
        for (int u = 0; u < SCAN_U; ++u) { const size_t t = t0 + u;
#pragma unroll
            for (int i = 0; i < NS; i += 4) { const f32x4 kv = *(const f32x4*)(RK + t * 256 + i), qv = *(const f32x4*)(RQ + t * 256 + i);
                kb[u][i] = kv[0]; kb[u][i + 1] = kv[1]; kb[u][i + 2] = kv[2]; kb[u][i + 3] = kv[3]; qb[u][i] = qv[0]; qb[u][i + 1] = qv[1]; qb[u][i + 2] = qv[2]; qb[u][i + 3] = qv[3]; }
            vb[u] = bf2f(RV[t * PTP]); }
#pragma unroll
        for (int u = 0; u < SCAN_U; ++u) {
            float o = 0.f;
#pragma unroll
            for (int i = 0; i < NS; ++i) { s[i] = gam * s[i] + kb[u][i] * vb[u]; o += qb[u][i] * s[i]; }
            o = group_sum(o);
            if (sub == 0) OR[(size_t)(t0 + u) * 512] = o;
        }
    }
}
DEV void scan_ssd(CArgs& a, int l, int wv, int lane) {
    constexpr int NS = 128 / LPC; const int sub = lane % LPC, col = wv * CPW + lane / LPC, h = col >> 6, g = h >> 2;
    const float* MB = WSF(WS_MXBC) + 512 + g * 128 + sub * NS; const float* MC = WSF(WS_MXBC) + 768 + g * 128 + sub * NS; float* MX = WSF(WS_MXBC) + col; const float* DT = WSF(WS_MDT) + h * 2; float* OC = MX; const float Dh = LP(I_MD, 8)[h];
    float s[NS];
#pragma unroll
    for (int i = 0; i < NS; ++i) s[i] = 0.f;
    for (int t0 = 0; t0 < T; t0 += SCAN_U) {
        float Bb[SCAN_U][NS], Cb[SCAN_U][NS], xb[SCAN_U], db[SCAN_U], xr[SCAN_U];
#pragma unroll
        for (int u = 0; u < SCAN_U; ++u) { const size_t t = t0 + u;
#pragma unroll
            for (int i = 0; i < NS; i += 4) { const f32x4 bv = *(const f32x4*)(MB + t * 1024 + i), cv = *(const f32x4*)(MC + t * 1024 + i);
                Bb[u][i] = bv[0]; Bb[u][i + 1] = bv[1]; Bb[u][i + 2] = bv[2]; Bb[u][i + 3] = bv[3]; Cb[u][i] = cv[0]; Cb[u][i + 1] = cv[1]; Cb[u][i + 2] = cv[2]; Cb[u][i + 3] = cv[3]; }
            xr[u] = MX[t * 1024]; xb[u] = xr[u] * DT[t * 16]; db[u] = DT[t * 16 + 1]; }
#pragma unroll
        for (int u = 0; u < SCAN_U; ++u) {
            float y = 0.f;
#pragma unroll
            for (int i = 0; i < NS; ++i) { s[i] = db[u] * s[i] + Bb[u][i] * xb[u]; y += Cb[u][i] * s[i]; }
            y = group_sum(y);
            if (sub == 0) OC[(size_t)(t0 + u) * 1024] = y + Dh * xr[u];
        }
    }
}
DEV void scan_rwkv(CArgs& a, int wv, int lane) {
    constexpr int NS = 64 / LPC; const int sub = lane % LPC, row = wv * CPW + lane / LPC, h = row >> 6; const size_t vo = (size_t)h * 64 + sub * NS;
    const float* KK = WSF(WS_RWKK) + vo; const float* BB = WSF(WS_RWBB) + vo; const float* DD = WSF(WS_RWD) + vo; const float* KT = WSF(WS_RWKT) + vo; const float* RR = WSF(WS_RWR) + vo; const float* VV = WSF(WS_RWV) + row; float* OD = WSF(WS_OD) + row;
    float s[NS];
#pragma unroll
    for (int i = 0; i < NS; ++i) s[i] = 0.f;
    for (int t0 = 0; t0 < T; t0 += SCAN_U) {
        float kk[SCAN_U][NS], bb[SCAN_U][NS], dd[SCAN_U][NS], kt[SCAN_U][NS], rr[SCAN_U][NS], vb[SCAN_U];
#pragma unroll
        for (int u = 0; u < SCAN_U; ++u) { const size_t t = t0 + u;
#pragma unroll
            for (int i = 0; i < NS; i += 4) { const f32x4 v0 = *(const f32x4*)(KK + t * 512 + i), v1 = *(const f32x4*)(BB + t * 512 + i), v2 = *(const f32x4*)(DD + t * 512 + i), v3 = *(const f32x4*)(KT + t * 512 + i), v4 = *(const f32x4*)(RR + t * 512 + i);
#pragma unroll
                for (int j = 0; j < 4; ++j) { kk[u][i + j] = v0[j]; bb[u][i + j] = v1[j]; dd[u][i + j] = v2[j]; kt[u][i + j] = v3[j]; rr[u][i + j] = v4[j]; } }
            vb[u] = VV[t * 512]; }
#pragma unroll
        for (int u = 0; u < SCAN_U; ++u) {
            float sa = 0.f;
#pragma unroll
            for (int i = 0; i < NS; ++i) sa += s[i] * kk[u][i];
            sa = -group_sum(sa); float y = 0.f;
#pragma unroll
            for (int i = 0; i < NS; ++i) { s[i] = s[i] * dd[u][i] + sa * bb[u][i] + vb[u] * kt[u][i]; y += s[i] * rr[u][i]; }
            y = group_sum(y);
            if (sub == 0) OD[(size_t)(t0 + u) * 512] = y;
        }
    }
}

#ifndef HOST_TEST
namespace pg8 {
#define PG8_LAS __attribute__((address_space(3)))
typedef short bf16x8 __attribute__((ext_vector_type(8)));
typedef unsigned u32x4 __attribute__((ext_vector_type(4)));
constexpr int BM = 256, BK = 64, HALF = 128, HTB = HALF * BK * 2, STAGE_BYTES = 8 * HTB, NXCD = 8, WGM = 8;
__host__ __device__ __forceinline__ int lds_byte(int r, int c) { const int st = (r >> 4) * 2 + (c >> 5), rr = r & 15, cc = c & 31, ob = rr * 64 + cc * 2; return st * 1024 + (ob ^ (((ob >> 9) & 1) << 5)); }
__host__ __device__ __forceinline__ void stage_rc(int b, int& R, int& C) { const int st = b / 1024, sb = b % 1024, swz = sb ^ (((sb >> 9) & 1) << 5); R = (st >> 1) * 16 + swz / 64; C = (st & 1) * 32 + (swz % 64) / 2; }
__host__ __device__ __forceinline__ int perm32(int rho) { const int n = rho >> 4, i = rho & 15; return 8 * (i >> 2) + 4 * n + (i & 3); }
struct Unit { int pm, pn; };
struct Gemm { const bf16_t* A; const bf16_t* Bt; };
template <int M, int N> struct StaticOrder {
    static constexpr int nM = M / BM, nN = N / BM, nwg = nM * nN; int G, c;
    __device__ void init(int G_, int c_) { G = G_; c = c_; }
    __device__ bool next(int i, Unit& u) const {
        const long L = (long)i * G + c; if (L >= nwg) return false;
        int wgid = (int)L; { const int q = nwg / NXCD, r = nwg % NXCD, xcd = wgid % NXCD, off = wgid / NXCD; wgid = (xcd < r ? xcd * (q + 1) : r * (q + 1) + (xcd - r) * q) + off; }
        const int nig = WGM * nN, gid = wgid / nig, fm = gid * WGM, gsz = (nM - fm) < WGM ? (nM - fm) : WGM;
        u.pm = fm + ((wgid % nig) % gsz); u.pn = (wgid % nig) / gsz; return true;
    }
    __device__ __forceinline__ void a_ready(const Unit&) const {}
    __device__ __forceinline__ void done(const Unit&) const {}
};
__device__ __forceinline__ unsigned cvt_pk_bf16(float lo, float hi) { unsigned r; asm volatile("v_cvt_pk_bf16_f32 %0, %1, %2" : "=v"(r) : "v"(lo), "v"(hi)); return r; }
struct EpiStoreF32 {
    static constexpr bool PERM = false, AFTER_DRAIN = false; float* O; int ldc;
    __device__ __forceinline__ void operator()(const f32x4 (&acc)[2][2][4][2], const Unit& u, int wr, int wc, int fr, int fq) const {
        const int row0 = u.pm * BM + wr * 64 + fr, col0 = u.pn * BM + wc * 32 + 4 * fq;
#pragma unroll
        for (int ai = 0; ai < 2; ++ai)
#pragma unroll
            for (int m = 0; m < 4; ++m) { float* rowp = O + (size_t)(row0 + ai * HALF + m * 16) * ldc + col0;
#pragma unroll
                for (int bj = 0; bj < 2; ++bj)
#pragma unroll
                    for (int n = 0; n < 2; ++n) *(f32x4*)(rowp + bj * HALF + n * 16) = acc[ai][bj][m][n]; }
    }
};
struct EpiAddRes {
    static constexpr bool PERM = false, AFTER_DRAIN = false; const float* B; float* O; int ldc;
    __device__ __forceinline__ void operator()(const f32x4 (&acc)[2][2][4][2], const Unit& u, int wr, int wc, int fr, int fq) const {
        const int row0 = u.pm * BM + wr * 64 + fr, col0 = u.pn * BM + wc * 32 + 4 * fq;
#pragma unroll
        for (int ai = 0; ai < 2; ++ai)
#pragma unroll
            for (int m = 0; m < 4; ++m) { float* rowp = O + (size_t)(row0 + ai * HALF + m * 16) * ldc + col0; const float* bp = B + (size_t)(row0 + ai * HALF + m * 16) * ldc + col0;
                f32x4 b[2][2];
#pragma unroll
                for (int bj = 0; bj < 2; ++bj)
#pragma unroll
                    for (int n = 0; n < 2; ++n) b[bj][n] = *(const f32x4*)(bp + bj * HALF + n * 16);
#pragma unroll
                for (int bj = 0; bj < 2; ++bj)
#pragma unroll
                    for (int n = 0; n < 2; ++n) *(f32x4*)(rowp + bj * HALF + n * 16) = b[bj][n] + acc[ai][bj][m][n]; }
    }
};
template <bool SQRELU> struct EpiBf16 {
    static constexpr bool PERM = true, AFTER_DRAIN = false; bf16_t* O; int ldc;
    __device__ __forceinline__ void operator()(const f32x4 (&acc)[2][2][4][2], const Unit& u, int wr, int wc, int fr, int fq) const {
        const int row0 = u.pm * BM + wr * 64 + fr, col0 = u.pn * BM + wc * 32 + 8 * fq;
#pragma unroll
        for (int ai = 0; ai < 2; ++ai)
#pragma unroll
            for (int m = 0; m < 4; ++m) { bf16_t* rowp = O + (size_t)(row0 + ai * HALF + m * 16) * ldc + col0;
#pragma unroll
                for (int bj = 0; bj < 2; ++bj) { f32x4 v0 = acc[ai][bj][m][0], v1 = acc[ai][bj][m][1];
                    if (SQRELU) {
#pragma unroll
                        for (int j = 0; j < 4; ++j) { const float p0 = fmaxf(v0[j], 0.f), p1 = fmaxf(v1[j], 0.f); v0[j] = p0 * p0; v1[j] = p1 * p1; } }
                    u32x4 w; w.x = cvt_pk_bf16(v0[0], v0[1]); w.y = cvt_pk_bf16(v0[2], v0[3]); w.z = cvt_pk_bf16(v1[0], v1[1]); w.w = cvt_pk_bf16(v1[2], v1[3]);
                    *(u32x4*)(rowp + bj * HALF) = w; } }
    }
};

template <int K, class Epi, class Sched, bool ALIGN_EPI = false>
__device__ __forceinline__ void gemm_phase(PG8_LAS unsigned char* lds, const Gemm g, const Sched& S, const Epi& E, const int tid) {
    const int wid = __builtin_amdgcn_readfirstlane(tid >> 6), lane = tid & 63, wr = wid >> 2, wc = wid & 3, fr = lane & 15, fq = lane >> 4;
    constexpr int nt = K / BK;
    unsigned voffA[2], voffB[2];
#pragma unroll
    for (int i = 0; i < 2; ++i) { int R, C; stage_rc(tid * 16 + i * 8192, R, C); const int Rb = Epi::PERM ? ((R & ~31) + perm32(R & 31)) : R;
        voffA[i] = (unsigned)(R * K + C) * 2u; voffB[i] = (unsigned)(Rb * K + C) * 2u; }
    const size_t kstep = (size_t)(BK * 2);
    const size_t hstep = (size_t)HALF * K * 2;
    const size_t tstep = 2 * hstep;
    const unsigned ldsw = (unsigned)wid * 1024u;
    const int aoff = lds_byte(wr * 64 + fr, fq * 8), boff = lds_byte(wc * 32 + fr, fq * 8);
#define PG8_SA(b, h) (((b) * 2 + (h)) * HTB)
#define PG8_SB(b, h) ((4 + (b) * 2 + (h)) * HTB)
#define PG8_STAGE(bufoff, gbase, voff) do { _Pragma("unroll") for (int _i = 0; _i < 2; ++_i) \
        __builtin_amdgcn_global_load_lds((const unsigned*)((const char*)(gbase) + (voff)[_i]), (PG8_LAS unsigned*)(lds + (bufoff) + ldsw + _i * 8192), 16, 0, 0); } while (0)
#define PG8_LDA(dst, b, h) do { _Pragma("unroll") for (int m = 0; m < 4; ++m) _Pragma("unroll") for (int k = 0; k < 2; ++k) dst[m][k] = *(const PG8_LAS bf16x8*)(lds + PG8_SA(b, h) + aoff + m * 2048 + k * 1024); } while (0)
#define PG8_LDB(dst, b, h) do { _Pragma("unroll") for (int n = 0; n < 2; ++n) _Pragma("unroll") for (int k = 0; k < 2; ++k) dst[n][k] = *(const PG8_LAS bf16x8*)(lds + PG8_SB(b, h) + boff + n * 2048 + k * 1024); } while (0)
#define PG8_MMA(ai, bj, At, Bt) do { __builtin_amdgcn_s_setprio(1); _Pragma("unroll") for (int m = 0; m < 4; ++m) _Pragma("unroll") for (int n = 0; n < 2; ++n) _Pragma("unroll") for (int k = 0; k < 2; ++k) \
        acc[ai][bj][m][n] = __builtin_amdgcn_mfma_f32_16x16x32_bf16(Bt[n][k], At[m][k], acc[ai][bj][m][n], 0, 0, 0); __builtin_amdgcn_s_setprio(0); } while (0)
#define PG8_WAIT_V(n) asm volatile("s_waitcnt vmcnt(" #n ")" ::: "memory")
#define PG8_WAIT_L(n) asm volatile("s_waitcnt lgkmcnt(" #n ")" ::: "memory")
#define PG8_BAR __builtin_amdgcn_s_barrier()
#define PG8_SCHED __builtin_amdgcn_sched_barrier(0)
    Unit cur, nxt; int ui = 0;
    if (!S.next(0, cur)) return;
    f32x4 acc[2][2][4][2];
#pragma unroll
    for (int a = 0; a < 2; ++a)
#pragma unroll
        for (int b = 0; b < 2; ++b)
#pragma unroll
            for (int m = 0; m < 4; ++m)
#pragma unroll
                for (int n = 0; n < 2; ++n) acc[a][b][m][n] = (f32x4){0.f, 0.f, 0.f, 0.f};
    bf16x8 At[4][2], B0[2][2], B1[2][2];
    const char* cA = (const char*)g.A + (size_t)cur.pm * tstep; const char* cB = (const char*)g.Bt + (size_t)cur.pn * tstep;
    S.a_ready(cur);
    PG8_STAGE(PG8_SB(0, 0), cB, voffB); PG8_STAGE(PG8_SB(0, 1), cB + hstep, voffB); PG8_STAGE(PG8_SA(0, 0), cA, voffA); PG8_STAGE(PG8_SA(0, 1), cA + hstep, voffA);
    if (wr == 1) PG8_BAR;
    PG8_WAIT_V(2); PG8_BAR;
    PG8_STAGE(PG8_SB(1, 0), cB + kstep, voffB); PG8_STAGE(PG8_SA(1, 0), cA + kstep, voffA); PG8_STAGE(PG8_SB(1, 1), cB + hstep + kstep, voffB);
    PG8_WAIT_V(6); PG8_BAR;
    for (;;) {
        const bool has_next = S.next(ui + 1, nxt);
        const char* nA = has_next ? (const char*)g.A + (size_t)nxt.pm * tstep : cA; const char* nB = has_next ? (const char*)g.Bt + (size_t)nxt.pn * tstep : cB;
        for (int t = 0; t < nt; t += 2) {
            const bool last = (t == nt - 2);
            const char* a1 = cA + (size_t)(t + 1) * kstep;
            const char* a2 = last ? nA : cA + (size_t)(t + 2) * kstep; const char* b2 = last ? nB : cB + (size_t)(t + 2) * kstep;
            const char* a3 = a2 + kstep; const char* b3 = b2 + kstep;
            if (last && has_next) S.a_ready(nxt);
            PG8_LDB(B0, 0, 0); PG8_LDB(B1, 0, 1); PG8_SCHED; PG8_LDA(At, 0, 0); PG8_STAGE(PG8_SA(1, 1), a1 + hstep, voffA);
            PG8_WAIT_V(8); PG8_WAIT_L(0); PG8_BAR; PG8_MMA(0, 0, At, B0); PG8_MMA(0, 1, At, B1); PG8_BAR; PG8_SCHED;
            PG8_LDA(At, 0, 1); PG8_STAGE(PG8_SB(0, 0), b2, voffB); PG8_STAGE(PG8_SB(0, 1), b2 + hstep, voffB); PG8_STAGE(PG8_SA(0, 0), a2, voffA);
            PG8_WAIT_V(8); PG8_WAIT_L(0); PG8_BAR; PG8_MMA(1, 0, At, B0); PG8_MMA(1, 1, At, B1); PG8_BAR; PG8_SCHED;
            PG8_LDB(B0, 1, 0); PG8_LDB(B1, 1, 1); PG8_SCHED; PG8_LDA(At, 1, 0); PG8_STAGE(PG8_SA(0, 1), a2 + hstep, voffA);
            PG8_WAIT_V(8); PG8_WAIT_L(0); PG8_BAR; PG8_MMA(0, 0, At, B0); PG8_MMA(0, 1, At, B1); PG8_BAR; PG8_SCHED;
            PG8_LDA(At, 1, 1); PG8_STAGE(PG8_SB(1, 0), b3, voffB); PG8_STAGE(PG8_SB(1, 1), b3 + hstep, voffB); PG8_STAGE(PG8_SA(1, 0), a3, voffA);
            PG8_WAIT_V(8); PG8_WAIT_L(0); PG8_BAR; PG8_MMA(1, 0, At, B0); PG8_MMA(1, 1, At, B1); PG8_BAR; PG8_SCHED;
        }
        if constexpr (ALIGN_EPI) { if (wr == 0) PG8_BAR; }
        E(acc, cur, wr, wc, fr, fq); S.done(cur);
        if (!has_next) break;
#pragma unroll
        for (int a = 0; a < 2; ++a)
#pragma unroll
            for (int b = 0; b < 2; ++b)
#pragma unroll
                for (int m = 0; m < 4; ++m)
#pragma unroll
                    for (int n = 0; n < 2; ++n) acc[a][b][m][n] = (f32x4){0.f, 0.f, 0.f, 0.f};
        cur = nxt; cA = nA; cB = nB; ++ui;
        if constexpr (ALIGN_EPI) { if (wr == 1) PG8_BAR; }
    }
    PG8_WAIT_V(0);
    if constexpr (!ALIGN_EPI) { if (wr == 0) PG8_BAR; }
    PG8_BAR;
#undef PG8_SA
#undef PG8_SB
#undef PG8_STAGE
#undef PG8_LDA
#undef PG8_LDB
#undef PG8_MMA
#undef PG8_WAIT_V
#undef PG8_WAIT_L
#undef PG8_BAR
#undef PG8_SCHED
}
}

#define LAS __attribute__((address_space(3)))
#define GAS __attribute__((address_space(1)))
typedef unsigned v4u __attribute__((ext_vector_type(4)));
constexpr int NWAVES = 8, LDS_BYTES = 147456, RING_BYTES = 131072;
#define LDS_WAIT() asm volatile("s_waitcnt lgkmcnt(0)" ::: "memory")

__device__ __forceinline__ void transpose_item(const float* W, int K, int N, int Npad, bf16_t* WT, LAS float* scr, int item, int lane) {
    const int nblk = Npad / 32, kb = item / nblk, nb = item % nblk, k0 = 64 * kb, n0 = 32 * nb;
    const int n = n0 + (lane & 31); const bool ok = n < N;
#pragma unroll 8
    for (int i = 0; i < 32; ++i) { const int kk = 2 * i + (lane >> 5); scr[kk * 33 + (lane & 31)] = ok ? W[(size_t)(k0 + kk) * N + n] : 0.f; }
    LDS_WAIT(); asm volatile("" ::: "memory");
    const int c = lane & 7;
#pragma unroll
    for (int j = 0; j < 4; ++j) { const int nn = (lane >> 3) + 8 * j; const LAS float* s = scr + (8 * c) * 33 + nn;
        v4u o; o.x = pk2(s[0 * 33], s[1 * 33]); o.y = pk2(s[2 * 33], s[3 * 33]); o.z = pk2(s[4 * 33], s[5 * 33]); o.w = pk2(s[6 * 33], s[7 * 33]);
        *(GAS v4u*)(WT + (size_t)(n0 + nn) * K + k0 + 8 * c) = o; }
    LDS_WAIT(); asm volatile("" ::: "memory");
}

constexpr int N_PHASES = 1 + 9 * NL;

__device__ __forceinline__ void run_phase(CArgs& a, int ph, LAS unsigned char* lds, const int tid, const int bid) {
    const int lane = tid & 63, wave = __builtin_amdgcn_readfirstlane(tid >> 6);
    const int G = gridDim.x, gw = bid * NWAVES + wave, NGW = G * NWAVES;
    if (ph == N_PHASES - 1) {
        for (int t = gw; t < T; t += NGW) rms_row_f32(HRES + (size_t)t * D, a.in[I_NF], a.out + (size_t)t * D, lane);
        return;
    }
    const int l = ph / 9, sp = ph % 9;
    const float* hin = l == 0 ? a.in[I_X] : (const float*)HRES;
    switch (sp) {
    case 0: {
        LAS float* scr = (LAS float*)(lds + wave * 16384);
        constexpr int I_IN = (D / 64) * (PTP / 32), I_OUT = (D / 64) * (D / 32), I_UP = (D / 64) * (FF / 32), I_DN = (FF / 64) * (D / 32), I_L = I_IN + I_OUT + I_UP + I_DN;
        for (int it = gw; it < I_L; it += NGW) {
            int r = it;
            if (r < I_IN) { transpose_item(LP(I_WIN, (size_t)D * PT), D, PT, PTP, (bf16_t*)(a.ws + WS_WIN), scr, r, lane); continue; } r -= I_IN;
            if (r < I_OUT) { transpose_item(LP(I_WOUT, (size_t)D * D), D, D, D, (bf16_t*)(a.ws + WS_WOUT), scr, r, lane); continue; } r -= I_OUT;
            if (r < I_UP) { transpose_item(LP(I_WUP, (size_t)D * FF), D, FF, FF, (bf16_t*)(a.ws + WS_WUP), scr, r, lane); continue; } r -= I_UP;
            transpose_item(LP(I_WDN, (size_t)FF * D), FF, D, D, (bf16_t*)(a.ws + WS_WDN), scr, r, lane);
        }
        for (int t = gw; t < T; t += NGW) rms_row_bf16(hin + (size_t)t * D, LP(I_N1, D), (bf16_t*)(a.ws + WS_XN) + (size_t)t * D, lane);
    } break;
    case 1: { pg8::Gemm g{(const bf16_t*)(a.ws + WS_XN), (const bf16_t*)(a.ws + WS_WIN)}; pg8::StaticOrder<T, PTP> S; S.init(G, bid);
              pg8::EpiBf16<false> E{(bf16_t*)(a.ws + WS_PROJ), PTP}; pg8::gemm_phase<D, pg8::EpiBf16<false>, pg8::StaticOrder<T, PTP>, true>(lds, g, S, E, tid); } break;
    case 2: { LAS float* scr = (LAS float*)(lds + wave * 1024);
#pragma unroll 1
              for (int t = gw; t < T; t += NGW) prep_gdn(a, l, t, lane);
#pragma unroll 1
              for (int t = gw; t < T; t += NGW) prep_ret(a, l, t, lane);
#pragma unroll 1
              for (int t = gw; t < T; t += NGW) prep_ssd(a, l, t, lane);
#pragma unroll 1
              for (int t = gw; t < T; t += NGW) prep_rwkv(a, l, t, lane, scr); } break;
    case 3: { const int nb = 512 / (CPW * NWAVES);
              const int b = bid; if (b < 4 * nb) { const int mixer = b / nb, wv = (b % nb) * NWAVES + wave;
                  if (mixer == 0) scan_gdn(a, wv, lane); else if (mixer == 1) scan_ret(a, wv, lane); else if (mixer == 2) scan_ssd(a, l, wv, lane); else scan_rwkv(a, wv, lane); } } break;
    case 4: for (int t = gw; t < T; t += NGW) post_token(a, l, t, lane); break;
    case 5: { pg8::Gemm g{(const bf16_t*)(a.ws + WS_O), (const bf16_t*)(a.ws + WS_WOUT)}; pg8::StaticOrder<T, D> S; S.init(G, bid);
              pg8::EpiAddRes E{hin, HRES, D}; pg8::gemm_phase<D, pg8::EpiAddRes, pg8::StaticOrder<T, D>, false>(lds, g, S, E, tid); } break;
    case 6: for (int t = gw; t < T; t += NGW) rms_row_bf16(HRES + (size_t)t * D, LP(I_N2, D), (bf16_t*)(a.ws + WS_XN) + (size_t)t * D, lane); break;
    case 7: { pg8::Gemm g{(const bf16_t*)(a.ws + WS_XN), (const bf16_t*)(a.ws + WS_WUP)}; pg8::StaticOrder<T, FF> S; S.init(G, bid);
              pg8::EpiBf16<true> E{(bf16_t*)(a.ws + WS_HID), FF}; pg8::gemm_phase<D, pg8::EpiBf16<true>, pg8::StaticOrder<T, FF>, true>(lds, g, S, E, tid); } break;
    case 8: { pg8::Gemm g{(const bf16_t*)(a.ws + WS_HID), (const bf16_t*)(a.ws + WS_WDN)}; pg8::StaticOrder<T, D> S; S.init(G, bid);
              pg8::EpiAddRes E{HRES, HRES, D}; pg8::gemm_phase<FF, pg8::EpiAddRes, pg8::StaticOrder<T, D>, false>(lds, g, S, E, tid); } break;
    }
}

namespace cg = cooperative_groups;
__global__ void __launch_bounds__(NWAVES * 64, 2) fwd_kernel(Args a) {
    extern __shared__ __attribute__((aligned(16))) unsigned char lds_raw[];
    LAS unsigned char* lds = (LAS unsigned char*)lds_raw;
    const int ph_lo = a.ph_lo, ph_hi = a.ph_hi;
    for (int ph = ph_lo; ph < ph_hi; ++ph) {
        CArgs* ap = (CArgs*)__builtin_amdgcn_kernarg_segment_ptr();
        asm volatile("" : "+s"(ap));
        int tid = threadIdx.x, bid = blockIdx.x;
        asm volatile("" : "+v"(tid)); asm volatile("" : "+s"(bid));
        run_phase(*ap, ph, lds, tid, bid);
        if (ph + 1 < ph_hi) { cg::this_grid().sync(); }
    }
}

extern "C" void kernel_launch(void* const* d_in, const int* in_sizes, int n_in, void* d_out, int out_size, void* d_ws, size_t ws_size, hipStream_t stream) {
    static int grid = 0;
    if (grid == 0) {
        if (n_in != N_IN || in_sizes[0] != T * D || out_size != T * D || ws_size < WS_END) {
            fprintf(stderr, "kernel_launch: shape/workspace mismatch: n_in %d in0 %d out %d ws %zu (need %zu); nothing launched\n", n_in, n_in > 0 ? in_sizes[0] : -1, out_size, ws_size, (size_t)WS_END); grid = -1; return; }
        int dev = 0, cus = 0, per_cu = 0;
        if (hipGetDevice(&dev) != hipSuccess || hipDeviceGetAttribute(&cus, hipDeviceAttributeMultiprocessorCount, dev) != hipSuccess) { grid = -1; return; }
        if (hipFuncSetAttribute((const void*)fwd_kernel, hipFuncAttributeMaxDynamicSharedMemorySize, LDS_BYTES) != hipSuccess) { fprintf(stderr, "kernel_launch: hipFuncSetAttribute failed\n"); grid = -1; return; }
        if (hipOccupancyMaxActiveBlocksPerMultiprocessor(&per_cu, (const void*)fwd_kernel, NWAVES * 64, LDS_BYTES) != hipSuccess || per_cu < 1) { fprintf(stderr, "kernel_launch: occupancy query says %d blocks per CU\n", per_cu); per_cu = 1; }
        (void)hipGetLastError();
        grid = cus;
    }
    if (grid < 0) return;
    Args a{};
    for (int i = 0; i < N_IN; ++i) a.in[i] = (const float*)d_in[i];
    a.out = (float*)d_out; a.ws = (unsigned char*)d_ws;
#if N_LAUNCH_MODE == 1
    a.ph_lo = 0; a.ph_hi = N_PHASES;
    void* args[] = {&a};
    hipError_t e = hipLaunchCooperativeKernel((const void*)fwd_kernel, dim3(grid), dim3(NWAVES * 64), args, LDS_BYTES, stream);
    if (e != hipSuccess) fprintf(stderr, "kernel_launch: cooperative launch failed: %s (grid %d)\n", hipGetErrorString(e), grid);
#else
#ifndef DBG_MAXPH
#define DBG_MAXPH N_PHASES
#endif
    for (int ph = 0; ph < N_PHASES; ++ph) {
        if (ph >= DBG_MAXPH && ph != N_PHASES - 1) continue;
#ifdef DBG_SKIP_FINAL
        if (ph == N_PHASES - 1) continue;
#endif
        a.ph_lo = ph; a.ph_hi = ph + 1;
        hipLaunchKernelGGL(fwd_kernel, dim3(grid), dim3(NWAVES * 64), LDS_BYTES, stream, a);
    }
#endif
}
#endif
```

```cpp
#ifndef HOST_TEST
#include <hip/hip_runtime.h>
#include <hip/hip_cooperative_groups.h>
#endif
#include <cstdio>
#include <cstdint>
#include <cmath>
#include <cstddef>

#ifndef SEQ_T
#define SEQ_T 8192
#endif
#ifndef N_LAUNCH_MODE
#define N_LAUNCH_MODE 1
#endif

constexpr int T = SEQ_T, D = 2048, NL = 2, FF = 8192, PT = 6832, PTP = 6912;
constexpr int C_GQ = 0, C_GK = 512, C_GV = 1024, C_GZ = 1536, C_GB = 2048, C_GA = 2052;
constexpr int C_RQ = 2056, C_RK = 2312, C_RV = 2568, C_RG = 3080;
constexpr int C_MZ = 3592, C_MXBC = 4104, C_MDT = 5128;
constexpr int C_RW = 5136;
enum { I_X = 0, I_N1, I_WIN, I_GCONV, I_GALOG, I_GDTB, I_GNORM, I_RNORM, I_MCONV, I_MCONVB, I_MALOG, I_MDTB, I_MD, I_MNORM, I_RWMU, I_RWW0, I_RWWUP, I_RWA0, I_RWAUP,
       I_RWGUP, I_RWKK, I_RWKA, I_RWRK, I_RWLNW, I_RWLNB, I_WOUT, I_N2, I_WUP, I_WDN, I_NF, N_IN };

constexpr size_t MiB = 1u << 20;
constexpr size_t SZ_WIN = (size_t)PTP * D * 2, SZ_WOUT = (size_t)D * D * 2, SZ_WUP = (size_t)FF * D * 2, SZ_WDN = (size_t)D * FF * 2;
constexpr size_t WS_CTL = 0, CTL_BYTES = 1 * MiB;
constexpr size_t WS_WIN = WS_CTL + CTL_BYTES;
constexpr size_t WS_WOUT = WS_WIN + SZ_WIN;
constexpr size_t WS_WUP = WS_WOUT + SZ_WOUT;
constexpr size_t WS_WDN = WS_WUP + SZ_WUP;
constexpr size_t WS_XN = WS_WDN + SZ_WDN;
constexpr size_t WS_O = WS_XN;
constexpr size_t WS_PROJ = WS_XN + (size_t)T * D * 2;
constexpr size_t WS_HID = WS_PROJ;
constexpr size_t SZ_T512 = (size_t)T * 512 * 4;
constexpr size_t WS_GQ = WS_PROJ + (size_t)T * PTP * 2;
constexpr size_t WS_GK = WS_GQ + SZ_T512, WS_GV = WS_GK + SZ_T512;
constexpr size_t WS_GAB = WS_GV + SZ_T512;
constexpr size_t WS_RQ = WS_GAB + (size_t)T * 8 * 4;
constexpr size_t WS_RK = WS_RQ + (size_t)T * 256 * 4;
constexpr size_t WS_MXBC = WS_RK + (size_t)T * 256 * 4;
constexpr size_t WS_MDT = WS_MXBC + (size_t)T * 1024 * 4;
constexpr size_t WS_RWR = WS_MDT + (size_t)T * 16 * 4;
constexpr size_t WS_RWKK = WS_RWR + SZ_T512, WS_RWBB = WS_RWKK + SZ_T512, WS_RWD = WS_RWBB + SZ_T512, WS_RWKT = WS_RWD + SZ_T512, WS_RWV = WS_RWKT + SZ_T512, WS_RWG = WS_RWV + SZ_T512;
constexpr size_t WS_RKS = WS_RWG + SZ_T512;
constexpr size_t WS_OR = WS_RKS + (size_t)T * 8 * 4;
constexpr size_t WS_OD = WS_OR + SZ_T512;
constexpr size_t WS_END = WS_OD + SZ_T512;
static_assert(WS_HID + (size_t)T * FF * 2 <= WS_END, "HID overlay");
static_assert(SEQ_T != 8192 || WS_END <= 512 * MiB, "d_ws budget (512 MiB)");

typedef unsigned short bf16_t;
#ifdef HOST_TEST
#define DEV static inline
#define HD static inline
typedef float f32x4 __attribute__((vector_size(16)));
constexpr int WAVE = 1, LPC = 1;
static inline float wave_sum(float v) { return v; }
static inline float group_sum(float v) { return v; }
#else
#define DEV __device__ __forceinline__
#define HD __host__ __device__ __forceinline__
typedef float f32x4 __attribute__((ext_vector_type(4)));
constexpr int WAVE = 64, LPC = 16;
DEV float wave_sum(float v) {
#pragma unroll
    for (int o = 1; o < 64; o <<= 1) v += __shfl_xor(v, o);
    return v;
}
DEV float group_sum(float v) {
#pragma unroll
    for (int o = 1; o < 16; o <<= 1) v += __shfl_xor(v, o);
    return v;
}
#endif
constexpr int CPW = WAVE / LPC;

HD unsigned f2bf(float f) { unsigned u; __builtin_memcpy(&u, &f, 4); return (u + 0x7fffu + ((u >> 16) & 1u)) >> 16; }
HD unsigned pk2(float lo, float hi) { return f2bf(lo) | (f2bf(hi) << 16); }
HD float bf2f(bf16_t b) { unsigned u = (unsigned)b << 16; float f; __builtin_memcpy(&f, &u, 4); return f; }
DEV float sigmoid_f(float x) { return 1.0f / (1.0f + expf(-x)); }
DEV float silu_f(float x) { return x / (1.0f + expf(-x)); }
DEV float softplus_f(float x) { return x > 20.f ? x : log1pf(expf(x)); }

struct Args { const float* in[N_IN]; float* out; unsigned char* ws; int ph_lo, ph_hi; };
#ifdef HOST_TEST
typedef const Args CArgs;
#else
typedef const __attribute__((address_space(4))) Args CArgs;
#endif
#define WSF(off) ((float*)(a.ws + (off)))
#define HRES (a.out)
#define PROJROW(t) ((const bf16_t*)(a.ws + WS_PROJ) + (size_t)(t) * PTP)
#define LP(idx, per) (a.in[idx] + (size_t)l * (per))

DEV void rms_row_bf16(const float* x, const float* w, bf16_t* o, int lane) {
    float ss = 0.f;
    for (int i = lane * 4; i < D; i += WAVE * 4) { const f32x4 v = *(const f32x4*)(x + i); ss += (v[0] * v[0] + v[1] * v[1]) + (v[2] * v[2] + v[3] * v[3]); }
    const float r = 1.0f / sqrtf(wave_sum(ss) * (1.0f / D) + 1e-6f);
    for (int i = lane * 4; i < D; i += WAVE * 4) { const f32x4 v = *(const f32x4*)(x + i), g = *(const f32x4*)(w + i);
        unsigned* op = (unsigned*)(o + i); op[0] = pk2(v[0] * r * g[0], v[1] * r * g[1]); op[1] = pk2(v[2] * r * g[2], v[3] * r * g[3]); }
}
DEV void rms_row_f32(const float* x, const float* w, float* o, int lane) {
    float ss = 0.f;
    for (int i = lane * 4; i < D; i += WAVE * 4) { const f32x4 v = *(const f32x4*)(x + i); ss += (v[0] * v[0] + v[1] * v[1]) + (v[2] * v[2] + v[3] * v[3]); }
    const float r = 1.0f / sqrtf(wave_sum(ss) * (1.0f / D) + 1e-6f);
    for (int i = lane * 4; i < D; i += WAVE * 4) { const f32x4 v = *(const f32x4*)(x + i), g = *(const f32x4*)(w + i);
        f32x4 y; y[0] = v[0] * r * g[0]; y[1] = v[1] * r * g[1]; y[2] = v[2] * r * g[2]; y[3] = v[3] * r * g[3]; *(f32x4*)(o + i) = y; }
}

DEV float conv4(const bf16_t* projrow_t, int col, const float* w, int c, int wstride, int t) {
    float acc = 0.f;
#pragma unroll
    for (int j = 0; j < 4; ++j) { const int tt = t - 3 + j; if (tt >= 0) acc += w[j * wstride + c] * bf2f(projrow_t[(ptrdiff_t)(j - 3) * PTP + col]); }
    return acc;
}

#ifdef HOST_TEST
static const float THETA[32] = {
#else
__device__ const float THETA[32] = {
#endif
    1.000000000e+00f, 7.429639101e-01f, 5.519954562e-01f, 4.101127088e-01f, 3.046989739e-01f, 2.263803482e-01f, 1.681924462e-01f, 1.249609292e-01f, 9.284145385e-02f, 6.897785515e-02f,
    5.124806613e-02f, 3.807546571e-02f, 2.828869782e-02f, 2.101748064e-02f, 1.561523322e-02f, 1.160155423e-02f, 8.619536646e-03f, 6.404003594e-03f, 4.757945426e-03f, 3.534980817e-03f,
    2.626363887e-03f, 1.951293205e-03f, 1.449740841e-03f, 1.077104942e-03f, 8.002503891e-04f, 5.945570301e-04f, 4.417345626e-04f, 3.281927784e-04f, 2.438354713e-04f, 1.811609109e-04f,
    1.345960627e-04f, 9.999999747e-05f };

DEV void prep_gdn(CArgs& a, int l, int t, int lane) {
    const bf16_t* pr = PROJROW(t);
    {
        const float* cw = LP(I_GCONV, 4 * 1536);
        constexpr int NE = 128 / WAVE;
#pragma unroll 1
        for (int h = 0; h < 4; ++h) {
#pragma unroll 1
            for (int which = 0; which < 2; ++which) {
                float x[NE]; float ss = 0.f;
#pragma unroll
                for (int e = 0; e < NE; ++e) { const int c = which * 512 + h * 128 + lane + e * WAVE; x[e] = silu_f(conv4(pr, C_GQ + c, cw, c, 1536, t)); ss += x[e] * x[e]; }
                const float sc = (1.0f / sqrtf(wave_sum(ss) + 1e-6f)) * (which == 0 ? 0.08838834764831845f : 1.0f);
                float* o = WSF(which == 0 ? WS_GQ : WS_GK) + (size_t)t * 512 + h * 128;
#pragma unroll
                for (int e = 0; e < NE; ++e) o[lane + e * WAVE] = x[e] * sc;
            }
#pragma unroll
            for (int e = 0; e < NE; ++e) { const int c = 1024 + h * 128 + lane + e * WAVE; WSF(WS_GV)[(size_t)t * 512 + h * 128 + lane + e * WAVE] = silu_f(conv4(pr, C_GQ + c, cw, c, 1536, t)); }
        }
        for (int h = lane; h < 4; h += WAVE) {
            const float beta = sigmoid_f(bf2f(pr[C_GB + h]));
            const float la = -expf(LP(I_GALOG, 4)[h]) * softplus_f(bf2f(pr[C_GA + h]) + LP(I_GDTB, 4)[h]);
            WSF(WS_GAB)[(size_t)t * 8 + h * 2] = expf(la); WSF(WS_GAB)[(size_t)t * 8 + h * 2 + 1] = beta;
        }
    }
}
DEV void prep_ret(CArgs& a, int l, int t, int lane) {
    const bf16_t* pr = PROJROW(t);
#pragma unroll 1
    for (int p = lane; p < 128; p += WAVE) {
        const int i = p & 31; const float ang = (float)t * THETA[i]; float sn, cs;
#ifdef HOST_TEST
        sn = sinf(ang); cs = cosf(ang);
#else
        sincosf(ang, &sn, &cs);
#endif
        const float q0 = bf2f(pr[C_RQ + 2 * p]), q1 = bf2f(pr[C_RQ + 2 * p + 1]), k0 = bf2f(pr[C_RK + 2 * p]), k1 = bf2f(pr[C_RK + 2 * p + 1]);
        float* oq = WSF(WS_RQ) + (size_t)t * 256 + 2 * p; float* ok = WSF(WS_RK) + (size_t)t * 256 + 2 * p;
        oq[0] = q0 * cs - q1 * sn; oq[1] = q1 * cs + q0 * sn;
        ok[0] = (k0 * cs - k1 * sn) * 0.125f; ok[1] = (k1 * cs + k0 * sn) * 0.125f;
    }
}
DEV void prep_ssd(CArgs& a, int l, int t, int lane) {
    const bf16_t* pr = PROJROW(t);
    {
        const float* cw = LP(I_MCONV, 4 * 1024); const float* cb = LP(I_MCONVB, 1024);
#pragma unroll 2
        for (int c = lane; c < 1024; c += WAVE) WSF(WS_MXBC)[(size_t)t * 1024 + c] = silu_f(conv4(pr, C_MXBC + c, cw, c, 1024, t) + cb[c]);
        for (int h = lane; h < 8; h += WAVE) {
            const float dt = softplus_f(bf2f(pr[C_MDT + h]) + LP(I_MDTB, 8)[h]); const float A = -expf(LP(I_MALOG, 8)[h]);
            WSF(WS_MDT)[(size_t)t * 16 + 2 * h] = dt; WSF(WS_MDT)[(size_t)t * 16 + 2 * h + 1] = expf(dt * A);
        }
    }
}
template <class SCR> DEV void prep_rwkv(CArgs& a, int l, int t, int lane, SCR scr) {
    const bf16_t* pr = PROJROW(t);
    {
        const float* mu = LP(I_RWMU, 1696); const bf16_t* p1 = pr + C_RW; const bf16_t* p0 = p1 - PTP;
        for (int j = lane; j < 160; j += WAVE) { const int c = 1536 + j; const float cur = bf2f(p1[c]), prev = t > 0 ? bf2f(p0[c]) : 0.f; const float m = cur + (prev - cur) * mu[c];
            scr[j] = j < 32 ? tanhf(m) : (j < 64 ? m : sigmoid_f(m)); }
#ifndef HOST_TEST
        asm volatile("s_waitcnt lgkmcnt(0)" ::: "memory");
#endif
        const float* wup = LP(I_RWWUP, 32 * 512); const float* aup = LP(I_RWAUP, 32 * 512); const float* gup = LP(I_RWGUP, 96 * 512);
        constexpr int NE = 64 / WAVE;
#pragma unroll 1
        for (int h = 0; h < 8; ++h) {
            float r_[NE], kt_[NE], kk_[NE], a_[NE]; float ss = 0.f, rk = 0.f;
#pragma unroll
            for (int e = 0; e < NE; ++e) {
                const int c = h * 64 + lane + e * WAVE;
                float lw = 0.f, la = 0.f, lg = 0.f;
#pragma unroll 8
                for (int j = 0; j < 32; ++j) { lw += scr[j] * wup[j * 512 + c]; la += scr[32 + j] * aup[j * 512 + c]; }
#pragma unroll 8
                for (int j = 0; j < 96; ++j) lg += scr[64 + j] * gup[j * 512 + c];
                const float cr = bf2f(p1[c]), ck = bf2f(p1[512 + c]), cv = bf2f(p1[1024 + c]);
                const float pr_ = t > 0 ? bf2f(p0[c]) : 0.f, pk_ = t > 0 ? bf2f(p0[512 + c]) : 0.f, pv_ = t > 0 ? bf2f(p0[1024 + c]) : 0.f;
                const float r = cr + (pr_ - cr) * mu[c], k = ck + (pk_ - ck) * mu[512 + c], v = cv + (pv_ - cv) * mu[1024 + c];
                const float wraw = -softplus_f(-(LP(I_RWW0, 512)[c] + lw)) - 0.5f;
                const float dec = expf(-expf(wraw));
                const float av = sigmoid_f(LP(I_RWA0, 512)[c] + la);
                const float kkr = k * LP(I_RWKK, 512)[c];
                const float kt = k * (1.0f + (av - 1.0f) * LP(I_RWKA, 512)[c]);
                r_[e] = r; kt_[e] = kt; kk_[e] = kkr; a_[e] = av; ss += kkr * kkr; rk += r * kt * LP(I_RWRK, 512)[c];
                const size_t o = (size_t)t * 512 + c;
                WSF(WS_RWR)[o] = r; WSF(WS_RWD)[o] = dec; WSF(WS_RWKT)[o] = kt; WSF(WS_RWV)[o] = v; WSF(WS_RWG)[o] = lg;
            }
            ss = wave_sum(ss); rk = wave_sum(rk);
            const float inv = 1.0f / sqrtf(ss + 1e-6f);
#pragma unroll
            for (int e = 0; e < NE; ++e) { const size_t o = (size_t)t * 512 + h * 64 + lane + e * WAVE; const float kk = kk_[e] * inv; WSF(WS_RWKK)[o] = kk; WSF(WS_RWBB)[o] = kk * a_[e]; }
            if (lane == 0) WSF(WS_RKS)[(size_t)t * 8 + h] = rk;
        }
    }
}

DEV void post_token(CArgs& a, int l, int t, int lane) {
    const bf16_t* pr = PROJROW(t); bf16_t* O = (bf16_t*)(a.ws + WS_O) + (size_t)t * D;
    {
        constexpr int NE = 128 / WAVE; const float* w = LP(I_GNORM, 128);
        for (int h = 0; h < 4; ++h) { float x[NE]; float ss = 0.f;
#pragma unroll
            for (int e = 0; e < NE; ++e) { x[e] = WSF(WS_GV)[(size_t)t * 512 + h * 128 + lane + e * WAVE]; ss += x[e] * x[e]; }
            const float r = 1.0f / sqrtf(wave_sum(ss) * (1.0f / 128) + 1e-6f);
#pragma unroll
            for (int e = 0; e < NE; ++e) { const int i = lane + e * WAVE; O[h * 128 + i] = (bf16_t)f2bf(x[e] * r * w[i] * silu_f(bf2f(pr[C_GZ + h * 128 + i]))); } }
    }
    {
        constexpr int NE = 128 / WAVE; const float* w = LP(I_RNORM, 512);
        for (int h = 0; h < 4; ++h) { float x[NE]; float s = 0.f;
#pragma unroll
            for (int e = 0; e < NE; ++e) { x[e] = WSF(WS_OR)[(size_t)t * 512 + h * 128 + lane + e * WAVE]; s += x[e]; }
            const float mu = wave_sum(s) * (1.0f / 128); float q = 0.f;
#pragma unroll
            for (int e = 0; e < NE; ++e) { x[e] -= mu; q += x[e] * x[e]; }
            const float r = 1.0f / sqrtf(wave_sum(q) * (1.0f / 128) + 1e-6f);
#pragma unroll
            for (int e = 0; e < NE; ++e) { const int c = h * 128 + lane + e * WAVE; O[512 + c] = (bf16_t)f2bf(x[e] * r * w[c] * silu_f(bf2f(pr[C_RG + c]))); } }
    }
    {
        constexpr int NE = 256 / WAVE; const float* w = LP(I_MNORM, 512);
        for (int g = 0; g < 2; ++g) { float x[NE]; float ss = 0.f;
#pragma unroll
            for (int e = 0; e < NE; ++e) { const int c = g * 256 + lane + e * WAVE;
                x[e] = WSF(WS_MXBC)[(size_t)t * 1024 + c] * silu_f(bf2f(pr[C_MZ + c])); ss += x[e] * x[e]; }
            const float r = 1.0f / sqrtf(wave_sum(ss) * (1.0f / 256) + 1e-6f);
#pragma unroll
            for (int e = 0; e < NE; ++e) { const int c = g * 256 + lane + e * WAVE; O[1024 + c] = (bf16_t)f2bf(x[e] * r * w[c]); } }
    }
    {
        constexpr int NE = 64 / WAVE; const float* w = LP(I_RWLNW, 512); const float* b = LP(I_RWLNB, 512);
        for (int h = 0; h < 8; ++h) { float x[NE]; float s = 0.f;
#pragma unroll
            for (int e = 0; e < NE; ++e) { x[e] = WSF(WS_OD)[(size_t)t * 512 + h * 64 + lane + e * WAVE]; s += x[e]; }
            const float mu = wave_sum(s) * (1.0f / 64); float q = 0.f;
#pragma unroll
            for (int e = 0; e < NE; ++e) { x[e] -= mu; q += x[e] * x[e]; }
            const float r = 1.0f / sqrtf(wave_sum(q) * (1.0f / 64) + 64e-5f); const float rks = WSF(WS_RKS)[(size_t)t * 8 + h];
#pragma unroll
            for (int e = 0; e < NE; ++e) { const int c = h * 64 + lane + e * WAVE; const size_t o = (size_t)t * 512 + c;
                const float y = x[e] * r * w[c] + b[c] + rks * WSF(WS_RWV)[o]; O[1536 + c] = (bf16_t)f2bf(y * WSF(WS_RWG)[o]); } }
    }
}

constexpr int SCAN_U = 4;
DEV void scan_gdn(CArgs& a, int wv, int lane) {
    constexpr int NS = 128 / LPC; const int sub = lane % LPC, col = wv * CPW + lane / LPC, h = col >> 7;
    const float* GK = WSF(WS_GK) + h * 128 + sub * NS; const float* GQ = WSF(WS_GQ) + h * 128 + sub * NS; float* GV = WSF(WS_GV) + col; const float* AB = WSF(WS_GAB) + h * 2; float* OG = GV;
    float s[NS];
#pragma unroll
    for (int i = 0; i < NS; ++i) s[i] = 0.f;
    for (int t0 = 0; t0 < T; t0 += SCAN_U) {
        float kb[SCAN_U][NS], qb[SCAN_U][NS], vb[SCAN_U], ab[SCAN_U], bb[SCAN_U];
#pragma unroll
        for (int u = 0; u < SCAN_U; ++u) { const size_t t = t0 + u;
#pragma unroll
            for (int i = 0; i < NS; i += 4) { const f32x4 kv = *(const f32x4*)(GK + t * 512 + i), qv = *(const f32x4*)(GQ + t * 512 + i);
                kb[u][i] = kv[0]; kb[u][i + 1] = kv[1]; kb[u][i + 2] = kv[2]; kb[u][i + 3] = kv[3]; qb[u][i] = qv[0]; qb[u][i + 1] = qv[1]; qb[u][i + 2] = qv[2]; qb[u][i + 3] = qv[3]; }
            vb[u] = GV[t * 512]; ab[u] = AB[t * 8]; bb[u] = AB[t * 8 + 1]; }
#pragma unroll
        for (int u = 0; u < SCAN_U; ++u) {
            float d = 0.f;
#pragma unroll
            for (int i = 0; i < NS; ++i) d += kb[u][i] * s[i];
            d = group_sum(d);
            const float c = bb[u] * (vb[u] - ab[u] * d); float o = 0.f;
#pragma unroll
            for (int i = 0; i < NS; ++i) { s[i] = ab[u] * s[i] + kb[u][i] * c; o += qb[u][i] * s[i]; }
            o = group_sum(o);
            if (sub == 0) OG[(size_t)(t0 + u) * 512] = o;
        }
    }
}
DEV void scan_ret(CArgs& a, int wv, int lane) {
    constexpr int NS = 64 / LPC; const int sub = lane % LPC, col = wv * CPW + lane / LPC, h = col >> 7;
    const float* RK = WSF(WS_RK) + h * 64 + sub * NS; const float* RQ = WSF(WS_RQ) + h * 64 + sub * NS; const bf16_t* RV = PROJROW(0) + C_RV + col; float* OR = WSF(WS_OR) + col;
    const float gam = 1.0f - exp2f(-5.0f - (float)h);
    float s[NS];
#pragma unroll
    for (int i = 0; i < NS; ++i) s[i] = 0.f;
    for (int t0 = 0; t0 < T; t0 += SCAN_U) {
        float kb[SCAN_U][NS], qb[SCAN_U][NS], vb[SCAN_U];
#pragma unroll
        for (int u = 0; u < SCAN_U; ++u) { const size_t t = t0 + u;
#pragma unroll
            for (int i = 0; i < NS; i += 4) { const f32x4 kv = *(const f32x4*)(RK + t * 256 + i), qv = *(const f32x4*)(RQ + t * 256 + i);
                kb[u][i] = kv[0]; kb[u][i + 1] = kv[1]; kb[u][i + 2] = kv[2]; kb[u][i + 3] = kv[3]; qb[u][i] = qv[0]; qb[u][i + 1] = qv[1]; qb[u][i + 2] = qv[2]; qb[u][i + 3] = qv[3]; }
            vb[u] = bf2f(RV[t * PTP]); }
#pragma unroll
        for (int u = 0; u < SCAN_U; ++u) {
            float o = 0.f;
#pragma unroll
            for (int i = 0; i < NS; ++i) { s[i] = gam * s[i] + kb[u][i] * vb[u]; o += qb[u][i] * s[i]; }
            o = group_sum(o);
            if (sub == 0) OR[(size_t)(t0 + u) * 512] = o;
        }
    }
}
DEV void scan_ssd(CArgs& a, int l, int wv, int lane) {
    constexpr int NS = 128 / LPC; const int sub = lane % LPC, col = wv * CPW + lane / LPC, h = col >> 6, g = h >> 2;
    const float* MB = WSF(WS_MXBC) + 512 + g * 128 + sub * NS; const float* MC = WSF(WS_MXBC) + 768 + g * 128 + sub * NS; float* MX = WSF(WS_MXBC) + col; const float* DT = WSF(WS_MDT) + h * 2; float* OC = MX; const float Dh = LP(I_MD, 8)[h];
    float s[NS];
#pragma unroll
    for (int i = 0; i < NS; ++i) s[i] = 0.f;
    for (int t0 = 0; t0 < T; t0 += SCAN_U) {
        float Bb[SCAN_U][NS], Cb[SCAN_U][NS], xb[SCAN_U], db[SCAN_U], xr[SCAN_U];
#pragma unroll
        for (int u = 0; u < SCAN_U; ++u) { const size_t t = t0 + u;
#pragma unroll
            for (int i = 0; i < NS; i += 4) { const f32x4 bv = *(const f32x4*)(MB + t * 1024 + i), cv = *(const f32x4*)(MC + t * 1024 + i);
                Bb[u][i] = bv[0]; Bb[u][i + 1] = bv[1]; Bb[u][i + 2] = bv[2]; Bb[u][i + 3] = bv[3]; Cb[u][i] = cv[0]; Cb[u][i + 1] = cv[1]; Cb[u][i + 2] = cv[2]; Cb[u][i + 3] = cv[3]; }
            xr[u] = MX[t * 1024]; xb[u] = xr[u] * DT[t * 16]; db[u] = DT[t * 16 + 1]; }
#pragma unroll
        for (int u = 0; u < SCAN_U; ++u) {
            float y = 0.f;
#pragma unroll
            for (int i = 0; i < NS; ++i) { s[i] = db[u] * s[i] + Bb[u][i] * xb[u]; y += Cb[u][i] * s[i]; }
            y = group_sum(y);
            if (sub == 0) OC[(size_t)(t0 + u) * 1024] = y + Dh * xr[u];
        }
    }
}
DEV void scan_rwkv(CArgs& a, int wv, int lane) {
    constexpr int NS = 64 / LPC; const int sub = lane % LPC, row = wv * CPW + lane / LPC, h = row >> 6; const size_t vo = (size_t)h * 64 + sub * NS;
    const float* KK = WSF(WS_RWKK) + vo; const float* BB = WSF(WS_RWBB) + vo; const float* DD = WSF(WS_RWD) + vo; const float* KT = WSF(WS_RWKT) + vo; const float* RR = WSF(WS_RWR) + vo; const float* VV = WSF(WS_RWV) + row; float* OD = WSF(WS_OD) + row;
    float s[NS];
#pragma unroll
    for (int i = 0; i < NS; ++i) s[i] = 0.f;
    for (int t0 = 0; t0 < T; t0 += SCAN_U) {
        float kk[SCAN_U][NS], bb[SCAN_U][NS], dd[SCAN_U][NS], kt[SCAN_U][NS], rr[SCAN_U][NS], vb[SCAN_U];
#pragma unroll
        for (int u = 0; u < SCAN_U; ++u) { const size_t t = t0 + u;
#pragma unroll
            for (int i = 0; i < NS; i += 4) { const f32x4 v0 = *(const f32x4*)(KK + t * 512 + i), v1 = *(const f32x4*)(BB + t * 512 + i), v2 = *(const f32x4*)(DD + t * 512 + i), v3 = *(const f32x4*)(KT + t * 512 + i), v4 = *(const f32x4*)(RR + t * 512 + i);
#pragma unroll
                for (int j = 0; j < 4; ++j) { kk[u][i + j] = v0[j]; bb[u][i + j] = v1[j]; dd[u][i + j] = v2[j]; kt[u][i + j] = v3[j]; rr[u][i + j] = v4[j]; } }
            vb[u] = VV[t * 512]; }
#pragma unroll
        for (int u = 0; u < SCAN_U; ++u) {
            float sa = 0.f;
#pragma unroll
            for (int i = 0; i < NS; ++i) sa += s[i] * kk[u][i];
            sa = -group_sum(sa); float y = 0.f;
#pragma unroll
            for (int i = 0; i < NS; ++i) { s[i] = s[i] * dd[u][i] + sa * bb[u][i] + vb[u] * kt[u][i]; y += s[i] * rr[u][i]; }
            y = group_sum(y);
            if (sub == 0) OD[(size_t)(t0 + u) * 512] = y;
        }
    }
}

#ifndef HOST_TEST
namespace pg8 {
#define PG8_LAS __attribute__((address_space(3)))
typedef short bf16x8 __attribute__((ext_vector_type(8)));
typedef unsigned u32x4 __attribute__((ext_vector_type(4)));
constexpr int BM = 256, BK = 64, HALF = 128, HTB = HALF * BK * 2, STAGE_BYTES = 8 * HTB, NXCD = 8, WGM = 8;
__host__ __device__ __forceinline__ int lds_byte(int r, int c) { const int st = (r >> 4) * 2 + (c >> 5), rr = r & 15, cc = c & 31, ob = rr * 64 + cc * 2; return st * 1024 + (ob ^ (((ob >> 9) & 1) << 5)); }
__host__ __device__ __forceinline__ void stage_rc(int b, int& R, int& C) { const int st = b / 1024, sb = b % 1024, swz = sb ^ (((sb >> 9) & 1) << 5); R = (st >> 1) * 16 + swz / 64; C = (st & 1) * 32 + (swz % 64) / 2; }
__host__ __device__ __forceinline__ int perm32(int rho) { const int n = rho >> 4, i = rho & 15; return 8 * (i >> 2) + 4 * n + (i & 3); }
struct Unit { int pm, pn; };
struct Gemm { const bf16_t* A; const bf16_t* Bt; };
template <int M, int N> struct StaticOrder {
    static constexpr int nM = M / BM, nN = N / BM, nwg = nM * nN; int G, c;
    __device__ void init(int G_, int c_) { G = G_; c = c_; }
    __device__ bool next(int i, Unit& u) const {
        const long L = (long)i * G + c; if (L >= nwg) return false;
        int wgid = (int)L; { const int q = nwg / NXCD, r = nwg % NXCD, xcd = wgid % NXCD, off = wgid / NXCD; wgid = (xcd < r ? xcd * (q + 1) : r * (q + 1) + (xcd - r) * q) + off; }
        const int nig = WGM * nN, gid = wgid / nig, fm = gid * WGM, gsz = (nM - fm) < WGM ? (nM - fm) : WGM;
        u.pm = fm + ((wgid % nig) % gsz); u.pn = (wgid % nig) / gsz; return true;
    }
    __device__ __forceinline__ void a_ready(const Unit&) const {}
    __device__ __forceinline__ void done(const Unit&) const {}
};
__device__ __forceinline__ unsigned cvt_pk_bf16(float lo, float hi) { unsigned r; asm volatile("v_cvt_pk_bf16_f32 %0, %1, %2" : "=v"(r) : "v"(lo), "v"(hi)); return r; }
struct EpiStoreF32 {
    static constexpr bool PERM = false, AFTER_DRAIN = false; float* O; int ldc;
    __device__ __forceinline__ void operator()(const f32x4 (&acc)[2][2][4][2], const Unit& u, int wr, int wc, int fr, int fq) const {
        const int row0 = u.pm * BM + wr * 64 + fr, col0 = u.pn * BM + wc * 32 + 4 * fq;
#pragma unroll
        for (int ai = 0; ai < 2; ++ai)
#pragma unroll
            for (int m = 0; m < 4; ++m) { float* rowp = O + (size_t)(row0 + ai * HALF + m * 16) * ldc + col0;
#pragma unroll
                for (int bj = 0; bj < 2; ++bj)
#pragma unroll
                    for (int n = 0; n < 2; ++n) *(f32x4*)(rowp + bj * HALF + n * 16) = acc[ai][bj][m][n]; }
    }
};
struct EpiAddRes {
    static constexpr bool PERM = false, AFTER_DRAIN = false; const float* B; float* O; int ldc;
    __device__ __forceinline__ void operator()(const f32x4 (&acc)[2][2][4][2], const Unit& u, int wr, int wc, int fr, int fq) const {
        const int row0 = u.pm * BM + wr * 64 + fr, col0 = u.pn * BM + wc * 32 + 4 * fq;
#pragma unroll
        for (int ai = 0; ai < 2; ++ai)
#pragma unroll
            for (int m = 0; m < 4; ++m) { float* rowp = O + (size_t)(row0 + ai * HALF + m * 16) * ldc + col0; const float* bp = B + (size_t)(row0 + ai * HALF + m * 16) * ldc + col0;
                f32x4 b[2][2];
#pragma unroll
                for (int bj = 0; bj < 2; ++bj)
#pragma unroll
                    for (int n = 0; n < 2; ++n) b[bj][n] = *(const f32x4*)(bp + bj * HALF + n * 16);
#pragma unroll
                for (int bj = 0; bj < 2; ++bj)
#pragma unroll
                    for (int n = 0; n < 2; ++n) *(f32x4*)(rowp + bj * HALF + n * 16) = b[bj][n] + acc[ai][bj][m][n]; }
    }
};
template <bool SQRELU> struct EpiBf16 {
    static constexpr bool PERM = true, AFTER_DRAIN = false; bf16_t* O; int ldc;
    __device__ __forceinline__ void operator()(const f32x4 (&acc)[2][2][4][2], const Unit& u, int wr, int wc, int fr, int fq) const {
        const int row0 = u.pm * BM + wr * 64 + fr, col0 = u.pn * BM + wc * 32 + 8 * fq;
#pragma unroll
        for (int ai = 0; ai < 2; ++ai)
#pragma unroll
            for (int m = 0; m < 4; ++m) { bf16_t* rowp = O + (size_t)(row0 + ai * HALF + m * 16) * ldc + col0;
#pragma unroll
                for (int bj = 0; bj < 2; ++bj) { f32x4 v0 = acc[ai][bj][m][0], v1 = acc[ai][bj][m][1];
                    if (SQRELU) {
#pragma unroll
                        for (int j = 0; j < 4; ++j) { const float p0 = fmaxf(v0[j], 0.f), p1 = fmaxf(v1[j], 0.f); v0[j] = p0 * p0; v1[j] = p1 * p1; } }
                    u32x4 w; w.x = cvt_pk_bf16(v0[0], v0[1]); w.y = cvt_pk_bf16(v0[2], v0[3]); w.z = cvt_pk_bf16(v1[0], v1[1]); w.w = cvt_pk_bf16(v1[2], v1[3]);
                    *(u32x4*)(rowp + bj * HALF) = w; } }
    }
};

template <int K, class Epi, class Sched, bool ALIGN_EPI = false>
__device__ __forceinline__ void gemm_phase(PG8_LAS unsigned char* lds, const Gemm g, const Sched& S, const Epi& E, const int tid) {
    const int wid = __builtin_amdgcn_readfirstlane(tid >> 6), lane = tid & 63, wr = wid >> 2, wc = wid & 3, fr = lane & 15, fq = lane >> 4;
    constexpr int nt = K / BK;
    unsigned voffA[2], voffB[2];
#pragma unroll
    for (int i = 0; i < 2; ++i) { int R, C; stage_rc(tid * 16 + i * 8192, R, C); const int Rb = Epi::PERM ? ((R & ~31) + perm32(R & 31)) : R;
        voffA[i] = (unsigned)(R * K + C) * 2u; voffB[i] = (unsigned)(Rb * K + C) * 2u; }
    const size_t kstep = (size_t)(BK * 2);
    const size_t hstep = (size_t)HALF * K * 2;
    const size_t tstep = 2 * hstep;
    const unsigned ldsw = (unsigned)wid * 1024u;
    const int aoff = lds_byte(wr * 64 + fr, fq * 8), boff = lds_byte(wc * 32 + fr, fq * 8);
#define PG8_SA(b, h) (((b) * 2 + (h)) * HTB)
#define PG8_SB(b, h) ((4 + (b) * 2 + (h)) * HTB)
#define PG8_STAGE(bufoff, gbase, voff) do { _Pragma("unroll") for (int _i = 0; _i < 2; ++_i) \
        __builtin_amdgcn_global_load_lds((const unsigned*)((const char*)(gbase) + (voff)[_i]), (PG8_LAS unsigned*)(lds + (bufoff) + ldsw + _i * 8192), 16, 0, 0); } while (0)
#define PG8_LDA(dst, b, h) do { _Pragma("unroll") for (int m = 0; m < 4; ++m) _Pragma("unroll") for (int k = 0; k < 2; ++k) dst[m][k] = *(const PG8_LAS bf16x8*)(lds + PG8_SA(b, h) + aoff + m * 2048 + k * 1024); } while (0)
#define PG8_LDB(dst, b, h) do { _Pragma("unroll") for (int n = 0; n < 2; ++n) _Pragma("unroll") for (int k = 0; k < 2; ++k) dst[n][k] = *(const PG8_LAS bf16x8*)(lds + PG8_SB(b, h) + boff + n * 2048 + k * 1024); } while (0)
#define PG8_MMA(ai, bj, At, Bt) do { __builtin_amdgcn_s_setprio(1); _Pragma("unroll") for (int m = 0; m < 4; ++m) _Pragma("unroll") for (int n = 0; n < 2; ++n) _Pragma("unroll") for (int k = 0; k < 2; ++k) \
        acc[ai][bj][m][n] = __builtin_amdgcn_mfma_f32_16x16x32_bf16(Bt[n][k], At[m][k], acc[ai][bj][m][n], 0, 0, 0); __builtin_amdgcn_s_setprio(0); } while (0)
#define PG8_WAIT_V(n) asm volatile("s_waitcnt vmcnt(" #n ")" ::: "memory")
#define PG8_WAIT_L(n) asm volatile("s_waitcnt lgkmcnt(" #n ")" ::: "memory")
#define PG8_BAR __builtin_amdgcn_s_barrier()
#define PG8_SCHED __builtin_amdgcn_sched_barrier(0)
    Unit cur, nxt; int ui = 0;
    if (!S.next(0, cur)) return;
    f32x4 acc[2][2][4][2];
#pragma unroll
    for (int a = 0; a < 2; ++a)
#pragma unroll
        for (int b = 0; b < 2; ++b)
#pragma unroll
            for (int m = 0; m < 4; ++m)
#pragma unroll
                for (int n = 0; n < 2; ++n) acc[a][b][m][n] = (f32x4){0.f, 0.f, 0.f, 0.f};
    bf16x8 At[4][2], B0[2][2], B1[2][2];
    const char* cA = (const char*)g.A + (size_t)cur.pm * tstep; const char* cB = (const char*)g.Bt + (size_t)cur.pn * tstep;
    S.a_ready(cur);
    PG8_STAGE(PG8_SB(0, 0), cB, voffB); PG8_STAGE(PG8_SB(0, 1), cB + hstep, voffB); PG8_STAGE(PG8_SA(0, 0), cA, voffA); PG8_STAGE(PG8_SA(0, 1), cA + hstep, voffA);
    if (wr == 1) PG8_BAR;
    PG8_WAIT_V(2); PG8_BAR;
    PG8_STAGE(PG8_SB(1, 0), cB + kstep, voffB); PG8_STAGE(PG8_SA(1, 0), cA + kstep, voffA); PG8_STAGE(PG8_SB(1, 1), cB + hstep + kstep, voffB);
    PG8_WAIT_V(6); PG8_BAR;
    for (;;) {
        const bool has_next = S.next(ui + 1, nxt);
        const char* nA = has_next ? (const char*)g.A + (size_t)nxt.pm * tstep : cA; const char* nB = has_next ? (const char*)g.Bt + (size_t)nxt.pn * tstep : cB;
        for (int t = 0; t < nt; t += 2) {
            const bool last = (t == nt - 2);
            const char* a1 = cA + (size_t)(t + 1) * kstep;
            const char* a2 = last ? nA : cA + (size_t)(t + 2) * kstep; const char* b2 = last ? nB : cB + (size_t)(t + 2) * kstep;
            const char* a3 = a2 + kstep; const char* b3 = b2 + kstep;
            if (last && has_next) S.a_ready(nxt);
            PG8_LDB(B0, 0, 0); PG8_LDB(B1, 0, 1); PG8_SCHED; PG8_LDA(At, 0, 0); PG8_STAGE(PG8_SA(1, 1), a1 + hstep, voffA);
            PG8_WAIT_V(8); PG8_WAIT_L(0); PG8_BAR; PG8_MMA(0, 0, At, B0); PG8_MMA(0, 1, At, B1); PG8_BAR; PG8_SCHED;
            PG8_LDA(At, 0, 1); PG8_STAGE(PG8_SB(0, 0), b2, voffB); PG8_STAGE(PG8_SB(0, 1), b2 + hstep, voffB); PG8_STAGE(PG8_SA(0, 0), a2, voffA);
            PG8_WAIT_V(8); PG8_WAIT_L(0); PG8_BAR; PG8_MMA(1, 0, At, B0); PG8_MMA(1, 1, At, B1); PG8_BAR; PG8_SCHED;
            PG8_LDB(B0, 1, 0); PG8_LDB(B1, 1, 1); PG8_SCHED; PG8_LDA(At, 1, 0); PG8_STAGE(PG8_SA(0, 1), a2 + hstep, voffA);
            PG8_WAIT_V(8); PG8_WAIT_L(0); PG8_BAR; PG8_MMA(0, 0, At, B0); PG8_MMA(0, 1, At, B1); PG8_BAR; PG8_SCHED;
            PG8_LDA(At, 1, 1); PG8_STAGE(PG8_SB(1, 0), b3, voffB); PG8_STAGE(PG8_SB(1, 1), b3 + hstep, voffB); PG8_STAGE(PG8_SA(1, 0), a3, voffA);
            PG8_WAIT_V(8); PG8_WAIT_L(0); PG8_BAR; PG8_MMA(1, 0, At, B0); PG8_MMA(1, 1, At, B1); PG8_BAR; PG8_SCHED;
        }
        if constexpr (ALIGN_EPI) { if (wr == 0) PG8_BAR; }
        E(acc, cur, wr, wc, fr, fq); S.done(cur);
        if (!has_next) break;
#pragma unroll
        for (int a = 0; a < 2; ++a)
#pragma unroll
            for (int b = 0; b < 2; ++b)
#pragma unroll
                for (int m = 0; m < 4; ++m)
#pragma unroll
                    for (int n = 0; n < 2; ++n) acc[a][b][m][n] = (f32x4){0.f, 0.f, 0.f, 0.f};
        cur = nxt; cA = nA; cB = nB; ++ui;
        if constexpr (ALIGN_EPI) { if (wr == 1) PG8_BAR; }
    }
    PG8_WAIT_V(0);
    if constexpr (!ALIGN_EPI) { if (wr == 0) PG8_BAR; }
    PG8_BAR;
#undef PG8_SA
#undef PG8_SB
#undef PG8_STAGE
#undef PG8_LDA
#undef PG8_LDB
#undef PG8_MMA
#undef PG8_WAIT_V
#undef PG8_WAIT_L
#undef PG8_BAR
#undef PG8_SCHED
}
}

#define LAS __attribute__((address_space(3)))
#define GAS __attribute__((address_space(1)))
typedef unsigned v4u __attribute__((ext_vector_type(4)));
constexpr int NWAVES = 8, LDS_BYTES = 147456, RING_BYTES = 131072;
#define LDS_WAIT() asm volatile("s_waitcnt lgkmcnt(0)" ::: "memory")

__device__ __forceinline__ void transpose_item(const float* W, int K, int N, int Npad, bf16_t* WT, LAS float* scr, int item, int lane) {
    const int nblk = Npad / 32, kb = item / nblk, nb = item % nblk, k0 = 64 * kb, n0 = 32 * nb;
    const int n = n0 + (lane & 31); const bool ok = n < N;
#pragma unroll 8
    for (int i = 0; i < 32; ++i) { const int kk = 2 * i + (lane >> 5); scr[kk * 33 + (lane & 31)] = ok ? W[(size_t)(k0 + kk) * N + n] : 0.f; }
    LDS_WAIT(); asm volatile("" ::: "memory");
    const int c = lane & 7;
#pragma unroll
    for (int j = 0; j < 4; ++j) { const int nn = (lane >> 3) + 8 * j; const LAS float* s = scr + (8 * c) * 33 + nn;
        v4u o; o.x = pk2(s[0 * 33], s[1 * 33]); o.y = pk2(s[2 * 33], s[3 * 33]); o.z = pk2(s[4 * 33], s[5 * 33]); o.w = pk2(s[6 * 33], s[7 * 33]);
        *(GAS v4u*)(WT + (size_t)(n0 + nn) * K + k0 + 8 * c) = o; }
    LDS_WAIT(); asm volatile("" ::: "memory");
}

constexpr int N_PHASES = 1 + 9 * NL;

__device__ __forceinline__ void run_phase(CArgs& a, int ph, LAS unsigned char* lds, const int tid, const int bid) {
    const int lane = tid & 63, wave = __builtin_amdgcn_readfirstlane(tid >> 6);
    const int G = gridDim.x, gw = bid * NWAVES + wave, NGW = G * NWAVES;
    if (ph == N_PHASES - 1) {
        for (int t = gw; t < T; t += NGW) rms_row_f32(HRES + (size_t)t * D, a.in[I_NF], a.out + (size_t)t * D, lane);
        return;
    }
    const int l = ph / 9, sp = ph % 9;
    const float* hin = l == 0 ? a.in[I_X] : (const float*)HRES;
    switch (sp) {
    case 0: {
        LAS float* scr = (LAS float*)(lds + wave * 16384);
        constexpr int I_IN = (D / 64) * (PTP / 32), I_OUT = (D / 64) * (D / 32), I_UP = (D / 64) * (FF / 32), I_DN = (FF / 64) * (D / 32), I_L = I_IN + I_OUT + I_UP + I_DN;
        for (int it = gw; it < I_L; it += NGW) {
            int r = it;
            if (r < I_IN) { transpose_item(LP(I_WIN, (size_t)D * PT), D, PT, PTP, (bf16_t*)(a.ws + WS_WIN), scr, r, lane); continue; } r -= I_IN;
            if (r < I_OUT) { transpose_item(LP(I_WOUT, (size_t)D * D), D, D, D, (bf16_t*)(a.ws + WS_WOUT), scr, r, lane); continue; } r -= I_OUT;
            if (r < I_UP) { transpose_item(LP(I_WUP, (size_t)D * FF), D, FF, FF, (bf16_t*)(a.ws + WS_WUP), scr, r, lane); continue; } r -= I_UP;
            transpose_item(LP(I_WDN, (size_t)FF * D), FF, D, D, (bf16_t*)(a.ws + WS_WDN), scr, r, lane);
        }
        for (int t = gw; t < T; t += NGW) rms_row_bf16(hin + (size_t)t * D, LP(I_N1, D), (bf16_t*)(a.ws + WS_XN) + (size_t)t * D, lane);
    } break;
    case 1: { pg8::Gemm g{(const bf16_t*)(a.ws + WS_XN), (const bf16_t*)(a.ws + WS_WIN)}; pg8::StaticOrder<T, PTP> S; S.init(G, bid);
              pg8::EpiBf16<false> E{(bf16_t*)(a.ws + WS_PROJ), PTP}; pg8::gemm_phase<D, pg8::EpiBf16<false>, pg8::StaticOrder<T, PTP>, true>(lds, g, S, E, tid); } break;
    case 2: { LAS float* scr = (LAS float*)(lds + wave * 1024);
#pragma unroll 1
              for (int t = gw; t < T; t += NGW) prep_gdn(a, l, t, lane);
#pragma unroll 1
              for (int t = gw; t < T; t += NGW) prep_ret(a, l, t, lane);
#pragma unroll 1
              for (int t = gw; t < T; t += NGW) prep_ssd(a, l, t, lane);
#pragma unroll 1
              for (int t = gw; t < T; t += NGW) prep_rwkv(a, l, t, lane, scr); } break;
    case 3: { const int nb = 512 / (CPW * NWAVES);
              const int b = bid; if (b < 4 * nb) { const int mixer = b / nb, wv = (b % nb) * NWAVES + wave;
                  if (mixer == 0) scan_gdn(a, wv, lane); else if (mixer == 1) scan_ret(a, wv, lane); else if (mixer == 2) scan_ssd(a, l, wv, lane); else scan_rwkv(a, wv, lane); } } break;
    case 4: for (int t = gw; t < T; t += NGW) post_token(a, l, t, lane); break;
    case 5: { pg8::Gemm g{(const bf16_t*)(a.ws + WS_O), (const bf16_t*)(a.ws + WS_WOUT)}; pg8::StaticOrder<T, D> S; S.init(G, bid);
              pg8::EpiAddRes E{hin, HRES, D}; pg8::gemm_phase<D, pg8::EpiAddRes, pg8::StaticOrder<T, D>, false>(lds, g, S, E, tid); } break;
    case 6: for (int t = gw; t < T; t += NGW) rms_row_bf16(HRES + (size_t)t * D, LP(I_N2, D), (bf16_t*)(a.ws + WS_XN) + (size_t)t * D, lane); break;
    case 7: { pg8::Gemm g{(const bf16_t*)(a.ws + WS_XN), (const bf16_t*)(a.ws + WS_WUP)}; pg8::StaticOrder<T, FF> S; S.init(G, bid);
              pg8::EpiBf16<true> E{(bf16_t*)(a.ws + WS_HID), FF}; pg8::gemm_phase<D, pg8::EpiBf16<true>, pg8::StaticOrder<T, FF>, true>(lds, g, S, E, tid); } break;
    case 8: { pg8::Gemm g{(const bf16_t*)(a.ws + WS_HID), (const bf16_t*)(a.ws + WS_WDN)}; pg8::StaticOrder<T, D> S; S.init(G, bid);
              pg8::EpiAddRes E{HRES, HRES, D}; pg8::gemm_phase<FF, pg8::EpiAddRes, pg8::StaticOrder<T, D>, false>(lds, g, S, E, tid); } break;
    }
}

namespace cg = cooperative_groups;
__global__ void __launch_bounds__(NWAVES * 64, 2) fwd_kernel(Args a) {
    extern __shared__ __attribute__((aligned(16))) unsigned char lds_raw[];
    LAS unsigned char* lds = (LAS unsigned char*)lds_raw;
    const int ph_lo = a.ph_lo, ph_hi = a.ph_hi;
    for (int ph = ph_lo; ph < ph_hi; ++ph) {
        CArgs* ap = (CArgs*)__builtin_amdgcn_kernarg_segment_ptr();
        asm volatile("" : "+s"(ap));
        int tid = threadIdx.x, bid = blockIdx.x;
        asm volatile("" : "+v"(tid)); asm volatile("" : "+s"(bid));
        run_phase(*ap, ph, lds, tid, bid);
        if (ph + 1 < ph_hi) { cg::this_grid().sync(); }
    }
}

extern "C" void kernel_launch(void* const* d_in, const int* in_sizes, int n_in, void* d_out, int out_size, void* d_ws, size_t ws_size, hipStream_t stream) {
    static int grid = 0;
    if (grid == 0) {
        if (n_in != N_IN || in_sizes[0] != T * D || out_size != T * D || ws_size < WS_END) {
            fprintf(stderr, "kernel_launch: shape/workspace mismatch: n_in %d in0 %d out %d ws %zu (need %zu); nothing launched\n", n_in, n_in > 0 ? in_sizes[0] : -1, out_size, ws_size, (size_t)WS_END); grid = -1; return; }
        int dev = 0, cus = 0, per_cu = 0;
        if (hipGetDevice(&dev) != hipSuccess || hipDeviceGetAttribute(&cus, hipDeviceAttributeMultiprocessorCount, dev) != hipSuccess) { grid = -1; return; }
        if (hipFuncSetAttribute((const void*)fwd_kernel, hipFuncAttributeMaxDynamicSharedMemorySize, LDS_BYTES) != hipSuccess) { fprintf(stderr, "kernel_launch: hipFuncSetAttribute failed\n"); grid = -1; return; }
        if (hipOccupancyMaxActiveBlocksPerMultiprocessor(&per_cu, (const void*)fwd_kernel, NWAVES * 64, LDS_BYTES) != hipSuccess || per_cu < 1) { fprintf(stderr, "kernel_launch: occupancy query says %d blocks per CU\n", per_cu); per_cu = 1; }
        (void)hipGetLastError();
        grid = cus;
    }
    if (grid < 0) return;
    Args a{};
    for (int i = 0; i < N_IN; ++i) a.in[i] = (const float*)d_in[i];
    a.out = (float*)d_out; a.ws = (unsigned char*)d_ws;
#if N_LAUNCH_MODE == 1
    a.ph_lo = 0; a.ph_hi = N_PHASES;
    void* args[] = {&a};
    hipError_t e = hipLaunchCooperativeKernel((const void*)fwd_kernel, dim3(grid), dim3(NWAVES * 64), args, LDS_BYTES, stream);
    if (e != hipSuccess) fprintf(stderr, "kernel_launch: cooperative launch failed: %s (grid %d)\n", hipGetErrorString(e), grid);
#else
#ifndef DBG_MAXPH
#define DBG_MAXPH N_PHASES
#endif
    for (int ph = 0; ph < N_PHASES; ++ph) {
        if (ph >= DBG_MAXPH && ph != N_PHASES - 1) continue;
#ifdef DBG_SKIP_FINAL
        if (ph == N_PHASES - 1) continue;
#endif
        a.ph_lo = ph; a.ph_hi = ph + 1;
        hipLaunchKernelGGL(fwd_kernel, dim3(grid), dim3(NWAVES * 64), LDS_BYTES, stream, a);
    }
#endif
}
#endif
```

```cpp
#ifndef HOST_TEST
#include <hip/hip_runtime.h>
#endif
#include <cstdio>
#include <cstdint>
#include <cmath>
#include <cstddef>

#ifndef SEQ_T
#define SEQ_T 8192
#endif
#ifndef N_LAUNCH_MODE
#define N_LAUNCH_MODE 1
#endif

constexpr int T = SEQ_T, D = 2048, NL = 2, FF = 8192, PT = 6832, PTP = 6912;
constexpr int C_GQ = 0, C_GK = 512, C_GV = 1024, C_GZ = 1536, C_GB = 2048, C_GA = 2052;
constexpr int C_RQ = 2056, C_RK = 2312, C_RV = 2568, C_RG = 3080;
constexpr int C_MZ = 3592, C_MXBC = 4104, C_MDT = 5128;
constexpr int C_RW = 5136;
enum { I_X = 0, I_N1, I_WIN, I_GCONV, I_GALOG, I_GDTB, I_GNORM, I_RNORM, I_MCONV, I_MCONVB, I_MALOG, I_MDTB, I_MD, I_MNORM, I_RWMU, I_RWW0, I_RWWUP, I_RWA0, I_RWAUP,
       I_RWGUP, I_RWKK, I_RWKA, I_RWRK, I_RWLNW, I_RWLNB, I_WOUT, I_N2, I_WUP, I_WDN, I_NF, N_IN };

constexpr size_t MiB = 1u << 20;
constexpr size_t SZ_WIN = (size_t)PTP * D * 2, SZ_WOUT = (size_t)D * D * 2, SZ_WUP = (size_t)FF * D * 2, SZ_WDN = (size_t)D * FF * 2;
constexpr size_t WS_CTL = 0, CTL_BYTES = 1 * MiB;
constexpr size_t WS_WIN = WS_CTL + CTL_BYTES;
constexpr size_t WS_WOUT = WS_WIN + SZ_WIN;
constexpr size_t WS_WUP = WS_WOUT + SZ_WOUT;
constexpr size_t WS_WDN = WS_WUP + SZ_WUP;
constexpr size_t WS_XN = WS_WDN + SZ_WDN;
constexpr size_t WS_O = WS_XN;
constexpr size_t WS_PROJ = WS_XN + (size_t)T * D * 2;
constexpr size_t WS_HID = WS_PROJ;
constexpr size_t SZ_T512 = (size_t)T * 512 * 4;
constexpr size_t WS_GQ = WS_PROJ + (size_t)T * PTP * 2;
constexpr size_t WS_GK = WS_GQ + SZ_T512, WS_GV = WS_GK + SZ_T512;
constexpr size_t WS_GAB = WS_GV + SZ_T512;
constexpr size_t WS_RQ = WS_GAB + (size_t)T * 8 * 4;
constexpr size_t WS_RK = WS_RQ + (size_t)T * 256 * 4;
constexpr size_t WS_MXBC = WS_RK + (size_t)T * 256 * 4;
constexpr size_t WS_MDT = WS_MXBC + (size_t)T * 1024 * 4;
constexpr size_t WS_RWR = WS_MDT + (size_t)T * 16 * 4;
constexpr size_t WS_RWKK = WS_RWR + SZ_T512, WS_RWBB = WS_RWKK + SZ_T512, WS_RWD = WS_RWBB + SZ_T512, WS_RWKT = WS_RWD + SZ_T512, WS_RWV = WS_RWKT + SZ_T512, WS_RWG = WS_RWV + SZ_T512;
constexpr size_t WS_RKS = WS_RWG + SZ_T512;
constexpr size_t WS_OR = WS_RKS + (size_t)T * 8 * 4;
constexpr size_t WS_OD = WS_OR + SZ_T512;
constexpr size_t WS_END = WS_OD + SZ_T512;
static_assert(WS_HID + (size_t)T * FF * 2 <= WS_END, "HID overlay");
static_assert(SEQ_T != 8192 || WS_END <= 512 * MiB, "d_ws budget (512 MiB)");

typedef unsigned short bf16_t;
#ifdef HOST_TEST
#define DEV static inline
#define HD static inline
typedef float f32x4 __attribute__((vector_size(16)));
constexpr int WAVE = 1, LPC = 1;
static inline float wave_sum(float v) { return v; }
static inline float group_sum(float v) { return v; }
#else
#define DEV __device__ __forceinline__
#define HD __host__ __device__ __forceinline__
typedef float f32x4 __attribute__((ext_vector_type(4)));
constexpr int WAVE = 64, LPC = 16;
DEV float wave_sum(float v) {
#pragma unroll
    for (int o = 1; o < 64; o <<= 1) v += __shfl_xor(v, o);
    return v;
}
DEV float group_sum(float v) {
#pragma unroll
    for (int o = 1; o < 16; o <<= 1) v += __shfl_xor(v, o);
    return v;
}
#endif
constexpr int CPW = WAVE / LPC;

HD unsigned f2bf(float f) { unsigned u; __builtin_memcpy(&u, &f, 4); return (u + 0x7fffu + ((u >> 16) & 1u)) >> 16; }
HD unsigned pk2(float lo, float hi) { return f2bf(lo) | (f2bf(hi) << 16); }
HD float bf2f(bf16_t b) { unsigned u = (unsigned)b << 16; float f; __builtin_memcpy(&f, &u, 4); return f; }
DEV float sigmoid_f(float x) { return 1.0f / (1.0f + expf(-x)); }
DEV float silu_f(float x) { return x / (1.0f + expf(-x)); }
DEV float softplus_f(float x) { return x > 20.f ? x : log1pf(expf(x)); }

struct Args { const float* in[N_IN]; float* out; unsigned char* ws; int ph_lo, ph_hi; };
#ifdef HOST_TEST
typedef const Args CArgs;
#else
typedef const __attribute__((address_space(4))) Args CArgs;
#endif
#define WSF(off) ((float*)(a.ws + (off)))
#define HRES (a.out)
#define PROJROW(t) ((const bf16_t*)(a.ws + WS_PROJ) + (size_t)(t) * PTP)
#define LP(idx, per) (a.in[idx] + (size_t)l * (per))

DEV void rms_row_bf16(const float* x, const float* w, bf16_t* o, int lane) {
    float ss = 0.f;
    for (int i = lane * 4; i < D; i += WAVE * 4) { const f32x4 v = *(const f32x4*)(x + i); ss += (v[0] * v[0] + v[1] * v[1]) + (v[2] * v[2] + v[3] * v[3]); }
    const float r = 1.0f / sqrtf(wave_sum(ss) * (1.0f / D) + 1e-6f);
    for (int i = lane * 4; i < D; i += WAVE * 4) { const f32x4 v = *(const f32x4*)(x + i), g = *(const f32x4*)(w + i);
        unsigned* op = (unsigned*)(o + i); op[0] = pk2(v[0] * r * g[0], v[1] * r * g[1]); op[1] = pk2(v[2] * r * g[2], v[3] * r * g[3]); }
}
DEV void rms_row_f32(const float* x, const float* w, float* o, int lane) {
    float ss = 0.f;
    for (int i = lane * 4; i < D; i += WAVE * 4) { const f32x4 v = *(const f32x4*)(x + i); ss += (v[0] * v[0] + v[1] * v[1]) + (v[2] * v[2] + v[3] * v[3]); }
    const float r = 1.0f / sqrtf(wave_sum(ss) * (1.0f / D) + 1e-6f);
    for (int i = lane * 4; i < D; i += WAVE * 4) { const f32x4 v = *(const f32x4*)(x + i), g = *(const f32x4*)(w + i);
        f32x4 y; y[0] = v[0] * r * g[0]; y[1] = v[1] * r * g[1]; y[2] = v[2] * r * g[2]; y[3] = v[3] * r * g[3]; *(f32x4*)(o + i) = y; }
}

DEV float conv4(const bf16_t* projrow_t, int col, const float* w, int c, int wstride, int t) {
    float acc = 0.f;
#pragma unroll
    for (int j = 0; j < 4; ++j) { const int tt = t - 3 + j; if (tt >= 0) acc += w[j * wstride + c] * bf2f(projrow_t[(ptrdiff_t)(j - 3) * PTP + col]); }
    return acc;
}

#ifdef HOST_TEST
static const float THETA[32] = {
#else
__device__ const float THETA[32] = {
#endif
    1.000000000e+00f, 7.429639101e-01f, 5.519954562e-01f, 4.101127088e-01f, 3.046989739e-01f, 2.263803482e-01f, 1.681924462e-01f, 1.249609292e-01f, 9.284145385e-02f, 6.897785515e-02f,
    5.124806613e-02f, 3.807546571e-02f, 2.828869782e-02f, 2.101748064e-02f, 1.561523322e-02f, 1.160155423e-02f, 8.619536646e-03f, 6.404003594e-03f, 4.757945426e-03f, 3.534980817e-03f,
    2.626363887e-03f, 1.951293205e-03f, 1.449740841e-03f, 1.077104942e-03f, 8.002503891e-04f, 5.945570301e-04f, 4.417345626e-04f, 3.281927784e-04f, 2.438354713e-04f, 1.811609109e-04f,
    1.345960627e-04f, 9.999999747e-05f };

DEV void prep_gdn(CArgs& a, int l, int t, int lane) {
    const bf16_t* pr = PROJROW(t);
    {
        const float* cw = LP(I_GCONV, 4 * 1536);
        constexpr int NE = 128 / WAVE;
#pragma unroll 1
        for (int h = 0; h < 4; ++h) {
#pragma unroll 1
            for (int which = 0; which < 2; ++which) {
                float x[NE]; float ss = 0.f;
#pragma unroll
                for (int e = 0; e < NE; ++e) { const int c = which * 512 + h * 128 + lane + e * WAVE; x[e] = silu_f(conv4(pr, C_GQ + c, cw, c, 1536, t)); ss += x[e] * x[e]; }
                const float sc = (1.0f / sqrtf(wave_sum(ss) + 1e-6f)) * (which == 0 ? 0.08838834764831845f : 1.0f);
                float* o = WSF(which == 0 ? WS_GQ : WS_GK) + (size_t)t * 512 + h * 128;
#pragma unroll
                for (int e = 0; e < NE; ++e) o[lane + e * WAVE] = x[e] * sc;
            }
#pragma unroll
            for (int e = 0; e < NE; ++e) { const int c = 1024 + h * 128 + lane + e * WAVE; WSF(WS_GV)[(size_t)t * 512 + h * 128 + lane + e * WAVE] = silu_f(conv4(pr, C_GQ + c, cw, c, 1536, t)); }
        }
        for (int h = lane; h < 4; h += WAVE) {
            const float beta = sigmoid_f(bf2f(pr[C_GB + h]));
            const float la = -expf(LP(I_GALOG, 4)[h]) * softplus_f(bf2f(pr[C_GA + h]) + LP(I_GDTB, 4)[h]);
            WSF(WS_GAB)[(size_t)t * 8 + h * 2] = expf(la); WSF(WS_GAB)[(size_t)t * 8 + h * 2 + 1] = beta;
        }
    }
}
DEV void prep_ret(CArgs& a, int l, int t, int lane) {
    const bf16_t* pr = PROJROW(t);
#pragma unroll 1
    for (int p = lane; p < 128; p += WAVE) {
        const int i = p & 31; const float ang = (float)t * THETA[i]; float sn, cs;
#ifdef HOST_TEST
        sn = sinf(ang); cs = cosf(ang);
#else
        sincosf(ang, &sn, &cs);
#endif
        const float q0 = bf2f(pr[C_RQ + 2 * p]), q1 = bf2f(pr[C_RQ + 2 * p + 1]), k0 = bf2f(pr[C_RK + 2 * p]), k1 = bf2f(pr[C_RK + 2 * p + 1]);
        float* oq = WSF(WS_RQ) + (size_t)t * 256 + 2 * p; float* ok = WSF(WS_RK) + (size_t)t * 256 + 2 * p;
        oq[0] = q0 * cs - q1 * sn; oq[1] = q1 * cs + q0 * sn;
        ok[0] = (k0 * cs - k1 * sn) * 0.125f; ok[1] = (k1 * cs + k0 * sn) * 0.125f;
    }
}
DEV void prep_ssd(CArgs& a, int l, int t, int lane) {
    const bf16_t* pr = PROJROW(t);
    {
        const float* cw = LP(I_MCONV, 4 * 1024); const float* cb = LP(I_MCONVB, 1024);
#pragma unroll 2
        for (int c = lane; c < 1024; c += WAVE) WSF(WS_MXBC)[(size_t)t * 1024 + c] = silu_f(conv4(pr, C_MXBC + c, cw, c, 1024, t) + cb[c]);
        for (int h = lane; h < 8; h += WAVE) {
            const float dt = softplus_f(bf2f(pr[C_MDT + h]) + LP(I_MDTB, 8)[h]); const float A = -expf(LP(I_MALOG, 8)[h]);
            WSF(WS_MDT)[(size_t)t * 16 + 2 * h] = dt; WSF(WS_MDT)[(size_t)t * 16 + 2 * h + 1] = expf(dt * A);
        }
    }
}
template <class SCR> DEV void prep_rwkv(CArgs& a, int l, int t, int lane, SCR scr) {
    const bf16_t* pr = PROJROW(t);
    {
        const float* mu = LP(I_RWMU, 1696); const bf16_t* p1 = pr + C_RW; const bf16_t* p0 = p1 - PTP;
        for (int j = lane; j < 160; j += WAVE) { const int c = 1536 + j; const float cur = bf2f(p1[c]), prev = t > 0 ? bf2f(p0[c]) : 0.f; const float m = cur + (prev - cur) * mu[c];
            scr[j] = j < 32 ? tanhf(m) : (j < 64 ? m : sigmoid_f(m)); }
#ifndef HOST_TEST
        asm volatile("s_waitcnt lgkmcnt(0)" ::: "memory");
#endif
        const float* wup = LP(I_RWWUP, 32 * 512); const float* aup = LP(I_RWAUP, 32 * 512); const float* gup = LP(I_RWGUP, 96 * 512);
        constexpr int NE = 64 / WAVE;
#pragma unroll 1
        for (int h = 0; h < 8; ++h) {
            float r_[NE], kt_[NE], kk_[NE], a_[NE]; float ss = 0.f, rk = 0.f;
#pragma unroll
            for (int e = 0; e < NE; ++e) {
                const int c = h * 64 + lane + e * WAVE;
                float lw = 0.f, la = 0.f, lg = 0.f;
#pragma unroll 8
                for (int j = 0; j < 32; ++j) { lw += scr[j] * wup[j * 512 + c]; la += scr[32 + j] * aup[j * 512 + c]; }
#pragma unroll 8
                for (int j = 0; j < 96; ++j) lg += scr[64 + j] * gup[j * 512 + c];
                const float cr = bf2f(p1[c]), ck = bf2f(p1[512 + c]), cv = bf2f(p1[1024 + c]);
                const float pr_ = t > 0 ? bf2f(p0[c]) : 0.f, pk_ = t > 0 ? bf2f(p0[512 + c]) : 0.f, pv_ = t > 0 ? bf2f(p0[1024 + c]) : 0.f;
                const float r = cr + (pr_ - cr) * mu[c], k = ck + (pk_ - ck) * mu[512 + c], v = cv + (pv_ - cv) * mu[1024 + c];
                const float wraw = -softplus_f(-(LP(I_RWW0, 512)[c] + lw)) - 0.5f;
                const float dec = expf(-expf(wraw));
                const float av = sigmoid_f(LP(I_RWA0, 512)[c] + la);
                const float kkr = k * LP(I_RWKK, 512)[c];
                const float kt = k * (1.0f + (av - 1.0f) * LP(I_RWKA, 512)[c]);
                r_[e] = r; kt_[e] = kt; kk_[e] = kkr; a_[e] = av; ss += kkr * kkr; rk += r * kt * LP(I_RWRK, 512)[c];
                const size_t o = (size_t)t * 512 + c;
                WSF(WS_RWR)[o] = r; WSF(WS_RWD)[o] = dec; WSF(WS_RWKT)[o] = kt; WSF(WS_RWV)[o] = v; WSF(WS_RWG)[o] = lg;
            }
            ss = wave_sum(ss); rk = wave_sum(rk);
            const float inv = 1.0f / sqrtf(ss + 1e-6f);
#pragma unroll
            for (int e = 0; e < NE; ++e) { const size_t o = (size_t)t * 512 + h * 64 + lane + e * WAVE; const float kk = kk_[e] * inv; WSF(WS_RWKK)[o] = kk; WSF(WS_RWBB)[o] = kk * a_[e]; }
            if (lane == 0) WSF(WS_RKS)[(size_t)t * 8 + h] = rk;
        }
    }
}

DEV void post_token(CArgs& a, int l, int t, int lane) {
    const bf16_t* pr = PROJROW(t); bf16_t* O = (bf16_t*)(a.ws + WS_O) + (size_t)t * D;
    {
        constexpr int NE = 128 / WAVE; const float* w = LP(I_GNORM, 128);
        for (int h = 0; h < 4; ++h) { float x[NE]; float ss = 0.f;
#pragma unroll
            for (int e = 0; e < NE; ++e) { x[e] = WSF(WS_GV)[(size_t)t * 512 + h * 128 + lane + e * WAVE]; ss += x[e] * x[e]; }
            const float r = 1.0f / sqrtf(wave_sum(ss) * (1.0f / 128) + 1e-6f);
#pragma unroll
            for (int e = 0; e < NE; ++e) { const int i = lane + e * WAVE; O[h * 128 + i] = (bf16_t)f2bf(x[e] * r * w[i] * silu_f(bf2f(pr[C_GZ + h * 128 + i]))); } }
    }
    {
        constexpr int NE = 128 / WAVE; const float* w = LP(I_RNORM, 512);
        for (int h = 0; h < 4; ++h) { float x[NE]; float s = 0.f;
#pragma unroll
            for (int e = 0; e < NE; ++e) { x[e] = WSF(WS_OR)[(size_t)t * 512 + h * 128 + lane + e * WAVE]; s += x[e]; }
            const float mu = wave_sum(s) * (1.0f / 128); float q = 0.f;
#pragma unroll
            for (int e = 0; e < NE; ++e) { x[e] -= mu; q += x[e] * x[e]; }
            const float r = 1.0f / sqrtf(wave_sum(q) * (1.0f / 128) + 1e-6f);
#pragma unroll
            for (int e = 0; e < NE; ++e) { const int c = h * 128 + lane + e * WAVE; O[512 + c] = (bf16_t)f2bf(x[e] * r * w[c] * silu_f(bf2f(pr[C_RG + c]))); } }
    }
    {
        constexpr int NE = 256 / WAVE; const float* w = LP(I_MNORM, 512);
        for (int g = 0; g < 2; ++g) { float x[NE]; float ss = 0.f;
#pragma unroll
            for (int e = 0; e < NE; ++e) { const int c = g * 256 + lane + e * WAVE;
                x[e] = WSF(WS_MXBC)[(size_t)t * 1024 + c] * silu_f(bf2f(pr[C_MZ + c])); ss += x[e] * x[e]; }
            const float r = 1.0f / sqrtf(wave_sum(ss) * (1.0f / 256) + 1e-6f);
#pragma unroll
            for (int e = 0; e < NE; ++e) { const int c = g * 256 + lane + e * WAVE; O[1024 + c] = (bf16_t)f2bf(x[e] * r * w[c]); } }
    }
    {
        constexpr int NE = 64 / WAVE; const float* w = LP(I_RWLNW, 512); const float* b = LP(I_RWLNB, 512);
        for (int h = 0; h < 8; ++h) { float x[NE]; float s = 0.f;
#pragma unroll
            for (int e = 0; e < NE; ++e) { x[e] = WSF(WS_OD)[(size_t)t * 512 + h * 64 + lane + e * WAVE]; s += x[e]; }
            const float mu = wave_sum(s) * (1.0f / 64); float q = 0.f;
#pragma unroll
            for (int e = 0; e < NE; ++e) { x[e] -= mu; q += x[e] * x[e]; }
            const float r = 1.0f / sqrtf(wave_sum(q) * (1.0f / 64) + 64e-5f); const float rks = WSF(WS_RKS)[(size_t)t * 8 + h];
#pragma unroll
            for (int e = 0; e < NE; ++e) { const int c = h * 64 + lane + e * WAVE; const size_t o = (size_t)t * 512 + c;
                const float y = x[e] * r * w[c] + b[c] + rks * WSF(WS_RWV)[o]; O[1536 + c] = (bf16_t)f2bf(y * WSF(WS_RWG)[o]); } }
    }
}

constexpr int SCAN_U = 4;
DEV void scan_gdn(CArgs& a, int wv, int lane) {
    constexpr int NS = 128 / LPC; const int sub = lane % LPC, col = wv * CPW + lane / LPC, h = col >> 7;
    const float* GK = WSF(WS_GK) + h * 128 + sub * NS; const float* GQ = WSF(WS_GQ) + h * 128 + sub * NS; float* GV = WSF(WS_GV) + col; const float* AB = WSF(WS_GAB) + h * 2; float* OG = GV;
    float s[NS];
#pragma unroll
    for (int i = 0; i < NS; ++i) s[i] = 0.f;
    for (int t0 = 0; t0 < T; t0 += SCAN_U) {
        float kb[SCAN_U][NS], qb[SCAN_U][NS], vb[SCAN_U], ab[SCAN_U], bb[SCAN_U];
#pragma unroll
        for (int u = 0; u < SCAN_U; ++u) { const size_t t = t0 + u;
#pragma unroll
            for (int i = 0; i < NS; i += 4) { const f32x4 kv = *(const f32x4*)(GK + t * 512 + i), qv = *(const f32x4*)(GQ + t * 512 + i);
                kb[u][i] = kv[0]; kb[u][i + 1] = kv[1]; kb[u][i + 2] = kv[2]; kb[u][i + 3] = kv[3]; qb[u][i] = qv[0]; qb[u][i + 1] = qv[1]; qb[u][i + 2] = qv[2]; qb[u][i + 3] = qv[3]; }
            vb[u] = GV[t * 512]; ab[u] = AB[t * 8]; bb[u] = AB[t * 8 + 1]; }
#pragma unroll
        for (int u = 0; u < SCAN_U; ++u) {
            float d = 0.f;
#pragma unroll
            for (int i = 0; i < NS; ++i) d += kb[u][i] * s[i];
            d = group_sum(d);
            const float c = bb[u] * (vb[u] - ab[u] * d); float o = 0.f;
#pragma unroll
            for (int i = 0; i < NS; ++i) { s[i] = ab[u] * s[i] + kb[u][i] * c; o += qb[u][i] * s[i]; }
            o = group_sum(o);
            if (sub == 0) OG[(size_t)(t0 + u) * 512] = o;
        }
    }
}
DEV void scan_ret(CArgs& a, int wv, int lane) {
    constexpr int NS = 64 / LPC; const int sub = lane % LPC, col = wv * CPW + lane / LPC, h = col >> 7;
    const float* RK = WSF(WS_RK) + h * 64 + sub * NS; const float* RQ = WSF(WS_RQ) + h * 64 + sub * NS; const bf16_t* RV = PROJROW(0) + C_RV + col; float* OR = WSF(WS_OR) + col;
    const float gam = 1.0f - exp2f(-5.0f - (float)h);
    float s[NS];
#pragma unroll
    for (int i = 0; i < NS; ++i) s[i] = 0.f;
    for (int t0 = 0; t0 < T; t0 += SCAN_U) {
        float kb[SCAN_U][NS], qb[SCAN_U][NS], vb[SCAN_U];
#pragma unroll
        for (int u = 0; u < SCAN_U; ++u) { const size_t t = t0 + u;
#pragma unroll
            for (int i = 0; i < NS; i += 4) { const f32x4 kv = *(const f32x4*)(RK + t * 256 + i), qv = *(const f32x4*)(RQ + t * 256 + i);
                kb[u][i] = kv[0]; kb[u][i + 1] = kv[1]; kb[u][i + 2] = kv[2]; kb[u][i + 3] = kv[3]; qb[u][i] = qv[0]; qb[u][i + 1] = qv[1]; qb[u][i + 2] = qv[2]; qb[u][i + 3] = qv[3]; }
            vb[u] = bf2f(RV[t * PTP]); }
#pragma unroll
        for (int u = 0; u < SCAN_U; ++u) {
            float o = 0.f;
#pragma unroll
            for (int i = 0; i < NS; ++i) { s[i] = gam * s[i] + kb[u][i] * vb[u]; o += qb[u][i] * s[i]; }
            o = group_sum(o);
            if (sub == 0) OR[(size_t)(t0 + u) * 512] = o;
        }
    }
}
DEV void scan_ssd(CArgs& a, int l, int wv, int lane) {
    constexpr int NS = 128 / LPC; const int sub = lane % LPC, col = wv * CPW + lane / LPC, h = col >> 6, g = h >> 2;
    const float* MB = WSF(WS_MXBC) + 512 + g * 128 + sub * NS; const float* MC = WSF(WS_MXBC) + 768 + g * 128 + sub * NS; float* MX = WSF(WS_MXBC) + col; const float* DT = WSF(WS_MDT) + h * 2; float* OC = MX; const float Dh = LP(I_MD, 8)[h];
    float s[NS];
#pragma unroll
    for (int i = 0; i < NS; ++i) s[i] = 0.f;
    for (int t0 = 0; t0 < T; t0 += SCAN_U) {
        float Bb[SCAN_U][NS], Cb[SCAN_U][NS], xb[SCAN_U], db[SCAN_U], xr[SCAN_U];
#pragma unroll
        for (int u = 0; u < SCAN_U; ++u) { const size_t t = t0 + u;
#pragma unroll
            for (int i = 0; i < NS; i += 4) { const f32x4 bv = *(const f32x4*)(MB + t * 1024 + i), cv = *(const f32x4*)(MC + t * 1024 + i);
                Bb[u][i] = bv[0]; Bb[u][i + 1] = bv[1]; Bb[u][i + 2] = bv[2]; Bb[u][i + 3] = bv[3]; Cb[u][i] = cv[0]; Cb[u][i + 1] = cv[1]; Cb[u][i + 2] = cv[2]; Cb[u][i + 3] = cv[3]; }
            xr[u] = MX[t * 1024]; xb[u] = xr[u] * DT[t * 16]; db[u] = DT[t * 16 + 1]; }
#pragma unroll
        for (int u = 0; u < SCAN_U; ++u) {
            float y = 0.f;
#pragma unroll
            for (int i = 0; i < NS; ++i) { s[i] = db[u] * s[i] + Bb[u][i] * xb[u]; y += Cb[u][i] * s[i]; }
            y = group_sum(y);
            if (sub == 0) OC[(size_t)(t0 + u) * 1024] = y + Dh * xr[u];
        }
    }
}
DEV void scan_rwkv(CArgs& a, int wv, int lane) {
    constexpr int NS = 64 / LPC; const int sub = lane % LPC, row = wv * CPW + lane / LPC, h = row >> 6; const size_t vo = (size_t)h * 64 + sub * NS;
    const float* KK = WSF(WS_RWKK) + vo; const float* BB = WSF(WS_RWBB) + vo; const float* DD = WSF(WS_RWD) + vo; const float* KT = WSF(WS_RWKT) + vo; const float* RR = WSF(WS_RWR) + vo; const float* VV = WSF(WS_RWV) + row; float* OD = WSF(WS_OD) + row;
    float s[NS];
#pragma unroll
    for (int i = 0; i < NS; ++i) s[i] = 0.f;
    for (int t0 = 0; t0 < T; t0 += SCAN_U) {
        float kk[SCAN_U][NS], bb[SCAN_U][NS], dd[SCAN_U][NS], kt[SCAN_U][NS], rr[SCAN_U][NS], vb[SCAN_U];
#pragma unroll
        for (int u = 0; u < SCAN_U; ++u) { const size_t t = t0 + u;
#pragma unroll
            for (int i = 0; i < NS; i += 4) { const f32x4 v0 = *(const f32x4*)(KK + t * 512 + i), v1 = *(const f32x4*)(BB + t * 512 + i), v2 = *(const f32x4*)(DD + t * 512 + i), v3 = *(const f32x4*)(KT + t * 512 + i), v4 = *(const f32x4*)(RR + t * 512 + i);
#pragma unroll
                for (int j = 0; j < 4; ++j) { kk[u][i + j] = v0[j]; bb[u][i + j] = v1[j]; dd[u][i + j] = v2[j]; kt[u][i + j] = v3[j]; rr[u][i + j] = v4[j]; } }
            vb[u] = VV[t * 512]; }
#pragma unroll
        for (int u = 0; u < SCAN_U; ++u) {
            float sa = 0.f;
#pragma unroll
            for (int i = 0; i < NS; ++i) sa += s[i] * kk[u][i];
            sa = -group_sum(sa); float y = 0.f;
#pragma unroll
            for (int i = 0; i < NS; ++i) { s[i] = s[i] * dd[u][i] + sa * bb[u][i] + vb[u] * kt[u][i]; y += s[i] * rr[u][i]; }
            y = group_sum(y);
            if (sub == 0) OD[(size_t)(t0 + u) * 512] = y;
        }
    }
}

#ifndef HOST_TEST
namespace pg8 {
#define PG8_LAS __attribute__((address_space(3)))
typedef short bf16x8 __attribute__((ext_vector_type(8)));
typedef unsigned u32x4 __attribute__((ext_vector_type(4)));
constexpr int BM = 256, BK = 64, HALF = 128, HTB = HALF * BK * 2, STAGE_BYTES = 8 * HTB, NXCD = 8, WGM = 8;
__host__ __device__ __forceinline__ int lds_byte(int r, int c) { const int st = (r >> 4) * 2 + (c >> 5), rr = r & 15, cc = c & 31, ob = rr * 64 + cc * 2; return st * 1024 + (ob ^ (((ob >> 9) & 1) << 5)); }
__host__ __device__ __forceinline__ void stage_rc(int b, int& R, int& C) { const int st = b / 1024, sb = b % 1024, swz = sb ^ (((sb >> 9) & 1) << 5); R = (st >> 1) * 16 + swz / 64; C = (st & 1) * 32 + (swz % 64) / 2; }
__host__ __device__ __forceinline__ int perm32(int rho) { const int n = rho >> 4, i = rho & 15; return 8 * (i >> 2) + 4 * n + (i & 3); }
struct Unit { int pm, pn; };
struct Gemm { const bf16_t* A; const bf16_t* Bt; };
template <int M, int N> struct StaticOrder {
    static constexpr int nM = M / BM, nN = N / BM, nwg = nM * nN; int G, c;
    __device__ void init(int G_, int c_) { G = G_; c = c_; }
    __device__ bool next(int i, Unit& u) const {
        const long L = (long)i * G + c; if (L >= nwg) return false;
        int wgid = (int)L; { const int q = nwg / NXCD, r = nwg % NXCD, xcd = wgid % NXCD, off = wgid / NXCD; wgid = (xcd < r ? xcd * (q + 1) : r * (q + 1) + (xcd - r) * q) + off; }
        const int nig = WGM * nN, gid = wgid / nig, fm = gid * WGM, gsz = (nM - fm) < WGM ? (nM - fm) : WGM;
        u.pm = fm + ((wgid % nig) % gsz); u.pn = (wgid % nig) / gsz; return true;
    }
    __device__ __forceinline__ void a_ready(const Unit&) const {}
    __device__ __forceinline__ void done(const Unit&) const {}
};
__device__ __forceinline__ unsigned cvt_pk_bf16(float lo, float hi) { unsigned r; asm volatile("v_cvt_pk_bf16_f32 %0, %1, %2" : "=v"(r) : "v"(lo), "v"(hi)); return r; }
struct EpiStoreF32 {
    static constexpr bool PERM = false, AFTER_DRAIN = false; float* O; int ldc;
    __device__ __forceinline__ void operator()(const f32x4 (&acc)[2][2][4][2], const Unit& u, int wr, int wc, int fr, int fq) const {
        const int row0 = u.pm * BM + wr * 64 + fr, col0 = u.pn * BM + wc * 32 + 4 * fq;
#pragma unroll
        for (int ai = 0; ai < 2; ++ai)
#pragma unroll
            for (int m = 0; m < 4; ++m) { float* rowp = O + (size_t)(row0 + ai * HALF + m * 16) * ldc + col0;
#pragma unroll
                for (int bj = 0; bj < 2; ++bj)
#pragma unroll
                    for (int n = 0; n < 2; ++n) *(f32x4*)(rowp + bj * HALF + n * 16) = acc[ai][bj][m][n]; }
    }
};
struct EpiAddRes {
    static constexpr bool PERM = false, AFTER_DRAIN = false; const float* B; float* O; int ldc;
    __device__ __forceinline__ void operator()(const f32x4 (&acc)[2][2][4][2], const Unit& u, int wr, int wc, int fr, int fq) const {
        const int row0 = u.pm * BM + wr * 64 + fr, col0 = u.pn * BM + wc * 32 + 4 * fq;
#pragma unroll
        for (int ai = 0; ai < 2; ++ai)
#pragma unroll
            for (int m = 0; m < 4; ++m) { float* rowp = O + (size_t)(row0 + ai * HALF + m * 16) * ldc + col0; const float* bp = B + (size_t)(row0 + ai * HALF + m * 16) * ldc + col0;
                f32x4 b[2][2];
#pragma unroll
                for (int bj = 0; bj < 2; ++bj)
#pragma unroll
                    for (int n = 0; n < 2; ++n) b[bj][n] = *(const f32x4*)(bp + bj * HALF + n * 16);
#pragma unroll
                for (int bj = 0; bj < 2; ++bj)
#pragma unroll
                    for (int n = 0; n < 2; ++n) *(f32x4*)(rowp + bj * HALF + n * 16) = b[bj][n] + acc[ai][bj][m][n]; }
    }
};
template <bool SQRELU> struct EpiBf16 {
    static constexpr bool PERM = true, AFTER_DRAIN = false; bf16_t* O; int ldc;
    __device__ __forceinline__ void operator()(const f32x4 (&acc)[2][2][4][2], const Unit& u, int wr, int wc, int fr, int fq) const {
        const int row0 = u.pm * BM + wr * 64 + fr, col0 = u.pn * BM + wc * 32 + 8 * fq;
#pragma unroll
        for (int ai = 0; ai < 2; ++ai)
#pragma unroll
            for (int m = 0; m < 4; ++m) { bf16_t* rowp = O + (size_t)(row0 + ai * HALF + m * 16) * ldc + col0;
#pragma unroll
                for (int bj = 0; bj < 2; ++bj) { f32x4 v0 = acc[ai][bj][m][0], v1 = acc[ai][bj][m][1];
                    if (SQRELU) {
#pragma unroll
                        for (int j = 0; j < 4; ++j) { const float p0 = fmaxf(v0[j], 0.f), p1 = fmaxf(v1[j], 0.f); v0[j] = p0 * p0; v1[j] = p1 * p1; } }
                    u32x4 w; w.x = cvt_pk_bf16(v0[0], v0[1]); w.y = cvt_pk_bf16(v0[2], v0[3]); w.z = cvt_pk_bf16(v1[0], v1[1]); w.w = cvt_pk_bf16(v1[2], v1[3]);
                    *(u32x4*)(rowp + bj * HALF) = w; } }
    }
};

template <int K, class Epi, class Sched, bool ALIGN_EPI = false>
__device__ __forceinline__ void gemm_phase(PG8_LAS unsigned char* lds, const Gemm g, const Sched& S, const Epi& E, const int tid) {
    const int wid = __builtin_amdgcn_readfirstlane(tid >> 6), lane = tid & 63, wr = wid >> 2, wc = wid & 3, fr = lane & 15, fq = lane >> 4;
    constexpr int nt = K / BK;
    unsigned voffA[2], voffB[2];
#pragma unroll
    for (int i = 0; i < 2; ++i) { int R, C; stage_rc(tid * 16 + i * 8192, R, C); const int Rb = Epi::PERM ? ((R & ~31) + perm32(R & 31)) : R;
        voffA[i] = (unsigned)(R * K + C) * 2u; voffB[i] = (unsigned)(Rb * K + C) * 2u; }
    const size_t kstep = (size_t)(BK * 2);
    const size_t hstep = (size_t)HALF * K * 2;
    const size_t tstep = 2 * hstep;
    const unsigned ldsw = (unsigned)wid * 1024u;
    const int aoff = lds_byte(wr * 64 + fr, fq * 8), boff = lds_byte(wc * 32 + fr, fq * 8);
#define PG8_SA(b, h) (((b) * 2 + (h)) * HTB)
#define PG8_SB(b, h) ((4 + (b) * 2 + (h)) * HTB)
#define PG8_STAGE(bufoff, gbase, voff) do { _Pragma("unroll") for (int _i = 0; _i < 2; ++_i) \
        __builtin_amdgcn_global_load_lds((const unsigned*)((const char*)(gbase) + (voff)[_i]), (PG8_LAS unsigned*)(lds + (bufoff) + ldsw + _i * 8192), 16, 0, 0); } while (0)
#define PG8_LDA(dst, b, h) do { _Pragma("unroll") for (int m = 0; m < 4; ++m) _Pragma("unroll") for (int k = 0; k < 2; ++k) dst[m][k] = *(const PG8_LAS bf16x8*)(lds + PG8_SA(b, h) + aoff + m * 2048 + k * 1024); } while (0)
#define PG8_LDB(dst, b, h) do { _Pragma("unroll") for (int n = 0; n < 2; ++n) _Pragma("unroll") for (int k = 0; k < 2; ++k) dst[n][k] = *(const PG8_LAS bf16x8*)(lds + PG8_SB(b, h) + boff + n * 2048 + k * 1024); } while (0)
#define PG8_MMA(ai, bj, At, Bt) do { __builtin_amdgcn_s_setprio(1); _Pragma("unroll") for (int m = 0; m < 4; ++m) _Pragma("unroll") for (int n = 0; n < 2; ++n) _Pragma("unroll") for (int k = 0; k < 2; ++k) \
        acc[ai][bj][m][n] = __builtin_amdgcn_mfma_f32_16x16x32_bf16(Bt[n][k], At[m][k], acc[ai][bj][m][n], 0, 0, 0); __builtin_amdgcn_s_setprio(0); } while (0)
#define PG8_WAIT_V(n) asm volatile("s_waitcnt vmcnt(" #n ")" ::: "memory")
#define PG8_WAIT_L(n) asm volatile("s_waitcnt lgkmcnt(" #n ")" ::: "memory")
#define PG8_BAR __builtin_amdgcn_s_barrier()
#define PG8_SCHED __builtin_amdgcn_sched_barrier(0)
    Unit cur, nxt; int ui = 0;
    if (!S.next(0, cur)) return;
    f32x4 acc[2][2][4][2];
#pragma unroll
    for (int a = 0; a < 2; ++a)
#pragma unroll
        for (int b = 0; b < 2; ++b)
#pragma unroll
            for (int m = 0; m < 4; ++m)
#pragma unroll
                for (int n = 0; n < 2; ++n) acc[a][b][m][n] = (f32x4){0.f, 0.f, 0.f, 0.f};
    bf16x8 At[4][2], B0[2][2], B1[2][2];
    const char* cA = (const char*)g.A + (size_t)cur.pm * tstep; const char* cB = (const char*)g.Bt + (size_t)cur.pn * tstep;
    S.a_ready(cur);
    PG8_STAGE(PG8_SB(0, 0), cB, voffB); PG8_STAGE(PG8_SB(0, 1), cB + hstep, voffB); PG8_STAGE(PG8_SA(0, 0), cA, voffA); PG8_STAGE(PG8_SA(0, 1), cA + hstep, voffA);
    if (wr == 1) PG8_BAR;
    PG8_WAIT_V(2); PG8_BAR;
    PG8_STAGE(PG8_SB(1, 0), cB + kstep, voffB); PG8_STAGE(PG8_SA(1, 0), cA + kstep, voffA); PG8_STAGE(PG8_SB(1, 1), cB + hstep + kstep, voffB);
    PG8_WAIT_V(6); PG8_BAR;
    for (;;) {
        const bool has_next = S.next(ui + 1, nxt);
        const char* nA = has_next ? (const char*)g.A + (size_t)nxt.pm * tstep : cA; const char* nB = has_next ? (const char*)g.Bt + (size_t)nxt.pn * tstep : cB;
        for (int t = 0; t < nt; t += 2) {
            const bool last = (t == nt - 2);
            const char* a1 = cA + (size_t)(t + 1) * kstep;
            const char* a2 = last ? nA : cA + (size_t)(t + 2) * kstep; const char* b2 = last ? nB : cB + (size_t)(t + 2) * kstep;
            const char* a3 = a2 + kstep; const char* b3 = b2 + kstep;
            if (last && has_next) S.a_ready(nxt);
            PG8_LDB(B0, 0, 0); PG8_LDB(B1, 0, 1); PG8_SCHED; PG8_LDA(At, 0, 0); PG8_STAGE(PG8_SA(1, 1), a1 + hstep, voffA);
            PG8_WAIT_V(8); PG8_WAIT_L(0); PG8_BAR; PG8_MMA(0, 0, At, B0); PG8_MMA(0, 1, At, B1); PG8_BAR; PG8_SCHED;
            PG8_LDA(At, 0, 1); PG8_STAGE(PG8_SB(0, 0), b2, voffB); PG8_STAGE(PG8_SB(0, 1), b2 + hstep, voffB); PG8_STAGE(PG8_SA(0, 0), a2, voffA);
            PG8_WAIT_V(8); PG8_WAIT_L(0); PG8_BAR; PG8_MMA(1, 0, At, B0); PG8_MMA(1, 1, At, B1); PG8_BAR; PG8_SCHED;
            PG8_LDB(B0, 1, 0); PG8_LDB(B1, 1, 1); PG8_SCHED; PG8_LDA(At, 1, 0); PG8_STAGE(PG8_SA(0, 1), a2 + hstep, voffA);
            PG8_WAIT_V(8); PG8_WAIT_L(0); PG8_BAR; PG8_MMA(0, 0, At, B0); PG8_MMA(0, 1, At, B1); PG8_BAR; PG8_SCHED;
            PG8_LDA(At, 1, 1); PG8_STAGE(PG8_SB(1, 0), b3, voffB); PG8_STAGE(PG8_SB(1, 1), b3 + hstep, voffB); PG8_STAGE(PG8_SA(1, 0), a3, voffA);
            PG8_WAIT_V(8); PG8_WAIT_L(0); PG8_BAR; PG8_MMA(1, 0, At, B0); PG8_MMA(1, 1, At, B1); PG8_BAR; PG8_SCHED;
        }
        if constexpr (ALIGN_EPI) { if (wr == 0) PG8_BAR; }
        E(acc, cur, wr, wc, fr, fq); S.done(cur);
        if (!has_next) break;
#pragma unroll
        for (int a = 0; a < 2; ++a)
#pragma unroll
            for (int b = 0; b < 2; ++b)
#pragma unroll
                for (int m = 0; m < 4; ++m)
#pragma unroll
                    for (int n = 0; n < 2; ++n) acc[a][b][m][n] = (f32x4){0.f, 0.f, 0.f, 0.f};
        cur = nxt; cA = nA; cB = nB; ++ui;
        if constexpr (ALIGN_EPI) { if (wr == 1) PG8_BAR; }
    }
    PG8_WAIT_V(0);
    if constexpr (!ALIGN_EPI) { if (wr == 0) PG8_BAR; }
    PG8_BAR;
#undef PG8_SA
#undef PG8_SB
#undef PG8_STAGE
#undef PG8_LDA
#undef PG8_LDB
#undef PG8_MMA
#undef PG8_WAIT_V
#undef PG8_WAIT_L
#undef PG8_BAR
#undef PG8_SCHED
}
}

#define LAS __attribute__((address_space(3)))
#define GAS __attribute__((address_space(1)))
typedef unsigned v4u __attribute__((ext_vector_type(4)));
constexpr int NWAVES = 8, LDS_BYTES = 147456, RING_BYTES = 131072;
#define LDS_WAIT() asm volatile("s_waitcnt lgkmcnt(0)" ::: "memory")

__device__ __forceinline__ void transpose_item(const float* W, int K, int N, int Npad, bf16_t* WT, LAS float* scr, int item, int lane) {
    const int nblk = Npad / 32, kb = item / nblk, nb = item % nblk, k0 = 64 * kb, n0 = 32 * nb;
    const int n = n0 + (lane & 31); const bool ok = n < N;
#pragma unroll 8
    for (int i = 0; i < 32; ++i) { const int kk = 2 * i + (lane >> 5); scr[kk * 33 + (lane & 31)] = ok ? W[(size_t)(k0 + kk) * N + n] : 0.f; }
    LDS_WAIT(); asm volatile("" ::: "memory");
    const int c = lane & 7;
#pragma unroll
    for (int j = 0; j < 4; ++j) { const int nn = (lane >> 3) + 8 * j; const LAS float* s = scr + (8 * c) * 33 + nn;
        v4u o; o.x = pk2(s[0 * 33], s[1 * 33]); o.y = pk2(s[2 * 33], s[3 * 33]); o.z = pk2(s[4 * 33], s[5 * 33]); o.w = pk2(s[6 * 33], s[7 * 33]);
        *(GAS v4u*)(WT + (size_t)(n0 + nn) * K + k0 + 8 * c) = o; }
    LDS_WAIT(); asm volatile("" ::: "memory");
}


#define XB_TMO      128
#define XB_XCNT(j)  (256  + 64 * (j))
#define XB_XSUB(j)  (1280 + 64 * (j))
#define XB_XGEN(j)  (2304 + 64 * (j))
#define XB_TOP      3328
#define XB_TOPGEN   3392
#define XCD_BAR_WORDS 3456
#define XB_SPIN_CAP (1u << 20)
__device__ __forceinline__ unsigned xb_ld(unsigned* p)              { return __hip_atomic_load(p, __ATOMIC_RELAXED, __HIP_MEMORY_SCOPE_AGENT); }
__device__ __forceinline__ unsigned xb_add(unsigned* p, unsigned v) { return __hip_atomic_fetch_add(p, v, __ATOMIC_RELAXED, __HIP_MEMORY_SCOPE_AGENT); }
__device__ __forceinline__ unsigned xb_xcc_id() { return (unsigned)__builtin_amdgcn_s_getreg((3 << 11) | 20) & 0xFu; }
#define XB_SPIN(cond, bar) do { unsigned _sp = 0; while (cond) { __builtin_amdgcn_s_sleep(1); \
    if ((++_sp & 255u) == 0u) { if (xb_ld(&(bar)[XB_TMO])) break; if (_sp > XB_SPIN_CAP) { atomicAdd(&(bar)[XB_TMO], 1u); break; } } } } while (0)
struct XcdBarrier { unsigned* bar; unsigned x; volatile LAS unsigned* st; };
__device__ __forceinline__ XcdBarrier xcd_barrier_post(unsigned* bar, volatile LAS unsigned* st) {
    XcdBarrier b; b.bar = bar; b.x = xb_xcc_id(); b.st = st;
    if (threadIdx.x == 0) (void)xb_add(&bar[XB_XCNT(b.x)], 1u);
    return b;
}
__device__ __forceinline__ void xcd_barrier_complete(unsigned* bar, unsigned x, unsigned& nloc, unsigned& nx) {
    const unsigned G = gridDim.x * gridDim.y * gridDim.z;
    unsigned sum, cnt, mine, sp = 0u;
    for (;;) {
        sum = 0u; cnt = 0u; mine = 0u;
#pragma unroll
        for (unsigned j = 0; j < 16; ++j) { const unsigned c = xb_ld(&bar[XB_XCNT(j)]); sum += c; cnt += (c > 0u) ? 1u : 0u; mine = (j == x) ? c : mine; }
        if (sum == G) break;
        __builtin_amdgcn_s_sleep(1);
        if ((++sp & 255u) == 0u) { if (xb_ld(&bar[XB_TMO])) break; if (sp > XB_SPIN_CAP) { atomicAdd(&bar[XB_TMO], 1u); break; } }
    }
    nloc = mine > 0u ? mine : 1u; nx = cnt > 0u ? cnt : 1u;
}
__device__ __forceinline__ void xcd_barrier(const XcdBarrier& b) {
    asm volatile("s_waitcnt vmcnt(0)" ::: "memory");
    __syncthreads();
    if (threadIdx.x == 0) {
        unsigned* bar = b.bar;
        __builtin_amdgcn_s_waitcnt(0);
        unsigned nloc = b.st[0], nx = b.st[1];
        if (nloc == 0u) { xcd_barrier_complete(bar, b.x, nloc, nx); b.st[0] = nloc; b.st[1] = nx; }
        const unsigned old = xb_add(&bar[XB_XSUB(b.x)], 1u);
        const unsigned gen = old / nloc;
        if (old + 1u == (gen + 1u) * nloc) {
            __builtin_amdgcn_fence(__ATOMIC_RELEASE, "agent");
            asm volatile("s_waitcnt vmcnt(0)" ::: "memory");
            const unsigned og = xb_add(&bar[XB_TOP], 1u);
            const unsigned tg = og / nx;
            if (og + 1u == (tg + 1u) * nx) xb_add(&bar[XB_TOPGEN], 1u);
            else XB_SPIN(xb_ld(&bar[XB_TOPGEN]) == tg, bar);
            __builtin_amdgcn_fence(__ATOMIC_ACQUIRE, "agent");
            xb_add(&bar[XB_XGEN(b.x)], 1u);
            asm volatile("s_waitcnt vmcnt(0)" ::: "memory");
        } else {
            XB_SPIN(xb_ld(&bar[XB_XGEN(b.x)]) == gen, bar);
            __builtin_amdgcn_fence(__ATOMIC_ACQUIRE, "agent");
            asm volatile("s_waitcnt vmcnt(0)" ::: "memory");
        }
    }
    __syncthreads();
}

constexpr int N_PHASES = 1 + 9 * NL;

__device__ __forceinline__ void run_phase(CArgs& a, int ph, LAS unsigned char* lds, const int tid, const int bid) {
    const int lane = tid & 63, wave = __builtin_amdgcn_readfirstlane(tid >> 6);
    const int G = gridDim.x, gw = bid * NWAVES + wave, NGW = G * NWAVES;
    if (ph == N_PHASES - 1) {
        for (int t = gw; t < T; t += NGW) rms_row_f32(HRES + (size_t)t * D, a.in[I_NF], a.out + (size_t)t * D, lane);
        return;
    }
    const int l = ph / 9, sp = ph % 9;
    const float* hin = l == 0 ? a.in[I_X] : (const float*)HRES;
    switch (sp) {
    case 0: {
        LAS float* scr = (LAS float*)(lds + wave * 16384);
        constexpr int I_IN = (D / 64) * (PTP / 32), I_OUT = (D / 64) * (D / 32), I_UP = (D / 64) * (FF / 32), I_DN = (FF / 64) * (D / 32), I_L = I_IN + I_OUT + I_UP + I_DN;
        for (int it = gw; it < I_L; it += NGW) {
            int r = it;
            if (r < I_IN) { transpose_item(LP(I_WIN, (size_t)D * PT), D, PT, PTP, (bf16_t*)(a.ws + WS_WIN), scr, r, lane); continue; } r -= I_IN;
            if (r < I_OUT) { transpose_item(LP(I_WOUT, (size_t)D * D), D, D, D, (bf16_t*)(a.ws + WS_WOUT), scr, r, lane); continue; } r -= I_OUT;
            if (r < I_UP) { transpose_item(LP(I_WUP, (size_t)D * FF), D, FF, FF, (bf16_t*)(a.ws + WS_WUP), scr, r, lane); continue; } r -= I_UP;
            transpose_item(LP(I_WDN, (size_t)FF * D), FF, D, D, (bf16_t*)(a.ws + WS_WDN), scr, r, lane);
        }
        for (int t = gw; t < T; t += NGW) rms_row_bf16(hin + (size_t)t * D, LP(I_N1, D), (bf16_t*)(a.ws + WS_XN) + (size_t)t * D, lane);
    } break;
    case 1: { pg8::Gemm g{(const bf16_t*)(a.ws + WS_XN), (const bf16_t*)(a.ws + WS_WIN)}; pg8::StaticOrder<T, PTP> S; S.init(G, bid);
              pg8::EpiBf16<false> E{(bf16_t*)(a.ws + WS_PROJ), PTP}; pg8::gemm_phase<D, pg8::EpiBf16<false>, pg8::StaticOrder<T, PTP>, true>(lds, g, S, E, tid); } break;
    case 2: { LAS float* scr = (LAS float*)(lds + wave * 1024);
#pragma unroll 1
              for (int t = gw; t < T; t += NGW) prep_gdn(a, l, t, lane);
#pragma unroll 1
              for (int t = gw; t < T; t += NGW) prep_ret(a, l, t, lane);
#pragma unroll 1
              for (int t = gw; t < T; t += NGW) prep_ssd(a, l, t, lane);
#pragma unroll 1
              for (int t = gw; t < T; t += NGW) prep_rwkv(a, l, t, lane, scr); } break;
    case 3: { const int nb = 512 / (CPW * NWAVES);
              const int b = bid; if (b < 4 * nb) { const int mixer = b / nb, wv = (b % nb) * NWAVES + wave;
                  if (mixer == 0) scan_gdn(a, wv, lane); else if (mixer == 1) scan_ret(a, wv, lane); else if (mixer == 2) scan_ssd(a, l, wv, lane); else scan_rwkv(a, wv, lane); } } break;
    case 4: for (int t = gw; t < T; t += NGW) post_token(a, l, t, lane); break;
    case 5: { pg8::Gemm g{(const bf16_t*)(a.ws + WS_O), (const bf16_t*)(a.ws + WS_WOUT)}; pg8::StaticOrder<T, D> S; S.init(G, bid);
              pg8::EpiAddRes E{hin, HRES, D}; pg8::gemm_phase<D, pg8::EpiAddRes, pg8::StaticOrder<T, D>, false>(lds, g, S, E, tid); } break;
    case 6: for (int t = gw; t < T; t += NGW) rms_row_bf16(HRES + (size_t)t * D, LP(I_N2, D), (bf16_t*)(a.ws + WS_XN) + (size_t)t * D, lane); break;
    case 7: { pg8::Gemm g{(const bf16_t*)(a.ws + WS_XN), (const bf16_t*)(a.ws + WS_WUP)}; pg8::StaticOrder<T, FF> S; S.init(G, bid);
              pg8::EpiBf16<true> E{(bf16_t*)(a.ws + WS_HID), FF}; pg8::gemm_phase<D, pg8::EpiBf16<true>, pg8::StaticOrder<T, FF>, true>(lds, g, S, E, tid); } break;
    case 8: { pg8::Gemm g{(const bf16_t*)(a.ws + WS_HID), (const bf16_t*)(a.ws + WS_WDN)}; pg8::StaticOrder<T, D> S; S.init(G, bid);
              pg8::EpiAddRes E{HRES, HRES, D}; pg8::gemm_phase<FF, pg8::EpiAddRes, pg8::StaticOrder<T, D>, false>(lds, g, S, E, tid); } break;
    }
}

__global__ void __launch_bounds__(NWAVES * 64, 2) fwd_kernel(Args a) {
    extern __shared__ __attribute__((aligned(16))) unsigned char lds_raw[];
    LAS unsigned char* lds = (LAS unsigned char*)lds_raw;
    const int ph_lo = a.ph_lo, ph_hi = a.ph_hi;
    volatile LAS unsigned* MISC = (volatile LAS unsigned*)(lds + RING_BYTES);
    if (threadIdx.x < 64) MISC[threadIdx.x] = 0u;
    __syncthreads();
    const XcdBarrier bar = xcd_barrier_post((unsigned*)(a.ws + WS_CTL), MISC + 8);
    for (int ph = ph_lo; ph < ph_hi; ++ph) {
        CArgs* ap = (CArgs*)__builtin_amdgcn_kernarg_segment_ptr();
        asm volatile("" : "+s"(ap));
        int tid = threadIdx.x, bid = blockIdx.x;
        asm volatile("" : "+v"(tid)); asm volatile("" : "+s"(bid));
        run_phase(*ap, ph, lds, tid, bid);
        if (ph + 1 < ph_hi) xcd_barrier(bar);
    }
}

extern "C" void kernel_launch(void* const* d_in, const int* in_sizes, int n_in, void* d_out, int out_size, void* d_ws, size_t ws_size, hipStream_t stream) {
    static int grid = 0;
    if (grid == 0) {
        if (n_in != N_IN || in_sizes[0] != T * D || out_size != T * D || ws_size < WS_END) {
            fprintf(stderr, "kernel_launch: shape/workspace mismatch: n_in %d in0 %d out %d ws %zu (need %zu); nothing launched\n", n_in, n_in > 0 ? in_sizes[0] : -1, out_size, ws_size, (size_t)WS_END); grid = -1; return; }
        int dev = 0, cus = 0, per_cu = 0;
        if (hipGetDevice(&dev) != hipSuccess || hipDeviceGetAttribute(&cus, hipDeviceAttributeMultiprocessorCount, dev) != hipSuccess) { grid = -1; return; }
        if (hipFuncSetAttribute((const void*)fwd_kernel, hipFuncAttributeMaxDynamicSharedMemorySize, LDS_BYTES) != hipSuccess) { fprintf(stderr, "kernel_launch: hipFuncSetAttribute failed\n"); grid = -1; return; }
        if (hipOccupancyMaxActiveBlocksPerMultiprocessor(&per_cu, (const void*)fwd_kernel, NWAVES * 64, LDS_BYTES) != hipSuccess || per_cu < 1) { fprintf(stderr, "kernel_launch: occupancy query says %d blocks per CU\n", per_cu); per_cu = 1; }
        (void)hipGetLastError();
        grid = cus;
    }
    if (grid < 0) return;
    Args a{};
    for (int i = 0; i < N_IN; ++i) a.in[i] = (const float*)d_in[i];
    a.out = (float*)d_out; a.ws = (unsigned char*)d_ws;
#if N_LAUNCH_MODE == 1
    a.ph_lo = 0; a.ph_hi = N_PHASES;
    (void)hipMemsetAsync((char*)d_ws + WS_CTL, 0, XCD_BAR_WORDS * 4, stream);
    hipLaunchKernelGGL(fwd_kernel, dim3(grid), dim3(NWAVES * 64), LDS_BYTES, stream, a);
#else
#ifndef DBG_MAXPH
#define DBG_MAXPH N_PHASES
#endif
    for (int ph = 0; ph < N_PHASES; ++ph) {
        if (ph >= DBG_MAXPH && ph != N_PHASES - 1) continue;
#ifdef DBG_SKIP_FINAL
        if (ph == N_PHASES - 1) continue;
#endif
        (void)hipMemsetAsync((char*)d_ws + WS_CTL, 0, XCD_BAR_WORDS * 4, stream);
        a.ph_lo = ph; a.ph_hi = ph + 1;
        hipLaunchKernelGGL(fwd_kernel, dim3(grid), dim3(NWAVES * 64), LDS_BYTES, stream, a);
    }
#endif
}
#endif
```

```cpp
#ifndef HOST_TEST
#include <hip/hip_runtime.h>
#endif
#include <cstdio>
#include <cstdint>
#include <cmath>
#include <cstddef>

#ifndef SEQ_T
#define SEQ_T 8192
#endif
#ifndef N_LAUNCH_MODE
#define N_LAUNCH_MODE 1
#endif

constexpr int T = SEQ_T, D = 2048, NL = 2, FF = 8192, PT = 6832, PTP = 6912;
constexpr int C_GQ = 0, C_GK = 512, C_GV = 1024, C_GZ = 1536, C_GB = 2048, C_GA = 2052;
constexpr int C_RQ = 2056, C_RK = 2312, C_RV = 2568, C_RG = 3080;
constexpr int C_MZ = 3592, C_MXBC = 4104, C_MDT = 5128;
constexpr int C_RW = 5136;
enum { I_X = 0, I_N1, I_WIN, I_GCONV, I_GALOG, I_GDTB, I_GNORM, I_RNORM, I_MCONV, I_MCONVB, I_MALOG, I_MDTB, I_MD, I_MNORM, I_RWMU, I_RWW0, I_RWWUP, I_RWA0, I_RWAUP,
       I_RWGUP, I_RWKK, I_RWKA, I_RWRK, I_RWLNW, I_RWLNB, I_WOUT, I_N2, I_WUP, I_WDN, I_NF, N_IN };

constexpr size_t MiB = 1u << 20;
constexpr size_t SZ_WIN = (size_t)PTP * D * 2, SZ_WOUT = (size_t)D * D * 2, SZ_WUP = (size_t)FF * D * 2, SZ_WDN = (size_t)D * FF * 2;
constexpr size_t WS_CTL = 0, CTL_BYTES = 1 * MiB;
constexpr size_t WS_WIN = WS_CTL + CTL_BYTES;
constexpr size_t WS_WOUT = WS_WIN + SZ_WIN;
constexpr size_t WS_WUP = WS_WOUT + SZ_WOUT;
constexpr size_t WS_WDN = WS_WUP + SZ_WUP;
constexpr size_t WS_XN = WS_WDN + SZ_WDN;
constexpr size_t WS_O = WS_XN;
constexpr size_t WS_PROJ = WS_XN + (size_t)T * D * 2;
constexpr size_t WS_HID = WS_PROJ;
constexpr size_t GDN_ = (size_t)(T / 64) * 4 * 16384;
constexpr size_t WS_GD_G = WS_PROJ + (size_t)T * PTP * 2;
constexpr size_t WS_GD_Z = WS_GD_G + GDN_ * 2;
constexpr size_t WS_GD_QT = WS_GD_Z + GDN_ * 4;
constexpr size_t WS_GD_YI = WS_GD_QT + GDN_;
constexpr size_t WS_GD_S = WS_GD_YI + GDN_;
constexpr size_t WS_GAB = WS_GD_S + GDN_ * 2;
constexpr int NCH = T / 64;
constexpr size_t WS_RET_Z = WS_GAB;
constexpr size_t WS_RET_YI = WS_RET_Z + (size_t)NCH * 4 * 8192 * 4;
constexpr size_t WS_RET_QH = WS_RET_YI + (size_t)NCH * 4 * 8192 * 2;
constexpr size_t WS_RET_S = WS_RET_QH + (size_t)NCH * 4 * 4096 * 2;
constexpr size_t M2N = (size_t)NCH * 8 * 8192;
constexpr size_t WS_M2_Z = WS_RET_S + (size_t)NCH * 4 * 8192 * 2;
constexpr size_t WS_M2_YI = WS_M2_Z + M2N * 4;
constexpr size_t WS_M2_QH = WS_M2_YI + M2N;
constexpr size_t WS_M2_S = WS_M2_QH + M2N * 2;
constexpr size_t WS_M2_DEC = WS_M2_S + M2N * 2;
constexpr size_t WS_MDT = WS_M2_DEC + (size_t)NCH * 8 * 4;
constexpr size_t RWN = (size_t)NCH * 8 * 4096;
constexpr size_t WS_RW_G = WS_MDT;
constexpr size_t WS_RW_Z = WS_RW_G + RWN * 2;
constexpr size_t WS_RW_QT = WS_RW_Z + RWN * 4;
constexpr size_t WS_RW_YI = WS_RW_QT + RWN * 2;
constexpr size_t WS_RW_E = WS_RW_YI + RWN * 2;
constexpr size_t WS_RW_GT = WS_RW_E + RWN * 2;
constexpr size_t WS_RW_S = WS_RW_GT + RWN * 2;
constexpr size_t WS_END = WS_RW_S + RWN * 2;
static_assert(WS_HID + (size_t)T * FF * 2 <= WS_END, "HID overlay");
static_assert(SEQ_T != 8192 || WS_END <= 512 * MiB, "d_ws budget (512 MiB)");

typedef unsigned short bf16_t;
#ifdef HOST_TEST
#define DEV static inline
#define HD static inline
typedef float f32x4 __attribute__((vector_size(16)));
constexpr int WAVE = 1, LPC = 1;
static inline float wave_sum(float v) { return v; }
static inline float group_sum(float v) { return v; }
#else
#define DEV __device__ __forceinline__
#define HD __host__ __device__ __forceinline__
typedef float f32x4 __attribute__((ext_vector_type(4)));
constexpr int WAVE = 64, LPC = 16;
DEV float wave_sum(float v) {
#pragma unroll
    for (int o = 1; o < 64; o <<= 1) v += __shfl_xor(v, o);
    return v;
}
DEV float group_sum(float v) {
#pragma unroll
    for (int o = 1; o < 16; o <<= 1) v += __shfl_xor(v, o);
    return v;
}
#endif
constexpr int CPW = WAVE / LPC;

HD unsigned f2bf(float f) { unsigned u; __builtin_memcpy(&u, &f, 4); return (u + 0x7fffu + ((u >> 16) & 1u)) >> 16; }
HD unsigned pk2(float lo, float hi) { return f2bf(lo) | (f2bf(hi) << 16); }
HD float bf2f(bf16_t b) { unsigned u = (unsigned)b << 16; float f; __builtin_memcpy(&f, &u, 4); return f; }
DEV float sigmoid_f(float x) { return 1.0f / (1.0f + expf(-x)); }
DEV float silu_f(float x) { return x / (1.0f + expf(-x)); }
DEV float softplus_f(float x) { return x > 20.f ? x : log1pf(expf(x)); }

struct Args { const float* in[N_IN]; float* out; unsigned char* ws; int ph_lo, ph_hi; };
#ifdef HOST_TEST
typedef const Args CArgs;
#else
typedef const __attribute__((address_space(4))) Args CArgs;
#endif
#define WSF(off) ((float*)(a.ws + (off)))
#define HRES (a.out)
#define PROJROW(t) ((const bf16_t*)(a.ws + WS_PROJ) + (size_t)(t) * PTP)
#define LP(idx, per) (a.in[idx] + (size_t)l * (per))

DEV void rms_row_bf16(const float* x, const float* w, bf16_t* o, int lane) {
    float ss = 0.f;
    for (int i = lane * 4; i < D; i += WAVE * 4) { const f32x4 v = *(const f32x4*)(x + i); ss += (v[0] * v[0] + v[1] * v[1]) + (v[2] * v[2] + v[3] * v[3]); }
    const float r = 1.0f / sqrtf(wave_sum(ss) * (1.0f / D) + 1e-6f);
    for (int i = lane * 4; i < D; i += WAVE * 4) { const f32x4 v = *(const f32x4*)(x + i), g = *(const f32x4*)(w + i);
        unsigned* op = (unsigned*)(o + i); op[0] = pk2(v[0] * r * g[0], v[1] * r * g[1]); op[1] = pk2(v[2] * r * g[2], v[3] * r * g[3]); }
}
DEV void rms_row_f32(const float* x, const float* w, float* o, int lane) {
    float ss = 0.f;
    for (int i = lane * 4; i < D; i += WAVE * 4) { const f32x4 v = *(const f32x4*)(x + i); ss += (v[0] * v[0] + v[1] * v[1]) + (v[2] * v[2] + v[3] * v[3]); }
    const float r = 1.0f / sqrtf(wave_sum(ss) * (1.0f / D) + 1e-6f);
    for (int i = lane * 4; i < D; i += WAVE * 4) { const f32x4 v = *(const f32x4*)(x + i), g = *(const f32x4*)(w + i);
        f32x4 y; y[0] = v[0] * r * g[0]; y[1] = v[1] * r * g[1]; y[2] = v[2] * r * g[2]; y[3] = v[3] * r * g[3]; *(f32x4*)(o + i) = y; }
}

DEV float conv4(const bf16_t* projrow_t, int col, const float* w, int c, int wstride, int t) {
    float acc = 0.f;
#pragma unroll
    for (int j = 0; j < 4; ++j) { const int tt = t - 3 + j; if (tt >= 0) acc += w[j * wstride + c] * bf2f(projrow_t[(ptrdiff_t)(j - 3) * PTP + col]); }
    return acc;
}

#ifdef HOST_TEST
static const float THETA[32] = {
#else
__device__ const float THETA[32] = {
#endif
    1.000000000e+00f, 7.429639101e-01f, 5.519954562e-01f, 4.101127088e-01f, 3.046989739e-01f, 2.263803482e-01f, 1.681924462e-01f, 1.249609292e-01f, 9.284145385e-02f, 6.897785515e-02f,
    5.124806613e-02f, 3.807546571e-02f, 2.828869782e-02f, 2.101748064e-02f, 1.561523322e-02f, 1.160155423e-02f, 8.619536646e-03f, 6.404003594e-03f, 4.757945426e-03f, 3.534980817e-03f,
    2.626363887e-03f, 1.951293205e-03f, 1.449740841e-03f, 1.077104942e-03f, 8.002503891e-04f, 5.945570301e-04f, 4.417345626e-04f, 3.281927784e-04f, 2.438354713e-04f, 1.811609109e-04f,
    1.345960627e-04f, 9.999999747e-05f };

#ifndef HOST_TEST
namespace pg8 {
#define PG8_LAS __attribute__((address_space(3)))
typedef short bf16x8 __attribute__((ext_vector_type(8)));
typedef unsigned u32x4 __attribute__((ext_vector_type(4)));
constexpr int BM = 256, BK = 64, HALF = 128, HTB = HALF * BK * 2, STAGE_BYTES = 8 * HTB, NXCD = 8, WGM = 8;
__host__ __device__ __forceinline__ int lds_byte(int r, int c) { const int st = (r >> 4) * 2 + (c >> 5), rr = r & 15, cc = c & 31, ob = rr * 64 + cc * 2; return st * 1024 + (ob ^ (((ob >> 9) & 1) << 5)); }
__host__ __device__ __forceinline__ void stage_rc(int b, int& R, int& C) { const int st = b / 1024, sb = b % 1024, swz = sb ^ (((sb >> 9) & 1) << 5); R = (st >> 1) * 16 + swz / 64; C = (st & 1) * 32 + (swz % 64) / 2; }
__host__ __device__ __forceinline__ int perm32(int rho) { const int n = rho >> 4, i = rho & 15; return 8 * (i >> 2) + 4 * n + (i & 3); }
struct Unit { int pm, pn; };
struct Gemm { const bf16_t* A; const bf16_t* Bt; };
template <int M, int N> struct StaticOrder {
    static constexpr int nM = M / BM, nN = N / BM, nwg = nM * nN; int G, c;
    __device__ void init(int G_, int c_) { G = G_; c = c_; }
    __device__ bool next(int i, Unit& u) const {
        const long L = (long)i * G + c; if (L >= nwg) return false;
        int wgid = (int)L; { const int q = nwg / NXCD, r = nwg % NXCD, xcd = wgid % NXCD, off = wgid / NXCD; wgid = (xcd < r ? xcd * (q + 1) : r * (q + 1) + (xcd - r) * q) + off; }
        const int nig = WGM * nN, gid = wgid / nig, fm = gid * WGM, gsz = (nM - fm) < WGM ? (nM - fm) : WGM;
        u.pm = fm + ((wgid % nig) % gsz); u.pn = (wgid % nig) / gsz; return true;
    }
    __device__ __forceinline__ void a_ready(const Unit&) const {}
    __device__ __forceinline__ void done(const Unit&) const {}
};
__device__ __forceinline__ unsigned cvt_pk_bf16(float lo, float hi) { unsigned r; asm volatile("v_cvt_pk_bf16_f32 %0, %1, %2" : "=v"(r) : "v"(lo), "v"(hi)); return r; }
struct EpiStoreF32 {
    static constexpr bool PERM = false, AFTER_DRAIN = false; float* O; int ldc;
    __device__ __forceinline__ void operator()(const f32x4 (&acc)[2][2][4][2], const Unit& u, int wr, int wc, int fr, int fq) const {
        const int row0 = u.pm * BM + wr * 64 + fr, col0 = u.pn * BM + wc * 32 + 4 * fq;
#pragma unroll
        for (int ai = 0; ai < 2; ++ai)
#pragma unroll
            for (int m = 0; m < 4; ++m) { float* rowp = O + (size_t)(row0 + ai * HALF + m * 16) * ldc + col0;
#pragma unroll
                for (int bj = 0; bj < 2; ++bj)
#pragma unroll
                    for (int n = 0; n < 2; ++n) *(f32x4*)(rowp + bj * HALF + n * 16) = acc[ai][bj][m][n]; }
    }
};
struct EpiAddRes {
    static constexpr bool PERM = false, AFTER_DRAIN = false; const float* B; float* O; int ldc;
    __device__ __forceinline__ void operator()(const f32x4 (&acc)[2][2][4][2], const Unit& u, int wr, int wc, int fr, int fq) const {
        const int row0 = u.pm * BM + wr * 64 + fr, col0 = u.pn * BM + wc * 32 + 4 * fq;
#pragma unroll
        for (int ai = 0; ai < 2; ++ai)
#pragma unroll
            for (int m = 0; m < 4; ++m) { float* rowp = O + (size_t)(row0 + ai * HALF + m * 16) * ldc + col0; const float* bp = B + (size_t)(row0 + ai * HALF + m * 16) * ldc + col0;
                f32x4 b[2][2];
#pragma unroll
                for (int bj = 0; bj < 2; ++bj)
#pragma unroll
                    for (int n = 0; n < 2; ++n) b[bj][n] = *(const f32x4*)(bp + bj * HALF + n * 16);
#pragma unroll
                for (int bj = 0; bj < 2; ++bj)
#pragma unroll
                    for (int n = 0; n < 2; ++n) *(f32x4*)(rowp + bj * HALF + n * 16) = b[bj][n] + acc[ai][bj][m][n]; }
    }
};
template <bool SQRELU> struct EpiBf16 {
    static constexpr bool PERM = true, AFTER_DRAIN = false; bf16_t* O; int ldc;
    __device__ __forceinline__ void operator()(const f32x4 (&acc)[2][2][4][2], const Unit& u, int wr, int wc, int fr, int fq) const {
        const int row0 = u.pm * BM + wr * 64 + fr, col0 = u.pn * BM + wc * 32 + 8 * fq;
#pragma unroll
        for (int ai = 0; ai < 2; ++ai)
#pragma unroll
            for (int m = 0; m < 4; ++m) { bf16_t* rowp = O + (size_t)(row0 + ai * HALF + m * 16) * ldc + col0;
#pragma unroll
                for (int bj = 0; bj < 2; ++bj) { f32x4 v0 = acc[ai][bj][m][0], v1 = acc[ai][bj][m][1];
                    if (SQRELU) {
#pragma unroll
                        for (int j = 0; j < 4; ++j) { const float p0 = fmaxf(v0[j], 0.f), p1 = fmaxf(v1[j], 0.f); v0[j] = p0 * p0; v1[j] = p1 * p1; } }
                    u32x4 w; w.x = cvt_pk_bf16(v0[0], v0[1]); w.y = cvt_pk_bf16(v0[2], v0[3]); w.z = cvt_pk_bf16(v1[0], v1[1]); w.w = cvt_pk_bf16(v1[2], v1[3]);
                    *(u32x4*)(rowp + bj * HALF) = w; } }
    }
};

template <int K, class Epi, class Sched, bool ALIGN_EPI = false>
__device__ __forceinline__ void gemm_phase(PG8_LAS unsigned char* lds, const Gemm g, const Sched& S, const Epi& E, const int tid) {
    const int wid = __builtin_amdgcn_readfirstlane(tid >> 6), lane = tid & 63, wr = wid >> 2, wc = wid & 3, fr = lane & 15, fq = lane >> 4;
    constexpr int nt = K / BK;
    unsigned voffA[2], voffB[2];
#pragma unroll
    for (int i = 0; i < 2; ++i) { int R, C; stage_rc(tid * 16 + i * 8192, R, C); const int Rb = Epi::PERM ? ((R & ~31) + perm32(R & 31)) : R;
        voffA[i] = (unsigned)(R * K + C) * 2u; voffB[i] = (unsigned)(Rb * K + C) * 2u; }
    const size_t kstep = (size_t)(BK * 2);
    const size_t hstep = (size_t)HALF * K * 2;
    const size_t tstep = 2 * hstep;
    const unsigned ldsw = (unsigned)wid * 1024u;
    const int aoff = lds_byte(wr * 64 + fr, fq * 8), boff = lds_byte(wc * 32 + fr, fq * 8);
#define PG8_SA(b, h) (((b) * 2 + (h)) * HTB)
#define PG8_SB(b, h) ((4 + (b) * 2 + (h)) * HTB)
#define PG8_STAGE(bufoff, gbase, voff) do { _Pragma("unroll") for (int _i = 0; _i < 2; ++_i) \
        __builtin_amdgcn_global_load_lds((const unsigned*)((const char*)(gbase) + (voff)[_i]), (PG8_LAS unsigned*)(lds + (bufoff) + ldsw + _i * 8192), 16, 0, 0); } while (0)
#define PG8_LDA(dst, b, h) do { _Pragma("unroll") for (int m = 0; m < 4; ++m) _Pragma("unroll") for (int k = 0; k < 2; ++k) dst[m][k] = *(const PG8_LAS bf16x8*)(lds + PG8_SA(b, h) + aoff + m * 2048 + k * 1024); } while (0)
#define PG8_LDB(dst, b, h) do { _Pragma("unroll") for (int n = 0; n < 2; ++n) _Pragma("unroll") for (int k = 0; k < 2; ++k) dst[n][k] = *(const PG8_LAS bf16x8*)(lds + PG8_SB(b, h) + boff + n * 2048 + k * 1024); } while (0)
#define PG8_MMA(ai, bj, At, Bt) do { __builtin_amdgcn_s_setprio(1); _Pragma("unroll") for (int m = 0; m < 4; ++m) _Pragma("unroll") for (int n = 0; n < 2; ++n) _Pragma("unroll") for (int k = 0; k < 2; ++k) \
        acc[ai][bj][m][n] = __builtin_amdgcn_mfma_f32_16x16x32_bf16(Bt[n][k], At[m][k], acc[ai][bj][m][n], 0, 0, 0); __builtin_amdgcn_s_setprio(0); } while (0)
#define PG8_WAIT_V(n) asm volatile("s_waitcnt vmcnt(" #n ")" ::: "memory")
#define PG8_WAIT_L(n) asm volatile("s_waitcnt lgkmcnt(" #n ")" ::: "memory")
#define PG8_BAR __builtin_amdgcn_s_barrier()
#define PG8_SCHED __builtin_amdgcn_sched_barrier(0)
    Unit cur, nxt; int ui = 0;
    if (!S.next(0, cur)) return;
    f32x4 acc[2][2][4][2];
#pragma unroll
    for (int a = 0; a < 2; ++a)
#pragma unroll
        for (int b = 0; b < 2; ++b)
#pragma unroll
            for (int m = 0; m < 4; ++m)
#pragma unroll
                for (int n = 0; n < 2; ++n) acc[a][b][m][n] = (f32x4){0.f, 0.f, 0.f, 0.f};
    bf16x8 At[4][2], B0[2][2], B1[2][2];
    const char* cA = (const char*)g.A + (size_t)cur.pm * tstep; const char* cB = (const char*)g.Bt + (size_t)cur.pn * tstep;
    S.a_ready(cur);
    PG8_STAGE(PG8_SB(0, 0), cB, voffB); PG8_STAGE(PG8_SB(0, 1), cB + hstep, voffB); PG8_STAGE(PG8_SA(0, 0), cA, voffA); PG8_STAGE(PG8_SA(0, 1), cA + hstep, voffA);
    if (wr == 1) PG8_BAR;
    PG8_WAIT_V(2); PG8_BAR;
    PG8_STAGE(PG8_SB(1, 0), cB + kstep, voffB); PG8_STAGE(PG8_SA(1, 0), cA + kstep, voffA); PG8_STAGE(PG8_SB(1, 1), cB + hstep + kstep, voffB);
    PG8_WAIT_V(6); PG8_BAR;
    for (;;) {
        const bool has_next = S.next(ui + 1, nxt);
        const char* nA = has_next ? (const char*)g.A + (size_t)nxt.pm * tstep : cA; const char* nB = has_next ? (const char*)g.Bt + (size_t)nxt.pn * tstep : cB;
        for (int t = 0; t < nt; t += 2) {
            const bool last = (t == nt - 2);
            const char* a1 = cA + (size_t)(t + 1) * kstep;
            const char* a2 = last ? nA : cA + (size_t)(t + 2) * kstep; const char* b2 = last ? nB : cB + (size_t)(t + 2) * kstep;
            const char* a3 = a2 + kstep; const char* b3 = b2 + kstep;
            if (last && has_next) S.a_ready(nxt);
            PG8_LDB(B0, 0, 0); PG8_LDB(B1, 0, 1); PG8_SCHED; PG8_LDA(At, 0, 0); PG8_STAGE(PG8_SA(1, 1), a1 + hstep, voffA);
            PG8_WAIT_V(8); PG8_WAIT_L(0); PG8_BAR; PG8_MMA(0, 0, At, B0); PG8_MMA(0, 1, At, B1); PG8_BAR; PG8_SCHED;
            PG8_LDA(At, 0, 1); PG8_STAGE(PG8_SB(0, 0), b2, voffB); PG8_STAGE(PG8_SB(0, 1), b2 + hstep, voffB); PG8_STAGE(PG8_SA(0, 0), a2, voffA);
            PG8_WAIT_V(8); PG8_WAIT_L(0); PG8_BAR; PG8_MMA(1, 0, At, B0); PG8_MMA(1, 1, At, B1); PG8_BAR; PG8_SCHED;
            PG8_LDB(B0, 1, 0); PG8_LDB(B1, 1, 1); PG8_SCHED; PG8_LDA(At, 1, 0); PG8_STAGE(PG8_SA(0, 1), a2 + hstep, voffA);
            PG8_WAIT_V(8); PG8_WAIT_L(0); PG8_BAR; PG8_MMA(0, 0, At, B0); PG8_MMA(0, 1, At, B1); PG8_BAR; PG8_SCHED;
            PG8_LDA(At, 1, 1); PG8_STAGE(PG8_SB(1, 0), b3, voffB); PG8_STAGE(PG8_SB(1, 1), b3 + hstep, voffB); PG8_STAGE(PG8_SA(1, 0), a3, voffA);
            PG8_WAIT_V(8); PG8_WAIT_L(0); PG8_BAR; PG8_MMA(1, 0, At, B0); PG8_MMA(1, 1, At, B1); PG8_BAR; PG8_SCHED;
        }
        if constexpr (ALIGN_EPI) { if (wr == 0) PG8_BAR; }
        E(acc, cur, wr, wc, fr, fq); S.done(cur);
        if (!has_next) break;
#pragma unroll
        for (int a = 0; a < 2; ++a)
#pragma unroll
            for (int b = 0; b < 2; ++b)
#pragma unroll
                for (int m = 0; m < 4; ++m)
#pragma unroll
                    for (int n = 0; n < 2; ++n) acc[a][b][m][n] = (f32x4){0.f, 0.f, 0.f, 0.f};
        cur = nxt; cA = nA; cB = nB; ++ui;
        if constexpr (ALIGN_EPI) { if (wr == 1) PG8_BAR; }
    }
    PG8_WAIT_V(0);
    if constexpr (!ALIGN_EPI) { if (wr == 0) PG8_BAR; }
    PG8_BAR;
#undef PG8_SA
#undef PG8_SB
#undef PG8_STAGE
#undef PG8_LDA
#undef PG8_LDB
#undef PG8_MMA
#undef PG8_WAIT_V
#undef PG8_WAIT_L
#undef PG8_BAR
#undef PG8_SCHED
}
}

#define LAS __attribute__((address_space(3)))
#define GAS __attribute__((address_space(1)))
typedef unsigned v4u __attribute__((ext_vector_type(4)));
constexpr int NWAVES = 8, LDS_BYTES = 163840, MISC_OFF = LDS_BYTES - 512;
#define LDS_WAIT() asm volatile("s_waitcnt lgkmcnt(0)" ::: "memory")

__device__ __forceinline__ void transpose_item(const float* W, int K, int N, int Npad, bf16_t* WT, LAS float* scr, int item, int lane) {
    const int nblk = Npad / 32, kb = item / nblk, nb = item % nblk, k0 = 64 * kb, n0 = 32 * nb;
    const int n = n0 + (lane & 31); const bool ok = n < N;
#pragma unroll 8
    for (int i = 0; i < 32; ++i) { const int kk = 2 * i + (lane >> 5); scr[kk * 33 + (lane & 31)] = ok ? W[(size_t)(k0 + kk) * N + n] : 0.f; }
    LDS_WAIT(); asm volatile("" ::: "memory");
    const int c = lane & 7;
#pragma unroll
    for (int j = 0; j < 4; ++j) { const int nn = (lane >> 3) + 8 * j; const LAS float* s = scr + (8 * c) * 33 + nn;
        v4u o; o.x = pk2(s[0 * 33], s[1 * 33]); o.y = pk2(s[2 * 33], s[3 * 33]); o.z = pk2(s[4 * 33], s[5 * 33]); o.w = pk2(s[6 * 33], s[7 * 33]);
        *(GAS v4u*)(WT + (size_t)(n0 + nn) * K + k0 + 8 * c) = o; }
    LDS_WAIT(); asm volatile("" ::: "memory");
}


typedef short bf16x8 __attribute__((ext_vector_type(8)));
typedef short s16x4 __attribute__((ext_vector_type(4)));
typedef unsigned u32x2 __attribute__((ext_vector_type(2)));
__device__ __forceinline__ s16x4 tr16(const LAS bf16_t* p) { return __builtin_bit_cast(s16x4, __builtin_amdgcn_ds_read_tr16_b64_v4i16((LAS s16x4*)p)); }
__device__ __forceinline__ bf16x8 frag_row(const LAS bf16_t* img, int ld, int nc0, int k0, int lane) { return *(const LAS bf16x8*)(img + (nc0 + (lane & 15)) * ld + k0 + 8 * (lane >> 4)); }
__device__ __forceinline__ bf16x8 frag_tr(const LAS bf16_t* img, int ld, int nc0, int k0, int lane) {
    const int g = lane >> 4, q = (lane & 15) >> 2, p = lane & 3;
    const LAS bf16_t* ad = img + (k0 + 8 * g + q) * ld + nc0 + 4 * p;
    const s16x4 lo = tr16(ad), hi = tr16(ad + 4 * ld);
    return (bf16x8){lo[0], lo[1], lo[2], lo[3], hi[0], hi[1], hi[2], hi[3]};
}
__device__ __forceinline__ bf16x8 frag_row_g(const bf16_t* img, int ld, int nc0, int k0, int lane) { return *(const bf16x8*)(img + (size_t)(nc0 + (lane & 15)) * ld + k0 + 8 * (lane >> 4)); }
__device__ __forceinline__ f32x4 mfma16(bf16x8 a, bf16x8 b, f32x4 c) { return __builtin_amdgcn_mfma_f32_16x16x32_bf16(a, b, c, 0, 0, 0); }
__device__ __forceinline__ u32x2 pack4(f32x4 v) { u32x2 w; w.x = pk2(v[0], v[1]); w.y = pk2(v[2], v[3]); return w; }
__device__ __forceinline__ f32x4 unpack4(u32x2 w) { f32x4 v; v[0] = __uint_as_float(w.x << 16); v[1] = __uint_as_float(w.x & 0xffff0000u); v[2] = __uint_as_float(w.y << 16); v[3] = __uint_as_float(w.y & 0xffff0000u); return v; }
#define WG_SYNC() __syncthreads()

__device__ __forceinline__ void ret_stage1(CArgs& a, int n, int h, LAS unsigned char* lds, int tid) {
    const int lane = tid & 63, w = __builtin_amdgcn_readfirstlane(tid >> 6), r = lane & 15, g = lane >> 4;
    constexpr int LD = 72, LDV = 136;
    LAS bf16_t* Qi = (LAS bf16_t*)lds; LAS bf16_t* Ki = Qi + 64 * LD; LAS bf16_t* Kdi = Ki + 64 * LD; LAS bf16_t* Vi = Kdi + 64 * LD; LAS bf16_t* Si = Vi + 64 * LDV;
    const int tk = n * 4 + h; const float lg2 = log2f(1.0f - exp2f(-5.0f - (float)h));
    bf16_t* QH = (bf16_t*)(a.ws + WS_RET_QH) + (size_t)tk * 4096;
    for (int idx = tid; idx < 2048; idx += 512) {
        const int c = idx >> 5, i = idx & 31, t = n * 64 + c; float sn, cs; sincosf((float)t * THETA[i], &sn, &cs);
        const bf16_t* pr = PROJROW(t);
        const unsigned qq = *(const unsigned*)(pr + C_RQ + 64 * h + 2 * i), kk = *(const unsigned*)(pr + C_RK + 64 * h + 2 * i);
        const float q0 = __uint_as_float(qq << 16), q1 = __uint_as_float(qq & 0xffff0000u), k0 = __uint_as_float(kk << 16), k1 = __uint_as_float(kk & 0xffff0000u);
        const float rq0 = q0 * cs - q1 * sn, rq1 = q1 * cs + q0 * sn, rk0 = (k0 * cs - k1 * sn) * 0.125f, rk1 = (k1 * cs + k0 * sn) * 0.125f;
        const float dk = exp2f(lg2 * (float)(63 - c)), dq = exp2f(lg2 * (float)(c + 1));
        *(LAS unsigned*)(Qi + c * LD + 2 * i) = pk2(rq0, rq1); *(LAS unsigned*)(Ki + c * LD + 2 * i) = pk2(rk0, rk1); *(LAS unsigned*)(Kdi + c * LD + 2 * i) = pk2(rk0 * dk, rk1 * dk);
        *(unsigned*)(QH + c * 64 + 2 * i) = pk2(rq0 * dq, rq1 * dq);
    }
    for (int idx = tid; idx < 1024; idx += 512) { const int c = idx >> 4, ch = idx & 15; *(LAS v4u*)(Vi + c * LDV + 8 * ch) = *(const v4u*)(PROJROW(n * 64 + c) + C_RV + 128 * h + 8 * ch); }
    WG_SYNC();
#pragma unroll
    for (int tt = 0; tt < 2; ++tt) { const int tile = 2 * w + tt, im = tile >> 2, jc = tile & 3; f32x4 acc = {0.f, 0.f, 0.f, 0.f};
        if (jc >= im) {
#pragma unroll
            for (int k0 = 0; k0 < 64; k0 += 32) acc = mfma16(frag_row(Ki, LD, 16 * im, k0, lane), frag_row(Qi, LD, 16 * jc, k0, lane), acc);
#pragma unroll
            for (int e = 0; e < 4; ++e) { const int i = 16 * im + 4 * g + e, j = 16 * jc + r; acc[e] = j >= i ? acc[e] * exp2f(lg2 * (float)(j - i)) : 0.f; } }
        *(LAS u32x2*)(Si + (16 * jc + r) * LD + 16 * im + 4 * g) = pack4(acc); }
    WG_SYNC();
    bf16_t* YI = (bf16_t*)(a.ws + WS_RET_YI) + (size_t)tk * 8192; float* Z = WSF(WS_RET_Z) + (size_t)tk * 8192;
#pragma unroll
    for (int tt = 0; tt < 4; ++tt) { const int jc = w & 3, ie = 4 * (w >> 2) + tt; f32x4 acc = {0.f, 0.f, 0.f, 0.f};
#pragma unroll
        for (int k0 = 0; k0 < 64; k0 += 32) acc = mfma16(frag_tr(Vi, LDV, 16 * ie, k0, lane), frag_row(Si, LD, 16 * jc, k0, lane), acc);
        *(u32x2*)(YI + (16 * jc + r) * 128 + 16 * ie + 4 * g) = pack4(acc); }
#pragma unroll
    for (int tt = 0; tt < 4; ++tt) { const int id = w & 3, je = 4 * (w >> 2) + tt; f32x4 acc = {0.f, 0.f, 0.f, 0.f};
#pragma unroll
        for (int k0 = 0; k0 < 64; k0 += 32) acc = mfma16(frag_tr(Kdi, LD, 16 * id, k0, lane), frag_tr(Vi, LDV, 16 * je, k0, lane), acc);
        *(f32x4*)(Z + (16 * je + r) * 64 + 16 * id + 4 * g) = acc; }
    WG_SYNC();
}
__device__ __forceinline__ void ret_stage2(CArgs& a, int b, int tid) {
    const int idx = b * 512 + tid, h = idx >> 13, rem = idx & 8191; const float g64 = exp2f(64.0f * log2f(1.0f - exp2f(-5.0f - (float)h)));
    const float* Z = WSF(WS_RET_Z) + (size_t)h * 8192 + rem; bf16_t* S = (bf16_t*)(a.ws + WS_RET_S) + (size_t)h * 8192 + rem; float s = 0.f;
#pragma unroll 8
    for (int n = 0; n < NCH; ++n) { const float z = Z[(size_t)n * 4 * 8192]; S[(size_t)n * 4 * 8192] = (bf16_t)f2bf(s); s = g64 * s + z; }
}
__device__ __forceinline__ void ret_stage3(CArgs& a, int l, int n, int h, LAS unsigned char* lds, int tid) {
    const int lane = tid & 63, w = __builtin_amdgcn_readfirstlane(tid >> 6), r = lane & 15, g = lane >> 4, jc = w & 3, wh = w >> 2;
    const int tk = n * 4 + h; const int c = 16 * jc + r, t = n * 64 + c;
    const bf16_t* S = (const bf16_t*)(a.ws + WS_RET_S) + (size_t)tk * 8192; const bf16_t* QH = (const bf16_t*)(a.ws + WS_RET_QH) + (size_t)tk * 4096; const bf16_t* YI = (const bf16_t*)(a.ws + WS_RET_YI) + (size_t)tk * 8192;
    LAS float* xs = (LAS float*)lds;
    f32x4 acc[4];
#pragma unroll
    for (int tt = 0; tt < 4; ++tt) { const int ie = 4 * wh + tt; acc[tt] = unpack4(*(const u32x2*)(YI + c * 128 + 16 * ie + 4 * g));
#pragma unroll
        for (int k0 = 0; k0 < 64; k0 += 32) acc[tt] = mfma16(frag_row_g(S, 64, 16 * ie, k0, lane), frag_row_g(QH, 64, 16 * jc, k0, lane), acc[tt]); }
    float s1 = 0.f;
#pragma unroll
    for (int tt = 0; tt < 4; ++tt) s1 += (acc[tt][0] + acc[tt][1]) + (acc[tt][2] + acc[tt][3]);
    s1 += __shfl_xor(s1, 16); s1 += __shfl_xor(s1, 32);
    if (g == 0) xs[w * 16 + r] = s1;
    WG_SYNC();
    const float mu = (s1 + xs[(w ^ 4) * 16 + r]) * (1.0f / 128.0f); float s2 = 0.f;
#pragma unroll
    for (int tt = 0; tt < 4; ++tt)
#pragma unroll
        for (int e = 0; e < 4; ++e) { acc[tt][e] -= mu; s2 += acc[tt][e] * acc[tt][e]; }
    s2 += __shfl_xor(s2, 16); s2 += __shfl_xor(s2, 32);
    if (g == 0) xs[128 + w * 16 + r] = s2;
    WG_SYNC();
    const float rs = 1.0f / sqrtf((s2 + xs[128 + (w ^ 4) * 16 + r]) * (1.0f / 128.0f) + 1e-6f);
    const float* nw = LP(I_RNORM, 512) + h * 128; const bf16_t* pr = PROJROW(t) + C_RG + h * 128; bf16_t* O = (bf16_t*)(a.ws + WS_O) + (size_t)t * D + 512 + h * 128;
#pragma unroll
    for (int tt = 0; tt < 4; ++tt) { const int e0 = 16 * (4 * wh + tt) + 4 * g; const f32x4 gt = unpack4(*(const u32x2*)(pr + e0)); const f32x4 wv = *(const f32x4*)(nw + e0); f32x4 y;
#pragma unroll
        for (int e = 0; e < 4; ++e) y[e] = acc[tt][e] * rs * wv[e] * silu_f(gt[e]);
        *(u32x2*)(O + e0) = pack4(y); }
    WG_SYNC();
}

constexpr int RW_LD = 72;
constexpr int RWO_V = 0, RWO_IMG = 9216, RWO_CUMC = 64512, RWO_CUM = 65536, RWO_AM = 65536, RWO_TRI = 82944, RWO_RHS = 110592, RWO_WX = 143360;
constexpr int RWO_LW = 9216, RWO_LIN = 82944;
__device__ __forceinline__ void rw_stage1(CArgs& a, int l, int n, int h, LAS unsigned char* lds, int tid) {
    const int w = __builtin_amdgcn_readfirstlane(tid >> 6), tk = n * 8 + h;
    int lane, r, g, c, kg, t;
#define RW_IDX() do { int tl_ = tid; asm volatile("" : "+v"(tl_)); lane = tl_ & 63; r = lane & 15; g = lane >> 4; c = tl_ >> 3; kg = tl_ & 7; t = n * 64 + c; } while (0)
    RW_IDX();
    LAS bf16_t* Vi = (LAS bf16_t*)(lds + RWO_V);
    LAS bf16_t* RHi = (LAS bf16_t*)(lds + RWO_IMG); LAS bf16_t* BTi = RHi + 64 * RW_LD; LAS bf16_t* KTi = BTi + 64 * RW_LD; LAS bf16_t* KHi = KTi + 64 * RW_LD; LAS bf16_t* BMi = KHi + 64 * RW_LD; LAS bf16_t* KMi = BMi + 64 * RW_LD;
    LAS float* CUMC = (LAS float*)(lds + RWO_CUMC); LAS float* CUM = (LAS float*)(lds + RWO_CUM); LAS float* AM = (LAS float*)(lds + RWO_AM);
    LAS bf16_t* BMI = (LAS bf16_t*)(lds + RWO_TRI); LAS bf16_t* PBI = BMI + 64 * RW_LD; LAS bf16_t* PKI = PBI + 64 * RW_LD;
    LAS float* RHS = (LAS float*)(lds + RWO_RHS); LAS bf16_t* WHi = (LAS bf16_t*)(lds + RWO_WX); LAS bf16_t* Xi = WHi + 64 * RW_LD;
    LAS float* LW = (LAS float*)(lds + RWO_LW); LAS float* LA = LW + 4096; LAS float* LG = LA + 4096;
    LAS bf16_t* WLi = (LAS bf16_t*)(lds + RWO_LIN); LAS bf16_t* ALi = WLi + 64 * 40; LAS bf16_t* GLi = ALi + 64 * 40; LAS bf16_t* WUPi = GLi + 64 * 104; LAS bf16_t* AUPi = WUPi + 32 * RW_LD; LAS bf16_t* GUPi = AUPi + 32 * RW_LD;
    const float* mu = LP(I_RWMU, 1696); const bf16_t* p1 = PROJROW(t) + C_RW; const bf16_t* p0 = p1 - PTP; bool hp = t > 0;
    float vv[8];
    { const v4u cu = *(const v4u*)(p1 + 1024 + 64 * h + 8 * kg); v4u pv = {0u, 0u, 0u, 0u}; if (hp) pv = *(const v4u*)(p0 + 1024 + 64 * h + 8 * kg);
      const float* m = mu + 1024 + 64 * h + 8 * kg; v4u o;
#pragma unroll
      for (int u = 0; u < 4; ++u) { const unsigned cw = cu[u], pw = pv[u]; const float c0 = __uint_as_float(cw << 16), c1 = __uint_as_float(cw & 0xffff0000u), q0 = __uint_as_float(pw << 16), q1 = __uint_as_float(pw & 0xffff0000u);
          vv[2 * u] = c0 + (q0 - c0) * m[2 * u]; vv[2 * u + 1] = c1 + (q1 - c1) * m[2 * u + 1]; o[u] = pk2(vv[2 * u], vv[2 * u + 1]); }
      *(LAS v4u*)(Vi + c * RW_LD + 8 * kg) = o; }
    { float x[4];
#pragma unroll
      for (int u = 0; u < 4; ++u) { const int col = 1536 + 4 * kg + u; const float cur = bf2f(p1[col]), prev = hp ? bf2f(p0[col]) : 0.f; x[u] = tanhf(cur + (prev - cur) * mu[col]); }
      *(LAS u32x2*)(WLi + c * 40 + 4 * kg) = (u32x2){pk2(x[0], x[1]), pk2(x[2], x[3])};
#pragma unroll
      for (int u = 0; u < 4; ++u) { const int col = 1568 + 4 * kg + u; const float cur = bf2f(p1[col]), prev = hp ? bf2f(p0[col]) : 0.f; x[u] = cur + (prev - cur) * mu[col]; }
      *(LAS u32x2*)(ALi + c * 40 + 4 * kg) = (u32x2){pk2(x[0], x[1]), pk2(x[2], x[3])};
#pragma unroll
      for (int q = 0; q < 3; ++q) {
#pragma unroll
          for (int u = 0; u < 4; ++u) { const int col = 1600 + 12 * kg + 4 * q + u; const float cur = bf2f(p1[col]), prev = hp ? bf2f(p0[col]) : 0.f; x[u] = sigmoid_f(cur + (prev - cur) * mu[col]); }
          *(LAS u32x2*)(GLi + c * 104 + 12 * kg + 4 * q) = (u32x2){pk2(x[0], x[1]), pk2(x[2], x[3])}; } }
    { const int j = tid >> 4, k4 = (tid & 15) * 4;
      const f32x4 wv = *(const f32x4*)(LP(I_RWWUP, 32 * 512) + j * 512 + 64 * h + k4), av = *(const f32x4*)(LP(I_RWAUP, 32 * 512) + j * 512 + 64 * h + k4);
      *(LAS u32x2*)(WUPi + j * RW_LD + k4) = pack4(wv); *(LAS u32x2*)(AUPi + j * RW_LD + k4) = pack4(av);
#pragma unroll
      for (int q = 0; q < 3; ++q) { const f32x4 gv = *(const f32x4*)(LP(I_RWGUP, 96 * 512) + (32 * q + j) * 512 + 64 * h + k4); *(LAS u32x2*)(GUPi + (32 * q + j) * RW_LD + k4) = pack4(gv); } }
    WG_SYNC();
    RW_IDX();
#pragma unroll
    for (int tt = 0; tt < 2; ++tt) { const int tile = 2 * w + tt, ik = tile >> 2, jc = tile & 3;
        f32x4 aw = {0.f, 0.f, 0.f, 0.f}, aa = aw, ag = aw;
        aw = mfma16(frag_tr(WUPi, RW_LD, 16 * ik, 0, lane), frag_row(WLi, 40, 16 * jc, 0, lane), aw);
        aa = mfma16(frag_tr(AUPi, RW_LD, 16 * ik, 0, lane), frag_row(ALi, 40, 16 * jc, 0, lane), aa);
#pragma unroll
        for (int k0 = 0; k0 < 96; k0 += 32) ag = mfma16(frag_tr(GUPi, RW_LD, 16 * ik, k0, lane), frag_row(GLi, 104, 16 * jc, k0, lane), ag);
        const int o = (16 * jc + r) * 64 + 16 * ik + 4 * g; *(LAS f32x4*)(LW + o) = aw; *(LAS f32x4*)(LA + o) = aa; *(LAS f32x4*)(LG + o) = ag; }
    WG_SYNC();
    RW_IDX();
    p1 = PROJROW(t) + C_RW; p0 = p1 - PTP; hp = t > 0;
    float rr[8], kk[8], bb[8], kt[8], lwd[8];
    { const int ch0 = 64 * h + 8 * kg; float ss = 0.f, rk = 0.f; float gt[8];
      const v4u cr = *(const v4u*)(p1 + ch0), ck = *(const v4u*)(p1 + 512 + ch0); v4u qr = {0u, 0u, 0u, 0u}, qk = qr; if (hp) { qr = *(const v4u*)(p0 + ch0); qk = *(const v4u*)(p0 + 512 + ch0); }
#pragma unroll
      for (int u = 0; u < 8; ++u) { const int ch = ch0 + u; const unsigned crw = cr[u >> 1], ckw = ck[u >> 1], qrw = qr[u >> 1], qkw = qk[u >> 1];
          const float curR = (u & 1) ? __uint_as_float(crw & 0xffff0000u) : __uint_as_float(crw << 16), curK = (u & 1) ? __uint_as_float(ckw & 0xffff0000u) : __uint_as_float(ckw << 16);
          const float prvR = (u & 1) ? __uint_as_float(qrw & 0xffff0000u) : __uint_as_float(qrw << 16), prvK = (u & 1) ? __uint_as_float(qkw & 0xffff0000u) : __uint_as_float(qkw << 16);
          const float rv = curR + (prvR - curR) * mu[ch], kr = curK + (prvK - curK) * mu[512 + ch];
          const float lw = LW[c * 64 + 8 * kg + u], la = LA[c * 64 + 8 * kg + u]; gt[u] = LG[c * 64 + 8 * kg + u];
          const float wraw = -softplus_f(-(LP(I_RWW0, 512)[ch] + lw)) - 0.5f; lwd[u] = -expf(wraw);
          const float av = sigmoid_f(LP(I_RWA0, 512)[ch] + la); const float kkr = kr * LP(I_RWKK, 512)[ch]; kt[u] = kr * (1.0f + (av - 1.0f) * LP(I_RWKA, 512)[ch]);
          rr[u] = rv; kk[u] = kkr; bb[u] = av; ss += kkr * kkr; rk += rv * kt[u] * LP(I_RWRK, 512)[ch]; }
      ss += __shfl_xor(ss, 1); ss += __shfl_xor(ss, 2); ss += __shfl_xor(ss, 4); rk += __shfl_xor(rk, 1); rk += __shfl_xor(rk, 2); rk += __shfl_xor(rk, 4);
      const float inv = 1.0f / sqrtf(ss + 1e-6f);
#pragma unroll
      for (int u = 0; u < 8; ++u) { kk[u] *= inv; bb[u] *= kk[u]; }
      *(LAS f32x4*)(CUM + c * 64 + 8 * kg) = (f32x4){lwd[0], lwd[1], lwd[2], lwd[3]}; *(LAS f32x4*)(CUM + c * 64 + 8 * kg + 4) = (f32x4){lwd[4], lwd[5], lwd[6], lwd[7]};
      v4u eo, go;
#pragma unroll
      for (int u = 0; u < 4; ++u) { eo[u] = pk2(rk * vv[2 * u], rk * vv[2 * u + 1]); go[u] = pk2(gt[2 * u], gt[2 * u + 1]); }
      *(v4u*)((bf16_t*)(a.ws + WS_RW_E) + (size_t)tk * 4096 + c * 64 + 8 * kg) = eo; *(v4u*)((bf16_t*)(a.ws + WS_RW_GT) + (size_t)tk * 4096 + c * 64 + 8 * kg) = go; }
    WG_SYNC();
    RW_IDX();
    { const int tq_ = c * 8 + kg; if (tq_ < 64) { float cu = 0.f;
#pragma unroll 8
        for (int cc = 0; cc < 64; ++cc) { cu += CUM[cc * 64 + tq_]; CUM[cc * 64 + tq_] = cu; }
        CUMC[tq_] = cu; } }
    WG_SYNC();
    RW_IDX();
    { v4u oRH, oBT, oKT, oKH, oBM, oKM; float kh[8];
#pragma unroll
      for (int u = 0; u < 8; u += 2) { float x[6][2];
#pragma unroll
          for (int e = 0; e < 2; ++e) { const float cu = CUM[c * 64 + 8 * kg + u + e], cc = CUMC[8 * kg + u + e]; const float ep = expf(cu), em = expf(-cu), et = expf(cc - cu), ex = expf(cu - lwd[u + e]);
              x[0][e] = rr[u + e] * ep; x[1][e] = bb[u + e] * et; x[2][e] = kt[u + e] * et; x[3][e] = kk[u + e] * ex; x[4][e] = bb[u + e] * em; x[5][e] = kt[u + e] * em; kh[u + e] = x[3][e]; }
          oRH[u >> 1] = pk2(x[0][0], x[0][1]); oBT[u >> 1] = pk2(x[1][0], x[1][1]); oKT[u >> 1] = pk2(x[2][0], x[2][1]); oKH[u >> 1] = pk2(x[3][0], x[3][1]); oBM[u >> 1] = pk2(x[4][0], x[4][1]); oKM[u >> 1] = pk2(x[5][0], x[5][1]); }
      const int o = c * RW_LD + 8 * kg;
      *(LAS v4u*)(RHi + o) = oRH; *(LAS v4u*)(BTi + o) = oBT; *(LAS v4u*)(KTi + o) = oKT; *(LAS v4u*)(KHi + o) = oKH; *(LAS v4u*)(BMi + o) = oBM; *(LAS v4u*)(KMi + o) = oKM;
      *(LAS f32x4*)(RHS + c * 128 + 8 * kg) = (f32x4){kh[0], kh[1], kh[2], kh[3]}; *(LAS f32x4*)(RHS + c * 128 + 8 * kg + 4) = (f32x4){kh[4], kh[5], kh[6], kh[7]}; }
    WG_SYNC();
    RW_IDX();
#pragma unroll
    for (int tt = 0; tt < 2; ++tt) { const int tile = 2 * w + tt, ii = tile >> 2, jt = tile & 3;
        f32x4 cA = {0.f, 0.f, 0.f, 0.f}, cB = cA, cPb = cA, cPk = cA;
        if (ii <= jt) {
#pragma unroll
            for (int k0 = 0; k0 < 64; k0 += 32) { const bf16x8 fbm = frag_row(BMi, RW_LD, 16 * ii, k0, lane), fkm = frag_row(KMi, RW_LD, 16 * ii, k0, lane), fkh = frag_row(KHi, RW_LD, 16 * jt, k0, lane), frh = frag_row(RHi, RW_LD, 16 * jt, k0, lane);
                cA = mfma16(fbm, fkh, cA); cB = mfma16(fkm, fkh, cB); cPb = mfma16(fbm, frh, cPb); cPk = mfma16(fkm, frh, cPk); }
#pragma unroll
            for (int e = 0; e < 4; ++e) { const int i = 16 * ii + 4 * g + e, tq = 16 * jt + r; if (!(i < tq)) { cA[e] = 0.f; cB[e] = 0.f; } if (!(i <= tq)) { cPb[e] = 0.f; cPk[e] = 0.f; } } }
        const int tq = 16 * jt + r, i0 = 16 * ii + 4 * g;
        *(LAS f32x4*)(AM + tq * 68 + i0) = cA; *(LAS u32x2*)(BMI + tq * RW_LD + i0) = pack4(cB); *(LAS u32x2*)(PBI + tq * RW_LD + i0) = pack4(cPb); *(LAS u32x2*)(PKI + tq * RW_LD + i0) = pack4(cPk); }
    WG_SYNC();
    RW_IDX();
#pragma unroll
    for (int tt = 0; tt < 2; ++tt) { const int tile = 2 * w + tt, iv = tile >> 2, jt = tile & 3; f32x4 acc = {0.f, 0.f, 0.f, 0.f};
#pragma unroll
        for (int k0 = 0; k0 < 64; k0 += 32) acc = mfma16(frag_tr(Vi, RW_LD, 16 * iv, k0, lane), frag_row(BMI, RW_LD, 16 * jt, k0, lane), acc);
        *(LAS f32x4*)(RHS + (16 * jt + r) * 128 + 64 + 16 * iv + 4 * g) = acc; }
    WG_SYNC();
    RW_IDX();
    { const int col = c * 8 + kg; if (col < 128) { float x[64];
#pragma unroll
        for (int i = 0; i < 64; ++i) x[i] = 0.f;
        int vz = 0; asm volatile("" : "+v"(vz));
        const LAS float* AMv = AM + vz;
        LAS bf16_t* dst = col < 64 ? WHi + col : Xi + (col - 64);
#pragma unroll
        for (int tq = 0; tq < 64; ++tq) { float acc = RHS[tq * 128 + col];
#pragma unroll
            for (int i = 0; i < ((tq + 3) & ~3); i += 4) { const f32x4 av = *(const LAS f32x4*)(AMv + tq * 68 + i); acc -= av[0] * x[i]; acc -= av[1] * x[i + 1]; acc -= av[2] * x[i + 2]; acc -= av[3] * x[i + 3]; }
            x[tq] = acc; dst[tq * RW_LD] = (bf16_t)f2bf(acc); } } }
    WG_SYNC();
    RW_IDX();
    { const int o = w >> 1;
#pragma unroll
      for (int tt = 0; tt < 8; ++tt) { const int tile = (w & 1) * 8 + tt, ti = tile >> 2, tj = tile & 3; f32x4 c1 = {0.f, 0.f, 0.f, 0.f}, c2 = c1;
          if (o == 0) {
#pragma unroll
              for (int k0 = 0; k0 < 64; k0 += 32) c1 = mfma16(frag_tr(WHi, RW_LD, 16 * ti, k0, lane), frag_tr(BTi, RW_LD, 16 * tj, k0, lane), c1);
              const int kq = 16 * tj + r; const float dg = expf(CUMC[kq]); f32x4 gv;
#pragma unroll
              for (int e = 0; e < 4; ++e) gv[e] = ((16 * ti + 4 * g + e) == kq ? dg : 0.f) - c1[e];
              *(u32x2*)((bf16_t*)(a.ws + WS_RW_G) + (size_t)tk * 4096 + kq * 64 + 16 * ti + 4 * g) = pack4(gv);
          } else if (o == 1) {
#pragma unroll
              for (int k0 = 0; k0 < 64; k0 += 32) { c1 = mfma16(frag_tr(KTi, RW_LD, 16 * ti, k0, lane), frag_tr(Vi, RW_LD, 16 * tj, k0, lane), c1); c2 = mfma16(frag_tr(BTi, RW_LD, 16 * ti, k0, lane), frag_tr(Xi, RW_LD, 16 * tj, k0, lane), c2); }
              *(f32x4*)(WSF(WS_RW_Z) + (size_t)tk * 4096 + (16 * tj + r) * 64 + 16 * ti + 4 * g) = c1 - c2;
          } else if (o == 2) {
#pragma unroll
              for (int k0 = 0; k0 < 64; k0 += 32) c1 = mfma16(frag_tr(WHi, RW_LD, 16 * ti, k0, lane), frag_row(PBI, RW_LD, 16 * tj, k0, lane), c1);
              const int tq = 16 * tj + r; const f32x4 rh = unpack4(*(const LAS u32x2*)(RHi + tq * RW_LD + 16 * ti + 4 * g));
              *(u32x2*)((bf16_t*)(a.ws + WS_RW_QT) + (size_t)tk * 4096 + tq * 64 + 16 * ti + 4 * g) = pack4(rh - c1);
          } else {
#pragma unroll
              for (int k0 = 0; k0 < 64; k0 += 32) { c1 = mfma16(frag_tr(Vi, RW_LD, 16 * ti, k0, lane), frag_row(PKI, RW_LD, 16 * tj, k0, lane), c1); c2 = mfma16(frag_tr(Xi, RW_LD, 16 * ti, k0, lane), frag_row(PBI, RW_LD, 16 * tj, k0, lane), c2); }
              *(u32x2*)((bf16_t*)(a.ws + WS_RW_YI) + (size_t)tk * 4096 + (16 * tj + r) * 64 + 16 * ti + 4 * g) = pack4(c1 - c2);
          } } }
    WG_SYNC();
#undef RW_IDX
}
__device__ __forceinline__ void rw_stage2(CArgs& a, int h, int vs, LAS unsigned char* lds, int tid) {
    const int lane = tid & 63, w = __builtin_amdgcn_readfirstlane(tid >> 6), r = lane & 15, g = lane >> 4;
    LAS bf16_t* Si = (LAS bf16_t*)lds;
    const bf16_t* G = (const bf16_t*)(a.ws + WS_RW_G); const float* Z = WSF(WS_RW_Z); bf16_t* S = (bf16_t*)(a.ws + WS_RW_S);
    if (w < 4) { *(LAS u32x2*)(Si + r * RW_LD + 16 * w + 4 * g) = (u32x2){0u, 0u}; *(u32x2*)(S + (size_t)h * 4096 + (16 * vs + r) * 64 + 16 * w + 4 * g) = (u32x2){0u, 0u}; }
    WG_SYNC();
#pragma unroll 1
    for (int n = 0; n < NCH - 1; ++n) { const size_t tk = (size_t)n * 8 + h; const int cur = n & 1;
        if (w < 4) { f32x4 acc = *(const f32x4*)(Z + tk * 4096 + (16 * vs + r) * 64 + 16 * w + 4 * g);
#pragma unroll
            for (int k0 = 0; k0 < 64; k0 += 32) acc = mfma16(frag_row_g(G + tk * 4096, 64, 16 * w, k0, lane), frag_row(Si + cur * 16 * RW_LD, RW_LD, 0, k0, lane), acc);
            const u32x2 pv = pack4(acc);
            *(LAS u32x2*)(Si + (cur ^ 1) * 16 * RW_LD + r * RW_LD + 16 * w + 4 * g) = pv; *(u32x2*)(S + (tk + 8) * 4096 + (16 * vs + r) * 64 + 16 * w + 4 * g) = pv; }
        WG_SYNC(); }
}
__device__ __forceinline__ void rw_stage3(CArgs& a, int l, int n, int h, LAS unsigned char* lds, int tid) {
    const int lane = tid & 63, w = __builtin_amdgcn_readfirstlane(tid >> 6), r = lane & 15, g = lane >> 4, jc = w & 3, wh = w >> 2;
    const size_t tk = (size_t)n * 8 + h; const int c = 16 * jc + r, t = n * 64 + c;
    const bf16_t* S = (const bf16_t*)(a.ws + WS_RW_S) + tk * 4096; const bf16_t* QT = (const bf16_t*)(a.ws + WS_RW_QT) + tk * 4096; const bf16_t* YI = (const bf16_t*)(a.ws + WS_RW_YI) + tk * 4096;
    LAS float* xs = (LAS float*)lds;
    f32x4 acc[2];
#pragma unroll
    for (int tt = 0; tt < 2; ++tt) { const int iv = 2 * wh + tt; acc[tt] = unpack4(*(const u32x2*)(YI + c * 64 + 16 * iv + 4 * g));
#pragma unroll
        for (int k0 = 0; k0 < 64; k0 += 32) acc[tt] = mfma16(frag_row_g(S, 64, 16 * iv, k0, lane), frag_row_g(QT, 64, 16 * jc, k0, lane), acc[tt]); }
    float s1 = (acc[0][0] + acc[0][1]) + (acc[0][2] + acc[0][3]) + (acc[1][0] + acc[1][1]) + (acc[1][2] + acc[1][3]);
    s1 += __shfl_xor(s1, 16); s1 += __shfl_xor(s1, 32);
    if (g == 0) xs[w * 16 + r] = s1;
    WG_SYNC();
    const float mu = (s1 + xs[(w ^ 4) * 16 + r]) * (1.0f / 64.0f); float s2 = 0.f;
#pragma unroll
    for (int tt = 0; tt < 2; ++tt)
#pragma unroll
        for (int e = 0; e < 4; ++e) { acc[tt][e] -= mu; s2 += acc[tt][e] * acc[tt][e]; }
    s2 += __shfl_xor(s2, 16); s2 += __shfl_xor(s2, 32);
    if (g == 0) xs[128 + w * 16 + r] = s2;
    WG_SYNC();
    const float rs = 1.0f / sqrtf((s2 + xs[128 + (w ^ 4) * 16 + r]) * (1.0f / 64.0f) + 64e-5f);
    const bf16_t* E = (const bf16_t*)(a.ws + WS_RW_E) + tk * 4096 + c * 64; const bf16_t* GT = (const bf16_t*)(a.ws + WS_RW_GT) + tk * 4096 + c * 64;
    bf16_t* O = (bf16_t*)(a.ws + WS_O) + (size_t)t * D + 1536 + h * 64;
#pragma unroll
    for (int tt = 0; tt < 2; ++tt) { const int v0 = 16 * (2 * wh + tt) + 4 * g; const f32x4 ev = unpack4(*(const u32x2*)(E + v0)), gv = unpack4(*(const u32x2*)(GT + v0));
        const f32x4 lw = *(const f32x4*)(LP(I_RWLNW, 512) + h * 64 + v0), lb = *(const f32x4*)(LP(I_RWLNB, 512) + h * 64 + v0); f32x4 y;
#pragma unroll
        for (int e = 0; e < 4; ++e) y[e] = (acc[tt][e] * rs * lw[e] + lb[e] + ev[e]) * gv[e];
        *(u32x2*)(O + v0) = pack4(y); }
    WG_SYNC();
}

constexpr int M2_LDS = 136, M2_LDX = 264, M2O_B = 0, M2O_C = 17408, M2O_X = 34816, M2O_XW = 68608, M2O_M = 102400, M2O_DT = 139264, M2O_G = 140288, M2O_GL = 141312;
__device__ __forceinline__ void m2_stage1(CArgs& a, int l, int n, int gr, LAS unsigned char* lds, int tid) {
    const int lane = tid & 63, w = __builtin_amdgcn_readfirstlane(tid >> 6), r = lane & 15, g = lane >> 4;
    LAS bf16_t* Bi = (LAS bf16_t*)(lds + M2O_B); LAS bf16_t* Ci = (LAS bf16_t*)(lds + M2O_C); LAS bf16_t* Xi = (LAS bf16_t*)(lds + M2O_X); LAS bf16_t* XWi = (LAS bf16_t*)(lds + M2O_XW); LAS bf16_t* Mi = (LAS bf16_t*)(lds + M2O_M);
    LAS float* DT = (LAS float*)(lds + M2O_DT); LAS float* GC = (LAS float*)(lds + M2O_G); LAS float* GLAST = (LAS float*)(lds + M2O_GL);
    const int t0 = n * 64;
    { int col; LAS bf16_t* dst; int dld;
      if (tid < 256) { col = gr * 256 + tid; dst = Xi + tid; dld = M2_LDX; } else if (tid < 384) { col = 512 + gr * 128 + (tid - 256); dst = Bi + (tid - 256); dld = M2_LDS; } else { col = 768 + gr * 128 + (tid - 384); dst = Ci + (tid - 384); dld = M2_LDS; }
      const float* cw = LP(I_MCONV, 4 * 1024) + col; const float w0 = cw[0], w1 = cw[1024], w2 = cw[2048], w3 = cw[3072], cb = LP(I_MCONVB, 1024)[col];
      const bf16_t* src = PROJROW(t0) + C_MXBC + col;
      float x0 = t0 > 0 ? bf2f(src[-3 * PTP]) : 0.f, x1 = t0 > 0 ? bf2f(src[-2 * PTP]) : 0.f, x2 = t0 > 0 ? bf2f(src[-1 * PTP]) : 0.f;
#pragma unroll 4
      for (int c = 0; c < 64; ++c) { const float x3 = bf2f(src[(size_t)c * PTP]); const float y = silu_f(w0 * x0 + w1 * x1 + w2 * x2 + w3 * x3 + cb); dst[c * dld] = (bf16_t)f2bf(y); x0 = x1; x1 = x2; x2 = x3; } }
    if (tid < 256) { const int c = tid >> 2, hh = tid & 3, hd = gr * 4 + hh; const float dt = softplus_f(bf2f(PROJROW(t0 + c)[C_MDT + hd]) + LP(I_MDTB, 8)[hd]); DT[c * 4 + hh] = dt; GC[c * 4 + hh] = -expf(LP(I_MALOG, 8)[hd]) * dt; }
    WG_SYNC();
    if (tid < 4) { float cu = 0.f; for (int c = 0; c < 64; ++c) { cu += GC[c * 4 + tid]; GC[c * 4 + tid] = cu; } GLAST[tid] = cu; WSF(WS_M2_DEC)[n * 8 + gr * 4 + tid] = expf(cu); }
    WG_SYNC();
    { const int c = tid >> 3, q = tid & 7;
      const int hh = q >> 1; const float sc = DT[c * 4 + hh] * expf(GLAST[hh] - GC[c * 4 + hh]);
#pragma unroll
      for (int u = 0; u < 4; ++u) { const v4u xv = *(const LAS v4u*)(Xi + c * M2_LDX + 32 * q + 8 * u); v4u o;
#pragma unroll
          for (int e = 0; e < 4; ++e) o[e] = pk2(__uint_as_float(xv[e] << 16) * sc, __uint_as_float(xv[e] & 0xffff0000u) * sc);
          *(LAS v4u*)(XWi + c * M2_LDX + 32 * q + 8 * u) = o; }
      const float eg = expf(GC[c * 4 + hh]); bf16_t* QH = (bf16_t*)(a.ws + WS_M2_QH) + ((size_t)(n * 8 + gr * 4 + hh) * 64 + c) * 128 + 64 * (q & 1);
#pragma unroll
      for (int u = 0; u < 8; ++u) { const v4u cv = *(const LAS v4u*)(Ci + c * M2_LDS + 64 * (q & 1) + 8 * u); v4u o;
#pragma unroll
          for (int e = 0; e < 4; ++e) o[e] = pk2(__uint_as_float(cv[e] << 16) * eg, __uint_as_float(cv[e] & 0xffff0000u) * eg);
          *(v4u*)(QH + 8 * u) = o; } }
#pragma unroll
    for (int tt = 0; tt < 2; ++tt) { const int tile = 2 * w + tt, im = tile >> 2, jc = tile & 3; f32x4 acc = {0.f, 0.f, 0.f, 0.f};
        if (jc >= im) {
#pragma unroll
            for (int k0 = 0; k0 < 128; k0 += 32) acc = mfma16(frag_row(Bi, M2_LDS, 16 * im, k0, lane), frag_row(Ci, M2_LDS, 16 * jc, k0, lane), acc); }
        const int cq = 16 * jc + r;
#pragma unroll
        for (int hh = 0; hh < 4; ++hh) { f32x4 mv; const float gc = GC[cq * 4 + hh];
#pragma unroll
            for (int e = 0; e < 4; ++e) { const int m = 16 * im + 4 * g + e; mv[e] = cq >= m ? acc[e] * expf(gc - GC[m * 4 + hh]) * DT[m * 4 + hh] : 0.f; }
            *(LAS u32x2*)(Mi + hh * 64 * 72 + cq * 72 + 16 * im + 4 * g) = pack4(mv); } }
    WG_SYNC();
    { const int hh = w >> 1, hd = gr * 4 + hh; const size_t tk = (size_t)n * 8 + hd; const float Dh = LP(I_MD, 8)[hd];
      bf16_t* YI = (bf16_t*)(a.ws + WS_M2_YI) + tk * 4096; float* Z = WSF(WS_M2_Z) + tk * 8192;
#pragma unroll
      for (int tt = 0; tt < 8; ++tt) { const int tile = (w & 1) * 8 + tt, ip = tile >> 2, jc = tile & 3; f32x4 acc = {0.f, 0.f, 0.f, 0.f};
#pragma unroll
          for (int k0 = 0; k0 < 64; k0 += 32) acc = mfma16(frag_tr(Xi, M2_LDX, 64 * hh + 16 * ip, k0, lane), frag_row(Mi + hh * 64 * 72, 72, 16 * jc, k0, lane), acc);
          const int cq = 16 * jc + r; const f32x4 xv = unpack4(*(const LAS u32x2*)(Xi + cq * M2_LDX + 64 * hh + 16 * ip + 4 * g));
          *(u32x2*)(YI + cq * 64 + 16 * ip + 4 * g) = pack4(acc + xv * Dh); }
#pragma unroll
      for (int tt = 0; tt < 16; ++tt) { const int tile = (w & 1) * 16 + tt, is = tile >> 2, jp = tile & 3; f32x4 acc = {0.f, 0.f, 0.f, 0.f};
#pragma unroll
          for (int k0 = 0; k0 < 64; k0 += 32) acc = mfma16(frag_tr(Bi, M2_LDS, 16 * is, k0, lane), frag_tr(XWi, M2_LDX, 64 * hh + 16 * jp, k0, lane), acc);
          *(f32x4*)(Z + (16 * jp + r) * 128 + 16 * is + 4 * g) = acc; } }
    WG_SYNC();
}
__device__ __forceinline__ void m2_stage2(CArgs& a, int b, int tid) {
    const int idx = b * 512 + tid, hd = idx >> 13, rem = idx & 8191;
    const float* Z = WSF(WS_M2_Z) + (size_t)hd * 8192 + rem; bf16_t* S = (bf16_t*)(a.ws + WS_M2_S) + (size_t)hd * 8192 + rem; const float* DEC = WSF(WS_M2_DEC) + hd; float s = 0.f;
#pragma unroll 8
    for (int n = 0; n < NCH; ++n) { const float z = Z[(size_t)n * 8 * 8192], dc = DEC[n * 8]; S[(size_t)n * 8 * 8192] = (bf16_t)f2bf(s); s = dc * s + z; }
}
__device__ __forceinline__ void m2_stage3(CArgs& a, int l, int n, int gr, LAS unsigned char* lds, int tid) {
    const int lane = tid & 63, w = __builtin_amdgcn_readfirstlane(tid >> 6), r = lane & 15, g = lane >> 4, hh = w >> 1, hd = gr * 4 + hh;
    const size_t tk = (size_t)n * 8 + hd;
    const bf16_t* S = (const bf16_t*)(a.ws + WS_M2_S) + tk * 8192; const bf16_t* QH = (const bf16_t*)(a.ws + WS_M2_QH) + tk * 8192; const bf16_t* YI = (const bf16_t*)(a.ws + WS_M2_YI) + tk * 4096;
    LAS float* xs = (LAS float*)lds;
    f32x4 acc[2][4]; float ss[2];
#pragma unroll
    for (int cj = 0; cj < 2; ++cj) { const int jc = 2 * (w & 1) + cj, c = 16 * jc + r, t = n * 64 + c; const bf16_t* pz = PROJROW(t) + C_MZ + hd * 64; ss[cj] = 0.f;
#pragma unroll
        for (int ip = 0; ip < 4; ++ip) { acc[cj][ip] = unpack4(*(const u32x2*)(YI + c * 64 + 16 * ip + 4 * g));
#pragma unroll
            for (int k0 = 0; k0 < 128; k0 += 32) acc[cj][ip] = mfma16(frag_row_g(S, 128, 16 * ip, k0, lane), frag_row_g(QH, 128, 16 * jc, k0, lane), acc[cj][ip]);
            const f32x4 zv = unpack4(*(const u32x2*)(pz + 16 * ip + 4 * g));
#pragma unroll
            for (int e = 0; e < 4; ++e) { acc[cj][ip][e] *= silu_f(zv[e]); ss[cj] += acc[cj][ip][e] * acc[cj][ip][e]; } }
        ss[cj] += __shfl_xor(ss[cj], 16); ss[cj] += __shfl_xor(ss[cj], 32);
        if (g == 0) xs[w * 32 + cj * 16 + r] = ss[cj]; }
    WG_SYNC();
#pragma unroll
    for (int cj = 0; cj < 2; ++cj) { const int jc = 2 * (w & 1) + cj, c = 16 * jc + r, t = n * 64 + c;
        const float tot = xs[((w & 1) + 0) * 32 + cj * 16 + r] + xs[((w & 1) + 2) * 32 + cj * 16 + r] + xs[((w & 1) + 4) * 32 + cj * 16 + r] + xs[((w & 1) + 6) * 32 + cj * 16 + r];
        const float rs = 1.0f / sqrtf(tot * (1.0f / 256.0f) + 1e-6f);
        const float* nw = LP(I_MNORM, 512) + hd * 64; bf16_t* O = (bf16_t*)(a.ws + WS_O) + (size_t)t * D + 1024 + hd * 64;
#pragma unroll
        for (int ip = 0; ip < 4; ++ip) { const f32x4 wv = *(const f32x4*)(nw + 16 * ip + 4 * g); f32x4 y;
#pragma unroll
            for (int e = 0; e < 4; ++e) y[e] = acc[cj][ip][e] * rs * wv[e];
            *(u32x2*)(O + 16 * ip + 4 * g) = pack4(y); } }
    WG_SYNC();
}

constexpr int GD_LD = 136;
constexpr int GDO_K = 0, GDO_V = 17408, GDO_KT = 34816, GDO_QG = 52224, GDO_Q = 69632, GDO_AM = 87040, GDO_AQ = 104448, GDO_U = 113664, GDO_W = 131072, GDO_QF = 87040, GDO_KF = 119808, GDO_SM = 152576;
__device__ __forceinline__ void gd_stage1(CArgs& a, int l, int n, int h, LAS unsigned char* lds, int tid) {
    const int w = __builtin_amdgcn_readfirstlane(tid >> 6), tk = n * 4 + h, t0 = n * 64;
    int lane, r, g, c, q8;
#define GD_IDX() do { int tl_ = tid; asm volatile("" : "+v"(tl_)); lane = tl_ & 63; r = lane & 15; g = lane >> 4; c = tl_ >> 3; q8 = tl_ & 7; } while (0)
    LAS bf16_t* Ki = (LAS bf16_t*)(lds + GDO_K); LAS bf16_t* Vi = (LAS bf16_t*)(lds + GDO_V); LAS bf16_t* KTi = (LAS bf16_t*)(lds + GDO_KT); LAS bf16_t* QGi = (LAS bf16_t*)(lds + GDO_QG); LAS bf16_t* Qi = (LAS bf16_t*)(lds + GDO_Q);
    LAS float* AM = (LAS float*)(lds + GDO_AM); LAS bf16_t* AQ = (LAS bf16_t*)(lds + GDO_AQ); LAS bf16_t* Ui = (LAS bf16_t*)(lds + GDO_U); LAS bf16_t* Wi = (LAS bf16_t*)(lds + GDO_W);
    LAS float* QF = (LAS float*)(lds + GDO_QF); LAS float* KF = (LAS float*)(lds + GDO_KF);
    LAS float* BETA = (LAS float*)(lds + GDO_SM); LAS float* GC = BETA + 64; LAS float* BG = GC + 64;
    if (tid < 384) { const int which = tid >> 7, dcol = tid & 127, cwi = which * 512 + h * 128 + dcol;
        const float* cw = LP(I_GCONV, 4 * 1536) + cwi; const float w0 = cw[0], w1 = cw[1536], w2 = cw[3072], w3 = cw[4608];
        const bf16_t* src = PROJROW(t0) + C_GQ + cwi;
        float x0 = t0 > 0 ? bf2f(src[-3 * PTP]) : 0.f, x1 = t0 > 0 ? bf2f(src[-2 * PTP]) : 0.f, x2 = t0 > 0 ? bf2f(src[-1 * PTP]) : 0.f;
        if (which == 2) {
#pragma unroll 4
            for (int cc = 0; cc < 64; ++cc) { const float x3 = bf2f(src[(size_t)cc * PTP]); Vi[cc * GD_LD + dcol] = (bf16_t)f2bf(silu_f(w0 * x0 + w1 * x1 + w2 * x2 + w3 * x3)); x0 = x1; x1 = x2; x2 = x3; }
        } else { LAS float* dstf = (which == 0 ? QF : KF) + dcol;
#pragma unroll 4
            for (int cc = 0; cc < 64; ++cc) { const float x3 = bf2f(src[(size_t)cc * PTP]); dstf[cc * 128] = silu_f(w0 * x0 + w1 * x1 + w2 * x2 + w3 * x3); x0 = x1; x1 = x2; x2 = x3; } }
    } else if (tid < 448) { const int cc = tid - 384; const bf16_t* pr = PROJROW(t0 + cc);
        const float beta = sigmoid_f(bf2f(pr[C_GB + h])); float cu = -expf(LP(I_GALOG, 4)[h]) * softplus_f(bf2f(pr[C_GA + h]) + LP(I_GDTB, 4)[h]);
#pragma unroll
        for (int o = 1; o < 64; o <<= 1) { const float up = __shfl_up(cu, o); if (cc >= o) cu += up; }
        BETA[cc] = beta; GC[cc] = cu; BG[cc] = beta * expf(cu); }
    WG_SYNC();
    GD_IDX();
    { float qv[16], kv[16]; float sq = 0.f, sk = 0.f;
#pragma unroll
      for (int u = 0; u < 4; ++u) { const f32x4 a4 = *(const LAS f32x4*)(QF + c * 128 + 16 * q8 + 4 * u), b4 = *(const LAS f32x4*)(KF + c * 128 + 16 * q8 + 4 * u);
#pragma unroll
          for (int e = 0; e < 4; ++e) { qv[4 * u + e] = a4[e]; kv[4 * u + e] = b4[e]; sq += a4[e] * a4[e]; sk += b4[e] * b4[e]; } }
      sq += __shfl_xor(sq, 1); sq += __shfl_xor(sq, 2); sq += __shfl_xor(sq, 4); sk += __shfl_xor(sk, 1); sk += __shfl_xor(sk, 2); sk += __shfl_xor(sk, 4);
      const float gc = GC[c], iq = (1.0f / sqrtf(sq + 1e-6f)) * 0.08838834764831845f, ik = 1.0f / sqrtf(sk + 1e-6f), et = expf(GC[63] - gc), eg = expf(gc);
      v4u oK[2], oQ[2], oKT[2], oQG[2];
#pragma unroll
      for (int u = 0; u < 8; ++u) { const float k0 = kv[2 * u] * ik, k1 = kv[2 * u + 1] * ik, q0 = qv[2 * u] * iq, q1 = qv[2 * u + 1] * iq;
          oK[u >> 2][u & 3] = pk2(k0, k1); oQ[u >> 2][u & 3] = pk2(q0, q1); oKT[u >> 2][u & 3] = pk2(k0 * et, k1 * et); oQG[u >> 2][u & 3] = pk2(q0 * eg, q1 * eg); }
      const int o = c * GD_LD + 16 * q8;
      *(LAS v4u*)(Ki + o) = oK[0]; *(LAS v4u*)(Ki + o + 8) = oK[1]; *(LAS v4u*)(Qi + o) = oQ[0]; *(LAS v4u*)(Qi + o + 8) = oQ[1];
      *(LAS v4u*)(KTi + o) = oKT[0]; *(LAS v4u*)(KTi + o + 8) = oKT[1]; *(LAS v4u*)(QGi + o) = oQG[0]; *(LAS v4u*)(QGi + o + 8) = oQG[1]; }
    WG_SYNC();
    GD_IDX();
#pragma unroll
    for (int tt = 0; tt < 2; ++tt) { const int tile = 2 * w + tt, im = tile >> 2, jc = tile & 3; f32x4 c1 = {0.f, 0.f, 0.f, 0.f}, c2 = c1;
        if (jc >= im) {
#pragma unroll
            for (int k0 = 0; k0 < 128; k0 += 32) { const bf16x8 fa = frag_row(Ki, GD_LD, 16 * im, k0, lane); c1 = mfma16(fa, frag_row(Ki, GD_LD, 16 * jc, k0, lane), c1); c2 = mfma16(fa, frag_row(Qi, GD_LD, 16 * jc, k0, lane), c2); }
            const int cq = 16 * jc + r; const float gc = GC[cq], bc = BETA[cq];
#pragma unroll
            for (int e = 0; e < 4; ++e) { const int m = 16 * im + 4 * g + e; const float dc = expf(gc - GC[m]); c1[e] = m < cq ? c1[e] * dc * bc : 0.f; c2[e] = m <= cq ? c2[e] * dc : 0.f; } }
        const int cq = 16 * jc + r; *(LAS f32x4*)(AM + cq * 68 + 16 * im + 4 * g) = c1; *(LAS u32x2*)(AQ + cq * 72 + 16 * im + 4 * g) = pack4(c2); }
    WG_SYNC();
    GD_IDX();
    { const int col = c * 8 + q8; if (col < 256) { float x[64];
#pragma unroll
        for (int i = 0; i < 64; ++i) x[i] = 0.f;
        int vz = 0; asm volatile("" : "+v"(vz)); const LAS float* AMv = AM + vz;
        const LAS bf16_t* src = col < 128 ? Vi + col : Ki + (col - 128); const LAS float* scl = col < 128 ? BETA : BG; LAS bf16_t* dst = col < 128 ? Ui + col : Wi + (col - 128);
#pragma unroll
        for (int tq = 0; tq < 64; ++tq) { float acc = bf2f(src[tq * GD_LD]) * scl[tq];
#pragma unroll
            for (int i = 0; i < ((tq + 3) & ~3); i += 4) { const f32x4 av = *(const LAS f32x4*)(AMv + tq * 68 + i); acc -= av[0] * x[i]; acc -= av[1] * x[i + 1]; acc -= av[2] * x[i + 2]; acc -= av[3] * x[i + 3]; }
            x[tq] = acc; dst[tq * GD_LD] = (bf16_t)f2bf(acc); } } }
    WG_SYNC();
    GD_IDX();
    { const int jc = w & 3, wh = w >> 2; const int cq = 16 * jc + r;
      bf16_t* QT = (bf16_t*)(a.ws + WS_GD_QT) + (size_t)tk * 8192; bf16_t* YI = (bf16_t*)(a.ws + WS_GD_YI) + (size_t)tk * 8192; bf16_t* GG = (bf16_t*)(a.ws + WS_GD_G) + (size_t)tk * 16384; float* Z = WSF(WS_GD_Z) + (size_t)tk * 16384;
#pragma unroll
      for (int tt = 0; tt < 4; ++tt) { const int id = 4 * wh + tt; f32x4 c1 = {0.f, 0.f, 0.f, 0.f}, c2 = c1;
#pragma unroll
          for (int k0 = 0; k0 < 64; k0 += 32) { const bf16x8 fb = frag_row(AQ, 72, 16 * jc, k0, lane); c1 = mfma16(frag_tr(Wi, GD_LD, 16 * id, k0, lane), fb, c1); c2 = mfma16(frag_tr(Ui, GD_LD, 16 * id, k0, lane), fb, c2); }
          const f32x4 qg = unpack4(*(const LAS u32x2*)(QGi + cq * GD_LD + 16 * id + 4 * g));
          *(u32x2*)(QT + cq * 128 + 16 * id + 4 * g) = pack4(qg - c1); *(u32x2*)(YI + cq * 128 + 16 * id + 4 * g) = pack4(c2); }
      const float e63 = expf(GC[63]);
#pragma unroll
      for (int ti = 0; ti < 8; ++ti) { f32x4 c1 = {0.f, 0.f, 0.f, 0.f}, c2 = c1;
#pragma unroll
          for (int k0 = 0; k0 < 64; k0 += 32) { c1 = mfma16(frag_tr(Wi, GD_LD, 16 * ti, k0, lane), frag_tr(KTi, GD_LD, 16 * w, k0, lane), c1); c2 = mfma16(frag_tr(KTi, GD_LD, 16 * ti, k0, lane), frag_tr(Ui, GD_LD, 16 * w, k0, lane), c2); }
          const int dq = 16 * w + r; f32x4 gv;
#pragma unroll
          for (int e = 0; e < 4; ++e) gv[e] = ((16 * ti + 4 * g + e) == dq ? e63 : 0.f) - c1[e];
          *(u32x2*)(GG + dq * 128 + 16 * ti + 4 * g) = pack4(gv); *(f32x4*)(Z + dq * 128 + 16 * ti + 4 * g) = c2; } }
    WG_SYNC();
#undef GD_IDX
}
__device__ __forceinline__ void gd_stage2(CArgs& a, int h, int es, LAS unsigned char* lds, int tid) {
    const int lane = tid & 63, w = __builtin_amdgcn_readfirstlane(tid >> 6), r = lane & 15, g = lane >> 4;
    LAS bf16_t* Si = (LAS bf16_t*)lds;
    const bf16_t* G = (const bf16_t*)(a.ws + WS_GD_G); const float* Z = WSF(WS_GD_Z); bf16_t* S = (bf16_t*)(a.ws + WS_GD_S);
    const int so = (16 * es + r) * 128 + 16 * w + 4 * g;
    *(LAS u32x2*)(Si + r * GD_LD + 16 * w + 4 * g) = (u32x2){0u, 0u}; *(u32x2*)(S + (size_t)h * 16384 + so) = (u32x2){0u, 0u};
    WG_SYNC();
#pragma unroll 1
    for (int n = 0; n < NCH - 1; ++n) { const size_t tk = (size_t)n * 4 + h; const int cur = n & 1;
        f32x4 acc = *(const f32x4*)(Z + tk * 16384 + so);
#pragma unroll
        for (int k0 = 0; k0 < 128; k0 += 32) acc = mfma16(frag_row_g(G + tk * 16384, 128, 16 * w, k0, lane), frag_row(Si + cur * 16 * GD_LD, GD_LD, 0, k0, lane), acc);
        const u32x2 pv = pack4(acc);
        *(LAS u32x2*)(Si + (cur ^ 1) * 16 * GD_LD + r * GD_LD + 16 * w + 4 * g) = pv; *(u32x2*)(S + (tk + 4) * 16384 + so) = pv;
        WG_SYNC(); }
}
__device__ __forceinline__ void gd_stage3(CArgs& a, int l, int n, int h, LAS unsigned char* lds, int tid) {
    const int lane = tid & 63, w = __builtin_amdgcn_readfirstlane(tid >> 6), r = lane & 15, g = lane >> 4, jc = w & 3, wh = w >> 2;
    const size_t tk = (size_t)n * 4 + h; const int c = 16 * jc + r, t = n * 64 + c;
    const bf16_t* S = (const bf16_t*)(a.ws + WS_GD_S) + tk * 16384; const bf16_t* QT = (const bf16_t*)(a.ws + WS_GD_QT) + tk * 8192; const bf16_t* YI = (const bf16_t*)(a.ws + WS_GD_YI) + tk * 8192;
    LAS float* xs = (LAS float*)lds;
    f32x4 acc[4]; float ss = 0.f;
#pragma unroll
    for (int tt = 0; tt < 4; ++tt) { const int ie = 4 * wh + tt; acc[tt] = unpack4(*(const u32x2*)(YI + c * 128 + 16 * ie + 4 * g));
#pragma unroll
        for (int k0 = 0; k0 < 128; k0 += 32) acc[tt] = mfma16(frag_row_g(S, 128, 16 * ie, k0, lane), frag_row_g(QT, 128, 16 * jc, k0, lane), acc[tt]);
#pragma unroll
        for (int e = 0; e < 4; ++e) ss += acc[tt][e] * acc[tt][e]; }
    ss += __shfl_xor(ss, 16); ss += __shfl_xor(ss, 32);
    if (g == 0) xs[w * 16 + r] = ss;
    WG_SYNC();
    const float rs = 1.0f / sqrtf((ss + xs[(w ^ 4) * 16 + r]) * (1.0f / 128.0f) + 1e-6f);
    const float* nw = LP(I_GNORM, 128); const bf16_t* pz = PROJROW(t) + C_GZ + h * 128; bf16_t* O = (bf16_t*)(a.ws + WS_O) + (size_t)t * D + h * 128;
#pragma unroll
    for (int tt = 0; tt < 4; ++tt) { const int e0 = 16 * (4 * wh + tt) + 4 * g; const f32x4 zv = unpack4(*(const u32x2*)(pz + e0)), wv = *(const f32x4*)(nw + e0); f32x4 y;
#pragma unroll
        for (int e = 0; e < 4; ++e) y[e] = acc[tt][e] * rs * wv[e] * silu_f(zv[e]);
        *(u32x2*)(O + e0) = pack4(y); }
    WG_SYNC();
}

#define XB_TMO      128
#define XB_XCNT(j)  (256  + 64 * (j))
#define XB_XSUB(j)  (1280 + 64 * (j))
#define XB_XGEN(j)  (2304 + 64 * (j))
#define XB_TOP      3328
#define XB_TOPGEN   3392
#define XCD_BAR_WORDS 3456
#define XB_SPIN_CAP (1u << 20)
__device__ __forceinline__ unsigned xb_ld(unsigned* p)              { return __hip_atomic_load(p, __ATOMIC_RELAXED, __HIP_MEMORY_SCOPE_AGENT); }
__device__ __forceinline__ unsigned xb_add(unsigned* p, unsigned v) { return __hip_atomic_fetch_add(p, v, __ATOMIC_RELAXED, __HIP_MEMORY_SCOPE_AGENT); }
__device__ __forceinline__ unsigned xb_xcc_id() { return (unsigned)__builtin_amdgcn_s_getreg((3 << 11) | 20) & 0xFu; }
#define XB_SPIN(cond, bar) do { unsigned _sp = 0; while (cond) { __builtin_amdgcn_s_sleep(1); \
    if ((++_sp & 255u) == 0u) { if (xb_ld(&(bar)[XB_TMO])) break; if (_sp > XB_SPIN_CAP) { atomicAdd(&(bar)[XB_TMO], 1u); break; } } } } while (0)
struct XcdBarrier { unsigned* bar; unsigned x; volatile LAS unsigned* st; };
__device__ __forceinline__ XcdBarrier xcd_barrier_post(unsigned* bar, volatile LAS unsigned* st) {
    XcdBarrier b; b.bar = bar; b.x = xb_xcc_id(); b.st = st;
    if (threadIdx.x == 0) (void)xb_add(&bar[XB_XCNT(b.x)], 1u);
    return b;
}
__device__ __forceinline__ void xcd_barrier_complete(unsigned* bar, unsigned x, unsigned& nloc, unsigned& nx) {
    const unsigned G = gridDim.x * gridDim.y * gridDim.z;
    unsigned sum, cnt, mine, sp = 0u;
    for (;;) {
        sum = 0u; cnt = 0u; mine = 0u;
#pragma unroll
        for (unsigned j = 0; j < 16; ++j) { const unsigned c = xb_ld(&bar[XB_XCNT(j)]); sum += c; cnt += (c > 0u) ? 1u : 0u; mine = (j == x) ? c : mine; }
        if (sum == G) break;
        __builtin_amdgcn_s_sleep(1);
        if ((++sp & 255u) == 0u) { if (xb_ld(&bar[XB_TMO])) break; if (sp > XB_SPIN_CAP) { atomicAdd(&bar[XB_TMO], 1u); break; } }
    }
    nloc = mine > 0u ? mine : 1u; nx = cnt > 0u ? cnt : 1u;
}
__device__ __forceinline__ void xcd_barrier(const XcdBarrier& b) {
    asm volatile("s_waitcnt vmcnt(0)" ::: "memory");
    __syncthreads();
    if (threadIdx.x == 0) {
        unsigned* bar = b.bar;
        __builtin_amdgcn_s_waitcnt(0);
        unsigned nloc = b.st[0], nx = b.st[1];
        if (nloc == 0u) { xcd_barrier_complete(bar, b.x, nloc, nx); b.st[0] = nloc; b.st[1] = nx; }
        const unsigned old = xb_add(&bar[XB_XSUB(b.x)], 1u);
        const unsigned gen = old / nloc;
        if (old + 1u == (gen + 1u) * nloc) {
            __builtin_amdgcn_fence(__ATOMIC_RELEASE, "agent");
            asm volatile("s_waitcnt vmcnt(0)" ::: "memory");
            const unsigned og = xb_add(&bar[XB_TOP], 1u);
            const unsigned tg = og / nx;
            if (og + 1u == (tg + 1u) * nx) xb_add(&bar[XB_TOPGEN], 1u);
            else XB_SPIN(xb_ld(&bar[XB_TOPGEN]) == tg, bar);
            __builtin_amdgcn_fence(__ATOMIC_ACQUIRE, "agent");
            xb_add(&bar[XB_XGEN(b.x)], 1u);
            asm volatile("s_waitcnt vmcnt(0)" ::: "memory");
        } else {
            XB_SPIN(xb_ld(&bar[XB_XGEN(b.x)]) == gen, bar);
            __builtin_amdgcn_fence(__ATOMIC_ACQUIRE, "agent");
            asm volatile("s_waitcnt vmcnt(0)" ::: "memory");
        }
    }
    __syncthreads();
}

constexpr int N_PHASES = 1 + 9 * NL;

__device__ __forceinline__ void run_phase(CArgs& a, int ph, LAS unsigned char* lds, const int tid, const int bid) {
    const int lane = tid & 63, wave = __builtin_amdgcn_readfirstlane(tid >> 6);
    const int G = gridDim.x, gw = bid * NWAVES + wave, NGW = G * NWAVES;
    if (ph == N_PHASES - 1) {
        for (int t = gw; t < T; t += NGW) rms_row_f32(HRES + (size_t)t * D, a.in[I_NF], a.out + (size_t)t * D, lane);
        return;
    }
    const int l = ph / 9, sp = ph % 9;
    const float* hin = l == 0 ? a.in[I_X] : (const float*)HRES;
    switch (sp) {
    case 0: {
        LAS float* scr = (LAS float*)(lds + wave * 16384);
        constexpr int I_IN = (D / 64) * (PTP / 32), I_OUT = (D / 64) * (D / 32), I_UP = (D / 64) * (FF / 32), I_DN = (FF / 64) * (D / 32), I_L = I_IN + I_OUT + I_UP + I_DN;
        for (int it = gw; it < I_L; it += NGW) {
            int r = it;
            if (r < I_IN) { transpose_item(LP(I_WIN, (size_t)D * PT), D, PT, PTP, (bf16_t*)(a.ws + WS_WIN), scr, r, lane); continue; } r -= I_IN;
            if (r < I_OUT) { transpose_item(LP(I_WOUT, (size_t)D * D), D, D, D, (bf16_t*)(a.ws + WS_WOUT), scr, r, lane); continue; } r -= I_OUT;
            if (r < I_UP) { transpose_item(LP(I_WUP, (size_t)D * FF), D, FF, FF, (bf16_t*)(a.ws + WS_WUP), scr, r, lane); continue; } r -= I_UP;
            transpose_item(LP(I_WDN, (size_t)FF * D), FF, D, D, (bf16_t*)(a.ws + WS_WDN), scr, r, lane);
        }
        for (int t = gw; t < T; t += NGW) rms_row_bf16(hin + (size_t)t * D, LP(I_N1, D), (bf16_t*)(a.ws + WS_XN) + (size_t)t * D, lane);
    } break;
    case 1: { pg8::Gemm g{(const bf16_t*)(a.ws + WS_XN), (const bf16_t*)(a.ws + WS_WIN)}; pg8::StaticOrder<T, PTP> S; S.init(G, bid);
              pg8::EpiBf16<false> E{(bf16_t*)(a.ws + WS_PROJ), PTP}; pg8::gemm_phase<D, pg8::EpiBf16<false>, pg8::StaticOrder<T, PTP>, true>(lds, g, S, E, tid); } break;
    case 2: {
#pragma unroll 1
              for (int it = bid; it < NCH * 4; it += G) gd_stage1(a, l, it >> 2, it & 3, lds, tid);
#pragma unroll 1
              for (int it = bid; it < NCH * 8; it += G) rw_stage1(a, l, it >> 3, it & 7, lds, tid);
#pragma unroll 1
              for (int it = bid; it < NCH * 2; it += G) m2_stage1(a, l, it >> 1, it & 1, lds, tid);
#pragma unroll 1
              for (int it = bid; it < NCH * 4; it += G) ret_stage1(a, it >> 2, it & 3, lds, tid); } break;
    case 3: { const int b = bid;
              if (b < 32) gd_stage2(a, b >> 3, b & 7, lds, tid);
              else if (b < 96) ret_stage2(a, b - 32, tid);
              else if (b < 128) rw_stage2(a, (b - 96) >> 2, (b - 96) & 3, lds, tid);
              else m2_stage2(a, b - 128, tid); } break;
    case 4:
#pragma unroll 1
            for (int it = bid; it < NCH * 4; it += G) gd_stage3(a, l, it >> 2, it & 3, lds, tid);
#pragma unroll 1
            for (int it = bid; it < NCH * 4; it += G) ret_stage3(a, l, it >> 2, it & 3, lds, tid);
#pragma unroll 1
            for (int it = bid; it < NCH * 8; it += G) rw_stage3(a, l, it >> 3, it & 7, lds, tid);
#pragma unroll 1
            for (int it = bid; it < NCH * 2; it += G) m2_stage3(a, l, it >> 1, it & 1, lds, tid);
            break;
    case 5: { pg8::Gemm g{(const bf16_t*)(a.ws + WS_O), (const bf16_t*)(a.ws + WS_WOUT)}; pg8::StaticOrder<T, D> S; S.init(G, bid);
              pg8::EpiAddRes E{hin, HRES, D}; pg8::gemm_phase<D, pg8::EpiAddRes, pg8::StaticOrder<T, D>, false>(lds, g, S, E, tid); } break;
    case 6: for (int t = gw; t < T; t += NGW) rms_row_bf16(HRES + (size_t)t * D, LP(I_N2, D), (bf16_t*)(a.ws + WS_XN) + (size_t)t * D, lane); break;
    case 7: { pg8::Gemm g{(const bf16_t*)(a.ws + WS_XN), (const bf16_t*)(a.ws + WS_WUP)}; pg8::StaticOrder<T, FF> S; S.init(G, bid);
              pg8::EpiBf16<true> E{(bf16_t*)(a.ws + WS_HID), FF}; pg8::gemm_phase<D, pg8::EpiBf16<true>, pg8::StaticOrder<T, FF>, true>(lds, g, S, E, tid); } break;
    case 8: { pg8::Gemm g{(const bf16_t*)(a.ws + WS_HID), (const bf16_t*)(a.ws + WS_WDN)}; pg8::StaticOrder<T, D> S; S.init(G, bid);
              pg8::EpiAddRes E{HRES, HRES, D}; pg8::gemm_phase<FF, pg8::EpiAddRes, pg8::StaticOrder<T, D>, false>(lds, g, S, E, tid); } break;
    }
}

__global__ void __launch_bounds__(NWAVES * 64, 2) fwd_kernel(Args a) {
    extern __shared__ __attribute__((aligned(16))) unsigned char lds_raw[];
    LAS unsigned char* lds = (LAS unsigned char*)lds_raw;
    const int ph_lo = a.ph_lo, ph_hi = a.ph_hi;
    volatile LAS unsigned* MISC = (volatile LAS unsigned*)(lds + MISC_OFF);
    if (threadIdx.x < 64) MISC[threadIdx.x] = 0u;
    __syncthreads();
    const XcdBarrier bar = xcd_barrier_post((unsigned*)(a.ws + WS_CTL), MISC + 8);
    for (int ph = ph_lo; ph < ph_hi; ++ph) {
        CArgs* ap = (CArgs*)__builtin_amdgcn_kernarg_segment_ptr();
        asm volatile("" : "+s"(ap));
        int tid = threadIdx.x, bid = blockIdx.x;
        asm volatile("" : "+v"(tid)); asm volatile("" : "+s"(bid));
        run_phase(*ap, ph, lds, tid, bid);
        if (ph + 1 < ph_hi) xcd_barrier(bar);
    }
}

extern "C" void kernel_launch(void* const* d_in, const int* in_sizes, int n_in, void* d_out, int out_size, void* d_ws, size_t ws_size, hipStream_t stream) {
    static int grid = 0;
    if (grid == 0) {
        if (n_in != N_IN || in_sizes[0] != T * D || out_size != T * D || ws_size < WS_END) {
            fprintf(stderr, "kernel_launch: shape/workspace mismatch: n_in %d in0 %d out %d ws %zu (need %zu); nothing launched\n", n_in, n_in > 0 ? in_sizes[0] : -1, out_size, ws_size, (size_t)WS_END); grid = -1; return; }
        int dev = 0, cus = 0, per_cu = 0;
        if (hipGetDevice(&dev) != hipSuccess || hipDeviceGetAttribute(&cus, hipDeviceAttributeMultiprocessorCount, dev) != hipSuccess) { grid = -1; return; }
        if (hipFuncSetAttribute((const void*)fwd_kernel, hipFuncAttributeMaxDynamicSharedMemorySize, LDS_BYTES) != hipSuccess) { fprintf(stderr, "kernel_launch: hipFuncSetAttribute failed\n"); grid = -1; return; }
        if (hipOccupancyMaxActiveBlocksPerMultiprocessor(&per_cu, (const void*)fwd_kernel, NWAVES * 64, LDS_BYTES) != hipSuccess || per_cu < 1) { fprintf(stderr, "kernel_launch: occupancy query says %d blocks per CU\n", per_cu); per_cu = 1; }
        (void)hipGetLastError();
        grid = cus;
    }
    if (grid < 0) return;
    Args a{};
    for (int i = 0; i < N_IN; ++i) a.in[i] = (const float*)d_in[i];
    a.out = (float*)d_out; a.ws = (unsigned char*)d_ws;
#if N_LAUNCH_MODE == 1
    a.ph_lo = 0; a.ph_hi = N_PHASES;
    (void)hipMemsetAsync((char*)d_ws + WS_CTL, 0, XCD_BAR_WORDS * 4, stream);
    hipLaunchKernelGGL(fwd_kernel, dim3(grid), dim3(NWAVES * 64), LDS_BYTES, stream, a);
#else
#ifndef DBG_MAXPH
#define DBG_MAXPH N_PHASES
#endif
    for (int ph = 0; ph < N_PHASES; ++ph) {
        if (ph >= DBG_MAXPH && ph != N_PHASES - 1) continue;
#ifdef DBG_SKIP_FINAL
        if (ph == N_PHASES - 1) continue;
#endif
        (void)hipMemsetAsync((char*)d_ws + WS_CTL, 0, XCD_BAR_WORDS * 4, stream);
        a.ph_lo = ph; a.ph_hi = ph + 1;
        hipLaunchKernelGGL(fwd_kernel, dim3(grid), dim3(NWAVES * 64), LDS_BYTES, stream, a);
    }
#endif
}
#endif
```

```cpp
#ifndef HOST_TEST
#include <hip/hip_runtime.h>
#endif
#include <cstdio>
#include <cstdint>
#include <cmath>
#include <cstddef>

#ifndef SEQ_T
#define SEQ_T 8192
#endif
#ifndef N_LAUNCH_MODE
#define N_LAUNCH_MODE 1
#endif

constexpr int T = SEQ_T, D = 2048, NL = 2, FF = 8192, PT = 6832, PTP = 6912;
constexpr int C_GQ = 0, C_GK = 512, C_GV = 1024, C_GZ = 1536, C_GB = 2048, C_GA = 2052;
constexpr int C_RQ = 2056, C_RK = 2312, C_RV = 2568, C_RG = 3080;
constexpr int C_MZ = 3592, C_MXBC = 4104, C_MDT = 5128;
constexpr int C_RW = 5136;
enum { I_X = 0, I_N1, I_WIN, I_GCONV, I_GALOG, I_GDTB, I_GNORM, I_RNORM, I_MCONV, I_MCONVB, I_MALOG, I_MDTB, I_MD, I_MNORM, I_RWMU, I_RWW0, I_RWWUP, I_RWA0, I_RWAUP,
       I_RWGUP, I_RWKK, I_RWKA, I_RWRK, I_RWLNW, I_RWLNB, I_WOUT, I_N2, I_WUP, I_WDN, I_NF, N_IN };

constexpr size_t MiB = 1u << 20;
constexpr size_t SZ_WIN = (size_t)PTP * D * 2, SZ_WOUT = (size_t)D * D * 2, SZ_WUP = (size_t)FF * D * 2, SZ_WDN = (size_t)D * FF * 2;
constexpr size_t WS_CTL = 0, CTL_BYTES = 1 * MiB;
constexpr size_t WS_WIN = WS_CTL + CTL_BYTES;
constexpr size_t WS_WOUT = WS_WIN + SZ_WIN;
constexpr size_t WS_WUP = WS_WOUT + SZ_WOUT;
constexpr size_t WS_WDN = WS_WUP + SZ_WUP;
constexpr size_t WS_XN = WS_WDN + SZ_WDN;
constexpr size_t WS_O = WS_XN;
constexpr size_t WS_PROJ = WS_XN + (size_t)T * D * 2;
constexpr size_t WS_HID = WS_PROJ;
constexpr size_t GDN_ = (size_t)(T / 64) * 4 * 16384;
constexpr size_t WS_GD_G = WS_PROJ + (size_t)T * PTP * 2;
constexpr size_t WS_GD_Z = WS_GD_G + GDN_ * 2;
constexpr size_t WS_GD_QT = WS_GD_Z + GDN_ * 4;
constexpr size_t WS_GD_YI = WS_GD_QT + GDN_;
constexpr size_t WS_GD_S = WS_GD_YI + GDN_;
constexpr size_t WS_GAB = WS_GD_S + GDN_ * 2;
constexpr int NCH = T / 64;
constexpr size_t WS_RET_Z = WS_GAB;
constexpr size_t WS_RET_YI = WS_RET_Z + (size_t)NCH * 4 * 8192 * 4;
constexpr size_t WS_RET_QH = WS_RET_YI + (size_t)NCH * 4 * 8192 * 2;
constexpr size_t WS_RET_S = WS_RET_QH + (size_t)NCH * 4 * 4096 * 2;
constexpr size_t M2N = (size_t)NCH * 8 * 8192;
constexpr size_t WS_M2_Z = WS_RET_S + (size_t)NCH * 4 * 8192 * 2;
constexpr size_t WS_M2_YI = WS_M2_Z + M2N * 4;
constexpr size_t WS_M2_QH = WS_M2_YI + M2N;
constexpr size_t WS_M2_S = WS_M2_QH + M2N * 2;
constexpr size_t WS_M2_DEC = WS_M2_S + M2N * 2;
constexpr size_t WS_MDT = WS_M2_DEC + (size_t)NCH * 8 * 4;
constexpr size_t RWN = (size_t)NCH * 8 * 4096;
constexpr size_t WS_RW_G = WS_MDT;
constexpr size_t WS_RW_Z = WS_RW_G + RWN * 2;
constexpr size_t WS_RW_QT = WS_RW_Z + RWN * 4;
constexpr size_t WS_RW_YI = WS_RW_QT + RWN * 2;
constexpr size_t WS_RW_E = WS_RW_YI + RWN * 2;
constexpr size_t WS_RW_GT = WS_RW_E + RWN * 2;
constexpr size_t WS_RW_S = WS_RW_GT + RWN * 2;
constexpr size_t WS_END = WS_RW_S + RWN * 2;
static_assert(WS_HID + (size_t)T * FF * 2 <= WS_END, "HID overlay");
static_assert(SEQ_T != 8192 || WS_END <= 512 * MiB, "d_ws budget (512 MiB)");

typedef unsigned short bf16_t;
#ifdef HOST_TEST
#define DEV static inline
#define HD static inline
typedef float f32x4 __attribute__((vector_size(16)));
constexpr int WAVE = 1, LPC = 1;
static inline float wave_sum(float v) { return v; }
static inline float group_sum(float v) { return v; }
#else
#define DEV __device__ __forceinline__
#define HD __host__ __device__ __forceinline__
typedef float f32x4 __attribute__((ext_vector_type(4)));
constexpr int WAVE = 64, LPC = 16;
DEV float wave_sum(float v) {
#pragma unroll
    for (int o = 1; o < 64; o <<= 1) v += __shfl_xor(v, o);
    return v;
}
DEV float group_sum(float v) {
#pragma unroll
    for (int o = 1; o < 16; o <<= 1) v += __shfl_xor(v, o);
    return v;
}
#endif
constexpr int CPW = WAVE / LPC;

HD unsigned f2bf(float f) { unsigned u; __builtin_memcpy(&u, &f, 4); return (u + 0x7fffu + ((u >> 16) & 1u)) >> 16; }
HD unsigned pk2(float lo, float hi) { return f2bf(lo) | (f2bf(hi) << 16); }
HD float bf2f(bf16_t b) { unsigned u = (unsigned)b << 16; float f; __builtin_memcpy(&f, &u, 4); return f; }
#ifdef HOST_TEST
DEV float sigmoid_f(float x) { return 1.0f / (1.0f + expf(-x)); }
DEV float silu_f(float x) { return x / (1.0f + expf(-x)); }
#else
DEV float fexp(float x) { return __builtin_amdgcn_exp2f(x * 1.4426950408889634f); }
DEV float sigmoid_f(float x) { return __builtin_amdgcn_rcpf(1.0f + fexp(-x)); }
DEV float silu_f(float x) { return x * __builtin_amdgcn_rcpf(1.0f + fexp(-x)); }
#endif
DEV float softplus_f(float x) { return x > 20.f ? x : log1pf(expf(x)); }

struct Args { const float* in[N_IN]; float* out; unsigned char* ws; int ph_lo, ph_hi; };
#ifdef HOST_TEST
typedef const Args CArgs;
#else
typedef const __attribute__((address_space(4))) Args CArgs;
#endif
#define WSF(off) ((float*)(a.ws + (off)))
#define HRES (a.out)
#define PROJROW(t) ((const bf16_t*)(a.ws + WS_PROJ) + (size_t)(t) * PTP)
#define LP(idx, per) (a.in[idx] + (size_t)l * (per))

DEV void rms_row_bf16(const float* x, const float* w, bf16_t* o, int lane) {
    float ss = 0.f;
    for (int i = lane * 4; i < D; i += WAVE * 4) { const f32x4 v = *(const f32x4*)(x + i); ss += (v[0] * v[0] + v[1] * v[1]) + (v[2] * v[2] + v[3] * v[3]); }
    const float r = 1.0f / sqrtf(wave_sum(ss) * (1.0f / D) + 1e-6f);
    for (int i = lane * 4; i < D; i += WAVE * 4) { const f32x4 v = *(const f32x4*)(x + i), g = *(const f32x4*)(w + i);
        unsigned* op = (unsigned*)(o + i); op[0] = pk2(v[0] * r * g[0], v[1] * r * g[1]); op[1] = pk2(v[2] * r * g[2], v[3] * r * g[3]); }
}
DEV void rms_row_f32(const float* x, const float* w, float* o, int lane) {
    float ss = 0.f;
    for (int i = lane * 4; i < D; i += WAVE * 4) { const f32x4 v = *(const f32x4*)(x + i); ss += (v[0] * v[0] + v[1] * v[1]) + (v[2] * v[2] + v[3] * v[3]); }
    const float r = 1.0f / sqrtf(wave_sum(ss) * (1.0f / D) + 1e-6f);
    for (int i = lane * 4; i < D; i += WAVE * 4) { const f32x4 v = *(const f32x4*)(x + i), g = *(const f32x4*)(w + i);
        f32x4 y; y[0] = v[0] * r * g[0]; y[1] = v[1] * r * g[1]; y[2] = v[2] * r * g[2]; y[3] = v[3] * r * g[3]; *(f32x4*)(o + i) = y; }
}

DEV float conv4(const bf16_t* projrow_t, int col, const float* w, int c, int wstride, int t) {
    float acc = 0.f;
#pragma unroll
    for (int j = 0; j < 4; ++j) { const int tt = t - 3 + j; if (tt >= 0) acc += w[j * wstride + c] * bf2f(projrow_t[(ptrdiff_t)(j - 3) * PTP + col]); }
    return acc;
}

#ifdef HOST_TEST
static const float THETA[32] = {
#else
__device__ const float THETA[32] = {
#endif
    1.000000000e+00f, 7.429639101e-01f, 5.519954562e-01f, 4.101127088e-01f, 3.046989739e-01f, 2.263803482e-01f, 1.681924462e-01f, 1.249609292e-01f, 9.284145385e-02f, 6.897785515e-02f,
    5.124806613e-02f, 3.807546571e-02f, 2.828869782e-02f, 2.101748064e-02f, 1.561523322e-02f, 1.160155423e-02f, 8.619536646e-03f, 6.404003594e-03f, 4.757945426e-03f, 3.534980817e-03f,
    2.626363887e-03f, 1.951293205e-03f, 1.449740841e-03f, 1.077104942e-03f, 8.002503891e-04f, 5.945570301e-04f, 4.417345626e-04f, 3.281927784e-04f, 2.438354713e-04f, 1.811609109e-04f,
    1.345960627e-04f, 9.999999747e-05f };

#ifndef HOST_TEST
namespace pg8 {
#define PG8_LAS __attribute__((address_space(3)))
typedef short bf16x8 __attribute__((ext_vector_type(8)));
typedef unsigned u32x4 __attribute__((ext_vector_type(4)));
constexpr int BM = 256, BK = 64, HALF = 128, HTB = HALF * BK * 2, STAGE_BYTES = 8 * HTB, NXCD = 8, WGM = 8;
__host__ __device__ __forceinline__ int lds_byte(int r, int c) { const int st = (r >> 4) * 2 + (c >> 5), rr = r & 15, cc = c & 31, ob = rr * 64 + cc * 2; return st * 1024 + (ob ^ (((ob >> 9) & 1) << 5)); }
__host__ __device__ __forceinline__ void stage_rc(int b, int& R, int& C) { const int st = b / 1024, sb = b % 1024, swz = sb ^ (((sb >> 9) & 1) << 5); R = (st >> 1) * 16 + swz / 64; C = (st & 1) * 32 + (swz % 64) / 2; }
__host__ __device__ __forceinline__ int perm32(int rho) { const int n = rho >> 4, i = rho & 15; return 8 * (i >> 2) + 4 * n + (i & 3); }
struct Unit { int pm, pn; };
struct Gemm { const bf16_t* A; const bf16_t* Bt; };
template <int M, int N> struct StaticOrder {
    static constexpr int nM = M / BM, nN = N / BM, nwg = nM * nN; int G, c;
    __device__ void init(int G_, int c_) { G = G_; c = c_; }
    __device__ bool next(int i, Unit& u) const {
        const long L = (long)i * G + c; if (L >= nwg) return false;
        int wgid = (int)L; { const int q = nwg / NXCD, r = nwg % NXCD, xcd = wgid % NXCD, off = wgid / NXCD; wgid = (xcd < r ? xcd * (q + 1) : r * (q + 1) + (xcd - r) * q) + off; }
        const int nig = WGM * nN, gid = wgid / nig, fm = gid * WGM, gsz = (nM - fm) < WGM ? (nM - fm) : WGM;
        u.pm = fm + ((wgid % nig) % gsz); u.pn = (wgid % nig) / gsz; return true;
    }
    __device__ __forceinline__ void a_ready(const Unit&) const {}
    __device__ __forceinline__ void done(const Unit&) const {}
};
__device__ __forceinline__ unsigned cvt_pk_bf16(float lo, float hi) { unsigned r; asm volatile("v_cvt_pk_bf16_f32 %0, %1, %2" : "=v"(r) : "v"(lo), "v"(hi)); return r; }
struct EpiStoreF32 {
    static constexpr bool PERM = false, AFTER_DRAIN = false; float* O; int ldc;
    __device__ __forceinline__ void operator()(const f32x4 (&acc)[2][2][4][2], const Unit& u, int wr, int wc, int fr, int fq) const {
        const int row0 = u.pm * BM + wr * 64 + fr, col0 = u.pn * BM + wc * 32 + 4 * fq;
#pragma unroll
        for (int ai = 0; ai < 2; ++ai)
#pragma unroll
            for (int m = 0; m < 4; ++m) { float* rowp = O + (size_t)(row0 + ai * HALF + m * 16) * ldc + col0;
#pragma unroll
                for (int bj = 0; bj < 2; ++bj)
#pragma unroll
                    for (int n = 0; n < 2; ++n) *(f32x4*)(rowp + bj * HALF + n * 16) = acc[ai][bj][m][n]; }
    }
};
struct EpiAddRes {
    static constexpr bool PERM = false, AFTER_DRAIN = false; const float* B; float* O; int ldc;
    __device__ __forceinline__ void operator()(const f32x4 (&acc)[2][2][4][2], const Unit& u, int wr, int wc, int fr, int fq) const {
        const int row0 = u.pm * BM + wr * 64 + fr, col0 = u.pn * BM + wc * 32 + 4 * fq;
#pragma unroll
        for (int ai = 0; ai < 2; ++ai)
#pragma unroll
            for (int m = 0; m < 4; ++m) { float* rowp = O + (size_t)(row0 + ai * HALF + m * 16) * ldc + col0; const float* bp = B + (size_t)(row0 + ai * HALF + m * 16) * ldc + col0;
                f32x4 b[2][2];
#pragma unroll
                for (int bj = 0; bj < 2; ++bj)
#pragma unroll
                    for (int n = 0; n < 2; ++n) b[bj][n] = *(const f32x4*)(bp + bj * HALF + n * 16);
#pragma unroll
                for (int bj = 0; bj < 2; ++bj)
#pragma unroll
                    for (int n = 0; n < 2; ++n) *(f32x4*)(rowp + bj * HALF + n * 16) = b[bj][n] + acc[ai][bj][m][n]; }
    }
};
template <bool SQRELU> struct EpiBf16 {
    static constexpr bool PERM = true, AFTER_DRAIN = false; bf16_t* O; int ldc;
    __device__ __forceinline__ void operator()(const f32x4 (&acc)[2][2][4][2], const Unit& u, int wr, int wc, int fr, int fq) const {
        const int row0 = u.pm * BM + wr * 64 + fr, col0 = u.pn * BM + wc * 32 + 8 * fq;
#pragma unroll
        for (int ai = 0; ai < 2; ++ai)
#pragma unroll
            for (int m = 0; m < 4; ++m) { bf16_t* rowp = O + (size_t)(row0 + ai * HALF + m * 16) * ldc + col0;
#pragma unroll
                for (int bj = 0; bj < 2; ++bj) { f32x4 v0 = acc[ai][bj][m][0], v1 = acc[ai][bj][m][1];
                    if (SQRELU) {
#pragma unroll
                        for (int j = 0; j < 4; ++j) { const float p0 = fmaxf(v0[j], 0.f), p1 = fmaxf(v1[j], 0.f); v0[j] = p0 * p0; v1[j] = p1 * p1; } }
                    u32x4 w; w.x = cvt_pk_bf16(v0[0], v0[1]); w.y = cvt_pk_bf16(v0[2], v0[3]); w.z = cvt_pk_bf16(v1[0], v1[1]); w.w = cvt_pk_bf16(v1[2], v1[3]);
                    *(u32x4*)(rowp + bj * HALF) = w; } }
    }
};

template <int K, class Epi, class Sched, bool ALIGN_EPI = false>
__device__ __forceinline__ void gemm_phase(PG8_LAS unsigned char* lds, const Gemm g, const Sched& S, const Epi& E, const int tid) {
    const int wid = __builtin_amdgcn_readfirstlane(tid >> 6), lane = tid & 63, wr = wid >> 2, wc = wid & 3, fr = lane & 15, fq = lane >> 4;
    constexpr int nt = K / BK;
    unsigned voffA[2], voffB[2];
#pragma unroll
    for (int i = 0; i < 2; ++i) { int R, C; stage_rc(tid * 16 + i * 8192, R, C); const int Rb = Epi::PERM ? ((R & ~31) + perm32(R & 31)) : R;
        voffA[i] = (unsigned)(R * K + C) * 2u; voffB[i] = (unsigned)(Rb * K + C) * 2u; }
    const size_t kstep = (size_t)(BK * 2);
    const size_t hstep = (size_t)HALF * K * 2;
    const size_t tstep = 2 * hstep;
    const unsigned ldsw = (unsigned)wid * 1024u;
    const int aoff = lds_byte(wr * 64 + fr, fq * 8), boff = lds_byte(wc * 32 + fr, fq * 8);
#define PG8_SA(b, h) (((b) * 2 + (h)) * HTB)
#define PG8_SB(b, h) ((4 + (b) * 2 + (h)) * HTB)
#define PG8_STAGE(bufoff, gbase, voff) do { _Pragma("unroll") for (int _i = 0; _i < 2; ++_i) \
        __builtin_amdgcn_global_load_lds((const unsigned*)((const char*)(gbase) + (voff)[_i]), (PG8_LAS unsigned*)(lds + (bufoff) + ldsw + _i * 8192), 16, 0, 0); } while (0)
#define PG8_LDA(dst, b, h) do { _Pragma("unroll") for (int m = 0; m < 4; ++m) _Pragma("unroll") for (int k = 0; k < 2; ++k) dst[m][k] = *(const PG8_LAS bf16x8*)(lds + PG8_SA(b, h) + aoff + m * 2048 + k * 1024); } while (0)
#define PG8_LDB(dst, b, h) do { _Pragma("unroll") for (int n = 0; n < 2; ++n) _Pragma("unroll") for (int k = 0; k < 2; ++k) dst[n][k] = *(const PG8_LAS bf16x8*)(lds + PG8_SB(b, h) + boff + n * 2048 + k * 1024); } while (0)
#define PG8_MMA(ai, bj, At, Bt) do { __builtin_amdgcn_s_setprio(1); _Pragma("unroll") for (int m = 0; m < 4; ++m) _Pragma("unroll") for (int n = 0; n < 2; ++n) _Pragma("unroll") for (int k = 0; k < 2; ++k) \
        acc[ai][bj][m][n] = __builtin_amdgcn_mfma_f32_16x16x32_bf16(Bt[n][k], At[m][k], acc[ai][bj][m][n], 0, 0, 0); __builtin_amdgcn_s_setprio(0); } while (0)
#define PG8_WAIT_V(n) asm volatile("s_waitcnt vmcnt(" #n ")" ::: "memory")
#define PG8_WAIT_L(n) asm volatile("s_waitcnt lgkmcnt(" #n ")" ::: "memory")
#define PG8_BAR __builtin_amdgcn_s_barrier()
#define PG8_SCHED __builtin_amdgcn_sched_barrier(0)
    Unit cur, nxt; int ui = 0;
    if (!S.next(0, cur)) return;
    f32x4 acc[2][2][4][2];
#pragma unroll
    for (int a = 0; a < 2; ++a)
#pragma unroll
        for (int b = 0; b < 2; ++b)
#pragma unroll
            for (int m = 0; m < 4; ++m)
#pragma unroll
                for (int n = 0; n < 2; ++n) acc[a][b][m][n] = (f32x4){0.f, 0.f, 0.f, 0.f};
    bf16x8 At[4][2], B0[2][2], B1[2][2];
    const char* cA = (const char*)g.A + (size_t)cur.pm * tstep; const char* cB = (const char*)g.Bt + (size_t)cur.pn * tstep;
    S.a_ready(cur);
    PG8_STAGE(PG8_SB(0, 0), cB, voffB); PG8_STAGE(PG8_SB(0, 1), cB + hstep, voffB); PG8_STAGE(PG8_SA(0, 0), cA, voffA); PG8_STAGE(PG8_SA(0, 1), cA + hstep, voffA);
    if (wr == 1) PG8_BAR;
    PG8_WAIT_V(2); PG8_BAR;
    PG8_STAGE(PG8_SB(1, 0), cB + kstep, voffB); PG8_STAGE(PG8_SA(1, 0), cA + kstep, voffA); PG8_STAGE(PG8_SB(1, 1), cB + hstep + kstep, voffB);
    PG8_WAIT_V(6); PG8_BAR;
    for (;;) {
        const bool has_next = S.next(ui + 1, nxt);
        const char* nA = has_next ? (const char*)g.A + (size_t)nxt.pm * tstep : cA; const char* nB = has_next ? (const char*)g.Bt + (size_t)nxt.pn * tstep : cB;
        for (int t = 0; t < nt; t += 2) {
            const bool last = (t == nt - 2);
            const char* a1 = cA + (size_t)(t + 1) * kstep;
            const char* a2 = last ? nA : cA + (size_t)(t + 2) * kstep; const char* b2 = last ? nB : cB + (size_t)(t + 2) * kstep;
            const char* a3 = a2 + kstep; const char* b3 = b2 + kstep;
            if (last && has_next) S.a_ready(nxt);
            PG8_LDB(B0, 0, 0); PG8_LDB(B1, 0, 1); PG8_SCHED; PG8_LDA(At, 0, 0); PG8_STAGE(PG8_SA(1, 1), a1 + hstep, voffA);
            PG8_WAIT_V(8); PG8_WAIT_L(0); PG8_BAR; PG8_MMA(0, 0, At, B0); PG8_MMA(0, 1, At, B1); PG8_BAR; PG8_SCHED;
            PG8_LDA(At, 0, 1); PG8_STAGE(PG8_SB(0, 0), b2, voffB); PG8_STAGE(PG8_SB(0, 1), b2 + hstep, voffB); PG8_STAGE(PG8_SA(0, 0), a2, voffA);
            PG8_WAIT_V(8); PG8_WAIT_L(0); PG8_BAR; PG8_MMA(1, 0, At, B0); PG8_MMA(1, 1, At, B1); PG8_BAR; PG8_SCHED;
            PG8_LDB(B0, 1, 0); PG8_LDB(B1, 1, 1); PG8_SCHED; PG8_LDA(At, 1, 0); PG8_STAGE(PG8_SA(0, 1), a2 + hstep, voffA);
            PG8_WAIT_V(8); PG8_WAIT_L(0); PG8_BAR; PG8_MMA(0, 0, At, B0); PG8_MMA(0, 1, At, B1); PG8_BAR; PG8_SCHED;
            PG8_LDA(At, 1, 1); PG8_STAGE(PG8_SB(1, 0), b3, voffB); PG8_STAGE(PG8_SB(1, 1), b3 + hstep, voffB); PG8_STAGE(PG8_SA(1, 0), a3, voffA);
            PG8_WAIT_V(8); PG8_WAIT_L(0); PG8_BAR; PG8_MMA(1, 0, At, B0); PG8_MMA(1, 1, At, B1); PG8_BAR; PG8_SCHED;
        }
        if constexpr (ALIGN_EPI) { if (wr == 0) PG8_BAR; }
        E(acc, cur, wr, wc, fr, fq); S.done(cur);
        if (!has_next) break;
#pragma unroll
        for (int a = 0; a < 2; ++a)
#pragma unroll
            for (int b = 0; b < 2; ++b)
#pragma unroll
                for (int m = 0; m < 4; ++m)
#pragma unroll
                    for (int n = 0; n < 2; ++n) acc[a][b][m][n] = (f32x4){0.f, 0.f, 0.f, 0.f};
        cur = nxt; cA = nA; cB = nB; ++ui;
        if constexpr (ALIGN_EPI) { if (wr == 1) PG8_BAR; }
    }
    PG8_WAIT_V(0);
    if constexpr (!ALIGN_EPI) { if (wr == 0) PG8_BAR; }
    PG8_BAR;
#undef PG8_SA
#undef PG8_SB
#undef PG8_STAGE
#undef PG8_LDA
#undef PG8_LDB
#undef PG8_MMA
#undef PG8_WAIT_V
#undef PG8_WAIT_L
#undef PG8_BAR
#undef PG8_SCHED
}
}

#define LAS __attribute__((address_space(3)))
#define GAS __attribute__((address_space(1)))
typedef unsigned v4u __attribute__((ext_vector_type(4)));
constexpr int NWAVES = 8, LDS_BYTES = 163840, MISC_OFF = LDS_BYTES - 512;
#define LDS_WAIT() asm volatile("s_waitcnt lgkmcnt(0)" ::: "memory")

__device__ __forceinline__ void transpose_item(const float* W, int K, int N, int Npad, bf16_t* WT, LAS float* scr, int item, int lane) {
    const int nblk = Npad / 32, kb = item / nblk, nb = item % nblk, k0 = 64 * kb, n0 = 32 * nb;
    const int n = n0 + (lane & 31); const bool ok = n < N;
#pragma unroll 8
    for (int i = 0; i < 32; ++i) { const int kk = 2 * i + (lane >> 5); scr[kk * 33 + (lane & 31)] = ok ? W[(size_t)(k0 + kk) * N + n] : 0.f; }
    LDS_WAIT(); asm volatile("" ::: "memory");
    const int c = lane & 7;
#pragma unroll
    for (int j = 0; j < 4; ++j) { const int nn = (lane >> 3) + 8 * j; const LAS float* s = scr + (8 * c) * 33 + nn;
        v4u o; o.x = pk2(s[0 * 33], s[1 * 33]); o.y = pk2(s[2 * 33], s[3 * 33]); o.z = pk2(s[4 * 33], s[5 * 33]); o.w = pk2(s[6 * 33], s[7 * 33]);
        *(GAS v4u*)(WT + (size_t)(n0 + nn) * K + k0 + 8 * c) = o; }
    LDS_WAIT(); asm volatile("" ::: "memory");
}


typedef short bf16x8 __attribute__((ext_vector_type(8)));
typedef short s16x4 __attribute__((ext_vector_type(4)));
typedef unsigned u32x2 __attribute__((ext_vector_type(2)));
__device__ __forceinline__ s16x4 tr16(const LAS bf16_t* p) { return __builtin_bit_cast(s16x4, __builtin_amdgcn_ds_read_tr16_b64_v4i16((LAS s16x4*)p)); }
__device__ __forceinline__ bf16x8 frag_row(const LAS bf16_t* img, int ld, int nc0, int k0, int lane) { return *(const LAS bf16x8*)(img + (nc0 + (lane & 15)) * ld + k0 + 8 * (lane >> 4)); }
__device__ __forceinline__ bf16x8 frag_tr(const LAS bf16_t* img, int ld, int nc0, int k0, int lane) {
    const int g = lane >> 4, q = (lane & 15) >> 2, p = lane & 3;
    const LAS bf16_t* ad = img + (k0 + 8 * g + q) * ld + nc0 + 4 * p;
    const s16x4 lo = tr16(ad), hi = tr16(ad + 4 * ld);
    return (bf16x8){lo[0], lo[1], lo[2], lo[3], hi[0], hi[1], hi[2], hi[3]};
}
__device__ __forceinline__ bf16x8 frag_row_g(const bf16_t* img, int ld, int nc0, int k0, int lane) { return *(const bf16x8*)(img + (size_t)(nc0 + (lane & 15)) * ld + k0 + 8 * (lane >> 4)); }
__device__ __forceinline__ bf16x8 frag_fo(const bf16_t* img, int KS, int tile, int ks, int lane) { return *(const bf16x8*)(img + ((size_t)(tile * KS + ks) * 64 + lane) * 8); }
__device__ __forceinline__ int fo_st(int tile, int KS, int k0, int g, int r) { const int k = k0 + 4 * g; return ((tile * KS + (k >> 5)) * 64 + ((k >> 3) & 3) * 16 + r) * 8 + (k & 7); }
__device__ __forceinline__ int co_off(int tj, int NI, int ti, int lane) { return ((tj * NI + ti) * 64 + lane) * 4; }
__device__ __forceinline__ f32x4 mfma16(bf16x8 a, bf16x8 b, f32x4 c) { return __builtin_amdgcn_mfma_f32_16x16x32_bf16(a, b, c, 0, 0, 0); }
__device__ __forceinline__ u32x2 pack4(f32x4 v) { u32x2 w; w.x = pk2(v[0], v[1]); w.y = pk2(v[2], v[3]); return w; }
__device__ __forceinline__ f32x4 unpack4(u32x2 w) { f32x4 v; v[0] = __uint_as_float(w.x << 16); v[1] = __uint_as_float(w.x & 0xffff0000u); v[2] = __uint_as_float(w.y << 16); v[3] = __uint_as_float(w.y & 0xffff0000u); return v; }
#define WG_SYNC() __syncthreads()

__device__ __forceinline__ void ret_stage1(CArgs& a, int n, int h, LAS unsigned char* lds, int tid) {
    const int lane = tid & 63, w = __builtin_amdgcn_readfirstlane(tid >> 6), r = lane & 15, g = lane >> 4;
    constexpr int LD = 72, LDV = 136;
    LAS bf16_t* Qi = (LAS bf16_t*)lds; LAS bf16_t* Ki = Qi + 64 * LD; LAS bf16_t* Kdi = Ki + 64 * LD; LAS bf16_t* Vi = Kdi + 64 * LD; LAS bf16_t* Si = Vi + 64 * LDV;
    const int tk = n * 4 + h; const float lg2 = log2f(1.0f - exp2f(-5.0f - (float)h));
    bf16_t* QH = (bf16_t*)(a.ws + WS_RET_QH) + (size_t)tk * 4096;
    for (int idx = tid; idx < 2048; idx += 512) {
        const int c = idx >> 5, i = idx & 31, t = n * 64 + c; float sn, cs; sincosf((float)t * THETA[i], &sn, &cs);
        const bf16_t* pr = PROJROW(t);
        const unsigned qq = *(const unsigned*)(pr + C_RQ + 64 * h + 2 * i), kk = *(const unsigned*)(pr + C_RK + 64 * h + 2 * i);
        const float q0 = __uint_as_float(qq << 16), q1 = __uint_as_float(qq & 0xffff0000u), k0 = __uint_as_float(kk << 16), k1 = __uint_as_float(kk & 0xffff0000u);
        const float rq0 = q0 * cs - q1 * sn, rq1 = q1 * cs + q0 * sn, rk0 = (k0 * cs - k1 * sn) * 0.125f, rk1 = (k1 * cs + k0 * sn) * 0.125f;
        const float dk = exp2f(lg2 * (float)(63 - c)), dq = exp2f(lg2 * (float)(c + 1));
        *(LAS unsigned*)(Qi + c * LD + 2 * i) = pk2(rq0, rq1); *(LAS unsigned*)(Ki + c * LD + 2 * i) = pk2(rk0, rk1); *(LAS unsigned*)(Kdi + c * LD + 2 * i) = pk2(rk0 * dk, rk1 * dk);
        { const int d = 2 * i; *(unsigned*)(QH + (((c >> 4) * 2 + (d >> 5)) * 64 + ((d >> 3) & 3) * 16 + (c & 15)) * 8 + (d & 7)) = pk2(rq0 * dq, rq1 * dq); }
    }
    for (int idx = tid; idx < 1024; idx += 512) { const int c = idx >> 4, ch = idx & 15; *(LAS v4u*)(Vi + c * LDV + 8 * ch) = *(const v4u*)(PROJROW(n * 64 + c) + C_RV + 128 * h + 8 * ch); }
    WG_SYNC();
#pragma unroll
    for (int tt = 0; tt < 2; ++tt) { const int tile = 2 * w + tt, im = tile >> 2, jc = tile & 3; f32x4 acc = {0.f, 0.f, 0.f, 0.f};
        if (jc >= im) {
#pragma unroll
            for (int k0 = 0; k0 < 64; k0 += 32) acc = mfma16(frag_row(Ki, LD, 16 * im, k0, lane), frag_row(Qi, LD, 16 * jc, k0, lane), acc);
#pragma unroll
            for (int e = 0; e < 4; ++e) { const int i = 16 * im + 4 * g + e, j = 16 * jc + r; acc[e] = j >= i ? acc[e] * exp2f(lg2 * (float)(j - i)) : 0.f; } }
        *(LAS u32x2*)(Si + (16 * jc + r) * LD + 16 * im + 4 * g) = pack4(acc); }
    WG_SYNC();
    bf16_t* YI = (bf16_t*)(a.ws + WS_RET_YI) + (size_t)tk * 8192; float* Z = WSF(WS_RET_Z) + (size_t)tk * 8192;
#pragma unroll
    for (int tt = 0; tt < 4; ++tt) { const int jc = w & 3, ie = 4 * (w >> 2) + tt; f32x4 acc = {0.f, 0.f, 0.f, 0.f};
#pragma unroll
        for (int k0 = 0; k0 < 64; k0 += 32) acc = mfma16(frag_tr(Vi, LDV, 16 * ie, k0, lane), frag_row(Si, LD, 16 * jc, k0, lane), acc);
        *(u32x2*)(YI + co_off(jc, 8, ie, lane)) = pack4(acc); }
#pragma unroll
    for (int tt = 0; tt < 4; ++tt) { const int id = w & 3, je = 4 * (w >> 2) + tt; f32x4 acc = {0.f, 0.f, 0.f, 0.f};
#pragma unroll
        for (int k0 = 0; k0 < 64; k0 += 32) acc = mfma16(frag_tr(Kdi, LD, 16 * id, k0, lane), frag_tr(Vi, LDV, 16 * je, k0, lane), acc);
        *(f32x4*)(Z + fo_st(je, 2, 16 * id, g, r)) = acc; }
    WG_SYNC();
}
__device__ __forceinline__ void ret_stage2(CArgs& a, int b, int tid) {
    const int idx = b * 512 + tid, h = idx >> 13, rem = idx & 8191; const float g64 = exp2f(64.0f * log2f(1.0f - exp2f(-5.0f - (float)h)));
    const float* Z = WSF(WS_RET_Z) + (size_t)h * 8192 + rem; bf16_t* S = (bf16_t*)(a.ws + WS_RET_S) + (size_t)h * 8192 + rem; float s = 0.f;
#pragma unroll 8
    for (int n = 0; n < NCH; ++n) { const float z = Z[(size_t)n * 4 * 8192]; S[(size_t)n * 4 * 8192] = (bf16_t)f2bf(s); s = g64 * s + z; }
}
__device__ __forceinline__ void ret_stage3(CArgs& a, int l, int n, int h, LAS unsigned char* lds, int tid) {
    const int lane = tid & 63, w = __builtin_amdgcn_readfirstlane(tid >> 6), r = lane & 15, g = lane >> 4, jc = w & 3, wh = w >> 2;
    const int tk = n * 4 + h; const int c = 16 * jc + r, t = n * 64 + c;
    const bf16_t* S = (const bf16_t*)(a.ws + WS_RET_S) + (size_t)tk * 8192; const bf16_t* QH = (const bf16_t*)(a.ws + WS_RET_QH) + (size_t)tk * 4096; const bf16_t* YI = (const bf16_t*)(a.ws + WS_RET_YI) + (size_t)tk * 8192;
    LAS float* xs = (LAS float*)lds;
    f32x4 acc[4];
#pragma unroll
    for (int tt = 0; tt < 4; ++tt) { const int ie = 4 * wh + tt; acc[tt] = unpack4(*(const u32x2*)(YI + co_off(jc, 8, ie, lane)));
#pragma unroll
        for (int k = 0; k < 2; ++k) acc[tt] = mfma16(frag_fo(S, 2, ie, k, lane), frag_fo(QH, 2, jc, k, lane), acc[tt]); }
    float s1 = 0.f;
#pragma unroll
    for (int tt = 0; tt < 4; ++tt) s1 += (acc[tt][0] + acc[tt][1]) + (acc[tt][2] + acc[tt][3]);
    s1 += __shfl_xor(s1, 16); s1 += __shfl_xor(s1, 32);
    if (g == 0) xs[w * 16 + r] = s1;
    WG_SYNC();
    const float mu = (s1 + xs[(w ^ 4) * 16 + r]) * (1.0f / 128.0f); float s2 = 0.f;
#pragma unroll
    for (int tt = 0; tt < 4; ++tt)
#pragma unroll
        for (int e = 0; e < 4; ++e) { acc[tt][e] -= mu; s2 += acc[tt][e] * acc[tt][e]; }
    s2 += __shfl_xor(s2, 16); s2 += __shfl_xor(s2, 32);
    if (g == 0) xs[128 + w * 16 + r] = s2;
    WG_SYNC();
    const float rs = 1.0f / sqrtf((s2 + xs[128 + (w ^ 4) * 16 + r]) * (1.0f / 128.0f) + 1e-6f);
    const float* nw = LP(I_RNORM, 512) + h * 128; const bf16_t* pr = PROJROW(t) + C_RG + h * 128; bf16_t* O = (bf16_t*)(a.ws + WS_O) + (size_t)t * D + 512 + h * 128;
#pragma unroll
    for (int tt = 0; tt < 4; ++tt) { const int e0 = 16 * (4 * wh + tt) + 4 * g; const f32x4 gt = unpack4(*(const u32x2*)(pr + e0)); const f32x4 wv = *(const f32x4*)(nw + e0); f32x4 y;
#pragma unroll
        for (int e = 0; e < 4; ++e) y[e] = acc[tt][e] * rs * wv[e] * silu_f(gt[e]);
        *(u32x2*)(O + e0) = pack4(y); }
    WG_SYNC();
}

constexpr int RW_LD = 72;
constexpr int RWO_V = 0, RWO_IMG = 9216, RWO_CUMC = 64512, RWO_CUM = 65536, RWO_AM = 65536, RWO_TRI = 82944, RWO_RHS = 110592, RWO_WX = 143360;
constexpr int RWO_LW = 9216, RWO_LIN = 82944;
__device__ __forceinline__ void rw_stage1(CArgs& a, int l, int n, int h, LAS unsigned char* lds, int tid, const int stop = 99) {
    const int w = __builtin_amdgcn_readfirstlane(tid >> 6), tk = n * 8 + h;
    int lane, r, g, c, kg, t;
#define RW_IDX() do { int tl_ = tid; asm volatile("" : "+v"(tl_)); lane = tl_ & 63; r = lane & 15; g = lane >> 4; c = tl_ >> 3; kg = tl_ & 7; t = n * 64 + c; } while (0)
    RW_IDX();
    LAS bf16_t* Vi = (LAS bf16_t*)(lds + RWO_V);
    LAS bf16_t* RHi = (LAS bf16_t*)(lds + RWO_IMG); LAS bf16_t* BTi = RHi + 64 * RW_LD; LAS bf16_t* KTi = BTi + 64 * RW_LD; LAS bf16_t* KHi = KTi + 64 * RW_LD; LAS bf16_t* BMi = KHi + 64 * RW_LD; LAS bf16_t* KMi = BMi + 64 * RW_LD;
    LAS float* CUMC = (LAS float*)(lds + RWO_CUMC); LAS float* CUM = (LAS float*)(lds + RWO_CUM); LAS float* AM = (LAS float*)(lds + RWO_AM);
    LAS bf16_t* BMI = (LAS bf16_t*)(lds + RWO_TRI); LAS bf16_t* PBI = BMI + 64 * RW_LD; LAS bf16_t* PKI = PBI + 64 * RW_LD;
    LAS float* RHS = (LAS float*)(lds + RWO_RHS); LAS bf16_t* WHi = (LAS bf16_t*)(lds + RWO_WX); LAS bf16_t* Xi = WHi + 64 * RW_LD;
    LAS float* LW = (LAS float*)(lds + RWO_LW); LAS float* LA = LW + 4096; LAS float* LG = LA + 4096;
    LAS bf16_t* WLi = (LAS bf16_t*)(lds + RWO_LIN); LAS bf16_t* ALi = WLi + 64 * 40; LAS bf16_t* GLi = ALi + 64 * 40; LAS bf16_t* WUPi = GLi + 64 * 104; LAS bf16_t* AUPi = WUPi + 32 * RW_LD; LAS bf16_t* GUPi = AUPi + 32 * RW_LD;
    const float* mu = LP(I_RWMU, 1696); const bf16_t* p1 = PROJROW(t) + C_RW; const bf16_t* p0 = p1 - PTP; bool hp = t > 0;
    float vv[8];
    { const v4u cu = *(const v4u*)(p1 + 1024 + 64 * h + 8 * kg); v4u pv = {0u, 0u, 0u, 0u}; if (hp) pv = *(const v4u*)(p0 + 1024 + 64 * h + 8 * kg);
      const float* m = mu + 1024 + 64 * h + 8 * kg; v4u o;
#pragma unroll
      for (int u = 0; u < 4; ++u) { const unsigned cw = cu[u], pw = pv[u]; const float c0 = __uint_as_float(cw << 16), c1 = __uint_as_float(cw & 0xffff0000u), q0 = __uint_as_float(pw << 16), q1 = __uint_as_float(pw & 0xffff0000u);
          vv[2 * u] = c0 + (q0 - c0) * m[2 * u]; vv[2 * u + 1] = c1 + (q1 - c1) * m[2 * u + 1]; o[u] = pk2(vv[2 * u], vv[2 * u + 1]); }
      *(LAS v4u*)(Vi + c * RW_LD + 8 * kg) = o; }
    { float x[4];
#pragma unroll
      for (int u = 0; u < 4; ++u) { const int col = 1536 + 4 * kg + u; const float cur = bf2f(p1[col]), prev = hp ? bf2f(p0[col]) : 0.f; x[u] = tanhf(cur + (prev - cur) * mu[col]); }
      *(LAS u32x2*)(WLi + c * 40 + 4 * kg) = (u32x2){pk2(x[0], x[1]), pk2(x[2], x[3])};
#pragma unroll
      for (int u = 0; u < 4; ++u) { const int col = 1568 + 4 * kg + u; const float cur = bf2f(p1[col]), prev = hp ? bf2f(p0[col]) : 0.f; x[u] = cur + (prev - cur) * mu[col]; }
      *(LAS u32x2*)(ALi + c * 40 + 4 * kg) = (u32x2){pk2(x[0], x[1]), pk2(x[2], x[3])};
#pragma unroll
      for (int q = 0; q < 3; ++q) {
#pragma unroll
          for (int u = 0; u < 4; ++u) { const int col = 1600 + 12 * kg + 4 * q + u; const float cur = bf2f(p1[col]), prev = hp ? bf2f(p0[col]) : 0.f; x[u] = sigmoid_f(cur + (prev - cur) * mu[col]); }
          *(LAS u32x2*)(GLi + c * 104 + 12 * kg + 4 * q) = (u32x2){pk2(x[0], x[1]), pk2(x[2], x[3])}; } }
    { const int j = tid >> 4, k4 = (tid & 15) * 4;
      const f32x4 wv = *(const f32x4*)(LP(I_RWWUP, 32 * 512) + j * 512 + 64 * h + k4), av = *(const f32x4*)(LP(I_RWAUP, 32 * 512) + j * 512 + 64 * h + k4);
      *(LAS u32x2*)(WUPi + j * RW_LD + k4) = pack4(wv); *(LAS u32x2*)(AUPi + j * RW_LD + k4) = pack4(av);
#pragma unroll
      for (int q = 0; q < 3; ++q) { const f32x4 gv = *(const f32x4*)(LP(I_RWGUP, 96 * 512) + (32 * q + j) * 512 + 64 * h + k4); *(LAS u32x2*)(GUPi + (32 * q + j) * RW_LD + k4) = pack4(gv); } }
    WG_SYNC();
    if (stop <= 0) return;
    RW_IDX();
#pragma unroll
    for (int tt = 0; tt < 2; ++tt) { const int tile = 2 * w + tt, ik = tile >> 2, jc = tile & 3;
        f32x4 aw = {0.f, 0.f, 0.f, 0.f}, aa = aw, ag = aw;
        aw = mfma16(frag_tr(WUPi, RW_LD, 16 * ik, 0, lane), frag_row(WLi, 40, 16 * jc, 0, lane), aw);
        aa = mfma16(frag_tr(AUPi, RW_LD, 16 * ik, 0, lane), frag_row(ALi, 40, 16 * jc, 0, lane), aa);
#pragma unroll
        for (int k0 = 0; k0 < 96; k0 += 32) ag = mfma16(frag_tr(GUPi, RW_LD, 16 * ik, k0, lane), frag_row(GLi, 104, 16 * jc, k0, lane), ag);
        const int o = (16 * jc + r) * 64 + 16 * ik + 4 * g; *(LAS f32x4*)(LW + o) = aw; *(LAS f32x4*)(LA + o) = aa; *(LAS f32x4*)(LG + o) = ag; }
    WG_SYNC();
    if (stop <= 1) return;
    RW_IDX();
    p1 = PROJROW(t) + C_RW; p0 = p1 - PTP; hp = t > 0;
    float rr[8], kk[8], bb[8], kt[8], lwd[8];
    { const int ch0 = 64 * h + 8 * kg; float ss = 0.f, rk = 0.f; float gt[8];
      const v4u cr = *(const v4u*)(p1 + ch0), ck = *(const v4u*)(p1 + 512 + ch0); v4u qr = {0u, 0u, 0u, 0u}, qk = qr; if (hp) { qr = *(const v4u*)(p0 + ch0); qk = *(const v4u*)(p0 + 512 + ch0); }
#pragma unroll
      for (int u = 0; u < 8; ++u) { const int ch = ch0 + u; const unsigned crw = cr[u >> 1], ckw = ck[u >> 1], qrw = qr[u >> 1], qkw = qk[u >> 1];
          const float curR = (u & 1) ? __uint_as_float(crw & 0xffff0000u) : __uint_as_float(crw << 16), curK = (u & 1) ? __uint_as_float(ckw & 0xffff0000u) : __uint_as_float(ckw << 16);
          const float prvR = (u & 1) ? __uint_as_float(qrw & 0xffff0000u) : __uint_as_float(qrw << 16), prvK = (u & 1) ? __uint_as_float(qkw & 0xffff0000u) : __uint_as_float(qkw << 16);
          const float rv = curR + (prvR - curR) * mu[ch], kr = curK + (prvK - curK) * mu[512 + ch];
          const float lw = LW[c * 64 + 8 * kg + u], la = LA[c * 64 + 8 * kg + u]; gt[u] = LG[c * 64 + 8 * kg + u];
          const float wraw = -softplus_f(-(LP(I_RWW0, 512)[ch] + lw)) - 0.5f; lwd[u] = -fexp(wraw);
          const float av = sigmoid_f(LP(I_RWA0, 512)[ch] + la); const float kkr = kr * LP(I_RWKK, 512)[ch]; kt[u] = kr * (1.0f + (av - 1.0f) * LP(I_RWKA, 512)[ch]);
          rr[u] = rv; kk[u] = kkr; bb[u] = av; ss += kkr * kkr; rk += rv * kt[u] * LP(I_RWRK, 512)[ch]; }
      ss += __shfl_xor(ss, 1); ss += __shfl_xor(ss, 2); ss += __shfl_xor(ss, 4); rk += __shfl_xor(rk, 1); rk += __shfl_xor(rk, 2); rk += __shfl_xor(rk, 4);
      const float inv = 1.0f / sqrtf(ss + 1e-6f);
#pragma unroll
      for (int u = 0; u < 8; ++u) { kk[u] *= inv; bb[u] *= kk[u]; }
      *(LAS f32x4*)(CUM + c * 64 + 8 * kg) = (f32x4){lwd[0], lwd[1], lwd[2], lwd[3]}; *(LAS f32x4*)(CUM + c * 64 + 8 * kg + 4) = (f32x4){lwd[4], lwd[5], lwd[6], lwd[7]};
      v4u eo, go;
#pragma unroll
      for (int u = 0; u < 4; ++u) { eo[u] = pk2(rk * vv[2 * u], rk * vv[2 * u + 1]); go[u] = pk2(gt[2 * u], gt[2 * u + 1]); }
      bf16_t* Eo = (bf16_t*)(a.ws + WS_RW_E) + (size_t)tk * 4096; bf16_t* Go = (bf16_t*)(a.ws + WS_RW_GT) + (size_t)tk * 4096;
#pragma unroll
      for (int hf = 0; hf < 2; ++hf) { const int o = (((c >> 4) * 4 + (kg >> 1)) * 64 + ((2 * kg + hf) & 3) * 16 + (c & 15)) * 4;
          *(u32x2*)(Eo + o) = (u32x2){eo[2 * hf], eo[2 * hf + 1]}; *(u32x2*)(Go + o) = (u32x2){go[2 * hf], go[2 * hf + 1]}; } }
    WG_SYNC();
    if (stop <= 2) return;
    RW_IDX();
    { const int tq_ = c * 8 + kg; if (tq_ < 64) { float cu = 0.f;
#pragma unroll 8
        for (int cc = 0; cc < 64; ++cc) { cu += CUM[cc * 64 + tq_]; CUM[cc * 64 + tq_] = cu; }
        CUMC[tq_] = cu; } }
    WG_SYNC();
    if (stop <= 3) return;
    RW_IDX();
    { v4u oRH, oBT, oKT, oKH, oBM, oKM; float kh[8];
#pragma unroll
      for (int u = 0; u < 8; u += 2) { float x[6][2];
#pragma unroll
          for (int e = 0; e < 2; ++e) { const float cu = CUM[c * 64 + 8 * kg + u + e], cc = CUMC[8 * kg + u + e]; const float ep = fexp(cu), em = fexp(-cu), et = fexp(cc - cu), ex = fexp(cu - lwd[u + e]);
              x[0][e] = rr[u + e] * ep; x[1][e] = bb[u + e] * et; x[2][e] = kt[u + e] * et; x[3][e] = kk[u + e] * ex; x[4][e] = bb[u + e] * em; x[5][e] = kt[u + e] * em; kh[u + e] = x[3][e]; }
          oRH[u >> 1] = pk2(x[0][0], x[0][1]); oBT[u >> 1] = pk2(x[1][0], x[1][1]); oKT[u >> 1] = pk2(x[2][0], x[2][1]); oKH[u >> 1] = pk2(x[3][0], x[3][1]); oBM[u >> 1] = pk2(x[4][0], x[4][1]); oKM[u >> 1] = pk2(x[5][0], x[5][1]); }
      const int o = c * RW_LD + 8 * kg;
      *(LAS v4u*)(RHi + o) = oRH; *(LAS v4u*)(BTi + o) = oBT; *(LAS v4u*)(KTi + o) = oKT; *(LAS v4u*)(KHi + o) = oKH; *(LAS v4u*)(BMi + o) = oBM; *(LAS v4u*)(KMi + o) = oKM;
      *(LAS f32x4*)(RHS + c * 128 + 8 * kg) = (f32x4){kh[0], kh[1], kh[2], kh[3]}; *(LAS f32x4*)(RHS + c * 128 + 8 * kg + 4) = (f32x4){kh[4], kh[5], kh[6], kh[7]}; }
    WG_SYNC();
    if (stop <= 4) return;
    RW_IDX();
#pragma unroll
    for (int tt = 0; tt < 2; ++tt) { const int tile = 2 * w + tt, ii = tile >> 2, jt = tile & 3;
        f32x4 cA = {0.f, 0.f, 0.f, 0.f}, cB = cA, cPb = cA, cPk = cA;
        if (ii <= jt) {
#pragma unroll
            for (int k0 = 0; k0 < 64; k0 += 32) { const bf16x8 fbm = frag_row(BMi, RW_LD, 16 * ii, k0, lane), fkm = frag_row(KMi, RW_LD, 16 * ii, k0, lane), fkh = frag_row(KHi, RW_LD, 16 * jt, k0, lane), frh = frag_row(RHi, RW_LD, 16 * jt, k0, lane);
                cA = mfma16(fbm, fkh, cA); cB = mfma16(fkm, fkh, cB); cPb = mfma16(fbm, frh, cPb); cPk = mfma16(fkm, frh, cPk); }
#pragma unroll
            for (int e = 0; e < 4; ++e) { const int i = 16 * ii + 4 * g + e, tq = 16 * jt + r; if (!(i < tq)) { cA[e] = 0.f; cB[e] = 0.f; } if (!(i <= tq)) { cPb[e] = 0.f; cPk[e] = 0.f; } } }
        const int tq = 16 * jt + r, i0 = 16 * ii + 4 * g;
        *(LAS f32x4*)(AM + tq * 68 + i0) = cA; *(LAS u32x2*)(BMI + tq * RW_LD + i0) = pack4(cB); *(LAS u32x2*)(PBI + tq * RW_LD + i0) = pack4(cPb); *(LAS u32x2*)(PKI + tq * RW_LD + i0) = pack4(cPk); }
    WG_SYNC();
    if (stop <= 5) return;
    RW_IDX();
#pragma unroll
    for (int tt = 0; tt < 2; ++tt) { const int tile = 2 * w + tt, iv = tile >> 2, jt = tile & 3; f32x4 acc = {0.f, 0.f, 0.f, 0.f};
#pragma unroll
        for (int k0 = 0; k0 < 64; k0 += 32) acc = mfma16(frag_tr(Vi, RW_LD, 16 * iv, k0, lane), frag_row(BMI, RW_LD, 16 * jt, k0, lane), acc);
        *(LAS f32x4*)(RHS + (16 * jt + r) * 128 + 64 + 16 * iv + 4 * g) = acc; }
    WG_SYNC();
    if (stop <= 6) return;
    RW_IDX();
    { const int col = c * 8 + kg; if (col < 128) { float x[64];
#pragma unroll
        for (int i = 0; i < 64; ++i) x[i] = 0.f;
        int vz = 0; asm volatile("" : "+v"(vz));
        const LAS float* AMv = AM + vz;
        LAS bf16_t* dst = col < 64 ? WHi + col : Xi + (col - 64);
#pragma unroll
        for (int tq = 0; tq < 64; ++tq) { float acc = RHS[tq * 128 + col];
#pragma unroll
            for (int i = 0; i < ((tq + 3) & ~3); i += 4) { const f32x4 av = *(const LAS f32x4*)(AMv + tq * 68 + i); acc -= av[0] * x[i]; acc -= av[1] * x[i + 1]; acc -= av[2] * x[i + 2]; acc -= av[3] * x[i + 3]; }
            x[tq] = acc; dst[tq * RW_LD] = (bf16_t)f2bf(acc); } } }
    WG_SYNC();
    if (stop <= 7) return;
    RW_IDX();
    { const int o = w >> 1;
#pragma unroll
      for (int tt = 0; tt < 8; ++tt) { const int tile = (w & 1) * 8 + tt, ti = tile >> 2, tj = tile & 3; f32x4 c1 = {0.f, 0.f, 0.f, 0.f}, c2 = c1;
          if (o == 0) {
#pragma unroll
              for (int k0 = 0; k0 < 64; k0 += 32) c1 = mfma16(frag_tr(WHi, RW_LD, 16 * ti, k0, lane), frag_tr(BTi, RW_LD, 16 * tj, k0, lane), c1);
              const int kq = 16 * tj + r; const float dg = fexp(CUMC[kq]); f32x4 gv;
#pragma unroll
              for (int e = 0; e < 4; ++e) gv[e] = ((16 * ti + 4 * g + e) == kq ? dg : 0.f) - c1[e];
              *(u32x2*)((bf16_t*)(a.ws + WS_RW_G) + (size_t)tk * 4096 + fo_st(tj, 2, 16 * ti, g, r)) = pack4(gv);
          } else if (o == 1) {
#pragma unroll
              for (int k0 = 0; k0 < 64; k0 += 32) { c1 = mfma16(frag_tr(KTi, RW_LD, 16 * ti, k0, lane), frag_tr(Vi, RW_LD, 16 * tj, k0, lane), c1); c2 = mfma16(frag_tr(BTi, RW_LD, 16 * ti, k0, lane), frag_tr(Xi, RW_LD, 16 * tj, k0, lane), c2); }
              *(f32x4*)(WSF(WS_RW_Z) + (size_t)tk * 4096 + co_off(tj, 4, ti, lane)) = c1 - c2;
          } else if (o == 2) {
#pragma unroll
              for (int k0 = 0; k0 < 64; k0 += 32) c1 = mfma16(frag_tr(WHi, RW_LD, 16 * ti, k0, lane), frag_row(PBI, RW_LD, 16 * tj, k0, lane), c1);
              const int tq = 16 * tj + r; const f32x4 rh = unpack4(*(const LAS u32x2*)(RHi + tq * RW_LD + 16 * ti + 4 * g));
              *(u32x2*)((bf16_t*)(a.ws + WS_RW_QT) + (size_t)tk * 4096 + fo_st(tj, 2, 16 * ti, g, r)) = pack4(rh - c1);
          } else {
#pragma unroll
              for (int k0 = 0; k0 < 64; k0 += 32) { c1 = mfma16(frag_tr(Vi, RW_LD, 16 * ti, k0, lane), frag_row(PKI, RW_LD, 16 * tj, k0, lane), c1); c2 = mfma16(frag_tr(Xi, RW_LD, 16 * ti, k0, lane), frag_row(PBI, RW_LD, 16 * tj, k0, lane), c2); }
              *(u32x2*)((bf16_t*)(a.ws + WS_RW_YI) + (size_t)tk * 4096 + co_off(tj, 4, ti, lane)) = pack4(c1 - c2);
          } } }
    WG_SYNC();
#undef RW_IDX
}
__device__ __forceinline__ void rw_stage2(CArgs& a, int h, int vs, LAS unsigned char* lds, int tid) {
    const int lane = tid & 63, w = __builtin_amdgcn_readfirstlane(tid >> 6), r = lane & 15, g = lane >> 4;
    LAS bf16_t* Si = (LAS bf16_t*)lds;
    const bf16_t* G = (const bf16_t*)(a.ws + WS_RW_G); const float* Z = WSF(WS_RW_Z); bf16_t* S = (bf16_t*)(a.ws + WS_RW_S);
    if (w < 4) { *(LAS u32x2*)(Si + r * RW_LD + 16 * w + 4 * g) = (u32x2){0u, 0u}; *(u32x2*)(S + (size_t)h * 4096 + fo_st(vs, 2, 16 * w, g, r)) = (u32x2){0u, 0u}; }
    WG_SYNC();
    constexpr int PD = 8; const int wq = w & 3; const int so = fo_st(vs, 2, 16 * wq, g, r), zo = co_off(vs, 4, wq, lane);
    bf16x8 gf[PD][2]; f32x4 zf[PD];
#pragma unroll
    for (int u = 0; u < PD; ++u) { const size_t tk = (size_t)u * 8 + h; zf[u] = *(const f32x4*)(Z + tk * 4096 + zo); gf[u][0] = frag_fo(G + tk * 4096, 2, wq, 0, lane); gf[u][1] = frag_fo(G + tk * 4096, 2, wq, 1, lane); }
#define RW_STEP(n_, u_, REFILL) do { const int n = (n_); const size_t tk = (size_t)n * 8 + h; const int cur = n & 1; \
            f32x4 acc = zf[u_], acc2 = {0.f, 0.f, 0.f, 0.f}; \
            acc = mfma16(gf[u_][0], frag_row(Si + cur * 16 * RW_LD, RW_LD, 0, 0, lane), acc); acc2 = mfma16(gf[u_][1], frag_row(Si + cur * 16 * RW_LD, RW_LD, 0, 32, lane), acc2); \
            if (REFILL) { const int nn = n + PD < NCH - 1 ? n + PD : NCH - 2; const size_t tn = (size_t)nn * 8 + h; zf[u_] = *(const f32x4*)(Z + tn * 4096 + zo); gf[u_][0] = frag_fo(G + tn * 4096, 2, wq, 0, lane); gf[u_][1] = frag_fo(G + tn * 4096, 2, wq, 1, lane); } \
            const u32x2 pv = pack4(acc + acc2); \
            if (w < 4) { *(LAS u32x2*)(Si + (cur ^ 1) * 16 * RW_LD + r * RW_LD + 16 * wq + 4 * g) = pv; *(u32x2*)(S + (tk + 8) * 4096 + so) = pv; } \
            asm volatile("s_waitcnt lgkmcnt(0)" ::: "memory"); __builtin_amdgcn_s_barrier(); asm volatile("" ::: "memory"); } while (0)
#pragma unroll
    for (int nq = 0; nq < NCH - 1; ++nq) RW_STEP(nq, nq % PD, nq + PD < NCH - 1);
#undef RW_STEP
}
__device__ __forceinline__ void rw_stage3(CArgs& a, int l, int n, int h, LAS unsigned char* lds, int tid) {
    const int lane = tid & 63, w = __builtin_amdgcn_readfirstlane(tid >> 6), r = lane & 15, g = lane >> 4, jc = w & 3, wh = w >> 2;
    const size_t tk = (size_t)n * 8 + h; const int c = 16 * jc + r, t = n * 64 + c;
    const bf16_t* S = (const bf16_t*)(a.ws + WS_RW_S) + tk * 4096; const bf16_t* QT = (const bf16_t*)(a.ws + WS_RW_QT) + tk * 4096; const bf16_t* YI = (const bf16_t*)(a.ws + WS_RW_YI) + tk * 4096;
    LAS float* xs = (LAS float*)lds;
    f32x4 acc[2];
#pragma unroll
    for (int tt = 0; tt < 2; ++tt) { const int iv = 2 * wh + tt; acc[tt] = unpack4(*(const u32x2*)(YI + co_off(jc, 4, iv, lane)));
#pragma unroll
        for (int k = 0; k < 2; ++k) acc[tt] = mfma16(frag_fo(S, 2, iv, k, lane), frag_fo(QT, 2, jc, k, lane), acc[tt]); }
    float s1 = (acc[0][0] + acc[0][1]) + (acc[0][2] + acc[0][3]) + (acc[1][0] + acc[1][1]) + (acc[1][2] + acc[1][3]);
    s1 += __shfl_xor(s1, 16); s1 += __shfl_xor(s1, 32);
    if (g == 0) xs[w * 16 + r] = s1;
    WG_SYNC();
    const float mu = (s1 + xs[(w ^ 4) * 16 + r]) * (1.0f / 64.0f); float s2 = 0.f;
#pragma unroll
    for (int tt = 0; tt < 2; ++tt)
#pragma unroll
        for (int e = 0; e < 4; ++e) { acc[tt][e] -= mu; s2 += acc[tt][e] * acc[tt][e]; }
    s2 += __shfl_xor(s2, 16); s2 += __shfl_xor(s2, 32);
    if (g == 0) xs[128 + w * 16 + r] = s2;
    WG_SYNC();
    const float rs = 1.0f / sqrtf((s2 + xs[128 + (w ^ 4) * 16 + r]) * (1.0f / 64.0f) + 64e-5f);
    const bf16_t* E = (const bf16_t*)(a.ws + WS_RW_E) + tk * 4096; const bf16_t* GT = (const bf16_t*)(a.ws + WS_RW_GT) + tk * 4096;
    bf16_t* O = (bf16_t*)(a.ws + WS_O) + (size_t)t * D + 1536 + h * 64;
#pragma unroll
    for (int tt = 0; tt < 2; ++tt) { const int v0 = 16 * (2 * wh + tt) + 4 * g; const int eo_ = co_off(jc, 4, 2 * wh + tt, lane); const f32x4 ev = unpack4(*(const u32x2*)(E + eo_)), gv = unpack4(*(const u32x2*)(GT + eo_));
        const f32x4 lw = *(const f32x4*)(LP(I_RWLNW, 512) + h * 64 + v0), lb = *(const f32x4*)(LP(I_RWLNB, 512) + h * 64 + v0); f32x4 y;
#pragma unroll
        for (int e = 0; e < 4; ++e) y[e] = (acc[tt][e] * rs * lw[e] + lb[e] + ev[e]) * gv[e];
        *(u32x2*)(O + v0) = pack4(y); }
    WG_SYNC();
}

constexpr int M2_LDS = 136, M2_LDX = 264, M2O_B = 0, M2O_C = 17408, M2O_X = 34816, M2O_XW = 68608, M2O_M = 102400, M2O_DT = 139264, M2O_G = 140288, M2O_GL = 141312;
__device__ __forceinline__ void m2_stage1(CArgs& a, int l, int n, int gr, LAS unsigned char* lds, int tid) {
    const int lane = tid & 63, w = __builtin_amdgcn_readfirstlane(tid >> 6), r = lane & 15, g = lane >> 4;
    LAS bf16_t* Bi = (LAS bf16_t*)(lds + M2O_B); LAS bf16_t* Ci = (LAS bf16_t*)(lds + M2O_C); LAS bf16_t* Xi = (LAS bf16_t*)(lds + M2O_X); LAS bf16_t* XWi = (LAS bf16_t*)(lds + M2O_XW); LAS bf16_t* Mi = (LAS bf16_t*)(lds + M2O_M);
    LAS float* DT = (LAS float*)(lds + M2O_DT); LAS float* GC = (LAS float*)(lds + M2O_G); LAS float* GLAST = (LAS float*)(lds + M2O_GL);
    const int t0 = n * 64;
    LAS bf16_t* RAW = (LAS bf16_t*)(lds + M2O_XW);
    for (int idx = tid; idx < 67 * 64; idx += 512) { const int row = idx >> 6, ch = idx & 63, t = t0 - 3 + row; v4u v = {0u, 0u, 0u, 0u};
        const int col = ch < 32 ? gr * 256 + 8 * ch : (ch < 48 ? 512 + gr * 128 + 8 * (ch - 32) : 768 + gr * 128 + 8 * (ch - 48));
        if (t >= 0) v = *(const v4u*)(PROJROW(t) + C_MXBC + col);
        *(LAS v4u*)(RAW + row * 512 + 8 * ch) = v; }
    WG_SYNC();
    for (int it = tid; it < 512 * 4; it += 512) { const int lc = it & 511, seg = it >> 9; int col; LAS bf16_t* dst; int dld;
      if (lc < 256) { col = gr * 256 + lc; dst = Xi + lc; dld = M2_LDX; } else if (lc < 384) { col = 512 + gr * 128 + (lc - 256); dst = Bi + (lc - 256); dld = M2_LDS; } else { col = 768 + gr * 128 + (lc - 384); dst = Ci + (lc - 384); dld = M2_LDS; }
      const float* cw = LP(I_MCONV, 4 * 1024) + col; const float w0 = cw[0], w1 = cw[1024], w2 = cw[2048], w3 = cw[3072], cb = LP(I_MCONVB, 1024)[col];
      const LAS bf16_t* src = RAW + (16 * seg) * 512 + lc;
      float x0 = bf2f(src[0]), x1 = bf2f(src[512]), x2 = bf2f(src[1024]);
#pragma unroll
      for (int cc = 0; cc < 16; ++cc) { const float x3 = bf2f(src[(cc + 3) * 512]); const float y = silu_f(w0 * x0 + w1 * x1 + w2 * x2 + w3 * x3 + cb); dst[(16 * seg + cc) * dld] = (bf16_t)f2bf(y); x0 = x1; x1 = x2; x2 = x3; } }
    if (tid < 256) { const int c = tid >> 2, hh = tid & 3, hd = gr * 4 + hh; const float dt = softplus_f(bf2f(PROJROW(t0 + c)[C_MDT + hd]) + LP(I_MDTB, 8)[hd]); DT[c * 4 + hh] = dt; GC[c * 4 + hh] = -fexp(LP(I_MALOG, 8)[hd]) * dt; }
    WG_SYNC();
    if (tid < 4) { float cu = 0.f; for (int c = 0; c < 64; ++c) { cu += GC[c * 4 + tid]; GC[c * 4 + tid] = cu; } GLAST[tid] = cu; WSF(WS_M2_DEC)[n * 8 + gr * 4 + tid] = fexp(cu); }
    WG_SYNC();
    { const int c = tid >> 3, q = tid & 7;
      const int hh = q >> 1; const float sc = DT[c * 4 + hh] * fexp(GLAST[hh] - GC[c * 4 + hh]);
#pragma unroll
      for (int u = 0; u < 4; ++u) { const v4u xv = *(const LAS v4u*)(Xi + c * M2_LDX + 32 * q + 8 * u); v4u o;
#pragma unroll
          for (int e = 0; e < 4; ++e) o[e] = pk2(__uint_as_float(xv[e] << 16) * sc, __uint_as_float(xv[e] & 0xffff0000u) * sc);
          *(LAS v4u*)(XWi + c * M2_LDX + 32 * q + 8 * u) = o; }
      const float eg = fexp(GC[c * 4 + hh]); bf16_t* QH = (bf16_t*)(a.ws + WS_M2_QH) + (size_t)(n * 8 + gr * 4 + hh) * 8192;
#pragma unroll
      for (int u = 0; u < 8; ++u) { const v4u cv = *(const LAS v4u*)(Ci + c * M2_LDS + 64 * (q & 1) + 8 * u); v4u o;
#pragma unroll
          for (int e = 0; e < 4; ++e) o[e] = pk2(__uint_as_float(cv[e] << 16) * eg, __uint_as_float(cv[e] & 0xffff0000u) * eg);
          { const int s0 = 64 * (q & 1) + 8 * u; *(v4u*)(QH + (((c >> 4) * 4 + (s0 >> 5)) * 64 + ((s0 >> 3) & 3) * 16 + (c & 15)) * 8) = o; } } }
#pragma unroll
    for (int tt = 0; tt < 2; ++tt) { const int tile = 2 * w + tt, im = tile >> 2, jc = tile & 3; f32x4 acc = {0.f, 0.f, 0.f, 0.f};
        if (jc >= im) {
#pragma unroll
            for (int k0 = 0; k0 < 128; k0 += 32) acc = mfma16(frag_row(Bi, M2_LDS, 16 * im, k0, lane), frag_row(Ci, M2_LDS, 16 * jc, k0, lane), acc); }
        const int cq = 16 * jc + r;
#pragma unroll
        for (int hh = 0; hh < 4; ++hh) { f32x4 mv; const float gc = GC[cq * 4 + hh];
#pragma unroll
            for (int e = 0; e < 4; ++e) { const int m = 16 * im + 4 * g + e; mv[e] = cq >= m ? acc[e] * fexp(gc - GC[m * 4 + hh]) * DT[m * 4 + hh] : 0.f; }
            *(LAS u32x2*)(Mi + hh * 64 * 72 + cq * 72 + 16 * im + 4 * g) = pack4(mv); } }
    WG_SYNC();
    { const int hh = w >> 1, hd = gr * 4 + hh; const size_t tk = (size_t)n * 8 + hd; const float Dh = LP(I_MD, 8)[hd];
      bf16_t* YI = (bf16_t*)(a.ws + WS_M2_YI) + tk * 4096; float* Z = WSF(WS_M2_Z) + tk * 8192;
#pragma unroll
      for (int tt = 0; tt < 8; ++tt) { const int tile = (w & 1) * 8 + tt, ip = tile >> 2, jc = tile & 3; f32x4 acc = {0.f, 0.f, 0.f, 0.f};
#pragma unroll
          for (int k0 = 0; k0 < 64; k0 += 32) acc = mfma16(frag_tr(Xi, M2_LDX, 64 * hh + 16 * ip, k0, lane), frag_row(Mi + hh * 64 * 72, 72, 16 * jc, k0, lane), acc);
          const int cq = 16 * jc + r; const f32x4 xv = unpack4(*(const LAS u32x2*)(Xi + cq * M2_LDX + 64 * hh + 16 * ip + 4 * g));
          *(u32x2*)(YI + co_off(jc, 4, ip, lane)) = pack4(acc + xv * Dh); }
#pragma unroll
      for (int tt = 0; tt < 16; ++tt) { const int tile = (w & 1) * 16 + tt, is = tile >> 2, jp = tile & 3; f32x4 acc = {0.f, 0.f, 0.f, 0.f};
#pragma unroll
          for (int k0 = 0; k0 < 64; k0 += 32) acc = mfma16(frag_tr(Bi, M2_LDS, 16 * is, k0, lane), frag_tr(XWi, M2_LDX, 64 * hh + 16 * jp, k0, lane), acc);
          *(f32x4*)(Z + fo_st(jp, 4, 16 * is, g, r)) = acc; } }
    WG_SYNC();
}
__device__ __forceinline__ void m2_stage2(CArgs& a, int b, int tid) {
    const int idx = b * 512 + tid, hd = idx >> 13, rem = idx & 8191;
    const float* Z = WSF(WS_M2_Z) + (size_t)hd * 8192 + rem; bf16_t* S = (bf16_t*)(a.ws + WS_M2_S) + (size_t)hd * 8192 + rem; const float* DEC = WSF(WS_M2_DEC) + hd; float s = 0.f;
#pragma unroll 8
    for (int n = 0; n < NCH; ++n) { const float z = Z[(size_t)n * 8 * 8192], dc = DEC[n * 8]; S[(size_t)n * 8 * 8192] = (bf16_t)f2bf(s); s = dc * s + z; }
}
__device__ __forceinline__ void m2_stage3(CArgs& a, int l, int n, int gr, LAS unsigned char* lds, int tid) {
    const int lane = tid & 63, w = __builtin_amdgcn_readfirstlane(tid >> 6), r = lane & 15, g = lane >> 4, hh = w >> 1, hd = gr * 4 + hh;
    const size_t tk = (size_t)n * 8 + hd;
    const bf16_t* S = (const bf16_t*)(a.ws + WS_M2_S) + tk * 8192; const bf16_t* QH = (const bf16_t*)(a.ws + WS_M2_QH) + tk * 8192; const bf16_t* YI = (const bf16_t*)(a.ws + WS_M2_YI) + tk * 4096;
    LAS float* xs = (LAS float*)lds;
    f32x4 acc[2][4]; float ss[2];
#pragma unroll
    for (int cj = 0; cj < 2; ++cj) { const int jc = 2 * (w & 1) + cj, c = 16 * jc + r, t = n * 64 + c; const bf16_t* pz = PROJROW(t) + C_MZ + hd * 64; ss[cj] = 0.f;
#pragma unroll
        for (int ip = 0; ip < 4; ++ip) { acc[cj][ip] = unpack4(*(const u32x2*)(YI + co_off(jc, 4, ip, lane)));
#pragma unroll
            for (int k = 0; k < 4; ++k) acc[cj][ip] = mfma16(frag_fo(S, 4, ip, k, lane), frag_fo(QH, 4, jc, k, lane), acc[cj][ip]);
            const f32x4 zv = unpack4(*(const u32x2*)(pz + 16 * ip + 4 * g));
#pragma unroll
            for (int e = 0; e < 4; ++e) { acc[cj][ip][e] *= silu_f(zv[e]); ss[cj] += acc[cj][ip][e] * acc[cj][ip][e]; } }
        ss[cj] += __shfl_xor(ss[cj], 16); ss[cj] += __shfl_xor(ss[cj], 32);
        if (g == 0) xs[w * 32 + cj * 16 + r] = ss[cj]; }
    WG_SYNC();
#pragma unroll
    for (int cj = 0; cj < 2; ++cj) { const int jc = 2 * (w & 1) + cj, c = 16 * jc + r, t = n * 64 + c;
        const float tot = xs[((w & 1) + 0) * 32 + cj * 16 + r] + xs[((w & 1) + 2) * 32 + cj * 16 + r] + xs[((w & 1) + 4) * 32 + cj * 16 + r] + xs[((w & 1) + 6) * 32 + cj * 16 + r];
        const float rs = 1.0f / sqrtf(tot * (1.0f / 256.0f) + 1e-6f);
        const float* nw = LP(I_MNORM, 512) + hd * 64; bf16_t* O = (bf16_t*)(a.ws + WS_O) + (size_t)t * D + 1024 + hd * 64;
#pragma unroll
        for (int ip = 0; ip < 4; ++ip) { const f32x4 wv = *(const f32x4*)(nw + 16 * ip + 4 * g); f32x4 y;
#pragma unroll
            for (int e = 0; e < 4; ++e) y[e] = acc[cj][ip][e] * rs * wv[e];
            *(u32x2*)(O + 16 * ip + 4 * g) = pack4(y); } }
    WG_SYNC();
}

constexpr int GD_LD = 136;
constexpr int GDO_K = 0, GDO_V = 17408, GDO_KT = 34816, GDO_QG = 52224, GDO_Q = 69632, GDO_AM = 87040, GDO_AQ = 104448, GDO_U = 113664, GDO_W = 131072, GDO_QF = 87040, GDO_KF = 119808, GDO_SM = 152576;
__device__ __forceinline__ void gd_stage1(CArgs& a, int l, int n, int h, LAS unsigned char* lds, int tid) {
    const int w = __builtin_amdgcn_readfirstlane(tid >> 6), tk = n * 4 + h, t0 = n * 64;
    int lane, r, g, c, q8;
#define GD_IDX() do { int tl_ = tid; asm volatile("" : "+v"(tl_)); lane = tl_ & 63; r = lane & 15; g = lane >> 4; c = tl_ >> 3; q8 = tl_ & 7; } while (0)
    LAS bf16_t* Ki = (LAS bf16_t*)(lds + GDO_K); LAS bf16_t* Vi = (LAS bf16_t*)(lds + GDO_V); LAS bf16_t* KTi = (LAS bf16_t*)(lds + GDO_KT); LAS bf16_t* QGi = (LAS bf16_t*)(lds + GDO_QG); LAS bf16_t* Qi = (LAS bf16_t*)(lds + GDO_Q);
    LAS float* AM = (LAS float*)(lds + GDO_AM); LAS bf16_t* AQ = (LAS bf16_t*)(lds + GDO_AQ); LAS bf16_t* Ui = (LAS bf16_t*)(lds + GDO_U); LAS bf16_t* Wi = (LAS bf16_t*)(lds + GDO_W);
    LAS float* QF = (LAS float*)(lds + GDO_QF); LAS float* KF = (LAS float*)(lds + GDO_KF);
    LAS float* BETA = (LAS float*)(lds + GDO_SM); LAS float* GC = BETA + 64; LAS float* BG = GC + 64;
    LAS bf16_t* RAW = (LAS bf16_t*)(lds + GDO_KT);
    for (int idx = tid; idx < 67 * 48; idx += 512) { const int row = idx / 48, ch = idx % 48, which = ch >> 4, t = t0 - 3 + row; v4u v = {0u, 0u, 0u, 0u};
        if (t >= 0) v = *(const v4u*)(PROJROW(t) + C_GQ + which * 512 + h * 128 + 8 * (ch & 15));
        *(LAS v4u*)(RAW + row * 384 + 8 * ch) = v; }
    WG_SYNC();
    for (int it = tid; it < 384 * 4; it += 512) { const int col = it % 384, seg = it / 384, which = col >> 7, dcol = col & 127, cwi = which * 512 + h * 128 + dcol;
        const float* cw = LP(I_GCONV, 4 * 1536) + cwi; const float w0 = cw[0], w1 = cw[1536], w2 = cw[3072], w3 = cw[4608];
        const LAS bf16_t* src = RAW + (16 * seg) * 384 + col;
        float x0 = bf2f(src[0]), x1 = bf2f(src[384]), x2 = bf2f(src[768]);
#pragma unroll
        for (int cc = 0; cc < 16; ++cc) { const float x3 = bf2f(src[(cc + 3) * 384]); const float y = silu_f(w0 * x0 + w1 * x1 + w2 * x2 + w3 * x3); const int tok = 16 * seg + cc;
            if (which == 2) Vi[tok * GD_LD + dcol] = (bf16_t)f2bf(y); else (which == 0 ? QF : KF)[tok * 128 + dcol] = y;
            x0 = x1; x1 = x2; x2 = x3; } }
    if (tid >= 384 && tid < 448) { const int cc = tid - 384; const bf16_t* pr = PROJROW(t0 + cc);
        const float beta = sigmoid_f(bf2f(pr[C_GB + h])); float cu = -fexp(LP(I_GALOG, 4)[h]) * softplus_f(bf2f(pr[C_GA + h]) + LP(I_GDTB, 4)[h]);
#pragma unroll
        for (int o = 1; o < 64; o <<= 1) { const float up = __shfl_up(cu, o); if (cc >= o) cu += up; }
        BETA[cc] = beta; GC[cc] = cu; BG[cc] = beta * fexp(cu); }
    WG_SYNC();
    GD_IDX();
    { float qv[16], kv[16]; float sq = 0.f, sk = 0.f;
#pragma unroll
      for (int u = 0; u < 4; ++u) { const f32x4 a4 = *(const LAS f32x4*)(QF + c * 128 + 16 * q8 + 4 * u), b4 = *(const LAS f32x4*)(KF + c * 128 + 16 * q8 + 4 * u);
#pragma unroll
          for (int e = 0; e < 4; ++e) { qv[4 * u + e] = a4[e]; kv[4 * u + e] = b4[e]; sq += a4[e] * a4[e]; sk += b4[e] * b4[e]; } }
      sq += __shfl_xor(sq, 1); sq += __shfl_xor(sq, 2); sq += __shfl_xor(sq, 4); sk += __shfl_xor(sk, 1); sk += __shfl_xor(sk, 2); sk += __shfl_xor(sk, 4);
      const float gc = GC[c], iq = (1.0f / sqrtf(sq + 1e-6f)) * 0.08838834764831845f, ik = 1.0f / sqrtf(sk + 1e-6f), et = fexp(GC[63] - gc), eg = fexp(gc);
      v4u oK[2], oQ[2], oKT[2], oQG[2];
#pragma unroll
      for (int u = 0; u < 8; ++u) { const float k0 = kv[2 * u] * ik, k1 = kv[2 * u + 1] * ik, q0 = qv[2 * u] * iq, q1 = qv[2 * u + 1] * iq;
          oK[u >> 2][u & 3] = pk2(k0, k1); oQ[u >> 2][u & 3] = pk2(q0, q1); oKT[u >> 2][u & 3] = pk2(k0 * et, k1 * et); oQG[u >> 2][u & 3] = pk2(q0 * eg, q1 * eg); }
      const int o = c * GD_LD + 16 * q8;
      *(LAS v4u*)(Ki + o) = oK[0]; *(LAS v4u*)(Ki + o + 8) = oK[1]; *(LAS v4u*)(Qi + o) = oQ[0]; *(LAS v4u*)(Qi + o + 8) = oQ[1];
      *(LAS v4u*)(KTi + o) = oKT[0]; *(LAS v4u*)(KTi + o + 8) = oKT[1]; *(LAS v4u*)(QGi + o) = oQG[0]; *(LAS v4u*)(QGi + o + 8) = oQG[1]; }
    WG_SYNC();
    GD_IDX();
#pragma unroll
    for (int tt = 0; tt < 2; ++tt) { const int tile = 2 * w + tt, im = tile >> 2, jc = tile & 3; f32x4 c1 = {0.f, 0.f, 0.f, 0.f}, c2 = c1;
        if (jc >= im) {
#pragma unroll
            for (int k0 = 0; k0 < 128; k0 += 32) { const bf16x8 fa = frag_row(Ki, GD_LD, 16 * im, k0, lane); c1 = mfma16(fa, frag_row(Ki, GD_LD, 16 * jc, k0, lane), c1); c2 = mfma16(fa, frag_row(Qi, GD_LD, 16 * jc, k0, lane), c2); }
            const int cq = 16 * jc + r; const float gc = GC[cq], bc = BETA[cq];
#pragma unroll
            for (int e = 0; e < 4; ++e) { const int m = 16 * im + 4 * g + e; const float dc = fexp(gc - GC[m]); c1[e] = m < cq ? c1[e] * dc * bc : 0.f; c2[e] = m <= cq ? c2[e] * dc : 0.f; } }
        const int cq = 16 * jc + r; *(LAS f32x4*)(AM + cq * 68 + 16 * im + 4 * g) = c1; *(LAS u32x2*)(AQ + cq * 72 + 16 * im + 4 * g) = pack4(c2); }
    WG_SYNC();
    GD_IDX();
    { const int col = c * 8 + q8; if (col < 256) { float x[64];
#pragma unroll
        for (int i = 0; i < 64; ++i) x[i] = 0.f;
        int vz = 0; asm volatile("" : "+v"(vz)); const LAS float* AMv = AM + vz;
        const LAS bf16_t* src = col < 128 ? Vi + col : Ki + (col - 128); const LAS float* scl = col < 128 ? BETA : BG; LAS bf16_t* dst = col < 128 ? Ui + col : Wi + (col - 128);
#pragma unroll
        for (int tq = 0; tq < 64; ++tq) { float acc = bf2f(src[tq * GD_LD]) * scl[tq];
#pragma unroll
            for (int i = 0; i < ((tq + 3) & ~3); i += 4) { const f32x4 av = *(const LAS f32x4*)(AMv + tq * 68 + i); acc -= av[0] * x[i]; acc -= av[1] * x[i + 1]; acc -= av[2] * x[i + 2]; acc -= av[3] * x[i + 3]; }
            x[tq] = acc; dst[tq * GD_LD] = (bf16_t)f2bf(acc); } } }
    WG_SYNC();
    GD_IDX();
    { const int jc = w & 3, wh = w >> 2; const int cq = 16 * jc + r;
      bf16_t* QT = (bf16_t*)(a.ws + WS_GD_QT) + (size_t)tk * 8192; bf16_t* YI = (bf16_t*)(a.ws + WS_GD_YI) + (size_t)tk * 8192; bf16_t* GG = (bf16_t*)(a.ws + WS_GD_G) + (size_t)tk * 16384; float* Z = WSF(WS_GD_Z) + (size_t)tk * 16384;
#pragma unroll
      for (int tt = 0; tt < 4; ++tt) { const int id = 4 * wh + tt; f32x4 c1 = {0.f, 0.f, 0.f, 0.f}, c2 = c1;
#pragma unroll
          for (int k0 = 0; k0 < 64; k0 += 32) { const bf16x8 fb = frag_row(AQ, 72, 16 * jc, k0, lane); c1 = mfma16(frag_tr(Wi, GD_LD, 16 * id, k0, lane), fb, c1); c2 = mfma16(frag_tr(Ui, GD_LD, 16 * id, k0, lane), fb, c2); }
          const f32x4 qg = unpack4(*(const LAS u32x2*)(QGi + cq * GD_LD + 16 * id + 4 * g));
          *(u32x2*)(QT + fo_st(jc, 4, 16 * id, g, r)) = pack4(qg - c1); *(u32x2*)(YI + co_off(jc, 8, id, lane)) = pack4(c2); }
      const float e63 = fexp(GC[63]);
#pragma unroll
      for (int ti = 0; ti < 8; ++ti) { f32x4 c1 = {0.f, 0.f, 0.f, 0.f}, c2 = c1;
#pragma unroll
          for (int k0 = 0; k0 < 64; k0 += 32) { c1 = mfma16(frag_tr(Wi, GD_LD, 16 * ti, k0, lane), frag_tr(KTi, GD_LD, 16 * w, k0, lane), c1); c2 = mfma16(frag_tr(KTi, GD_LD, 16 * ti, k0, lane), frag_tr(Ui, GD_LD, 16 * w, k0, lane), c2); }
          const int dq = 16 * w + r; f32x4 gv;
#pragma unroll
          for (int e = 0; e < 4; ++e) gv[e] = ((16 * ti + 4 * g + e) == dq ? e63 : 0.f) - c1[e];
          *(u32x2*)(GG + fo_st(w, 4, 16 * ti, g, r)) = pack4(gv); *(f32x4*)(Z + co_off(w, 8, ti, lane)) = c2; } }
    WG_SYNC();
#undef GD_IDX
}
__device__ __forceinline__ void gd_stage2(CArgs& a, int h, int es, LAS unsigned char* lds, int tid, const int var = 0) {
    const int lane = tid & 63, w = __builtin_amdgcn_readfirstlane(tid >> 6), r = lane & 15, g = lane >> 4;
    LAS bf16_t* Si = (LAS bf16_t*)lds;
    const bf16_t* G = (const bf16_t*)(a.ws + WS_GD_G); const float* Z = WSF(WS_GD_Z); bf16_t* S = (bf16_t*)(a.ws + WS_GD_S);
    const int so = fo_st(es, 4, 16 * w, g, r), zo = co_off(es, 8, w, lane);
    *(LAS u32x2*)(Si + r * GD_LD + 16 * w + 4 * g) = (u32x2){0u, 0u}; *(u32x2*)(S + (size_t)h * 16384 + so) = (u32x2){0u, 0u};
    WG_SYNC();
    constexpr int PD = 8;
    bf16x8 gf[PD][4]; f32x4 zf[PD];
#pragma unroll
    for (int u = 0; u < PD; ++u) { const size_t tk = (size_t)u * 4 + h; zf[u] = *(const f32x4*)(Z + tk * 16384 + zo);
#pragma unroll
        for (int k = 0; k < 4; ++k) gf[u][k] = frag_fo(G + tk * 16384, 4, w, k, lane); }
#define GD_STEP(n_, u_, REFILL) do { const int n = (n_); const size_t tk = (size_t)n * 4 + h; const int cur = n & 1; \
            f32x4 acc = zf[u_], acc2 = {0.f, 0.f, 0.f, 0.f}; \
            acc = mfma16(gf[u_][0], frag_row(Si + cur * 16 * GD_LD, GD_LD, 0, 0, lane), acc); acc2 = mfma16(gf[u_][1], frag_row(Si + cur * 16 * GD_LD, GD_LD, 0, 32, lane), acc2); \
            acc = mfma16(gf[u_][2], frag_row(Si + cur * 16 * GD_LD, GD_LD, 0, 64, lane), acc); acc2 = mfma16(gf[u_][3], frag_row(Si + cur * 16 * GD_LD, GD_LD, 0, 96, lane), acc2); \
            if (REFILL && !(var & 2)) { const int nn = n + PD < NCH - 1 ? n + PD : NCH - 2; const size_t tn = (size_t)nn * 4 + h; zf[u_] = *(const f32x4*)(Z + tn * 16384 + zo); \
                _Pragma("unroll") for (int k = 0; k < 4; ++k) gf[u_][k] = frag_fo(G + tn * 16384, 4, w, k, lane); } \
            const u32x2 pv = pack4(acc + acc2); \
            if (!(var & 4)) *(LAS u32x2*)(Si + (cur ^ 1) * 16 * GD_LD + r * GD_LD + 16 * w + 4 * g) = pv; if (!(var & 1)) *(u32x2*)(S + (tk + 4) * 16384 + so) = pv; \
            if (!(var & 4)) { asm volatile("s_waitcnt lgkmcnt(0)" ::: "memory"); __builtin_amdgcn_s_barrier(); } asm volatile("" ::: "memory"); } while (0)
#pragma unroll
    for (int nq = 0; nq < NCH - 1; ++nq) GD_STEP(nq, nq % PD, nq + PD < NCH - 1);
#undef GD_STEP
}
__device__ __forceinline__ void gd_stage3(CArgs& a, int l, int n, int h, LAS unsigned char* lds, int tid) {
    const int lane = tid & 63, w = __builtin_amdgcn_readfirstlane(tid >> 6), r = lane & 15, g = lane >> 4, jc = w & 3, wh = w >> 2;
    const size_t tk = (size_t)n * 4 + h; const int c = 16 * jc + r, t = n * 64 + c;
    const bf16_t* S = (const bf16_t*)(a.ws + WS_GD_S) + tk * 16384; const bf16_t* QT = (const bf16_t*)(a.ws + WS_GD_QT) + tk * 8192; const bf16_t* YI = (const bf16_t*)(a.ws + WS_GD_YI) + tk * 8192;
    LAS float* xs = (LAS float*)lds;
    f32x4 acc[4]; float ss = 0.f;
#pragma unroll
    for (int tt = 0; tt < 4; ++tt) { const int ie = 4 * wh + tt; acc[tt] = unpack4(*(const u32x2*)(YI + co_off(jc, 8, ie, lane)));
#pragma unroll
        for (int k = 0; k < 4; ++k) acc[tt] = mfma16(frag_fo(S, 4, ie, k, lane), frag_fo(QT, 4, jc, k, lane), acc[tt]);
#pragma unroll
        for (int e = 0; e < 4; ++e) ss += acc[tt][e] * acc[tt][e]; }
    ss += __shfl_xor(ss, 16); ss += __shfl_xor(ss, 32);
    if (g == 0) xs[w * 16 + r] = ss;
    WG_SYNC();
    const float rs = 1.0f / sqrtf((ss + xs[(w ^ 4) * 16 + r]) * (1.0f / 128.0f) + 1e-6f);
    const float* nw = LP(I_GNORM, 128); const bf16_t* pz = PROJROW(t) + C_GZ + h * 128; bf16_t* O = (bf16_t*)(a.ws + WS_O) + (size_t)t * D + h * 128;
#pragma unroll
    for (int tt = 0; tt < 4; ++tt) { const int e0 = 16 * (4 * wh + tt) + 4 * g; const f32x4 zv = unpack4(*(const u32x2*)(pz + e0)), wv = *(const f32x4*)(nw + e0); f32x4 y;
#pragma unroll
        for (int e = 0; e < 4; ++e) y[e] = acc[tt][e] * rs * wv[e] * silu_f(zv[e]);
        *(u32x2*)(O + e0) = pack4(y); }
    WG_SYNC();
}

#define XB_TMO      128
#define XB_XCNT(j)  (256  + 64 * (j))
#define XB_XSUB(j)  (1280 + 64 * (j))
#define XB_XGEN(j)  (2304 + 64 * (j))
#define XB_TOP      3328
#define XB_TOPGEN   3392
#define XCD_BAR_WORDS 3456
#define XB_SPIN_CAP (1u << 20)
__device__ __forceinline__ unsigned xb_ld(unsigned* p)              { return __hip_atomic_load(p, __ATOMIC_RELAXED, __HIP_MEMORY_SCOPE_AGENT); }
__device__ __forceinline__ unsigned xb_add(unsigned* p, unsigned v) { return __hip_atomic_fetch_add(p, v, __ATOMIC_RELAXED, __HIP_MEMORY_SCOPE_AGENT); }
__device__ __forceinline__ unsigned xb_xcc_id() { return (unsigned)__builtin_amdgcn_s_getreg((3 << 11) | 20) & 0xFu; }
#define XB_SPIN(cond, bar) do { unsigned _sp = 0; while (cond) { __builtin_amdgcn_s_sleep(1); \
    if ((++_sp & 255u) == 0u) { if (xb_ld(&(bar)[XB_TMO])) break; if (_sp > XB_SPIN_CAP) { atomicAdd(&(bar)[XB_TMO], 1u); break; } } } } while (0)
struct XcdBarrier { unsigned* bar; unsigned x; volatile LAS unsigned* st; };
__device__ __forceinline__ XcdBarrier xcd_barrier_post(unsigned* bar, volatile LAS unsigned* st) {
    XcdBarrier b; b.bar = bar; b.x = xb_xcc_id(); b.st = st;
    if (threadIdx.x == 0) (void)xb_add(&bar[XB_XCNT(b.x)], 1u);
    return b;
}
__device__ __forceinline__ void xcd_barrier_complete(unsigned* bar, unsigned x, unsigned& nloc, unsigned& nx) {
    const unsigned G = gridDim.x * gridDim.y * gridDim.z;
    unsigned sum, cnt, mine, sp = 0u;
    for (;;) {
        sum = 0u; cnt = 0u; mine = 0u;
#pragma unroll
        for (unsigned j = 0; j < 16; ++j) { const unsigned c = xb_ld(&bar[XB_XCNT(j)]); sum += c; cnt += (c > 0u) ? 1u : 0u; mine = (j == x) ? c : mine; }
        if (sum == G) break;
        __builtin_amdgcn_s_sleep(1);
        if ((++sp & 255u) == 0u) { if (xb_ld(&bar[XB_TMO])) break; if (sp > XB_SPIN_CAP) { atomicAdd(&bar[XB_TMO], 1u); break; } }
    }
    nloc = mine > 0u ? mine : 1u; nx = cnt > 0u ? cnt : 1u;
}
__device__ __forceinline__ void xcd_barrier(const XcdBarrier& b) {
    asm volatile("s_waitcnt vmcnt(0)" ::: "memory");
    __syncthreads();
    if (threadIdx.x == 0) {
        unsigned* bar = b.bar;
        __builtin_amdgcn_s_waitcnt(0);
        unsigned nloc = b.st[0], nx = b.st[1];
        if (nloc == 0u) { xcd_barrier_complete(bar, b.x, nloc, nx); b.st[0] = nloc; b.st[1] = nx; }
        const unsigned old = xb_add(&bar[XB_XSUB(b.x)], 1u);
        const unsigned gen = old / nloc;
        if (old + 1u == (gen + 1u) * nloc) {
            __builtin_amdgcn_fence(__ATOMIC_RELEASE, "agent");
            asm volatile("s_waitcnt vmcnt(0)" ::: "memory");
            const unsigned og = xb_add(&bar[XB_TOP], 1u);
            const unsigned tg = og / nx;
            if (og + 1u == (tg + 1u) * nx) xb_add(&bar[XB_TOPGEN], 1u);
            else XB_SPIN(xb_ld(&bar[XB_TOPGEN]) == tg, bar);
            __builtin_amdgcn_fence(__ATOMIC_ACQUIRE, "agent");
            xb_add(&bar[XB_XGEN(b.x)], 1u);
            asm volatile("s_waitcnt vmcnt(0)" ::: "memory");
        } else {
            XB_SPIN(xb_ld(&bar[XB_XGEN(b.x)]) == gen, bar);
            __builtin_amdgcn_fence(__ATOMIC_ACQUIRE, "agent");
            asm volatile("s_waitcnt vmcnt(0)" ::: "memory");
        }
    }
    __syncthreads();
}

constexpr int N_PHASES = 1 + 9 * NL;

__device__ __forceinline__ void run_phase(CArgs& a, int ph, LAS unsigned char* lds, const int tid, const int bid, const int mask = 15) {
    const int lane = tid & 63, wave = __builtin_amdgcn_readfirstlane(tid >> 6);
    const int G = gridDim.x, gw = bid * NWAVES + wave, NGW = G * NWAVES;
    if (ph == N_PHASES - 1) {
        for (int t = gw; t < T; t += NGW) rms_row_f32(HRES + (size_t)t * D, a.in[I_NF], a.out + (size_t)t * D, lane);
        return;
    }
    const int l = ph / 9, sp = ph % 9;
    const float* hin = l == 0 ? a.in[I_X] : (const float*)HRES;
    switch (sp) {
    case 0: {
        LAS float* scr = (LAS float*)(lds + wave * 16384);
        constexpr int I_IN = (D / 64) * (PTP / 32), I_OUT = (D / 64) * (D / 32), I_UP = (D / 64) * (FF / 32), I_DN = (FF / 64) * (D / 32), I_L = I_IN + I_OUT + I_UP + I_DN;
        if (mask & 1) for (int it = gw; it < I_L; it += NGW) {
            int r = it;
            if (r < I_IN) { transpose_item(LP(I_WIN, (size_t)D * PT), D, PT, PTP, (bf16_t*)(a.ws + WS_WIN), scr, r, lane); continue; } r -= I_IN;
            if (r < I_OUT) { transpose_item(LP(I_WOUT, (size_t)D * D), D, D, D, (bf16_t*)(a.ws + WS_WOUT), scr, r, lane); continue; } r -= I_OUT;
            if (r < I_UP) { transpose_item(LP(I_WUP, (size_t)D * FF), D, FF, FF, (bf16_t*)(a.ws + WS_WUP), scr, r, lane); continue; } r -= I_UP;
            transpose_item(LP(I_WDN, (size_t)FF * D), FF, D, D, (bf16_t*)(a.ws + WS_WDN), scr, r, lane);
        }
        if (mask & 2) for (int t = gw; t < T; t += NGW) rms_row_bf16(hin + (size_t)t * D, LP(I_N1, D), (bf16_t*)(a.ws + WS_XN) + (size_t)t * D, lane);
    } break;
    case 1: { pg8::Gemm g{(const bf16_t*)(a.ws + WS_XN), (const bf16_t*)(a.ws + WS_WIN)}; pg8::StaticOrder<T, PTP> S; S.init(G, bid);
              pg8::EpiBf16<false> E{(bf16_t*)(a.ws + WS_PROJ), PTP}; pg8::gemm_phase<D, pg8::EpiBf16<false>, pg8::StaticOrder<T, PTP>, true>(lds, g, S, E, tid); } break;
    case 2: {
#pragma unroll 1
              for (int it = bid; (mask & 1) && it < NCH * 4; it += G) gd_stage1(a, l, it >> 2, it & 3, lds, tid);
#pragma unroll 1
              for (int it = bid; (mask & 4) && it < NCH * 8; it += G) rw_stage1(a, l, it >> 3, it & 7, lds, tid, mask >> 8 ? (mask >> 8) - 1 : 99);
#pragma unroll 1
              for (int it = bid; (mask & 8) && it < NCH * 2; it += G) m2_stage1(a, l, it >> 1, it & 1, lds, tid);
#pragma unroll 1
              for (int it = bid; (mask & 2) && it < NCH * 4; it += G) ret_stage1(a, it >> 2, it & 3, lds, tid); } break;
    case 3: { const int b = bid;
              if (b < 64) { const int x = b & 7, j = b >> 3;
                  if (x < 4) { if (mask & 1) gd_stage2(a, x, j, lds, tid, mask >> 8); }
                  else if (mask & 4) rw_stage2(a, (x - 4) * 2 + (j >> 2), j & 3, lds, tid); }
              else if (b < 128) { if (mask & 2) ret_stage2(a, b - 64, tid); }
              else if (mask & 8) m2_stage2(a, b - 128, tid); } break;
    case 4:
#pragma unroll 1
            for (int it = bid; (mask & 1) && it < NCH * 4; it += G) gd_stage3(a, l, it >> 2, it & 3, lds, tid);
#pragma unroll 1
            for (int it = bid; (mask & 2) && it < NCH * 4; it += G) ret_stage3(a, l, it >> 2, it & 3, lds, tid);
#pragma unroll 1
            for (int it = bid; (mask & 4) && it < NCH * 8; it += G) rw_stage3(a, l, it >> 3, it & 7, lds, tid);
#pragma unroll 1
            for (int it = bid; (mask & 8) && it < NCH * 2; it += G) m2_stage3(a, l, it >> 1, it & 1, lds, tid);
            break;
    case 5: { pg8::Gemm g{(const bf16_t*)(a.ws + WS_O), (const bf16_t*)(a.ws + WS_WOUT)}; pg8::StaticOrder<T, D> S; S.init(G, bid);
              pg8::EpiAddRes E{hin, HRES, D}; pg8::gemm_phase<D, pg8::EpiAddRes, pg8::StaticOrder<T, D>, false>(lds, g, S, E, tid); } break;
    case 6: for (int t = gw; t < T; t += NGW) rms_row_bf16(HRES + (size_t)t * D, LP(I_N2, D), (bf16_t*)(a.ws + WS_XN) + (size_t)t * D, lane); break;
    case 7: { pg8::Gemm g{(const bf16_t*)(a.ws + WS_XN), (const bf16_t*)(a.ws + WS_WUP)}; pg8::StaticOrder<T, FF> S; S.init(G, bid);
              pg8::EpiBf16<true> E{(bf16_t*)(a.ws + WS_HID), FF}; pg8::gemm_phase<D, pg8::EpiBf16<true>, pg8::StaticOrder<T, FF>, true>(lds, g, S, E, tid); } break;
    case 8: { pg8::Gemm g{(const bf16_t*)(a.ws + WS_HID), (const bf16_t*)(a.ws + WS_WDN)}; pg8::StaticOrder<T, D> S; S.init(G, bid);
              pg8::EpiAddRes E{HRES, HRES, D}; pg8::gemm_phase<FF, pg8::EpiAddRes, pg8::StaticOrder<T, D>, false>(lds, g, S, E, tid); } break;
    }
}

__global__ void __launch_bounds__(NWAVES * 64, 2) fwd_kernel(Args a) {
    extern __shared__ __attribute__((aligned(16))) unsigned char lds_raw[];
    LAS unsigned char* lds = (LAS unsigned char*)lds_raw;
    const int ph_lo = a.ph_lo, ph_hi = a.ph_hi;
    volatile LAS unsigned* MISC = (volatile LAS unsigned*)(lds + MISC_OFF);
    if (threadIdx.x < 64) MISC[threadIdx.x] = 0u;
    __syncthreads();
    const XcdBarrier bar = xcd_barrier_post((unsigned*)(a.ws + WS_CTL), MISC + 8);
    for (int ph = ph_lo; ph < ph_hi; ++ph) {
        CArgs* ap = (CArgs*)__builtin_amdgcn_kernarg_segment_ptr();
        asm volatile("" : "+s"(ap));
        int tid = threadIdx.x, bid = blockIdx.x;
        asm volatile("" : "+v"(tid)); asm volatile("" : "+s"(bid));
        run_phase(*ap, ph, lds, tid, bid);
#ifdef DUP_PHASE
#ifndef DUP_MASK
#define DUP_MASK 15
#endif
        if (ph == DUP_PHASE) { xcd_barrier(bar); asm volatile("" : "+s"(ap)); asm volatile("" : "+v"(tid)); asm volatile("" : "+s"(bid)); run_phase(*ap, ph, lds, tid, bid, DUP_MASK); }
#endif
        if (ph + 1 < ph_hi) xcd_barrier(bar);
    }
}

extern "C" void kernel_launch(void* const* d_in, const int* in_sizes, int n_in, void* d_out, int out_size, void* d_ws, size_t ws_size, hipStream_t stream) {
    static int grid = 0;
    if (grid == 0) {
        if (n_in != N_IN || in_sizes[0] != T * D || out_size != T * D || ws_size < WS_END) {
            fprintf(stderr, "kernel_launch: shape/workspace mismatch: n_in %d in0 %d out %d ws %zu (need %zu); nothing launched\n", n_in, n_in > 0 ? in_sizes[0] : -1, out_size, ws_size, (size_t)WS_END); grid = -1; return; }
        int dev = 0, cus = 0, per_cu = 0;
        if (hipGetDevice(&dev) != hipSuccess || hipDeviceGetAttribute(&cus, hipDeviceAttributeMultiprocessorCount, dev) != hipSuccess) { grid = -1; return; }
        if (hipFuncSetAttribute((const void*)fwd_kernel, hipFuncAttributeMaxDynamicSharedMemorySize, LDS_BYTES) != hipSuccess) { fprintf(stderr, "kernel_launch: hipFuncSetAttribute failed\n"); grid = -1; return; }
        if (hipOccupancyMaxActiveBlocksPerMultiprocessor(&per_cu, (const void*)fwd_kernel, NWAVES * 64, LDS_BYTES) != hipSuccess || per_cu < 1) { fprintf(stderr, "kernel_launch: occupancy query says %d blocks per CU\n", per_cu); per_cu = 1; }
        (void)hipGetLastError();
        grid = cus;
    }
    if (grid < 0) return;
    Args a{};
    for (int i = 0; i < N_IN; ++i) a.in[i] = (const float*)d_in[i];
    a.out = (float*)d_out; a.ws = (unsigned char*)d_ws;
#if N_LAUNCH_MODE == 1
    a.ph_lo = 0; a.ph_hi = N_PHASES;
    (void)hipMemsetAsync((char*)d_ws + WS_CTL, 0, XCD_BAR_WORDS * 4, stream);
    hipLaunchKernelGGL(fwd_kernel, dim3(grid), dim3(NWAVES * 64), LDS_BYTES, stream, a);
#else
#ifndef DBG_MAXPH
#define DBG_MAXPH N_PHASES
#endif
    for (int ph = 0; ph < N_PHASES; ++ph) {
        if (ph >= DBG_MAXPH && ph != N_PHASES - 1) continue;
#ifdef DBG_SKIP_FINAL
        if (ph == N_PHASES - 1) continue;
#endif
        (void)hipMemsetAsync((char*)d_ws + WS_CTL, 0, XCD_BAR_WORDS * 4, stream);
        a.ph_lo = ph; a.ph_hi = ph + 1;
        hipLaunchKernelGGL(fwd_kernel, dim3(grid), dim3(NWAVES * 64), LDS_BYTES, stream, a);
    }
#endif
}
#endif
```

```cpp
#ifndef HOST_TEST
#include <hip/hip_runtime.h>
#endif
#include <cstdio>
#include <cstdint>
#include <cmath>
#include <cstddef>

#ifndef SEQ_T
#define SEQ_T 8192
#endif
#ifndef N_LAUNCH_MODE
#define N_LAUNCH_MODE 1
#endif

constexpr int T = SEQ_T, D = 2048, NL = 2, FF = 8192, PT = 6832, PTP = 6912;
constexpr int C_GQ = 0, C_GK = 512, C_GV = 1024, C_GZ = 1536, C_GB = 2048, C_GA = 2052;
constexpr int C_RQ = 2056, C_RK = 2312, C_RV = 2568, C_RG = 3080;
constexpr int C_MZ = 3592, C_MXBC = 4104, C_MDT = 5128;
constexpr int C_RW = 5136;
enum { I_X = 0, I_N1, I_WIN, I_GCONV, I_GALOG, I_GDTB, I_GNORM, I_RNORM, I_MCONV, I_MCONVB, I_MALOG, I_MDTB, I_MD, I_MNORM, I_RWMU, I_RWW0, I_RWWUP, I_RWA0, I_RWAUP,
       I_RWGUP, I_RWKK, I_RWKA, I_RWRK, I_RWLNW, I_RWLNB, I_WOUT, I_N2, I_WUP, I_WDN, I_NF, N_IN };

constexpr size_t MiB = 1u << 20;
constexpr size_t SZ_WIN = (size_t)PTP * D * 2, SZ_WOUT = (size_t)D * D * 2, SZ_WUP = (size_t)FF * D * 2, SZ_WDN = (size_t)D * FF * 2;
constexpr size_t WS_CTL = 0, CTL_BYTES = 1 * MiB;
constexpr size_t WS_SS = 64 * 1024, SS_STRIDE = (size_t)SEQ_T * 4;
constexpr size_t CTL_ZERO_BYTES = WS_SS + (2 * 2 + 1) * SS_STRIDE;
constexpr size_t WS_WIN = WS_CTL + CTL_BYTES;
constexpr size_t WS_WOUT = WS_WIN + SZ_WIN;
constexpr size_t WS_WUP = WS_WOUT + SZ_WOUT;
constexpr size_t WS_WDN = WS_WUP + SZ_WUP;
constexpr size_t WS_XN = WS_WDN + SZ_WDN;
constexpr size_t WS_O = WS_XN;
constexpr size_t WS_PROJ = WS_XN + (size_t)T * D * 2;
constexpr size_t WS_HID = WS_PROJ;
constexpr size_t GDN_ = (size_t)(T / 64) * 4 * 16384;
constexpr size_t WS_GD_G = WS_PROJ + (size_t)T * PTP * 2;
constexpr size_t WS_GD_Z = WS_GD_G + GDN_ * 2;
constexpr size_t WS_GD_QT = WS_GD_Z + GDN_ * 4;
constexpr size_t WS_GD_YI = WS_GD_QT + GDN_;
constexpr size_t WS_GD_S = WS_GD_YI + GDN_;
constexpr size_t WS_GAB = WS_GD_S + GDN_ * 2;
constexpr int NCH = T / 64;
constexpr size_t WS_RET_Z = WS_GAB;
constexpr size_t WS_RET_YI = WS_RET_Z + (size_t)NCH * 4 * 8192 * 4;
constexpr size_t WS_RET_QH = WS_RET_YI + (size_t)NCH * 4 * 8192 * 2;
constexpr size_t WS_RET_S = WS_RET_QH + (size_t)NCH * 4 * 4096 * 2;
constexpr size_t M2N = (size_t)NCH * 8 * 8192;
constexpr size_t WS_M2_Z = WS_RET_S + (size_t)NCH * 4 * 8192 * 2;
constexpr size_t WS_M2_YI = WS_M2_Z + M2N * 4;
constexpr size_t WS_M2_QH = WS_M2_YI + M2N;
constexpr size_t WS_M2_S = WS_M2_QH + M2N * 2;
constexpr size_t WS_M2_DEC = WS_M2_S + M2N * 2;
constexpr size_t WS_MDT = WS_M2_DEC + (size_t)NCH * 8 * 4;
constexpr size_t RWN = (size_t)NCH * 8 * 4096;
constexpr size_t WS_RW_G = WS_MDT;
constexpr size_t WS_RW_Z = WS_RW_G + RWN * 2;
constexpr size_t WS_RW_QT = WS_RW_Z + RWN * 4;
constexpr size_t WS_RW_YI = WS_RW_QT + RWN * 2;
constexpr size_t WS_RW_E = WS_RW_YI + RWN * 2;
constexpr size_t WS_RW_GT = WS_RW_E + RWN * 2;
constexpr size_t WS_RW_S = WS_RW_GT + RWN * 2;
constexpr size_t WS_END = WS_RW_S + RWN * 2;
constexpr size_t WS_XN2 = WS_RET_Z;
static_assert(WS_HID + (size_t)T * FF * 2 <= WS_XN2 && WS_XN2 + (size_t)T * D * 2 <= WS_M2_Z, "HID overlay / XN2 alias");
static_assert(CTL_ZERO_BYTES <= CTL_BYTES, "CTL");
static_assert(SEQ_T != 8192 || WS_END <= 512 * MiB, "d_ws budget (512 MiB)");

typedef unsigned short bf16_t;
#ifdef HOST_TEST
#define DEV static inline
#define HD static inline
typedef float f32x4 __attribute__((vector_size(16)));
constexpr int WAVE = 1, LPC = 1;
static inline float wave_sum(float v) { return v; }
static inline float group_sum(float v) { return v; }
#else
#define DEV __device__ __forceinline__
#define HD __host__ __device__ __forceinline__
typedef float f32x4 __attribute__((ext_vector_type(4)));
constexpr int WAVE = 64, LPC = 16;
DEV float wave_sum(float v) {
#pragma unroll
    for (int o = 1; o < 64; o <<= 1) v += __shfl_xor(v, o);
    return v;
}
DEV float group_sum(float v) {
#pragma unroll
    for (int o = 1; o < 16; o <<= 1) v += __shfl_xor(v, o);
    return v;
}
#endif
constexpr int CPW = WAVE / LPC;

HD unsigned f2bf(float f) { unsigned u; __builtin_memcpy(&u, &f, 4); return (u + 0x7fffu + ((u >> 16) & 1u)) >> 16; }
HD unsigned pk2(float lo, float hi) { return f2bf(lo) | (f2bf(hi) << 16); }
HD float bf2f(bf16_t b) { unsigned u = (unsigned)b << 16; float f; __builtin_memcpy(&f, &u, 4); return f; }
#ifdef HOST_TEST
DEV float sigmoid_f(float x) { return 1.0f / (1.0f + expf(-x)); }
DEV float silu_f(float x) { return x / (1.0f + expf(-x)); }
#else
DEV float fexp(float x) { return __builtin_amdgcn_exp2f(x * 1.4426950408889634f); }
DEV float sigmoid_f(float x) { return __builtin_amdgcn_rcpf(1.0f + fexp(-x)); }
DEV float silu_f(float x) { return x * __builtin_amdgcn_rcpf(1.0f + fexp(-x)); }
#endif
DEV float softplus_f(float x) { return x > 20.f ? x : log1pf(expf(x)); }

struct Args { const float* in[N_IN]; float* out; unsigned char* ws; int ph_lo, ph_hi; };
#ifdef HOST_TEST
typedef const Args CArgs;
#else
typedef const __attribute__((address_space(4))) Args CArgs;
#endif
#define WSF(off) ((float*)(a.ws + (off)))
#define HRES (a.out)
#define PROJROW(t) ((const bf16_t*)(a.ws + WS_PROJ) + (size_t)(t) * PTP)
#define LP(idx, per) (a.in[idx] + (size_t)l * (per))

DEV void xn_row(const float* x, const float* w, bf16_t* o, float* ss_out, int lane) {
    float ss = 0.f;
    for (int i = lane * 4; i < D; i += WAVE * 4) { const f32x4 v = *(const f32x4*)(x + i), g = *(const f32x4*)(w + i); ss += (v[0] * v[0] + v[1] * v[1]) + (v[2] * v[2] + v[3] * v[3]);
        unsigned* op = (unsigned*)(o + i); op[0] = pk2(v[0] * g[0], v[1] * g[1]); op[1] = pk2(v[2] * g[2], v[3] * g[3]); }
    ss = wave_sum(ss); if (lane == 0) *ss_out = ss;
}
DEV void final_row(float* x, const float* w, float ss, int lane) {
    const float r = 1.0f / sqrtf(ss * (1.0f / D) + 1e-6f);
    for (int i = lane * 4; i < D; i += WAVE * 4) { const f32x4 v = *(const f32x4*)(x + i), g = *(const f32x4*)(w + i); f32x4 y; y[0] = v[0] * r * g[0]; y[1] = v[1] * r * g[1]; y[2] = v[2] * r * g[2]; y[3] = v[3] * r * g[3]; *(f32x4*)(x + i) = y; }
}
DEV void rms_row_bf16(const float* x, const float* w, bf16_t* o, int lane) {
    float ss = 0.f;
    for (int i = lane * 4; i < D; i += WAVE * 4) { const f32x4 v = *(const f32x4*)(x + i); ss += (v[0] * v[0] + v[1] * v[1]) + (v[2] * v[2] + v[3] * v[3]); }
    const float r = 1.0f / sqrtf(wave_sum(ss) * (1.0f / D) + 1e-6f);
    for (int i = lane * 4; i < D; i += WAVE * 4) { const f32x4 v = *(const f32x4*)(x + i), g = *(const f32x4*)(w + i);
        unsigned* op = (unsigned*)(o + i); op[0] = pk2(v[0] * r * g[0], v[1] * r * g[1]); op[1] = pk2(v[2] * r * g[2], v[3] * r * g[3]); }
}
DEV void rms_row_f32(const float* x, const float* w, float* o, int lane) {
    float ss = 0.f;
    for (int i = lane * 4; i < D; i += WAVE * 4) { const f32x4 v = *(const f32x4*)(x + i); ss += (v[0] * v[0] + v[1] * v[1]) + (v[2] * v[2] + v[3] * v[3]); }
    const float r = 1.0f / sqrtf(wave_sum(ss) * (1.0f / D) + 1e-6f);
    for (int i = lane * 4; i < D; i += WAVE * 4) { const f32x4 v = *(const f32x4*)(x + i), g = *(const f32x4*)(w + i);
        f32x4 y; y[0] = v[0] * r * g[0]; y[1] = v[1] * r * g[1]; y[2] = v[2] * r * g[2]; y[3] = v[3] * r * g[3]; *(f32x4*)(o + i) = y; }
}

DEV float conv4(const bf16_t* projrow_t, int col, const float* w, int c, int wstride, int t) {
    float acc = 0.f;
#pragma unroll
    for (int j = 0; j < 4; ++j) { const int tt = t - 3 + j; if (tt >= 0) acc += w[j * wstride + c] * bf2f(projrow_t[(ptrdiff_t)(j - 3) * PTP + col]); }
    return acc;
}

#ifdef HOST_TEST
static const float THETA[32] = {
#else
__device__ const float THETA[32] = {
#endif
    1.000000000e+00f, 7.429639101e-01f, 5.519954562e-01f, 4.101127088e-01f, 3.046989739e-01f, 2.263803482e-01f, 1.681924462e-01f, 1.249609292e-01f, 9.284145385e-02f, 6.897785515e-02f,
    5.124806613e-02f, 3.807546571e-02f, 2.828869782e-02f, 2.101748064e-02f, 1.561523322e-02f, 1.160155423e-02f, 8.619536646e-03f, 6.404003594e-03f, 4.757945426e-03f, 3.534980817e-03f,
    2.626363887e-03f, 1.951293205e-03f, 1.449740841e-03f, 1.077104942e-03f, 8.002503891e-04f, 5.945570301e-04f, 4.417345626e-04f, 3.281927784e-04f, 2.438354713e-04f, 1.811609109e-04f,
    1.345960627e-04f, 9.999999747e-05f };

#ifndef HOST_TEST
namespace pg8 {
#define PG8_LAS __attribute__((address_space(3)))
typedef short bf16x8 __attribute__((ext_vector_type(8)));
typedef unsigned u32x4 __attribute__((ext_vector_type(4)));
constexpr int BM = 256, BK = 64, HALF = 128, HTB = HALF * BK * 2, STAGE_BYTES = 8 * HTB, NXCD = 8, WGM = 8;
__host__ __device__ __forceinline__ int lds_byte(int r, int c) { const int st = (r >> 4) * 2 + (c >> 5), rr = r & 15, cc = c & 31, ob = rr * 64 + cc * 2; return st * 1024 + (ob ^ (((ob >> 9) & 1) << 5)); }
__host__ __device__ __forceinline__ void stage_rc(int b, int& R, int& C) { const int st = b / 1024, sb = b % 1024, swz = sb ^ (((sb >> 9) & 1) << 5); R = (st >> 1) * 16 + swz / 64; C = (st & 1) * 32 + (swz % 64) / 2; }
__host__ __device__ __forceinline__ int perm32(int rho) { const int n = rho >> 4, i = rho & 15; return 8 * (i >> 2) + 4 * n + (i & 3); }
struct Unit { int pm, pn; };
struct Gemm { const bf16_t* A; const bf16_t* Bt; };
template <int M, int N> struct StaticOrder {
    static constexpr int nM = M / BM, nN = N / BM, nwg = nM * nN; int G, c;
    __device__ void init(int G_, int c_) { G = G_; c = c_; }
    __device__ bool next(int i, Unit& u) const {
        const long L = (long)i * G + c; if (L >= nwg) return false;
        int wgid = (int)L; { const int q = nwg / NXCD, r = nwg % NXCD, xcd = wgid % NXCD, off = wgid / NXCD; wgid = (xcd < r ? xcd * (q + 1) : r * (q + 1) + (xcd - r) * q) + off; }
        const int nig = WGM * nN, gid = wgid / nig, fm = gid * WGM, gsz = (nM - fm) < WGM ? (nM - fm) : WGM;
        u.pm = fm + ((wgid % nig) % gsz); u.pn = (wgid % nig) / gsz; return true;
    }
    __device__ __forceinline__ void a_ready(const Unit&) const {}
    __device__ __forceinline__ void done(const Unit&) const {}
};
__device__ __forceinline__ unsigned cvt_pk_bf16(float lo, float hi) { unsigned r; asm volatile("v_cvt_pk_bf16_f32 %0, %1, %2" : "=v"(r) : "v"(lo), "v"(hi)); return r; }
struct EpiStoreF32 {
    static constexpr bool PERM = false, AFTER_DRAIN = false; float* O; int ldc;
    __device__ __forceinline__ void operator()(const f32x4 (&acc)[2][2][4][2], const Unit& u, int wr, int wc, int fr, int fq) const {
        const int row0 = u.pm * BM + wr * 64 + fr, col0 = u.pn * BM + wc * 32 + 4 * fq;
#pragma unroll
        for (int ai = 0; ai < 2; ++ai)
#pragma unroll
            for (int m = 0; m < 4; ++m) { float* rowp = O + (size_t)(row0 + ai * HALF + m * 16) * ldc + col0;
#pragma unroll
                for (int bj = 0; bj < 2; ++bj)
#pragma unroll
                    for (int n = 0; n < 2; ++n) *(f32x4*)(rowp + bj * HALF + n * 16) = acc[ai][bj][m][n]; }
    }
};
struct EpiAddRes {
    static constexpr bool PERM = false, AFTER_DRAIN = false; const float* B; float* O; int ldc; bf16_t* XN; const float* nw; float* SS;
    __device__ __forceinline__ void operator()(const f32x4 (&acc)[2][2][4][2], const Unit& u, int wr, int wc, int fr, int fq) const {
        const int row0 = u.pm * BM + wr * 64 + fr, col0 = u.pn * BM + wc * 32 + 4 * fq;
#pragma unroll
        for (int ai = 0; ai < 2; ++ai)
#pragma unroll
            for (int m = 0; m < 4; ++m) { float* rowp = O + (size_t)(row0 + ai * HALF + m * 16) * ldc + col0; const float* bp = B + (size_t)(row0 + ai * HALF + m * 16) * ldc + col0;
                f32x4 b[2][2];
#pragma unroll
                for (int bj = 0; bj < 2; ++bj)
#pragma unroll
                    for (int n = 0; n < 2; ++n) b[bj][n] = *(const f32x4*)(bp + bj * HALF + n * 16);
                bf16_t* xp = XN + (size_t)(row0 + ai * HALF + m * 16) * ldc + col0; float ss = 0.f;
#pragma unroll
                for (int bj = 0; bj < 2; ++bj)
#pragma unroll
                    for (int n = 0; n < 2; ++n) { const f32x4 hn = b[bj][n] + acc[ai][bj][m][n]; *(f32x4*)(rowp + bj * HALF + n * 16) = hn; const f32x4 wv = *(const f32x4*)(nw + col0 + bj * HALF + n * 16);
                        ss += (hn[0] * hn[0] + hn[1] * hn[1]) + (hn[2] * hn[2] + hn[3] * hn[3]);
                        typedef unsigned u32x2e __attribute__((ext_vector_type(2))); u32x2e pw; pw.x = cvt_pk_bf16(hn[0] * wv[0], hn[1] * wv[1]); pw.y = cvt_pk_bf16(hn[2] * wv[2], hn[3] * wv[3]); *(u32x2e*)(xp + bj * HALF + n * 16) = pw; }
                ss += __shfl_xor(ss, 16); ss += __shfl_xor(ss, 32);
                if (fq == 0) atomicAdd(SS + row0 + ai * HALF + m * 16, ss); }
    }
};
template <bool SQRELU> struct EpiBf16 {
    static constexpr bool PERM = true, AFTER_DRAIN = false; bf16_t* O; int ldc; const float* SS;
    __device__ __forceinline__ void operator()(const f32x4 (&acc)[2][2][4][2], const Unit& u, int wr, int wc, int fr, int fq) const {
        const int row0 = u.pm * BM + wr * 64 + fr, col0 = u.pn * BM + wc * 32 + 8 * fq;
#pragma unroll
        for (int ai = 0; ai < 2; ++ai)
#pragma unroll
            for (int m = 0; m < 4; ++m) { bf16_t* rowp = O + (size_t)(row0 + ai * HALF + m * 16) * ldc + col0; const float rs = __builtin_amdgcn_rsqf(SS[row0 + ai * HALF + m * 16] * (1.0f / D) + 1e-6f);
#pragma unroll
                for (int bj = 0; bj < 2; ++bj) { f32x4 v0 = acc[ai][bj][m][0] * rs, v1 = acc[ai][bj][m][1] * rs;
                    if (SQRELU) {
#pragma unroll
                        for (int j = 0; j < 4; ++j) { const float p0 = fmaxf(v0[j], 0.f), p1 = fmaxf(v1[j], 0.f); v0[j] = p0 * p0; v1[j] = p1 * p1; } }
                    u32x4 w; w.x = cvt_pk_bf16(v0[0], v0[1]); w.y = cvt_pk_bf16(v0[2], v0[3]); w.z = cvt_pk_bf16(v1[0], v1[1]); w.w = cvt_pk_bf16(v1[2], v1[3]);
                    *(u32x4*)(rowp + bj * HALF) = w; } }
    }
};

template <int K, class Epi, class Sched, bool ALIGN_EPI = false>
__device__ __forceinline__ void gemm_phase(PG8_LAS unsigned char* lds, const Gemm g, const Sched& S, const Epi& E, const int tid) {
    const int wid = __builtin_amdgcn_readfirstlane(tid >> 6), lane = tid & 63, wr = wid >> 2, wc = wid & 3, fr = lane & 15, fq = lane >> 4;
    constexpr int nt = K / BK;
    unsigned voffA[2], voffB[2];
#pragma unroll
    for (int i = 0; i < 2; ++i) { int R, C; stage_rc(tid * 16 + i * 8192, R, C); const int Rb = Epi::PERM ? ((R & ~31) + perm32(R & 31)) : R;
        voffA[i] = (unsigned)(R * K + C) * 2u; voffB[i] = (unsigned)(Rb * K + C) * 2u; }
    const size_t kstep = (size_t)(BK * 2);
    const size_t hstep = (size_t)HALF * K * 2;
    const size_t tstep = 2 * hstep;
    const unsigned ldsw = (unsigned)wid * 1024u;
    const int aoff = lds_byte(wr * 64 + fr, fq * 8), boff = lds_byte(wc * 32 + fr, fq * 8);
#define PG8_SA(b, h) (((b) * 2 + (h)) * HTB)
#define PG8_SB(b, h) ((4 + (b) * 2 + (h)) * HTB)
#define PG8_STAGE(bufoff, gbase, voff) do { _Pragma("unroll") for (int _i = 0; _i < 2; ++_i) \
        __builtin_amdgcn_global_load_lds((const unsigned*)((const char*)(gbase) + (voff)[_i]), (PG8_LAS unsigned*)(lds + (bufoff) + ldsw + _i * 8192), 16, 0, 0); } while (0)
#define PG8_LDA(dst, b, h) do { _Pragma("unroll") for (int m = 0; m < 4; ++m) _Pragma("unroll") for (int k = 0; k < 2; ++k) dst[m][k] = *(const PG8_LAS bf16x8*)(lds + PG8_SA(b, h) + aoff + m * 2048 + k * 1024); } while (0)
#define PG8_LDB(dst, b, h) do { _Pragma("unroll") for (int n = 0; n < 2; ++n) _Pragma("unroll") for (int k = 0; k < 2; ++k) dst[n][k] = *(const PG8_LAS bf16x8*)(lds + PG8_SB(b, h) + boff + n * 2048 + k * 1024); } while (0)
#define PG8_MMA(ai, bj, At, Bt) do { __builtin_amdgcn_s_setprio(1); _Pragma("unroll") for (int m = 0; m < 4; ++m) _Pragma("unroll") for (int n = 0; n < 2; ++n) _Pragma("unroll") for (int k = 0; k < 2; ++k) \
        acc[ai][bj][m][n] = __builtin_amdgcn_mfma_f32_16x16x32_bf16(Bt[n][k], At[m][k], acc[ai][bj][m][n], 0, 0, 0); __builtin_amdgcn_s_setprio(0); } while (0)
#define PG8_WAIT_V(n) asm volatile("s_waitcnt vmcnt(" #n ")" ::: "memory")
#define PG8_WAIT_L(n) asm volatile("s_waitcnt lgkmcnt(" #n ")" ::: "memory")
#define PG8_BAR __builtin_amdgcn_s_barrier()
#define PG8_SCHED __builtin_amdgcn_sched_barrier(0)
    Unit cur, nxt; int ui = 0;
    if (!S.next(0, cur)) return;
    f32x4 acc[2][2][4][2];
#pragma unroll
    for (int a = 0; a < 2; ++a)
#pragma unroll
        for (int b = 0; b < 2; ++b)
#pragma unroll
            for (int m = 0; m < 4; ++m)
#pragma unroll
                for (int n = 0; n < 2; ++n) acc[a][b][m][n] = (f32x4){0.f, 0.f, 0.f, 0.f};
    bf16x8 At[4][2], B0[2][2], B1[2][2];
    const char* cA = (const char*)g.A + (size_t)cur.pm * tstep; const char* cB = (const char*)g.Bt + (size_t)cur.pn * tstep;
    S.a_ready(cur);
    PG8_STAGE(PG8_SB(0, 0), cB, voffB); PG8_STAGE(PG8_SB(0, 1), cB + hstep, voffB); PG8_STAGE(PG8_SA(0, 0), cA, voffA); PG8_STAGE(PG8_SA(0, 1), cA + hstep, voffA);
    if (wr == 1) PG8_BAR;
    PG8_WAIT_V(2); PG8_BAR;
    PG8_STAGE(PG8_SB(1, 0), cB + kstep, voffB); PG8_STAGE(PG8_SA(1, 0), cA + kstep, voffA); PG8_STAGE(PG8_SB(1, 1), cB + hstep + kstep, voffB);
    PG8_WAIT_V(6); PG8_BAR;
    for (;;) {
        const bool has_next = S.next(ui + 1, nxt);
        const char* nA = has_next ? (const char*)g.A + (size_t)nxt.pm * tstep : cA; const char* nB = has_next ? (const char*)g.Bt + (size_t)nxt.pn * tstep : cB;
        for (int t = 0; t < nt; t += 2) {
            const bool last = (t == nt - 2);
            const char* a1 = cA + (size_t)(t + 1) * kstep;
            const char* a2 = last ? nA : cA + (size_t)(t + 2) * kstep; const char* b2 = last ? nB : cB + (size_t)(t + 2) * kstep;
            const char* a3 = a2 + kstep; const char* b3 = b2 + kstep;
            if (last && has_next) S.a_ready(nxt);
            PG8_LDB(B0, 0, 0); PG8_LDB(B1, 0, 1); PG8_SCHED; PG8_LDA(At, 0, 0); PG8_STAGE(PG8_SA(1, 1), a1 + hstep, voffA);
            PG8_WAIT_V(8); PG8_WAIT_L(0); PG8_BAR; PG8_MMA(0, 0, At, B0); PG8_MMA(0, 1, At, B1); PG8_BAR; PG8_SCHED;
            PG8_LDA(At, 0, 1); PG8_STAGE(PG8_SB(0, 0), b2, voffB); PG8_STAGE(PG8_SB(0, 1), b2 + hstep, voffB); PG8_STAGE(PG8_SA(0, 0), a2, voffA);
            PG8_WAIT_V(8); PG8_WAIT_L(0); PG8_BAR; PG8_MMA(1, 0, At, B0); PG8_MMA(1, 1, At, B1); PG8_BAR; PG8_SCHED;
            PG8_LDB(B0, 1, 0); PG8_LDB(B1, 1, 1); PG8_SCHED; PG8_LDA(At, 1, 0); PG8_STAGE(PG8_SA(0, 1), a2 + hstep, voffA);
            PG8_WAIT_V(8); PG8_WAIT_L(0); PG8_BAR; PG8_MMA(0, 0, At, B0); PG8_MMA(0, 1, At, B1); PG8_BAR; PG8_SCHED;
            PG8_LDA(At, 1, 1); PG8_STAGE(PG8_SB(1, 0), b3, voffB); PG8_STAGE(PG8_SB(1, 1), b3 + hstep, voffB); PG8_STAGE(PG8_SA(1, 0), a3, voffA);
            PG8_WAIT_V(8); PG8_WAIT_L(0); PG8_BAR; PG8_MMA(1, 0, At, B0); PG8_MMA(1, 1, At, B1); PG8_BAR; PG8_SCHED;
        }
        if constexpr (ALIGN_EPI) { if (wr == 0) PG8_BAR; }
        E(acc, cur, wr, wc, fr, fq); S.done(cur);
        if (!has_next) break;
#pragma unroll
        for (int a = 0; a < 2; ++a)
#pragma unroll
            for (int b = 0; b < 2; ++b)
#pragma unroll
                for (int m = 0; m < 4; ++m)
#pragma unroll
                    for (int n = 0; n < 2; ++n) acc[a][b][m][n] = (f32x4){0.f, 0.f, 0.f, 0.f};
        cur = nxt; cA = nA; cB = nB; ++ui;
        if constexpr (ALIGN_EPI) { if (wr == 1) PG8_BAR; }
    }
    PG8_WAIT_V(0);
    if constexpr (!ALIGN_EPI) { if (wr == 0) PG8_BAR; }
    PG8_BAR;
#undef PG8_SA
#undef PG8_SB
#undef PG8_STAGE
#undef PG8_LDA
#undef PG8_LDB
#undef PG8_MMA
#undef PG8_WAIT_V
#undef PG8_WAIT_L
#undef PG8_BAR
#undef PG8_SCHED
}
}

#define LAS __attribute__((address_space(3)))
#define GAS __attribute__((address_space(1)))
typedef unsigned v4u __attribute__((ext_vector_type(4)));
constexpr int NWAVES = 8, LDS_BYTES = 163840, MISC_OFF = LDS_BYTES - 512;
#define LDS_WAIT() asm volatile("s_waitcnt lgkmcnt(0)" ::: "memory")

__device__ __forceinline__ void transpose_item(const float* W, int K, int N, int Npad, bf16_t* WT, LAS float* scr, int item, int lane) {
    const int nblk = Npad / 32, kb = item / nblk, nb = item % nblk, k0 = 64 * kb, n0 = 32 * nb;
    const int n = n0 + (lane & 31); const bool ok = n < N;
    float v[32];
    const float* src = W + (size_t)(k0 + (lane >> 5)) * N + n;
#pragma unroll
    for (int i = 0; i < 32; ++i) v[i] = ok ? src[(size_t)(2 * i) * N] : 0.f;
#pragma unroll
    for (int i = 0; i < 32; ++i) scr[(2 * i + (lane >> 5)) * 33 + (lane & 31)] = v[i];
    LDS_WAIT(); asm volatile("" ::: "memory");
    const int c = lane & 7;
#pragma unroll
    for (int j = 0; j < 4; ++j) { const int nn = (lane >> 3) + 8 * j; const LAS float* s = scr + (8 * c) * 33 + nn;
        v4u o; o.x = pk2(s[0 * 33], s[1 * 33]); o.y = pk2(s[2 * 33], s[3 * 33]); o.z = pk2(s[4 * 33], s[5 * 33]); o.w = pk2(s[6 * 33], s[7 * 33]);
        *(GAS v4u*)(WT + (size_t)(n0 + nn) * K + k0 + 8 * c) = o; }
    LDS_WAIT(); asm volatile("" ::: "memory");
}


typedef short bf16x8 __attribute__((ext_vector_type(8)));
typedef short s16x4 __attribute__((ext_vector_type(4)));
typedef unsigned u32x2 __attribute__((ext_vector_type(2)));
__device__ __forceinline__ s16x4 tr16(const LAS bf16_t* p) { return __builtin_bit_cast(s16x4, __builtin_amdgcn_ds_read_tr16_b64_v4i16((LAS s16x4*)p)); }
__device__ __forceinline__ bf16x8 frag_row(const LAS bf16_t* img, int ld, int nc0, int k0, int lane) { return *(const LAS bf16x8*)(img + (nc0 + (lane & 15)) * ld + k0 + 8 * (lane >> 4)); }
__device__ __forceinline__ bf16x8 frag_tr(const LAS bf16_t* img, int ld, int nc0, int k0, int lane) {
    const int g = lane >> 4, q = (lane & 15) >> 2, p = lane & 3;
    const LAS bf16_t* ad = img + (k0 + 8 * g + q) * ld + nc0 + 4 * p;
    const s16x4 lo = tr16(ad), hi = tr16(ad + 4 * ld);
    return (bf16x8){lo[0], lo[1], lo[2], lo[3], hi[0], hi[1], hi[2], hi[3]};
}
__device__ __forceinline__ bf16x8 frag_row_g(const bf16_t* img, int ld, int nc0, int k0, int lane) { return *(const bf16x8*)(img + (size_t)(nc0 + (lane & 15)) * ld + k0 + 8 * (lane >> 4)); }
__device__ __forceinline__ bf16x8 frag_fo(const bf16_t* img, int KS, int tile, int ks, int lane) { return *(const bf16x8*)(img + ((size_t)(tile * KS + ks) * 64 + lane) * 8); }
__device__ __forceinline__ int fo_st(int tile, int KS, int k0, int g, int r) { const int k = k0 + 4 * g; return ((tile * KS + (k >> 5)) * 64 + ((k >> 3) & 3) * 16 + r) * 8 + (k & 7); }
__device__ __forceinline__ int co_off(int tj, int NI, int ti, int lane) { return ((tj * NI + ti) * 64 + lane) * 4; }
__device__ __forceinline__ f32x4 mfma16(bf16x8 a, bf16x8 b, f32x4 c) { return __builtin_amdgcn_mfma_f32_16x16x32_bf16(a, b, c, 0, 0, 0); }
__device__ __forceinline__ u32x2 pack4(f32x4 v) { u32x2 w; w.x = pk2(v[0], v[1]); w.y = pk2(v[2], v[3]); return w; }
__device__ __forceinline__ f32x4 unpack4(u32x2 w) { f32x4 v; v[0] = __uint_as_float(w.x << 16); v[1] = __uint_as_float(w.x & 0xffff0000u); v[2] = __uint_as_float(w.y << 16); v[3] = __uint_as_float(w.y & 0xffff0000u); return v; }
#define WG_SYNC() __syncthreads()

__device__ __forceinline__ void ret_stage1(CArgs& a, int n, int h, LAS unsigned char* lds, int tid) {
    const int lane = tid & 63, w = __builtin_amdgcn_readfirstlane(tid >> 6), r = lane & 15, g = lane >> 4;
    constexpr int LD = 72, LDV = 136;
    LAS bf16_t* Qi = (LAS bf16_t*)lds; LAS bf16_t* Ki = Qi + 64 * LD; LAS bf16_t* Kdi = Ki + 64 * LD; LAS bf16_t* Vi = Kdi + 64 * LD; LAS bf16_t* Si = Vi + 64 * LDV;
    const int tk = n * 4 + h; const float lg2 = log2f(1.0f - exp2f(-5.0f - (float)h));
    bf16_t* QH = (bf16_t*)(a.ws + WS_RET_QH) + (size_t)tk * 4096;
    for (int idx = tid; idx < 2048; idx += 512) {
        const int c = idx >> 5, i = idx & 31, t = n * 64 + c; float sn, cs; sincosf((float)t * THETA[i], &sn, &cs);
        const bf16_t* pr = PROJROW(t);
        const unsigned qq = *(const unsigned*)(pr + C_RQ + 64 * h + 2 * i), kk = *(const unsigned*)(pr + C_RK + 64 * h + 2 * i);
        const float q0 = __uint_as_float(qq << 16), q1 = __uint_as_float(qq & 0xffff0000u), k0 = __uint_as_float(kk << 16), k1 = __uint_as_float(kk & 0xffff0000u);
        const float rq0 = q0 * cs - q1 * sn, rq1 = q1 * cs + q0 * sn, rk0 = (k0 * cs - k1 * sn) * 0.125f, rk1 = (k1 * cs + k0 * sn) * 0.125f;
        const float dk = exp2f(lg2 * (float)(63 - c)), dq = exp2f(lg2 * (float)(c + 1));
        *(LAS unsigned*)(Qi + c * LD + 2 * i) = pk2(rq0, rq1); *(LAS unsigned*)(Ki + c * LD + 2 * i) = pk2(rk0, rk1); *(LAS unsigned*)(Kdi + c * LD + 2 * i) = pk2(rk0 * dk, rk1 * dk);
        { const int d = 2 * i; *(unsigned*)(QH + (((c >> 4) * 2 + (d >> 5)) * 64 + ((d >> 3) & 3) * 16 + (c & 15)) * 8 + (d & 7)) = pk2(rq0 * dq, rq1 * dq); }
    }
    for (int idx = tid; idx < 1024; idx += 512) { const int c = idx >> 4, ch = idx & 15; *(LAS v4u*)(Vi + c * LDV + 8 * ch) = *(const v4u*)(PROJROW(n * 64 + c) + C_RV + 128 * h + 8 * ch); }
    WG_SYNC();
#pragma unroll
    for (int tt = 0; tt < 2; ++tt) { const int tile = 2 * w + tt, im = tile >> 2, jc = tile & 3; f32x4 acc = {0.f, 0.f, 0.f, 0.f};
        if (jc >= im) {
#pragma unroll
            for (int k0 = 0; k0 < 64; k0 += 32) acc = mfma16(frag_row(Ki, LD, 16 * im, k0, lane), frag_row(Qi, LD, 16 * jc, k0, lane), acc);
#pragma unroll
            for (int e = 0; e < 4; ++e) { const int i = 16 * im + 4 * g + e, j = 16 * jc + r; acc[e] = j >= i ? acc[e] * exp2f(lg2 * (float)(j - i)) : 0.f; } }
        *(LAS u32x2*)(Si + (16 * jc + r) * LD + 16 * im + 4 * g) = pack4(acc); }
    WG_SYNC();
    bf16_t* YI = (bf16_t*)(a.ws + WS_RET_YI) + (size_t)tk * 8192; float* Z = WSF(WS_RET_Z) + (size_t)tk * 8192;
#pragma unroll
    for (int tt = 0; tt < 4; ++tt) { const int jc = w & 3, ie = 4 * (w >> 2) + tt; f32x4 acc = {0.f, 0.f, 0.f, 0.f};
#pragma unroll
        for (int k0 = 0; k0 < 64; k0 += 32) acc = mfma16(frag_tr(Vi, LDV, 16 * ie, k0, lane), frag_row(Si, LD, 16 * jc, k0, lane), acc);
        *(u32x2*)(YI + co_off(jc, 8, ie, lane)) = pack4(acc); }
#pragma unroll
    for (int tt = 0; tt < 4; ++tt) { const int id = w & 3, je = 4 * (w >> 2) + tt; f32x4 acc = {0.f, 0.f, 0.f, 0.f};
#pragma unroll
        for (int k0 = 0; k0 < 64; k0 += 32) acc = mfma16(frag_tr(Kdi, LD, 16 * id, k0, lane), frag_tr(Vi, LDV, 16 * je, k0, lane), acc);
        *(f32x4*)(Z + fo_st(je, 2, 16 * id, g, r)) = acc; }
    WG_SYNC();
}
__device__ __forceinline__ void ret_stage2(CArgs& a, int b, int tid) {
    const int idx = b * 512 + tid, h = idx >> 13, rem = idx & 8191; const float g64 = exp2f(64.0f * log2f(1.0f - exp2f(-5.0f - (float)h)));
    const float* Z = WSF(WS_RET_Z) + (size_t)h * 8192 + rem; bf16_t* S = (bf16_t*)(a.ws + WS_RET_S) + (size_t)h * 8192 + rem; float s = 0.f;
#pragma unroll 8
    for (int n = 0; n < NCH; ++n) { const float z = Z[(size_t)n * 4 * 8192]; S[(size_t)n * 4 * 8192] = (bf16_t)f2bf(s); s = g64 * s + z; }
}
__device__ __forceinline__ void ret_stage3(CArgs& a, int l, int n, int h, LAS unsigned char* lds, int tid) {
    const int lane = tid & 63, w = __builtin_amdgcn_readfirstlane(tid >> 6), r = lane & 15, g = lane >> 4, jc = w & 3, wh = w >> 2;
    const int tk = n * 4 + h; const int c = 16 * jc + r, t = n * 64 + c;
    const bf16_t* S = (const bf16_t*)(a.ws + WS_RET_S) + (size_t)tk * 8192; const bf16_t* QH = (const bf16_t*)(a.ws + WS_RET_QH) + (size_t)tk * 4096; const bf16_t* YI = (const bf16_t*)(a.ws + WS_RET_YI) + (size_t)tk * 8192;
    LAS float* xs = (LAS float*)lds;
    f32x4 acc[4];
#pragma unroll
    for (int tt = 0; tt < 4; ++tt) { const int ie = 4 * wh + tt; acc[tt] = unpack4(*(const u32x2*)(YI + co_off(jc, 8, ie, lane)));
#pragma unroll
        for (int k = 0; k < 2; ++k) acc[tt] = mfma16(frag_fo(S, 2, ie, k, lane), frag_fo(QH, 2, jc, k, lane), acc[tt]); }
    float s1 = 0.f;
#pragma unroll
    for (int tt = 0; tt < 4; ++tt) s1 += (acc[tt][0] + acc[tt][1]) + (acc[tt][2] + acc[tt][3]);
    s1 += __shfl_xor(s1, 16); s1 += __shfl_xor(s1, 32);
    if (g == 0) xs[w * 16 + r] = s1;
    WG_SYNC();
    const float mu = (s1 + xs[(w ^ 4) * 16 + r]) * (1.0f / 128.0f); float s2 = 0.f;
#pragma unroll
    for (int tt = 0; tt < 4; ++tt)
#pragma unroll
        for (int e = 0; e < 4; ++e) { acc[tt][e] -= mu; s2 += acc[tt][e] * acc[tt][e]; }
    s2 += __shfl_xor(s2, 16); s2 += __shfl_xor(s2, 32);
    if (g == 0) xs[128 + w * 16 + r] = s2;
    WG_SYNC();
    const float rs = 1.0f / sqrtf((s2 + xs[128 + (w ^ 4) * 16 + r]) * (1.0f / 128.0f) + 1e-6f);
    const float* nw = LP(I_RNORM, 512) + h * 128; const bf16_t* pr = PROJROW(t) + C_RG + h * 128; bf16_t* O = (bf16_t*)(a.ws + WS_O) + (size_t)t * D + 512 + h * 128;
#pragma unroll
    for (int tt = 0; tt < 4; ++tt) { const int e0 = 16 * (4 * wh + tt) + 4 * g; const f32x4 gt = unpack4(*(const u32x2*)(pr + e0)); const f32x4 wv = *(const f32x4*)(nw + e0); f32x4 y;
#pragma unroll
        for (int e = 0; e < 4; ++e) y[e] = acc[tt][e] * rs * wv[e] * silu_f(gt[e]);
        *(u32x2*)(O + e0) = pack4(y); }
    WG_SYNC();
}

constexpr int RW_LD = 72;
constexpr int RWO_V = 0, RWO_IMG = 9216  , RWO_XI = 36864  , RWO_UI = 55296, RWO_CUMC = 64512, RWO_WT = 65536  , RWO_AM = 65536, RWO_TRI = 82944,
              RWO_RHST = 110592, RWO_AI = 143360, RWO_DI = 152576;
constexpr int RWO_LW = 9216, RWO_LIN = 82944;
__device__ __forceinline__ float ftanh(float x) { return 1.0f - 2.0f * __builtin_amdgcn_rcpf(1.0f + fexp(2.0f * x)); }
__device__ __forceinline__ float fsoftplus(float x) { return x > 20.f ? x : __builtin_amdgcn_logf(1.0f + fexp(x)) * 0.6931471805599453f; }
__device__ __forceinline__ void rw_stage1(CArgs& a, int l, int n, int h, LAS unsigned char* lds, int tid, const int stop = 99) {
    const int w = __builtin_amdgcn_readfirstlane(tid >> 6), tk = n * 8 + h;
    int lane, r, g, c, kg, t;
#define RW_IDX() do { int tl_ = tid; asm volatile("" : "+v"(tl_)); lane = tl_ & 63; r = lane & 15; g = lane >> 4; c = tl_ >> 3; kg = tl_ & 7; t = n * 64 + c; } while (0)
    RW_IDX();
    LAS bf16_t* Vi = (LAS bf16_t*)(lds + RWO_V);
    LAS bf16_t* RHi = (LAS bf16_t*)(lds + RWO_IMG); LAS bf16_t* BTi = RHi + 64 * RW_LD; LAS bf16_t* KTi = BTi + 64 * RW_LD; LAS bf16_t* KHi = KTi + 64 * RW_LD; LAS bf16_t* BMi = KHi + 64 * RW_LD; LAS bf16_t* KMi = BMi + 64 * RW_LD;
    LAS bf16_t* XI = (LAS bf16_t*)(lds + RWO_XI);
    LAS bf16_t* UI = (LAS bf16_t*)(lds + RWO_UI);
    LAS float* CUMC = (LAS float*)(lds + RWO_CUMC); LAS float* WT = (LAS float*)(lds + RWO_WT); LAS float* AM = (LAS float*)(lds + RWO_AM);
    LAS bf16_t* BMI = (LAS bf16_t*)(lds + RWO_TRI); LAS bf16_t* PBI = BMI + 64 * RW_LD; LAS bf16_t* PKI = PBI + 64 * RW_LD;
    LAS float* RHST = (LAS float*)(lds + RWO_RHST);
    LAS bf16_t* AI = (LAS bf16_t*)(lds + RWO_AI);
    LAS bf16_t* DI = (LAS bf16_t*)(lds + RWO_DI);
    LAS float* LW = (LAS float*)(lds + RWO_LW); LAS float* LA = LW + 4096; LAS float* LG = LA + 4096;
    LAS bf16_t* WLi = (LAS bf16_t*)(lds + RWO_LIN); LAS bf16_t* ALi = WLi + 64 * 40; LAS bf16_t* GLi = ALi + 64 * 40; LAS bf16_t* WUPi = GLi + 64 * 104; LAS bf16_t* AUPi = WUPi + 32 * RW_LD; LAS bf16_t* GUPi = AUPi + 32 * RW_LD;
    const float* mu = LP(I_RWMU, 1696); const bf16_t* p1 = PROJROW(t) + C_RW; const bf16_t* p0 = p1 - PTP; bool hp = t > 0;
    float vv[8];
    { const v4u cu = *(const v4u*)(p1 + 1024 + 64 * h + 8 * kg); v4u pv = {0u, 0u, 0u, 0u}; if (hp) pv = *(const v4u*)(p0 + 1024 + 64 * h + 8 * kg);
      const float* m = mu + 1024 + 64 * h + 8 * kg; const f32x4 m0 = *(const f32x4*)m, m1 = *(const f32x4*)(m + 4); v4u o;
#pragma unroll
      for (int u = 0; u < 4; ++u) { const unsigned cw = cu[u], pw = pv[u]; const float c0 = __uint_as_float(cw << 16), c1 = __uint_as_float(cw & 0xffff0000u), q0 = __uint_as_float(pw << 16), q1 = __uint_as_float(pw & 0xffff0000u);
          const float ma = u < 2 ? m0[2 * u] : m1[2 * u - 4], mb = u < 2 ? m0[2 * u + 1] : m1[2 * u - 3];
          vv[2 * u] = c0 + (q0 - c0) * ma; vv[2 * u + 1] = c1 + (q1 - c1) * mb; o[u] = pk2(vv[2 * u], vv[2 * u + 1]); }
      *(LAS v4u*)(Vi + c * RW_LD + 8 * kg) = o; }
    {
      u32x2 cw = *(const u32x2*)(p1 + 1536 + 4 * kg), ca = *(const u32x2*)(p1 + 1568 + 4 * kg), pw = {0u, 0u}, pa = {0u, 0u};
      u32x2 cg[3], pg[3] = {{0u, 0u}, {0u, 0u}, {0u, 0u}};
#pragma unroll
      for (int q = 0; q < 3; ++q) cg[q] = *(const u32x2*)(p1 + 1600 + 12 * kg + 4 * q);
      if (hp) { pw = *(const u32x2*)(p0 + 1536 + 4 * kg); pa = *(const u32x2*)(p0 + 1568 + 4 * kg);
#pragma unroll
          for (int q = 0; q < 3; ++q) pg[q] = *(const u32x2*)(p0 + 1600 + 12 * kg + 4 * q); }
      const f32x4 mw = *(const f32x4*)(mu + 1536 + 4 * kg), ma = *(const f32x4*)(mu + 1568 + 4 * kg);
      { const f32x4 cv = unpack4(cw), pv = unpack4(pw); f32x4 x;
#pragma unroll
        for (int u = 0; u < 4; ++u) x[u] = ftanh(cv[u] + (pv[u] - cv[u]) * mw[u]);
        *(LAS u32x2*)(WLi + c * 40 + 4 * kg) = pack4(x); }
      { const f32x4 cv = unpack4(ca), pv = unpack4(pa); f32x4 x;
#pragma unroll
        for (int u = 0; u < 4; ++u) x[u] = cv[u] + (pv[u] - cv[u]) * ma[u];
        *(LAS u32x2*)(ALi + c * 40 + 4 * kg) = pack4(x); }
#pragma unroll
      for (int q = 0; q < 3; ++q) { const f32x4 cv = unpack4(cg[q]), pv = unpack4(pg[q]), mg = *(const f32x4*)(mu + 1600 + 12 * kg + 4 * q); f32x4 x;
#pragma unroll
          for (int u = 0; u < 4; ++u) x[u] = sigmoid_f(cv[u] + (pv[u] - cv[u]) * mg[u]);
          *(LAS u32x2*)(GLi + c * 104 + 12 * kg + 4 * q) = pack4(x); } }
    { const int j = tid >> 4, k4 = (tid & 15) * 4;
      const f32x4 wv = *(const f32x4*)(LP(I_RWWUP, 32 * 512) + j * 512 + 64 * h + k4), av = *(const f32x4*)(LP(I_RWAUP, 32 * 512) + j * 512 + 64 * h + k4);
      *(LAS u32x2*)(WUPi + j * RW_LD + k4) = pack4(wv); *(LAS u32x2*)(AUPi + j * RW_LD + k4) = pack4(av);
#pragma unroll
      for (int q = 0; q < 3; ++q) { const f32x4 gv = *(const f32x4*)(LP(I_RWGUP, 96 * 512) + (32 * q + j) * 512 + 64 * h + k4); *(LAS u32x2*)(GUPi + (32 * q + j) * RW_LD + k4) = pack4(gv); } }
    WG_SYNC();
    if (stop <= 0) return;
    RW_IDX();
#pragma unroll
    for (int tt = 0; tt < 2; ++tt) { const int tile = 2 * w + tt, ik = tile >> 2, jc = tile & 3;
        f32x4 aw = {0.f, 0.f, 0.f, 0.f}, aa = aw, ag = aw;
        aw = mfma16(frag_tr(WUPi, RW_LD, 16 * ik, 0, lane), frag_row(WLi, 40, 16 * jc, 0, lane), aw);
        aa = mfma16(frag_tr(AUPi, RW_LD, 16 * ik, 0, lane), frag_row(ALi, 40, 16 * jc, 0, lane), aa);
#pragma unroll
        for (int k0 = 0; k0 < 96; k0 += 32) ag = mfma16(frag_tr(GUPi, RW_LD, 16 * ik, k0, lane), frag_row(GLi, 104, 16 * jc, k0, lane), ag);
        const int o = (16 * jc + r) * 64 + 16 * ik + 4 * g; *(LAS f32x4*)(LW + o) = aw; *(LAS f32x4*)(LA + o) = aa; *(LAS f32x4*)(LG + o) = ag; }
    WG_SYNC();
    if (stop <= 1) return;
    RW_IDX();
    p1 = PROJROW(t) + C_RW; p0 = p1 - PTP; hp = t > 0;
    float rr[8], kk[8], bb[8], kt[8], lwd[8], cum[8];
    { const int ch0 = 64 * h + 8 * kg; float ss = 0.f, rk = 0.f; float gt[8];
      const v4u cr = *(const v4u*)(p1 + ch0), ck = *(const v4u*)(p1 + 512 + ch0); v4u qr = {0u, 0u, 0u, 0u}, qk = qr; if (hp) { qr = *(const v4u*)(p0 + ch0); qk = *(const v4u*)(p0 + 512 + ch0); }
      float pw0[8], pa0[8], pkk[8], pka[8], prk[8], pmr[8], pmk[8];
#pragma unroll
      for (int q = 0; q < 2; ++q) { const f32x4 x0 = *(const f32x4*)(LP(I_RWW0, 512) + ch0 + 4 * q), x1 = *(const f32x4*)(LP(I_RWA0, 512) + ch0 + 4 * q), x2 = *(const f32x4*)(LP(I_RWKK, 512) + ch0 + 4 * q), x3 = *(const f32x4*)(LP(I_RWKA, 512) + ch0 + 4 * q),
                                                 x4 = *(const f32x4*)(LP(I_RWRK, 512) + ch0 + 4 * q), x5 = *(const f32x4*)(mu + ch0 + 4 * q), x6 = *(const f32x4*)(mu + 512 + ch0 + 4 * q);
#pragma unroll
          for (int e = 0; e < 4; ++e) { pw0[4 * q + e] = x0[e]; pa0[4 * q + e] = x1[e]; pkk[4 * q + e] = x2[e]; pka[4 * q + e] = x3[e]; prk[4 * q + e] = x4[e]; pmr[4 * q + e] = x5[e]; pmk[4 * q + e] = x6[e]; } }
#pragma unroll
      for (int u = 0; u < 8; ++u) { const unsigned crw = cr[u >> 1], ckw = ck[u >> 1], qrw = qr[u >> 1], qkw = qk[u >> 1];
          const float curR = (u & 1) ? __uint_as_float(crw & 0xffff0000u) : __uint_as_float(crw << 16), curK = (u & 1) ? __uint_as_float(ckw & 0xffff0000u) : __uint_as_float(ckw << 16);
          const float prvR = (u & 1) ? __uint_as_float(qrw & 0xffff0000u) : __uint_as_float(qrw << 16), prvK = (u & 1) ? __uint_as_float(qkw & 0xffff0000u) : __uint_as_float(qkw << 16);
          const float rv = curR + (prvR - curR) * pmr[u], kr = curK + (prvK - curK) * pmk[u];
          const float lw = LW[c * 64 + 8 * kg + u], la = LA[c * 64 + 8 * kg + u]; gt[u] = LG[c * 64 + 8 * kg + u];
          const float wraw = -fsoftplus(-(pw0[u] + lw)) - 0.5f; lwd[u] = -fexp(wraw);
          const float av = sigmoid_f(pa0[u] + la); const float kkr = kr * pkk[u]; kt[u] = kr * (1.0f + (av - 1.0f) * pka[u]);
          rr[u] = rv; kk[u] = kkr; bb[u] = av; ss += kkr * kkr; rk += rv * kt[u] * prk[u]; }
      ss += __shfl_xor(ss, 1); ss += __shfl_xor(ss, 2); ss += __shfl_xor(ss, 4); rk += __shfl_xor(rk, 1); rk += __shfl_xor(rk, 2); rk += __shfl_xor(rk, 4);
      const float inv = __builtin_amdgcn_rsqf(ss + 1e-6f);
#pragma unroll
      for (int u = 0; u < 8; ++u) { kk[u] *= inv; bb[u] *= kk[u]; }
#pragma unroll
      for (int u = 0; u < 8; ++u) { float x = lwd[u];
#pragma unroll
          for (int o = 8; o < 64; o <<= 1) { const float up = __shfl_up(x, o); if (lane >= o) x += up; }
          cum[u] = x; }
      if (lane >= 56) { *(LAS f32x4*)(WT + w * 64 + 8 * kg) = (f32x4){cum[0], cum[1], cum[2], cum[3]}; *(LAS f32x4*)(WT + w * 64 + 8 * kg + 4) = (f32x4){cum[4], cum[5], cum[6], cum[7]}; }
      v4u eo, go;
#pragma unroll
      for (int u = 0; u < 4; ++u) { eo[u] = pk2(rk * vv[2 * u], rk * vv[2 * u + 1]); go[u] = pk2(gt[2 * u], gt[2 * u + 1]); }
      bf16_t* Eo = (bf16_t*)(a.ws + WS_RW_E) + (size_t)tk * 4096; bf16_t* Go = (bf16_t*)(a.ws + WS_RW_GT) + (size_t)tk * 4096;
#pragma unroll
      for (int hf = 0; hf < 2; ++hf) { const int o = (((c >> 4) * 4 + (kg >> 1)) * 64 + ((2 * kg + hf) & 3) * 16 + (c & 15)) * 4;
          *(u32x2*)(Eo + o) = (u32x2){eo[2 * hf], eo[2 * hf + 1]}; *(u32x2*)(Go + o) = (u32x2){go[2 * hf], go[2 * hf + 1]}; } }
    WG_SYNC();
    if (stop <= 3) return;
    RW_IDX();
    { float cc[8];
#pragma unroll
      for (int u = 0; u < 8; ++u) cc[u] = 0.f;
#pragma unroll
      for (int ww = 0; ww < 8; ++ww) { const f32x4 t0 = *(const LAS f32x4*)(WT + ww * 64 + 8 * kg), t1 = *(const LAS f32x4*)(WT + ww * 64 + 8 * kg + 4);
#pragma unroll
          for (int e = 0; e < 4; ++e) { if (ww < w) { cum[e] += t0[e]; cum[4 + e] += t1[e]; } cc[e] += t0[e]; cc[4 + e] += t1[e]; } }
      if (c == 0) { *(LAS f32x4*)(CUMC + 8 * kg) = (f32x4){cc[0], cc[1], cc[2], cc[3]}; *(LAS f32x4*)(CUMC + 8 * kg + 4) = (f32x4){cc[4], cc[5], cc[6], cc[7]}; }
      v4u oRH, oBT, oKT, oKH, oBM, oKM;
#pragma unroll
      for (int u = 0; u < 8; u += 2) { float x[6][2];
#pragma unroll
          for (int e = 0; e < 2; ++e) { const float cu = cum[u + e]; const float ep = fexp(cu), em = fexp(-cu), et = fexp(cc[u + e] - cu), ex = fexp(cu - lwd[u + e]);
              x[0][e] = rr[u + e] * ep; x[1][e] = bb[u + e] * et; x[2][e] = kt[u + e] * et; x[3][e] = kk[u + e] * ex; x[4][e] = bb[u + e] * em; x[5][e] = kt[u + e] * em;
              RHST[(8 * kg + u + e) * 64 + c] = x[3][e]; }
          oRH[u >> 1] = pk2(x[0][0], x[0][1]); oBT[u >> 1] = pk2(x[1][0], x[1][1]); oKT[u >> 1] = pk2(x[2][0], x[2][1]); oKH[u >> 1] = pk2(x[3][0], x[3][1]); oBM[u >> 1] = pk2(x[4][0], x[4][1]); oKM[u >> 1] = pk2(x[5][0], x[5][1]); }
      const int o = c * RW_LD + 8 * kg;
      *(LAS v4u*)(RHi + o) = oRH; *(LAS v4u*)(BTi + o) = oBT; *(LAS v4u*)(KTi + o) = oKT; *(LAS v4u*)(KHi + o) = oKH; *(LAS v4u*)(BMi + o) = oBM; *(LAS v4u*)(KMi + o) = oKM; }
    WG_SYNC();
    if (stop <= 4) return;
    RW_IDX();
#pragma unroll
    for (int tt = 0; tt < 2; ++tt) { const int tile = 2 * w + tt, ii = tile >> 2, jt = tile & 3;
        f32x4 cA = {0.f, 0.f, 0.f, 0.f}, cB = cA, cPb = cA, cPk = cA;
        if (ii <= jt) {
#pragma unroll
            for (int k0 = 0; k0 < 64; k0 += 32) { const bf16x8 fbm = frag_row(BMi, RW_LD, 16 * ii, k0, lane), fkm = frag_row(KMi, RW_LD, 16 * ii, k0, lane), fkh = frag_row(KHi, RW_LD, 16 * jt, k0, lane), frh = frag_row(RHi, RW_LD, 16 * jt, k0, lane);
                cA = mfma16(fbm, fkh, cA); cB = mfma16(fkm, fkh, cB); cPb = mfma16(fbm, frh, cPb); cPk = mfma16(fkm, frh, cPk); }
#pragma unroll
            for (int e = 0; e < 4; ++e) { const int i = 16 * ii + 4 * g + e, tq = 16 * jt + r; if (!(i < tq)) { cA[e] = 0.f; cB[e] = 0.f; } if (!(i <= tq)) { cPb[e] = 0.f; cPk[e] = 0.f; } } }
        const int tq = 16 * jt + r, i0 = 16 * ii + 4 * g;
        *(LAS f32x4*)(AM + tq * 68 + i0) = cA; *(LAS u32x2*)(AI + tq * RW_LD + i0) = pack4(-cA); *(LAS u32x2*)(BMI + tq * RW_LD + i0) = pack4(cB); *(LAS u32x2*)(PBI + tq * RW_LD + i0) = pack4(cPb); *(LAS u32x2*)(PKI + tq * RW_LD + i0) = pack4(cPk); }
    WG_SYNC();
    if (stop <= 5) return;
    RW_IDX();
#pragma unroll
    for (int tt = 0; tt < 2; ++tt) { const int tile = 2 * w + tt, it = tile >> 2, jv = tile & 3; f32x4 acc = {0.f, 0.f, 0.f, 0.f};
#pragma unroll
        for (int k0 = 0; k0 < 64; k0 += 32) acc = mfma16(frag_row(BMI, RW_LD, 16 * it, k0, lane), frag_tr(Vi, RW_LD, 16 * jv, k0, lane), acc);
        *(LAS f32x4*)(RHST + (64 + 16 * jv + r) * 64 + 16 * it + 4 * g) = acc; }
    { const int q = c * 8 + kg;
      if (q < 64) { const int b = q >> 4, j = q & 15; float d[16];
#pragma unroll
          for (int tq = 0; tq < 16; ++tq) { float acc = tq == j ? 1.f : 0.f;
#pragma unroll
              for (int i = 0; i < tq; ++i) acc -= AM[(16 * b + tq) * 68 + 16 * b + i] * d[i];
              d[tq] = acc; DI[(b * 16 + tq) * 32 + j] = (bf16_t)f2bf(acc); DI[(b * 16 + tq) * 32 + 16 + j] = (bf16_t)0; } }
      for (int i = q; i < 128 * RW_LD / 8; i += 512) *(LAS v4u*)(XI + 8 * i) = (v4u){0u, 0u, 0u, 0u};
      *(LAS v4u*)(UI + w * 512 + lane * 8) = (v4u){0u, 0u, 0u, 0u}; }
    WG_SYNC();
    if (stop <= 6) return;
    RW_IDX();
    { LAS bf16_t* Uw = UI + w * 512; LAS bf16_t* Xw = XI + (16 * w) * RW_LD;
#pragma unroll
      for (int b = 0; b < 4; ++b) { f32x4 acc = *(const LAS f32x4*)(RHST + (16 * w + r) * 64 + 16 * b + 4 * g);
#pragma unroll
          for (int k0 = 0; k0 < 16 * b; k0 += 32) acc = mfma16(frag_row(AI, RW_LD, 16 * b, k0, lane), frag_row(Xw, RW_LD, 0, k0, lane), acc);
          *(LAS u32x2*)(Uw + r * 32 + 4 * g) = pack4(acc);
          asm volatile("s_waitcnt lgkmcnt(0)" ::: "memory");
          f32x4 x = {0.f, 0.f, 0.f, 0.f}; x = mfma16(frag_row(DI + b * 512, 32, 0, 0, lane), frag_row(Uw, 32, 0, 0, lane), x);
          *(LAS u32x2*)(Xw + r * RW_LD + 16 * b + 4 * g) = pack4(x);
          asm volatile("s_waitcnt lgkmcnt(0)" ::: "memory"); } }
    WG_SYNC();
    if (stop <= 7) return;
    RW_IDX();
    { const int o = w >> 1; const LAS bf16_t* WHt = XI; const LAS bf16_t* XTt = XI + 64 * RW_LD;
#pragma unroll
      for (int tt = 0; tt < 8; ++tt) { const int tile = (w & 1) * 8 + tt, ti = tile >> 2, tj = tile & 3; f32x4 c1 = {0.f, 0.f, 0.f, 0.f}, c2 = c1;
          if (o == 0) {
#pragma unroll
              for (int k0 = 0; k0 < 64; k0 += 32) c1 = mfma16(frag_row(WHt, RW_LD, 16 * ti, k0, lane), frag_tr(BTi, RW_LD, 16 * tj, k0, lane), c1);
              const int kq = 16 * tj + r; const float dg = fexp(CUMC[kq]); f32x4 gv;
#pragma unroll
              for (int e = 0; e < 4; ++e) gv[e] = ((16 * ti + 4 * g + e) == kq ? dg : 0.f) - c1[e];
              *(u32x2*)((bf16_t*)(a.ws + WS_RW_G) + (size_t)tk * 4096 + fo_st(tj, 2, 16 * ti, g, r)) = pack4(gv);
          } else if (o == 1) {
#pragma unroll
              for (int k0 = 0; k0 < 64; k0 += 32) { c1 = mfma16(frag_tr(KTi, RW_LD, 16 * ti, k0, lane), frag_tr(Vi, RW_LD, 16 * tj, k0, lane), c1); c2 = mfma16(frag_tr(BTi, RW_LD, 16 * ti, k0, lane), frag_row(XTt, RW_LD, 16 * tj, k0, lane), c2); }
              *(f32x4*)(WSF(WS_RW_Z) + (size_t)tk * 4096 + co_off(tj, 4, ti, lane)) = c1 - c2;
          } else if (o == 2) {
#pragma unroll
              for (int k0 = 0; k0 < 64; k0 += 32) c1 = mfma16(frag_row(WHt, RW_LD, 16 * ti, k0, lane), frag_row(PBI, RW_LD, 16 * tj, k0, lane), c1);
              const int tq = 16 * tj + r; const f32x4 rh = unpack4(*(const LAS u32x2*)(RHi + tq * RW_LD + 16 * ti + 4 * g));
              *(u32x2*)((bf16_t*)(a.ws + WS_RW_QT) + (size_t)tk * 4096 + fo_st(tj, 2, 16 * ti, g, r)) = pack4(rh - c1);
          } else {
#pragma unroll
              for (int k0 = 0; k0 < 64; k0 += 32) { c1 = mfma16(frag_tr(Vi, RW_LD, 16 * ti, k0, lane), frag_row(PKI, RW_LD, 16 * tj, k0, lane), c1); c2 = mfma16(frag_row(XTt, RW_LD, 16 * ti, k0, lane), frag_row(PBI, RW_LD, 16 * tj, k0, lane), c2); }
              *(u32x2*)((bf16_t*)(a.ws + WS_RW_YI) + (size_t)tk * 4096 + co_off(tj, 4, ti, lane)) = pack4(c1 - c2);
          } } }
    WG_SYNC();
#undef RW_IDX
}
__device__ __forceinline__ void rw_stage2(CArgs& a, int h, int vs, LAS unsigned char* lds, int tid) {
    const int lane = tid & 63, w = __builtin_amdgcn_readfirstlane(tid >> 6), r = lane & 15, g = lane >> 4;
    LAS bf16_t* Si = (LAS bf16_t*)lds;
    const bf16_t* G = (const bf16_t*)(a.ws + WS_RW_G); const float* Z = WSF(WS_RW_Z); bf16_t* S = (bf16_t*)(a.ws + WS_RW_S);
    if (w < 4) { *(LAS u32x2*)(Si + r * RW_LD + 16 * w + 4 * g) = (u32x2){0u, 0u}; *(u32x2*)(S + (size_t)h * 4096 + fo_st(vs, 2, 16 * w, g, r)) = (u32x2){0u, 0u}; }
    WG_SYNC();
    constexpr int PD = 8; const int wq = w & 3; const int so = fo_st(vs, 2, 16 * wq, g, r), zo = co_off(vs, 4, wq, lane);
    bf16x8 gf[PD][2]; f32x4 zf[PD];
#pragma unroll
    for (int u = 0; u < PD; ++u) { const size_t tk = (size_t)u * 8 + h; zf[u] = *(const f32x4*)(Z + tk * 4096 + zo); gf[u][0] = frag_fo(G + tk * 4096, 2, wq, 0, lane); gf[u][1] = frag_fo(G + tk * 4096, 2, wq, 1, lane); }
#define RW_STEP(n_, u_, REFILL) do { const int n = (n_); const size_t tk = (size_t)n * 8 + h; const int cur = n & 1; \
            f32x4 acc = zf[u_], acc2 = {0.f, 0.f, 0.f, 0.f}; \
            acc = mfma16(gf[u_][0], frag_row(Si + cur * 16 * RW_LD, RW_LD, 0, 0, lane), acc); acc2 = mfma16(gf[u_][1], frag_row(Si + cur * 16 * RW_LD, RW_LD, 0, 32, lane), acc2); \
            if (REFILL) { const int nn = n + PD < NCH - 1 ? n + PD : NCH - 2; const size_t tn = (size_t)nn * 8 + h; zf[u_] = *(const f32x4*)(Z + tn * 4096 + zo); gf[u_][0] = frag_fo(G + tn * 4096, 2, wq, 0, lane); gf[u_][1] = frag_fo(G + tn * 4096, 2, wq, 1, lane); } \
            const u32x2 pv = pack4(acc + acc2); \
            if (w < 4) { *(LAS u32x2*)(Si + (cur ^ 1) * 16 * RW_LD + r * RW_LD + 16 * wq + 4 * g) = pv; *(u32x2*)(S + (tk + 8) * 4096 + so) = pv; } \
            asm volatile("s_waitcnt lgkmcnt(0)" ::: "memory"); __builtin_amdgcn_s_barrier(); asm volatile("" ::: "memory"); } while (0)
#pragma unroll
    for (int nq = 0; nq < NCH - 1; ++nq) RW_STEP(nq, nq % PD, nq + PD < NCH - 1);
#undef RW_STEP
}
__device__ __forceinline__ void rw_stage3(CArgs& a, int l, int n, int h, LAS unsigned char* lds, int tid) {
    const int lane = tid & 63, w = __builtin_amdgcn_readfirstlane(tid >> 6), r = lane & 15, g = lane >> 4, jc = w & 3, wh = w >> 2;
    const size_t tk = (size_t)n * 8 + h; const int c = 16 * jc + r, t = n * 64 + c;
    const bf16_t* S = (const bf16_t*)(a.ws + WS_RW_S) + tk * 4096; const bf16_t* QT = (const bf16_t*)(a.ws + WS_RW_QT) + tk * 4096; const bf16_t* YI = (const bf16_t*)(a.ws + WS_RW_YI) + tk * 4096;
    LAS float* xs = (LAS float*)lds;
    f32x4 acc[2];
#pragma unroll
    for (int tt = 0; tt < 2; ++tt) { const int iv = 2 * wh + tt; acc[tt] = unpack4(*(const u32x2*)(YI + co_off(jc, 4, iv, lane)));
#pragma unroll
        for (int k = 0; k < 2; ++k) acc[tt] = mfma16(frag_fo(S, 2, iv, k, lane), frag_fo(QT, 2, jc, k, lane), acc[tt]); }
    float s1 = (acc[0][0] + acc[0][1]) + (acc[0][2] + acc[0][3]) + (acc[1][0] + acc[1][1]) + (acc[1][2] + acc[1][3]);
    s1 += __shfl_xor(s1, 16); s1 += __shfl_xor(s1, 32);
    if (g == 0) xs[w * 16 + r] = s1;
    WG_SYNC();
    const float mu = (s1 + xs[(w ^ 4) * 16 + r]) * (1.0f / 64.0f); float s2 = 0.f;
#pragma unroll
    for (int tt = 0; tt < 2; ++tt)
#pragma unroll
        for (int e = 0; e < 4; ++e) { acc[tt][e] -= mu; s2 += acc[tt][e] * acc[tt][e]; }
    s2 += __shfl_xor(s2, 16); s2 += __shfl_xor(s2, 32);
    if (g == 0) xs[128 + w * 16 + r] = s2;
    WG_SYNC();
    const float rs = 1.0f / sqrtf((s2 + xs[128 + (w ^ 4) * 16 + r]) * (1.0f / 64.0f) + 64e-5f);
    const bf16_t* E = (const bf16_t*)(a.ws + WS_RW_E) + tk * 4096; const bf16_t* GT = (const bf16_t*)(a.ws + WS_RW_GT) + tk * 4096;
    bf16_t* O = (bf16_t*)(a.ws + WS_O) + (size_t)t * D + 1536 + h * 64;
#pragma unroll
    for (int tt = 0; tt < 2; ++tt) { const int v0 = 16 * (2 * wh + tt) + 4 * g; const int eo_ = co_off(jc, 4, 2 * wh + tt, lane); const f32x4 ev = unpack4(*(const u32x2*)(E + eo_)), gv = unpack4(*(const u32x2*)(GT + eo_));
        const f32x4 lw = *(const f32x4*)(LP(I_RWLNW, 512) + h * 64 + v0), lb = *(const f32x4*)(LP(I_RWLNB, 512) + h * 64 + v0); f32x4 y;
#pragma unroll
        for (int e = 0; e < 4; ++e) y[e] = (acc[tt][e] * rs * lw[e] + lb[e] + ev[e]) * gv[e];
        *(u32x2*)(O + v0) = pack4(y); }
    WG_SYNC();
}

constexpr int M2_LDS = 136, M2_LDX = 264, M2O_B = 0, M2O_C = 17408, M2O_X = 34816, M2O_XW = 68608, M2O_M = 102400, M2O_DT = 139264, M2O_G = 140288, M2O_GL = 141312;
__device__ __forceinline__ void m2_stage1(CArgs& a, int l, int n, int gr, LAS unsigned char* lds, int tid) {
    const int lane = tid & 63, w = __builtin_amdgcn_readfirstlane(tid >> 6), r = lane & 15, g = lane >> 4;
    LAS bf16_t* Bi = (LAS bf16_t*)(lds + M2O_B); LAS bf16_t* Ci = (LAS bf16_t*)(lds + M2O_C); LAS bf16_t* Xi = (LAS bf16_t*)(lds + M2O_X); LAS bf16_t* XWi = (LAS bf16_t*)(lds + M2O_XW); LAS bf16_t* Mi = (LAS bf16_t*)(lds + M2O_M);
    LAS float* DT = (LAS float*)(lds + M2O_DT); LAS float* GC = (LAS float*)(lds + M2O_G); LAS float* GLAST = (LAS float*)(lds + M2O_GL);
    const int t0 = n * 64;
    LAS bf16_t* RAW = (LAS bf16_t*)(lds + M2O_XW);
    for (int idx = tid; idx < 67 * 64; idx += 512) { const int row = idx >> 6, ch = idx & 63, t = t0 - 3 + row; v4u v = {0u, 0u, 0u, 0u};
        const int col = ch < 32 ? gr * 256 + 8 * ch : (ch < 48 ? 512 + gr * 128 + 8 * (ch - 32) : 768 + gr * 128 + 8 * (ch - 48));
        if (t >= 0) v = *(const v4u*)(PROJROW(t) + C_MXBC + col);
        *(LAS v4u*)(RAW + row * 512 + 8 * ch) = v; }
    WG_SYNC();
    for (int it = tid; it < 512 * 4; it += 512) { const int lc = it & 511, seg = it >> 9; int col; LAS bf16_t* dst; int dld;
      if (lc < 256) { col = gr * 256 + lc; dst = Xi + lc; dld = M2_LDX; } else if (lc < 384) { col = 512 + gr * 128 + (lc - 256); dst = Bi + (lc - 256); dld = M2_LDS; } else { col = 768 + gr * 128 + (lc - 384); dst = Ci + (lc - 384); dld = M2_LDS; }
      const float* cw = LP(I_MCONV, 4 * 1024) + col; const float w0 = cw[0], w1 = cw[1024], w2 = cw[2048], w3 = cw[3072], cb = LP(I_MCONVB, 1024)[col];
      const LAS bf16_t* src = RAW + (16 * seg) * 512 + lc;
      float x0 = bf2f(src[0]), x1 = bf2f(src[512]), x2 = bf2f(src[1024]);
#pragma unroll
      for (int cc = 0; cc < 16; ++cc) { const float x3 = bf2f(src[(cc + 3) * 512]); const float y = silu_f(w0 * x0 + w1 * x1 + w2 * x2 + w3 * x3 + cb); dst[(16 * seg + cc) * dld] = (bf16_t)f2bf(y); x0 = x1; x1 = x2; x2 = x3; } }
    if (tid < 256) { const int c = tid >> 2, hh = tid & 3, hd = gr * 4 + hh; const float dt = softplus_f(bf2f(PROJROW(t0 + c)[C_MDT + hd]) + LP(I_MDTB, 8)[hd]); DT[c * 4 + hh] = dt; GC[c * 4 + hh] = -fexp(LP(I_MALOG, 8)[hd]) * dt; }
    WG_SYNC();
    if (tid < 4) { float cu = 0.f; for (int c = 0; c < 64; ++c) { cu += GC[c * 4 + tid]; GC[c * 4 + tid] = cu; } GLAST[tid] = cu; WSF(WS_M2_DEC)[n * 8 + gr * 4 + tid] = fexp(cu); }
    WG_SYNC();
    { const int c = tid >> 3, q = tid & 7;
      const int hh = q >> 1; const float sc = DT[c * 4 + hh] * fexp(GLAST[hh] - GC[c * 4 + hh]);
#pragma unroll
      for (int u = 0; u < 4; ++u) { const v4u xv = *(const LAS v4u*)(Xi + c * M2_LDX + 32 * q + 8 * u); v4u o;
#pragma unroll
          for (int e = 0; e < 4; ++e) o[e] = pk2(__uint_as_float(xv[e] << 16) * sc, __uint_as_float(xv[e] & 0xffff0000u) * sc);
          *(LAS v4u*)(XWi + c * M2_LDX + 32 * q + 8 * u) = o; }
      const float eg = fexp(GC[c * 4 + hh]); bf16_t* QH = (bf16_t*)(a.ws + WS_M2_QH) + (size_t)(n * 8 + gr * 4 + hh) * 8192;
#pragma unroll
      for (int u = 0; u < 8; ++u) { const v4u cv = *(const LAS v4u*)(Ci + c * M2_LDS + 64 * (q & 1) + 8 * u); v4u o;
#pragma unroll
          for (int e = 0; e < 4; ++e) o[e] = pk2(__uint_as_float(cv[e] << 16) * eg, __uint_as_float(cv[e] & 0xffff0000u) * eg);
          { const int s0 = 64 * (q & 1) + 8 * u; *(v4u*)(QH + (((c >> 4) * 4 + (s0 >> 5)) * 64 + ((s0 >> 3) & 3) * 16 + (c & 15)) * 8) = o; } } }
#pragma unroll
    for (int tt = 0; tt < 2; ++tt) { const int tile = 2 * w + tt, im = tile >> 2, jc = tile & 3; f32x4 acc = {0.f, 0.f, 0.f, 0.f};
        if (jc >= im) {
#pragma unroll
            for (int k0 = 0; k0 < 128; k0 += 32) acc = mfma16(frag_row(Bi, M2_LDS, 16 * im, k0, lane), frag_row(Ci, M2_LDS, 16 * jc, k0, lane), acc); }
        const int cq = 16 * jc + r;
#pragma unroll
        for (int hh = 0; hh < 4; ++hh) { f32x4 mv; const float gc = GC[cq * 4 + hh];
#pragma unroll
            for (int e = 0; e < 4; ++e) { const int m = 16 * im + 4 * g + e; mv[e] = cq >= m ? acc[e] * fexp(gc - GC[m * 4 + hh]) * DT[m * 4 + hh] : 0.f; }
            *(LAS u32x2*)(Mi + hh * 64 * 72 + cq * 72 + 16 * im + 4 * g) = pack4(mv); } }
    WG_SYNC();
    { const int hh = w >> 1, hd = gr * 4 + hh; const size_t tk = (size_t)n * 8 + hd; const float Dh = LP(I_MD, 8)[hd];
      bf16_t* YI = (bf16_t*)(a.ws + WS_M2_YI) + tk * 4096; float* Z = WSF(WS_M2_Z) + tk * 8192;
#pragma unroll
      for (int tt = 0; tt < 8; ++tt) { const int tile = (w & 1) * 8 + tt, ip = tile >> 2, jc = tile & 3; f32x4 acc = {0.f, 0.f, 0.f, 0.f};
#pragma unroll
          for (int k0 = 0; k0 < 64; k0 += 32) acc = mfma16(frag_tr(Xi, M2_LDX, 64 * hh + 16 * ip, k0, lane), frag_row(Mi + hh * 64 * 72, 72, 16 * jc, k0, lane), acc);
          const int cq = 16 * jc + r; const f32x4 xv = unpack4(*(const LAS u32x2*)(Xi + cq * M2_LDX + 64 * hh + 16 * ip + 4 * g));
          *(u32x2*)(YI + co_off(jc, 4, ip, lane)) = pack4(acc + xv * Dh); }
#pragma unroll
      for (int tt = 0; tt < 16; ++tt) { const int tile = (w & 1) * 16 + tt, is = tile >> 2, jp = tile & 3; f32x4 acc = {0.f, 0.f, 0.f, 0.f};
#pragma unroll
          for (int k0 = 0; k0 < 64; k0 += 32) acc = mfma16(frag_tr(Bi, M2_LDS, 16 * is, k0, lane), frag_tr(XWi, M2_LDX, 64 * hh + 16 * jp, k0, lane), acc);
          *(f32x4*)(Z + fo_st(jp, 4, 16 * is, g, r)) = acc; } }
    WG_SYNC();
}
__device__ __forceinline__ void m2_stage2(CArgs& a, int b, int tid) {
    const int idx = b * 512 + tid, hd = idx >> 13, rem = idx & 8191;
    const float* Z = WSF(WS_M2_Z) + (size_t)hd * 8192 + rem; bf16_t* S = (bf16_t*)(a.ws + WS_M2_S) + (size_t)hd * 8192 + rem; const float* DEC = WSF(WS_M2_DEC) + hd; float s = 0.f;
#pragma unroll 8
    for (int n = 0; n < NCH; ++n) { const float z = Z[(size_t)n * 8 * 8192], dc = DEC[n * 8]; S[(size_t)n * 8 * 8192] = (bf16_t)f2bf(s); s = dc * s + z; }
}
__device__ __forceinline__ void m2_stage3(CArgs& a, int l, int n, int gr, LAS unsigned char* lds, int tid) {
    const int lane = tid & 63, w = __builtin_amdgcn_readfirstlane(tid >> 6), r = lane & 15, g = lane >> 4, hh = w >> 1, hd = gr * 4 + hh;
    const size_t tk = (size_t)n * 8 + hd;
    const bf16_t* S = (const bf16_t*)(a.ws + WS_M2_S) + tk * 8192; const bf16_t* QH = (const bf16_t*)(a.ws + WS_M2_QH) + tk * 8192; const bf16_t* YI = (const bf16_t*)(a.ws + WS_M2_YI) + tk * 4096;
    LAS float* xs = (LAS float*)lds;
    f32x4 acc[2][4]; float ss[2];
#pragma unroll
    for (int cj = 0; cj < 2; ++cj) { const int jc = 2 * (w & 1) + cj, c = 16 * jc + r, t = n * 64 + c; const bf16_t* pz = PROJROW(t) + C_MZ + hd * 64; ss[cj] = 0.f;
#pragma unroll
        for (int ip = 0; ip < 4; ++ip) { acc[cj][ip] = unpack4(*(const u32x2*)(YI + co_off(jc, 4, ip, lane)));
#pragma unroll
            for (int k = 0; k < 4; ++k) acc[cj][ip] = mfma16(frag_fo(S, 4, ip, k, lane), frag_fo(QH, 4, jc, k, lane), acc[cj][ip]);
            const f32x4 zv = unpack4(*(const u32x2*)(pz + 16 * ip + 4 * g));
#pragma unroll
            for (int e = 0; e < 4; ++e) { acc[cj][ip][e] *= silu_f(zv[e]); ss[cj] += acc[cj][ip][e] * acc[cj][ip][e]; } }
        ss[cj] += __shfl_xor(ss[cj], 16); ss[cj] += __shfl_xor(ss[cj], 32);
        if (g == 0) xs[w * 32 + cj * 16 + r] = ss[cj]; }
    WG_SYNC();
#pragma unroll
    for (int cj = 0; cj < 2; ++cj) { const int jc = 2 * (w & 1) + cj, c = 16 * jc + r, t = n * 64 + c;
        const float tot = xs[((w & 1) + 0) * 32 + cj * 16 + r] + xs[((w & 1) + 2) * 32 + cj * 16 + r] + xs[((w & 1) + 4) * 32 + cj * 16 + r] + xs[((w & 1) + 6) * 32 + cj * 16 + r];
        const float rs = 1.0f / sqrtf(tot * (1.0f / 256.0f) + 1e-6f);
        const float* nw = LP(I_MNORM, 512) + hd * 64; bf16_t* O = (bf16_t*)(a.ws + WS_O) + (size_t)t * D + 1024 + hd * 64;
#pragma unroll
        for (int ip = 0; ip < 4; ++ip) { const f32x4 wv = *(const f32x4*)(nw + 16 * ip + 4 * g); f32x4 y;
#pragma unroll
            for (int e = 0; e < 4; ++e) y[e] = acc[cj][ip][e] * rs * wv[e];
            *(u32x2*)(O + 16 * ip + 4 * g) = pack4(y); } }
    WG_SYNC();
}

constexpr int GD_LD = 136;
constexpr int GDO_K = 0, GDO_V = 17408, GDO_KT = 34816, GDO_QG = 52224, GDO_Q = 69632, GDO_AM = 87040, GDO_AQ = 104448, GDO_U = 113664, GDO_W = 131072, GDO_QF = 87040, GDO_KF = 119808, GDO_SM = 152576;
__device__ __forceinline__ void gd_stage1(CArgs& a, int l, int n, int h, LAS unsigned char* lds, int tid) {
    const int w = __builtin_amdgcn_readfirstlane(tid >> 6), tk = n * 4 + h, t0 = n * 64;
    int lane, r, g, c, q8;
#define GD_IDX() do { int tl_ = tid; asm volatile("" : "+v"(tl_)); lane = tl_ & 63; r = lane & 15; g = lane >> 4; c = tl_ >> 3; q8 = tl_ & 7; } while (0)
    LAS bf16_t* Ki = (LAS bf16_t*)(lds + GDO_K); LAS bf16_t* Vi = (LAS bf16_t*)(lds + GDO_V); LAS bf16_t* KTi = (LAS bf16_t*)(lds + GDO_KT); LAS bf16_t* QGi = (LAS bf16_t*)(lds + GDO_QG); LAS bf16_t* Qi = (LAS bf16_t*)(lds + GDO_Q);
    LAS float* AM = (LAS float*)(lds + GDO_AM); LAS bf16_t* AQ = (LAS bf16_t*)(lds + GDO_AQ); LAS bf16_t* Ui = (LAS bf16_t*)(lds + GDO_U); LAS bf16_t* Wi = (LAS bf16_t*)(lds + GDO_W);
    LAS float* QF = (LAS float*)(lds + GDO_QF); LAS float* KF = (LAS float*)(lds + GDO_KF);
    LAS float* BETA = (LAS float*)(lds + GDO_SM); LAS float* GC = BETA + 64; LAS float* BG = GC + 64;
    LAS bf16_t* RAW = (LAS bf16_t*)(lds + GDO_KT);
    for (int idx = tid; idx < 67 * 48; idx += 512) { const int row = idx / 48, ch = idx % 48, which = ch >> 4, t = t0 - 3 + row; v4u v = {0u, 0u, 0u, 0u};
        if (t >= 0) v = *(const v4u*)(PROJROW(t) + C_GQ + which * 512 + h * 128 + 8 * (ch & 15));
        *(LAS v4u*)(RAW + row * 384 + 8 * ch) = v; }
    WG_SYNC();
    for (int it = tid; it < 384 * 4; it += 512) { const int col = it % 384, seg = it / 384, which = col >> 7, dcol = col & 127, cwi = which * 512 + h * 128 + dcol;
        const float* cw = LP(I_GCONV, 4 * 1536) + cwi; const float w0 = cw[0], w1 = cw[1536], w2 = cw[3072], w3 = cw[4608];
        const LAS bf16_t* src = RAW + (16 * seg) * 384 + col;
        float x0 = bf2f(src[0]), x1 = bf2f(src[384]), x2 = bf2f(src[768]);
#pragma unroll
        for (int cc = 0; cc < 16; ++cc) { const float x3 = bf2f(src[(cc + 3) * 384]); const float y = silu_f(w0 * x0 + w1 * x1 + w2 * x2 + w3 * x3); const int tok = 16 * seg + cc;
            if (which == 2) Vi[tok * GD_LD + dcol] = (bf16_t)f2bf(y); else (which == 0 ? QF : KF)[tok * 128 + dcol] = y;
            x0 = x1; x1 = x2; x2 = x3; } }
    if (tid >= 384 && tid < 448) { const int cc = tid - 384; const bf16_t* pr = PROJROW(t0 + cc);
        const float beta = sigmoid_f(bf2f(pr[C_GB + h])); float cu = -fexp(LP(I_GALOG, 4)[h]) * softplus_f(bf2f(pr[C_GA + h]) + LP(I_GDTB, 4)[h]);
#pragma unroll
        for (int o = 1; o < 64; o <<= 1) { const float up = __shfl_up(cu, o); if (cc >= o) cu += up; }
        BETA[cc] = beta; GC[cc] = cu; BG[cc] = beta * fexp(cu); }
    WG_SYNC();
    GD_IDX();
    { float qv[16], kv[16]; float sq = 0.f, sk = 0.f;
#pragma unroll
      for (int u = 0; u < 4; ++u) { const f32x4 a4 = *(const LAS f32x4*)(QF + c * 128 + 16 * q8 + 4 * u), b4 = *(const LAS f32x4*)(KF + c * 128 + 16 * q8 + 4 * u);
#pragma unroll
          for (int e = 0; e < 4; ++e) { qv[4 * u + e] = a4[e]; kv[4 * u + e] = b4[e]; sq += a4[e] * a4[e]; sk += b4[e] * b4[e]; } }
      sq += __shfl_xor(sq, 1); sq += __shfl_xor(sq, 2); sq += __shfl_xor(sq, 4); sk += __shfl_xor(sk, 1); sk += __shfl_xor(sk, 2); sk += __shfl_xor(sk, 4);
      const float gc = GC[c], iq = (1.0f / sqrtf(sq + 1e-6f)) * 0.08838834764831845f, ik = 1.0f / sqrtf(sk + 1e-6f), et = fexp(GC[63] - gc), eg = fexp(gc);
      v4u oK[2], oQ[2], oKT[2], oQG[2];
#pragma unroll
      for (int u = 0; u < 8; ++u) { const float k0 = kv[2 * u] * ik, k1 = kv[2 * u + 1] * ik, q0 = qv[2 * u] * iq, q1 = qv[2 * u + 1] * iq;
          oK[u >> 2][u & 3] = pk2(k0, k1); oQ[u >> 2][u & 3] = pk2(q0, q1); oKT[u >> 2][u & 3] = pk2(k0 * et, k1 * et); oQG[u >> 2][u & 3] = pk2(q0 * eg, q1 * eg); }
      const int o = c * GD_LD + 16 * q8;
      *(LAS v4u*)(Ki + o) = oK[0]; *(LAS v4u*)(Ki + o + 8) = oK[1]; *(LAS v4u*)(Qi + o) = oQ[0]; *(LAS v4u*)(Qi + o + 8) = oQ[1];
      *(LAS v4u*)(KTi + o) = oKT[0]; *(LAS v4u*)(KTi + o + 8) = oKT[1]; *(LAS v4u*)(QGi + o) = oQG[0]; *(LAS v4u*)(QGi + o + 8) = oQG[1]; }
    WG_SYNC();
    GD_IDX();
#pragma unroll
    for (int tt = 0; tt < 2; ++tt) { const int tile = 2 * w + tt, im = tile >> 2, jc = tile & 3; f32x4 c1 = {0.f, 0.f, 0.f, 0.f}, c2 = c1;
        if (jc >= im) {
#pragma unroll
            for (int k0 = 0; k0 < 128; k0 += 32) { const bf16x8 fa = frag_row(Ki, GD_LD, 16 * im, k0, lane); c1 = mfma16(fa, frag_row(Ki, GD_LD, 16 * jc, k0, lane), c1); c2 = mfma16(fa, frag_row(Qi, GD_LD, 16 * jc, k0, lane), c2); }
            const int cq = 16 * jc + r; const float gc = GC[cq], bc = BETA[cq];
#pragma unroll
            for (int e = 0; e < 4; ++e) { const int m = 16 * im + 4 * g + e; const float dc = fexp(gc - GC[m]); c1[e] = m < cq ? c1[e] * dc * bc : 0.f; c2[e] = m <= cq ? c2[e] * dc : 0.f; } }
        const int cq = 16 * jc + r; *(LAS f32x4*)(AM + cq * 68 + 16 * im + 4 * g) = c1; *(LAS u32x2*)(AQ + cq * 72 + 16 * im + 4 * g) = pack4(c2); }
    WG_SYNC();
    GD_IDX();
    { const int col = c * 8 + q8; if (col < 256) { float x[64];
#pragma unroll
        for (int i = 0; i < 64; ++i) x[i] = 0.f;
        int vz = 0; asm volatile("" : "+v"(vz)); const LAS float* AMv = AM + vz;
        const LAS bf16_t* src = col < 128 ? Vi + col : Ki + (col - 128); const LAS float* scl = col < 128 ? BETA : BG; LAS bf16_t* dst = col < 128 ? Ui + col : Wi + (col - 128);
#pragma unroll
        for (int tq = 0; tq < 64; ++tq) { float acc = bf2f(src[tq * GD_LD]) * scl[tq];
#pragma unroll
            for (int i = 0; i < ((tq + 3) & ~3); i += 4) { const f32x4 av = *(const LAS f32x4*)(AMv + tq * 68 + i); acc -= av[0] * x[i]; acc -= av[1] * x[i + 1]; acc -= av[2] * x[i + 2]; acc -= av[3] * x[i + 3]; }
            x[tq] = acc; dst[tq * GD_LD] = (bf16_t)f2bf(acc); } } }
    WG_SYNC();
    GD_IDX();
    { const int jc = w & 3, wh = w >> 2; const int cq = 16 * jc + r;
      bf16_t* QT = (bf16_t*)(a.ws + WS_GD_QT) + (size_t)tk * 8192; bf16_t* YI = (bf16_t*)(a.ws + WS_GD_YI) + (size_t)tk * 8192; bf16_t* GG = (bf16_t*)(a.ws + WS_GD_G) + (size_t)tk * 16384; float* Z = WSF(WS_GD_Z) + (size_t)tk * 16384;
#pragma unroll
      for (int tt = 0; tt < 4; ++tt) { const int id = 4 * wh + tt; f32x4 c1 = {0.f, 0.f, 0.f, 0.f}, c2 = c1;
#pragma unroll
          for (int k0 = 0; k0 < 64; k0 += 32) { const bf16x8 fb = frag_row(AQ, 72, 16 * jc, k0, lane); c1 = mfma16(frag_tr(Wi, GD_LD, 16 * id, k0, lane), fb, c1); c2 = mfma16(frag_tr(Ui, GD_LD, 16 * id, k0, lane), fb, c2); }
          const f32x4 qg = unpack4(*(const LAS u32x2*)(QGi + cq * GD_LD + 16 * id + 4 * g));
          *(u32x2*)(QT + fo_st(jc, 4, 16 * id, g, r)) = pack4(qg - c1); *(u32x2*)(YI + co_off(jc, 8, id, lane)) = pack4(c2); }
      const float e63 = fexp(GC[63]);
#pragma unroll
      for (int ti = 0; ti < 8; ++ti) { f32x4 c1 = {0.f, 0.f, 0.f, 0.f}, c2 = c1;
#pragma unroll
          for (int k0 = 0; k0 < 64; k0 += 32) { c1 = mfma16(frag_tr(Wi, GD_LD, 16 * ti, k0, lane), frag_tr(KTi, GD_LD, 16 * w, k0, lane), c1); c2 = mfma16(frag_tr(KTi, GD_LD, 16 * ti, k0, lane), frag_tr(Ui, GD_LD, 16 * w, k0, lane), c2); }
          const int dq = 16 * w + r; f32x4 gv;
#pragma unroll
          for (int e = 0; e < 4; ++e) gv[e] = ((16 * ti + 4 * g + e) == dq ? e63 : 0.f) - c1[e];
          *(u32x2*)(GG + fo_st(w, 4, 16 * ti, g, r)) = pack4(gv); *(f32x4*)(Z + co_off(w, 8, ti, lane)) = c2; } }
    WG_SYNC();
#undef GD_IDX
}
__device__ __forceinline__ void gd_stage2(CArgs& a, int h, int es, LAS unsigned char* lds, int tid, const int var = 0) {
    const int lane = tid & 63, w = __builtin_amdgcn_readfirstlane(tid >> 6), r = lane & 15, g = lane >> 4;
    LAS bf16_t* Si = (LAS bf16_t*)lds;
    const bf16_t* G = (const bf16_t*)(a.ws + WS_GD_G); const float* Z = WSF(WS_GD_Z); bf16_t* S = (bf16_t*)(a.ws + WS_GD_S);
    const int so = fo_st(es, 4, 16 * w, g, r), zo = co_off(es, 8, w, lane);
    *(LAS u32x2*)(Si + r * GD_LD + 16 * w + 4 * g) = (u32x2){0u, 0u}; *(u32x2*)(S + (size_t)h * 16384 + so) = (u32x2){0u, 0u};
    WG_SYNC();
    constexpr int PD = 8;
    bf16x8 gf[PD][4]; f32x4 zf[PD];
#pragma unroll
    for (int u = 0; u < PD; ++u) { const size_t tk = (size_t)u * 4 + h; zf[u] = *(const f32x4*)(Z + tk * 16384 + zo);
#pragma unroll
        for (int k = 0; k < 4; ++k) gf[u][k] = frag_fo(G + tk * 16384, 4, w, k, lane); }
#define GD_STEP(n_, u_, REFILL) do { const int n = (n_); const size_t tk = (size_t)n * 4 + h; const int cur = n & 1; \
            f32x4 acc = zf[u_], acc2 = {0.f, 0.f, 0.f, 0.f}; \
            acc = mfma16(gf[u_][0], frag_row(Si + cur * 16 * GD_LD, GD_LD, 0, 0, lane), acc); acc2 = mfma16(gf[u_][1], frag_row(Si + cur * 16 * GD_LD, GD_LD, 0, 32, lane), acc2); \
            acc = mfma16(gf[u_][2], frag_row(Si + cur * 16 * GD_LD, GD_LD, 0, 64, lane), acc); acc2 = mfma16(gf[u_][3], frag_row(Si + cur * 16 * GD_LD, GD_LD, 0, 96, lane), acc2); \
            if (REFILL && !(var & 2)) { const int nn = n + PD < NCH - 1 ? n + PD : NCH - 2; const size_t tn = (size_t)nn * 4 + h; zf[u_] = *(const f32x4*)(Z + tn * 16384 + zo); \
                _Pragma("unroll") for (int k = 0; k < 4; ++k) gf[u_][k] = frag_fo(G + tn * 16384, 4, w, k, lane); } \
            const u32x2 pv = pack4(acc + acc2); \
            if (!(var & 4)) *(LAS u32x2*)(Si + (cur ^ 1) * 16 * GD_LD + r * GD_LD + 16 * w + 4 * g) = pv; if (!(var & 1)) *(u32x2*)(S + (tk + 4) * 16384 + so) = pv; \
            if (!(var & 4)) { asm volatile("s_waitcnt lgkmcnt(0)" ::: "memory"); __builtin_amdgcn_s_barrier(); } asm volatile("" ::: "memory"); } while (0)
#pragma unroll
    for (int nq = 0; nq < NCH - 1; ++nq) GD_STEP(nq, nq % PD, nq + PD < NCH - 1);
#undef GD_STEP
}
__device__ __forceinline__ void gd_stage3(CArgs& a, int l, int n, int h, LAS unsigned char* lds, int tid) {
    const int lane = tid & 63, w = __builtin_amdgcn_readfirstlane(tid >> 6), r = lane & 15, g = lane >> 4, jc = w & 3, wh = w >> 2;
    const size_t tk = (size_t)n * 4 + h; const int c = 16 * jc + r, t = n * 64 + c;
    const bf16_t* S = (const bf16_t*)(a.ws + WS_GD_S) + tk * 16384; const bf16_t* QT = (const bf16_t*)(a.ws + WS_GD_QT) + tk * 8192; const bf16_t* YI = (const bf16_t*)(a.ws + WS_GD_YI) + tk * 8192;
    LAS float* xs = (LAS float*)lds;
    f32x4 acc[4]; float ss = 0.f;
#pragma unroll
    for (int tt = 0; tt < 4; ++tt) { const int ie = 4 * wh + tt; acc[tt] = unpack4(*(const u32x2*)(YI + co_off(jc, 8, ie, lane)));
#pragma unroll
        for (int k = 0; k < 4; ++k) acc[tt] = mfma16(frag_fo(S, 4, ie, k, lane), frag_fo(QT, 4, jc, k, lane), acc[tt]);
#pragma unroll
        for (int e = 0; e < 4; ++e) ss += acc[tt][e] * acc[tt][e]; }
    ss += __shfl_xor(ss, 16); ss += __shfl_xor(ss, 32);
    if (g == 0) xs[w * 16 + r] = ss;
    WG_SYNC();
    const float rs = 1.0f / sqrtf((ss + xs[(w ^ 4) * 16 + r]) * (1.0f / 128.0f) + 1e-6f);
    const float* nw = LP(I_GNORM, 128); const bf16_t* pz = PROJROW(t) + C_GZ + h * 128; bf16_t* O = (bf16_t*)(a.ws + WS_O) + (size_t)t * D + h * 128;
#pragma unroll
    for (int tt = 0; tt < 4; ++tt) { const int e0 = 16 * (4 * wh + tt) + 4 * g; const f32x4 zv = unpack4(*(const u32x2*)(pz + e0)), wv = *(const f32x4*)(nw + e0); f32x4 y;
#pragma unroll
        for (int e = 0; e < 4; ++e) y[e] = acc[tt][e] * rs * wv[e] * silu_f(zv[e]);
        *(u32x2*)(O + e0) = pack4(y); }
    WG_SYNC();
}

#define XB_TMO      128
#define XB_XCNT(j)  (256  + 64 * (j))
#define XB_XSUB(j)  (1280 + 64 * (j))
#define XB_XGEN(j)  (2304 + 64 * (j))
#define XB_TOP      3328
#define XB_TOPGEN   3392
#define XCD_BAR_WORDS 3456
#define XB_SPIN_CAP (1u << 20)
__device__ __forceinline__ unsigned xb_ld(unsigned* p)              { return __hip_atomic_load(p, __ATOMIC_RELAXED, __HIP_MEMORY_SCOPE_AGENT); }
__device__ __forceinline__ unsigned xb_add(unsigned* p, unsigned v) { return __hip_atomic_fetch_add(p, v, __ATOMIC_RELAXED, __HIP_MEMORY_SCOPE_AGENT); }
__device__ __forceinline__ unsigned xb_xcc_id() { return (unsigned)__builtin_amdgcn_s_getreg((3 << 11) | 20) & 0xFu; }
#define XB_SPIN(cond, bar) do { unsigned _sp = 0; while (cond) { __builtin_amdgcn_s_sleep(1); \
    if ((++_sp & 255u) == 0u) { if (xb_ld(&(bar)[XB_TMO])) break; if (_sp > XB_SPIN_CAP) { atomicAdd(&(bar)[XB_TMO], 1u); break; } } } } while (0)
struct XcdBarrier { unsigned* bar; unsigned x; volatile LAS unsigned* st; };
__device__ __forceinline__ XcdBarrier xcd_barrier_post(unsigned* bar, volatile LAS unsigned* st) {
    XcdBarrier b; b.bar = bar; b.x = xb_xcc_id(); b.st = st;
    if (threadIdx.x == 0) (void)xb_add(&bar[XB_XCNT(b.x)], 1u);
    return b;
}
__device__ __forceinline__ void xcd_barrier_complete(unsigned* bar, unsigned x, unsigned& nloc, unsigned& nx) {
    const unsigned G = gridDim.x * gridDim.y * gridDim.z;
    unsigned sum, cnt, mine, sp = 0u;
    for (;;) {
        sum = 0u; cnt = 0u; mine = 0u;
#pragma unroll
        for (unsigned j = 0; j < 16; ++j) { const unsigned c = xb_ld(&bar[XB_XCNT(j)]); sum += c; cnt += (c > 0u) ? 1u : 0u; mine = (j == x) ? c : mine; }
        if (sum == G) break;
        __builtin_amdgcn_s_sleep(1);
        if ((++sp & 255u) == 0u) { if (xb_ld(&bar[XB_TMO])) break; if (sp > XB_SPIN_CAP) { atomicAdd(&bar[XB_TMO], 1u); break; } }
    }
    nloc = mine > 0u ? mine : 1u; nx = cnt > 0u ? cnt : 1u;
}
__device__ __forceinline__ void xcd_barrier(const XcdBarrier& b) {
    asm volatile("s_waitcnt vmcnt(0)" ::: "memory");
    __syncthreads();
    if (threadIdx.x == 0) {
        unsigned* bar = b.bar;
        __builtin_amdgcn_s_waitcnt(0);
        unsigned nloc = b.st[0], nx = b.st[1];
        if (nloc == 0u) { xcd_barrier_complete(bar, b.x, nloc, nx); b.st[0] = nloc; b.st[1] = nx; }
        const unsigned old = xb_add(&bar[XB_XSUB(b.x)], 1u);
        const unsigned gen = old / nloc;
        if (old + 1u == (gen + 1u) * nloc) {
            __builtin_amdgcn_fence(__ATOMIC_RELEASE, "agent");
            asm volatile("s_waitcnt vmcnt(0)" ::: "memory");
            const unsigned og = xb_add(&bar[XB_TOP], 1u);
            const unsigned tg = og / nx;
            if (og + 1u == (tg + 1u) * nx) xb_add(&bar[XB_TOPGEN], 1u);
            else XB_SPIN(xb_ld(&bar[XB_TOPGEN]) == tg, bar);
            __builtin_amdgcn_fence(__ATOMIC_ACQUIRE, "agent");
            xb_add(&bar[XB_XGEN(b.x)], 1u);
            asm volatile("s_waitcnt vmcnt(0)" ::: "memory");
        } else {
            XB_SPIN(xb_ld(&bar[XB_XGEN(b.x)]) == gen, bar);
            __builtin_amdgcn_fence(__ATOMIC_ACQUIRE, "agent");
            asm volatile("s_waitcnt vmcnt(0)" ::: "memory");
        }
    }
    __syncthreads();
}

constexpr int CV_IN = (D / 64) * (PTP / 32), CV_OUT = (D / 64) * (D / 32), CV_UP = (D / 64) * (FF / 32), CV_DN = (FF / 64) * (D / 32), CV_ALL = CV_IN + CV_OUT + CV_UP + CV_DN;
__device__ __forceinline__ void cvt_items(CArgs& a, int l, int lo, int hi, int gwv, int ngwv, LAS float* scr, int lane) {
#pragma unroll 1
    for (int it = lo + gwv; it < hi; it += ngwv) {
        int r = it;
        if (r < CV_IN) { transpose_item(LP(I_WIN, (size_t)D * PT), D, PT, PTP, (bf16_t*)(a.ws + WS_WIN), scr, r, lane); continue; } r -= CV_IN;
        if (r < CV_OUT) { transpose_item(LP(I_WOUT, (size_t)D * D), D, D, D, (bf16_t*)(a.ws + WS_WOUT), scr, r, lane); continue; } r -= CV_OUT;
        if (r < CV_UP) { transpose_item(LP(I_WUP, (size_t)D * FF), D, FF, FF, (bf16_t*)(a.ws + WS_WUP), scr, r, lane); continue; } r -= CV_UP;
        transpose_item(LP(I_WDN, (size_t)FF * D), FF, D, D, (bf16_t*)(a.ws + WS_WDN), scr, r, lane);
    }
}

constexpr int N_PHASES = 1 + 9 * NL;

__device__ __forceinline__ void run_phase(CArgs& a, int ph, LAS unsigned char* lds, const int tid, const int bid, const int mask = 15) {
    const int lane = tid & 63, wave = __builtin_amdgcn_readfirstlane(tid >> 6);
    const int G = gridDim.x, gw = bid * NWAVES + wave, NGW = G * NWAVES;
    float* SSb = (float*)(a.ws + WS_SS);
    if (ph == N_PHASES - 1) {
        for (int t = gw; t < T; t += NGW) final_row(HRES + (size_t)t * D, a.in[I_NF], SSb[2 * NL * T + t], lane);
        return;
    }
    const int l = ph / 9, sp = ph % 9;
    const float* hin = l == 0 ? a.in[I_X] : (const float*)HRES;
    switch (sp) {
    case 0: {
        if (mask & 1) cvt_items(a, l, 0, CV_IN, gw, NGW, (LAS float*)(lds + wave * 16384), lane);
        if (mask & 2) for (int t = gw; t < T; t += NGW) xn_row(hin + (size_t)t * D, LP(I_N1, D), (bf16_t*)(a.ws + WS_XN) + (size_t)t * D, SSb + t, lane);
    } break;
    case 1: { pg8::Gemm g{(const bf16_t*)(a.ws + WS_XN), (const bf16_t*)(a.ws + WS_WIN)}; pg8::StaticOrder<T, PTP> S; S.init(G, bid);
              pg8::EpiBf16<false> E{(bf16_t*)(a.ws + WS_PROJ), PTP, SSb + l * T}; pg8::gemm_phase<D, pg8::EpiBf16<false>, pg8::StaticOrder<T, PTP>, true>(lds, g, S, E, tid);
              constexpr int NFULL = (T / 256) * (PTP / 256) % 256; if (bid >= NFULL) cvt_items(a, l, CV_IN + CV_OUT, CV_IN + CV_OUT + CV_UP, (bid - NFULL) * NWAVES + wave, (G - NFULL) * NWAVES, (LAS float*)(lds + wave * 16384), lane); } break;
    case 2: {
#pragma unroll 1
              for (int it = bid; (mask & 1) && it < NCH * 4; it += G) gd_stage1(a, l, it >> 2, it & 3, lds, tid);
#pragma unroll 1
              for (int it = bid; (mask & 4) && it < NCH * 8; it += G) rw_stage1(a, l, it >> 3, it & 7, lds, tid, mask >> 8 ? (mask >> 8) - 1 : 99);
#pragma unroll 1
              for (int it = bid; (mask & 8) && it < NCH * 2; it += G) m2_stage1(a, l, it >> 1, it & 1, lds, tid);
#pragma unroll 1
              for (int it = bid; (mask & 2) && it < NCH * 4; it += G) ret_stage1(a, it >> 2, it & 3, lds, tid); } break;
    case 3: { const int b = bid;
              if (b < 64) { const int x = b & 7, j = b >> 3;
                  if (x < 4) { if (mask & 1) gd_stage2(a, x, j, lds, tid, mask >> 8); }
                  else if (mask & 4) rw_stage2(a, (x - 4) * 2 + (j >> 2), j & 3, lds, tid); }
              else if (b < 128) { if (mask & 2) ret_stage2(a, b - 64, tid); }
              else if (mask & 8) m2_stage2(a, b - 128, tid);
              if (b >= 64 && mask == 15) { const int gwv = (b - 64) * NWAVES + wave, ngwv = (G - 64) * NWAVES; LAS float* scr = (LAS float*)(lds + wave * 16384);
                  cvt_items(a, l, CV_IN, CV_IN + CV_OUT, gwv, ngwv, scr, lane); cvt_items(a, l, CV_IN + CV_OUT + CV_UP, CV_ALL, gwv, ngwv, scr, lane);
                  if (l + 1 < NL) cvt_items(a, l + 1, 0, CV_IN, gwv, ngwv, scr, lane); } } break;
    case 4:
#pragma unroll 1
            for (int it = bid; (mask & 1) && it < NCH * 4; it += G) gd_stage3(a, l, it >> 2, it & 3, lds, tid);
#pragma unroll 1
            for (int it = bid; (mask & 2) && it < NCH * 4; it += G) ret_stage3(a, l, it >> 2, it & 3, lds, tid);
#pragma unroll 1
            for (int it = bid; (mask & 4) && it < NCH * 8; it += G) rw_stage3(a, l, it >> 3, it & 7, lds, tid);
#pragma unroll 1
            for (int it = bid; (mask & 8) && it < NCH * 2; it += G) m2_stage3(a, l, it >> 1, it & 1, lds, tid);
            break;
    case 5: { pg8::Gemm g{(const bf16_t*)(a.ws + WS_O), (const bf16_t*)(a.ws + WS_WOUT)}; pg8::StaticOrder<T, D> S; S.init(G, bid);
              pg8::EpiAddRes E{hin, HRES, D, (bf16_t*)(a.ws + WS_XN2), LP(I_N2, D), SSb + (NL + l) * T}; pg8::gemm_phase<D, pg8::EpiAddRes, pg8::StaticOrder<T, D>, false>(lds, g, S, E, tid); } break;
    case 6: break;
    case 7: { pg8::Gemm g{(const bf16_t*)(a.ws + WS_XN2), (const bf16_t*)(a.ws + WS_WUP)}; pg8::StaticOrder<T, FF> S; S.init(G, bid);
              pg8::EpiBf16<true> E{(bf16_t*)(a.ws + WS_HID), FF, SSb + (NL + l) * T}; pg8::gemm_phase<D, pg8::EpiBf16<true>, pg8::StaticOrder<T, FF>, true>(lds, g, S, E, tid); } break;
    case 8: { pg8::Gemm g{(const bf16_t*)(a.ws + WS_HID), (const bf16_t*)(a.ws + WS_WDN)}; pg8::StaticOrder<T, D> S; S.init(G, bid);
              pg8::EpiAddRes E{HRES, HRES, D, (bf16_t*)(a.ws + WS_XN), l + 1 < NL ? a.in[I_N1] + (size_t)(l + 1) * D : a.in[I_NF], SSb + (l + 1 < NL ? (l + 1) : 2 * NL) * T}; pg8::gemm_phase<FF, pg8::EpiAddRes, pg8::StaticOrder<T, D>, false>(lds, g, S, E, tid); } break;
    }
}

__global__ void __launch_bounds__(NWAVES * 64, 2) fwd_kernel(Args a) {
    extern __shared__ __attribute__((aligned(16))) unsigned char lds_raw[];
    LAS unsigned char* lds = (LAS unsigned char*)lds_raw;
    const int ph_lo = a.ph_lo, ph_hi = a.ph_hi;
    volatile LAS unsigned* MISC = (volatile LAS unsigned*)(lds + MISC_OFF);
    if (threadIdx.x < 64) MISC[threadIdx.x] = 0u;
    __syncthreads();
    const XcdBarrier bar = xcd_barrier_post((unsigned*)(a.ws + WS_CTL), MISC + 8);
    for (int ph = ph_lo; ph < ph_hi; ++ph) {
        if (ph != N_PHASES - 1 && (ph % 9 == 6 || (ph % 9 == 0 && ph > 0))) continue;
        CArgs* ap = (CArgs*)__builtin_amdgcn_kernarg_segment_ptr();
        asm volatile("" : "+s"(ap));
        int tid = threadIdx.x, bid = blockIdx.x;
        asm volatile("" : "+v"(tid)); asm volatile("" : "+s"(bid));
        run_phase(*ap, ph, lds, tid, bid);
#ifdef DUP_PHASE
#ifndef DUP_MASK
#define DUP_MASK 15
#endif
        if (ph == DUP_PHASE) { xcd_barrier(bar); asm volatile("" : "+s"(ap)); asm volatile("" : "+v"(tid)); asm volatile("" : "+s"(bid)); run_phase(*ap, ph, lds, tid, bid, DUP_MASK); }
#endif
        if (ph + 1 < ph_hi) xcd_barrier(bar);
    }
}

extern "C" void kernel_launch(void* const* d_in, const int* in_sizes, int n_in, void* d_out, int out_size, void* d_ws, size_t ws_size, hipStream_t stream) {
    static int grid = 0;
    if (grid == 0) {
        if (n_in != N_IN || in_sizes[0] != T * D || out_size != T * D || ws_size < WS_END) {
            fprintf(stderr, "kernel_launch: shape/workspace mismatch: n_in %d in0 %d out %d ws %zu (need %zu); nothing launched\n", n_in, n_in > 0 ? in_sizes[0] : -1, out_size, ws_size, (size_t)WS_END); grid = -1; return; }
        int dev = 0, cus = 0, per_cu = 0;
        if (hipGetDevice(&dev) != hipSuccess || hipDeviceGetAttribute(&cus, hipDeviceAttributeMultiprocessorCount, dev) != hipSuccess) { grid = -1; return; }
        if (hipFuncSetAttribute((const void*)fwd_kernel, hipFuncAttributeMaxDynamicSharedMemorySize, LDS_BYTES) != hipSuccess) { fprintf(stderr, "kernel_launch: hipFuncSetAttribute failed\n"); grid = -1; return; }
        if (hipOccupancyMaxActiveBlocksPerMultiprocessor(&per_cu, (const void*)fwd_kernel, NWAVES * 64, LDS_BYTES) != hipSuccess || per_cu < 1) { fprintf(stderr, "kernel_launch: occupancy query says %d blocks per CU\n", per_cu); per_cu = 1; }
        (void)hipGetLastError();
        grid = cus;
    }
    if (grid < 0) return;
    Args a{};
    for (int i = 0; i < N_IN; ++i) a.in[i] = (const float*)d_in[i];
    a.out = (float*)d_out; a.ws = (unsigned char*)d_ws;
#if N_LAUNCH_MODE == 1
    a.ph_lo = 0; a.ph_hi = N_PHASES;
    (void)hipMemsetAsync((char*)d_ws + WS_CTL, 0, CTL_ZERO_BYTES, stream);
    hipLaunchKernelGGL(fwd_kernel, dim3(grid), dim3(NWAVES * 64), LDS_BYTES, stream, a);
#else
#ifndef DBG_MAXPH
#define DBG_MAXPH N_PHASES
#endif
    for (int ph = 0; ph < N_PHASES; ++ph) {
        if (ph >= DBG_MAXPH && ph != N_PHASES - 1) continue;
#ifdef DBG_SKIP_FINAL
        if (ph == N_PHASES - 1) continue;
#endif
        (void)hipMemsetAsync((char*)d_ws + WS_CTL, 0, CTL_ZERO_BYTES, stream);
        a.ph_lo = ph; a.ph_hi = ph + 1;
        hipLaunchKernelGGL(fwd_kernel, dim3(grid), dim3(NWAVES * 64), LDS_BYTES, stream, a);
    }
#endif
}
#endif
```

```cpp
#ifndef HOST_TEST
#include <hip/hip_runtime.h>
#endif
#include <cstdio>
#include <cstdint>
#include <cmath>
#include <cstddef>

#ifndef SEQ_T
#define SEQ_T 8192
#endif
#ifndef N_LAUNCH_MODE
#define N_LAUNCH_MODE 1
#endif

constexpr int T = SEQ_T, D = 2048, NL = 2, FF = 8192, PT = 6832, PTP = 6912;
constexpr int C_GQ = 0, C_GK = 512, C_GV = 1024, C_GZ = 1536, C_GB = 2048, C_GA = 2052;
constexpr int C_RQ = 2056, C_RK = 2312, C_RV = 2568, C_RG = 3080;
constexpr int C_MZ = 3592, C_MXBC = 4104, C_MDT = 5128;
constexpr int C_RW = 5136;
enum { I_X = 0, I_N1, I_WIN, I_GCONV, I_GALOG, I_GDTB, I_GNORM, I_RNORM, I_MCONV, I_MCONVB, I_MALOG, I_MDTB, I_MD, I_MNORM, I_RWMU, I_RWW0, I_RWWUP, I_RWA0, I_RWAUP,
       I_RWGUP, I_RWKK, I_RWKA, I_RWRK, I_RWLNW, I_RWLNB, I_WOUT, I_N2, I_WUP, I_WDN, I_NF, N_IN };

constexpr size_t MiB = 1u << 20;
constexpr size_t SZ_WIN = (size_t)PTP * D * 2, SZ_WOUT = (size_t)D * D * 2, SZ_WUP = (size_t)FF * D * 2, SZ_WDN = (size_t)D * FF * 2;
constexpr size_t WS_CTL = 0, CTL_BYTES = 1 * MiB;
constexpr size_t WS_SS = 64 * 1024, SS_STRIDE = (size_t)SEQ_T * 4;
constexpr size_t CTL_ZERO_BYTES = WS_SS + (2 * 2 + 1) * SS_STRIDE;
constexpr size_t WS_WIN = WS_CTL + CTL_BYTES;
constexpr size_t WS_WOUT = WS_WIN + SZ_WIN;
constexpr size_t WS_WUP = WS_WOUT + SZ_WOUT;
constexpr size_t WS_WDN = WS_WUP + SZ_WUP;
constexpr size_t WS_XN = WS_WDN + SZ_WDN;
constexpr size_t WS_O = WS_XN;
constexpr size_t WS_PROJ = WS_XN + (size_t)T * D * 2;
constexpr size_t WS_HID = WS_PROJ;
constexpr size_t GDN_ = (size_t)(T / 64) * 4 * 16384;
constexpr size_t WS_GD_G = WS_PROJ + (size_t)T * PTP * 2;
constexpr size_t WS_GD_Z = WS_GD_G + GDN_ * 2;
constexpr size_t WS_GD_QT = WS_GD_Z + GDN_ * 4;
constexpr size_t WS_GD_YI = WS_GD_QT + GDN_;
constexpr size_t WS_GD_S = WS_GD_YI + GDN_;
constexpr size_t WS_GAB = WS_GD_S + GDN_ * 2;
constexpr int NCH = T / 64;
constexpr size_t WS_RET_Z = WS_GAB;
constexpr size_t WS_RET_YI = WS_RET_Z + (size_t)NCH * 4 * 8192 * 4;
constexpr size_t WS_RET_QH = WS_RET_YI + (size_t)NCH * 4 * 8192 * 2;
constexpr size_t WS_RET_S = WS_RET_QH + (size_t)NCH * 4 * 4096 * 2;
constexpr size_t M2N = (size_t)NCH * 8 * 8192;
constexpr size_t WS_M2_Z = WS_RET_S + (size_t)NCH * 4 * 8192 * 2;
constexpr size_t WS_M2_YI = WS_M2_Z + M2N * 4;
constexpr size_t WS_M2_QH = WS_M2_YI + M2N;
constexpr size_t WS_M2_S = WS_M2_QH + M2N * 2;
constexpr size_t WS_M2_DEC = WS_M2_S + M2N * 2;
constexpr size_t WS_MDT = WS_M2_DEC + (size_t)NCH * 8 * 4;
constexpr size_t RWN = (size_t)NCH * 8 * 4096;
constexpr size_t WS_RW_G = WS_MDT;
constexpr size_t WS_RW_Z = WS_RW_G + RWN * 2;
constexpr size_t WS_RW_QT = WS_RW_Z + RWN * 4;
constexpr size_t WS_RW_YI = WS_RW_QT + RWN * 2;
constexpr size_t WS_RW_E = WS_RW_YI + RWN * 2;
constexpr size_t WS_RW_GT = WS_RW_E + RWN * 2;
constexpr size_t WS_RW_S = WS_RW_GT + RWN * 2;
constexpr size_t WS_END = WS_RW_S + RWN * 2;
constexpr size_t WS_XN2 = WS_RET_Z;
static_assert(WS_HID + (size_t)T * FF * 2 <= WS_XN2 && WS_XN2 + (size_t)T * D * 2 <= WS_M2_Z, "HID overlay / XN2 alias");
static_assert(CTL_ZERO_BYTES <= CTL_BYTES, "CTL");
static_assert(SEQ_T != 8192 || WS_END <= 512 * MiB, "d_ws budget (512 MiB)");

typedef unsigned short bf16_t;
#ifdef HOST_TEST
#define DEV static inline
#define HD static inline
typedef float f32x4 __attribute__((vector_size(16)));
constexpr int WAVE = 1, LPC = 1;
static inline float wave_sum(float v) { return v; }
static inline float group_sum(float v) { return v; }
#else
#define DEV __device__ __forceinline__
#define HD __host__ __device__ __forceinline__
typedef float f32x4 __attribute__((ext_vector_type(4)));
constexpr int WAVE = 64, LPC = 16;
DEV float wave_sum(float v) {
#pragma unroll
    for (int o = 1; o < 64; o <<= 1) v += __shfl_xor(v, o);
    return v;
}
DEV float group_sum(float v) {
#pragma unroll
    for (int o = 1; o < 16; o <<= 1) v += __shfl_xor(v, o);
    return v;
}
#endif
constexpr int CPW = WAVE / LPC;

HD unsigned f2bf(float f) { unsigned u; __builtin_memcpy(&u, &f, 4); return (u + 0x7fffu + ((u >> 16) & 1u)) >> 16; }
HD unsigned pk2(float lo, float hi) { return f2bf(lo) | (f2bf(hi) << 16); }
HD float bf2f(bf16_t b) { unsigned u = (unsigned)b << 16; float f; __builtin_memcpy(&f, &u, 4); return f; }
#ifdef HOST_TEST
DEV float sigmoid_f(float x) { return 1.0f / (1.0f + expf(-x)); }
DEV float silu_f(float x) { return x / (1.0f + expf(-x)); }
#else
DEV float fexp(float x) { return __builtin_amdgcn_exp2f(x * 1.4426950408889634f); }
DEV float sigmoid_f(float x) { return __builtin_amdgcn_rcpf(1.0f + fexp(-x)); }
DEV float silu_f(float x) { return x * __builtin_amdgcn_rcpf(1.0f + fexp(-x)); }
#endif
DEV float softplus_f(float x) { return x > 20.f ? x : log1pf(expf(x)); }

struct Args { const float* in[N_IN]; float* out; unsigned char* ws; int ph_lo, ph_hi; };
#ifdef HOST_TEST
typedef const Args CArgs;
#else
typedef const __attribute__((address_space(4))) Args CArgs;
#endif
#define WSF(off) ((float*)(a.ws + (off)))
#define HRES (a.out)
#define PROJROW(t) ((const bf16_t*)(a.ws + WS_PROJ) + (size_t)(t) * PTP)
#define LP(idx, per) (a.in[idx] + (size_t)l * (per))

DEV void xn_row(const float* x, const float* w, bf16_t* o, float* ss_out, int lane) {
    float ss = 0.f;
    for (int i = lane * 4; i < D; i += WAVE * 4) { const f32x4 v = *(const f32x4*)(x + i), g = *(const f32x4*)(w + i); ss += (v[0] * v[0] + v[1] * v[1]) + (v[2] * v[2] + v[3] * v[3]);
        unsigned* op = (unsigned*)(o + i); op[0] = pk2(v[0] * g[0], v[1] * g[1]); op[1] = pk2(v[2] * g[2], v[3] * g[3]); }
    ss = wave_sum(ss); if (lane == 0) *ss_out = ss;
}
DEV void final_row(float* x, const float* w, float ss, int lane) {
    const float r = 1.0f / sqrtf(ss * (1.0f / D) + 1e-6f);
    for (int i = lane * 4; i < D; i += WAVE * 4) { const f32x4 v = *(const f32x4*)(x + i), g = *(const f32x4*)(w + i); f32x4 y; y[0] = v[0] * r * g[0]; y[1] = v[1] * r * g[1]; y[2] = v[2] * r * g[2]; y[3] = v[3] * r * g[3]; *(f32x4*)(x + i) = y; }
}
DEV void rms_row_bf16(const float* x, const float* w, bf16_t* o, int lane) {
    float ss = 0.f;
    for (int i = lane * 4; i < D; i += WAVE * 4) { const f32x4 v = *(const f32x4*)(x + i); ss += (v[0] * v[0] + v[1] * v[1]) + (v[2] * v[2] + v[3] * v[3]); }
    const float r = 1.0f / sqrtf(wave_sum(ss) * (1.0f / D) + 1e-6f);
    for (int i = lane * 4; i < D; i += WAVE * 4) { const f32x4 v = *(const f32x4*)(x + i), g = *(const f32x4*)(w + i);
        unsigned* op = (unsigned*)(o + i); op[0] = pk2(v[0] * r * g[0], v[1] * r * g[1]); op[1] = pk2(v[2] * r * g[2], v[3] * r * g[3]); }
}
DEV void rms_row_f32(const float* x, const float* w, float* o, int lane) {
    float ss = 0.f;
    for (int i = lane * 4; i < D; i += WAVE * 4) { const f32x4 v = *(const f32x4*)(x + i); ss += (v[0] * v[0] + v[1] * v[1]) + (v[2] * v[2] + v[3] * v[3]); }
    const float r = 1.0f / sqrtf(wave_sum(ss) * (1.0f / D) + 1e-6f);
    for (int i = lane * 4; i < D; i += WAVE * 4) { const f32x4 v = *(const f32x4*)(x + i), g = *(const f32x4*)(w + i);
        f32x4 y; y[0] = v[0] * r * g[0]; y[1] = v[1] * r * g[1]; y[2] = v[2] * r * g[2]; y[3] = v[3] * r * g[3]; *(f32x4*)(o + i) = y; }
}

DEV float conv4(const bf16_t* projrow_t, int col, const float* w, int c, int wstride, int t) {
    float acc = 0.f;
#pragma unroll
    for (int j = 0; j < 4; ++j) { const int tt = t - 3 + j; if (tt >= 0) acc += w[j * wstride + c] * bf2f(projrow_t[(ptrdiff_t)(j - 3) * PTP + col]); }
    return acc;
}

#ifdef HOST_TEST
static const float THETA[32] = {
#else
__device__ const float THETA[32] = {
#endif
    1.000000000e+00f, 7.429639101e-01f, 5.519954562e-01f, 4.101127088e-01f, 3.046989739e-01f, 2.263803482e-01f, 1.681924462e-01f, 1.249609292e-01f, 9.284145385e-02f, 6.897785515e-02f,
    5.124806613e-02f, 3.807546571e-02f, 2.828869782e-02f, 2.101748064e-02f, 1.561523322e-02f, 1.160155423e-02f, 8.619536646e-03f, 6.404003594e-03f, 4.757945426e-03f, 3.534980817e-03f,
    2.626363887e-03f, 1.951293205e-03f, 1.449740841e-03f, 1.077104942e-03f, 8.002503891e-04f, 5.945570301e-04f, 4.417345626e-04f, 3.281927784e-04f, 2.438354713e-04f, 1.811609109e-04f,
    1.345960627e-04f, 9.999999747e-05f };

#ifndef HOST_TEST
namespace pg8 {
#define PG8_LAS __attribute__((address_space(3)))
typedef short bf16x8 __attribute__((ext_vector_type(8)));
typedef unsigned u32x4 __attribute__((ext_vector_type(4)));
constexpr int BM = 256, BK = 64, HALF = 128, HTB = HALF * BK * 2, STAGE_BYTES = 8 * HTB, NXCD = 8, WGM = 8;
__host__ __device__ __forceinline__ int lds_byte(int r, int c) { const int st = (r >> 4) * 2 + (c >> 5), rr = r & 15, cc = c & 31, ob = rr * 64 + cc * 2; return st * 1024 + (ob ^ (((ob >> 9) & 1) << 5)); }
__host__ __device__ __forceinline__ void stage_rc(int b, int& R, int& C) { const int st = b / 1024, sb = b % 1024, swz = sb ^ (((sb >> 9) & 1) << 5); R = (st >> 1) * 16 + swz / 64; C = (st & 1) * 32 + (swz % 64) / 2; }
__host__ __device__ __forceinline__ int perm32(int rho) { const int n = rho >> 4, i = rho & 15; return 8 * (i >> 2) + 4 * n + (i & 3); }
struct Unit { int pm, pn; };
struct Gemm { const bf16_t* A; const bf16_t* Bt; };
template <int M, int N> struct StaticOrder {
    static constexpr int nM = M / BM, nN = N / BM, nwg = nM * nN; int G, c;
    __device__ void init(int G_, int c_) { G = G_; c = c_; }
    __device__ bool next(int i, Unit& u) const {
        const long L = (long)i * G + c; if (L >= nwg) return false;
        int wgid = (int)L; { const int q = nwg / NXCD, r = nwg % NXCD, xcd = wgid % NXCD, off = wgid / NXCD; wgid = (xcd < r ? xcd * (q + 1) : r * (q + 1) + (xcd - r) * q) + off; }
        const int nig = WGM * nN, gid = wgid / nig, fm = gid * WGM, gsz = (nM - fm) < WGM ? (nM - fm) : WGM;
        u.pm = fm + ((wgid % nig) % gsz); u.pn = (wgid % nig) / gsz; return true;
    }
    __device__ __forceinline__ void a_ready(const Unit&) const {}
    __device__ __forceinline__ void done(const Unit&) const {}
};
__device__ __forceinline__ unsigned cvt_pk_bf16(float lo, float hi) { unsigned r; asm volatile("v_cvt_pk_bf16_f32 %0, %1, %2" : "=v"(r) : "v"(lo), "v"(hi)); return r; }
struct EpiStoreF32 {
    static constexpr bool PERM = false, AFTER_DRAIN = false; float* O; int ldc;
    __device__ __forceinline__ void operator()(const f32x4 (&acc)[2][2][4][2], const Unit& u, int wr, int wc, int fr, int fq) const {
        const int row0 = u.pm * BM + wr * 64 + fr, col0 = u.pn * BM + wc * 32 + 4 * fq;
#pragma unroll
        for (int ai = 0; ai < 2; ++ai)
#pragma unroll
            for (int m = 0; m < 4; ++m) { float* rowp = O + (size_t)(row0 + ai * HALF + m * 16) * ldc + col0;
#pragma unroll
                for (int bj = 0; bj < 2; ++bj)
#pragma unroll
                    for (int n = 0; n < 2; ++n) *(f32x4*)(rowp + bj * HALF + n * 16) = acc[ai][bj][m][n]; }
    }
};
struct EpiAddRes {
    static constexpr bool PERM = false, AFTER_DRAIN = false; const float* B; float* O; int ldc; bf16_t* XN; const float* nw; float* SS;
    __device__ __forceinline__ void operator()(const f32x4 (&acc)[2][2][4][2], const Unit& u, int wr, int wc, int fr, int fq) const {
        const int row0 = u.pm * BM + wr * 64 + fr, col0 = u.pn * BM + wc * 32 + 4 * fq;
#pragma unroll
        for (int ai = 0; ai < 2; ++ai)
#pragma unroll
            for (int m = 0; m < 4; ++m) { float* rowp = O + (size_t)(row0 + ai * HALF + m * 16) * ldc + col0; const float* bp = B + (size_t)(row0 + ai * HALF + m * 16) * ldc + col0;
                f32x4 b[2][2];
#pragma unroll
                for (int bj = 0; bj < 2; ++bj)
#pragma unroll
                    for (int n = 0; n < 2; ++n) b[bj][n] = *(const f32x4*)(bp + bj * HALF + n * 16);
                bf16_t* xp = XN + (size_t)(row0 + ai * HALF + m * 16) * ldc + col0; float ss = 0.f;
#pragma unroll
                for (int bj = 0; bj < 2; ++bj)
#pragma unroll
                    for (int n = 0; n < 2; ++n) { const f32x4 hn = b[bj][n] + acc[ai][bj][m][n]; *(f32x4*)(rowp + bj * HALF + n * 16) = hn; const f32x4 wv = *(const f32x4*)(nw + col0 + bj * HALF + n * 16);
                        ss += (hn[0] * hn[0] + hn[1] * hn[1]) + (hn[2] * hn[2] + hn[3] * hn[3]);
                        typedef unsigned u32x2e __attribute__((ext_vector_type(2))); u32x2e pw; pw.x = cvt_pk_bf16(hn[0] * wv[0], hn[1] * wv[1]); pw.y = cvt_pk_bf16(hn[2] * wv[2], hn[3] * wv[3]); *(u32x2e*)(xp + bj * HALF + n * 16) = pw; }
                ss += __shfl_xor(ss, 16); ss += __shfl_xor(ss, 32);
                if (fq == 0) atomicAdd(SS + row0 + ai * HALF + m * 16, ss); }
    }
};
template <bool SQRELU> struct EpiBf16 {
    static constexpr bool PERM = true, AFTER_DRAIN = false; bf16_t* O; int ldc; const float* SS;
    __device__ __forceinline__ void operator()(const f32x4 (&acc)[2][2][4][2], const Unit& u, int wr, int wc, int fr, int fq) const {
        const int row0 = u.pm * BM + wr * 64 + fr, col0 = u.pn * BM + wc * 32 + 8 * fq;
#pragma unroll
        for (int ai = 0; ai < 2; ++ai)
#pragma unroll
            for (int m = 0; m < 4; ++m) { bf16_t* rowp = O + (size_t)(row0 + ai * HALF + m * 16) * ldc + col0; const float rs = __builtin_amdgcn_rsqf(SS[row0 + ai * HALF + m * 16] * (1.0f / D) + 1e-6f);
#pragma unroll
                for (int bj = 0; bj < 2; ++bj) { f32x4 v0 = acc[ai][bj][m][0] * rs, v1 = acc[ai][bj][m][1] * rs;
                    if (SQRELU) {
#pragma unroll
                        for (int j = 0; j < 4; ++j) { const float p0 = fmaxf(v0[j], 0.f), p1 = fmaxf(v1[j], 0.f); v0[j] = p0 * p0; v1[j] = p1 * p1; } }
                    u32x4 w; w.x = cvt_pk_bf16(v0[0], v0[1]); w.y = cvt_pk_bf16(v0[2], v0[3]); w.z = cvt_pk_bf16(v1[0], v1[1]); w.w = cvt_pk_bf16(v1[2], v1[3]);
                    *(u32x4*)(rowp + bj * HALF) = w; } }
    }
};

template <int K, class Epi, class Sched, bool ALIGN_EPI = false>
__device__ __forceinline__ void gemm_phase(PG8_LAS unsigned char* lds, const Gemm g, const Sched& S, const Epi& E, const int tid) {
    const int wid = __builtin_amdgcn_readfirstlane(tid >> 6), lane = tid & 63, wr = wid >> 2, wc = wid & 3, fr = lane & 15, fq = lane >> 4;
    constexpr int nt = K / BK;
    unsigned voffA[2], voffB[2];
#pragma unroll
    for (int i = 0; i < 2; ++i) { int R, C; stage_rc(tid * 16 + i * 8192, R, C); const int Rb = Epi::PERM ? ((R & ~31) + perm32(R & 31)) : R;
        voffA[i] = (unsigned)(R * K + C) * 2u; voffB[i] = (unsigned)(Rb * K + C) * 2u; }
    const size_t kstep = (size_t)(BK * 2);
    const size_t hstep = (size_t)HALF * K * 2;
    const size_t tstep = 2 * hstep;
    const unsigned ldsw = (unsigned)wid * 1024u;
    const int aoff = lds_byte(wr * 64 + fr, fq * 8), boff = lds_byte(wc * 32 + fr, fq * 8);
#define PG8_SA(b, h) (((b) * 2 + (h)) * HTB)
#define PG8_SB(b, h) ((4 + (b) * 2 + (h)) * HTB)
#define PG8_STAGE(bufoff, gbase, voff) do { _Pragma("unroll") for (int _i = 0; _i < 2; ++_i) \
        __builtin_amdgcn_global_load_lds((const unsigned*)((const char*)(gbase) + (voff)[_i]), (PG8_LAS unsigned*)(lds + (bufoff) + ldsw + _i * 8192), 16, 0, 0); } while (0)
#define PG8_LDA(dst, b, h) do { _Pragma("unroll") for (int m = 0; m < 4; ++m) _Pragma("unroll") for (int k = 0; k < 2; ++k) dst[m][k] = *(const PG8_LAS bf16x8*)(lds + PG8_SA(b, h) + aoff + m * 2048 + k * 1024); } while (0)
#define PG8_LDB(dst, b, h) do { _Pragma("unroll") for (int n = 0; n < 2; ++n) _Pragma("unroll") for (int k = 0; k < 2; ++k) dst[n][k] = *(const PG8_LAS bf16x8*)(lds + PG8_SB(b, h) + boff + n * 2048 + k * 1024); } while (0)
#define PG8_MMA(ai, bj, At, Bt) do { __builtin_amdgcn_s_setprio(1); _Pragma("unroll") for (int m = 0; m < 4; ++m) _Pragma("unroll") for (int n = 0; n < 2; ++n) _Pragma("unroll") for (int k = 0; k < 2; ++k) \
        acc[ai][bj][m][n] = __builtin_amdgcn_mfma_f32_16x16x32_bf16(Bt[n][k], At[m][k], acc[ai][bj][m][n], 0, 0, 0); __builtin_amdgcn_s_setprio(0); } while (0)
#define PG8_WAIT_V(n) asm volatile("s_waitcnt vmcnt(" #n ")" ::: "memory")
#define PG8_WAIT_L(n) asm volatile("s_waitcnt lgkmcnt(" #n ")" ::: "memory")
#define PG8_BAR __builtin_amdgcn_s_barrier()
#define PG8_SCHED __builtin_amdgcn_sched_barrier(0)
    Unit cur, nxt; int ui = 0;
    if (!S.next(0, cur)) return;
    f32x4 acc[2][2][4][2];
#pragma unroll
    for (int a = 0; a < 2; ++a)
#pragma unroll
        for (int b = 0; b < 2; ++b)
#pragma unroll
            for (int m = 0; m < 4; ++m)
#pragma unroll
                for (int n = 0; n < 2; ++n) acc[a][b][m][n] = (f32x4){0.f, 0.f, 0.f, 0.f};
    bf16x8 At[4][2], B0[2][2], B1[2][2];
    const char* cA = (const char*)g.A + (size_t)cur.pm * tstep; const char* cB = (const char*)g.Bt + (size_t)cur.pn * tstep;
    S.a_ready(cur);
    PG8_STAGE(PG8_SB(0, 0), cB, voffB); PG8_STAGE(PG8_SB(0, 1), cB + hstep, voffB); PG8_STAGE(PG8_SA(0, 0), cA, voffA); PG8_STAGE(PG8_SA(0, 1), cA + hstep, voffA);
    if (wr == 1) PG8_BAR;
    PG8_WAIT_V(2); PG8_BAR;
    PG8_STAGE(PG8_SB(1, 0), cB + kstep, voffB); PG8_STAGE(PG8_SA(1, 0), cA + kstep, voffA); PG8_STAGE(PG8_SB(1, 1), cB + hstep + kstep, voffB);
    PG8_WAIT_V(6); PG8_BAR;
    for (;;) {
        const bool has_next = S.next(ui + 1, nxt);
        const char* nA = has_next ? (const char*)g.A + (size_t)nxt.pm * tstep : cA; const char* nB = has_next ? (const char*)g.Bt + (size_t)nxt.pn * tstep : cB;
        for (int t = 0; t < nt; t += 2) {
            const bool last = (t == nt - 2);
            const char* a1 = cA + (size_t)(t + 1) * kstep;
            const char* a2 = last ? nA : cA + (size_t)(t + 2) * kstep; const char* b2 = last ? nB : cB + (size_t)(t + 2) * kstep;
            const char* a3 = a2 + kstep; const char* b3 = b2 + kstep;
            if (last && has_next) S.a_ready(nxt);
            PG8_LDB(B0, 0, 0); PG8_LDB(B1, 0, 1); PG8_SCHED; PG8_LDA(At, 0, 0); PG8_STAGE(PG8_SA(1, 1), a1 + hstep, voffA);
            PG8_WAIT_V(8); PG8_WAIT_L(0); PG8_BAR; PG8_MMA(0, 0, At, B0); PG8_MMA(0, 1, At, B1); PG8_BAR; PG8_SCHED;
            PG8_LDA(At, 0, 1); PG8_STAGE(PG8_SB(0, 0), b2, voffB); PG8_STAGE(PG8_SB(0, 1), b2 + hstep, voffB); PG8_STAGE(PG8_SA(0, 0), a2, voffA);
            PG8_WAIT_V(8); PG8_WAIT_L(0); PG8_BAR; PG8_MMA(1, 0, At, B0); PG8_MMA(1, 1, At, B1); PG8_BAR; PG8_SCHED;
            PG8_LDB(B0, 1, 0); PG8_LDB(B1, 1, 1); PG8_SCHED; PG8_LDA(At, 1, 0); PG8_STAGE(PG8_SA(0, 1), a2 + hstep, voffA);
            PG8_WAIT_V(8); PG8_WAIT_L(0); PG8_BAR; PG8_MMA(0, 0, At, B0); PG8_MMA(0, 1, At, B1); PG8_BAR; PG8_SCHED;
            PG8_LDA(At, 1, 1); PG8_STAGE(PG8_SB(1, 0), b3, voffB); PG8_STAGE(PG8_SB(1, 1), b3 + hstep, voffB); PG8_STAGE(PG8_SA(1, 0), a3, voffA);
            PG8_WAIT_V(8); PG8_WAIT_L(0); PG8_BAR; PG8_MMA(1, 0, At, B0); PG8_MMA(1, 1, At, B1); PG8_BAR; PG8_SCHED;
        }
        if constexpr (ALIGN_EPI) { if (wr == 0) PG8_BAR; }
        E(acc, cur, wr, wc, fr, fq); S.done(cur);
        if (!has_next) break;
#pragma unroll
        for (int a = 0; a < 2; ++a)
#pragma unroll
            for (int b = 0; b < 2; ++b)
#pragma unroll
                for (int m = 0; m < 4; ++m)
#pragma unroll
                    for (int n = 0; n < 2; ++n) acc[a][b][m][n] = (f32x4){0.f, 0.f, 0.f, 0.f};
        cur = nxt; cA = nA; cB = nB; ++ui;
        if constexpr (ALIGN_EPI) { if (wr == 1) PG8_BAR; }
    }
    PG8_WAIT_V(0);
    if constexpr (!ALIGN_EPI) { if (wr == 0) PG8_BAR; }
    PG8_BAR;
#undef PG8_SA
#undef PG8_SB
#undef PG8_STAGE
#undef PG8_LDA
#undef PG8_LDB
#undef PG8_MMA
#undef PG8_WAIT_V
#undef PG8_WAIT_L
#undef PG8_BAR
#undef PG8_SCHED
}
}

#define LAS __attribute__((address_space(3)))
#define GAS __attribute__((address_space(1)))
typedef unsigned v4u __attribute__((ext_vector_type(4)));
constexpr int NWAVES = 8, LDS_BYTES = 163840, MISC_OFF = LDS_BYTES - 512;
#define LDS_WAIT() asm volatile("s_waitcnt lgkmcnt(0)" ::: "memory")

__device__ __forceinline__ void transpose_item(const float* W, int K, int N, int Npad, bf16_t* WT, LAS float* scr, int item, int lane) {
    const int nblk = Npad / 32, kb = item / nblk, nb = item % nblk, k0 = 64 * kb, n0 = 32 * nb;
    const int n = n0 + (lane & 31); const bool ok = n < N;
    float v[32];
    const float* src = W + (size_t)(k0 + (lane >> 5)) * N + n;
#pragma unroll
    for (int i = 0; i < 32; ++i) v[i] = ok ? src[(size_t)(2 * i) * N] : 0.f;
#pragma unroll
    for (int i = 0; i < 32; ++i) scr[(2 * i + (lane >> 5)) * 33 + (lane & 31)] = v[i];
    LDS_WAIT(); asm volatile("" ::: "memory");
    const int c = lane & 7;
#pragma unroll
    for (int j = 0; j < 4; ++j) { const int nn = (lane >> 3) + 8 * j; const LAS float* s = scr + (8 * c) * 33 + nn;
        v4u o; o.x = pk2(s[0 * 33], s[1 * 33]); o.y = pk2(s[2 * 33], s[3 * 33]); o.z = pk2(s[4 * 33], s[5 * 33]); o.w = pk2(s[6 * 33], s[7 * 33]);
        *(GAS v4u*)(WT + (size_t)(n0 + nn) * K + k0 + 8 * c) = o; }
    LDS_WAIT(); asm volatile("" ::: "memory");
}


typedef short bf16x8 __attribute__((ext_vector_type(8)));
typedef short s16x4 __attribute__((ext_vector_type(4)));
typedef unsigned u32x2 __attribute__((ext_vector_type(2)));
__device__ __forceinline__ s16x4 tr16(const LAS bf16_t* p) { return __builtin_bit_cast(s16x4, __builtin_amdgcn_ds_read_tr16_b64_v4i16((LAS s16x4*)p)); }
__device__ __forceinline__ bf16x8 frag_row(const LAS bf16_t* img, int ld, int nc0, int k0, int lane) { return *(const LAS bf16x8*)(img + (nc0 + (lane & 15)) * ld + k0 + 8 * (lane >> 4)); }
__device__ __forceinline__ bf16x8 frag_tr(const LAS bf16_t* img, int ld, int nc0, int k0, int lane) {
    const int g = lane >> 4, q = (lane & 15) >> 2, p = lane & 3;
    const LAS bf16_t* ad = img + (k0 + 8 * g + q) * ld + nc0 + 4 * p;
    const s16x4 lo = tr16(ad), hi = tr16(ad + 4 * ld);
    return (bf16x8){lo[0], lo[1], lo[2], lo[3], hi[0], hi[1], hi[2], hi[3]};
}
__device__ __forceinline__ bf16x8 frag_row_g(const bf16_t* img, int ld, int nc0, int k0, int lane) { return *(const bf16x8*)(img + (size_t)(nc0 + (lane & 15)) * ld + k0 + 8 * (lane >> 4)); }
__device__ __forceinline__ bf16x8 frag_fo(const bf16_t* img, int KS, int tile, int ks, int lane) { return *(const bf16x8*)(img + ((size_t)(tile * KS + ks) * 64 + lane) * 8); }
__device__ __forceinline__ int fo_st(int tile, int KS, int k0, int g, int r) { const int k = k0 + 4 * g; return ((tile * KS + (k >> 5)) * 64 + ((k >> 3) & 3) * 16 + r) * 8 + (k & 7); }
__device__ __forceinline__ int co_off(int tj, int NI, int ti, int lane) { return ((tj * NI + ti) * 64 + lane) * 4; }
__device__ __forceinline__ f32x4 mfma16(bf16x8 a, bf16x8 b, f32x4 c) { return __builtin_amdgcn_mfma_f32_16x16x32_bf16(a, b, c, 0, 0, 0); }
__device__ __forceinline__ u32x2 pack4(f32x4 v) { u32x2 w; w.x = pk2(v[0], v[1]); w.y = pk2(v[2], v[3]); return w; }
__device__ __forceinline__ f32x4 unpack4(u32x2 w) { f32x4 v; v[0] = __uint_as_float(w.x << 16); v[1] = __uint_as_float(w.x & 0xffff0000u); v[2] = __uint_as_float(w.y << 16); v[3] = __uint_as_float(w.y & 0xffff0000u); return v; }
#define WG_SYNC() __syncthreads()

__device__ __forceinline__ void ret_stage1(CArgs& a, int n, int h, LAS unsigned char* lds, int tid) {
    const int lane = tid & 63, w = __builtin_amdgcn_readfirstlane(tid >> 6), r = lane & 15, g = lane >> 4;
    constexpr int LD = 72, LDV = 136;
    LAS bf16_t* Qi = (LAS bf16_t*)lds; LAS bf16_t* Ki = Qi + 64 * LD; LAS bf16_t* Kdi = Ki + 64 * LD; LAS bf16_t* Vi = Kdi + 64 * LD; LAS bf16_t* Si = Vi + 64 * LDV;
    const int tk = n * 4 + h; const float lg2 = log2f(1.0f - exp2f(-5.0f - (float)h));
    bf16_t* QH = (bf16_t*)(a.ws + WS_RET_QH) + (size_t)tk * 4096;
    for (int idx = tid; idx < 2048; idx += 512) {
        const int c = idx >> 5, i = idx & 31, t = n * 64 + c; float sn, cs; sincosf((float)t * THETA[i], &sn, &cs);
        const bf16_t* pr = PROJROW(t);
        const unsigned qq = *(const unsigned*)(pr + C_RQ + 64 * h + 2 * i), kk = *(const unsigned*)(pr + C_RK + 64 * h + 2 * i);
        const float q0 = __uint_as_float(qq << 16), q1 = __uint_as_float(qq & 0xffff0000u), k0 = __uint_as_float(kk << 16), k1 = __uint_as_float(kk & 0xffff0000u);
        const float rq0 = q0 * cs - q1 * sn, rq1 = q1 * cs + q0 * sn, rk0 = (k0 * cs - k1 * sn) * 0.125f, rk1 = (k1 * cs + k0 * sn) * 0.125f;
        const float dk = exp2f(lg2 * (float)(63 - c)), dq = exp2f(lg2 * (float)(c + 1));
        *(LAS unsigned*)(Qi + c * LD + 2 * i) = pk2(rq0, rq1); *(LAS unsigned*)(Ki + c * LD + 2 * i) = pk2(rk0, rk1); *(LAS unsigned*)(Kdi + c * LD + 2 * i) = pk2(rk0 * dk, rk1 * dk);
        { const int d = 2 * i; *(unsigned*)(QH + (((c >> 4) * 2 + (d >> 5)) * 64 + ((d >> 3) & 3) * 16 + (c & 15)) * 8 + (d & 7)) = pk2(rq0 * dq, rq1 * dq); }
    }
    for (int idx = tid; idx < 1024; idx += 512) { const int c = idx >> 4, ch = idx & 15; *(LAS v4u*)(Vi + c * LDV + 8 * ch) = *(const v4u*)(PROJROW(n * 64 + c) + C_RV + 128 * h + 8 * ch); }
    WG_SYNC();
#pragma unroll
    for (int tt = 0; tt < 2; ++tt) { const int tile = 2 * w + tt, im = tile >> 2, jc = tile & 3; f32x4 acc = {0.f, 0.f, 0.f, 0.f};
        if (jc >= im) {
#pragma unroll
            for (int k0 = 0; k0 < 64; k0 += 32) acc = mfma16(frag_row(Ki, LD, 16 * im, k0, lane), frag_row(Qi, LD, 16 * jc, k0, lane), acc);
#pragma unroll
            for (int e = 0; e < 4; ++e) { const int i = 16 * im + 4 * g + e, j = 16 * jc + r; acc[e] = j >= i ? acc[e] * exp2f(lg2 * (float)(j - i)) : 0.f; } }
        *(LAS u32x2*)(Si + (16 * jc + r) * LD + 16 * im + 4 * g) = pack4(acc); }
    WG_SYNC();
    bf16_t* YI = (bf16_t*)(a.ws + WS_RET_YI) + (size_t)tk * 8192; float* Z = WSF(WS_RET_Z) + (size_t)tk * 8192;
#pragma unroll
    for (int tt = 0; tt < 4; ++tt) { const int jc = w & 3, ie = 4 * (w >> 2) + tt; f32x4 acc = {0.f, 0.f, 0.f, 0.f};
#pragma unroll
        for (int k0 = 0; k0 < 64; k0 += 32) acc = mfma16(frag_tr(Vi, LDV, 16 * ie, k0, lane), frag_row(Si, LD, 16 * jc, k0, lane), acc);
        *(u32x2*)(YI + co_off(jc, 8, ie, lane)) = pack4(acc); }
#pragma unroll
    for (int tt = 0; tt < 4; ++tt) { const int id = w & 3, je = 4 * (w >> 2) + tt; f32x4 acc = {0.f, 0.f, 0.f, 0.f};
#pragma unroll
        for (int k0 = 0; k0 < 64; k0 += 32) acc = mfma16(frag_tr(Kdi, LD, 16 * id, k0, lane), frag_tr(Vi, LDV, 16 * je, k0, lane), acc);
        *(f32x4*)(Z + fo_st(je, 2, 16 * id, g, r)) = acc; }
    WG_SYNC();
}
__device__ __forceinline__ void ret_stage2(CArgs& a, int b, int tid) {
    const int idx = b * 512 + tid, h = idx >> 13, rem = idx & 8191; const float g64 = exp2f(64.0f * log2f(1.0f - exp2f(-5.0f - (float)h)));
    const float* Z = WSF(WS_RET_Z) + (size_t)h * 8192 + rem; bf16_t* S = (bf16_t*)(a.ws + WS_RET_S) + (size_t)h * 8192 + rem; float s = 0.f;
#pragma unroll 8
    for (int n = 0; n < NCH; ++n) { const float z = Z[(size_t)n * 4 * 8192]; S[(size_t)n * 4 * 8192] = (bf16_t)f2bf(s); s = g64 * s + z; }
}
__device__ __forceinline__ void ret_stage3(CArgs& a, int l, int n, int h, LAS unsigned char* lds, int tid) {
    const int lane = tid & 63, w = __builtin_amdgcn_readfirstlane(tid >> 6), r = lane & 15, g = lane >> 4, jc = w & 3, wh = w >> 2;
    const int tk = n * 4 + h; const int c = 16 * jc + r, t = n * 64 + c;
    const bf16_t* S = (const bf16_t*)(a.ws + WS_RET_S) + (size_t)tk * 8192; const bf16_t* QH = (const bf16_t*)(a.ws + WS_RET_QH) + (size_t)tk * 4096; const bf16_t* YI = (const bf16_t*)(a.ws + WS_RET_YI) + (size_t)tk * 8192;
    LAS float* xs = (LAS float*)lds;
    f32x4 acc[4];
#pragma unroll
    for (int tt = 0; tt < 4; ++tt) { const int ie = 4 * wh + tt; acc[tt] = unpack4(*(const u32x2*)(YI + co_off(jc, 8, ie, lane)));
#pragma unroll
        for (int k = 0; k < 2; ++k) acc[tt] = mfma16(frag_fo(S, 2, ie, k, lane), frag_fo(QH, 2, jc, k, lane), acc[tt]); }
    float s1 = 0.f;
#pragma unroll
    for (int tt = 0; tt < 4; ++tt) s1 += (acc[tt][0] + acc[tt][1]) + (acc[tt][2] + acc[tt][3]);
    s1 += __shfl_xor(s1, 16); s1 += __shfl_xor(s1, 32);
    if (g == 0) xs[w * 16 + r] = s1;
    WG_SYNC();
    const float mu = (s1 + xs[(w ^ 4) * 16 + r]) * (1.0f / 128.0f); float s2 = 0.f;
#pragma unroll
    for (int tt = 0; tt < 4; ++tt)
#pragma unroll
        for (int e = 0; e < 4; ++e) { acc[tt][e] -= mu; s2 += acc[tt][e] * acc[tt][e]; }
    s2 += __shfl_xor(s2, 16); s2 += __shfl_xor(s2, 32);
    if (g == 0) xs[128 + w * 16 + r] = s2;
    WG_SYNC();
    const float rs = 1.0f / sqrtf((s2 + xs[128 + (w ^ 4) * 16 + r]) * (1.0f / 128.0f) + 1e-6f);
    const float* nw = LP(I_RNORM, 512) + h * 128; const bf16_t* pr = PROJROW(t) + C_RG + h * 128; bf16_t* O = (bf16_t*)(a.ws + WS_O) + (size_t)t * D + 512 + h * 128;
#pragma unroll
    for (int tt = 0; tt < 4; ++tt) { const int e0 = 16 * (4 * wh + tt) + 4 * g; const f32x4 gt = unpack4(*(const u32x2*)(pr + e0)); const f32x4 wv = *(const f32x4*)(nw + e0); f32x4 y;
#pragma unroll
        for (int e = 0; e < 4; ++e) y[e] = acc[tt][e] * rs * wv[e] * silu_f(gt[e]);
        *(u32x2*)(O + e0) = pack4(y); }
    WG_SYNC();
}

constexpr int RW_LD = 72;
constexpr int RWO_V = 0, RWO_IMG = 9216  , RWO_XI = 36864  , RWO_UI = 55296, RWO_CUMC = 64512, RWO_WT = 65536  , RWO_AM = 65536, RWO_TRI = 82944,
              RWO_RHST = 110592, RWO_AI = 143360, RWO_DI = 152576;
constexpr int RWO_LW = 9216, RWO_LIN = 82944;
__device__ __forceinline__ float ftanh(float x) { return 1.0f - 2.0f * __builtin_amdgcn_rcpf(1.0f + fexp(2.0f * x)); }
__device__ __forceinline__ float fsoftplus(float x) { return x > 20.f ? x : __builtin_amdgcn_logf(1.0f + fexp(x)) * 0.6931471805599453f; }
__device__ __forceinline__ void rw_stage1(CArgs& a, int l, int n, int h, LAS unsigned char* lds, int tid, const int stop = 99) {
    const int w = __builtin_amdgcn_readfirstlane(tid >> 6), tk = n * 8 + h;
    int lane, r, g, c, kg, t;
#define RW_IDX() do { int tl_ = tid; asm volatile("" : "+v"(tl_)); lane = tl_ & 63; r = lane & 15; g = lane >> 4; c = tl_ >> 3; kg = tl_ & 7; t = n * 64 + c; } while (0)
    RW_IDX();
    LAS bf16_t* Vi = (LAS bf16_t*)(lds + RWO_V);
    LAS bf16_t* RHi = (LAS bf16_t*)(lds + RWO_IMG); LAS bf16_t* BTi = RHi + 64 * RW_LD; LAS bf16_t* KTi = BTi + 64 * RW_LD; LAS bf16_t* KHi = KTi + 64 * RW_LD; LAS bf16_t* BMi = KHi + 64 * RW_LD; LAS bf16_t* KMi = BMi + 64 * RW_LD;
    LAS bf16_t* XI = (LAS bf16_t*)(lds + RWO_XI);
    LAS bf16_t* UI = (LAS bf16_t*)(lds + RWO_UI);
    LAS float* CUMC = (LAS float*)(lds + RWO_CUMC); LAS float* WT = (LAS float*)(lds + RWO_WT); LAS float* AM = (LAS float*)(lds + RWO_AM);
    LAS bf16_t* BMI = (LAS bf16_t*)(lds + RWO_TRI); LAS bf16_t* PBI = BMI + 64 * RW_LD; LAS bf16_t* PKI = PBI + 64 * RW_LD;
    LAS float* RHST = (LAS float*)(lds + RWO_RHST);
    LAS bf16_t* AI = (LAS bf16_t*)(lds + RWO_AI);
    LAS bf16_t* DI = (LAS bf16_t*)(lds + RWO_DI);
    LAS float* LW = (LAS float*)(lds + RWO_LW); LAS float* LA = LW + 4096; LAS float* LG = LA + 4096;
    LAS bf16_t* WLi = (LAS bf16_t*)(lds + RWO_LIN); LAS bf16_t* ALi = WLi + 64 * 40; LAS bf16_t* GLi = ALi + 64 * 40; LAS bf16_t* WUPi = GLi + 64 * 104; LAS bf16_t* AUPi = WUPi + 32 * RW_LD; LAS bf16_t* GUPi = AUPi + 32 * RW_LD;
    const float* mu = LP(I_RWMU, 1696); const bf16_t* p1 = PROJROW(t) + C_RW; const bf16_t* p0 = p1 - PTP; bool hp = t > 0;
    float vv[8];
    { const v4u cu = *(const v4u*)(p1 + 1024 + 64 * h + 8 * kg); v4u pv = {0u, 0u, 0u, 0u}; if (hp) pv = *(const v4u*)(p0 + 1024 + 64 * h + 8 * kg);
      const float* m = mu + 1024 + 64 * h + 8 * kg; const f32x4 m0 = *(const f32x4*)m, m1 = *(const f32x4*)(m + 4); v4u o;
#pragma unroll
      for (int u = 0; u < 4; ++u) { const unsigned cw = cu[u], pw = pv[u]; const float c0 = __uint_as_float(cw << 16), c1 = __uint_as_float(cw & 0xffff0000u), q0 = __uint_as_float(pw << 16), q1 = __uint_as_float(pw & 0xffff0000u);
          const float ma = u < 2 ? m0[2 * u] : m1[2 * u - 4], mb = u < 2 ? m0[2 * u + 1] : m1[2 * u - 3];
          vv[2 * u] = c0 + (q0 - c0) * ma; vv[2 * u + 1] = c1 + (q1 - c1) * mb; o[u] = pk2(vv[2 * u], vv[2 * u + 1]); }
      *(LAS v4u*)(Vi + c * RW_LD + 8 * kg) = o; }
    {
      u32x2 cw = *(const u32x2*)(p1 + 1536 + 4 * kg), ca = *(const u32x2*)(p1 + 1568 + 4 * kg), pw = {0u, 0u}, pa = {0u, 0u};
      u32x2 cg[3], pg[3] = {{0u, 0u}, {0u, 0u}, {0u, 0u}};
#pragma unroll
      for (int q = 0; q < 3; ++q) cg[q] = *(const u32x2*)(p1 + 1600 + 12 * kg + 4 * q);
      if (hp) { pw = *(const u32x2*)(p0 + 1536 + 4 * kg); pa = *(const u32x2*)(p0 + 1568 + 4 * kg);
#pragma unroll
          for (int q = 0; q < 3; ++q) pg[q] = *(const u32x2*)(p0 + 1600 + 12 * kg + 4 * q); }
      const f32x4 mw = *(const f32x4*)(mu + 1536 + 4 * kg), ma = *(const f32x4*)(mu + 1568 + 4 * kg);
      { const f32x4 cv = unpack4(cw), pv = unpack4(pw); f32x4 x;
#pragma unroll
        for (int u = 0; u < 4; ++u) x[u] = ftanh(cv[u] + (pv[u] - cv[u]) * mw[u]);
        *(LAS u32x2*)(WLi + c * 40 + 4 * kg) = pack4(x); }
      { const f32x4 cv = unpack4(ca), pv = unpack4(pa); f32x4 x;
#pragma unroll
        for (int u = 0; u < 4; ++u) x[u] = cv[u] + (pv[u] - cv[u]) * ma[u];
        *(LAS u32x2*)(ALi + c * 40 + 4 * kg) = pack4(x); }
#pragma unroll
      for (int q = 0; q < 3; ++q) { const f32x4 cv = unpack4(cg[q]), pv = unpack4(pg[q]), mg = *(const f32x4*)(mu + 1600 + 12 * kg + 4 * q); f32x4 x;
#pragma unroll
          for (int u = 0; u < 4; ++u) x[u] = sigmoid_f(cv[u] + (pv[u] - cv[u]) * mg[u]);
          *(LAS u32x2*)(GLi + c * 104 + 12 * kg + 4 * q) = pack4(x); } }
    { const int j = tid >> 4, k4 = (tid & 15) * 4;
      const f32x4 wv = *(const f32x4*)(LP(I_RWWUP, 32 * 512) + j * 512 + 64 * h + k4), av = *(const f32x4*)(LP(I_RWAUP, 32 * 512) + j * 512 + 64 * h + k4);
      *(LAS u32x2*)(WUPi + j * RW_LD + k4) = pack4(wv); *(LAS u32x2*)(AUPi + j * RW_LD + k4) = pack4(av);
#pragma unroll
      for (int q = 0; q < 3; ++q) { const f32x4 gv = *(const f32x4*)(LP(I_RWGUP, 96 * 512) + (32 * q + j) * 512 + 64 * h + k4); *(LAS u32x2*)(GUPi + (32 * q + j) * RW_LD + k4) = pack4(gv); } }
    WG_SYNC();
    if (stop <= 0) return;
    RW_IDX();
#pragma unroll
    for (int tt = 0; tt < 2; ++tt) { const int tile = 2 * w + tt, ik = tile >> 2, jc = tile & 3;
        f32x4 aw = {0.f, 0.f, 0.f, 0.f}, aa = aw, ag = aw;
        aw = mfma16(frag_tr(WUPi, RW_LD, 16 * ik, 0, lane), frag_row(WLi, 40, 16 * jc, 0, lane), aw);
        aa = mfma16(frag_tr(AUPi, RW_LD, 16 * ik, 0, lane), frag_row(ALi, 40, 16 * jc, 0, lane), aa);
#pragma unroll
        for (int k0 = 0; k0 < 96; k0 += 32) ag = mfma16(frag_tr(GUPi, RW_LD, 16 * ik, k0, lane), frag_row(GLi, 104, 16 * jc, k0, lane), ag);
        const int o = (16 * jc + r) * 64 + 16 * ik + 4 * g; *(LAS f32x4*)(LW + o) = aw; *(LAS f32x4*)(LA + o) = aa; *(LAS f32x4*)(LG + o) = ag; }
    WG_SYNC();
    if (stop <= 1) return;
    RW_IDX();
    p1 = PROJROW(t) + C_RW; p0 = p1 - PTP; hp = t > 0;
    float rr[8], kk[8], bb[8], kt[8], lwd[8], cum[8];
    { const int ch0 = 64 * h + 8 * kg; float ss = 0.f, rk = 0.f; float gt[8];
      const v4u cr = *(const v4u*)(p1 + ch0), ck = *(const v4u*)(p1 + 512 + ch0); v4u qr = {0u, 0u, 0u, 0u}, qk = qr; if (hp) { qr = *(const v4u*)(p0 + ch0); qk = *(const v4u*)(p0 + 512 + ch0); }
      float pw0[8], pa0[8], pkk[8], pka[8], prk[8], pmr[8], pmk[8];
#pragma unroll
      for (int q = 0; q < 2; ++q) { const f32x4 x0 = *(const f32x4*)(LP(I_RWW0, 512) + ch0 + 4 * q), x1 = *(const f32x4*)(LP(I_RWA0, 512) + ch0 + 4 * q), x2 = *(const f32x4*)(LP(I_RWKK, 512) + ch0 + 4 * q), x3 = *(const f32x4*)(LP(I_RWKA, 512) + ch0 + 4 * q),
                                                 x4 = *(const f32x4*)(LP(I_RWRK, 512) + ch0 + 4 * q), x5 = *(const f32x4*)(mu + ch0 + 4 * q), x6 = *(const f32x4*)(mu + 512 + ch0 + 4 * q);
#pragma unroll
          for (int e = 0; e < 4; ++e) { pw0[4 * q + e] = x0[e]; pa0[4 * q + e] = x1[e]; pkk[4 * q + e] = x2[e]; pka[4 * q + e] = x3[e]; prk[4 * q + e] = x4[e]; pmr[4 * q + e] = x5[e]; pmk[4 * q + e] = x6[e]; } }
#pragma unroll
      for (int u = 0; u < 8; ++u) { const unsigned crw = cr[u >> 1], ckw = ck[u >> 1], qrw = qr[u >> 1], qkw = qk[u >> 1];
          const float curR = (u & 1) ? __uint_as_float(crw & 0xffff0000u) : __uint_as_float(crw << 16), curK = (u & 1) ? __uint_as_float(ckw & 0xffff0000u) : __uint_as_float(ckw << 16);
          const float prvR = (u & 1) ? __uint_as_float(qrw & 0xffff0000u) : __uint_as_float(qrw << 16), prvK = (u & 1) ? __uint_as_float(qkw & 0xffff0000u) : __uint_as_float(qkw << 16);
          const float rv = curR + (prvR - curR) * pmr[u], kr = curK + (prvK - curK) * pmk[u];
          const float lw = LW[c * 64 + 8 * kg + u], la = LA[c * 64 + 8 * kg + u]; gt[u] = LG[c * 64 + 8 * kg + u];
          const float wraw = -fsoftplus(-(pw0[u] + lw)) - 0.5f; lwd[u] = -fexp(wraw);
          const float av = sigmoid_f(pa0[u] + la); const float kkr = kr * pkk[u]; kt[u] = kr * (1.0f + (av - 1.0f) * pka[u]);
          rr[u] = rv; kk[u] = kkr; bb[u] = av; ss += kkr * kkr; rk += rv * kt[u] * prk[u]; }
      ss += __shfl_xor(ss, 1); ss += __shfl_xor(ss, 2); ss += __shfl_xor(ss, 4); rk += __shfl_xor(rk, 1); rk += __shfl_xor(rk, 2); rk += __shfl_xor(rk, 4);
      const float inv = __builtin_amdgcn_rsqf(ss + 1e-6f);
#pragma unroll
      for (int u = 0; u < 8; ++u) { kk[u] *= inv; bb[u] *= kk[u]; }
#pragma unroll
      for (int u = 0; u < 8; ++u) { float x = lwd[u];
#pragma unroll
          for (int o = 8; o < 64; o <<= 1) { const float up = __shfl_up(x, o); if (lane >= o) x += up; }
          cum[u] = x; }
      if (lane >= 56) { *(LAS f32x4*)(WT + w * 64 + 8 * kg) = (f32x4){cum[0], cum[1], cum[2], cum[3]}; *(LAS f32x4*)(WT + w * 64 + 8 * kg + 4) = (f32x4){cum[4], cum[5], cum[6], cum[7]}; }
      v4u eo, go;
#pragma unroll
      for (int u = 0; u < 4; ++u) { eo[u] = pk2(rk * vv[2 * u], rk * vv[2 * u + 1]); go[u] = pk2(gt[2 * u], gt[2 * u + 1]); }
      bf16_t* Eo = (bf16_t*)(a.ws + WS_RW_E) + (size_t)tk * 4096; bf16_t* Go = (bf16_t*)(a.ws + WS_RW_GT) + (size_t)tk * 4096;
#pragma unroll
      for (int hf = 0; hf < 2; ++hf) { const int o = (((c >> 4) * 4 + (kg >> 1)) * 64 + ((2 * kg + hf) & 3) * 16 + (c & 15)) * 4;
          *(u32x2*)(Eo + o) = (u32x2){eo[2 * hf], eo[2 * hf + 1]}; *(u32x2*)(Go + o) = (u32x2){go[2 * hf], go[2 * hf + 1]}; } }
    WG_SYNC();
    if (stop <= 3) return;
    RW_IDX();
    { float cc[8];
#pragma unroll
      for (int u = 0; u < 8; ++u) cc[u] = 0.f;
#pragma unroll
      for (int ww = 0; ww < 8; ++ww) { const f32x4 t0 = *(const LAS f32x4*)(WT + ww * 64 + 8 * kg), t1 = *(const LAS f32x4*)(WT + ww * 64 + 8 * kg + 4);
#pragma unroll
          for (int e = 0; e < 4; ++e) { if (ww < w) { cum[e] += t0[e]; cum[4 + e] += t1[e]; } cc[e] += t0[e]; cc[4 + e] += t1[e]; } }
      if (c == 0) { *(LAS f32x4*)(CUMC + 8 * kg) = (f32x4){cc[0], cc[1], cc[2], cc[3]}; *(LAS f32x4*)(CUMC + 8 * kg + 4) = (f32x4){cc[4], cc[5], cc[6], cc[7]}; }
      v4u oRH, oBT, oKT, oKH, oBM, oKM;
#pragma unroll
      for (int u = 0; u < 8; u += 2) { float x[6][2];
#pragma unroll
          for (int e = 0; e < 2; ++e) { const float cu = cum[u + e]; const float ep = fexp(cu), em = fexp(-cu), et = fexp(cc[u + e] - cu), ex = fexp(cu - lwd[u + e]);
              x[0][e] = rr[u + e] * ep; x[1][e] = bb[u + e] * et; x[2][e] = kt[u + e] * et; x[3][e] = kk[u + e] * ex; x[4][e] = bb[u + e] * em; x[5][e] = kt[u + e] * em;
              RHST[(8 * kg + u + e) * 64 + c] = x[3][e]; }
          oRH[u >> 1] = pk2(x[0][0], x[0][1]); oBT[u >> 1] = pk2(x[1][0], x[1][1]); oKT[u >> 1] = pk2(x[2][0], x[2][1]); oKH[u >> 1] = pk2(x[3][0], x[3][1]); oBM[u >> 1] = pk2(x[4][0], x[4][1]); oKM[u >> 1] = pk2(x[5][0], x[5][1]); }
      const int o = c * RW_LD + 8 * kg;
      *(LAS v4u*)(RHi + o) = oRH; *(LAS v4u*)(BTi + o) = oBT; *(LAS v4u*)(KTi + o) = oKT; *(LAS v4u*)(KHi + o) = oKH; *(LAS v4u*)(BMi + o) = oBM; *(LAS v4u*)(KMi + o) = oKM; }
    WG_SYNC();
    if (stop <= 4) return;
    RW_IDX();
#pragma unroll
    for (int tt = 0; tt < 2; ++tt) { const int tile = 2 * w + tt, ii = tile >> 2, jt = tile & 3;
        f32x4 cA = {0.f, 0.f, 0.f, 0.f}, cB = cA, cPb = cA, cPk = cA;
        if (ii <= jt) {
#pragma unroll
            for (int k0 = 0; k0 < 64; k0 += 32) { const bf16x8 fbm = frag_row(BMi, RW_LD, 16 * ii, k0, lane), fkm = frag_row(KMi, RW_LD, 16 * ii, k0, lane), fkh = frag_row(KHi, RW_LD, 16 * jt, k0, lane), frh = frag_row(RHi, RW_LD, 16 * jt, k0, lane);
                cA = mfma16(fbm, fkh, cA); cB = mfma16(fkm, fkh, cB); cPb = mfma16(fbm, frh, cPb); cPk = mfma16(fkm, frh, cPk); }
#pragma unroll
            for (int e = 0; e < 4; ++e) { const int i = 16 * ii + 4 * g + e, tq = 16 * jt + r; if (!(i < tq)) { cA[e] = 0.f; cB[e] = 0.f; } if (!(i <= tq)) { cPb[e] = 0.f; cPk[e] = 0.f; } } }
        const int tq = 16 * jt + r, i0 = 16 * ii + 4 * g;
        *(LAS f32x4*)(AM + tq * 68 + i0) = cA; *(LAS u32x2*)(AI + tq * RW_LD + i0) = pack4(-cA); *(LAS u32x2*)(BMI + tq * RW_LD + i0) = pack4(cB); *(LAS u32x2*)(PBI + tq * RW_LD + i0) = pack4(cPb); *(LAS u32x2*)(PKI + tq * RW_LD + i0) = pack4(cPk); }
    WG_SYNC();
    if (stop <= 5) return;
    RW_IDX();
#pragma unroll
    for (int tt = 0; tt < 2; ++tt) { const int tile = 2 * w + tt, it = tile >> 2, jv = tile & 3; f32x4 acc = {0.f, 0.f, 0.f, 0.f};
#pragma unroll
        for (int k0 = 0; k0 < 64; k0 += 32) acc = mfma16(frag_row(BMI, RW_LD, 16 * it, k0, lane), frag_tr(Vi, RW_LD, 16 * jv, k0, lane), acc);
        *(LAS f32x4*)(RHST + (64 + 16 * jv + r) * 64 + 16 * it + 4 * g) = acc; }
    { const int q = c * 8 + kg;
      if (q < 64) { const int b = q >> 4, j = q & 15; float d[16];
#pragma unroll
          for (int tq = 0; tq < 16; ++tq) { float acc = tq == j ? 1.f : 0.f;
#pragma unroll
              for (int i = 0; i < tq; ++i) acc -= AM[(16 * b + tq) * 68 + 16 * b + i] * d[i];
              d[tq] = acc; DI[(b * 16 + tq) * 32 + j] = (bf16_t)f2bf(acc); DI[(b * 16 + tq) * 32 + 16 + j] = (bf16_t)0; } }
      for (int i = q; i < 128 * RW_LD / 8; i += 512) *(LAS v4u*)(XI + 8 * i) = (v4u){0u, 0u, 0u, 0u};
      *(LAS v4u*)(UI + w * 512 + lane * 8) = (v4u){0u, 0u, 0u, 0u}; }
    WG_SYNC();
    if (stop <= 6) return;
    RW_IDX();
    { LAS bf16_t* Uw = UI + w * 512; LAS bf16_t* Xw = XI + (16 * w) * RW_LD;
#pragma unroll
      for (int b = 0; b < 4; ++b) { f32x4 acc = *(const LAS f32x4*)(RHST + (16 * w + r) * 64 + 16 * b + 4 * g);
#pragma unroll
          for (int k0 = 0; k0 < 16 * b; k0 += 32) acc = mfma16(frag_row(AI, RW_LD, 16 * b, k0, lane), frag_row(Xw, RW_LD, 0, k0, lane), acc);
          *(LAS u32x2*)(Uw + r * 32 + 4 * g) = pack4(acc);
          asm volatile("s_waitcnt lgkmcnt(0)" ::: "memory");
          f32x4 x = {0.f, 0.f, 0.f, 0.f}; x = mfma16(frag_row(DI + b * 512, 32, 0, 0, lane), frag_row(Uw, 32, 0, 0, lane), x);
          *(LAS u32x2*)(Xw + r * RW_LD + 16 * b + 4 * g) = pack4(x);
          asm volatile("s_waitcnt lgkmcnt(0)" ::: "memory"); } }
    WG_SYNC();
    if (stop <= 7) return;
    RW_IDX();
    { const int o = w >> 1; const LAS bf16_t* WHt = XI; const LAS bf16_t* XTt = XI + 64 * RW_LD;
#pragma unroll
      for (int tt = 0; tt < 8; ++tt) { const int tile = (w & 1) * 8 + tt, ti = tile >> 2, tj = tile & 3; f32x4 c1 = {0.f, 0.f, 0.f, 0.f}, c2 = c1;
          if (o == 0) {
#pragma unroll
              for (int k0 = 0; k0 < 64; k0 += 32) c1 = mfma16(frag_row(WHt, RW_LD, 16 * ti, k0, lane), frag_tr(BTi, RW_LD, 16 * tj, k0, lane), c1);
              const int kq = 16 * tj + r; const float dg = fexp(CUMC[kq]); f32x4 gv;
#pragma unroll
              for (int e = 0; e < 4; ++e) gv[e] = ((16 * ti + 4 * g + e) == kq ? dg : 0.f) - c1[e];
              *(u32x2*)((bf16_t*)(a.ws + WS_RW_G) + (size_t)tk * 4096 + fo_st(tj, 2, 16 * ti, g, r)) = pack4(gv);
          } else if (o == 1) {
#pragma unroll
              for (int k0 = 0; k0 < 64; k0 += 32) { c1 = mfma16(frag_tr(KTi, RW_LD, 16 * ti, k0, lane), frag_tr(Vi, RW_LD, 16 * tj, k0, lane), c1); c2 = mfma16(frag_tr(BTi, RW_LD, 16 * ti, k0, lane), frag_row(XTt, RW_LD, 16 * tj, k0, lane), c2); }
              *(f32x4*)(WSF(WS_RW_Z) + (size_t)tk * 4096 + co_off(tj, 4, ti, lane)) = c1 - c2;
          } else if (o == 2) {
#pragma unroll
              for (int k0 = 0; k0 < 64; k0 += 32) c1 = mfma16(frag_row(WHt, RW_LD, 16 * ti, k0, lane), frag_row(PBI, RW_LD, 16 * tj, k0, lane), c1);
              const int tq = 16 * tj + r; const f32x4 rh = unpack4(*(const LAS u32x2*)(RHi + tq * RW_LD + 16 * ti + 4 * g));
              *(u32x2*)((bf16_t*)(a.ws + WS_RW_QT) + (size_t)tk * 4096 + fo_st(tj, 2, 16 * ti, g, r)) = pack4(rh - c1);
          } else {
#pragma unroll
              for (int k0 = 0; k0 < 64; k0 += 32) { c1 = mfma16(frag_tr(Vi, RW_LD, 16 * ti, k0, lane), frag_row(PKI, RW_LD, 16 * tj, k0, lane), c1); c2 = mfma16(frag_row(XTt, RW_LD, 16 * ti, k0, lane), frag_row(PBI, RW_LD, 16 * tj, k0, lane), c2); }
              *(u32x2*)((bf16_t*)(a.ws + WS_RW_YI) + (size_t)tk * 4096 + co_off(tj, 4, ti, lane)) = pack4(c1 - c2);
          } } }
    WG_SYNC();
#undef RW_IDX
}
__device__ __forceinline__ void rw_stage2(CArgs& a, int h, int vs, LAS unsigned char* lds, int tid) {
    const int lane = tid & 63, w = __builtin_amdgcn_readfirstlane(tid >> 6), r = lane & 15, g = lane >> 4;
    LAS bf16_t* Si = (LAS bf16_t*)lds;
    const bf16_t* G = (const bf16_t*)(a.ws + WS_RW_G); const float* Z = WSF(WS_RW_Z); bf16_t* S = (bf16_t*)(a.ws + WS_RW_S);
    if (w < 4) { *(LAS u32x2*)(Si + r * RW_LD + 16 * w + 4 * g) = (u32x2){0u, 0u}; *(u32x2*)(S + (size_t)h * 4096 + fo_st(vs, 2, 16 * w, g, r)) = (u32x2){0u, 0u}; }
    WG_SYNC();
    constexpr int PD = 8; const int wq = w & 3; const int so = fo_st(vs, 2, 16 * wq, g, r), zo = co_off(vs, 4, wq, lane);
    bf16x8 gf[PD][2]; f32x4 zf[PD];
#pragma unroll
    for (int u = 0; u < PD; ++u) { const size_t tk = (size_t)u * 8 + h; zf[u] = *(const f32x4*)(Z + tk * 4096 + zo); gf[u][0] = frag_fo(G + tk * 4096, 2, wq, 0, lane); gf[u][1] = frag_fo(G + tk * 4096, 2, wq, 1, lane); }
#define RW_STEP(n_, u_, REFILL) do { const int n = (n_); const size_t tk = (size_t)n * 8 + h; const int cur = n & 1; \
            f32x4 acc = zf[u_], acc2 = {0.f, 0.f, 0.f, 0.f}; \
            acc = mfma16(gf[u_][0], frag_row(Si + cur * 16 * RW_LD, RW_LD, 0, 0, lane), acc); acc2 = mfma16(gf[u_][1], frag_row(Si + cur * 16 * RW_LD, RW_LD, 0, 32, lane), acc2); \
            if (REFILL) { const int nn = n + PD < NCH - 1 ? n + PD : NCH - 2; const size_t tn = (size_t)nn * 8 + h; zf[u_] = *(const f32x4*)(Z + tn * 4096 + zo); gf[u_][0] = frag_fo(G + tn * 4096, 2, wq, 0, lane); gf[u_][1] = frag_fo(G + tn * 4096, 2, wq, 1, lane); } \
            const u32x2 pv = pack4(acc + acc2); \
            if (w < 4) { *(LAS u32x2*)(Si + (cur ^ 1) * 16 * RW_LD + r * RW_LD + 16 * wq + 4 * g) = pv; *(u32x2*)(S + (tk + 8) * 4096 + so) = pv; } \
            asm volatile("s_waitcnt lgkmcnt(0)" ::: "memory"); __builtin_amdgcn_s_barrier(); asm volatile("" ::: "memory"); } while (0)
#pragma unroll
    for (int nq = 0; nq < NCH - 1; ++nq) RW_STEP(nq, nq % PD, nq + PD < NCH - 1);
#undef RW_STEP
}
__device__ __forceinline__ void rw_stage3(CArgs& a, int l, int n, int h, LAS unsigned char* lds, int tid) {
    const int lane = tid & 63, w = __builtin_amdgcn_readfirstlane(tid >> 6), r = lane & 15, g = lane >> 4, jc = w & 3, wh = w >> 2;
    const size_t tk = (size_t)n * 8 + h; const int c = 16 * jc + r, t = n * 64 + c;
    const bf16_t* S = (const bf16_t*)(a.ws + WS_RW_S) + tk * 4096; const bf16_t* QT = (const bf16_t*)(a.ws + WS_RW_QT) + tk * 4096; const bf16_t* YI = (const bf16_t*)(a.ws + WS_RW_YI) + tk * 4096;
    LAS float* xs = (LAS float*)lds;
    f32x4 acc[2];
#pragma unroll
    for (int tt = 0; tt < 2; ++tt) { const int iv = 2 * wh + tt; acc[tt] = unpack4(*(const u32x2*)(YI + co_off(jc, 4, iv, lane)));
#pragma unroll
        for (int k = 0; k < 2; ++k) acc[tt] = mfma16(frag_fo(S, 2, iv, k, lane), frag_fo(QT, 2, jc, k, lane), acc[tt]); }
    float s1 = (acc[0][0] + acc[0][1]) + (acc[0][2] + acc[0][3]) + (acc[1][0] + acc[1][1]) + (acc[1][2] + acc[1][3]);
    s1 += __shfl_xor(s1, 16); s1 += __shfl_xor(s1, 32);
    if (g == 0) xs[w * 16 + r] = s1;
    WG_SYNC();
    const float mu = (s1 + xs[(w ^ 4) * 16 + r]) * (1.0f / 64.0f); float s2 = 0.f;
#pragma unroll
    for (int tt = 0; tt < 2; ++tt)
#pragma unroll
        for (int e = 0; e < 4; ++e) { acc[tt][e] -= mu; s2 += acc[tt][e] * acc[tt][e]; }
    s2 += __shfl_xor(s2, 16); s2 += __shfl_xor(s2, 32);
    if (g == 0) xs[128 + w * 16 + r] = s2;
    WG_SYNC();
    const float rs = 1.0f / sqrtf((s2 + xs[128 + (w ^ 4) * 16 + r]) * (1.0f / 64.0f) + 64e-5f);
    const bf16_t* E = (const bf16_t*)(a.ws + WS_RW_E) + tk * 4096; const bf16_t* GT = (const bf16_t*)(a.ws + WS_RW_GT) + tk * 4096;
    bf16_t* O = (bf16_t*)(a.ws + WS_O) + (size_t)t * D + 1536 + h * 64;
#pragma unroll
    for (int tt = 0; tt < 2; ++tt) { const int v0 = 16 * (2 * wh + tt) + 4 * g; const int eo_ = co_off(jc, 4, 2 * wh + tt, lane); const f32x4 ev = unpack4(*(const u32x2*)(E + eo_)), gv = unpack4(*(const u32x2*)(GT + eo_));
        const f32x4 lw = *(const f32x4*)(LP(I_RWLNW, 512) + h * 64 + v0), lb = *(const f32x4*)(LP(I_RWLNB, 512) + h * 64 + v0); f32x4 y;
#pragma unroll
        for (int e = 0; e < 4; ++e) y[e] = (acc[tt][e] * rs * lw[e] + lb[e] + ev[e]) * gv[e];
        *(u32x2*)(O + v0) = pack4(y); }
    WG_SYNC();
}

constexpr int M2_LDS = 136, M2_LDX = 264, M2O_B = 0, M2O_C = 17408, M2O_X = 34816, M2O_XW = 68608, M2O_M = 102400, M2O_DT = 139264, M2O_G = 140288, M2O_GL = 141312;
__device__ __forceinline__ void m2_stage1(CArgs& a, int l, int n, int gr, LAS unsigned char* lds, int tid) {
    const int lane = tid & 63, w = __builtin_amdgcn_readfirstlane(tid >> 6), r = lane & 15, g = lane >> 4;
    LAS bf16_t* Bi = (LAS bf16_t*)(lds + M2O_B); LAS bf16_t* Ci = (LAS bf16_t*)(lds + M2O_C); LAS bf16_t* Xi = (LAS bf16_t*)(lds + M2O_X); LAS bf16_t* XWi = (LAS bf16_t*)(lds + M2O_XW); LAS bf16_t* Mi = (LAS bf16_t*)(lds + M2O_M);
    LAS float* DT = (LAS float*)(lds + M2O_DT); LAS float* GC = (LAS float*)(lds + M2O_G); LAS float* GLAST = (LAS float*)(lds + M2O_GL);
    const int t0 = n * 64;
    LAS bf16_t* RAW = (LAS bf16_t*)(lds + M2O_XW);
    for (int idx = tid; idx < 67 * 64; idx += 512) { const int row = idx >> 6, ch = idx & 63, t = t0 - 3 + row; v4u v = {0u, 0u, 0u, 0u};
        const int col = ch < 32 ? gr * 256 + 8 * ch : (ch < 48 ? 512 + gr * 128 + 8 * (ch - 32) : 768 + gr * 128 + 8 * (ch - 48));
        if (t >= 0) v = *(const v4u*)(PROJROW(t) + C_MXBC + col);
        *(LAS v4u*)(RAW + row * 512 + 8 * ch) = v; }
    WG_SYNC();
    for (int it = tid; it < 512 * 4; it += 512) { const int lc = it & 511, seg = it >> 9; int col; LAS bf16_t* dst; int dld;
      if (lc < 256) { col = gr * 256 + lc; dst = Xi + lc; dld = M2_LDX; } else if (lc < 384) { col = 512 + gr * 128 + (lc - 256); dst = Bi + (lc - 256); dld = M2_LDS; } else { col = 768 + gr * 128 + (lc - 384); dst = Ci + (lc - 384); dld = M2_LDS; }
      const float* cw = LP(I_MCONV, 4 * 1024) + col; const float w0 = cw[0], w1 = cw[1024], w2 = cw[2048], w3 = cw[3072], cb = LP(I_MCONVB, 1024)[col];
      const LAS bf16_t* src = RAW + (16 * seg) * 512 + lc;
      float x0 = bf2f(src[0]), x1 = bf2f(src[512]), x2 = bf2f(src[1024]);
#pragma unroll
      for (int cc = 0; cc < 16; ++cc) { const float x3 = bf2f(src[(cc + 3) * 512]); const float y = silu_f(w0 * x0 + w1 * x1 + w2 * x2 + w3 * x3 + cb); dst[(16 * seg + cc) * dld] = (bf16_t)f2bf(y); x0 = x1; x1 = x2; x2 = x3; } }
    if (tid < 256) { const int c = tid >> 2, hh = tid & 3, hd = gr * 4 + hh; const float dt = softplus_f(bf2f(PROJROW(t0 + c)[C_MDT + hd]) + LP(I_MDTB, 8)[hd]); DT[c * 4 + hh] = dt; GC[c * 4 + hh] = -fexp(LP(I_MALOG, 8)[hd]) * dt; }
    WG_SYNC();
    if (tid < 4) { float cu = 0.f; for (int c = 0; c < 64; ++c) { cu += GC[c * 4 + tid]; GC[c * 4 + tid] = cu; } GLAST[tid] = cu; WSF(WS_M2_DEC)[n * 8 + gr * 4 + tid] = fexp(cu); }
    WG_SYNC();
    { const int c = tid >> 3, q = tid & 7;
      const int hh = q >> 1; const float sc = DT[c * 4 + hh] * fexp(GLAST[hh] - GC[c * 4 + hh]);
#pragma unroll
      for (int u = 0; u < 4; ++u) { const v4u xv = *(const LAS v4u*)(Xi + c * M2_LDX + 32 * q + 8 * u); v4u o;
#pragma unroll
          for (int e = 0; e < 4; ++e) o[e] = pk2(__uint_as_float(xv[e] << 16) * sc, __uint_as_float(xv[e] & 0xffff0000u) * sc);
          *(LAS v4u*)(XWi + c * M2_LDX + 32 * q + 8 * u) = o; }
      const float eg = fexp(GC[c * 4 + hh]); bf16_t* QH = (bf16_t*)(a.ws + WS_M2_QH) + (size_t)(n * 8 + gr * 4 + hh) * 8192;
#pragma unroll
      for (int u = 0; u < 8; ++u) { const v4u cv = *(const LAS v4u*)(Ci + c * M2_LDS + 64 * (q & 1) + 8 * u); v4u o;
#pragma unroll
          for (int e = 0; e < 4; ++e) o[e] = pk2(__uint_as_float(cv[e] << 16) * eg, __uint_as_float(cv[e] & 0xffff0000u) * eg);
          { const int s0 = 64 * (q & 1) + 8 * u; *(v4u*)(QH + (((c >> 4) * 4 + (s0 >> 5)) * 64 + ((s0 >> 3) & 3) * 16 + (c & 15)) * 8) = o; } } }
#pragma unroll
    for (int tt = 0; tt < 2; ++tt) { const int tile = 2 * w + tt, im = tile >> 2, jc = tile & 3; f32x4 acc = {0.f, 0.f, 0.f, 0.f};
        if (jc >= im) {
#pragma unroll
            for (int k0 = 0; k0 < 128; k0 += 32) acc = mfma16(frag_row(Bi, M2_LDS, 16 * im, k0, lane), frag_row(Ci, M2_LDS, 16 * jc, k0, lane), acc); }
        const int cq = 16 * jc + r;
#pragma unroll
        for (int hh = 0; hh < 4; ++hh) { f32x4 mv; const float gc = GC[cq * 4 + hh];
#pragma unroll
            for (int e = 0; e < 4; ++e) { const int m = 16 * im + 4 * g + e; mv[e] = cq >= m ? acc[e] * fexp(gc - GC[m * 4 + hh]) * DT[m * 4 + hh] : 0.f; }
            *(LAS u32x2*)(Mi + hh * 64 * 72 + cq * 72 + 16 * im + 4 * g) = pack4(mv); } }
    WG_SYNC();
    { const int hh = w >> 1, hd = gr * 4 + hh; const size_t tk = (size_t)n * 8 + hd; const float Dh = LP(I_MD, 8)[hd];
      bf16_t* YI = (bf16_t*)(a.ws + WS_M2_YI) + tk * 4096; float* Z = WSF(WS_M2_Z) + tk * 8192;
#pragma unroll
      for (int tt = 0; tt < 8; ++tt) { const int tile = (w & 1) * 8 + tt, ip = tile >> 2, jc = tile & 3; f32x4 acc = {0.f, 0.f, 0.f, 0.f};
#pragma unroll
          for (int k0 = 0; k0 < 64; k0 += 32) acc = mfma16(frag_tr(Xi, M2_LDX, 64 * hh + 16 * ip, k0, lane), frag_row(Mi + hh * 64 * 72, 72, 16 * jc, k0, lane), acc);
          const int cq = 16 * jc + r; const f32x4 xv = unpack4(*(const LAS u32x2*)(Xi + cq * M2_LDX + 64 * hh + 16 * ip + 4 * g));
          *(u32x2*)(YI + co_off(jc, 4, ip, lane)) = pack4(acc + xv * Dh); }
#pragma unroll
      for (int tt = 0; tt < 16; ++tt) { const int tile = (w & 1) * 16 + tt, is = tile >> 2, jp = tile & 3; f32x4 acc = {0.f, 0.f, 0.f, 0.f};
#pragma unroll
          for (int k0 = 0; k0 < 64; k0 += 32) acc = mfma16(frag_tr(Bi, M2_LDS, 16 * is, k0, lane), frag_tr(XWi, M2_LDX, 64 * hh + 16 * jp, k0, lane), acc);
          *(f32x4*)(Z + fo_st(jp, 4, 16 * is, g, r)) = acc; } }
    WG_SYNC();
}
__device__ __forceinline__ void m2_stage2(CArgs& a, int b, int tid) {
    const int idx = b * 512 + tid, hd = idx >> 13, rem = idx & 8191;
    const float* Z = WSF(WS_M2_Z) + (size_t)hd * 8192 + rem; bf16_t* S = (bf16_t*)(a.ws + WS_M2_S) + (size_t)hd * 8192 + rem; const float* DEC = WSF(WS_M2_DEC) + hd; float s = 0.f;
#pragma unroll 8
    for (int n = 0; n < NCH; ++n) { const float z = Z[(size_t)n * 8 * 8192], dc = DEC[n * 8]; S[(size_t)n * 8 * 8192] = (bf16_t)f2bf(s); s = dc * s + z; }
}
__device__ __forceinline__ void m2_stage3(CArgs& a, int l, int n, int gr, LAS unsigned char* lds, int tid) {
    const int lane = tid & 63, w = __builtin_amdgcn_readfirstlane(tid >> 6), r = lane & 15, g = lane >> 4, hh = w >> 1, hd = gr * 4 + hh;
    const size_t tk = (size_t)n * 8 + hd;
    const bf16_t* S = (const bf16_t*)(a.ws + WS_M2_S) + tk * 8192; const bf16_t* QH = (const bf16_t*)(a.ws + WS_M2_QH) + tk * 8192; const bf16_t* YI = (const bf16_t*)(a.ws + WS_M2_YI) + tk * 4096;
    LAS float* xs = (LAS float*)lds;
    f32x4 acc[2][4]; float ss[2];
#pragma unroll
    for (int cj = 0; cj < 2; ++cj) { const int jc = 2 * (w & 1) + cj, c = 16 * jc + r, t = n * 64 + c; const bf16_t* pz = PROJROW(t) + C_MZ + hd * 64; ss[cj] = 0.f;
#pragma unroll
        for (int ip = 0; ip < 4; ++ip) { acc[cj][ip] = unpack4(*(const u32x2*)(YI + co_off(jc, 4, ip, lane)));
#pragma unroll
            for (int k = 0; k < 4; ++k) acc[cj][ip] = mfma16(frag_fo(S, 4, ip, k, lane), frag_fo(QH, 4, jc, k, lane), acc[cj][ip]);
            const f32x4 zv = unpack4(*(const u32x2*)(pz + 16 * ip + 4 * g));
#pragma unroll
            for (int e = 0; e < 4; ++e) { acc[cj][ip][e] *= silu_f(zv[e]); ss[cj] += acc[cj][ip][e] * acc[cj][ip][e]; } }
        ss[cj] += __shfl_xor(ss[cj], 16); ss[cj] += __shfl_xor(ss[cj], 32);
        if (g == 0) xs[w * 32 + cj * 16 + r] = ss[cj]; }
    WG_SYNC();
#pragma unroll
    for (int cj = 0; cj < 2; ++cj) { const int jc = 2 * (w & 1) + cj, c = 16 * jc + r, t = n * 64 + c;
        const float tot = xs[((w & 1) + 0) * 32 + cj * 16 + r] + xs[((w & 1) + 2) * 32 + cj * 16 + r] + xs[((w & 1) + 4) * 32 + cj * 16 + r] + xs[((w & 1) + 6) * 32 + cj * 16 + r];
        const float rs = 1.0f / sqrtf(tot * (1.0f / 256.0f) + 1e-6f);
        const float* nw = LP(I_MNORM, 512) + hd * 64; bf16_t* O = (bf16_t*)(a.ws + WS_O) + (size_t)t * D + 1024 + hd * 64;
#pragma unroll
        for (int ip = 0; ip < 4; ++ip) { const f32x4 wv = *(const f32x4*)(nw + 16 * ip + 4 * g); f32x4 y;
#pragma unroll
            for (int e = 0; e < 4; ++e) y[e] = acc[cj][ip][e] * rs * wv[e];
            *(u32x2*)(O + 16 * ip + 4 * g) = pack4(y); } }
    WG_SYNC();
}

constexpr int GD_LD = 136;
constexpr int GDO_K = 0, GDO_V = 17408, GDO_KT = 34816, GDO_QG = 52224, GDO_Q = 69632, GDO_AI = 87040, GDO_AMD = 96256, GDO_DI = 100352, GDO_AQ = 104448, GDO_XI = 113664, GDO_QF = 87040, GDO_KF = 119808, GDO_SM = 152576, GDO_UI = 153600;
__device__ __forceinline__ void gd_stage1(CArgs& a, int l, int n, int h, LAS unsigned char* lds, int tid) {
    const int w = __builtin_amdgcn_readfirstlane(tid >> 6), tk = n * 4 + h, t0 = n * 64;
    int lane, r, g, c, q8;
#define GD_IDX() do { int tl_ = tid; asm volatile("" : "+v"(tl_)); lane = tl_ & 63; r = lane & 15; g = lane >> 4; c = tl_ >> 3; q8 = tl_ & 7; } while (0)
    LAS bf16_t* Ki = (LAS bf16_t*)(lds + GDO_K); LAS bf16_t* Vi = (LAS bf16_t*)(lds + GDO_V); LAS bf16_t* KTi = (LAS bf16_t*)(lds + GDO_KT); LAS bf16_t* QGi = (LAS bf16_t*)(lds + GDO_QG); LAS bf16_t* Qi = (LAS bf16_t*)(lds + GDO_Q);
    LAS bf16_t* AI = (LAS bf16_t*)(lds + GDO_AI);
    LAS float* AMD = (LAS float*)(lds + GDO_AMD);
    LAS bf16_t* DI = (LAS bf16_t*)(lds + GDO_DI);
    LAS bf16_t* AQ = (LAS bf16_t*)(lds + GDO_AQ);
    LAS bf16_t* XI = (LAS bf16_t*)(lds + GDO_XI);
    LAS bf16_t* UI = (LAS bf16_t*)(lds + GDO_UI);
    LAS float* QF = (LAS float*)(lds + GDO_QF); LAS float* KF = (LAS float*)(lds + GDO_KF);
    LAS float* BETA = (LAS float*)(lds + GDO_SM); LAS float* GC = BETA + 64; LAS float* BG = GC + 64;
    LAS bf16_t* RAW = (LAS bf16_t*)(lds + GDO_KT);
    for (int idx = tid; idx < 67 * 48; idx += 512) { const int row = idx / 48, ch = idx % 48, which = ch >> 4, t = t0 - 3 + row; v4u v = {0u, 0u, 0u, 0u};
        if (t >= 0) v = *(const v4u*)(PROJROW(t) + C_GQ + which * 512 + h * 128 + 8 * (ch & 15));
        *(LAS v4u*)(RAW + row * 384 + 8 * ch) = v; }
    WG_SYNC();
    for (int it = tid; it < 384 * 4; it += 512) { const int col = it % 384, seg = it / 384, which = col >> 7, dcol = col & 127, cwi = which * 512 + h * 128 + dcol;
        const float* cw = LP(I_GCONV, 4 * 1536) + cwi; const float w0 = cw[0], w1 = cw[1536], w2 = cw[3072], w3 = cw[4608];
        const LAS bf16_t* src = RAW + (16 * seg) * 384 + col;
        float x0 = bf2f(src[0]), x1 = bf2f(src[384]), x2 = bf2f(src[768]);
#pragma unroll
        for (int cc = 0; cc < 16; ++cc) { const float x3 = bf2f(src[(cc + 3) * 384]); const float y = silu_f(w0 * x0 + w1 * x1 + w2 * x2 + w3 * x3); const int tok = 16 * seg + cc;
            if (which == 2) Vi[tok * GD_LD + dcol] = (bf16_t)f2bf(y); else (which == 0 ? QF : KF)[tok * 128 + dcol] = y;
            x0 = x1; x1 = x2; x2 = x3; } }
    if (tid >= 384 && tid < 448) { const int cc = tid - 384; const bf16_t* pr = PROJROW(t0 + cc);
        const float beta = sigmoid_f(bf2f(pr[C_GB + h])); float cu = -fexp(LP(I_GALOG, 4)[h]) * softplus_f(bf2f(pr[C_GA + h]) + LP(I_GDTB, 4)[h]);
#pragma unroll
        for (int o = 1; o < 64; o <<= 1) { const float up = __shfl_up(cu, o); if (cc >= o) cu += up; }
        BETA[cc] = beta; GC[cc] = cu; BG[cc] = beta * fexp(cu); }
    WG_SYNC();
    GD_IDX();
    { float qv[16], kv[16]; float sq = 0.f, sk = 0.f;
#pragma unroll
      for (int u = 0; u < 4; ++u) { const f32x4 a4 = *(const LAS f32x4*)(QF + c * 128 + 16 * q8 + 4 * u), b4 = *(const LAS f32x4*)(KF + c * 128 + 16 * q8 + 4 * u);
#pragma unroll
          for (int e = 0; e < 4; ++e) { qv[4 * u + e] = a4[e]; kv[4 * u + e] = b4[e]; sq += a4[e] * a4[e]; sk += b4[e] * b4[e]; } }
      sq += __shfl_xor(sq, 1); sq += __shfl_xor(sq, 2); sq += __shfl_xor(sq, 4); sk += __shfl_xor(sk, 1); sk += __shfl_xor(sk, 2); sk += __shfl_xor(sk, 4);
      const float gc = GC[c], iq = (1.0f / sqrtf(sq + 1e-6f)) * 0.08838834764831845f, ik = 1.0f / sqrtf(sk + 1e-6f), et = fexp(GC[63] - gc), eg = fexp(gc);
      v4u oK[2], oQ[2], oKT[2], oQG[2];
#pragma unroll
      for (int u = 0; u < 8; ++u) { const float k0 = kv[2 * u] * ik, k1 = kv[2 * u + 1] * ik, q0 = qv[2 * u] * iq, q1 = qv[2 * u + 1] * iq;
          oK[u >> 2][u & 3] = pk2(k0, k1); oQ[u >> 2][u & 3] = pk2(q0, q1); oKT[u >> 2][u & 3] = pk2(k0 * et, k1 * et); oQG[u >> 2][u & 3] = pk2(q0 * eg, q1 * eg); }
      const int o = c * GD_LD + 16 * q8;
      *(LAS v4u*)(Ki + o) = oK[0]; *(LAS v4u*)(Ki + o + 8) = oK[1]; *(LAS v4u*)(Qi + o) = oQ[0]; *(LAS v4u*)(Qi + o + 8) = oQ[1];
      *(LAS v4u*)(KTi + o) = oKT[0]; *(LAS v4u*)(KTi + o + 8) = oKT[1]; *(LAS v4u*)(QGi + o) = oQG[0]; *(LAS v4u*)(QGi + o + 8) = oQG[1]; }
    WG_SYNC();
    GD_IDX();
#pragma unroll
    for (int tt = 0; tt < 2; ++tt) { const int tile = 2 * w + tt, im = tile >> 2, jc = tile & 3; f32x4 c1 = {0.f, 0.f, 0.f, 0.f}, c2 = c1;
        if (jc >= im) {
#pragma unroll
            for (int k0 = 0; k0 < 128; k0 += 32) { const bf16x8 fa = frag_row(Ki, GD_LD, 16 * im, k0, lane); c1 = mfma16(fa, frag_row(Ki, GD_LD, 16 * jc, k0, lane), c1); c2 = mfma16(fa, frag_row(Qi, GD_LD, 16 * jc, k0, lane), c2); }
            const int cq = 16 * jc + r; const float gc = GC[cq], bc = BETA[cq];
#pragma unroll
            for (int e = 0; e < 4; ++e) { const int m = 16 * im + 4 * g + e; const float dc = fexp(gc - GC[m]); c1[e] = m < cq ? c1[e] * dc * bc : 0.f; c2[e] = m <= cq ? c2[e] * dc : 0.f; } }
        const int cq = 16 * jc + r; *(LAS u32x2*)(AI + cq * 72 + 16 * im + 4 * g) = pack4(-c1); *(LAS u32x2*)(AQ + cq * 72 + 16 * im + 4 * g) = pack4(c2);
        if (im == jc) *(LAS f32x4*)(AMD + (im * 16 + r) * 16 + 4 * g) = c1; }
    WG_SYNC();
    GD_IDX();
    { const int q = c * 8 + q8;
      if (q < 64) { const int b = q >> 4, j = q & 15; float d[16];
#pragma unroll
          for (int tq = 0; tq < 16; ++tq) { float acc = tq == j ? 1.f : 0.f;
#pragma unroll
              for (int i = 0; i < tq; ++i) acc -= AMD[(b * 16 + tq) * 16 + i] * d[i];
              d[tq] = acc; DI[(b * 16 + tq) * 32 + j] = (bf16_t)f2bf(acc); DI[(b * 16 + tq) * 32 + 16 + j] = (bf16_t)0; } }
      for (int i = q; i < 256 * 72 / 8; i += 512) *(LAS v4u*)(XI + 8 * i) = (v4u){0u, 0u, 0u, 0u};
      *(LAS v4u*)(UI + w * 512 + lane * 8) = (v4u){0u, 0u, 0u, 0u}; }
    WG_SYNC();
    GD_IDX();
    { LAS bf16_t* Uw = UI + w * 512;
#pragma unroll
      for (int tt = 0; tt < 2; ++tt) { const int nt = 2 * w + tt; LAS bf16_t* Xw = XI + (16 * nt) * 72;
          const LAS bf16_t* src = nt < 8 ? Vi + 16 * nt + r : Ki + 16 * (nt - 8) + r; const LAS float* scl = nt < 8 ? BETA : BG;
#pragma unroll
          for (int b = 0; b < 4; ++b) { const f32x4 sc = *(const LAS f32x4*)(scl + 16 * b + 4 * g); f32x4 acc;
#pragma unroll
              for (int e = 0; e < 4; ++e) acc[e] = bf2f(src[(16 * b + 4 * g + e) * GD_LD]) * sc[e];
#pragma unroll
              for (int k0 = 0; k0 < 16 * b; k0 += 32) acc = mfma16(frag_row(AI, 72, 16 * b, k0, lane), frag_row(Xw, 72, 0, k0, lane), acc);
              *(LAS u32x2*)(Uw + r * 32 + 4 * g) = pack4(acc);
              asm volatile("s_waitcnt lgkmcnt(0)" ::: "memory");
              f32x4 x = {0.f, 0.f, 0.f, 0.f}; x = mfma16(frag_row(DI + b * 512, 32, 0, 0, lane), frag_row(Uw, 32, 0, 0, lane), x);
              *(LAS u32x2*)(Xw + r * 72 + 16 * b + 4 * g) = pack4(x);
              asm volatile("s_waitcnt lgkmcnt(0)" ::: "memory"); } } }
    WG_SYNC();
    GD_IDX();
    { const int jc = w & 3, wh = w >> 2; const int cq = 16 * jc + r;
      bf16_t* QT = (bf16_t*)(a.ws + WS_GD_QT) + (size_t)tk * 8192; bf16_t* YI = (bf16_t*)(a.ws + WS_GD_YI) + (size_t)tk * 8192; bf16_t* GG = (bf16_t*)(a.ws + WS_GD_G) + (size_t)tk * 16384; float* Z = WSF(WS_GD_Z) + (size_t)tk * 16384;
#pragma unroll
      for (int tt = 0; tt < 4; ++tt) { const int id = 4 * wh + tt; f32x4 c1 = {0.f, 0.f, 0.f, 0.f}, c2 = c1;
#pragma unroll
          for (int k0 = 0; k0 < 64; k0 += 32) { const bf16x8 fb = frag_row(AQ, 72, 16 * jc, k0, lane); c1 = mfma16(frag_row(XI + 128 * 72, 72, 16 * id, k0, lane), fb, c1); c2 = mfma16(frag_row(XI, 72, 16 * id, k0, lane), fb, c2); }
          const f32x4 qg = unpack4(*(const LAS u32x2*)(QGi + cq * GD_LD + 16 * id + 4 * g));
          *(u32x2*)(QT + fo_st(jc, 4, 16 * id, g, r)) = pack4(qg - c1); *(u32x2*)(YI + co_off(jc, 8, id, lane)) = pack4(c2); }
      const float e63 = fexp(GC[63]);
#pragma unroll
      for (int ti = 0; ti < 8; ++ti) { f32x4 c1 = {0.f, 0.f, 0.f, 0.f}, c2 = c1;
#pragma unroll
          for (int k0 = 0; k0 < 64; k0 += 32) { c1 = mfma16(frag_row(XI + 128 * 72, 72, 16 * ti, k0, lane), frag_tr(KTi, GD_LD, 16 * w, k0, lane), c1); c2 = mfma16(frag_tr(KTi, GD_LD, 16 * ti, k0, lane), frag_row(XI, 72, 16 * w, k0, lane), c2); }
          const int dq = 16 * w + r; f32x4 gv;
#pragma unroll
          for (int e = 0; e < 4; ++e) gv[e] = ((16 * ti + 4 * g + e) == dq ? e63 : 0.f) - c1[e];
          *(u32x2*)(GG + fo_st(w, 4, 16 * ti, g, r)) = pack4(gv); *(f32x4*)(Z + co_off(w, 8, ti, lane)) = c2; } }
    WG_SYNC();
#undef GD_IDX
}
__device__ __forceinline__ void gd_stage2(CArgs& a, int h, int es, LAS unsigned char* lds, int tid, const int var = 0) {
    const int lane = tid & 63, w = __builtin_amdgcn_readfirstlane(tid >> 6), r = lane & 15, g = lane >> 4;
    LAS bf16_t* Si = (LAS bf16_t*)lds;
    const bf16_t* G = (const bf16_t*)(a.ws + WS_GD_G); const float* Z = WSF(WS_GD_Z); bf16_t* S = (bf16_t*)(a.ws + WS_GD_S);
    const int so = fo_st(es, 4, 16 * w, g, r), zo = co_off(es, 8, w, lane);
    *(LAS u32x2*)(Si + r * GD_LD + 16 * w + 4 * g) = (u32x2){0u, 0u}; *(u32x2*)(S + (size_t)h * 16384 + so) = (u32x2){0u, 0u};
    WG_SYNC();
    constexpr int PD = 8;
    bf16x8 gf[PD][4]; f32x4 zf[PD];
#pragma unroll
    for (int u = 0; u < PD; ++u) { const size_t tk = (size_t)u * 4 + h; zf[u] = *(const f32x4*)(Z + tk * 16384 + zo);
#pragma unroll
        for (int k = 0; k < 4; ++k) gf[u][k] = frag_fo(G + tk * 16384, 4, w, k, lane); }
#define GD_STEP(n_, u_, REFILL) do { const int n = (n_); const size_t tk = (size_t)n * 4 + h; const int cur = n & 1; \
            f32x4 acc = zf[u_], acc2 = {0.f, 0.f, 0.f, 0.f}; \
            acc = mfma16(gf[u_][0], frag_row(Si + cur * 16 * GD_LD, GD_LD, 0, 0, lane), acc); acc2 = mfma16(gf[u_][1], frag_row(Si + cur * 16 * GD_LD, GD_LD, 0, 32, lane), acc2); \
            acc = mfma16(gf[u_][2], frag_row(Si + cur * 16 * GD_LD, GD_LD, 0, 64, lane), acc); acc2 = mfma16(gf[u_][3], frag_row(Si + cur * 16 * GD_LD, GD_LD, 0, 96, lane), acc2); \
            if (REFILL && !(var & 2)) { const int nn = n + PD < NCH - 1 ? n + PD : NCH - 2; const size_t tn = (size_t)nn * 4 + h; zf[u_] = *(const f32x4*)(Z + tn * 16384 + zo); \
                _Pragma("unroll") for (int k = 0; k < 4; ++k) gf[u_][k] = frag_fo(G + tn * 16384, 4, w, k, lane); } \
            const u32x2 pv = pack4(acc + acc2); \
            if (!(var & 4)) *(LAS u32x2*)(Si + (cur ^ 1) * 16 * GD_LD + r * GD_LD + 16 * w + 4 * g) = pv; if (!(var & 1)) *(u32x2*)(S + (tk + 4) * 16384 + so) = pv; \
            if (!(var & 4)) { asm volatile("s_waitcnt lgkmcnt(0)" ::: "memory"); __builtin_amdgcn_s_barrier(); } asm volatile("" ::: "memory"); } while (0)
#pragma unroll
    for (int nq = 0; nq < NCH - 1; ++nq) GD_STEP(nq, nq % PD, nq + PD < NCH - 1);
#undef GD_STEP
}
__device__ __forceinline__ void gd_stage3(CArgs& a, int l, int n, int h, LAS unsigned char* lds, int tid) {
    const int lane = tid & 63, w = __builtin_amdgcn_readfirstlane(tid >> 6), r = lane & 15, g = lane >> 4, jc = w & 3, wh = w >> 2;
    const size_t tk = (size_t)n * 4 + h; const int c = 16 * jc + r, t = n * 64 + c;
    const bf16_t* S = (const bf16_t*)(a.ws + WS_GD_S) + tk * 16384; const bf16_t* QT = (const bf16_t*)(a.ws + WS_GD_QT) + tk * 8192; const bf16_t* YI = (const bf16_t*)(a.ws + WS_GD_YI) + tk * 8192;
    LAS float* xs = (LAS float*)lds;
    f32x4 acc[4]; float ss = 0.f;
#pragma unroll
    for (int tt = 0; tt < 4; ++tt) { const int ie = 4 * wh + tt; acc[tt] = unpack4(*(const u32x2*)(YI + co_off(jc, 8, ie, lane)));
#pragma unroll
        for (int k = 0; k < 4; ++k) acc[tt] = mfma16(frag_fo(S, 4, ie, k, lane), frag_fo(QT, 4, jc, k, lane), acc[tt]);
#pragma unroll
        for (int e = 0; e < 4; ++e) ss += acc[tt][e] * acc[tt][e]; }
    ss += __shfl_xor(ss, 16); ss += __shfl_xor(ss, 32);
    if (g == 0) xs[w * 16 + r] = ss;
    WG_SYNC();
    const float rs = 1.0f / sqrtf((ss + xs[(w ^ 4) * 16 + r]) * (1.0f / 128.0f) + 1e-6f);
    const float* nw = LP(I_GNORM, 128); const bf16_t* pz = PROJROW(t) + C_GZ + h * 128; bf16_t* O = (bf16_t*)(a.ws + WS_O) + (size_t)t * D + h * 128;
#pragma unroll
    for (int tt = 0; tt < 4; ++tt) { const int e0 = 16 * (4 * wh + tt) + 4 * g; const f32x4 zv = unpack4(*(const u32x2*)(pz + e0)), wv = *(const f32x4*)(nw + e0); f32x4 y;
#pragma unroll
        for (int e = 0; e < 4; ++e) y[e] = acc[tt][e] * rs * wv[e] * silu_f(zv[e]);
        *(u32x2*)(O + e0) = pack4(y); }
    WG_SYNC();
}

#define XB_TMO      128
#define XB_XCNT(j)  (256  + 64 * (j))
#define XB_XSUB(j)  (1280 + 64 * (j))
#define XB_XGEN(j)  (2304 + 64 * (j))
#define XB_TOP      3328
#define XB_TOPGEN   3392
#define XCD_BAR_WORDS 3456
#define XB_SPIN_CAP (1u << 20)
__device__ __forceinline__ unsigned xb_ld(unsigned* p)              { return __hip_atomic_load(p, __ATOMIC_RELAXED, __HIP_MEMORY_SCOPE_AGENT); }
__device__ __forceinline__ unsigned xb_add(unsigned* p, unsigned v) { return __hip_atomic_fetch_add(p, v, __ATOMIC_RELAXED, __HIP_MEMORY_SCOPE_AGENT); }
__device__ __forceinline__ unsigned xb_xcc_id() { return (unsigned)__builtin_amdgcn_s_getreg((3 << 11) | 20) & 0xFu; }
#define XB_SPIN(cond, bar) do { unsigned _sp = 0; while (cond) { __builtin_amdgcn_s_sleep(1); \
    if ((++_sp & 255u) == 0u) { if (xb_ld(&(bar)[XB_TMO])) break; if (_sp > XB_SPIN_CAP) { atomicAdd(&(bar)[XB_TMO], 1u); break; } } } } while (0)
struct XcdBarrier { unsigned* bar; unsigned x; volatile LAS unsigned* st; };
__device__ __forceinline__ XcdBarrier xcd_barrier_post(unsigned* bar, volatile LAS unsigned* st) {
    XcdBarrier b; b.bar = bar; b.x = xb_xcc_id(); b.st = st;
    if (threadIdx.x == 0) (void)xb_add(&bar[XB_XCNT(b.x)], 1u);
    return b;
}
__device__ __forceinline__ void xcd_barrier_complete(unsigned* bar, unsigned x, unsigned& nloc, unsigned& nx) {
    const unsigned G = gridDim.x * gridDim.y * gridDim.z;
    unsigned sum, cnt, mine, sp = 0u;
    for (;;) {
        sum = 0u; cnt = 0u; mine = 0u;
#pragma unroll
        for (unsigned j = 0; j < 16; ++j) { const unsigned c = xb_ld(&bar[XB_XCNT(j)]); sum += c; cnt += (c > 0u) ? 1u : 0u; mine = (j == x) ? c : mine; }
        if (sum == G) break;
        __builtin_amdgcn_s_sleep(1);
        if ((++sp & 255u) == 0u) { if (xb_ld(&bar[XB_TMO])) break; if (sp > XB_SPIN_CAP) { atomicAdd(&bar[XB_TMO], 1u); break; } }
    }
    nloc = mine > 0u ? mine : 1u; nx = cnt > 0u ? cnt : 1u;
}
__device__ __forceinline__ void xcd_barrier(const XcdBarrier& b) {
    asm volatile("s_waitcnt vmcnt(0)" ::: "memory");
    __syncthreads();
    if (threadIdx.x == 0) {
        unsigned* bar = b.bar;
        __builtin_amdgcn_s_waitcnt(0);
        unsigned nloc = b.st[0], nx = b.st[1];
        if (nloc == 0u) { xcd_barrier_complete(bar, b.x, nloc, nx); b.st[0] = nloc; b.st[1] = nx; }
        const unsigned old = xb_add(&bar[XB_XSUB(b.x)], 1u);
        const unsigned gen = old / nloc;
        if (old + 1u == (gen + 1u) * nloc) {
            __builtin_amdgcn_fence(__ATOMIC_RELEASE, "agent");
            asm volatile("s_waitcnt vmcnt(0)" ::: "memory");
            const unsigned og = xb_add(&bar[XB_TOP], 1u);
            const unsigned tg = og / nx;
            if (og + 1u == (tg + 1u) * nx) xb_add(&bar[XB_TOPGEN], 1u);
            else XB_SPIN(xb_ld(&bar[XB_TOPGEN]) == tg, bar);
            __builtin_amdgcn_fence(__ATOMIC_ACQUIRE, "agent");
            xb_add(&bar[XB_XGEN(b.x)], 1u);
            asm volatile("s_waitcnt vmcnt(0)" ::: "memory");
        } else {
            XB_SPIN(xb_ld(&bar[XB_XGEN(b.x)]) == gen, bar);
            __builtin_amdgcn_fence(__ATOMIC_ACQUIRE, "agent");
            asm volatile("s_waitcnt vmcnt(0)" ::: "memory");
        }
    }
    __syncthreads();
}

constexpr int CV_IN = (D / 64) * (PTP / 32), CV_OUT = (D / 64) * (D / 32), CV_UP = (D / 64) * (FF / 32), CV_DN = (FF / 64) * (D / 32), CV_ALL = CV_IN + CV_OUT + CV_UP + CV_DN;
__device__ __forceinline__ void cvt_items(CArgs& a, int l, int lo, int hi, int gwv, int ngwv, LAS float* scr, int lane) {
#pragma unroll 1
    for (int it = lo + gwv; it < hi; it += ngwv) {
        int r = it;
        if (r < CV_IN) { transpose_item(LP(I_WIN, (size_t)D * PT), D, PT, PTP, (bf16_t*)(a.ws + WS_WIN), scr, r, lane); continue; } r -= CV_IN;
        if (r < CV_OUT) { transpose_item(LP(I_WOUT, (size_t)D * D), D, D, D, (bf16_t*)(a.ws + WS_WOUT), scr, r, lane); continue; } r -= CV_OUT;
        if (r < CV_UP) { transpose_item(LP(I_WUP, (size_t)D * FF), D, FF, FF, (bf16_t*)(a.ws + WS_WUP), scr, r, lane); continue; } r -= CV_UP;
        transpose_item(LP(I_WDN, (size_t)FF * D), FF, D, D, (bf16_t*)(a.ws + WS_WDN), scr, r, lane);
    }
}

constexpr int CW_SUB = 8192;
__device__ __forceinline__ void cnt_arrive(unsigned* cnt) {
    asm volatile("s_waitcnt vmcnt(0)" ::: "memory"); __syncthreads();
    if (threadIdx.x == 0) { __builtin_amdgcn_fence(__ATOMIC_RELEASE, "agent"); asm volatile("s_waitcnt vmcnt(0)" ::: "memory"); (void)xb_add(cnt, 1u); }
}
__device__ __forceinline__ void cnt_wait(unsigned* cnt, unsigned want, unsigned* tmo) {
    if (threadIdx.x == 0) { unsigned sp = 0; while (xb_ld(cnt) < want) { __builtin_amdgcn_s_sleep(2); if ((++sp & 255u) == 0u) { if (xb_ld(tmo)) break; if (sp > XB_SPIN_CAP) { atomicAdd(tmo, 1u); break; } } }
        __builtin_amdgcn_fence(__ATOMIC_ACQUIRE, "agent"); asm volatile("s_waitcnt vmcnt(0)" ::: "memory"); }
    __syncthreads();
}

constexpr int N_PHASES = 1 + 9 * NL;

__device__ __forceinline__ void run_phase(CArgs& a, int ph, LAS unsigned char* lds, const int tid, const int bid, const int mask = 15) {
    const int lane = tid & 63, wave = __builtin_amdgcn_readfirstlane(tid >> 6);
    const int G = gridDim.x, gw = bid * NWAVES + wave, NGW = G * NWAVES;
    float* SSb = (float*)(a.ws + WS_SS);
    if (ph == N_PHASES - 1) {
        for (int t = gw; t < T; t += NGW) final_row(HRES + (size_t)t * D, a.in[I_NF], SSb[2 * NL * T + t], lane);
        return;
    }
    const int l = ph / 9, sp = ph % 9;
    const float* hin = l == 0 ? a.in[I_X] : (const float*)HRES;
    switch (sp) {
    case 0: {
        if (mask & 1) cvt_items(a, l, 0, CV_IN, gw, NGW, (LAS float*)(lds + wave * 16384), lane);
        if (mask & 2) for (int t = gw; t < T; t += NGW) xn_row(hin + (size_t)t * D, LP(I_N1, D), (bf16_t*)(a.ws + WS_XN) + (size_t)t * D, SSb + t, lane);
    } break;
    case 1: { pg8::Gemm g{(const bf16_t*)(a.ws + WS_XN), (const bf16_t*)(a.ws + WS_WIN)}; pg8::StaticOrder<T, PTP> S; S.init(G, bid);
              pg8::EpiBf16<false> E{(bf16_t*)(a.ws + WS_PROJ), PTP, SSb + l * T}; pg8::gemm_phase<D, pg8::EpiBf16<false>, pg8::StaticOrder<T, PTP>, true>(lds, g, S, E, tid);
              constexpr int NFULL = (T / 256) * (PTP / 256) % 256; if (bid >= NFULL) cvt_items(a, l, CV_IN, CV_IN + CV_OUT + CV_UP, (bid - NFULL) * NWAVES + wave, (G - NFULL) * NWAVES, (LAS float*)(lds + wave * 16384), lane); } break;
    case 2: {
#pragma unroll 1
              for (int it = bid; (mask & 1) && it < NCH * 4; it += G) gd_stage1(a, l, it >> 2, it & 3, lds, tid);
#pragma unroll 1
              for (int it = bid; (mask & 4) && it < NCH * 8; it += G) rw_stage1(a, l, it >> 3, it & 7, lds, tid, mask >> 8 ? (mask >> 8) - 1 : 99);
#pragma unroll 1
              for (int it = bid; (mask & 8) && it < NCH * 2; it += G) m2_stage1(a, l, it >> 1, it & 1, lds, tid);
#pragma unroll 1
              for (int it = bid; (mask & 2) && it < NCH * 4; it += G) ret_stage1(a, it >> 2, it & 3, lds, tid); } break;
    case 3: { const int b = bid;
              unsigned* ctl = (unsigned*)(a.ws + WS_CTL); unsigned* sub = ctl + CW_SUB + 128 * l; unsigned* ddone = sub + 64;
              if (b < 64) { const int x = b & 7, j = b >> 3;
                  if (x < 4) { if (mask & 1) gd_stage2(a, x, j, lds, tid, mask >> 8); }
                  else { if (mask & 4) rw_stage2(a, (x - 4) * 2 + (j >> 2), j & 3, lds, tid); if (mask == 15) cnt_arrive(ddone); } }
              else { if (b < 128) { if (mask & 2) ret_stage2(a, b - 64, tid); } else if (mask & 8) m2_stage2(a, b - 128, tid);
                  if (mask == 15) { const int hb = b - 64, NH = G - 64;
                      cnt_arrive(sub); cnt_wait(sub, (unsigned)NH, ctl + XB_TMO);
#pragma unroll 1
                      for (int it = hb; it < NCH * 4; it += NH) ret_stage3(a, l, it >> 2, it & 3, lds, tid);
#pragma unroll 1
                      for (int it = hb; it < NCH * 2; it += NH) m2_stage3(a, l, it >> 1, it & 1, lds, tid);
                      const int gwv = hb * NWAVES + wave, ngwv = NH * NWAVES; LAS float* scr = (LAS float*)(lds + wave * 16384);
                      cvt_items(a, l, CV_IN + CV_OUT + CV_UP, CV_ALL, gwv, ngwv, scr, lane);
                      if (l + 1 < NL) cvt_items(a, l + 1, 0, CV_IN, gwv, ngwv, scr, lane);
                      __syncthreads();
                      cnt_wait(ddone, 32u, ctl + XB_TMO);
#pragma unroll 1
                      for (int it = hb; it < NCH * 8; it += NH) rw_stage3(a, l, it >> 3, it & 7, lds, tid); } } } break;
    case 4:
#pragma unroll 1
            for (int it = bid; (mask & 1) && it < NCH * 4; it += G) gd_stage3(a, l, it >> 2, it & 3, lds, tid);
            break;
    case 5: { pg8::Gemm g{(const bf16_t*)(a.ws + WS_O), (const bf16_t*)(a.ws + WS_WOUT)}; pg8::StaticOrder<T, D> S; S.init(G, bid);
              pg8::EpiAddRes E{hin, HRES, D, (bf16_t*)(a.ws + WS_XN2), LP(I_N2, D), SSb + (NL + l) * T}; pg8::gemm_phase<D, pg8::EpiAddRes, pg8::StaticOrder<T, D>, false>(lds, g, S, E, tid); } break;
    case 6: break;
    case 7: { pg8::Gemm g{(const bf16_t*)(a.ws + WS_XN2), (const bf16_t*)(a.ws + WS_WUP)}; pg8::StaticOrder<T, FF> S; S.init(G, bid);
              pg8::EpiBf16<true> E{(bf16_t*)(a.ws + WS_HID), FF, SSb + (NL + l) * T}; pg8::gemm_phase<D, pg8::EpiBf16<true>, pg8::StaticOrder<T, FF>, true>(lds, g, S, E, tid); } break;
    case 8: { pg8::Gemm g{(const bf16_t*)(a.ws + WS_HID), (const bf16_t*)(a.ws + WS_WDN)}; pg8::StaticOrder<T, D> S; S.init(G, bid);
              pg8::EpiAddRes E{HRES, HRES, D, (bf16_t*)(a.ws + WS_XN), l + 1 < NL ? a.in[I_N1] + (size_t)(l + 1) * D : a.in[I_NF], SSb + (l + 1 < NL ? (l + 1) : 2 * NL) * T}; pg8::gemm_phase<FF, pg8::EpiAddRes, pg8::StaticOrder<T, D>, false>(lds, g, S, E, tid); } break;
    }
}

__global__ void __launch_bounds__(NWAVES * 64, 2) fwd_kernel(Args a) {
    extern __shared__ __attribute__((aligned(16))) unsigned char lds_raw[];
    LAS unsigned char* lds = (LAS unsigned char*)lds_raw;
    const int ph_lo = a.ph_lo, ph_hi = a.ph_hi;
    volatile LAS unsigned* MISC = (volatile LAS unsigned*)(lds + MISC_OFF);
    if (threadIdx.x < 64) MISC[threadIdx.x] = 0u;
    __syncthreads();
    const XcdBarrier bar = xcd_barrier_post((unsigned*)(a.ws + WS_CTL), MISC + 8);
    for (int ph = ph_lo; ph < ph_hi; ++ph) {
        if (ph != N_PHASES - 1 && (ph % 9 == 6 || (ph % 9 == 0 && ph > 0))) continue;
        CArgs* ap = (CArgs*)__builtin_amdgcn_kernarg_segment_ptr();
        asm volatile("" : "+s"(ap));
        int tid = threadIdx.x, bid = blockIdx.x;
        asm volatile("" : "+v"(tid)); asm volatile("" : "+s"(bid));
        run_phase(*ap, ph, lds, tid, bid);
#ifdef DUP_PHASE
#ifndef DUP_MASK
#define DUP_MASK 15
#endif
        if (ph == DUP_PHASE) { xcd_barrier(bar); asm volatile("" : "+s"(ap)); asm volatile("" : "+v"(tid)); asm volatile("" : "+s"(bid)); run_phase(*ap, ph, lds, tid, bid, DUP_MASK); }
#endif
        if (ph + 1 < ph_hi) xcd_barrier(bar);
    }
}

extern "C" void kernel_launch(void* const* d_in, const int* in_sizes, int n_in, void* d_out, int out_size, void* d_ws, size_t ws_size, hipStream_t stream) {
    static int grid = 0;
    if (grid == 0) {
        if (n_in != N_IN || in_sizes[0] != T * D || out_size != T * D || ws_size < WS_END) {
            fprintf(stderr, "kernel_launch: shape/workspace mismatch: n_in %d in0 %d out %d ws %zu (need %zu); nothing launched\n", n_in, n_in > 0 ? in_sizes[0] : -1, out_size, ws_size, (size_t)WS_END); grid = -1; return; }
        int dev = 0, cus = 0, per_cu = 0;
        if (hipGetDevice(&dev) != hipSuccess || hipDeviceGetAttribute(&cus, hipDeviceAttributeMultiprocessorCount, dev) != hipSuccess) { grid = -1; return; }
        if (hipFuncSetAttribute((const void*)fwd_kernel, hipFuncAttributeMaxDynamicSharedMemorySize, LDS_BYTES) != hipSuccess) { fprintf(stderr, "kernel_launch: hipFuncSetAttribute failed\n"); grid = -1; return; }
        if (hipOccupancyMaxActiveBlocksPerMultiprocessor(&per_cu, (const void*)fwd_kernel, NWAVES * 64, LDS_BYTES) != hipSuccess || per_cu < 1) { fprintf(stderr, "kernel_launch: occupancy query says %d blocks per CU\n", per_cu); per_cu = 1; }
        (void)hipGetLastError();
        grid = cus;
    }
    if (grid < 0) return;
    Args a{};
    for (int i = 0; i < N_IN; ++i) a.in[i] = (const float*)d_in[i];
    a.out = (float*)d_out; a.ws = (unsigned char*)d_ws;
#if N_LAUNCH_MODE == 1
    a.ph_lo = 0; a.ph_hi = N_PHASES;
    (void)hipMemsetAsync((char*)d_ws + WS_CTL, 0, CTL_ZERO_BYTES, stream);
    hipLaunchKernelGGL(fwd_kernel, dim3(grid), dim3(NWAVES * 64), LDS_BYTES, stream, a);
#else
#ifndef DBG_MAXPH
#define DBG_MAXPH N_PHASES
#endif
    for (int ph = 0; ph < N_PHASES; ++ph) {
        if (ph >= DBG_MAXPH && ph != N_PHASES - 1) continue;
#ifdef DBG_SKIP_FINAL
        if (ph == N_PHASES - 1) continue;
#endif
        (void)hipMemsetAsync((char*)d_ws + WS_CTL, 0, CTL_ZERO_BYTES, stream);
        a.ph_lo = ph; a.ph_hi = ph + 1;
        hipLaunchKernelGGL(fwd_kernel, dim3(grid), dim3(NWAVES * 64), LDS_BYTES, stream, a);
    }
#endif
}
#endif
```

```cpp
#ifndef HOST_TEST
#include <hip/hip_runtime.h>
#endif
#include <cstdio>
#include <cstdint>
#include <cmath>
#include <cstddef>

#ifndef SEQ_T
#define SEQ_T 8192
#endif
#ifndef N_LAUNCH_MODE
#define N_LAUNCH_MODE 1
#endif

constexpr int T = SEQ_T, D = 2048, NL = 2, FF = 8192, PT = 6832, PTP = 6912;
constexpr int C_GQ = 0, C_GK = 512, C_GV = 1024, C_GZ = 1536, C_GB = 2048, C_GA = 2052;
constexpr int C_RQ = 2056, C_RK = 2312, C_RV = 2568, C_RG = 3080;
constexpr int C_MZ = 3592, C_MXBC = 4104, C_MDT = 5128;
constexpr int C_RW = 5136;
enum { I_X = 0, I_N1, I_WIN, I_GCONV, I_GALOG, I_GDTB, I_GNORM, I_RNORM, I_MCONV, I_MCONVB, I_MALOG, I_MDTB, I_MD, I_MNORM, I_RWMU, I_RWW0, I_RWWUP, I_RWA0, I_RWAUP,
       I_RWGUP, I_RWKK, I_RWKA, I_RWRK, I_RWLNW, I_RWLNB, I_WOUT, I_N2, I_WUP, I_WDN, I_NF, N_IN };

constexpr size_t MiB = 1u << 20;
constexpr size_t SZ_WIN = (size_t)PTP * D * 2, SZ_WOUT = (size_t)D * D * 2, SZ_WUP = (size_t)FF * D * 2, SZ_WDN = (size_t)D * FF * 2;
constexpr size_t WS_CTL = 0, CTL_BYTES = 1 * MiB;
constexpr size_t WS_SS = 64 * 1024, SS_STRIDE = (size_t)SEQ_T * 4;
constexpr size_t CTL_ZERO_BYTES = WS_SS + (2 * 2 + 1) * SS_STRIDE;
constexpr size_t WS_WIN = WS_CTL + CTL_BYTES;
constexpr size_t WS_WOUT = WS_WIN + SZ_WIN;
constexpr size_t WS_WUP = WS_WOUT + SZ_WOUT;
constexpr size_t WS_WDN = WS_WUP + SZ_WUP;
constexpr size_t WS_XN = WS_WDN + SZ_WDN;
constexpr size_t WS_O = WS_XN;
constexpr size_t WS_PROJ = WS_XN + (size_t)T * D * 2;
constexpr size_t WS_HID = WS_PROJ;
constexpr size_t GDN_ = (size_t)(T / 64) * 4 * 16384;
constexpr size_t WS_GD_G = WS_PROJ + (size_t)T * PTP * 2;
constexpr size_t WS_GD_Z = WS_GD_G + GDN_ * 2;
constexpr size_t WS_GD_QT = WS_GD_Z + GDN_ * 4;
constexpr size_t WS_GD_YI = WS_GD_QT + GDN_;
constexpr size_t WS_GD_S = WS_GD_YI + GDN_;
constexpr size_t WS_GAB = WS_GD_S + GDN_ * 2;
constexpr int NCH = T / 64;
constexpr size_t WS_RET_Z = WS_GAB;
constexpr size_t WS_RET_YI = WS_RET_Z + (size_t)NCH * 4 * 8192 * 4;
constexpr size_t WS_RET_QH = WS_RET_YI + (size_t)NCH * 4 * 8192 * 2;
constexpr size_t WS_RET_S = WS_RET_QH + (size_t)NCH * 4 * 4096 * 2;
constexpr size_t M2N = (size_t)NCH * 8 * 8192;
constexpr size_t WS_M2_Z = WS_RET_S + (size_t)NCH * 4 * 8192 * 2;
constexpr size_t WS_M2_YI = WS_M2_Z + M2N * 4;
constexpr size_t WS_M2_QH = WS_M2_YI + M2N;
constexpr size_t WS_M2_S = WS_M2_QH + M2N * 2;
constexpr size_t WS_M2_DEC = WS_M2_S + M2N * 2;
constexpr size_t WS_MDT = WS_M2_DEC + (size_t)NCH * 8 * 4;
constexpr size_t RWN = (size_t)NCH * 8 * 4096;
constexpr size_t WS_RW_G = WS_MDT;
constexpr size_t WS_RW_Z = WS_RW_G + RWN * 2;
constexpr size_t WS_RW_QT = WS_RW_Z + RWN * 4;
constexpr size_t WS_RW_YI = WS_RW_QT + RWN * 2;
constexpr size_t WS_RW_E = WS_RW_YI + RWN * 2;
constexpr size_t WS_RW_GT = WS_RW_E + RWN * 2;
constexpr size_t WS_RW_S = WS_RW_GT + RWN * 2;
constexpr size_t WS_END = WS_RW_S + RWN * 2;
constexpr size_t WS_XN2 = WS_RET_Z;
static_assert(WS_HID + (size_t)T * FF * 2 <= WS_XN2 && WS_XN2 + (size_t)T * D * 2 <= WS_M2_Z, "HID overlay / XN2 alias");
static_assert(CTL_ZERO_BYTES <= CTL_BYTES, "CTL");
static_assert(SEQ_T != 8192 || WS_END <= 512 * MiB, "d_ws budget (512 MiB)");

typedef unsigned short bf16_t;
#ifdef HOST_TEST
#define DEV static inline
#define HD static inline
typedef float f32x4 __attribute__((vector_size(16)));
constexpr int WAVE = 1, LPC = 1;
static inline float wave_sum(float v) { return v; }
static inline float group_sum(float v) { return v; }
#else
#define DEV __device__ __forceinline__
#define HD __host__ __device__ __forceinline__
typedef float f32x4 __attribute__((ext_vector_type(4)));
constexpr int WAVE = 64, LPC = 16;
DEV float wave_sum(float v) {
#pragma unroll
    for (int o = 1; o < 64; o <<= 1) v += __shfl_xor(v, o);
    return v;
}
DEV float group_sum(float v) {
#pragma unroll
    for (int o = 1; o < 16; o <<= 1) v += __shfl_xor(v, o);
    return v;
}
#endif
constexpr int CPW = WAVE / LPC;

HD unsigned f2bf(float f) { unsigned u; __builtin_memcpy(&u, &f, 4); return (u + 0x7fffu + ((u >> 16) & 1u)) >> 16; }
HD unsigned pk2(float lo, float hi) { return f2bf(lo) | (f2bf(hi) << 16); }
HD float bf2f(bf16_t b) { unsigned u = (unsigned)b << 16; float f; __builtin_memcpy(&f, &u, 4); return f; }
#ifdef HOST_TEST
DEV float sigmoid_f(float x) { return 1.0f / (1.0f + expf(-x)); }
DEV float silu_f(float x) { return x / (1.0f + expf(-x)); }
#else
DEV float fexp(float x) { return __builtin_amdgcn_exp2f(x * 1.4426950408889634f); }
DEV float sigmoid_f(float x) { return __builtin_amdgcn_rcpf(1.0f + fexp(-x)); }
DEV float silu_f(float x) { return x * __builtin_amdgcn_rcpf(1.0f + fexp(-x)); }
#endif
DEV float softplus_f(float x) { return x > 20.f ? x : log1pf(expf(x)); }

struct Args { const float* in[N_IN]; float* out; unsigned char* ws; int ph_lo, ph_hi; };
#ifdef HOST_TEST
typedef const Args CArgs;
#else
typedef const __attribute__((address_space(4))) Args CArgs;
#endif
#define WSF(off) ((float*)(a.ws + (off)))
#define HRES (a.out)
#define PROJROW(t) ((const bf16_t*)(a.ws + WS_PROJ) + (size_t)(t) * PTP)
#define LP(idx, per) (a.in[idx] + (size_t)l * (per))

DEV void xn_row(const float* x, const float* w, bf16_t* o, float* ss_out, int lane) {
    float ss = 0.f;
    for (int i = lane * 4; i < D; i += WAVE * 4) { const f32x4 v = *(const f32x4*)(x + i), g = *(const f32x4*)(w + i); ss += (v[0] * v[0] + v[1] * v[1]) + (v[2] * v[2] + v[3] * v[3]);
        unsigned* op = (unsigned*)(o + i); op[0] = pk2(v[0] * g[0], v[1] * g[1]); op[1] = pk2(v[2] * g[2], v[3] * g[3]); }
    ss = wave_sum(ss); if (lane == 0) *ss_out = ss;
}
DEV void final_row(float* x, const float* w, float ss, int lane) {
    const float r = 1.0f / sqrtf(ss * (1.0f / D) + 1e-6f);
    for (int i = lane * 4; i < D; i += WAVE * 4) { const f32x4 v = *(const f32x4*)(x + i), g = *(const f32x4*)(w + i); f32x4 y; y[0] = v[0] * r * g[0]; y[1] = v[1] * r * g[1]; y[2] = v[2] * r * g[2]; y[3] = v[3] * r * g[3]; *(f32x4*)(x + i) = y; }
}
DEV void rms_row_bf16(const float* x, const float* w, bf16_t* o, int lane) {
    float ss = 0.f;
    for (int i = lane * 4; i < D; i += WAVE * 4) { const f32x4 v = *(const f32x4*)(x + i); ss += (v[0] * v[0] + v[1] * v[1]) + (v[2] * v[2] + v[3] * v[3]); }
    const float r = 1.0f / sqrtf(wave_sum(ss) * (1.0f / D) + 1e-6f);
    for (int i = lane * 4; i < D; i += WAVE * 4) { const f32x4 v = *(const f32x4*)(x + i), g = *(const f32x4*)(w + i);
        unsigned* op = (unsigned*)(o + i); op[0] = pk2(v[0] * r * g[0], v[1] * r * g[1]); op[1] = pk2(v[2] * r * g[2], v[3] * r * g[3]); }
}
DEV void rms_row_f32(const float* x, const float* w, float* o, int lane) {
    float ss = 0.f;
    for (int i = lane * 4; i < D; i += WAVE * 4) { const f32x4 v = *(const f32x4*)(x + i); ss += (v[0] * v[0] + v[1] * v[1]) + (v[2] * v[2] + v[3] * v[3]); }
    const float r = 1.0f / sqrtf(wave_sum(ss) * (1.0f / D) + 1e-6f);
    for (int i = lane * 4; i < D; i += WAVE * 4) { const f32x4 v = *(const f32x4*)(x + i), g = *(const f32x4*)(w + i);
        f32x4 y; y[0] = v[0] * r * g[0]; y[1] = v[1] * r * g[1]; y[2] = v[2] * r * g[2]; y[3] = v[3] * r * g[3]; *(f32x4*)(o + i) = y; }
}

DEV float conv4(const bf16_t* projrow_t, int col, const float* w, int c, int wstride, int t) {
    float acc = 0.f;
#pragma unroll
    for (int j = 0; j < 4; ++j) { const int tt = t - 3 + j; if (tt >= 0) acc += w[j * wstride + c] * bf2f(projrow_t[(ptrdiff_t)(j - 3) * PTP + col]); }
    return acc;
}

#ifdef HOST_TEST
static const float THETA[32] = {
#else
__device__ const float THETA[32] = {
#endif
    1.000000000e+00f, 7.429639101e-01f, 5.519954562e-01f, 4.101127088e-01f, 3.046989739e-01f, 2.263803482e-01f, 1.681924462e-01f, 1.249609292e-01f, 9.284145385e-02f, 6.897785515e-02f,
    5.124806613e-02f, 3.807546571e-02f, 2.828869782e-02f, 2.101748064e-02f, 1.561523322e-02f, 1.160155423e-02f, 8.619536646e-03f, 6.404003594e-03f, 4.757945426e-03f, 3.534980817e-03f,
    2.626363887e-03f, 1.951293205e-03f, 1.449740841e-03f, 1.077104942e-03f, 8.002503891e-04f, 5.945570301e-04f, 4.417345626e-04f, 3.281927784e-04f, 2.438354713e-04f, 1.811609109e-04f,
    1.345960627e-04f, 9.999999747e-05f };

#ifndef HOST_TEST
namespace pg8 {
#define PG8_LAS __attribute__((address_space(3)))
typedef short bf16x8 __attribute__((ext_vector_type(8)));
typedef unsigned u32x4 __attribute__((ext_vector_type(4)));
constexpr int BM = 256, BK = 64, HALF = 128, HTB = HALF * BK * 2, STAGE_BYTES = 8 * HTB, NXCD = 8, WGM = 8;
__host__ __device__ __forceinline__ int lds_byte(int r, int c) { const int st = (r >> 4) * 2 + (c >> 5), rr = r & 15, cc = c & 31, ob = rr * 64 + cc * 2; return st * 1024 + (ob ^ (((ob >> 9) & 1) << 5)); }
__host__ __device__ __forceinline__ void stage_rc(int b, int& R, int& C) { const int st = b / 1024, sb = b % 1024, swz = sb ^ (((sb >> 9) & 1) << 5); R = (st >> 1) * 16 + swz / 64; C = (st & 1) * 32 + (swz % 64) / 2; }
__host__ __device__ __forceinline__ int perm32(int rho) { const int n = rho >> 4, i = rho & 15; return 8 * (i >> 2) + 4 * n + (i & 3); }
struct Unit { int pm, pn; };
struct Gemm { const bf16_t* A; const bf16_t* Bt; };
template <int M, int N> struct StaticOrder {
    static constexpr int nM = M / BM, nN = N / BM, nwg = nM * nN; int G, c;
    __device__ void init(int G_, int c_) { G = G_; c = c_; }
    __device__ bool next(int i, Unit& u) const {
        const long L = (long)i * G + c; if (L >= nwg) return false;
        int wgid = (int)L; { const int q = nwg / NXCD, r = nwg % NXCD, xcd = wgid % NXCD, off = wgid / NXCD; wgid = (xcd < r ? xcd * (q + 1) : r * (q + 1) + (xcd - r) * q) + off; }
        const int nig = WGM * nN, gid = wgid / nig, fm = gid * WGM, gsz = (nM - fm) < WGM ? (nM - fm) : WGM;
        u.pm = fm + ((wgid % nig) % gsz); u.pn = (wgid % nig) / gsz; return true;
    }
    __device__ __forceinline__ void a_ready(const Unit&) const {}
    __device__ __forceinline__ void done(const Unit&) const {}
};
__device__ __forceinline__ unsigned cvt_pk_bf16(float lo, float hi) { unsigned r; asm volatile("v_cvt_pk_bf16_f32 %0, %1, %2" : "=v"(r) : "v"(lo), "v"(hi)); return r; }
struct EpiStoreF32 {
    static constexpr bool PERM = false, AFTER_DRAIN = false; float* O; int ldc;
    __device__ __forceinline__ void operator()(const f32x4 (&acc)[2][2][4][2], const Unit& u, int wr, int wc, int fr, int fq) const {
        const int row0 = u.pm * BM + wr * 64 + fr, col0 = u.pn * BM + wc * 32 + 4 * fq;
#pragma unroll
        for (int ai = 0; ai < 2; ++ai)
#pragma unroll
            for (int m = 0; m < 4; ++m) { float* rowp = O + (size_t)(row0 + ai * HALF + m * 16) * ldc + col0;
#pragma unroll
                for (int bj = 0; bj < 2; ++bj)
#pragma unroll
                    for (int n = 0; n < 2; ++n) *(f32x4*)(rowp + bj * HALF + n * 16) = acc[ai][bj][m][n]; }
    }
};
struct EpiAddRes {
    static constexpr bool PERM = false, AFTER_DRAIN = false; const float* B; float* O; int ldc; bf16_t* XN; const float* nw; float* SS;
    __device__ __forceinline__ void operator()(const f32x4 (&acc)[2][2][4][2], const Unit& u, int wr, int wc, int fr, int fq) const {
        typedef unsigned u32x2e __attribute__((ext_vector_type(2)));
        const int row0 = u.pm * BM + wr * 64 + fr, col0 = u.pn * BM + wc * 32 + 4 * fq;
#pragma unroll
        for (int ai = 0; ai < 2; ++ai)
#pragma unroll
            for (int mp = 0; mp < 4; mp += 2) {
                f32x4 b[2][2][2];
#pragma unroll
                for (int mm = 0; mm < 2; ++mm) { const float* bp = B + (size_t)(row0 + ai * HALF + (mp + mm) * 16) * ldc + col0;
#pragma unroll
                    for (int bj = 0; bj < 2; ++bj)
#pragma unroll
                        for (int n = 0; n < 2; ++n) b[mm][bj][n] = *(const f32x4*)(bp + bj * HALF + n * 16); }
#pragma unroll
                for (int mm = 0; mm < 2; ++mm) { const int m = mp + mm; const size_t ro = (size_t)(row0 + ai * HALF + m * 16) * ldc + col0; float* rowp = O + ro; bf16_t* xp = XN + ro; float ss = 0.f;
#pragma unroll
                    for (int bj = 0; bj < 2; ++bj)
#pragma unroll
                        for (int n = 0; n < 2; ++n) { const f32x4 hn = b[mm][bj][n] + acc[ai][bj][m][n]; *(f32x4*)(rowp + bj * HALF + n * 16) = hn; const f32x4 wv = *(const f32x4*)(nw + col0 + bj * HALF + n * 16);
                            ss += (hn[0] * hn[0] + hn[1] * hn[1]) + (hn[2] * hn[2] + hn[3] * hn[3]);
                            u32x2e pw; pw.x = cvt_pk_bf16(hn[0] * wv[0], hn[1] * wv[1]); pw.y = cvt_pk_bf16(hn[2] * wv[2], hn[3] * wv[3]); *(u32x2e*)(xp + bj * HALF + n * 16) = pw; }
                    ss += __shfl_xor(ss, 16); ss += __shfl_xor(ss, 32);
                    if (fq == 0) atomicAdd(SS + row0 + ai * HALF + m * 16, ss); } }
    }
};
template <bool SQRELU> struct EpiBf16 {
    static constexpr bool PERM = true, AFTER_DRAIN = false; bf16_t* O; int ldc; const float* SS;
    __device__ __forceinline__ void operator()(const f32x4 (&acc)[2][2][4][2], const Unit& u, int wr, int wc, int fr, int fq) const {
        const int row0 = u.pm * BM + wr * 64 + fr, col0 = u.pn * BM + wc * 32 + 8 * fq;
#pragma unroll
        for (int ai = 0; ai < 2; ++ai)
#pragma unroll
            for (int m = 0; m < 4; ++m) { bf16_t* rowp = O + (size_t)(row0 + ai * HALF + m * 16) * ldc + col0; const float rs = __builtin_amdgcn_rsqf(SS[row0 + ai * HALF + m * 16] * (1.0f / D) + 1e-6f);
#pragma unroll
                for (int bj = 0; bj < 2; ++bj) { f32x4 v0 = acc[ai][bj][m][0] * rs, v1 = acc[ai][bj][m][1] * rs;
                    if (SQRELU) {
#pragma unroll
                        for (int j = 0; j < 4; ++j) { const float p0 = fmaxf(v0[j], 0.f), p1 = fmaxf(v1[j], 0.f); v0[j] = p0 * p0; v1[j] = p1 * p1; } }
                    u32x4 w; w.x = cvt_pk_bf16(v0[0], v0[1]); w.y = cvt_pk_bf16(v0[2], v0[3]); w.z = cvt_pk_bf16(v1[0], v1[1]); w.w = cvt_pk_bf16(v1[2], v1[3]);
                    *(u32x4*)(rowp + bj * HALF) = w; } }
    }
};

template <int K, class Epi, class Sched, bool ALIGN_EPI = false>
__device__ __forceinline__ void gemm_phase(PG8_LAS unsigned char* lds, const Gemm g, const Sched& S, const Epi& E, const int tid) {
    const int wid = __builtin_amdgcn_readfirstlane(tid >> 6), lane = tid & 63, wr = wid >> 2, wc = wid & 3, fr = lane & 15, fq = lane >> 4;
    constexpr int nt = K / BK;
    unsigned voffA[2], voffB[2];
#pragma unroll
    for (int i = 0; i < 2; ++i) { int R, C; stage_rc(tid * 16 + i * 8192, R, C); const int Rb = Epi::PERM ? ((R & ~31) + perm32(R & 31)) : R;
        voffA[i] = (unsigned)(R * K + C) * 2u; voffB[i] = (unsigned)(Rb * K + C) * 2u; }
    const size_t kstep = (size_t)(BK * 2);
    const size_t hstep = (size_t)HALF * K * 2;
    const size_t tstep = 2 * hstep;
    const unsigned ldsw = (unsigned)wid * 1024u;
    const int aoff = lds_byte(wr * 64 + fr, fq * 8), boff = lds_byte(wc * 32 + fr, fq * 8);
#define PG8_SA(b, h) (((b) * 2 + (h)) * HTB)
#define PG8_SB(b, h) ((4 + (b) * 2 + (h)) * HTB)
#define PG8_STAGE(bufoff, gbase, voff) do { _Pragma("unroll") for (int _i = 0; _i < 2; ++_i) \
        __builtin_amdgcn_global_load_lds((const unsigned*)((const char*)(gbase) + (voff)[_i]), (PG8_LAS unsigned*)(lds + (bufoff) + ldsw + _i * 8192), 16, 0, 0); } while (0)
#define PG8_LDA(dst, b, h) do { _Pragma("unroll") for (int m = 0; m < 4; ++m) _Pragma("unroll") for (int k = 0; k < 2; ++k) dst[m][k] = *(const PG8_LAS bf16x8*)(lds + PG8_SA(b, h) + aoff + m * 2048 + k * 1024); } while (0)
#define PG8_LDB(dst, b, h) do { _Pragma("unroll") for (int n = 0; n < 2; ++n) _Pragma("unroll") for (int k = 0; k < 2; ++k) dst[n][k] = *(const PG8_LAS bf16x8*)(lds + PG8_SB(b, h) + boff + n * 2048 + k * 1024); } while (0)
#define PG8_MMA(ai, bj, At, Bt) do { __builtin_amdgcn_s_setprio(1); _Pragma("unroll") for (int m = 0; m < 4; ++m) _Pragma("unroll") for (int n = 0; n < 2; ++n) _Pragma("unroll") for (int k = 0; k < 2; ++k) \
        acc[ai][bj][m][n] = __builtin_amdgcn_mfma_f32_16x16x32_bf16(Bt[n][k], At[m][k], acc[ai][bj][m][n], 0, 0, 0); __builtin_amdgcn_s_setprio(0); } while (0)
#define PG8_WAIT_V(n) asm volatile("s_waitcnt vmcnt(" #n ")" ::: "memory")
#define PG8_WAIT_L(n) asm volatile("s_waitcnt lgkmcnt(" #n ")" ::: "memory")
#define PG8_BAR __builtin_amdgcn_s_barrier()
#define PG8_SCHED __builtin_amdgcn_sched_barrier(0)
    Unit cur, nxt; int ui = 0;
    if (!S.next(0, cur)) return;
    f32x4 acc[2][2][4][2];
#pragma unroll
    for (int a = 0; a < 2; ++a)
#pragma unroll
        for (int b = 0; b < 2; ++b)
#pragma unroll
            for (int m = 0; m < 4; ++m)
#pragma unroll
                for (int n = 0; n < 2; ++n) acc[a][b][m][n] = (f32x4){0.f, 0.f, 0.f, 0.f};
    bf16x8 At[4][2], B0[2][2], B1[2][2];
    const char* cA = (const char*)g.A + (size_t)cur.pm * tstep; const char* cB = (const char*)g.Bt + (size_t)cur.pn * tstep;
    S.a_ready(cur);
    PG8_STAGE(PG8_SB(0, 0), cB, voffB); PG8_STAGE(PG8_SB(0, 1), cB + hstep, voffB); PG8_STAGE(PG8_SA(0, 0), cA, voffA); PG8_STAGE(PG8_SA(0, 1), cA + hstep, voffA);
    if (wr == 1) PG8_BAR;
    PG8_WAIT_V(2); PG8_BAR;
    PG8_STAGE(PG8_SB(1, 0), cB + kstep, voffB); PG8_STAGE(PG8_SA(1, 0), cA + kstep, voffA); PG8_STAGE(PG8_SB(1, 1), cB + hstep + kstep, voffB);
    PG8_WAIT_V(6); PG8_BAR;
    for (;;) {
        const bool has_next = S.next(ui + 1, nxt);
        const char* nA = has_next ? (const char*)g.A + (size_t)nxt.pm * tstep : cA; const char* nB = has_next ? (const char*)g.Bt + (size_t)nxt.pn * tstep : cB;
        for (int t = 0; t < nt; t += 2) {
            const bool last = (t == nt - 2);
            const char* a1 = cA + (size_t)(t + 1) * kstep;
            const char* a2 = last ? nA : cA + (size_t)(t + 2) * kstep; const char* b2 = last ? nB : cB + (size_t)(t + 2) * kstep;
            const char* a3 = a2 + kstep; const char* b3 = b2 + kstep;
            if (last && has_next) S.a_ready(nxt);
            PG8_LDB(B0, 0, 0); PG8_LDB(B1, 0, 1); PG8_SCHED; PG8_LDA(At, 0, 0); PG8_STAGE(PG8_SA(1, 1), a1 + hstep, voffA);
            PG8_WAIT_V(8); PG8_WAIT_L(0); PG8_BAR; PG8_MMA(0, 0, At, B0); PG8_MMA(0, 1, At, B1); PG8_BAR; PG8_SCHED;
            PG8_LDA(At, 0, 1); PG8_STAGE(PG8_SB(0, 0), b2, voffB); PG8_STAGE(PG8_SB(0, 1), b2 + hstep, voffB); PG8_STAGE(PG8_SA(0, 0), a2, voffA);
            PG8_WAIT_V(8); PG8_WAIT_L(0); PG8_BAR; PG8_MMA(1, 0, At, B0); PG8_MMA(1, 1, At, B1); PG8_BAR; PG8_SCHED;
            PG8_LDB(B0, 1, 0); PG8_LDB(B1, 1, 1); PG8_SCHED; PG8_LDA(At, 1, 0); PG8_STAGE(PG8_SA(0, 1), a2 + hstep, voffA);
            PG8_WAIT_V(8); PG8_WAIT_L(0); PG8_BAR; PG8_MMA(0, 0, At, B0); PG8_MMA(0, 1, At, B1); PG8_BAR; PG8_SCHED;
            PG8_LDA(At, 1, 1); PG8_STAGE(PG8_SB(1, 0), b3, voffB); PG8_STAGE(PG8_SB(1, 1), b3 + hstep, voffB); PG8_STAGE(PG8_SA(1, 0), a3, voffA);
            PG8_WAIT_V(8); PG8_WAIT_L(0); PG8_BAR; PG8_MMA(1, 0, At, B0); PG8_MMA(1, 1, At, B1); PG8_BAR; PG8_SCHED;
        }
        if constexpr (ALIGN_EPI) { if (wr == 0) PG8_BAR; }
        E(acc, cur, wr, wc, fr, fq); S.done(cur);
        if (!has_next) break;
#pragma unroll
        for (int a = 0; a < 2; ++a)
#pragma unroll
            for (int b = 0; b < 2; ++b)
#pragma unroll
                for (int m = 0; m < 4; ++m)
#pragma unroll
                    for (int n = 0; n < 2; ++n) acc[a][b][m][n] = (f32x4){0.f, 0.f, 0.f, 0.f};
        cur = nxt; cA = nA; cB = nB; ++ui;
        if constexpr (ALIGN_EPI) { if (wr == 1) PG8_BAR; }
    }
    PG8_WAIT_V(0);
    if constexpr (!ALIGN_EPI) { if (wr == 0) PG8_BAR; }
    PG8_BAR;
#undef PG8_SA
#undef PG8_SB
#undef PG8_STAGE
#undef PG8_LDA
#undef PG8_LDB
#undef PG8_MMA
#undef PG8_WAIT_V
#undef PG8_WAIT_L
#undef PG8_BAR
#undef PG8_SCHED
}
}

#define LAS __attribute__((address_space(3)))
#define GAS __attribute__((address_space(1)))
typedef unsigned v4u __attribute__((ext_vector_type(4)));
constexpr int NWAVES = 8, LDS_BYTES = 163840, MISC_OFF = LDS_BYTES - 512;
#define LDS_WAIT() asm volatile("s_waitcnt lgkmcnt(0)" ::: "memory")

__device__ __forceinline__ void transpose_item(const float* W, int K, int N, int Npad, bf16_t* WT, LAS float* scr, int item, int lane) {
    const int nblk = Npad / 32, kb = item / nblk, nb = item % nblk, k0 = 64 * kb, n0 = 32 * nb;
    const int n = n0 + (lane & 31); const bool ok = n < N;
    float v[32];
    const float* src = W + (size_t)(k0 + (lane >> 5)) * N + n;
#pragma unroll
    for (int i = 0; i < 32; ++i) v[i] = ok ? src[(size_t)(2 * i) * N] : 0.f;
#pragma unroll
    for (int i = 0; i < 32; ++i) scr[(2 * i + (lane >> 5)) * 33 + (lane & 31)] = v[i];
    LDS_WAIT(); asm volatile("" ::: "memory");
    const int c = lane & 7;
#pragma unroll
    for (int j = 0; j < 4; ++j) { const int nn = (lane >> 3) + 8 * j; const LAS float* s = scr + (8 * c) * 33 + nn;
        v4u o; o.x = pk2(s[0 * 33], s[1 * 33]); o.y = pk2(s[2 * 33], s[3 * 33]); o.z = pk2(s[4 * 33], s[5 * 33]); o.w = pk2(s[6 * 33], s[7 * 33]);
        *(GAS v4u*)(WT + (size_t)(n0 + nn) * K + k0 + 8 * c) = o; }
    LDS_WAIT(); asm volatile("" ::: "memory");
}


typedef short bf16x8 __attribute__((ext_vector_type(8)));
typedef short s16x4 __attribute__((ext_vector_type(4)));
typedef unsigned u32x2 __attribute__((ext_vector_type(2)));
__device__ __forceinline__ s16x4 tr16(const LAS bf16_t* p) { return __builtin_bit_cast(s16x4, __builtin_amdgcn_ds_read_tr16_b64_v4i16((LAS s16x4*)p)); }
__device__ __forceinline__ bf16x8 frag_row(const LAS bf16_t* img, int ld, int nc0, int k0, int lane) { return *(const LAS bf16x8*)(img + (nc0 + (lane & 15)) * ld + k0 + 8 * (lane >> 4)); }
__device__ __forceinline__ bf16x8 frag_tr(const LAS bf16_t* img, int ld, int nc0, int k0, int lane) {
    const int g = lane >> 4, q = (lane & 15) >> 2, p = lane & 3;
    const LAS bf16_t* ad = img + (k0 + 8 * g + q) * ld + nc0 + 4 * p;
    const s16x4 lo = tr16(ad), hi = tr16(ad + 4 * ld);
    return (bf16x8){lo[0], lo[1], lo[2], lo[3], hi[0], hi[1], hi[2], hi[3]};
}
__device__ __forceinline__ bf16x8 frag_row_g(const bf16_t* img, int ld, int nc0, int k0, int lane) { return *(const bf16x8*)(img + (size_t)(nc0 + (lane & 15)) * ld + k0 + 8 * (lane >> 4)); }
__device__ __forceinline__ bf16x8 frag_fo(const bf16_t* img, int KS, int tile, int ks, int lane) { return *(const bf16x8*)(img + ((size_t)(tile * KS + ks) * 64 + lane) * 8); }
__device__ __forceinline__ int fo_st(int tile, int KS, int k0, int g, int r) { const int k = k0 + 4 * g; return ((tile * KS + (k >> 5)) * 64 + ((k >> 3) & 3) * 16 + r) * 8 + (k & 7); }
__device__ __forceinline__ int co_off(int tj, int NI, int ti, int lane) { return ((tj * NI + ti) * 64 + lane) * 4; }
__device__ __forceinline__ f32x4 mfma16(bf16x8 a, bf16x8 b, f32x4 c) { return __builtin_amdgcn_mfma_f32_16x16x32_bf16(a, b, c, 0, 0, 0); }
__device__ __forceinline__ u32x2 pack4(f32x4 v) { u32x2 w; w.x = pk2(v[0], v[1]); w.y = pk2(v[2], v[3]); return w; }
__device__ __forceinline__ f32x4 unpack4(u32x2 w) { f32x4 v; v[0] = __uint_as_float(w.x << 16); v[1] = __uint_as_float(w.x & 0xffff0000u); v[2] = __uint_as_float(w.y << 16); v[3] = __uint_as_float(w.y & 0xffff0000u); return v; }
#define WG_SYNC() do { asm volatile("s_waitcnt lgkmcnt(0)" ::: "memory"); __builtin_amdgcn_s_barrier(); asm volatile("" ::: "memory"); } while (0)

__device__ __forceinline__ void ret_stage1(CArgs& a, int n, int h, LAS unsigned char* lds, int tid) {
    const int lane = tid & 63, w = __builtin_amdgcn_readfirstlane(tid >> 6), r = lane & 15, g = lane >> 4;
    constexpr int LD = 72, LDV = 136;
    LAS bf16_t* Qi = (LAS bf16_t*)lds; LAS bf16_t* Ki = Qi + 64 * LD; LAS bf16_t* Kdi = Ki + 64 * LD; LAS bf16_t* Vi = Kdi + 64 * LD; LAS bf16_t* Si = Vi + 64 * LDV;
    const int tk = n * 4 + h; const float lg2 = log2f(1.0f - exp2f(-5.0f - (float)h));
    bf16_t* QH = (bf16_t*)(a.ws + WS_RET_QH) + (size_t)tk * 4096;
    unsigned rqq[4], rkk[4]; v4u rvv[2];
#pragma unroll
    for (int ii = 0; ii < 4; ++ii) { const int idx = tid + 512 * ii, c = idx >> 5, i = idx & 31; const bf16_t* pr = PROJROW(n * 64 + c); rqq[ii] = *(const unsigned*)(pr + C_RQ + 64 * h + 2 * i); rkk[ii] = *(const unsigned*)(pr + C_RK + 64 * h + 2 * i); }
#pragma unroll
    for (int ii = 0; ii < 2; ++ii) { const int idx = tid + 512 * ii, c = idx >> 4, ch = idx & 15; rvv[ii] = *(const v4u*)(PROJROW(n * 64 + c) + C_RV + 128 * h + 8 * ch); }
#pragma unroll
    for (int ii = 0; ii < 4; ++ii) { const int idx = tid + 512 * ii;
        const int c = idx >> 5, i = idx & 31, t = n * 64 + c; float sn, cs; sincosf((float)t * THETA[i], &sn, &cs);
        const unsigned qq = rqq[ii], kk = rkk[ii];
        const float q0 = __uint_as_float(qq << 16), q1 = __uint_as_float(qq & 0xffff0000u), k0 = __uint_as_float(kk << 16), k1 = __uint_as_float(kk & 0xffff0000u);
        const float rq0 = q0 * cs - q1 * sn, rq1 = q1 * cs + q0 * sn, rk0 = (k0 * cs - k1 * sn) * 0.125f, rk1 = (k1 * cs + k0 * sn) * 0.125f;
        const float dk = exp2f(lg2 * (float)(63 - c)), dq = exp2f(lg2 * (float)(c + 1));
        *(LAS unsigned*)(Qi + c * LD + 2 * i) = pk2(rq0, rq1); *(LAS unsigned*)(Ki + c * LD + 2 * i) = pk2(rk0, rk1); *(LAS unsigned*)(Kdi + c * LD + 2 * i) = pk2(rk0 * dk, rk1 * dk);
        { const int d = 2 * i; *(unsigned*)(QH + (((c >> 4) * 2 + (d >> 5)) * 64 + ((d >> 3) & 3) * 16 + (c & 15)) * 8 + (d & 7)) = pk2(rq0 * dq, rq1 * dq); }
    }
#pragma unroll
    for (int ii = 0; ii < 2; ++ii) { const int idx = tid + 512 * ii, c = idx >> 4, ch = idx & 15; *(LAS v4u*)(Vi + c * LDV + 8 * ch) = rvv[ii]; }
    WG_SYNC();
#pragma unroll
    for (int tt = 0; tt < 2; ++tt) { const int tile = 2 * w + tt, im = tile >> 2, jc = tile & 3; f32x4 acc = {0.f, 0.f, 0.f, 0.f};
        if (jc >= im) {
#pragma unroll
            for (int k0 = 0; k0 < 64; k0 += 32) acc = mfma16(frag_row(Ki, LD, 16 * im, k0, lane), frag_row(Qi, LD, 16 * jc, k0, lane), acc);
#pragma unroll
            for (int e = 0; e < 4; ++e) { const int i = 16 * im + 4 * g + e, j = 16 * jc + r; acc[e] = j >= i ? acc[e] * exp2f(lg2 * (float)(j - i)) : 0.f; } }
        *(LAS u32x2*)(Si + (16 * jc + r) * LD + 16 * im + 4 * g) = pack4(acc); }
    WG_SYNC();
    bf16_t* YI = (bf16_t*)(a.ws + WS_RET_YI) + (size_t)tk * 8192; bf16_t* Z = (bf16_t*)(a.ws + WS_RET_Z) + (size_t)tk * 8192;
#pragma unroll
    for (int tt = 0; tt < 4; ++tt) { const int jc = w & 3, ie = 4 * (w >> 2) + tt; f32x4 acc = {0.f, 0.f, 0.f, 0.f};
#pragma unroll
        for (int k0 = 0; k0 < 64; k0 += 32) acc = mfma16(frag_tr(Vi, LDV, 16 * ie, k0, lane), frag_row(Si, LD, 16 * jc, k0, lane), acc);
        *(u32x2*)(YI + co_off(jc, 8, ie, lane)) = pack4(acc); }
#pragma unroll
    for (int tt = 0; tt < 4; ++tt) { const int id = w & 3, je = 4 * (w >> 2) + tt; f32x4 acc = {0.f, 0.f, 0.f, 0.f};
#pragma unroll
        for (int k0 = 0; k0 < 64; k0 += 32) acc = mfma16(frag_tr(Kdi, LD, 16 * id, k0, lane), frag_tr(Vi, LDV, 16 * je, k0, lane), acc);
        *(u32x2*)(Z + fo_st(je, 2, 16 * id, g, r)) = pack4(acc); }
    WG_SYNC();
}
__device__ __forceinline__ void ret_stage2(CArgs& a, int b, int tid) {
    const int idx = b * 512 + tid, h = idx >> 13, rem = idx & 8191; const float g64 = exp2f(64.0f * log2f(1.0f - exp2f(-5.0f - (float)h)));
    const bf16_t* Z = (const bf16_t*)(a.ws + WS_RET_Z) + (size_t)h * 8192 + rem; bf16_t* S = (bf16_t*)(a.ws + WS_RET_S) + (size_t)h * 8192 + rem; float s = 0.f;
#pragma unroll 32
    for (int n = 0; n < NCH; ++n) { const float z = bf2f(Z[(size_t)n * 4 * 8192]); S[(size_t)n * 4 * 8192] = (bf16_t)f2bf(s); s = g64 * s + z; }
}
__device__ __forceinline__ void ret_stage3(CArgs& a, int l, int n, int h, LAS unsigned char* lds, int tid) {
    const int lane = tid & 63, w = __builtin_amdgcn_readfirstlane(tid >> 6), r = lane & 15, g = lane >> 4, jc = w & 3, wh = w >> 2;
    const int tk = n * 4 + h; const int c = 16 * jc + r, t = n * 64 + c;
    const bf16_t* S = (const bf16_t*)(a.ws + WS_RET_S) + (size_t)tk * 8192; const bf16_t* QH = (const bf16_t*)(a.ws + WS_RET_QH) + (size_t)tk * 4096; const bf16_t* YI = (const bf16_t*)(a.ws + WS_RET_YI) + (size_t)tk * 8192;
    LAS float* xs = (LAS float*)lds;
    f32x4 acc[4];
#pragma unroll
    for (int tt = 0; tt < 4; ++tt) { const int ie = 4 * wh + tt; acc[tt] = unpack4(*(const u32x2*)(YI + co_off(jc, 8, ie, lane)));
#pragma unroll
        for (int k = 0; k < 2; ++k) acc[tt] = mfma16(frag_fo(S, 2, ie, k, lane), frag_fo(QH, 2, jc, k, lane), acc[tt]); }
    float s1 = 0.f;
#pragma unroll
    for (int tt = 0; tt < 4; ++tt) s1 += (acc[tt][0] + acc[tt][1]) + (acc[tt][2] + acc[tt][3]);
    s1 += __shfl_xor(s1, 16); s1 += __shfl_xor(s1, 32);
    if (g == 0) xs[w * 16 + r] = s1;
    WG_SYNC();
    const float mu = (s1 + xs[(w ^ 4) * 16 + r]) * (1.0f / 128.0f); float s2 = 0.f;
#pragma unroll
    for (int tt = 0; tt < 4; ++tt)
#pragma unroll
        for (int e = 0; e < 4; ++e) { acc[tt][e] -= mu; s2 += acc[tt][e] * acc[tt][e]; }
    s2 += __shfl_xor(s2, 16); s2 += __shfl_xor(s2, 32);
    if (g == 0) xs[128 + w * 16 + r] = s2;
    WG_SYNC();
    const float rs = 1.0f / sqrtf((s2 + xs[128 + (w ^ 4) * 16 + r]) * (1.0f / 128.0f) + 1e-6f);
    const float* nw = LP(I_RNORM, 512) + h * 128; const bf16_t* pr = PROJROW(t) + C_RG + h * 128; bf16_t* O = (bf16_t*)(a.ws + WS_O) + (size_t)t * D + 512 + h * 128;
#pragma unroll
    for (int tt = 0; tt < 4; ++tt) { const int e0 = 16 * (4 * wh + tt) + 4 * g; const f32x4 gt = unpack4(*(const u32x2*)(pr + e0)); const f32x4 wv = *(const f32x4*)(nw + e0); f32x4 y;
#pragma unroll
        for (int e = 0; e < 4; ++e) y[e] = acc[tt][e] * rs * wv[e] * silu_f(gt[e]);
        *(u32x2*)(O + e0) = pack4(y); }
    WG_SYNC();
}

constexpr int RW_LD = 72;
constexpr int RWO_V = 0, RWO_IMG = 9216  , RWO_XI = 36864  , RWO_UI = 55296, RWO_CUMC = 64512, RWO_WT = 65536  , RWO_AM = 65536, RWO_TRI = 82944,
              RWO_RHST = 110592, RWO_AI = 143360, RWO_DI = 152576;
constexpr int RWO_LW = 9216, RWO_LIN = 82944;
__device__ __forceinline__ float ftanh(float x) { return 1.0f - 2.0f * __builtin_amdgcn_rcpf(1.0f + fexp(2.0f * x)); }
__device__ __forceinline__ float fsoftplus(float x) { return x > 20.f ? x : __builtin_amdgcn_logf(1.0f + fexp(x)) * 0.6931471805599453f; }
__device__ __forceinline__ void rw_stage1(CArgs& a, int l, int n, int h, LAS unsigned char* lds, int tid, const int stop = 99) {
    const int w = __builtin_amdgcn_readfirstlane(tid >> 6), tk = n * 8 + h;
    int lane, r, g, c, kg, t;
#define RW_IDX() do { int tl_ = tid; asm volatile("" : "+v"(tl_)); lane = tl_ & 63; r = lane & 15; g = lane >> 4; c = tl_ >> 3; kg = tl_ & 7; t = n * 64 + c; } while (0)
    RW_IDX();
    LAS bf16_t* Vi = (LAS bf16_t*)(lds + RWO_V);
    LAS bf16_t* RHi = (LAS bf16_t*)(lds + RWO_IMG); LAS bf16_t* BTi = RHi + 64 * RW_LD; LAS bf16_t* KTi = BTi + 64 * RW_LD; LAS bf16_t* KHi = KTi + 64 * RW_LD; LAS bf16_t* BMi = KHi + 64 * RW_LD; LAS bf16_t* KMi = BMi + 64 * RW_LD;
    LAS bf16_t* XI = (LAS bf16_t*)(lds + RWO_XI);
    LAS bf16_t* UI = (LAS bf16_t*)(lds + RWO_UI);
    LAS float* CUMC = (LAS float*)(lds + RWO_CUMC); LAS float* WT = (LAS float*)(lds + RWO_WT); LAS float* AM = (LAS float*)(lds + RWO_AM);
    LAS bf16_t* BMI = (LAS bf16_t*)(lds + RWO_TRI); LAS bf16_t* PBI = BMI + 64 * RW_LD; LAS bf16_t* PKI = PBI + 64 * RW_LD;
    LAS float* RHST = (LAS float*)(lds + RWO_RHST);
    LAS bf16_t* AI = (LAS bf16_t*)(lds + RWO_AI);
    LAS bf16_t* DI = (LAS bf16_t*)(lds + RWO_DI);
    LAS float* LW = (LAS float*)(lds + RWO_LW); LAS float* LA = LW + 4096; LAS float* LG = LA + 4096;
    LAS bf16_t* WLi = (LAS bf16_t*)(lds + RWO_LIN); LAS bf16_t* ALi = WLi + 64 * 40; LAS bf16_t* GLi = ALi + 64 * 40; LAS bf16_t* WUPi = GLi + 64 * 104; LAS bf16_t* AUPi = WUPi + 32 * RW_LD; LAS bf16_t* GUPi = AUPi + 32 * RW_LD;
    const float* mu = LP(I_RWMU, 1696); const bf16_t* p1 = PROJROW(t) + C_RW; const bf16_t* p0 = p1 - PTP; bool hp = t > 0;
    float vv[8];
    { const v4u cu = *(const v4u*)(p1 + 1024 + 64 * h + 8 * kg); v4u pv = {0u, 0u, 0u, 0u};
      const float* m = mu + 1024 + 64 * h + 8 * kg; const f32x4 m0 = *(const f32x4*)m, m1 = *(const f32x4*)(m + 4);
      u32x2 cw = *(const u32x2*)(p1 + 1536 + 4 * kg), ca = *(const u32x2*)(p1 + 1568 + 4 * kg), pw = {0u, 0u}, pa = {0u, 0u};
      u32x2 cg[3], pg[3] = {{0u, 0u}, {0u, 0u}, {0u, 0u}}; f32x4 mg[3];
#pragma unroll
      for (int q = 0; q < 3; ++q) { cg[q] = *(const u32x2*)(p1 + 1600 + 12 * kg + 4 * q); mg[q] = *(const f32x4*)(mu + 1600 + 12 * kg + 4 * q); }
      if (hp) { pv = *(const v4u*)(p0 + 1024 + 64 * h + 8 * kg); pw = *(const u32x2*)(p0 + 1536 + 4 * kg); pa = *(const u32x2*)(p0 + 1568 + 4 * kg);
#pragma unroll
          for (int q = 0; q < 3; ++q) pg[q] = *(const u32x2*)(p0 + 1600 + 12 * kg + 4 * q); }
      const f32x4 mw = *(const f32x4*)(mu + 1536 + 4 * kg), ma = *(const f32x4*)(mu + 1568 + 4 * kg);
      const int j = tid >> 4, k4 = (tid & 15) * 4;
      const f32x4 lwv = *(const f32x4*)(LP(I_RWWUP, 32 * 512) + j * 512 + 64 * h + k4), lav = *(const f32x4*)(LP(I_RWAUP, 32 * 512) + j * 512 + 64 * h + k4); f32x4 lgv[3];
#pragma unroll
      for (int q = 0; q < 3; ++q) lgv[q] = *(const f32x4*)(LP(I_RWGUP, 96 * 512) + (32 * q + j) * 512 + 64 * h + k4);
      asm volatile("" ::: "memory");
      { v4u o;
#pragma unroll
        for (int u = 0; u < 4; ++u) { const unsigned cww = cu[u], pww = pv[u]; const float c0 = __uint_as_float(cww << 16), c1 = __uint_as_float(cww & 0xffff0000u), q0 = __uint_as_float(pww << 16), q1 = __uint_as_float(pww & 0xffff0000u);
            const float mA = u < 2 ? m0[2 * u] : m1[2 * u - 4], mB = u < 2 ? m0[2 * u + 1] : m1[2 * u - 3];
            vv[2 * u] = c0 + (q0 - c0) * mA; vv[2 * u + 1] = c1 + (q1 - c1) * mB; o[u] = pk2(vv[2 * u], vv[2 * u + 1]); }
        *(LAS v4u*)(Vi + c * RW_LD + 8 * kg) = o; }
      { const f32x4 cv = unpack4(cw), pvv = unpack4(pw); f32x4 x;
#pragma unroll
        for (int u = 0; u < 4; ++u) x[u] = ftanh(cv[u] + (pvv[u] - cv[u]) * mw[u]);
        *(LAS u32x2*)(WLi + c * 40 + 4 * kg) = pack4(x); }
      { const f32x4 cv = unpack4(ca), pvv = unpack4(pa); f32x4 x;
#pragma unroll
        for (int u = 0; u < 4; ++u) x[u] = cv[u] + (pvv[u] - cv[u]) * ma[u];
        *(LAS u32x2*)(ALi + c * 40 + 4 * kg) = pack4(x); }
#pragma unroll
      for (int q = 0; q < 3; ++q) { const f32x4 cv = unpack4(cg[q]), pvv = unpack4(pg[q]); f32x4 x;
#pragma unroll
          for (int u = 0; u < 4; ++u) x[u] = sigmoid_f(cv[u] + (pvv[u] - cv[u]) * mg[q][u]);
          *(LAS u32x2*)(GLi + c * 104 + 12 * kg + 4 * q) = pack4(x); }
      *(LAS u32x2*)(WUPi + j * RW_LD + k4) = pack4(lwv); *(LAS u32x2*)(AUPi + j * RW_LD + k4) = pack4(lav);
#pragma unroll
      for (int q = 0; q < 3; ++q) *(LAS u32x2*)(GUPi + (32 * q + j) * RW_LD + k4) = pack4(lgv[q]); }
    WG_SYNC();
    if (stop <= 0) return;
    RW_IDX();
#pragma unroll
    for (int tt = 0; tt < 2; ++tt) { const int tile = 2 * w + tt, ik = tile >> 2, jc = tile & 3;
        f32x4 aw = {0.f, 0.f, 0.f, 0.f}, aa = aw, ag = aw;
        aw = mfma16(frag_tr(WUPi, RW_LD, 16 * ik, 0, lane), frag_row(WLi, 40, 16 * jc, 0, lane), aw);
        aa = mfma16(frag_tr(AUPi, RW_LD, 16 * ik, 0, lane), frag_row(ALi, 40, 16 * jc, 0, lane), aa);
#pragma unroll
        for (int k0 = 0; k0 < 96; k0 += 32) ag = mfma16(frag_tr(GUPi, RW_LD, 16 * ik, k0, lane), frag_row(GLi, 104, 16 * jc, k0, lane), ag);
        const int o = (16 * jc + r) * 64 + 16 * ik + 4 * g; *(LAS f32x4*)(LW + o) = aw; *(LAS f32x4*)(LA + o) = aa; *(LAS f32x4*)(LG + o) = ag; }
    WG_SYNC();
    if (stop <= 1) return;
    RW_IDX();
    p1 = PROJROW(t) + C_RW; p0 = p1 - PTP; hp = t > 0;
    float rr[8], kk[8], bb[8], kt[8], lwd[8], cum[8];
    { const int ch0 = 64 * h + 8 * kg; float ss = 0.f, rk = 0.f; float gt[8];
      const v4u cr = *(const v4u*)(p1 + ch0), ck = *(const v4u*)(p1 + 512 + ch0); v4u qr = {0u, 0u, 0u, 0u}, qk = qr; if (hp) { qr = *(const v4u*)(p0 + ch0); qk = *(const v4u*)(p0 + 512 + ch0); }
      float pw0[8], pa0[8], pkk[8], pka[8], prk[8], pmr[8], pmk[8];
#pragma unroll
      for (int q = 0; q < 2; ++q) { const f32x4 x0 = *(const f32x4*)(LP(I_RWW0, 512) + ch0 + 4 * q), x1 = *(const f32x4*)(LP(I_RWA0, 512) + ch0 + 4 * q), x2 = *(const f32x4*)(LP(I_RWKK, 512) + ch0 + 4 * q), x3 = *(const f32x4*)(LP(I_RWKA, 512) + ch0 + 4 * q),
                                                 x4 = *(const f32x4*)(LP(I_RWRK, 512) + ch0 + 4 * q), x5 = *(const f32x4*)(mu + ch0 + 4 * q), x6 = *(const f32x4*)(mu + 512 + ch0 + 4 * q);
#pragma unroll
          for (int e = 0; e < 4; ++e) { pw0[4 * q + e] = x0[e]; pa0[4 * q + e] = x1[e]; pkk[4 * q + e] = x2[e]; pka[4 * q + e] = x3[e]; prk[4 * q + e] = x4[e]; pmr[4 * q + e] = x5[e]; pmk[4 * q + e] = x6[e]; } }
#pragma unroll
      for (int u = 0; u < 8; ++u) { const unsigned crw = cr[u >> 1], ckw = ck[u >> 1], qrw = qr[u >> 1], qkw = qk[u >> 1];
          const float curR = (u & 1) ? __uint_as_float(crw & 0xffff0000u) : __uint_as_float(crw << 16), curK = (u & 1) ? __uint_as_float(ckw & 0xffff0000u) : __uint_as_float(ckw << 16);
          const float prvR = (u & 1) ? __uint_as_float(qrw & 0xffff0000u) : __uint_as_float(qrw << 16), prvK = (u & 1) ? __uint_as_float(qkw & 0xffff0000u) : __uint_as_float(qkw << 16);
          const float rv = curR + (prvR - curR) * pmr[u], kr = curK + (prvK - curK) * pmk[u];
          const float lw = LW[c * 64 + 8 * kg + u], la = LA[c * 64 + 8 * kg + u]; gt[u] = LG[c * 64 + 8 * kg + u];
          const float wraw = -fsoftplus(-(pw0[u] + lw)) - 0.5f; lwd[u] = -fexp(wraw);
          const float av = sigmoid_f(pa0[u] + la); const float kkr = kr * pkk[u]; kt[u] = kr * (1.0f + (av - 1.0f) * pka[u]);
          rr[u] = rv; kk[u] = kkr; bb[u] = av; ss += kkr * kkr; rk += rv * kt[u] * prk[u]; }
      ss += __shfl_xor(ss, 1); ss += __shfl_xor(ss, 2); ss += __shfl_xor(ss, 4); rk += __shfl_xor(rk, 1); rk += __shfl_xor(rk, 2); rk += __shfl_xor(rk, 4);
      const float inv = __builtin_amdgcn_rsqf(ss + 1e-6f);
#pragma unroll
      for (int u = 0; u < 8; ++u) { kk[u] *= inv; bb[u] *= kk[u]; }
#pragma unroll
      for (int u = 0; u < 8; ++u) { float x = lwd[u];
#pragma unroll
          for (int o = 8; o < 64; o <<= 1) { const float up = __shfl_up(x, o); if (lane >= o) x += up; }
          cum[u] = x; }
      if (lane >= 56) { *(LAS f32x4*)(WT + w * 64 + 8 * kg) = (f32x4){cum[0], cum[1], cum[2], cum[3]}; *(LAS f32x4*)(WT + w * 64 + 8 * kg + 4) = (f32x4){cum[4], cum[5], cum[6], cum[7]}; }
      v4u eo, go;
#pragma unroll
      for (int u = 0; u < 4; ++u) { eo[u] = pk2(rk * vv[2 * u], rk * vv[2 * u + 1]); go[u] = pk2(gt[2 * u], gt[2 * u + 1]); }
      bf16_t* Eo = (bf16_t*)(a.ws + WS_RW_E) + (size_t)tk * 4096; bf16_t* Go = (bf16_t*)(a.ws + WS_RW_GT) + (size_t)tk * 4096;
#pragma unroll
      for (int hf = 0; hf < 2; ++hf) { const int o = (((c >> 4) * 4 + (kg >> 1)) * 64 + ((2 * kg + hf) & 3) * 16 + (c & 15)) * 4;
          *(u32x2*)(Eo + o) = (u32x2){eo[2 * hf], eo[2 * hf + 1]}; *(u32x2*)(Go + o) = (u32x2){go[2 * hf], go[2 * hf + 1]}; } }
    WG_SYNC();
    if (stop <= 3) return;
    RW_IDX();
    { float cc[8];
#pragma unroll
      for (int u = 0; u < 8; ++u) cc[u] = 0.f;
#pragma unroll
      for (int ww = 0; ww < 8; ++ww) { const f32x4 t0 = *(const LAS f32x4*)(WT + ww * 64 + 8 * kg), t1 = *(const LAS f32x4*)(WT + ww * 64 + 8 * kg + 4);
#pragma unroll
          for (int e = 0; e < 4; ++e) { if (ww < w) { cum[e] += t0[e]; cum[4 + e] += t1[e]; } cc[e] += t0[e]; cc[4 + e] += t1[e]; } }
      if (c == 0) { *(LAS f32x4*)(CUMC + 8 * kg) = (f32x4){cc[0], cc[1], cc[2], cc[3]}; *(LAS f32x4*)(CUMC + 8 * kg + 4) = (f32x4){cc[4], cc[5], cc[6], cc[7]}; }
      v4u oRH, oBT, oKT, oKH, oBM, oKM;
#pragma unroll
      for (int u = 0; u < 8; u += 2) { float x[6][2];
#pragma unroll
          for (int e = 0; e < 2; ++e) { const float cu = cum[u + e]; const float ep = fexp(cu), em = fexp(-cu), et = fexp(cc[u + e] - cu), ex = fexp(cu - lwd[u + e]);
              x[0][e] = rr[u + e] * ep; x[1][e] = bb[u + e] * et; x[2][e] = kt[u + e] * et; x[3][e] = kk[u + e] * ex; x[4][e] = bb[u + e] * em; x[5][e] = kt[u + e] * em;
              RHST[(8 * kg + u + e) * 64 + c] = x[3][e]; }
          oRH[u >> 1] = pk2(x[0][0], x[0][1]); oBT[u >> 1] = pk2(x[1][0], x[1][1]); oKT[u >> 1] = pk2(x[2][0], x[2][1]); oKH[u >> 1] = pk2(x[3][0], x[3][1]); oBM[u >> 1] = pk2(x[4][0], x[4][1]); oKM[u >> 1] = pk2(x[5][0], x[5][1]); }
      const int o = c * RW_LD + 8 * kg;
      *(LAS v4u*)(RHi + o) = oRH; *(LAS v4u*)(BTi + o) = oBT; *(LAS v4u*)(KTi + o) = oKT; *(LAS v4u*)(KHi + o) = oKH; *(LAS v4u*)(BMi + o) = oBM; *(LAS v4u*)(KMi + o) = oKM; }
    WG_SYNC();
    if (stop <= 4) return;
    RW_IDX();
#pragma unroll
    for (int tt = 0; tt < 2; ++tt) { const int tile = 2 * w + tt, ii = tile >> 2, jt = tile & 3;
        f32x4 cA = {0.f, 0.f, 0.f, 0.f}, cB = cA, cPb = cA, cPk = cA;
        if (ii <= jt) {
#pragma unroll
            for (int k0 = 0; k0 < 64; k0 += 32) { const bf16x8 fbm = frag_row(BMi, RW_LD, 16 * ii, k0, lane), fkm = frag_row(KMi, RW_LD, 16 * ii, k0, lane), fkh = frag_row(KHi, RW_LD, 16 * jt, k0, lane), frh = frag_row(RHi, RW_LD, 16 * jt, k0, lane);
                cA = mfma16(fbm, fkh, cA); cB = mfma16(fkm, fkh, cB); cPb = mfma16(fbm, frh, cPb); cPk = mfma16(fkm, frh, cPk); }
#pragma unroll
            for (int e = 0; e < 4; ++e) { const int i = 16 * ii + 4 * g + e, tq = 16 * jt + r; if (!(i < tq)) { cA[e] = 0.f; cB[e] = 0.f; } if (!(i <= tq)) { cPb[e] = 0.f; cPk[e] = 0.f; } } }
        const int tq = 16 * jt + r, i0 = 16 * ii + 4 * g;
        *(LAS f32x4*)(AM + tq * 68 + i0) = cA; *(LAS u32x2*)(AI + tq * RW_LD + i0) = pack4(-cA); *(LAS u32x2*)(BMI + tq * RW_LD + i0) = pack4(cB); *(LAS u32x2*)(PBI + tq * RW_LD + i0) = pack4(cPb); *(LAS u32x2*)(PKI + tq * RW_LD + i0) = pack4(cPk); }
    WG_SYNC();
    if (stop <= 5) return;
    RW_IDX();
#pragma unroll
    for (int tt = 0; tt < 2; ++tt) { const int tile = 2 * w + tt, it = tile >> 2, jv = tile & 3; f32x4 acc = {0.f, 0.f, 0.f, 0.f};
#pragma unroll
        for (int k0 = 0; k0 < 64; k0 += 32) acc = mfma16(frag_row(BMI, RW_LD, 16 * it, k0, lane), frag_tr(Vi, RW_LD, 16 * jv, k0, lane), acc);
        *(LAS f32x4*)(RHST + (64 + 16 * jv + r) * 64 + 16 * it + 4 * g) = acc; }
    { const int q = c * 8 + kg;
      if (q < 64) { const int b = q >> 4, j = q & 15; float d[16], av[16][16];
#pragma unroll
          for (int tq = 1; tq < 16; ++tq)
#pragma unroll
              for (int i = 0; i < tq; ++i) av[tq][i] = AM[(16 * b + tq) * 68 + 16 * b + i];
#pragma unroll
          for (int tq = 0; tq < 16; ++tq) d[tq] = tq == j ? 1.f : 0.f;
#pragma unroll
          for (int i = 0; i < 15; ++i)
#pragma unroll
              for (int tq = i + 1; tq < 16; ++tq) d[tq] -= av[tq][i] * d[i];
#pragma unroll
          for (int tq = 0; tq < 16; ++tq) { DI[(b * 16 + tq) * 32 + j] = (bf16_t)f2bf(d[tq]); DI[(b * 16 + tq) * 32 + 16 + j] = (bf16_t)0; } }
      for (int i = q; i < 128 * RW_LD / 8; i += 512) *(LAS v4u*)(XI + 8 * i) = (v4u){0u, 0u, 0u, 0u};
      *(LAS v4u*)(UI + w * 512 + lane * 8) = (v4u){0u, 0u, 0u, 0u}; }
    WG_SYNC();
    if (stop <= 6) return;
    RW_IDX();
    { LAS bf16_t* Uw = UI + w * 512; LAS bf16_t* Xw = XI + (16 * w) * RW_LD;
#pragma unroll
      for (int b = 0; b < 4; ++b) { f32x4 acc = *(const LAS f32x4*)(RHST + (16 * w + r) * 64 + 16 * b + 4 * g);
#pragma unroll
          for (int k0 = 0; k0 < 16 * b; k0 += 32) acc = mfma16(frag_row(AI, RW_LD, 16 * b, k0, lane), frag_row(Xw, RW_LD, 0, k0, lane), acc);
          *(LAS u32x2*)(Uw + r * 32 + 4 * g) = pack4(acc);
          asm volatile("s_waitcnt lgkmcnt(0)" ::: "memory");
          f32x4 x = {0.f, 0.f, 0.f, 0.f}; x = mfma16(frag_row(DI + b * 512, 32, 0, 0, lane), frag_row(Uw, 32, 0, 0, lane), x);
          *(LAS u32x2*)(Xw + r * RW_LD + 16 * b + 4 * g) = pack4(x);
          asm volatile("s_waitcnt lgkmcnt(0)" ::: "memory"); } }
    WG_SYNC();
    if (stop <= 7) return;
    RW_IDX();
    { const int o = w >> 1; const LAS bf16_t* WHt = XI; const LAS bf16_t* XTt = XI + 64 * RW_LD;
#pragma unroll
      for (int tt = 0; tt < 8; ++tt) { const int tile = (w & 1) * 8 + tt, ti = tile >> 2, tj = tile & 3; f32x4 c1 = {0.f, 0.f, 0.f, 0.f}, c2 = c1;
          if (o == 0) {
#pragma unroll
              for (int k0 = 0; k0 < 64; k0 += 32) c1 = mfma16(frag_row(WHt, RW_LD, 16 * ti, k0, lane), frag_tr(BTi, RW_LD, 16 * tj, k0, lane), c1);
              const int kq = 16 * tj + r; const float dg = fexp(CUMC[kq]); f32x4 gv;
#pragma unroll
              for (int e = 0; e < 4; ++e) gv[e] = ((16 * ti + 4 * g + e) == kq ? dg : 0.f) - c1[e];
              *(u32x2*)((bf16_t*)(a.ws + WS_RW_G) + (size_t)tk * 4096 + fo_st(tj, 2, 16 * ti, g, r)) = pack4(gv);
          } else if (o == 1) {
#pragma unroll
              for (int k0 = 0; k0 < 64; k0 += 32) { c1 = mfma16(frag_tr(KTi, RW_LD, 16 * ti, k0, lane), frag_tr(Vi, RW_LD, 16 * tj, k0, lane), c1); c2 = mfma16(frag_tr(BTi, RW_LD, 16 * ti, k0, lane), frag_row(XTt, RW_LD, 16 * tj, k0, lane), c2); }
              *(u32x2*)((bf16_t*)(a.ws + WS_RW_Z) + (size_t)tk * 4096 + co_off(tj, 4, ti, lane)) = pack4(c1 - c2);
          } else if (o == 2) {
#pragma unroll
              for (int k0 = 0; k0 < 64; k0 += 32) c1 = mfma16(frag_row(WHt, RW_LD, 16 * ti, k0, lane), frag_row(PBI, RW_LD, 16 * tj, k0, lane), c1);
              const int tq = 16 * tj + r; const f32x4 rh = unpack4(*(const LAS u32x2*)(RHi + tq * RW_LD + 16 * ti + 4 * g));
              *(u32x2*)((bf16_t*)(a.ws + WS_RW_QT) + (size_t)tk * 4096 + fo_st(tj, 2, 16 * ti, g, r)) = pack4(rh - c1);
          } else {
#pragma unroll
              for (int k0 = 0; k0 < 64; k0 += 32) { c1 = mfma16(frag_tr(Vi, RW_LD, 16 * ti, k0, lane), frag_row(PKI, RW_LD, 16 * tj, k0, lane), c1); c2 = mfma16(frag_row(XTt, RW_LD, 16 * ti, k0, lane), frag_row(PBI, RW_LD, 16 * tj, k0, lane), c2); }
              *(u32x2*)((bf16_t*)(a.ws + WS_RW_YI) + (size_t)tk * 4096 + co_off(tj, 4, ti, lane)) = pack4(c1 - c2);
          } } }
    WG_SYNC();
#undef RW_IDX
}
__device__ __forceinline__ void rw_stage2(CArgs& a, int h, int vs, LAS unsigned char* lds, int tid) {
    const int lane = tid & 63, w = __builtin_amdgcn_readfirstlane(tid >> 6), r = lane & 15, g = lane >> 4;
    LAS bf16_t* Si = (LAS bf16_t*)lds;
    const bf16_t* G = (const bf16_t*)(a.ws + WS_RW_G); const bf16_t* Z = (const bf16_t*)(a.ws + WS_RW_Z); bf16_t* S = (bf16_t*)(a.ws + WS_RW_S);
    if (w < 4) { *(LAS u32x2*)(Si + r * RW_LD + 16 * w + 4 * g) = (u32x2){0u, 0u}; *(u32x2*)(S + (size_t)h * 4096 + fo_st(vs, 2, 16 * w, g, r)) = (u32x2){0u, 0u}; }
    WG_SYNC();
    constexpr int PD = 8; const int wq = w & 3; const int so = fo_st(vs, 2, 16 * wq, g, r), zo = co_off(vs, 4, wq, lane);
    bf16x8 gf[PD][2]; u32x2 zf[PD];
#pragma unroll
    for (int u = 0; u < PD; ++u) { const size_t tk = (size_t)u * 8 + h; zf[u] = *(const u32x2*)(Z + tk * 4096 + zo); gf[u][0] = frag_fo(G + tk * 4096, 2, wq, 0, lane); gf[u][1] = frag_fo(G + tk * 4096, 2, wq, 1, lane); }
#define RW_STEP(n_, u_, REFILL) do { const int n = (n_); const size_t tk = (size_t)n * 8 + h; const int cur = n & 1; \
            f32x4 acc = unpack4(zf[u_]), acc2 = {0.f, 0.f, 0.f, 0.f}; \
            acc = mfma16(gf[u_][0], frag_row(Si + cur * 16 * RW_LD, RW_LD, 0, 0, lane), acc); acc2 = mfma16(gf[u_][1], frag_row(Si + cur * 16 * RW_LD, RW_LD, 0, 32, lane), acc2); \
            if (REFILL) { const int nn = n + PD < NCH - 1 ? n + PD : NCH - 2; const size_t tn = (size_t)nn * 8 + h; zf[u_] = *(const u32x2*)(Z + tn * 4096 + zo); gf[u_][0] = frag_fo(G + tn * 4096, 2, wq, 0, lane); gf[u_][1] = frag_fo(G + tn * 4096, 2, wq, 1, lane); } \
            const u32x2 pv = pack4(acc + acc2); \
            if (w < 4) { *(LAS u32x2*)(Si + (cur ^ 1) * 16 * RW_LD + r * RW_LD + 16 * wq + 4 * g) = pv; *(u32x2*)(S + (tk + 8) * 4096 + so) = pv; } \
            asm volatile("s_waitcnt lgkmcnt(0)" ::: "memory"); __builtin_amdgcn_s_barrier(); asm volatile("" ::: "memory"); } while (0)
#pragma unroll
    for (int nq = 0; nq < NCH - 1; ++nq) RW_STEP(nq, nq % PD, nq + PD < NCH - 1);
#undef RW_STEP
}
__device__ __forceinline__ void rw_stage3(CArgs& a, int l, int n, int h, LAS unsigned char* lds, int tid) {
    const int lane = tid & 63, w = __builtin_amdgcn_readfirstlane(tid >> 6), r = lane & 15, g = lane >> 4, jc = w & 3, wh = w >> 2;
    const size_t tk = (size_t)n * 8 + h; const int c = 16 * jc + r, t = n * 64 + c;
    const bf16_t* S = (const bf16_t*)(a.ws + WS_RW_S) + tk * 4096; const bf16_t* QT = (const bf16_t*)(a.ws + WS_RW_QT) + tk * 4096; const bf16_t* YI = (const bf16_t*)(a.ws + WS_RW_YI) + tk * 4096;
    LAS float* xs = (LAS float*)lds;
    f32x4 acc[2];
#pragma unroll
    for (int tt = 0; tt < 2; ++tt) { const int iv = 2 * wh + tt; acc[tt] = unpack4(*(const u32x2*)(YI + co_off(jc, 4, iv, lane)));
#pragma unroll
        for (int k = 0; k < 2; ++k) acc[tt] = mfma16(frag_fo(S, 2, iv, k, lane), frag_fo(QT, 2, jc, k, lane), acc[tt]); }
    float s1 = (acc[0][0] + acc[0][1]) + (acc[0][2] + acc[0][3]) + (acc[1][0] + acc[1][1]) + (acc[1][2] + acc[1][3]);
    s1 += __shfl_xor(s1, 16); s1 += __shfl_xor(s1, 32);
    if (g == 0) xs[w * 16 + r] = s1;
    WG_SYNC();
    const float mu = (s1 + xs[(w ^ 4) * 16 + r]) * (1.0f / 64.0f); float s2 = 0.f;
#pragma unroll
    for (int tt = 0; tt < 2; ++tt)
#pragma unroll
        for (int e = 0; e < 4; ++e) { acc[tt][e] -= mu; s2 += acc[tt][e] * acc[tt][e]; }
    s2 += __shfl_xor(s2, 16); s2 += __shfl_xor(s2, 32);
    if (g == 0) xs[128 + w * 16 + r] = s2;
    WG_SYNC();
    const float rs = 1.0f / sqrtf((s2 + xs[128 + (w ^ 4) * 16 + r]) * (1.0f / 64.0f) + 64e-5f);
    const bf16_t* E = (const bf16_t*)(a.ws + WS_RW_E) + tk * 4096; const bf16_t* GT = (const bf16_t*)(a.ws + WS_RW_GT) + tk * 4096;
    bf16_t* O = (bf16_t*)(a.ws + WS_O) + (size_t)t * D + 1536 + h * 64;
#pragma unroll
    for (int tt = 0; tt < 2; ++tt) { const int v0 = 16 * (2 * wh + tt) + 4 * g; const int eo_ = co_off(jc, 4, 2 * wh + tt, lane); const f32x4 ev = unpack4(*(const u32x2*)(E + eo_)), gv = unpack4(*(const u32x2*)(GT + eo_));
        const f32x4 lw = *(const f32x4*)(LP(I_RWLNW, 512) + h * 64 + v0), lb = *(const f32x4*)(LP(I_RWLNB, 512) + h * 64 + v0); f32x4 y;
#pragma unroll
        for (int e = 0; e < 4; ++e) y[e] = (acc[tt][e] * rs * lw[e] + lb[e] + ev[e]) * gv[e];
        *(u32x2*)(O + v0) = pack4(y); }
    WG_SYNC();
}

constexpr int M2_LDS = 136, M2_LDX = 264, M2O_B = 0, M2O_C = 17408, M2O_X = 34816, M2O_XW = 68608, M2O_M = 102400, M2O_DT = 139264, M2O_G = 140288, M2O_GL = 141312;
__device__ __forceinline__ void m2_stage1(CArgs& a, int l, int n, int gr, LAS unsigned char* lds, int tid) {
    const int lane = tid & 63, w = __builtin_amdgcn_readfirstlane(tid >> 6), r = lane & 15, g = lane >> 4;
    LAS bf16_t* Bi = (LAS bf16_t*)(lds + M2O_B); LAS bf16_t* Ci = (LAS bf16_t*)(lds + M2O_C); LAS bf16_t* Xi = (LAS bf16_t*)(lds + M2O_X); LAS bf16_t* XWi = (LAS bf16_t*)(lds + M2O_XW); LAS bf16_t* Mi = (LAS bf16_t*)(lds + M2O_M);
    LAS float* DT = (LAS float*)(lds + M2O_DT); LAS float* GC = (LAS float*)(lds + M2O_G); LAS float* GLAST = (LAS float*)(lds + M2O_GL);
    const int t0 = n * 64;
    LAS bf16_t* RAW = (LAS bf16_t*)(lds + M2O_XW);
    { v4u sv[9];
#pragma unroll
      for (int i = 0; i < 9; ++i) { const int idx = tid + 512 * i, row = idx >> 6, ch = idx & 63, t = t0 - 3 + row; sv[i] = (v4u){0u, 0u, 0u, 0u};
          const int col = ch < 32 ? gr * 256 + 8 * ch : (ch < 48 ? 512 + gr * 128 + 8 * (ch - 32) : 768 + gr * 128 + 8 * (ch - 48));
          if (idx < 67 * 64 && t >= 0) sv[i] = *(const v4u*)(PROJROW(t) + C_MXBC + col); }
#pragma unroll
      for (int i = 0; i < 9; ++i) { const int idx = tid + 512 * i; if (idx < 67 * 64) *(LAS v4u*)(RAW + (idx >> 6) * 512 + 8 * (idx & 63)) = sv[i]; } }
    WG_SYNC();
    for (int it = tid; it < 512 * 4; it += 512) { const int lc = it & 511, seg = it >> 9; int col; LAS bf16_t* dst; int dld;
      if (lc < 256) { col = gr * 256 + lc; dst = Xi + lc; dld = M2_LDX; } else if (lc < 384) { col = 512 + gr * 128 + (lc - 256); dst = Bi + (lc - 256); dld = M2_LDS; } else { col = 768 + gr * 128 + (lc - 384); dst = Ci + (lc - 384); dld = M2_LDS; }
      const float* cw = LP(I_MCONV, 4 * 1024) + col; const float w0 = cw[0], w1 = cw[1024], w2 = cw[2048], w3 = cw[3072], cb = LP(I_MCONVB, 1024)[col];
      const LAS bf16_t* src = RAW + (16 * seg) * 512 + lc;
      float x0 = bf2f(src[0]), x1 = bf2f(src[512]), x2 = bf2f(src[1024]);
#pragma unroll
      for (int cc = 0; cc < 16; ++cc) { const float x3 = bf2f(src[(cc + 3) * 512]); const float y = silu_f(w0 * x0 + w1 * x1 + w2 * x2 + w3 * x3 + cb); dst[(16 * seg + cc) * dld] = (bf16_t)f2bf(y); x0 = x1; x1 = x2; x2 = x3; } }
    if (tid < 256) { const int c = tid >> 2, hh = tid & 3, hd = gr * 4 + hh; const float dt = softplus_f(bf2f(PROJROW(t0 + c)[C_MDT + hd]) + LP(I_MDTB, 8)[hd]); DT[c * 4 + hh] = dt; GC[c * 4 + hh] = -fexp(LP(I_MALOG, 8)[hd]) * dt; }
    WG_SYNC();
    if (tid < 4) { float cu = 0.f; for (int c = 0; c < 64; ++c) { cu += GC[c * 4 + tid]; GC[c * 4 + tid] = cu; } GLAST[tid] = cu; WSF(WS_M2_DEC)[n * 8 + gr * 4 + tid] = fexp(cu); }
    WG_SYNC();
    { const int c = tid >> 3, q = tid & 7;
      const int hh = q >> 1; const float sc = DT[c * 4 + hh] * fexp(GLAST[hh] - GC[c * 4 + hh]);
#pragma unroll
      for (int u = 0; u < 4; ++u) { const v4u xv = *(const LAS v4u*)(Xi + c * M2_LDX + 32 * q + 8 * u); v4u o;
#pragma unroll
          for (int e = 0; e < 4; ++e) o[e] = pk2(__uint_as_float(xv[e] << 16) * sc, __uint_as_float(xv[e] & 0xffff0000u) * sc);
          *(LAS v4u*)(XWi + c * M2_LDX + 32 * q + 8 * u) = o; }
      const float eg = fexp(GC[c * 4 + hh]); bf16_t* QH = (bf16_t*)(a.ws + WS_M2_QH) + (size_t)(n * 8 + gr * 4 + hh) * 8192;
#pragma unroll
      for (int u = 0; u < 8; ++u) { const v4u cv = *(const LAS v4u*)(Ci + c * M2_LDS + 64 * (q & 1) + 8 * u); v4u o;
#pragma unroll
          for (int e = 0; e < 4; ++e) o[e] = pk2(__uint_as_float(cv[e] << 16) * eg, __uint_as_float(cv[e] & 0xffff0000u) * eg);
          { const int s0 = 64 * (q & 1) + 8 * u; *(v4u*)(QH + (((c >> 4) * 4 + (s0 >> 5)) * 64 + ((s0 >> 3) & 3) * 16 + (c & 15)) * 8) = o; } } }
#pragma unroll
    for (int tt = 0; tt < 2; ++tt) { const int tile = 2 * w + tt, im = tile >> 2, jc = tile & 3; f32x4 acc = {0.f, 0.f, 0.f, 0.f};
        if (jc >= im) {
#pragma unroll
            for (int k0 = 0; k0 < 128; k0 += 32) acc = mfma16(frag_row(Bi, M2_LDS, 16 * im, k0, lane), frag_row(Ci, M2_LDS, 16 * jc, k0, lane), acc); }
        const int cq = 16 * jc + r;
#pragma unroll
        for (int hh = 0; hh < 4; ++hh) { f32x4 mv; const float gc = GC[cq * 4 + hh];
#pragma unroll
            for (int e = 0; e < 4; ++e) { const int m = 16 * im + 4 * g + e; mv[e] = cq >= m ? acc[e] * fexp(gc - GC[m * 4 + hh]) * DT[m * 4 + hh] : 0.f; }
            *(LAS u32x2*)(Mi + hh * 64 * 72 + cq * 72 + 16 * im + 4 * g) = pack4(mv); } }
    WG_SYNC();
    { const int hh = w >> 1, hd = gr * 4 + hh; const size_t tk = (size_t)n * 8 + hd; const float Dh = LP(I_MD, 8)[hd];
      bf16_t* YI = (bf16_t*)(a.ws + WS_M2_YI) + tk * 4096; bf16_t* Z = (bf16_t*)(a.ws + WS_M2_Z) + tk * 8192;
#pragma unroll
      for (int tt = 0; tt < 8; ++tt) { const int tile = (w & 1) * 8 + tt, ip = tile >> 2, jc = tile & 3; f32x4 acc = {0.f, 0.f, 0.f, 0.f};
#pragma unroll
          for (int k0 = 0; k0 < 64; k0 += 32) acc = mfma16(frag_tr(Xi, M2_LDX, 64 * hh + 16 * ip, k0, lane), frag_row(Mi + hh * 64 * 72, 72, 16 * jc, k0, lane), acc);
          const int cq = 16 * jc + r; const f32x4 xv = unpack4(*(const LAS u32x2*)(Xi + cq * M2_LDX + 64 * hh + 16 * ip + 4 * g));
          *(u32x2*)(YI + co_off(jc, 4, ip, lane)) = pack4(acc + xv * Dh); }
#pragma unroll
      for (int tt = 0; tt < 16; ++tt) { const int tile = (w & 1) * 16 + tt, is = tile >> 2, jp = tile & 3; f32x4 acc = {0.f, 0.f, 0.f, 0.f};
#pragma unroll
          for (int k0 = 0; k0 < 64; k0 += 32) acc = mfma16(frag_tr(Bi, M2_LDS, 16 * is, k0, lane), frag_tr(XWi, M2_LDX, 64 * hh + 16 * jp, k0, lane), acc);
          *(u32x2*)(Z + fo_st(jp, 4, 16 * is, g, r)) = pack4(acc); } }
    WG_SYNC();
}
__device__ __forceinline__ void m2_stage2(CArgs& a, int b, int tid) {
    const int idx = b * 512 + tid, hd = idx >> 13, rem = idx & 8191;
    const bf16_t* Z = (const bf16_t*)(a.ws + WS_M2_Z) + (size_t)hd * 8192 + rem; bf16_t* S = (bf16_t*)(a.ws + WS_M2_S) + (size_t)hd * 8192 + rem; const float* DEC = WSF(WS_M2_DEC) + hd; float s = 0.f;
#pragma unroll 32
    for (int n = 0; n < NCH; ++n) { const float z = bf2f(Z[(size_t)n * 8 * 8192]), dc = DEC[n * 8]; S[(size_t)n * 8 * 8192] = (bf16_t)f2bf(s); s = dc * s + z; }
}
__device__ __forceinline__ void m2_stage3(CArgs& a, int l, int n, int gr, LAS unsigned char* lds, int tid) {
    const int lane = tid & 63, w = __builtin_amdgcn_readfirstlane(tid >> 6), r = lane & 15, g = lane >> 4, hh = w >> 1, hd = gr * 4 + hh;
    const size_t tk = (size_t)n * 8 + hd;
    const bf16_t* S = (const bf16_t*)(a.ws + WS_M2_S) + tk * 8192; const bf16_t* QH = (const bf16_t*)(a.ws + WS_M2_QH) + tk * 8192; const bf16_t* YI = (const bf16_t*)(a.ws + WS_M2_YI) + tk * 4096;
    LAS float* xs = (LAS float*)lds;
    f32x4 acc[2][4]; float ss[2];
#pragma unroll
    for (int cj = 0; cj < 2; ++cj) { const int jc = 2 * (w & 1) + cj, c = 16 * jc + r, t = n * 64 + c; const bf16_t* pz = PROJROW(t) + C_MZ + hd * 64; ss[cj] = 0.f;
#pragma unroll
        for (int ip = 0; ip < 4; ++ip) { acc[cj][ip] = unpack4(*(const u32x2*)(YI + co_off(jc, 4, ip, lane)));
#pragma unroll
            for (int k = 0; k < 4; ++k) acc[cj][ip] = mfma16(frag_fo(S, 4, ip, k, lane), frag_fo(QH, 4, jc, k, lane), acc[cj][ip]);
            const f32x4 zv = unpack4(*(const u32x2*)(pz + 16 * ip + 4 * g));
#pragma unroll
            for (int e = 0; e < 4; ++e) { acc[cj][ip][e] *= silu_f(zv[e]); ss[cj] += acc[cj][ip][e] * acc[cj][ip][e]; } }
        ss[cj] += __shfl_xor(ss[cj], 16); ss[cj] += __shfl_xor(ss[cj], 32);
        if (g == 0) xs[w * 32 + cj * 16 + r] = ss[cj]; }
    WG_SYNC();
#pragma unroll
    for (int cj = 0; cj < 2; ++cj) { const int jc = 2 * (w & 1) + cj, c = 16 * jc + r, t = n * 64 + c;
        const float tot = xs[((w & 1) + 0) * 32 + cj * 16 + r] + xs[((w & 1) + 2) * 32 + cj * 16 + r] + xs[((w & 1) + 4) * 32 + cj * 16 + r] + xs[((w & 1) + 6) * 32 + cj * 16 + r];
        const float rs = 1.0f / sqrtf(tot * (1.0f / 256.0f) + 1e-6f);
        const float* nw = LP(I_MNORM, 512) + hd * 64; bf16_t* O = (bf16_t*)(a.ws + WS_O) + (size_t)t * D + 1024 + hd * 64;
#pragma unroll
        for (int ip = 0; ip < 4; ++ip) { const f32x4 wv = *(const f32x4*)(nw + 16 * ip + 4 * g); f32x4 y;
#pragma unroll
            for (int e = 0; e < 4; ++e) y[e] = acc[cj][ip][e] * rs * wv[e];
            *(u32x2*)(O + 16 * ip + 4 * g) = pack4(y); } }
    WG_SYNC();
}

constexpr int GD_LD = 136;
constexpr int GDO_K = 0, GDO_V = 17408, GDO_KT = 34816, GDO_QG = 52224, GDO_Q = 69632, GDO_AI = 87040, GDO_AMD = 96256, GDO_DI = 100352, GDO_AQ = 104448, GDO_XI = 113664, GDO_QF = 87040, GDO_KF = 119808, GDO_SM = 152576, GDO_UI = 153600;
__device__ __forceinline__ void gd_stage1(CArgs& a, int l, int n, int h, LAS unsigned char* lds, int tid, const int stop = 99) {
    const int w = __builtin_amdgcn_readfirstlane(tid >> 6), tk = n * 4 + h, t0 = n * 64;
    int lane, r, g, c, q8;
#define GD_IDX() do { int tl_ = tid; asm volatile("" : "+v"(tl_)); lane = tl_ & 63; r = lane & 15; g = lane >> 4; c = tl_ >> 3; q8 = tl_ & 7; } while (0)
    LAS bf16_t* Ki = (LAS bf16_t*)(lds + GDO_K); LAS bf16_t* Vi = (LAS bf16_t*)(lds + GDO_V); LAS bf16_t* KTi = (LAS bf16_t*)(lds + GDO_KT); LAS bf16_t* QGi = (LAS bf16_t*)(lds + GDO_QG); LAS bf16_t* Qi = (LAS bf16_t*)(lds + GDO_Q);
    LAS bf16_t* AI = (LAS bf16_t*)(lds + GDO_AI);
    LAS float* AMD = (LAS float*)(lds + GDO_AMD);
    LAS bf16_t* DI = (LAS bf16_t*)(lds + GDO_DI);
    LAS bf16_t* AQ = (LAS bf16_t*)(lds + GDO_AQ);
    LAS bf16_t* XI = (LAS bf16_t*)(lds + GDO_XI);
    LAS bf16_t* UI = (LAS bf16_t*)(lds + GDO_UI);
    LAS float* QF = (LAS float*)(lds + GDO_QF); LAS float* KF = (LAS float*)(lds + GDO_KF);
    LAS float* BETA = (LAS float*)(lds + GDO_SM); LAS float* GC = BETA + 64; LAS float* BG = GC + 64;
    LAS bf16_t* RAW = (LAS bf16_t*)(lds + GDO_KT);
    { v4u sv[7];
#pragma unroll
      for (int i = 0; i < 7; ++i) { const int idx = tid + 512 * i, row = idx / 48, ch = idx % 48, which = ch >> 4, t = t0 - 3 + row; sv[i] = (v4u){0u, 0u, 0u, 0u};
          if (idx < 67 * 48 && t >= 0) sv[i] = *(const v4u*)(PROJROW(t) + C_GQ + which * 512 + h * 128 + 8 * (ch & 15)); }
#pragma unroll
      for (int i = 0; i < 7; ++i) { const int idx = tid + 512 * i; if (idx < 67 * 48) *(LAS v4u*)(RAW + (idx / 48) * 384 + 8 * (idx % 48)) = sv[i]; } }
    WG_SYNC();
    for (int it = tid; it < 384 * 4; it += 512) { const int col = it % 384, seg = it / 384, which = col >> 7, dcol = col & 127, cwi = which * 512 + h * 128 + dcol;
        const float* cw = LP(I_GCONV, 4 * 1536) + cwi; const float w0 = cw[0], w1 = cw[1536], w2 = cw[3072], w3 = cw[4608];
        const LAS bf16_t* src = RAW + (16 * seg) * 384 + col;
        float x0 = bf2f(src[0]), x1 = bf2f(src[384]), x2 = bf2f(src[768]);
#pragma unroll
        for (int cc = 0; cc < 16; ++cc) { const float x3 = bf2f(src[(cc + 3) * 384]); const float y = silu_f(w0 * x0 + w1 * x1 + w2 * x2 + w3 * x3); const int tok = 16 * seg + cc;
            if (which == 2) Vi[tok * GD_LD + dcol] = (bf16_t)f2bf(y); else (which == 0 ? QF : KF)[tok * 128 + dcol] = y;
            x0 = x1; x1 = x2; x2 = x3; } }
    if (tid >= 384 && tid < 448) { const int cc = tid - 384; const bf16_t* pr = PROJROW(t0 + cc);
        const float beta = sigmoid_f(bf2f(pr[C_GB + h])); float cu = -fexp(LP(I_GALOG, 4)[h]) * softplus_f(bf2f(pr[C_GA + h]) + LP(I_GDTB, 4)[h]);
#pragma unroll
        for (int o = 1; o < 64; o <<= 1) { const float up = __shfl_up(cu, o); if (cc >= o) cu += up; }
        BETA[cc] = beta; GC[cc] = cu; BG[cc] = beta * fexp(cu); }
    WG_SYNC();
    GD_IDX();
    if (stop <= 0) return;
    { float qv[16], kv[16]; float sq = 0.f, sk = 0.f;
#pragma unroll
      for (int u = 0; u < 4; ++u) { const f32x4 a4 = *(const LAS f32x4*)(QF + c * 128 + 16 * q8 + 4 * u), b4 = *(const LAS f32x4*)(KF + c * 128 + 16 * q8 + 4 * u);
#pragma unroll
          for (int e = 0; e < 4; ++e) { qv[4 * u + e] = a4[e]; kv[4 * u + e] = b4[e]; sq += a4[e] * a4[e]; sk += b4[e] * b4[e]; } }
      sq += __shfl_xor(sq, 1); sq += __shfl_xor(sq, 2); sq += __shfl_xor(sq, 4); sk += __shfl_xor(sk, 1); sk += __shfl_xor(sk, 2); sk += __shfl_xor(sk, 4);
      const float gc = GC[c], iq = (1.0f / sqrtf(sq + 1e-6f)) * 0.08838834764831845f, ik = 1.0f / sqrtf(sk + 1e-6f), et = fexp(GC[63] - gc), eg = fexp(gc);
      v4u oK[2], oQ[2], oKT[2], oQG[2];
#pragma unroll
      for (int u = 0; u < 8; ++u) { const float k0 = kv[2 * u] * ik, k1 = kv[2 * u + 1] * ik, q0 = qv[2 * u] * iq, q1 = qv[2 * u + 1] * iq;
          oK[u >> 2][u & 3] = pk2(k0, k1); oQ[u >> 2][u & 3] = pk2(q0, q1); oKT[u >> 2][u & 3] = pk2(k0 * et, k1 * et); oQG[u >> 2][u & 3] = pk2(q0 * eg, q1 * eg); }
      const int o = c * GD_LD + 16 * q8;
      *(LAS v4u*)(Ki + o) = oK[0]; *(LAS v4u*)(Ki + o + 8) = oK[1]; *(LAS v4u*)(Qi + o) = oQ[0]; *(LAS v4u*)(Qi + o + 8) = oQ[1];
      *(LAS v4u*)(KTi + o) = oKT[0]; *(LAS v4u*)(KTi + o + 8) = oKT[1]; *(LAS v4u*)(QGi + o) = oQG[0]; *(LAS v4u*)(QGi + o + 8) = oQG[1]; }
    WG_SYNC();
    GD_IDX();
    if (stop <= 1) return;
#pragma unroll
    for (int tt = 0; tt < 2; ++tt) { const int tile = 2 * w + tt, im = tile >> 2, jc = tile & 3; f32x4 c1 = {0.f, 0.f, 0.f, 0.f}, c2 = c1;
        if (jc >= im) {
#pragma unroll
            for (int k0 = 0; k0 < 128; k0 += 32) { const bf16x8 fa = frag_row(Ki, GD_LD, 16 * im, k0, lane); c1 = mfma16(fa, frag_row(Ki, GD_LD, 16 * jc, k0, lane), c1); c2 = mfma16(fa, frag_row(Qi, GD_LD, 16 * jc, k0, lane), c2); }
            const int cq = 16 * jc + r; const float gc = GC[cq], bc = BETA[cq];
#pragma unroll
            for (int e = 0; e < 4; ++e) { const int m = 16 * im + 4 * g + e; const float dc = fexp(gc - GC[m]); c1[e] = m < cq ? c1[e] * dc * bc : 0.f; c2[e] = m <= cq ? c2[e] * dc : 0.f; } }
        const int cq = 16 * jc + r; *(LAS u32x2*)(AI + cq * 72 + 16 * im + 4 * g) = pack4(-c1); *(LAS u32x2*)(AQ + cq * 72 + 16 * im + 4 * g) = pack4(c2);
        if (im == jc) *(LAS f32x4*)(AMD + (im * 16 + r) * 16 + 4 * g) = c1; }
    WG_SYNC();
    GD_IDX();
    if (stop <= 2) return;
    { const int q = c * 8 + q8;
      if (q < 64) { const int b = q >> 4, j = q & 15; float d[16], av[16][16];
#pragma unroll
          for (int tq = 1; tq < 16; ++tq)
#pragma unroll
              for (int i = 0; i < tq; ++i) av[tq][i] = AMD[(b * 16 + tq) * 16 + i];
#pragma unroll
          for (int tq = 0; tq < 16; ++tq) d[tq] = tq == j ? 1.f : 0.f;
#pragma unroll
          for (int i = 0; i < 15; ++i)
#pragma unroll
              for (int tq = i + 1; tq < 16; ++tq) d[tq] -= av[tq][i] * d[i];
#pragma unroll
          for (int tq = 0; tq < 16; ++tq) { DI[(b * 16 + tq) * 32 + j] = (bf16_t)f2bf(d[tq]); DI[(b * 16 + tq) * 32 + 16 + j] = (bf16_t)0; } }
      for (int i = q; i < 256 * 72 / 8; i += 512) *(LAS v4u*)(XI + 8 * i) = (v4u){0u, 0u, 0u, 0u};
      *(LAS v4u*)(UI + w * 512 + lane * 8) = (v4u){0u, 0u, 0u, 0u}; }
    WG_SYNC();
    GD_IDX();
    if (stop <= 3) return;
    { LAS bf16_t* Uw = UI + w * 512;
#pragma unroll
      for (int tt = 0; tt < 2; ++tt) { const int nt = 2 * w + tt; LAS bf16_t* Xw = XI + (16 * nt) * 72;
          const LAS bf16_t* src = nt < 8 ? Vi + 16 * nt + r : Ki + 16 * (nt - 8) + r; const LAS float* scl = nt < 8 ? BETA : BG;
#pragma unroll
          for (int b = 0; b < 4; ++b) { const f32x4 sc = *(const LAS f32x4*)(scl + 16 * b + 4 * g); f32x4 acc;
#pragma unroll
              for (int e = 0; e < 4; ++e) acc[e] = bf2f(src[(16 * b + 4 * g + e) * GD_LD]) * sc[e];
#pragma unroll
              for (int k0 = 0; k0 < 16 * b; k0 += 32) acc = mfma16(frag_row(AI, 72, 16 * b, k0, lane), frag_row(Xw, 72, 0, k0, lane), acc);
              *(LAS u32x2*)(Uw + r * 32 + 4 * g) = pack4(acc);
              asm volatile("s_waitcnt lgkmcnt(0)" ::: "memory");
              f32x4 x = {0.f, 0.f, 0.f, 0.f}; x = mfma16(frag_row(DI + b * 512, 32, 0, 0, lane), frag_row(Uw, 32, 0, 0, lane), x);
              *(LAS u32x2*)(Xw + r * 72 + 16 * b + 4 * g) = pack4(x);
              asm volatile("s_waitcnt lgkmcnt(0)" ::: "memory"); } } }
    WG_SYNC();
    GD_IDX();
    if (stop <= 4) return;
    { const int jc = w & 3, wh = w >> 2; const int cq = 16 * jc + r;
      bf16_t* QT = (bf16_t*)(a.ws + WS_GD_QT) + (size_t)tk * 8192; bf16_t* YI = (bf16_t*)(a.ws + WS_GD_YI) + (size_t)tk * 8192; bf16_t* GG = (bf16_t*)(a.ws + WS_GD_G) + (size_t)tk * 16384; bf16_t* Z = (bf16_t*)(a.ws + WS_GD_Z) + (size_t)tk * 16384;
#pragma unroll
      for (int tt = 0; tt < 4; ++tt) { const int id = 4 * wh + tt; f32x4 c1 = {0.f, 0.f, 0.f, 0.f}, c2 = c1;
#pragma unroll
          for (int k0 = 0; k0 < 64; k0 += 32) { const bf16x8 fb = frag_row(AQ, 72, 16 * jc, k0, lane); c1 = mfma16(frag_row(XI + 128 * 72, 72, 16 * id, k0, lane), fb, c1); c2 = mfma16(frag_row(XI, 72, 16 * id, k0, lane), fb, c2); }
          const f32x4 qg = unpack4(*(const LAS u32x2*)(QGi + cq * GD_LD + 16 * id + 4 * g));
          *(u32x2*)(QT + fo_st(jc, 4, 16 * id, g, r)) = pack4(qg - c1); *(u32x2*)(YI + co_off(jc, 8, id, lane)) = pack4(c2); }
      const float e63 = fexp(GC[63]);
#pragma unroll
      for (int ti = 0; ti < 8; ++ti) { f32x4 c1 = {0.f, 0.f, 0.f, 0.f}, c2 = c1;
#pragma unroll
          for (int k0 = 0; k0 < 64; k0 += 32) { c1 = mfma16(frag_row(XI + 128 * 72, 72, 16 * ti, k0, lane), frag_tr(KTi, GD_LD, 16 * w, k0, lane), c1); c2 = mfma16(frag_tr(KTi, GD_LD, 16 * ti, k0, lane), frag_row(XI, 72, 16 * w, k0, lane), c2); }
          const int dq = 16 * w + r; f32x4 gv;
#pragma unroll
          for (int e = 0; e < 4; ++e) gv[e] = ((16 * ti + 4 * g + e) == dq ? e63 : 0.f) - c1[e];
          *(u32x2*)(GG + fo_st(w, 4, 16 * ti, g, r)) = pack4(gv); *(u32x2*)(Z + co_off(w, 8, ti, lane)) = pack4(c2); } }
    WG_SYNC();
#undef GD_IDX
}
__device__ __forceinline__ void gd_stage2(CArgs& a, int h, int es, LAS unsigned char* lds, int tid, const int var = 0) {
    const int lane = tid & 63, w = __builtin_amdgcn_readfirstlane(tid >> 6), r = lane & 15, g = lane >> 4;
    LAS bf16_t* Si = (LAS bf16_t*)lds;
    const bf16_t* G = (const bf16_t*)(a.ws + WS_GD_G); const bf16_t* Z = (const bf16_t*)(a.ws + WS_GD_Z); bf16_t* S = (bf16_t*)(a.ws + WS_GD_S);
    const int so = fo_st(es, 4, 16 * w, g, r), zo = co_off(es, 8, w, lane);
    *(LAS u32x2*)(Si + r * GD_LD + 16 * w + 4 * g) = (u32x2){0u, 0u}; *(u32x2*)(S + (size_t)h * 16384 + so) = (u32x2){0u, 0u};
    WG_SYNC();
    constexpr int PD = 8;
    bf16x8 gf[PD][4]; u32x2 zf[PD];
#pragma unroll
    for (int u = 0; u < PD; ++u) { const size_t tk = (size_t)u * 4 + h; zf[u] = *(const u32x2*)(Z + tk * 16384 + zo);
#pragma unroll
        for (int k = 0; k < 4; ++k) gf[u][k] = frag_fo(G + tk * 16384, 4, w, k, lane); }
#define GD_STEP(n_, u_, REFILL) do { const int n = (n_); const size_t tk = (size_t)n * 4 + h; const int cur = n & 1; \
            f32x4 acc = unpack4(zf[u_]), acc2 = {0.f, 0.f, 0.f, 0.f}; \
            acc = mfma16(gf[u_][0], frag_row(Si + cur * 16 * GD_LD, GD_LD, 0, 0, lane), acc); acc2 = mfma16(gf[u_][1], frag_row(Si + cur * 16 * GD_LD, GD_LD, 0, 32, lane), acc2); \
            acc = mfma16(gf[u_][2], frag_row(Si + cur * 16 * GD_LD, GD_LD, 0, 64, lane), acc); acc2 = mfma16(gf[u_][3], frag_row(Si + cur * 16 * GD_LD, GD_LD, 0, 96, lane), acc2); \
            if (REFILL && !(var & 2)) { const int nn = n + PD < NCH - 1 ? n + PD : NCH - 2; const size_t tn = (size_t)nn * 4 + h; zf[u_] = *(const u32x2*)(Z + tn * 16384 + zo); \
                _Pragma("unroll") for (int k = 0; k < 4; ++k) gf[u_][k] = frag_fo(G + tn * 16384, 4, w, k, lane); } \
            const u32x2 pv = pack4(acc + acc2); \
            if (!(var & 4)) *(LAS u32x2*)(Si + (cur ^ 1) * 16 * GD_LD + r * GD_LD + 16 * w + 4 * g) = pv; if (!(var & 1)) *(u32x2*)(S + (tk + 4) * 16384 + so) = pv; \
            if (!(var & 4)) { asm volatile("s_waitcnt lgkmcnt(0)" ::: "memory"); __builtin_amdgcn_s_barrier(); } asm volatile("" ::: "memory"); } while (0)
#pragma unroll
    for (int nq = 0; nq < NCH - 1; ++nq) GD_STEP(nq, nq % PD, nq + PD < NCH - 1);
#undef GD_STEP
}
__device__ __forceinline__ void gd_stage3(CArgs& a, int l, int n, int h, LAS unsigned char* lds, int tid) {
    const int lane = tid & 63, w = __builtin_amdgcn_readfirstlane(tid >> 6), r = lane & 15, g = lane >> 4, jc = w & 3, wh = w >> 2;
    const size_t tk = (size_t)n * 4 + h; const int c = 16 * jc + r, t = n * 64 + c;
    const bf16_t* S = (const bf16_t*)(a.ws + WS_GD_S) + tk * 16384; const bf16_t* QT = (const bf16_t*)(a.ws + WS_GD_QT) + tk * 8192; const bf16_t* YI = (const bf16_t*)(a.ws + WS_GD_YI) + tk * 8192;
    LAS float* xs = (LAS float*)lds;
    f32x4 acc[4]; float ss = 0.f;
#pragma unroll
    for (int tt = 0; tt < 4; ++tt) { const int ie = 4 * wh + tt; acc[tt] = unpack4(*(const u32x2*)(YI + co_off(jc, 8, ie, lane)));
#pragma unroll
        for (int k = 0; k < 4; ++k) acc[tt] = mfma16(frag_fo(S, 4, ie, k, lane), frag_fo(QT, 4, jc, k, lane), acc[tt]);
#pragma unroll
        for (int e = 0; e < 4; ++e) ss += acc[tt][e] * acc[tt][e]; }
    ss += __shfl_xor(ss, 16); ss += __shfl_xor(ss, 32);
    if (g == 0) xs[w * 16 + r] = ss;
    WG_SYNC();
    const float rs = 1.0f / sqrtf((ss + xs[(w ^ 4) * 16 + r]) * (1.0f / 128.0f) + 1e-6f);
    const float* nw = LP(I_GNORM, 128); const bf16_t* pz = PROJROW(t) + C_GZ + h * 128; bf16_t* O = (bf16_t*)(a.ws + WS_O) + (size_t)t * D + h * 128;
#pragma unroll
    for (int tt = 0; tt < 4; ++tt) { const int e0 = 16 * (4 * wh + tt) + 4 * g; const f32x4 zv = unpack4(*(const u32x2*)(pz + e0)), wv = *(const f32x4*)(nw + e0); f32x4 y;
#pragma unroll
        for (int e = 0; e < 4; ++e) y[e] = acc[tt][e] * rs * wv[e] * silu_f(zv[e]);
        *(u32x2*)(O + e0) = pack4(y); }
    WG_SYNC();
}

#define XB_TMO      128
#define XB_XCNT(j)  (256  + 64 * (j))
#define XB_XSUB(j)  (1280 + 64 * (j))
#define XB_XGEN(j)  (2304 + 64 * (j))
#define XB_TOP      3328
#define XB_TOPGEN   3392
#define XCD_BAR_WORDS 3456
#define XB_SPIN_CAP (1u << 20)
__device__ __forceinline__ unsigned xb_ld(unsigned* p)              { return __hip_atomic_load(p, __ATOMIC_RELAXED, __HIP_MEMORY_SCOPE_AGENT); }
__device__ __forceinline__ unsigned xb_add(unsigned* p, unsigned v) { return __hip_atomic_fetch_add(p, v, __ATOMIC_RELAXED, __HIP_MEMORY_SCOPE_AGENT); }
__device__ __forceinline__ unsigned xb_xcc_id() { return (unsigned)__builtin_amdgcn_s_getreg((3 << 11) | 20) & 0xFu; }
#define XB_SPIN(cond, bar) do { unsigned _sp = 0; while (cond) { __builtin_amdgcn_s_sleep(1); \
    if ((++_sp & 255u) == 0u) { if (xb_ld(&(bar)[XB_TMO])) break; if (_sp > XB_SPIN_CAP) { atomicAdd(&(bar)[XB_TMO], 1u); break; } } } } while (0)
struct XcdBarrier { unsigned* bar; unsigned x; volatile LAS unsigned* st; };
__device__ __forceinline__ XcdBarrier xcd_barrier_post(unsigned* bar, volatile LAS unsigned* st) {
    XcdBarrier b; b.bar = bar; b.x = xb_xcc_id(); b.st = st;
    if (threadIdx.x == 0) (void)xb_add(&bar[XB_XCNT(b.x)], 1u);
    return b;
}
__device__ __forceinline__ void xcd_barrier_complete(unsigned* bar, unsigned x, unsigned& nloc, unsigned& nx) {
    const unsigned G = gridDim.x * gridDim.y * gridDim.z;
    unsigned sum, cnt, mine, sp = 0u;
    for (;;) {
        sum = 0u; cnt = 0u; mine = 0u;
#pragma unroll
        for (unsigned j = 0; j < 16; ++j) { const unsigned c = xb_ld(&bar[XB_XCNT(j)]); sum += c; cnt += (c > 0u) ? 1u : 0u; mine = (j == x) ? c : mine; }
        if (sum == G) break;
        __builtin_amdgcn_s_sleep(1);
        if ((++sp & 255u) == 0u) { if (xb_ld(&bar[XB_TMO])) break; if (sp > XB_SPIN_CAP) { atomicAdd(&bar[XB_TMO], 1u); break; } }
    }
    nloc = mine > 0u ? mine : 1u; nx = cnt > 0u ? cnt : 1u;
}
__device__ __forceinline__ void xcd_barrier(const XcdBarrier& b) {
    asm volatile("s_waitcnt vmcnt(0)" ::: "memory");
    __syncthreads();
    if (threadIdx.x == 0) {
        unsigned* bar = b.bar;
        __builtin_amdgcn_s_waitcnt(0);
        unsigned nloc = b.st[0], nx = b.st[1];
        if (nloc == 0u) { xcd_barrier_complete(bar, b.x, nloc, nx); b.st[0] = nloc; b.st[1] = nx; }
        const unsigned old = xb_add(&bar[XB_XSUB(b.x)], 1u);
        const unsigned gen = old / nloc;
        if (old + 1u == (gen + 1u) * nloc) {
            __builtin_amdgcn_fence(__ATOMIC_RELEASE, "agent");
            asm volatile("s_waitcnt vmcnt(0)" ::: "memory");
            const unsigned og = xb_add(&bar[XB_TOP], 1u);
            const unsigned tg = og / nx;
            if (og + 1u == (tg + 1u) * nx) xb_add(&bar[XB_TOPGEN], 1u);
            else XB_SPIN(xb_ld(&bar[XB_TOPGEN]) == tg, bar);
            __builtin_amdgcn_fence(__ATOMIC_ACQUIRE, "agent");
            xb_add(&bar[XB_XGEN(b.x)], 1u);
            asm volatile("s_waitcnt vmcnt(0)" ::: "memory");
        } else {
            XB_SPIN(xb_ld(&bar[XB_XGEN(b.x)]) == gen, bar);
            __builtin_amdgcn_fence(__ATOMIC_ACQUIRE, "agent");
            asm volatile("s_waitcnt vmcnt(0)" ::: "memory");
        }
    }
    __syncthreads();
}

constexpr int CV_IN = (D / 64) * (PTP / 32), CV_OUT = (D / 64) * (D / 32), CV_UP = (D / 64) * (FF / 32), CV_DN = (FF / 64) * (D / 32), CV_ALL = CV_IN + CV_OUT + CV_UP + CV_DN;
__device__ __forceinline__ void cvt_items(CArgs& a, int l, int lo, int hi, int gwv, int ngwv, LAS float* scr, int lane) {
#pragma unroll 1
    for (int it = lo + gwv; it < hi; it += ngwv) {
        int r = it;
        if (r < CV_IN) { transpose_item(LP(I_WIN, (size_t)D * PT), D, PT, PTP, (bf16_t*)(a.ws + WS_WIN), scr, r, lane); continue; } r -= CV_IN;
        if (r < CV_OUT) { transpose_item(LP(I_WOUT, (size_t)D * D), D, D, D, (bf16_t*)(a.ws + WS_WOUT), scr, r, lane); continue; } r -= CV_OUT;
        if (r < CV_UP) { transpose_item(LP(I_WUP, (size_t)D * FF), D, FF, FF, (bf16_t*)(a.ws + WS_WUP), scr, r, lane); continue; } r -= CV_UP;
        transpose_item(LP(I_WDN, (size_t)FF * D), FF, D, D, (bf16_t*)(a.ws + WS_WDN), scr, r, lane);
    }
}

constexpr int CW_SUB = 8192;
__device__ __forceinline__ void cnt_arrive(unsigned* cnt) {
    asm volatile("s_waitcnt vmcnt(0)" ::: "memory"); __syncthreads();
    if (threadIdx.x == 0) { __builtin_amdgcn_fence(__ATOMIC_RELEASE, "agent"); asm volatile("s_waitcnt vmcnt(0)" ::: "memory"); (void)xb_add(cnt, 1u); }
}
__device__ __forceinline__ void cnt_wait(unsigned* cnt, unsigned want, unsigned* tmo) {
    if (threadIdx.x == 0) { unsigned sp = 0; while (xb_ld(cnt) < want) { __builtin_amdgcn_s_sleep(2); if ((++sp & 255u) == 0u) { if (xb_ld(tmo)) break; if (sp > XB_SPIN_CAP) { atomicAdd(tmo, 1u); break; } } }
        __builtin_amdgcn_fence(__ATOMIC_ACQUIRE, "agent"); asm volatile("s_waitcnt vmcnt(0)" ::: "memory"); }
    __syncthreads();
}

constexpr int N_PHASES = 1 + 9 * NL;

__device__ __forceinline__ void run_phase(CArgs& a, int ph, LAS unsigned char* lds, const int tid, const int bid, const int mask = 15) {
    const int lane = tid & 63, wave = __builtin_amdgcn_readfirstlane(tid >> 6);
    const int G = gridDim.x, gw = bid * NWAVES + wave, NGW = G * NWAVES;
    float* SSb = (float*)(a.ws + WS_SS);
    if (ph == N_PHASES - 1) {
        for (int t = gw; t < T; t += NGW) final_row(HRES + (size_t)t * D, a.in[I_NF], SSb[2 * NL * T + t], lane);
        return;
    }
    const int l = ph / 9, sp = ph % 9;
    const float* hin = l == 0 ? a.in[I_X] : (const float*)HRES;
    switch (sp) {
    case 0: {
        if (mask & 1) cvt_items(a, l, 0, CV_IN, gw, NGW, (LAS float*)(lds + wave * 16384), lane);
        if (mask & 2) for (int t = gw; t < T; t += NGW) xn_row(hin + (size_t)t * D, LP(I_N1, D), (bf16_t*)(a.ws + WS_XN) + (size_t)t * D, SSb + t, lane);
    } break;
    case 1: { pg8::Gemm g{(const bf16_t*)(a.ws + WS_XN), (const bf16_t*)(a.ws + WS_WIN)}; pg8::StaticOrder<T, PTP> S; S.init(G, bid);
              pg8::EpiBf16<false> E{(bf16_t*)(a.ws + WS_PROJ), PTP, SSb + l * T}; pg8::gemm_phase<D, pg8::EpiBf16<false>, pg8::StaticOrder<T, PTP>, true>(lds, g, S, E, tid);
              constexpr int NFULL = (T / 256) * (PTP / 256) % 256; if (bid >= NFULL) cvt_items(a, l, CV_IN, CV_IN + CV_OUT + CV_UP, (bid - NFULL) * NWAVES + wave, (G - NFULL) * NWAVES, (LAS float*)(lds + wave * 16384), lane); } break;
    case 2: {
#pragma unroll 1
              for (int it = bid; (mask & 1) && it < NCH * 4; it += G) gd_stage1(a, l, it >> 2, it & 3, lds, tid, mask >> 8 ? (mask >> 8) - 1 : 99);
#pragma unroll 1
              for (int it = bid; (mask & 4) && it < NCH * 8; it += G) rw_stage1(a, l, it >> 3, it & 7, lds, tid, mask >> 8 ? (mask >> 8) - 1 : 99);
#pragma unroll 1
              for (int it = bid; (mask & 8) && it < NCH * 2; it += G) m2_stage1(a, l, it >> 1, it & 1, lds, tid);
#pragma unroll 1
              for (int it = bid; (mask & 2) && it < NCH * 4; it += G) ret_stage1(a, it >> 2, it & 3, lds, tid); } break;
    case 3: { const int b = bid;
              unsigned* ctl = (unsigned*)(a.ws + WS_CTL); unsigned* sub = ctl + CW_SUB + 128 * l; unsigned* ddone = sub + 32; unsigned* gdone = sub + 64;
              if (b < 64) { const int x = b & 7, j = b >> 3;
                  if (x < 4) { if (mask & 1) gd_stage2(a, x, j, lds, tid, mask >> 8); if (mask == 15) cnt_arrive(gdone); }
                  else { if (mask & 4) rw_stage2(a, (x - 4) * 2 + (j >> 2), j & 3, lds, tid); if (mask == 15) cnt_arrive(ddone); } }
              else { if (b < 128) { if (mask & 2) ret_stage2(a, b - 64, tid); } else if (mask & 8) m2_stage2(a, b - 128, tid);
                  if (mask == 15) { const int hb = b - 64, NH = G - 64;
                      cnt_arrive(sub); cnt_wait(sub, (unsigned)NH, ctl + XB_TMO);
#pragma unroll 1
                      for (int it = hb; it < NCH * 4; it += NH) ret_stage3(a, l, it >> 2, it & 3, lds, tid);
#pragma unroll 1
                      for (int it = hb; it < NCH * 2; it += NH) m2_stage3(a, l, it >> 1, it & 1, lds, tid); } }
              if (mask == 15) { LAS float* scr = (LAS float*)(lds + wave * 16384);
                  __syncthreads();
                  cvt_items(a, l, CV_IN + CV_OUT + CV_UP, CV_ALL, gw, NGW, scr, lane);
                  if (l + 1 < NL) cvt_items(a, l + 1, 0, CV_IN, gw, NGW, scr, lane);
                  __syncthreads();
                  cnt_wait(ddone, 32u, ctl + XB_TMO);
#pragma unroll 1
                  for (int it = bid; it < NCH * 8; it += G) rw_stage3(a, l, it >> 3, it & 7, lds, tid);
                  cnt_wait(gdone, 32u, ctl + XB_TMO);
#pragma unroll 1
                  for (int it = bid; it < NCH * 4; it += G) gd_stage3(a, l, it >> 2, it & 3, lds, tid); } } break;
    case 4: break;
    case 5: { pg8::Gemm g{(const bf16_t*)(a.ws + WS_O), (const bf16_t*)(a.ws + WS_WOUT)}; pg8::StaticOrder<T, D> S; S.init(G, bid);
              pg8::EpiAddRes E{hin, HRES, D, (bf16_t*)(a.ws + WS_XN2), LP(I_N2, D), SSb + (NL + l) * T}; pg8::gemm_phase<D, pg8::EpiAddRes, pg8::StaticOrder<T, D>, false>(lds, g, S, E, tid); } break;
    case 6: break;
    case 7: { pg8::Gemm g{(const bf16_t*)(a.ws + WS_XN2), (const bf16_t*)(a.ws + WS_WUP)}; pg8::StaticOrder<T, FF> S; S.init(G, bid);
              pg8::EpiBf16<true> E{(bf16_t*)(a.ws + WS_HID), FF, SSb + (NL + l) * T}; pg8::gemm_phase<D, pg8::EpiBf16<true>, pg8::StaticOrder<T, FF>, true>(lds, g, S, E, tid); } break;
    case 8: { pg8::Gemm g{(const bf16_t*)(a.ws + WS_HID), (const bf16_t*)(a.ws + WS_WDN)}; pg8::StaticOrder<T, D> S; S.init(G, bid);
              pg8::EpiAddRes E{HRES, HRES, D, (bf16_t*)(a.ws + WS_XN), l + 1 < NL ? a.in[I_N1] + (size_t)(l + 1) * D : a.in[I_NF], SSb + (l + 1 < NL ? (l + 1) : 2 * NL) * T}; pg8::gemm_phase<FF, pg8::EpiAddRes, pg8::StaticOrder<T, D>, false>(lds, g, S, E, tid); } break;
    }
}

__global__ void __launch_bounds__(NWAVES * 64, 2) fwd_kernel(Args a) {
    extern __shared__ __attribute__((aligned(16))) unsigned char lds_raw[];
    LAS unsigned char* lds = (LAS unsigned char*)lds_raw;
    const int ph_lo = a.ph_lo, ph_hi = a.ph_hi;
    volatile LAS unsigned* MISC = (volatile LAS unsigned*)(lds + MISC_OFF);
    if (threadIdx.x < 64) MISC[threadIdx.x] = 0u;
    __syncthreads();
    const XcdBarrier bar = xcd_barrier_post((unsigned*)(a.ws + WS_CTL), MISC + 8);
    for (int ph = ph_lo; ph < ph_hi; ++ph) {
        if (ph != N_PHASES - 1 && (ph % 9 == 6 || ph % 9 == 4 || (ph % 9 == 0 && ph > 0))) continue;
        CArgs* ap = (CArgs*)__builtin_amdgcn_kernarg_segment_ptr();
        asm volatile("" : "+s"(ap));
        int tid = threadIdx.x, bid = blockIdx.x;
        asm volatile("" : "+v"(tid)); asm volatile("" : "+s"(bid));
        run_phase(*ap, ph, lds, tid, bid);
#ifdef DUP_PHASE
#ifndef DUP_MASK
#define DUP_MASK 15
#endif
        if (ph == DUP_PHASE) { xcd_barrier(bar); asm volatile("" : "+s"(ap)); asm volatile("" : "+v"(tid)); asm volatile("" : "+s"(bid)); run_phase(*ap, ph, lds, tid, bid, DUP_MASK); }
#endif
        if (ph + 1 < ph_hi) xcd_barrier(bar);
    }
}

extern "C" void kernel_launch(void* const* d_in, const int* in_sizes, int n_in, void* d_out, int out_size, void* d_ws, size_t ws_size, hipStream_t stream) {
    static int grid = 0;
    if (grid == 0) {
        if (n_in != N_IN || in_sizes[0] != T * D || out_size != T * D || ws_size < WS_END) {
            fprintf(stderr, "kernel_launch: shape/workspace mismatch: n_in %d in0 %d out %d ws %zu (need %zu); nothing launched\n", n_in, n_in > 0 ? in_sizes[0] : -1, out_size, ws_size, (size_t)WS_END); grid = -1; return; }
        int dev = 0, cus = 0, per_cu = 0;
        if (hipGetDevice(&dev) != hipSuccess || hipDeviceGetAttribute(&cus, hipDeviceAttributeMultiprocessorCount, dev) != hipSuccess) { grid = -1; return; }
        if (hipFuncSetAttribute((const void*)fwd_kernel, hipFuncAttributeMaxDynamicSharedMemorySize, LDS_BYTES) != hipSuccess) { fprintf(stderr, "kernel_launch: hipFuncSetAttribute failed\n"); grid = -1; return; }
        if (hipOccupancyMaxActiveBlocksPerMultiprocessor(&per_cu, (const void*)fwd_kernel, NWAVES * 64, LDS_BYTES) != hipSuccess || per_cu < 1) { fprintf(stderr, "kernel_launch: occupancy query says %d blocks per CU\n", per_cu); per_cu = 1; }
        (void)hipGetLastError();
        grid = cus;
    }
    if (grid < 0) return;
    Args a{};
    for (int i = 0; i < N_IN; ++i) a.in[i] = (const float*)d_in[i];
    a.out = (float*)d_out; a.ws = (unsigned char*)d_ws;
#if N_LAUNCH_MODE == 1
    a.ph_lo = 0; a.ph_hi = N_PHASES;
    (void)hipMemsetAsync((char*)d_ws + WS_CTL, 0, CTL_ZERO_BYTES, stream);
    hipLaunchKernelGGL(fwd_kernel, dim3(grid), dim3(NWAVES * 64), LDS_BYTES, stream, a);
#else
#ifndef DBG_MAXPH
#define DBG_MAXPH N_PHASES
#endif
    for (int ph = 0; ph < N_PHASES; ++ph) {
        if (ph >= DBG_MAXPH && ph != N_PHASES - 1) continue;
#ifdef DBG_SKIP_FINAL
        if (ph == N_PHASES - 1) continue;
#endif
        (void)hipMemsetAsync((char*)d_ws + WS_CTL, 0, CTL_ZERO_BYTES, stream);
        a.ph_lo = ph; a.ph_hi = ph + 1;
        hipLaunchKernelGGL(fwd_kernel, dim3(grid), dim3(NWAVES * 64), LDS_BYTES, stream, a);
    }
#endif
}
#endif
```

```cpp
#ifndef HOST_TEST
#include <hip/hip_runtime.h>
#endif
#include <cstdio>
#include <cstdint>
#include <cmath>
#include <cstddef>

#ifndef SEQ_T
#define SEQ_T 8192
#endif
#ifndef N_LAUNCH_MODE
#define N_LAUNCH_MODE 1
#endif

constexpr int T = SEQ_T, D = 2048, NL = 2, FF = 8192, PT = 6832, PTP = 6912;
constexpr int C_GQ = 0, C_GK = 512, C_GV = 1024, C_GZ = 1536, C_GB = 2048, C_GA = 2052;
constexpr int C_RQ = 2056, C_RK = 2312, C_RV = 2568, C_RG = 3080;
constexpr int C_MZ = 3592, C_MXBC = 4104, C_MDT = 5128;
constexpr int C_RW = 5136;
enum { I_X = 0, I_N1, I_WIN, I_GCONV, I_GALOG, I_GDTB, I_GNORM, I_RNORM, I_MCONV, I_MCONVB, I_MALOG, I_MDTB, I_MD, I_MNORM, I_RWMU, I_RWW0, I_RWWUP, I_RWA0, I_RWAUP,
       I_RWGUP, I_RWKK, I_RWKA, I_RWRK, I_RWLNW, I_RWLNB, I_WOUT, I_N2, I_WUP, I_WDN, I_NF, N_IN };

constexpr size_t MiB = 1u << 20;
constexpr size_t SZ_WIN = (size_t)PTP * D * 2, SZ_WOUT = (size_t)D * D * 2, SZ_WUP = (size_t)FF * D * 2, SZ_WDN = (size_t)D * FF * 2;
constexpr size_t WS_CTL = 0, CTL_BYTES = 1 * MiB;
typedef unsigned long long ss_t;
constexpr float SS_FIX = 16777216.0f, SS_INV = 1.0f / 16777216.0f;
constexpr size_t WS_SS = 64 * 1024, SS_STRIDE = (size_t)SEQ_T * 8;
constexpr size_t CTL_ZERO_BYTES = WS_SS + (2 * 2 + 1) * SS_STRIDE;
constexpr size_t WS_WIN = WS_CTL + CTL_BYTES;
constexpr size_t WS_WOUT = WS_WIN + SZ_WIN;
constexpr size_t WS_WUP = WS_WOUT + SZ_WOUT;
constexpr size_t WS_WDN = WS_WUP + SZ_WUP;
constexpr size_t WS_O = WS_WDN + SZ_WDN;
constexpr size_t WS_HB = WS_O + (size_t)T * D * 2;
constexpr size_t WS_PROJ = WS_HB + (size_t)T * D * 2;
constexpr size_t WS_HID = WS_PROJ;
constexpr size_t GDN_ = (size_t)(T / 64) * 4 * 16384;
constexpr size_t WS_GD_G = WS_PROJ + (size_t)T * PTP * 2;
constexpr size_t WS_GD_Z = WS_GD_G + GDN_ * 2;
constexpr size_t WS_GD_QT = WS_GD_Z + GDN_ * 2;
constexpr size_t WS_GD_YI = WS_GD_QT + GDN_;
constexpr size_t WS_GD_S = WS_GD_YI + GDN_;
constexpr size_t WS_GAB = WS_GD_S + GDN_ * 2;
constexpr int NCH = T / 64;
constexpr size_t WS_RET_Z = WS_GAB;
constexpr size_t WS_RET_YI = WS_RET_Z + (size_t)NCH * 4 * 8192 * 2;
constexpr size_t WS_RET_QH = WS_RET_YI + (size_t)NCH * 4 * 8192 * 2;
constexpr size_t WS_RET_S = WS_RET_QH + (size_t)NCH * 4 * 4096 * 2;
constexpr size_t M2N = (size_t)NCH * 8 * 8192;
constexpr size_t WS_M2_Z = WS_RET_S + (size_t)NCH * 4 * 8192 * 2;
constexpr size_t WS_M2_YI = WS_M2_Z + M2N * 2;
constexpr size_t WS_M2_QH = WS_M2_YI + M2N;
constexpr size_t WS_M2_S = WS_M2_QH + M2N * 2;
constexpr size_t WS_M2_DEC = WS_M2_S + M2N * 2;
constexpr size_t WS_MDT = WS_M2_DEC + (size_t)NCH * 8 * 4;
constexpr size_t RWN = (size_t)NCH * 8 * 4096;
constexpr size_t WS_RW_G = WS_MDT;
constexpr size_t WS_RW_Z = WS_RW_G + RWN * 2;
constexpr size_t WS_RW_QT = WS_RW_Z + RWN * 2;
constexpr size_t WS_RW_YI = WS_RW_QT + RWN * 2;
constexpr size_t WS_RW_E = WS_RW_YI + RWN * 2;
constexpr size_t WS_RW_GT = WS_RW_E + RWN * 2;
constexpr size_t WS_RW_S = WS_RW_GT + RWN * 2;
constexpr size_t WS_END = WS_RW_S + RWN * 2;
static_assert(WS_HID + (size_t)T * FF * 2 <= WS_END, "HID overlay");
static_assert(CTL_ZERO_BYTES <= CTL_BYTES, "CTL");
static_assert(SEQ_T != 8192 || WS_END <= 512 * MiB, "d_ws budget (512 MiB)");

typedef unsigned short bf16_t;
#ifdef HOST_TEST
#define DEV static inline
#define HD static inline
typedef float f32x4 __attribute__((vector_size(16)));
constexpr int WAVE = 1, LPC = 1;
static inline float wave_sum(float v) { return v; }
static inline float group_sum(float v) { return v; }
#else
#define DEV __device__ __forceinline__
#define HD __host__ __device__ __forceinline__
typedef float f32x4 __attribute__((ext_vector_type(4)));
constexpr int WAVE = 64, LPC = 16;
DEV float wave_sum(float v) {
#pragma unroll
    for (int o = 1; o < 64; o <<= 1) v += __shfl_xor(v, o);
    return v;
}
DEV float group_sum(float v) {
#pragma unroll
    for (int o = 1; o < 16; o <<= 1) v += __shfl_xor(v, o);
    return v;
}
#endif
constexpr int CPW = WAVE / LPC;

HD unsigned f2bf(float f) { unsigned u; __builtin_memcpy(&u, &f, 4); return (u + 0x7fffu + ((u >> 16) & 1u)) >> 16; }
HD unsigned pk2(float lo, float hi) { return f2bf(lo) | (f2bf(hi) << 16); }
HD float bf2f(bf16_t b) { unsigned u = (unsigned)b << 16; float f; __builtin_memcpy(&f, &u, 4); return f; }
#ifdef HOST_TEST
DEV float sigmoid_f(float x) { return 1.0f / (1.0f + expf(-x)); }
DEV float silu_f(float x) { return x / (1.0f + expf(-x)); }
#else
DEV float fexp(float x) { return __builtin_amdgcn_exp2f(x * 1.4426950408889634f); }
DEV float sigmoid_f(float x) { return __builtin_amdgcn_rcpf(1.0f + fexp(-x)); }
DEV float silu_f(float x) { return x * __builtin_amdgcn_rcpf(1.0f + fexp(-x)); }
#endif
DEV float softplus_f(float x) { return x > 20.f ? x : log1pf(expf(x)); }

struct Args { const float* in[N_IN]; float* out; unsigned char* ws; int ph_lo, ph_hi; };
#ifdef HOST_TEST
typedef const Args CArgs;
#else
typedef const __attribute__((address_space(4))) Args CArgs;
#endif
#define WSF(off) ((float*)(a.ws + (off)))
#define PROJROW(t) ((const bf16_t*)(a.ws + WS_PROJ) + (size_t)(t) * PTP)
#define LP(idx, per) (a.in[idx] + (size_t)l * (per))

DEV void hb_row(const float* x, bf16_t* o, ss_t* ss_out, int lane) {
    float ss = 0.f;
    for (int i = lane * 4; i < D; i += WAVE * 4) { const f32x4 v = *(const f32x4*)(x + i); ss += (v[0] * v[0] + v[1] * v[1]) + (v[2] * v[2] + v[3] * v[3]);
        unsigned* op = (unsigned*)(o + i); op[0] = pk2(v[0], v[1]); op[1] = pk2(v[2], v[3]); }
    ss = wave_sum(ss); if (lane == 0) *ss_out = (ss_t)(ss * SS_FIX);
}
DEV void final_row(const bf16_t* h, const float* w, float ss  , float* o, int lane) {
    const float r = 1.0f / sqrtf(ss * (1.0f / D) + 1e-6f);
    for (int i = lane * 4; i < D; i += WAVE * 4) { const unsigned* hp = (const unsigned*)(h + i); const unsigned h0 = hp[0], h1 = hp[1]; const f32x4 g = *(const f32x4*)(w + i); f32x4 y;
        unsigned u0 = h0 << 16, u1 = h0 & 0xffff0000u, u2 = h1 << 16, u3 = h1 & 0xffff0000u; float f0, f1, f2, f3; __builtin_memcpy(&f0, &u0, 4); __builtin_memcpy(&f1, &u1, 4); __builtin_memcpy(&f2, &u2, 4); __builtin_memcpy(&f3, &u3, 4);
        y[0] = f0 * r * g[0]; y[1] = f1 * r * g[1]; y[2] = f2 * r * g[2]; y[3] = f3 * r * g[3]; *(f32x4*)(o + i) = y; }
}
DEV void rms_row_bf16(const float* x, const float* w, bf16_t* o, int lane) {
    float ss = 0.f;
    for (int i = lane * 4; i < D; i += WAVE * 4) { const f32x4 v = *(const f32x4*)(x + i); ss += (v[0] * v[0] + v[1] * v[1]) + (v[2] * v[2] + v[3] * v[3]); }
    const float r = 1.0f / sqrtf(wave_sum(ss) * (1.0f / D) + 1e-6f);
    for (int i = lane * 4; i < D; i += WAVE * 4) { const f32x4 v = *(const f32x4*)(x + i), g = *(const f32x4*)(w + i);
        unsigned* op = (unsigned*)(o + i); op[0] = pk2(v[0] * r * g[0], v[1] * r * g[1]); op[1] = pk2(v[2] * r * g[2], v[3] * r * g[3]); }
}
DEV void rms_row_f32(const float* x, const float* w, float* o, int lane) {
    float ss = 0.f;
    for (int i = lane * 4; i < D; i += WAVE * 4) { const f32x4 v = *(const f32x4*)(x + i); ss += (v[0] * v[0] + v[1] * v[1]) + (v[2] * v[2] + v[3] * v[3]); }
    const float r = 1.0f / sqrtf(wave_sum(ss) * (1.0f / D) + 1e-6f);
    for (int i = lane * 4; i < D; i += WAVE * 4) { const f32x4 v = *(const f32x4*)(x + i), g = *(const f32x4*)(w + i);
        f32x4 y; y[0] = v[0] * r * g[0]; y[1] = v[1] * r * g[1]; y[2] = v[2] * r * g[2]; y[3] = v[3] * r * g[3]; *(f32x4*)(o + i) = y; }
}

DEV float conv4(const bf16_t* projrow_t, int col, const float* w, int c, int wstride, int t) {
    float acc = 0.f;
#pragma unroll
    for (int j = 0; j < 4; ++j) { const int tt = t - 3 + j; if (tt >= 0) acc += w[j * wstride + c] * bf2f(projrow_t[(ptrdiff_t)(j - 3) * PTP + col]); }
    return acc;
}

#ifdef HOST_TEST
static const float THETA[32] = {
#else
__device__ const float THETA[32] = {
#endif
    1.000000000e+00f, 7.429639101e-01f, 5.519954562e-01f, 4.101127088e-01f, 3.046989739e-01f, 2.263803482e-01f, 1.681924462e-01f, 1.249609292e-01f, 9.284145385e-02f, 6.897785515e-02f,
    5.124806613e-02f, 3.807546571e-02f, 2.828869782e-02f, 2.101748064e-02f, 1.561523322e-02f, 1.160155423e-02f, 8.619536646e-03f, 6.404003594e-03f, 4.757945426e-03f, 3.534980817e-03f,
    2.626363887e-03f, 1.951293205e-03f, 1.449740841e-03f, 1.077104942e-03f, 8.002503891e-04f, 5.945570301e-04f, 4.417345626e-04f, 3.281927784e-04f, 2.438354713e-04f, 1.811609109e-04f,
    1.345960627e-04f, 9.999999747e-05f };

#ifndef HOST_TEST
namespace pg8 {
#define PG8_LAS __attribute__((address_space(3)))
typedef short bf16x8 __attribute__((ext_vector_type(8)));
typedef unsigned u32x4 __attribute__((ext_vector_type(4)));
constexpr int BM = 256, BK = 64, HALF = 128, HTB = HALF * BK * 2, STAGE_BYTES = 8 * HTB, NXCD = 8, WGM = 8;
__host__ __device__ __forceinline__ int lds_byte(int r, int c) { const int st = (r >> 4) * 2 + (c >> 5), rr = r & 15, cc = c & 31, ob = rr * 64 + cc * 2; return st * 1024 + (ob ^ (((ob >> 9) & 1) << 5)); }
__host__ __device__ __forceinline__ void stage_rc(int b, int& R, int& C) { const int st = b / 1024, sb = b % 1024, swz = sb ^ (((sb >> 9) & 1) << 5); R = (st >> 1) * 16 + swz / 64; C = (st & 1) * 32 + (swz % 64) / 2; }
__host__ __device__ __forceinline__ int perm32(int rho) { const int n = rho >> 4, i = rho & 15; return 8 * (i >> 2) + 4 * n + (i & 3); }
struct Unit { int pm, pn; };
struct Gemm { const bf16_t* A; const bf16_t* Bt; };
template <int M, int N> struct StaticOrder {
    static constexpr int nM = M / BM, nN = N / BM, nwg = nM * nN; int G, c;
    __device__ void init(int G_, int c_) { G = G_; c = c_; }
    __device__ bool next(int i, Unit& u) const {
        const long L = (long)i * G + c; if (L >= nwg) return false;
        int wgid = (int)L; { const int q = nwg / NXCD, r = nwg % NXCD, xcd = wgid % NXCD, off = wgid / NXCD; wgid = (xcd < r ? xcd * (q + 1) : r * (q + 1) + (xcd - r) * q) + off; }
        const int nig = WGM * nN, gid = wgid / nig, fm = gid * WGM, gsz = (nM - fm) < WGM ? (nM - fm) : WGM;
        u.pm = fm + ((wgid % nig) % gsz); u.pn = (wgid % nig) / gsz; return true;
    }
    __device__ __forceinline__ void a_ready(const Unit&) const {}
    __device__ __forceinline__ void done(const Unit&) const {}
};
__device__ __forceinline__ unsigned cvt_pk_bf16(float lo, float hi) { unsigned r; asm volatile("v_cvt_pk_bf16_f32 %0, %1, %2" : "=v"(r) : "v"(lo), "v"(hi)); return r; }
struct EpiStoreF32 {
    static constexpr bool PERM = false, AFTER_DRAIN = false; float* O; int ldc;
    __device__ __forceinline__ void operator()(const f32x4 (&acc)[2][2][4][2], const Unit& u, int wr, int wc, int fr, int fq) const {
        const int row0 = u.pm * BM + wr * 64 + fr, col0 = u.pn * BM + wc * 32 + 4 * fq;
#pragma unroll
        for (int ai = 0; ai < 2; ++ai)
#pragma unroll
            for (int m = 0; m < 4; ++m) { float* rowp = O + (size_t)(row0 + ai * HALF + m * 16) * ldc + col0;
#pragma unroll
                for (int bj = 0; bj < 2; ++bj)
#pragma unroll
                    for (int n = 0; n < 2; ++n) *(f32x4*)(rowp + bj * HALF + n * 16) = acc[ai][bj][m][n]; }
    }
};
template <bool BASE_F32> struct EpiRes {
    static constexpr bool PERM = true, AFTER_DRAIN = false; const void* B; bf16_t* O; int ldc; ss_t* SS;
    __device__ __forceinline__ void operator()(const f32x4 (&acc)[2][2][4][2], const Unit& u, int wr, int wc, int fr, int fq) const {
        const int row0 = u.pm * BM + wr * 64 + fr, col0 = u.pn * BM + wc * 32 + 8 * fq;
#pragma unroll
        for (int ai = 0; ai < 2; ++ai)
#pragma unroll
            for (int mp = 0; mp < 4; mp += 2) {
                f32x4 b[2][2][2];
#pragma unroll
                for (int mm = 0; mm < 2; ++mm) { const size_t ro = (size_t)(row0 + ai * HALF + (mp + mm) * 16) * ldc + col0;
#pragma unroll
                    for (int bj = 0; bj < 2; ++bj) {
                        if (BASE_F32) { const float* bp = (const float*)B + ro + bj * HALF; b[mm][bj][0] = *(const f32x4*)bp; b[mm][bj][1] = *(const f32x4*)(bp + 4); }
                        else { const u32x4 w = *(const u32x4*)((const bf16_t*)B + ro + bj * HALF);
                            b[mm][bj][0] = (f32x4){__uint_as_float(w.x << 16), __uint_as_float(w.x & 0xffff0000u), __uint_as_float(w.y << 16), __uint_as_float(w.y & 0xffff0000u)};
                            b[mm][bj][1] = (f32x4){__uint_as_float(w.z << 16), __uint_as_float(w.z & 0xffff0000u), __uint_as_float(w.w << 16), __uint_as_float(w.w & 0xffff0000u)}; } } }
#pragma unroll
                for (int mm = 0; mm < 2; ++mm) { const int m = mp + mm; bf16_t* rowp = O + (size_t)(row0 + ai * HALF + m * 16) * ldc + col0; float ss = 0.f;
#pragma unroll
                    for (int bj = 0; bj < 2; ++bj) { const f32x4 h0 = b[mm][bj][0] + acc[ai][bj][m][0], h1 = b[mm][bj][1] + acc[ai][bj][m][1];
                        ss += ((h0[0] * h0[0] + h0[1] * h0[1]) + (h0[2] * h0[2] + h0[3] * h0[3])) + ((h1[0] * h1[0] + h1[1] * h1[1]) + (h1[2] * h1[2] + h1[3] * h1[3]));
                        u32x4 w; w.x = cvt_pk_bf16(h0[0], h0[1]); w.y = cvt_pk_bf16(h0[2], h0[3]); w.z = cvt_pk_bf16(h1[0], h1[1]); w.w = cvt_pk_bf16(h1[2], h1[3]); *(u32x4*)(rowp + bj * HALF) = w; }
                    ss += __shfl_xor(ss, 16); ss += __shfl_xor(ss, 32);
                    if (fq == 0) atomicAdd(SS + row0 + ai * HALF + m * 16, (ss_t)(ss * SS_FIX)); } }
    }
};
template <bool SQRELU> struct EpiBf16 {
    static constexpr bool PERM = true, AFTER_DRAIN = false; bf16_t* O; int ldc; const ss_t* SS;
    __device__ __forceinline__ void operator()(const f32x4 (&acc)[2][2][4][2], const Unit& u, int wr, int wc, int fr, int fq) const {
        const int row0 = u.pm * BM + wr * 64 + fr, col0 = u.pn * BM + wc * 32 + 8 * fq;
#pragma unroll
        for (int ai = 0; ai < 2; ++ai)
#pragma unroll
            for (int m = 0; m < 4; ++m) { bf16_t* rowp = O + (size_t)(row0 + ai * HALF + m * 16) * ldc + col0; const float rs = __builtin_amdgcn_rsqf((float)SS[row0 + ai * HALF + m * 16] * (SS_INV / D) + 1e-6f);
#pragma unroll
                for (int bj = 0; bj < 2; ++bj) { f32x4 v0 = acc[ai][bj][m][0] * rs, v1 = acc[ai][bj][m][1] * rs;
                    if (SQRELU) {
#pragma unroll
                        for (int j = 0; j < 4; ++j) { const float p0 = fmaxf(v0[j], 0.f), p1 = fmaxf(v1[j], 0.f); v0[j] = p0 * p0; v1[j] = p1 * p1; } }
                    u32x4 w; w.x = cvt_pk_bf16(v0[0], v0[1]); w.y = cvt_pk_bf16(v0[2], v0[3]); w.z = cvt_pk_bf16(v1[0], v1[1]); w.w = cvt_pk_bf16(v1[2], v1[3]);
                    *(u32x4*)(rowp + bj * HALF) = w; } }
    }
};

template <int K, class Epi, class Sched, bool ALIGN_EPI = false>
__device__ __forceinline__ void gemm_phase(PG8_LAS unsigned char* lds, const Gemm g, const Sched& S, const Epi& E, const int tid) {
    const int wid = __builtin_amdgcn_readfirstlane(tid >> 6), lane = tid & 63, wr = wid >> 2, wc = wid & 3, fr = lane & 15, fq = lane >> 4;
    constexpr int nt = K / BK;
    unsigned voffA[2], voffB[2];
#pragma unroll
    for (int i = 0; i < 2; ++i) { int R, C; stage_rc(tid * 16 + i * 8192, R, C); const int Rb = Epi::PERM ? ((R & ~31) + perm32(R & 31)) : R;
        voffA[i] = (unsigned)(R * K + C) * 2u; voffB[i] = (unsigned)(Rb * K + C) * 2u; }
    const size_t kstep = (size_t)(BK * 2);
    const size_t hstep = (size_t)HALF * K * 2;
    const size_t tstep = 2 * hstep;
    const unsigned ldsw = (unsigned)wid * 1024u;
    const int aoff = lds_byte(wr * 64 + fr, fq * 8), boff = lds_byte(wc * 32 + fr, fq * 8);
#define PG8_SA(b, h) (((b) * 2 + (h)) * HTB)
#define PG8_SB(b, h) ((4 + (b) * 2 + (h)) * HTB)
#define PG8_STAGE(bufoff, gbase, voff) do { _Pragma("unroll") for (int _i = 0; _i < 2; ++_i) \
        __builtin_amdgcn_global_load_lds((const unsigned*)((const char*)(gbase) + (voff)[_i]), (PG8_LAS unsigned*)(lds + (bufoff) + ldsw + _i * 8192), 16, 0, 0); } while (0)
#define PG8_LDA(dst, b, h) do { _Pragma("unroll") for (int m = 0; m < 4; ++m) _Pragma("unroll") for (int k = 0; k < 2; ++k) dst[m][k] = *(const PG8_LAS bf16x8*)(lds + PG8_SA(b, h) + aoff + m * 2048 + k * 1024); } while (0)
#define PG8_LDB(dst, b, h) do { _Pragma("unroll") for (int n = 0; n < 2; ++n) _Pragma("unroll") for (int k = 0; k < 2; ++k) dst[n][k] = *(const PG8_LAS bf16x8*)(lds + PG8_SB(b, h) + boff + n * 2048 + k * 1024); } while (0)
#define PG8_MMA(ai, bj, At, Bt) do { __builtin_amdgcn_s_setprio(1); _Pragma("unroll") for (int m = 0; m < 4; ++m) _Pragma("unroll") for (int n = 0; n < 2; ++n) _Pragma("unroll") for (int k = 0; k < 2; ++k) \
        acc[ai][bj][m][n] = __builtin_amdgcn_mfma_f32_16x16x32_bf16(Bt[n][k], At[m][k], acc[ai][bj][m][n], 0, 0, 0); __builtin_amdgcn_s_setprio(0); } while (0)
#define PG8_WAIT_V(n) asm volatile("s_waitcnt vmcnt(" #n ")" ::: "memory")
#define PG8_WAIT_L(n) asm volatile("s_waitcnt lgkmcnt(" #n ")" ::: "memory")
#define PG8_BAR __builtin_amdgcn_s_barrier()
#define PG8_SCHED __builtin_amdgcn_sched_barrier(0)
    Unit cur, nxt; int ui = 0;
    if (!S.next(0, cur)) return;
    f32x4 acc[2][2][4][2];
#pragma unroll
    for (int a = 0; a < 2; ++a)
#pragma unroll
        for (int b = 0; b < 2; ++b)
#pragma unroll
            for (int m = 0; m < 4; ++m)
#pragma unroll
                for (int n = 0; n < 2; ++n) acc[a][b][m][n] = (f32x4){0.f, 0.f, 0.f, 0.f};
    bf16x8 At[4][2], B0[2][2], B1[2][2];
    const char* cA = (const char*)g.A + (size_t)cur.pm * tstep; const char* cB = (const char*)g.Bt + (size_t)cur.pn * tstep;
    S.a_ready(cur);
    PG8_STAGE(PG8_SB(0, 0), cB, voffB); PG8_STAGE(PG8_SB(0, 1), cB + hstep, voffB); PG8_STAGE(PG8_SA(0, 0), cA, voffA); PG8_STAGE(PG8_SA(0, 1), cA + hstep, voffA);
    if (wr == 1) PG8_BAR;
    PG8_WAIT_V(2); PG8_BAR;
    PG8_STAGE(PG8_SB(1, 0), cB + kstep, voffB); PG8_STAGE(PG8_SA(1, 0), cA + kstep, voffA); PG8_STAGE(PG8_SB(1, 1), cB + hstep + kstep, voffB);
    PG8_WAIT_V(6); PG8_BAR;
    for (;;) {
        const bool has_next = S.next(ui + 1, nxt);
        const char* nA = has_next ? (const char*)g.A + (size_t)nxt.pm * tstep : cA; const char* nB = has_next ? (const char*)g.Bt + (size_t)nxt.pn * tstep : cB;
        for (int t = 0; t < nt; t += 2) {
            const bool last = (t == nt - 2);
            const char* a1 = cA + (size_t)(t + 1) * kstep;
            const char* a2 = last ? nA : cA + (size_t)(t + 2) * kstep; const char* b2 = last ? nB : cB + (size_t)(t + 2) * kstep;
            const char* a3 = a2 + kstep; const char* b3 = b2 + kstep;
            if (last && has_next) S.a_ready(nxt);
            PG8_LDB(B0, 0, 0); PG8_LDB(B1, 0, 1); PG8_SCHED; PG8_LDA(At, 0, 0); PG8_STAGE(PG8_SA(1, 1), a1 + hstep, voffA);
            PG8_WAIT_V(8); PG8_WAIT_L(0); PG8_BAR; PG8_MMA(0, 0, At, B0); PG8_MMA(0, 1, At, B1); PG8_BAR; PG8_SCHED;
            PG8_LDA(At, 0, 1); PG8_STAGE(PG8_SB(0, 0), b2, voffB); PG8_STAGE(PG8_SB(0, 1), b2 + hstep, voffB); PG8_STAGE(PG8_SA(0, 0), a2, voffA);
            PG8_WAIT_V(8); PG8_WAIT_L(0); PG8_BAR; PG8_MMA(1, 0, At, B0); PG8_MMA(1, 1, At, B1); PG8_BAR; PG8_SCHED;
            PG8_LDB(B0, 1, 0); PG8_LDB(B1, 1, 1); PG8_SCHED; PG8_LDA(At, 1, 0); PG8_STAGE(PG8_SA(0, 1), a2 + hstep, voffA);
            PG8_WAIT_V(8); PG8_WAIT_L(0); PG8_BAR; PG8_MMA(0, 0, At, B0); PG8_MMA(0, 1, At, B1); PG8_BAR; PG8_SCHED;
            PG8_LDA(At, 1, 1); PG8_STAGE(PG8_SB(1, 0), b3, voffB); PG8_STAGE(PG8_SB(1, 1), b3 + hstep, voffB); PG8_STAGE(PG8_SA(1, 0), a3, voffA);
            PG8_WAIT_V(8); PG8_WAIT_L(0); PG8_BAR; PG8_MMA(1, 0, At, B0); PG8_MMA(1, 1, At, B1); PG8_BAR; PG8_SCHED;
        }
        if constexpr (ALIGN_EPI) { if (wr == 0) PG8_BAR; }
        E(acc, cur, wr, wc, fr, fq); S.done(cur);
        if (!has_next) break;
#pragma unroll
        for (int a = 0; a < 2; ++a)
#pragma unroll
            for (int b = 0; b < 2; ++b)
#pragma unroll
                for (int m = 0; m < 4; ++m)
#pragma unroll
                    for (int n = 0; n < 2; ++n) acc[a][b][m][n] = (f32x4){0.f, 0.f, 0.f, 0.f};
        cur = nxt; cA = nA; cB = nB; ++ui;
        if constexpr (ALIGN_EPI) { if (wr == 1) PG8_BAR; }
    }
    PG8_WAIT_V(0);
    if constexpr (!ALIGN_EPI) { if (wr == 0) PG8_BAR; }
    PG8_BAR;
#undef PG8_SA
#undef PG8_SB
#undef PG8_STAGE
#undef PG8_LDA
#undef PG8_LDB
#undef PG8_MMA
#undef PG8_WAIT_V
#undef PG8_WAIT_L
#undef PG8_BAR
#undef PG8_SCHED
}
}

#define LAS __attribute__((address_space(3)))
#define GAS __attribute__((address_space(1)))
typedef unsigned v4u __attribute__((ext_vector_type(4)));
constexpr int NWAVES = 8, LDS_BYTES = 163840, MISC_OFF = LDS_BYTES - 512;
#define LDS_WAIT() asm volatile("s_waitcnt lgkmcnt(0)" ::: "memory")

__device__ __forceinline__ void transpose_item(const float* W, int K, int N, int Npad, bf16_t* WT, LAS float* scr, int item, int lane, const float* kscale = nullptr) {
    const int nblk = Npad / 32, kb = item / nblk, nb = item % nblk, k0 = 64 * kb, n0 = 32 * nb;
    const int n = n0 + (lane & 31); const bool ok = n < N;
    float v[32];
    const float* src = W + (size_t)(k0 + (lane >> 5)) * N + n;
#pragma unroll
    for (int i = 0; i < 32; ++i) v[i] = ok ? src[(size_t)(2 * i) * N] : 0.f;
    if (kscale) {
#pragma unroll
        for (int i = 0; i < 32; ++i) v[i] *= kscale[k0 + 2 * i + (lane >> 5)]; }
#pragma unroll
    for (int i = 0; i < 32; ++i) scr[(2 * i + (lane >> 5)) * 33 + (lane & 31)] = v[i];
    LDS_WAIT(); asm volatile("" ::: "memory");
    const int c = lane & 7;
#pragma unroll
    for (int j = 0; j < 4; ++j) { const int nn = (lane >> 3) + 8 * j; const LAS float* s = scr + (8 * c) * 33 + nn;
        v4u o; o.x = pk2(s[0 * 33], s[1 * 33]); o.y = pk2(s[2 * 33], s[3 * 33]); o.z = pk2(s[4 * 33], s[5 * 33]); o.w = pk2(s[6 * 33], s[7 * 33]);
        *(GAS v4u*)(WT + (size_t)(n0 + nn) * K + k0 + 8 * c) = o; }
    LDS_WAIT(); asm volatile("" ::: "memory");
}


typedef short bf16x8 __attribute__((ext_vector_type(8)));
typedef short s16x4 __attribute__((ext_vector_type(4)));
typedef unsigned u32x2 __attribute__((ext_vector_type(2)));
__device__ __forceinline__ s16x4 tr16(const LAS bf16_t* p) { return __builtin_bit_cast(s16x4, __builtin_amdgcn_ds_read_tr16_b64_v4i16((LAS s16x4*)p)); }
__device__ __forceinline__ bf16x8 frag_row(const LAS bf16_t* img, int ld, int nc0, int k0, int lane) { return *(const LAS bf16x8*)(img + (nc0 + (lane & 15)) * ld + k0 + 8 * (lane >> 4)); }
__device__ __forceinline__ bf16x8 frag_tr(const LAS bf16_t* img, int ld, int nc0, int k0, int lane) {
    const int g = lane >> 4, q = (lane & 15) >> 2, p = lane & 3;
    const LAS bf16_t* ad = img + (k0 + 8 * g + q) * ld + nc0 + 4 * p;
    const s16x4 lo = tr16(ad), hi = tr16(ad + 4 * ld);
    return (bf16x8){lo[0], lo[1], lo[2], lo[3], hi[0], hi[1], hi[2], hi[3]};
}
__device__ __forceinline__ bf16x8 frag_row_g(const bf16_t* img, int ld, int nc0, int k0, int lane) { return *(const bf16x8*)(img + (size_t)(nc0 + (lane & 15)) * ld + k0 + 8 * (lane >> 4)); }
__device__ __forceinline__ bf16x8 frag_fo(const bf16_t* img, int KS, int tile, int ks, int lane) { return *(const bf16x8*)(img + ((size_t)(tile * KS + ks) * 64 + lane) * 8); }
__device__ __forceinline__ int fo_st(int tile, int KS, int k0, int g, int r) { const int k = k0 + 4 * g; return ((tile * KS + (k >> 5)) * 64 + ((k >> 3) & 3) * 16 + r) * 8 + (k & 7); }
__device__ __forceinline__ int co_off(int tj, int NI, int ti, int lane) { return ((tj * NI + ti) * 64 + lane) * 4; }
__device__ __forceinline__ f32x4 mfma16(bf16x8 a, bf16x8 b, f32x4 c) { return __builtin_amdgcn_mfma_f32_16x16x32_bf16(a, b, c, 0, 0, 0); }
__device__ __forceinline__ u32x2 pack4(f32x4 v) { u32x2 w; w.x = pk2(v[0], v[1]); w.y = pk2(v[2], v[3]); return w; }
__device__ __forceinline__ f32x4 unpack4(u32x2 w) { f32x4 v; v[0] = __uint_as_float(w.x << 16); v[1] = __uint_as_float(w.x & 0xffff0000u); v[2] = __uint_as_float(w.y << 16); v[3] = __uint_as_float(w.y & 0xffff0000u); return v; }
#define WG_SYNC() do { asm volatile("s_waitcnt lgkmcnt(0)" ::: "memory"); __builtin_amdgcn_s_barrier(); asm volatile("" ::: "memory"); } while (0)

__device__ __forceinline__ void ret_stage1(CArgs& a, int n, int h, LAS unsigned char* lds, int tid) {
    const int lane = tid & 63, w = __builtin_amdgcn_readfirstlane(tid >> 6), r = lane & 15, g = lane >> 4;
    constexpr int LD = 72, LDV = 136;
    LAS bf16_t* Qi = (LAS bf16_t*)lds; LAS bf16_t* Ki = Qi + 64 * LD; LAS bf16_t* Kdi = Ki + 64 * LD; LAS bf16_t* Vi = Kdi + 64 * LD; LAS bf16_t* Si = Vi + 64 * LDV;
    const int tk = n * 4 + h; const float lg2 = log2f(1.0f - exp2f(-5.0f - (float)h));
    bf16_t* QH = (bf16_t*)(a.ws + WS_RET_QH) + (size_t)tk * 4096;
    unsigned rqq[4], rkk[4]; v4u rvv[2];
#pragma unroll
    for (int ii = 0; ii < 4; ++ii) { const int idx = tid + 512 * ii, c = idx >> 5, i = idx & 31; const bf16_t* pr = PROJROW(n * 64 + c); rqq[ii] = *(const unsigned*)(pr + C_RQ + 64 * h + 2 * i); rkk[ii] = *(const unsigned*)(pr + C_RK + 64 * h + 2 * i); }
#pragma unroll
    for (int ii = 0; ii < 2; ++ii) { const int idx = tid + 512 * ii, c = idx >> 4, ch = idx & 15; rvv[ii] = *(const v4u*)(PROJROW(n * 64 + c) + C_RV + 128 * h + 8 * ch); }
#pragma unroll
    for (int ii = 0; ii < 4; ++ii) { const int idx = tid + 512 * ii;
        const int c = idx >> 5, i = idx & 31, t = n * 64 + c; float sn, cs; sincosf((float)t * THETA[i], &sn, &cs);
        const unsigned qq = rqq[ii], kk = rkk[ii];
        const float q0 = __uint_as_float(qq << 16), q1 = __uint_as_float(qq & 0xffff0000u), k0 = __uint_as_float(kk << 16), k1 = __uint_as_float(kk & 0xffff0000u);
        const float rq0 = q0 * cs - q1 * sn, rq1 = q1 * cs + q0 * sn, rk0 = (k0 * cs - k1 * sn) * 0.125f, rk1 = (k1 * cs + k0 * sn) * 0.125f;
        const float dk = exp2f(lg2 * (float)(63 - c)), dq = exp2f(lg2 * (float)(c + 1));
        *(LAS unsigned*)(Qi + c * LD + 2 * i) = pk2(rq0, rq1); *(LAS unsigned*)(Ki + c * LD + 2 * i) = pk2(rk0, rk1); *(LAS unsigned*)(Kdi + c * LD + 2 * i) = pk2(rk0 * dk, rk1 * dk);
        { const int d = 2 * i; *(unsigned*)(QH + (((c >> 4) * 2 + (d >> 5)) * 64 + ((d >> 3) & 3) * 16 + (c & 15)) * 8 + (d & 7)) = pk2(rq0 * dq, rq1 * dq); }
    }
#pragma unroll
    for (int ii = 0; ii < 2; ++ii) { const int idx = tid + 512 * ii, c = idx >> 4, ch = idx & 15; *(LAS v4u*)(Vi + c * LDV + 8 * ch) = rvv[ii]; }
    WG_SYNC();
#pragma unroll
    for (int tt = 0; tt < 2; ++tt) { const int tile = 2 * w + tt, im = tile >> 2, jc = tile & 3; f32x4 acc = {0.f, 0.f, 0.f, 0.f};
        if (jc >= im) {
#pragma unroll
            for (int k0 = 0; k0 < 64; k0 += 32) acc = mfma16(frag_row(Ki, LD, 16 * im, k0, lane), frag_row(Qi, LD, 16 * jc, k0, lane), acc);
#pragma unroll
            for (int e = 0; e < 4; ++e) { const int i = 16 * im + 4 * g + e, j = 16 * jc + r; acc[e] = j >= i ? acc[e] * exp2f(lg2 * (float)(j - i)) : 0.f; } }
        *(LAS u32x2*)(Si + (16 * jc + r) * LD + 16 * im + 4 * g) = pack4(acc); }
    WG_SYNC();
    bf16_t* YI = (bf16_t*)(a.ws + WS_RET_YI) + (size_t)tk * 8192; bf16_t* Z = (bf16_t*)(a.ws + WS_RET_Z) + (size_t)tk * 8192;
#pragma unroll
    for (int tt = 0; tt < 4; ++tt) { const int jc = w & 3, ie = 4 * (w >> 2) + tt; f32x4 acc = {0.f, 0.f, 0.f, 0.f};
#pragma unroll
        for (int k0 = 0; k0 < 64; k0 += 32) acc = mfma16(frag_tr(Vi, LDV, 16 * ie, k0, lane), frag_row(Si, LD, 16 * jc, k0, lane), acc);
        *(u32x2*)(YI + co_off(jc, 8, ie, lane)) = pack4(acc); }
#pragma unroll
    for (int tt = 0; tt < 4; ++tt) { const int id = w & 3, je = 4 * (w >> 2) + tt; f32x4 acc = {0.f, 0.f, 0.f, 0.f};
#pragma unroll
        for (int k0 = 0; k0 < 64; k0 += 32) acc = mfma16(frag_tr(Kdi, LD, 16 * id, k0, lane), frag_tr(Vi, LDV, 16 * je, k0, lane), acc);
        *(u32x2*)(Z + fo_st(je, 2, 16 * id, g, r)) = pack4(acc); }
    WG_SYNC();
}
__device__ __forceinline__ void ret_stage2(CArgs& a, int b, int tid) {
    const int idx = b * 512 + tid, h = idx >> 13, rem = idx & 8191; const float g64 = exp2f(64.0f * log2f(1.0f - exp2f(-5.0f - (float)h)));
    const bf16_t* Z = (const bf16_t*)(a.ws + WS_RET_Z) + (size_t)h * 8192 + rem; bf16_t* S = (bf16_t*)(a.ws + WS_RET_S) + (size_t)h * 8192 + rem; float s = 0.f;
#pragma unroll 32
    for (int n = 0; n < NCH; ++n) { const float z = bf2f(Z[(size_t)n * 4 * 8192]); S[(size_t)n * 4 * 8192] = (bf16_t)f2bf(s); s = g64 * s + z; }
}
__device__ __forceinline__ void ret_stage3(CArgs& a, int l, int n, int h, LAS unsigned char* lds, int tid) {
    const int lane = tid & 63, w = __builtin_amdgcn_readfirstlane(tid >> 6), r = lane & 15, g = lane >> 4, jc = w & 3, wh = w >> 2;
    const int tk = n * 4 + h; const int c = 16 * jc + r, t = n * 64 + c;
    const bf16_t* S = (const bf16_t*)(a.ws + WS_RET_S) + (size_t)tk * 8192; const bf16_t* QH = (const bf16_t*)(a.ws + WS_RET_QH) + (size_t)tk * 4096; const bf16_t* YI = (const bf16_t*)(a.ws + WS_RET_YI) + (size_t)tk * 8192;
    LAS float* xs = (LAS float*)lds;
    f32x4 acc[4];
#pragma unroll
    for (int tt = 0; tt < 4; ++tt) { const int ie = 4 * wh + tt; acc[tt] = unpack4(*(const u32x2*)(YI + co_off(jc, 8, ie, lane)));
#pragma unroll
        for (int k = 0; k < 2; ++k) acc[tt] = mfma16(frag_fo(S, 2, ie, k, lane), frag_fo(QH, 2, jc, k, lane), acc[tt]); }
    float s1 = 0.f;
#pragma unroll
    for (int tt = 0; tt < 4; ++tt) s1 += (acc[tt][0] + acc[tt][1]) + (acc[tt][2] + acc[tt][3]);
    s1 += __shfl_xor(s1, 16); s1 += __shfl_xor(s1, 32);
    if (g == 0) xs[w * 16 + r] = s1;
    WG_SYNC();
    const float mu = (s1 + xs[(w ^ 4) * 16 + r]) * (1.0f / 128.0f); float s2 = 0.f;
#pragma unroll
    for (int tt = 0; tt < 4; ++tt)
#pragma unroll
        for (int e = 0; e < 4; ++e) { acc[tt][e] -= mu; s2 += acc[tt][e] * acc[tt][e]; }
    s2 += __shfl_xor(s2, 16); s2 += __shfl_xor(s2, 32);
    if (g == 0) xs[128 + w * 16 + r] = s2;
    WG_SYNC();
    const float rs = 1.0f / sqrtf((s2 + xs[128 + (w ^ 4) * 16 + r]) * (1.0f / 128.0f) + 1e-6f);
    const float* nw = LP(I_RNORM, 512) + h * 128; const bf16_t* pr = PROJROW(t) + C_RG + h * 128; bf16_t* O = (bf16_t*)(a.ws + WS_O) + (size_t)t * D + 512 + h * 128;
#pragma unroll
    for (int tt = 0; tt < 4; ++tt) { const int e0 = 16 * (4 * wh + tt) + 4 * g; const f32x4 gt = unpack4(*(const u32x2*)(pr + e0)); const f32x4 wv = *(const f32x4*)(nw + e0); f32x4 y;
#pragma unroll
        for (int e = 0; e < 4; ++e) y[e] = acc[tt][e] * rs * wv[e] * silu_f(gt[e]);
        *(u32x2*)(O + e0) = pack4(y); }
    WG_SYNC();
}

constexpr int RW_LD = 72;
constexpr int RWO_V = 0, RWO_IMG = 9216  , RWO_XI = 36864  , RWO_UI = 55296, RWO_CUMC = 64512, RWO_WT = 65536  , RWO_AM = 65536, RWO_TRI = 82944,
              RWO_RHST = 110592, RWO_AI = 143360, RWO_DI = 152576;
constexpr int RWO_LW = 9216, RWO_LIN = 82944;
__device__ __forceinline__ float ftanh(float x) { return 1.0f - 2.0f * __builtin_amdgcn_rcpf(1.0f + fexp(2.0f * x)); }
__device__ __forceinline__ float fsoftplus(float x) { return x > 20.f ? x : __builtin_amdgcn_logf(1.0f + fexp(x)) * 0.6931471805599453f; }
__device__ __forceinline__ void rw_stage1(CArgs& a, int l, int n, int h, LAS unsigned char* lds, int tid, const int stop = 99) {
    const int w = __builtin_amdgcn_readfirstlane(tid >> 6), tk = n * 8 + h;
    int lane, r, g, c, kg, t;
#define RW_IDX() do { int tl_ = tid; asm volatile("" : "+v"(tl_)); lane = tl_ & 63; r = lane & 15; g = lane >> 4; c = tl_ >> 3; kg = tl_ & 7; t = n * 64 + c; } while (0)
    RW_IDX();
    LAS bf16_t* Vi = (LAS bf16_t*)(lds + RWO_V);
    LAS bf16_t* RHi = (LAS bf16_t*)(lds + RWO_IMG); LAS bf16_t* BTi = RHi + 64 * RW_LD; LAS bf16_t* KTi = BTi + 64 * RW_LD; LAS bf16_t* KHi = KTi + 64 * RW_LD; LAS bf16_t* BMi = KHi + 64 * RW_LD; LAS bf16_t* KMi = BMi + 64 * RW_LD;
    LAS bf16_t* XI = (LAS bf16_t*)(lds + RWO_XI);
    LAS bf16_t* UI = (LAS bf16_t*)(lds + RWO_UI);
    LAS float* CUMC = (LAS float*)(lds + RWO_CUMC); LAS float* WT = (LAS float*)(lds + RWO_WT); LAS float* AM = (LAS float*)(lds + RWO_AM);
    LAS bf16_t* BMI = (LAS bf16_t*)(lds + RWO_TRI); LAS bf16_t* PBI = BMI + 64 * RW_LD; LAS bf16_t* PKI = PBI + 64 * RW_LD;
    LAS float* RHST = (LAS float*)(lds + RWO_RHST);
    LAS bf16_t* AI = (LAS bf16_t*)(lds + RWO_AI);
    LAS bf16_t* DI = (LAS bf16_t*)(lds + RWO_DI);
    LAS float* LW = (LAS float*)(lds + RWO_LW); LAS float* LA = LW + 4096; LAS float* LG = LA + 4096;
    LAS bf16_t* WLi = (LAS bf16_t*)(lds + RWO_LIN); LAS bf16_t* ALi = WLi + 64 * 40; LAS bf16_t* GLi = ALi + 64 * 40; LAS bf16_t* WUPi = GLi + 64 * 104; LAS bf16_t* AUPi = WUPi + 32 * RW_LD; LAS bf16_t* GUPi = AUPi + 32 * RW_LD;
    const float* mu = LP(I_RWMU, 1696); const bf16_t* p1 = PROJROW(t) + C_RW; const bf16_t* p0 = p1 - PTP; bool hp = t > 0;
    float vv[8];
    { const v4u cu = *(const v4u*)(p1 + 1024 + 64 * h + 8 * kg); v4u pv = {0u, 0u, 0u, 0u};
      const float* m = mu + 1024 + 64 * h + 8 * kg; const f32x4 m0 = *(const f32x4*)m, m1 = *(const f32x4*)(m + 4);
      u32x2 cw = *(const u32x2*)(p1 + 1536 + 4 * kg), ca = *(const u32x2*)(p1 + 1568 + 4 * kg), pw = {0u, 0u}, pa = {0u, 0u};
      u32x2 cg[3], pg[3] = {{0u, 0u}, {0u, 0u}, {0u, 0u}}; f32x4 mg[3];
#pragma unroll
      for (int q = 0; q < 3; ++q) { cg[q] = *(const u32x2*)(p1 + 1600 + 12 * kg + 4 * q); mg[q] = *(const f32x4*)(mu + 1600 + 12 * kg + 4 * q); }
      if (hp) { pv = *(const v4u*)(p0 + 1024 + 64 * h + 8 * kg); pw = *(const u32x2*)(p0 + 1536 + 4 * kg); pa = *(const u32x2*)(p0 + 1568 + 4 * kg);
#pragma unroll
          for (int q = 0; q < 3; ++q) pg[q] = *(const u32x2*)(p0 + 1600 + 12 * kg + 4 * q); }
      const f32x4 mw = *(const f32x4*)(mu + 1536 + 4 * kg), ma = *(const f32x4*)(mu + 1568 + 4 * kg);
      const int j = tid >> 4, k4 = (tid & 15) * 4;
      const f32x4 lwv = *(const f32x4*)(LP(I_RWWUP, 32 * 512) + j * 512 + 64 * h + k4), lav = *(const f32x4*)(LP(I_RWAUP, 32 * 512) + j * 512 + 64 * h + k4); f32x4 lgv[3];
#pragma unroll
      for (int q = 0; q < 3; ++q) lgv[q] = *(const f32x4*)(LP(I_RWGUP, 96 * 512) + (32 * q + j) * 512 + 64 * h + k4);
      asm volatile("" ::: "memory");
      { v4u o;
#pragma unroll
        for (int u = 0; u < 4; ++u) { const unsigned cww = cu[u], pww = pv[u]; const float c0 = __uint_as_float(cww << 16), c1 = __uint_as_float(cww & 0xffff0000u), q0 = __uint_as_float(pww << 16), q1 = __uint_as_float(pww & 0xffff0000u);
            const float mA = u < 2 ? m0[2 * u] : m1[2 * u - 4], mB = u < 2 ? m0[2 * u + 1] : m1[2 * u - 3];
            vv[2 * u] = c0 + (q0 - c0) * mA; vv[2 * u + 1] = c1 + (q1 - c1) * mB; o[u] = pk2(vv[2 * u], vv[2 * u + 1]); }
        *(LAS v4u*)(Vi + c * RW_LD + 8 * kg) = o; }
      { const f32x4 cv = unpack4(cw), pvv = unpack4(pw); f32x4 x;
#pragma unroll
        for (int u = 0; u < 4; ++u) x[u] = ftanh(cv[u] + (pvv[u] - cv[u]) * mw[u]);
        *(LAS u32x2*)(WLi + c * 40 + 4 * kg) = pack4(x); }
      { const f32x4 cv = unpack4(ca), pvv = unpack4(pa); f32x4 x;
#pragma unroll
        for (int u = 0; u < 4; ++u) x[u] = cv[u] + (pvv[u] - cv[u]) * ma[u];
        *(LAS u32x2*)(ALi + c * 40 + 4 * kg) = pack4(x); }
#pragma unroll
      for (int q = 0; q < 3; ++q) { const f32x4 cv = unpack4(cg[q]), pvv = unpack4(pg[q]); f32x4 x;
#pragma unroll
          for (int u = 0; u < 4; ++u) x[u] = sigmoid_f(cv[u] + (pvv[u] - cv[u]) * mg[q][u]);
          *(LAS u32x2*)(GLi + c * 104 + 12 * kg + 4 * q) = pack4(x); }
      *(LAS u32x2*)(WUPi + j * RW_LD + k4) = pack4(lwv); *(LAS u32x2*)(AUPi + j * RW_LD + k4) = pack4(lav);
#pragma unroll
      for (int q = 0; q < 3; ++q) *(LAS u32x2*)(GUPi + (32 * q + j) * RW_LD + k4) = pack4(lgv[q]); }
    WG_SYNC();
    if (stop <= 0) return;
    RW_IDX();
#pragma unroll
    for (int tt = 0; tt < 2; ++tt) { const int tile = 2 * w + tt, ik = tile >> 2, jc = tile & 3;
        f32x4 aw = {0.f, 0.f, 0.f, 0.f}, aa = aw, ag = aw;
        aw = mfma16(frag_tr(WUPi, RW_LD, 16 * ik, 0, lane), frag_row(WLi, 40, 16 * jc, 0, lane), aw);
        aa = mfma16(frag_tr(AUPi, RW_LD, 16 * ik, 0, lane), frag_row(ALi, 40, 16 * jc, 0, lane), aa);
#pragma unroll
        for (int k0 = 0; k0 < 96; k0 += 32) ag = mfma16(frag_tr(GUPi, RW_LD, 16 * ik, k0, lane), frag_row(GLi, 104, 16 * jc, k0, lane), ag);
        const int o = (16 * jc + r) * 64 + 16 * ik + 4 * g; *(LAS f32x4*)(LW + o) = aw; *(LAS f32x4*)(LA + o) = aa; *(LAS f32x4*)(LG + o) = ag; }
    WG_SYNC();
    if (stop <= 1) return;
    RW_IDX();
    p1 = PROJROW(t) + C_RW; p0 = p1 - PTP; hp = t > 0;
    float rr[8], kk[8], bb[8], kt[8], lwd[8], cum[8];
    { const int ch0 = 64 * h + 8 * kg; float ss = 0.f, rk = 0.f; float gt[8];
      const v4u cr = *(const v4u*)(p1 + ch0), ck = *(const v4u*)(p1 + 512 + ch0); v4u qr = {0u, 0u, 0u, 0u}, qk = qr; if (hp) { qr = *(const v4u*)(p0 + ch0); qk = *(const v4u*)(p0 + 512 + ch0); }
      float pw0[8], pa0[8], pkk[8], pka[8], prk[8], pmr[8], pmk[8];
#pragma unroll
      for (int q = 0; q < 2; ++q) { const f32x4 x0 = *(const f32x4*)(LP(I_RWW0, 512) + ch0 + 4 * q), x1 = *(const f32x4*)(LP(I_RWA0, 512) + ch0 + 4 * q), x2 = *(const f32x4*)(LP(I_RWKK, 512) + ch0 + 4 * q), x3 = *(const f32x4*)(LP(I_RWKA, 512) + ch0 + 4 * q),
                                                 x4 = *(const f32x4*)(LP(I_RWRK, 512) + ch0 + 4 * q), x5 = *(const f32x4*)(mu + ch0 + 4 * q), x6 = *(const f32x4*)(mu + 512 + ch0 + 4 * q);
#pragma unroll
          for (int e = 0; e < 4; ++e) { pw0[4 * q + e] = x0[e]; pa0[4 * q + e] = x1[e]; pkk[4 * q + e] = x2[e]; pka[4 * q + e] = x3[e]; prk[4 * q + e] = x4[e]; pmr[4 * q + e] = x5[e]; pmk[4 * q + e] = x6[e]; } }
#pragma unroll
      for (int u = 0; u < 8; ++u) { const unsigned crw = cr[u >> 1], ckw = ck[u >> 1], qrw = qr[u >> 1], qkw = qk[u >> 1];
          const float curR = (u & 1) ? __uint_as_float(crw & 0xffff0000u) : __uint_as_float(crw << 16), curK = (u & 1) ? __uint_as_float(ckw & 0xffff0000u) : __uint_as_float(ckw << 16);
          const float prvR = (u & 1) ? __uint_as_float(qrw & 0xffff0000u) : __uint_as_float(qrw << 16), prvK = (u & 1) ? __uint_as_float(qkw & 0xffff0000u) : __uint_as_float(qkw << 16);
          const float rv = curR + (prvR - curR) * pmr[u], kr = curK + (prvK - curK) * pmk[u];
          const float lw = LW[c * 64 + 8 * kg + u], la = LA[c * 64 + 8 * kg + u]; gt[u] = LG[c * 64 + 8 * kg + u];
          const float wraw = -fsoftplus(-(pw0[u] + lw)) - 0.5f; lwd[u] = -fexp(wraw);
          const float av = sigmoid_f(pa0[u] + la); const float kkr = kr * pkk[u]; kt[u] = kr * (1.0f + (av - 1.0f) * pka[u]);
          rr[u] = rv; kk[u] = kkr; bb[u] = av; ss += kkr * kkr; rk += rv * kt[u] * prk[u]; }
      ss += __shfl_xor(ss, 1); ss += __shfl_xor(ss, 2); ss += __shfl_xor(ss, 4); rk += __shfl_xor(rk, 1); rk += __shfl_xor(rk, 2); rk += __shfl_xor(rk, 4);
      const float inv = __builtin_amdgcn_rsqf(ss + 1e-6f);
#pragma unroll
      for (int u = 0; u < 8; ++u) { kk[u] *= inv; bb[u] *= kk[u]; }
#pragma unroll
      for (int u = 0; u < 8; ++u) { float x = lwd[u];
#pragma unroll
          for (int o = 8; o < 64; o <<= 1) { const float up = __shfl_up(x, o); if (lane >= o) x += up; }
          cum[u] = x; }
      if (lane >= 56) { *(LAS f32x4*)(WT + w * 64 + 8 * kg) = (f32x4){cum[0], cum[1], cum[2], cum[3]}; *(LAS f32x4*)(WT + w * 64 + 8 * kg + 4) = (f32x4){cum[4], cum[5], cum[6], cum[7]}; }
      v4u eo, go;
#pragma unroll
      for (int u = 0; u < 4; ++u) { eo[u] = pk2(rk * vv[2 * u], rk * vv[2 * u + 1]); go[u] = pk2(gt[2 * u], gt[2 * u + 1]); }
      bf16_t* Eo = (bf16_t*)(a.ws + WS_RW_E) + (size_t)tk * 4096; bf16_t* Go = (bf16_t*)(a.ws + WS_RW_GT) + (size_t)tk * 4096;
#pragma unroll
      for (int hf = 0; hf < 2; ++hf) { const int o = (((c >> 4) * 4 + (kg >> 1)) * 64 + ((2 * kg + hf) & 3) * 16 + (c & 15)) * 4;
          *(u32x2*)(Eo + o) = (u32x2){eo[2 * hf], eo[2 * hf + 1]}; *(u32x2*)(Go + o) = (u32x2){go[2 * hf], go[2 * hf + 1]}; } }
    WG_SYNC();
    if (stop <= 3) return;
    RW_IDX();
    { float cc[8];
#pragma unroll
      for (int u = 0; u < 8; ++u) cc[u] = 0.f;
#pragma unroll
      for (int ww = 0; ww < 8; ++ww) { const f32x4 t0 = *(const LAS f32x4*)(WT + ww * 64 + 8 * kg), t1 = *(const LAS f32x4*)(WT + ww * 64 + 8 * kg + 4);
#pragma unroll
          for (int e = 0; e < 4; ++e) { if (ww < w) { cum[e] += t0[e]; cum[4 + e] += t1[e]; } cc[e] += t0[e]; cc[4 + e] += t1[e]; } }
      if (c == 0) { *(LAS f32x4*)(CUMC + 8 * kg) = (f32x4){cc[0], cc[1], cc[2], cc[3]}; *(LAS f32x4*)(CUMC + 8 * kg + 4) = (f32x4){cc[4], cc[5], cc[6], cc[7]}; }
      v4u oRH, oBT, oKT, oKH, oBM, oKM;
#pragma unroll
      for (int u = 0; u < 8; u += 2) { float x[6][2];
#pragma unroll
          for (int e = 0; e < 2; ++e) { const float cu = cum[u + e]; const float ep = fexp(cu), em = fexp(-cu), et = fexp(cc[u + e] - cu), ex = fexp(cu - lwd[u + e]);
              x[0][e] = rr[u + e] * ep; x[1][e] = bb[u + e] * et; x[2][e] = kt[u + e] * et; x[3][e] = kk[u + e] * ex; x[4][e] = bb[u + e] * em; x[5][e] = kt[u + e] * em;
              RHST[(8 * kg + u + e) * 64 + c] = x[3][e]; }
          oRH[u >> 1] = pk2(x[0][0], x[0][1]); oBT[u >> 1] = pk2(x[1][0], x[1][1]); oKT[u >> 1] = pk2(x[2][0], x[2][1]); oKH[u >> 1] = pk2(x[3][0], x[3][1]); oBM[u >> 1] = pk2(x[4][0], x[4][1]); oKM[u >> 1] = pk2(x[5][0], x[5][1]); }
      const int o = c * RW_LD + 8 * kg;
      *(LAS v4u*)(RHi + o) = oRH; *(LAS v4u*)(BTi + o) = oBT; *(LAS v4u*)(KTi + o) = oKT; *(LAS v4u*)(KHi + o) = oKH; *(LAS v4u*)(BMi + o) = oBM; *(LAS v4u*)(KMi + o) = oKM; }
    WG_SYNC();
    if (stop <= 4) return;
    RW_IDX();
#pragma unroll
    for (int tt = 0; tt < 2; ++tt) { const int tile = 2 * w + tt, ii = tile >> 2, jt = tile & 3;
        f32x4 cA = {0.f, 0.f, 0.f, 0.f}, cB = cA, cPb = cA, cPk = cA;
        if (ii <= jt) {
#pragma unroll
            for (int k0 = 0; k0 < 64; k0 += 32) { const bf16x8 fbm = frag_row(BMi, RW_LD, 16 * ii, k0, lane), fkm = frag_row(KMi, RW_LD, 16 * ii, k0, lane), fkh = frag_row(KHi, RW_LD, 16 * jt, k0, lane), frh = frag_row(RHi, RW_LD, 16 * jt, k0, lane);
                cA = mfma16(fbm, fkh, cA); cB = mfma16(fkm, fkh, cB); cPb = mfma16(fbm, frh, cPb); cPk = mfma16(fkm, frh, cPk); }
#pragma unroll
            for (int e = 0; e < 4; ++e) { const int i = 16 * ii + 4 * g + e, tq = 16 * jt + r; if (!(i < tq)) { cA[e] = 0.f; cB[e] = 0.f; } if (!(i <= tq)) { cPb[e] = 0.f; cPk[e] = 0.f; } } }
        const int tq = 16 * jt + r, i0 = 16 * ii + 4 * g;
        *(LAS f32x4*)(AM + tq * 68 + i0) = cA; *(LAS u32x2*)(AI + tq * RW_LD + i0) = pack4(-cA); *(LAS u32x2*)(BMI + tq * RW_LD + i0) = pack4(cB); *(LAS u32x2*)(PBI + tq * RW_LD + i0) = pack4(cPb); *(LAS u32x2*)(PKI + tq * RW_LD + i0) = pack4(cPk); }
    WG_SYNC();
    if (stop <= 5) return;
    RW_IDX();
#pragma unroll
    for (int tt = 0; tt < 2; ++tt) { const int tile = 2 * w + tt, it = tile >> 2, jv = tile & 3; f32x4 acc = {0.f, 0.f, 0.f, 0.f};
#pragma unroll
        for (int k0 = 0; k0 < 64; k0 += 32) acc = mfma16(frag_row(BMI, RW_LD, 16 * it, k0, lane), frag_tr(Vi, RW_LD, 16 * jv, k0, lane), acc);
        *(LAS f32x4*)(RHST + (64 + 16 * jv + r) * 64 + 16 * it + 4 * g) = acc; }
    { const int q = c * 8 + kg;
      if (q < 64) { const int b = q >> 4, j = q & 15; float d[16], av[16][16];
#pragma unroll
          for (int tq = 1; tq < 16; ++tq)
#pragma unroll
              for (int i = 0; i < tq; ++i) av[tq][i] = AM[(16 * b + tq) * 68 + 16 * b + i];
#pragma unroll
          for (int tq = 0; tq < 16; ++tq) d[tq] = tq == j ? 1.f : 0.f;
#pragma unroll
          for (int i = 0; i < 15; ++i)
#pragma unroll
              for (int tq = i + 1; tq < 16; ++tq) d[tq] -= av[tq][i] * d[i];
#pragma unroll
          for (int tq = 0; tq < 16; ++tq) { DI[(b * 16 + tq) * 32 + j] = (bf16_t)f2bf(d[tq]); DI[(b * 16 + tq) * 32 + 16 + j] = (bf16_t)0; } }
      for (int i = q; i < 128 * RW_LD / 8; i += 512) *(LAS v4u*)(XI + 8 * i) = (v4u){0u, 0u, 0u, 0u};
      *(LAS v4u*)(UI + w * 512 + lane * 8) = (v4u){0u, 0u, 0u, 0u}; }
    WG_SYNC();
    if (stop <= 6) return;
    RW_IDX();
    { LAS bf16_t* Uw = UI + w * 512; LAS bf16_t* Xw = XI + (16 * w) * RW_LD;
#pragma unroll
      for (int b = 0; b < 4; ++b) { f32x4 acc = *(const LAS f32x4*)(RHST + (16 * w + r) * 64 + 16 * b + 4 * g);
#pragma unroll
          for (int k0 = 0; k0 < 16 * b; k0 += 32) acc = mfma16(frag_row(AI, RW_LD, 16 * b, k0, lane), frag_row(Xw, RW_LD, 0, k0, lane), acc);
          *(LAS u32x2*)(Uw + r * 32 + 4 * g) = pack4(acc);
          asm volatile("s_waitcnt lgkmcnt(0)" ::: "memory");
          f32x4 x = {0.f, 0.f, 0.f, 0.f}; x = mfma16(frag_row(DI + b * 512, 32, 0, 0, lane), frag_row(Uw, 32, 0, 0, lane), x);
          *(LAS u32x2*)(Xw + r * RW_LD + 16 * b + 4 * g) = pack4(x);
          asm volatile("s_waitcnt lgkmcnt(0)" ::: "memory"); } }
    WG_SYNC();
    if (stop <= 7) return;
    RW_IDX();
    { const int o = w >> 1; const LAS bf16_t* WHt = XI; const LAS bf16_t* XTt = XI + 64 * RW_LD;
#pragma unroll
      for (int tt = 0; tt < 8; ++tt) { const int tile = (w & 1) * 8 + tt, ti = tile >> 2, tj = tile & 3; f32x4 c1 = {0.f, 0.f, 0.f, 0.f}, c2 = c1;
          if (o == 0) {
#pragma unroll
              for (int k0 = 0; k0 < 64; k0 += 32) c1 = mfma16(frag_row(WHt, RW_LD, 16 * ti, k0, lane), frag_tr(BTi, RW_LD, 16 * tj, k0, lane), c1);
              const int kq = 16 * tj + r; const float dg = fexp(CUMC[kq]); f32x4 gv;
#pragma unroll
              for (int e = 0; e < 4; ++e) gv[e] = ((16 * ti + 4 * g + e) == kq ? dg : 0.f) - c1[e];
              *(u32x2*)((bf16_t*)(a.ws + WS_RW_G) + (size_t)tk * 4096 + fo_st(tj, 2, 16 * ti, g, r)) = pack4(gv);
          } else if (o == 1) {
#pragma unroll
              for (int k0 = 0; k0 < 64; k0 += 32) { c1 = mfma16(frag_tr(KTi, RW_LD, 16 * ti, k0, lane), frag_tr(Vi, RW_LD, 16 * tj, k0, lane), c1); c2 = mfma16(frag_tr(BTi, RW_LD, 16 * ti, k0, lane), frag_row(XTt, RW_LD, 16 * tj, k0, lane), c2); }
              *(u32x2*)((bf16_t*)(a.ws + WS_RW_Z) + (size_t)tk * 4096 + co_off(tj, 4, ti, lane)) = pack4(c1 - c2);
          } else if (o == 2) {
#pragma unroll
              for (int k0 = 0; k0 < 64; k0 += 32) c1 = mfma16(frag_row(WHt, RW_LD, 16 * ti, k0, lane), frag_row(PBI, RW_LD, 16 * tj, k0, lane), c1);
              const int tq = 16 * tj + r; const f32x4 rh = unpack4(*(const LAS u32x2*)(RHi + tq * RW_LD + 16 * ti + 4 * g));
              *(u32x2*)((bf16_t*)(a.ws + WS_RW_QT) + (size_t)tk * 4096 + fo_st(tj, 2, 16 * ti, g, r)) = pack4(rh - c1);
          } else {
#pragma unroll
              for (int k0 = 0; k0 < 64; k0 += 32) { c1 = mfma16(frag_tr(Vi, RW_LD, 16 * ti, k0, lane), frag_row(PKI, RW_LD, 16 * tj, k0, lane), c1); c2 = mfma16(frag_row(XTt, RW_LD, 16 * ti, k0, lane), frag_row(PBI, RW_LD, 16 * tj, k0, lane), c2); }
              *(u32x2*)((bf16_t*)(a.ws + WS_RW_YI) + (size_t)tk * 4096 + co_off(tj, 4, ti, lane)) = pack4(c1 - c2);
          } } }
    WG_SYNC();
#undef RW_IDX
}
__device__ __forceinline__ void rw_stage2(CArgs& a, int h, int vs, LAS unsigned char* lds, int tid) {
    const int lane = tid & 63, w = __builtin_amdgcn_readfirstlane(tid >> 6), r = lane & 15, g = lane >> 4;
    LAS bf16_t* Si = (LAS bf16_t*)lds;
    const bf16_t* G = (const bf16_t*)(a.ws + WS_RW_G); const bf16_t* Z = (const bf16_t*)(a.ws + WS_RW_Z); bf16_t* S = (bf16_t*)(a.ws + WS_RW_S);
    if (w < 4) { *(LAS u32x2*)(Si + r * RW_LD + 16 * w + 4 * g) = (u32x2){0u, 0u}; *(u32x2*)(S + (size_t)h * 4096 + fo_st(vs, 2, 16 * w, g, r)) = (u32x2){0u, 0u}; }
    WG_SYNC();
    constexpr int PD = 8; const int wq = w & 3; const int so = fo_st(vs, 2, 16 * wq, g, r), zo = co_off(vs, 4, wq, lane);
    bf16x8 gf[PD][2]; u32x2 zf[PD];
#pragma unroll
    for (int u = 0; u < PD; ++u) { const size_t tk = (size_t)u * 8 + h; zf[u] = *(const u32x2*)(Z + tk * 4096 + zo); gf[u][0] = frag_fo(G + tk * 4096, 2, wq, 0, lane); gf[u][1] = frag_fo(G + tk * 4096, 2, wq, 1, lane); }
#define RW_STEP(n_, u_, REFILL) do { const int n = (n_); const size_t tk = (size_t)n * 8 + h; const int cur = n & 1; \
            f32x4 acc = unpack4(zf[u_]), acc2 = {0.f, 0.f, 0.f, 0.f}; \
            acc = mfma16(gf[u_][0], frag_row(Si + cur * 16 * RW_LD, RW_LD, 0, 0, lane), acc); acc2 = mfma16(gf[u_][1], frag_row(Si + cur * 16 * RW_LD, RW_LD, 0, 32, lane), acc2); \
            if (REFILL) { const int nn = n + PD < NCH - 1 ? n + PD : NCH - 2; const size_t tn = (size_t)nn * 8 + h; zf[u_] = *(const u32x2*)(Z + tn * 4096 + zo); gf[u_][0] = frag_fo(G + tn * 4096, 2, wq, 0, lane); gf[u_][1] = frag_fo(G + tn * 4096, 2, wq, 1, lane); } \
            const u32x2 pv = pack4(acc + acc2); \
            if (w < 4) { *(LAS u32x2*)(Si + (cur ^ 1) * 16 * RW_LD + r * RW_LD + 16 * wq + 4 * g) = pv; *(u32x2*)(S + (tk + 8) * 4096 + so) = pv; } \
            asm volatile("s_waitcnt lgkmcnt(0)" ::: "memory"); __builtin_amdgcn_s_barrier(); asm volatile("" ::: "memory"); } while (0)
#pragma unroll
    for (int nq = 0; nq < NCH - 1; ++nq) RW_STEP(nq, nq % PD, nq + PD < NCH - 1);
#undef RW_STEP
}
__device__ __forceinline__ void rw_stage3(CArgs& a, int l, int n, int h, LAS unsigned char* lds, int tid) {
    const int lane = tid & 63, w = __builtin_amdgcn_readfirstlane(tid >> 6), r = lane & 15, g = lane >> 4, jc = w & 3, wh = w >> 2;
    const size_t tk = (size_t)n * 8 + h; const int c = 16 * jc + r, t = n * 64 + c;
    const bf16_t* S = (const bf16_t*)(a.ws + WS_RW_S) + tk * 4096; const bf16_t* QT = (const bf16_t*)(a.ws + WS_RW_QT) + tk * 4096; const bf16_t* YI = (const bf16_t*)(a.ws + WS_RW_YI) + tk * 4096;
    LAS float* xs = (LAS float*)lds;
    f32x4 acc[2];
#pragma unroll
    for (int tt = 0; tt < 2; ++tt) { const int iv = 2 * wh + tt; acc[tt] = unpack4(*(const u32x2*)(YI + co_off(jc, 4, iv, lane)));
#pragma unroll
        for (int k = 0; k < 2; ++k) acc[tt] = mfma16(frag_fo(S, 2, iv, k, lane), frag_fo(QT, 2, jc, k, lane), acc[tt]); }
    float s1 = (acc[0][0] + acc[0][1]) + (acc[0][2] + acc[0][3]) + (acc[1][0] + acc[1][1]) + (acc[1][2] + acc[1][3]);
    s1 += __shfl_xor(s1, 16); s1 += __shfl_xor(s1, 32);
    if (g == 0) xs[w * 16 + r] = s1;
    WG_SYNC();
    const float mu = (s1 + xs[(w ^ 4) * 16 + r]) * (1.0f / 64.0f); float s2 = 0.f;
#pragma unroll
    for (int tt = 0; tt < 2; ++tt)
#pragma unroll
        for (int e = 0; e < 4; ++e) { acc[tt][e] -= mu; s2 += acc[tt][e] * acc[tt][e]; }
    s2 += __shfl_xor(s2, 16); s2 += __shfl_xor(s2, 32);
    if (g == 0) xs[128 + w * 16 + r] = s2;
    WG_SYNC();
    const float rs = 1.0f / sqrtf((s2 + xs[128 + (w ^ 4) * 16 + r]) * (1.0f / 64.0f) + 64e-5f);
    const bf16_t* E = (const bf16_t*)(a.ws + WS_RW_E) + tk * 4096; const bf16_t* GT = (const bf16_t*)(a.ws + WS_RW_GT) + tk * 4096;
    bf16_t* O = (bf16_t*)(a.ws + WS_O) + (size_t)t * D + 1536 + h * 64;
#pragma unroll
    for (int tt = 0; tt < 2; ++tt) { const int v0 = 16 * (2 * wh + tt) + 4 * g; const int eo_ = co_off(jc, 4, 2 * wh + tt, lane); const f32x4 ev = unpack4(*(const u32x2*)(E + eo_)), gv = unpack4(*(const u32x2*)(GT + eo_));
        const f32x4 lw = *(const f32x4*)(LP(I_RWLNW, 512) + h * 64 + v0), lb = *(const f32x4*)(LP(I_RWLNB, 512) + h * 64 + v0); f32x4 y;
#pragma unroll
        for (int e = 0; e < 4; ++e) y[e] = (acc[tt][e] * rs * lw[e] + lb[e] + ev[e]) * gv[e];
        *(u32x2*)(O + v0) = pack4(y); }
    WG_SYNC();
}

constexpr int M2_LDS = 136, M2_LDX = 264, M2O_B = 0, M2O_C = 17408, M2O_X = 34816, M2O_XW = 68608, M2O_M = 102400, M2O_DT = 139264, M2O_G = 140288, M2O_GL = 141312;
__device__ __forceinline__ void m2_stage1(CArgs& a, int l, int n, int gr, LAS unsigned char* lds, int tid) {
    const int lane = tid & 63, w = __builtin_amdgcn_readfirstlane(tid >> 6), r = lane & 15, g = lane >> 4;
    LAS bf16_t* Bi = (LAS bf16_t*)(lds + M2O_B); LAS bf16_t* Ci = (LAS bf16_t*)(lds + M2O_C); LAS bf16_t* Xi = (LAS bf16_t*)(lds + M2O_X); LAS bf16_t* XWi = (LAS bf16_t*)(lds + M2O_XW); LAS bf16_t* Mi = (LAS bf16_t*)(lds + M2O_M);
    LAS float* DT = (LAS float*)(lds + M2O_DT); LAS float* GC = (LAS float*)(lds + M2O_G); LAS float* GLAST = (LAS float*)(lds + M2O_GL);
    const int t0 = n * 64;
    LAS bf16_t* RAW = (LAS bf16_t*)(lds + M2O_XW);
    { v4u sv[9];
#pragma unroll
      for (int i = 0; i < 9; ++i) { const int idx = tid + 512 * i, row = idx >> 6, ch = idx & 63, t = t0 - 3 + row; sv[i] = (v4u){0u, 0u, 0u, 0u};
          const int col = ch < 32 ? gr * 256 + 8 * ch : (ch < 48 ? 512 + gr * 128 + 8 * (ch - 32) : 768 + gr * 128 + 8 * (ch - 48));
          if (idx < 67 * 64 && t >= 0) sv[i] = *(const v4u*)(PROJROW(t) + C_MXBC + col); }
#pragma unroll
      for (int i = 0; i < 9; ++i) { const int idx = tid + 512 * i; if (idx < 67 * 64) *(LAS v4u*)(RAW + (idx >> 6) * 512 + 8 * (idx & 63)) = sv[i]; } }
    WG_SYNC();
    for (int it = tid; it < 512 * 4; it += 512) { const int lc = it & 511, seg = it >> 9; int col; LAS bf16_t* dst; int dld;
      if (lc < 256) { col = gr * 256 + lc; dst = Xi + lc; dld = M2_LDX; } else if (lc < 384) { col = 512 + gr * 128 + (lc - 256); dst = Bi + (lc - 256); dld = M2_LDS; } else { col = 768 + gr * 128 + (lc - 384); dst = Ci + (lc - 384); dld = M2_LDS; }
      const float* cw = LP(I_MCONV, 4 * 1024) + col; const float w0 = cw[0], w1 = cw[1024], w2 = cw[2048], w3 = cw[3072], cb = LP(I_MCONVB, 1024)[col];
      const LAS bf16_t* src = RAW + (16 * seg) * 512 + lc;
      float x0 = bf2f(src[0]), x1 = bf2f(src[512]), x2 = bf2f(src[1024]);
#pragma unroll
      for (int cc = 0; cc < 16; ++cc) { const float x3 = bf2f(src[(cc + 3) * 512]); const float y = silu_f(w0 * x0 + w1 * x1 + w2 * x2 + w3 * x3 + cb); dst[(16 * seg + cc) * dld] = (bf16_t)f2bf(y); x0 = x1; x1 = x2; x2 = x3; } }
    if (tid < 256) { const int c = tid >> 2, hh = tid & 3, hd = gr * 4 + hh; const float dt = softplus_f(bf2f(PROJROW(t0 + c)[C_MDT + hd]) + LP(I_MDTB, 8)[hd]); DT[c * 4 + hh] = dt; GC[c * 4 + hh] = -fexp(LP(I_MALOG, 8)[hd]) * dt; }
    WG_SYNC();
    if (tid < 4) { float cu = 0.f; for (int c = 0; c < 64; ++c) { cu += GC[c * 4 + tid]; GC[c * 4 + tid] = cu; } GLAST[tid] = cu; WSF(WS_M2_DEC)[n * 8 + gr * 4 + tid] = fexp(cu); }
    WG_SYNC();
    { const int c = tid >> 3, q = tid & 7;
      const int hh = q >> 1; const float sc = DT[c * 4 + hh] * fexp(GLAST[hh] - GC[c * 4 + hh]);
#pragma unroll
      for (int u = 0; u < 4; ++u) { const v4u xv = *(const LAS v4u*)(Xi + c * M2_LDX + 32 * q + 8 * u); v4u o;
#pragma unroll
          for (int e = 0; e < 4; ++e) o[e] = pk2(__uint_as_float(xv[e] << 16) * sc, __uint_as_float(xv[e] & 0xffff0000u) * sc);
          *(LAS v4u*)(XWi + c * M2_LDX + 32 * q + 8 * u) = o; }
      const float eg = fexp(GC[c * 4 + hh]); bf16_t* QH = (bf16_t*)(a.ws + WS_M2_QH) + (size_t)(n * 8 + gr * 4 + hh) * 8192;
#pragma unroll
      for (int u = 0; u < 8; ++u) { const v4u cv = *(const LAS v4u*)(Ci + c * M2_LDS + 64 * (q & 1) + 8 * u); v4u o;
#pragma unroll
          for (int e = 0; e < 4; ++e) o[e] = pk2(__uint_as_float(cv[e] << 16) * eg, __uint_as_float(cv[e] & 0xffff0000u) * eg);
          { const int s0 = 64 * (q & 1) + 8 * u; *(v4u*)(QH + (((c >> 4) * 4 + (s0 >> 5)) * 64 + ((s0 >> 3) & 3) * 16 + (c & 15)) * 8) = o; } } }
#pragma unroll
    for (int tt = 0; tt < 2; ++tt) { const int tile = 2 * w + tt, im = tile >> 2, jc = tile & 3; f32x4 acc = {0.f, 0.f, 0.f, 0.f};
        if (jc >= im) {
#pragma unroll
            for (int k0 = 0; k0 < 128; k0 += 32) acc = mfma16(frag_row(Bi, M2_LDS, 16 * im, k0, lane), frag_row(Ci, M2_LDS, 16 * jc, k0, lane), acc); }
        const int cq = 16 * jc + r;
#pragma unroll
        for (int hh = 0; hh < 4; ++hh) { f32x4 mv; const float gc = GC[cq * 4 + hh];
#pragma unroll
            for (int e = 0; e < 4; ++e) { const int m = 16 * im + 4 * g + e; mv[e] = cq >= m ? acc[e] * fexp(gc - GC[m * 4 + hh]) * DT[m * 4 + hh] : 0.f; }
            *(LAS u32x2*)(Mi + hh * 64 * 72 + cq * 72 + 16 * im + 4 * g) = pack4(mv); } }
    WG_SYNC();
    { const int hh = w >> 1, hd = gr * 4 + hh; const size_t tk = (size_t)n * 8 + hd; const float Dh = LP(I_MD, 8)[hd];
      bf16_t* YI = (bf16_t*)(a.ws + WS_M2_YI) + tk * 4096; bf16_t* Z = (bf16_t*)(a.ws + WS_M2_Z) + tk * 8192;
#pragma unroll
      for (int tt = 0; tt < 8; ++tt) { const int tile = (w & 1) * 8 + tt, ip = tile >> 2, jc = tile & 3; f32x4 acc = {0.f, 0.f, 0.f, 0.f};
#pragma unroll
          for (int k0 = 0; k0 < 64; k0 += 32) acc = mfma16(frag_tr(Xi, M2_LDX, 64 * hh + 16 * ip, k0, lane), frag_row(Mi + hh * 64 * 72, 72, 16 * jc, k0, lane), acc);
          const int cq = 16 * jc + r; const f32x4 xv = unpack4(*(const LAS u32x2*)(Xi + cq * M2_LDX + 64 * hh + 16 * ip + 4 * g));
          *(u32x2*)(YI + co_off(jc, 4, ip, lane)) = pack4(acc + xv * Dh); }
#pragma unroll
      for (int tt = 0; tt < 16; ++tt) { const int tile = (w & 1) * 16 + tt, is = tile >> 2, jp = tile & 3; f32x4 acc = {0.f, 0.f, 0.f, 0.f};
#pragma unroll
          for (int k0 = 0; k0 < 64; k0 += 32) acc = mfma16(frag_tr(Bi, M2_LDS, 16 * is, k0, lane), frag_tr(XWi, M2_LDX, 64 * hh + 16 * jp, k0, lane), acc);
          *(u32x2*)(Z + fo_st(jp, 4, 16 * is, g, r)) = pack4(acc); } }
    WG_SYNC();
}
__device__ __forceinline__ void m2_stage2(CArgs& a, int b, int tid) {
    const int idx = b * 512 + tid, hd = idx >> 13, rem = idx & 8191;
    const bf16_t* Z = (const bf16_t*)(a.ws + WS_M2_Z) + (size_t)hd * 8192 + rem; bf16_t* S = (bf16_t*)(a.ws + WS_M2_S) + (size_t)hd * 8192 + rem; const float* DEC = WSF(WS_M2_DEC) + hd; float s = 0.f;
#pragma unroll 32
    for (int n = 0; n < NCH; ++n) { const float z = bf2f(Z[(size_t)n * 8 * 8192]), dc = DEC[n * 8]; S[(size_t)n * 8 * 8192] = (bf16_t)f2bf(s); s = dc * s + z; }
}
__device__ __forceinline__ void m2_stage3(CArgs& a, int l, int n, int gr, LAS unsigned char* lds, int tid) {
    const int lane = tid & 63, w = __builtin_amdgcn_readfirstlane(tid >> 6), r = lane & 15, g = lane >> 4, hh = w >> 1, hd = gr * 4 + hh;
    const size_t tk = (size_t)n * 8 + hd;
    const bf16_t* S = (const bf16_t*)(a.ws + WS_M2_S) + tk * 8192; const bf16_t* QH = (const bf16_t*)(a.ws + WS_M2_QH) + tk * 8192; const bf16_t* YI = (const bf16_t*)(a.ws + WS_M2_YI) + tk * 4096;
    LAS float* xs = (LAS float*)lds;
    f32x4 acc[2][4]; float ss[2];
#pragma unroll
    for (int cj = 0; cj < 2; ++cj) { const int jc = 2 * (w & 1) + cj, c = 16 * jc + r, t = n * 64 + c; const bf16_t* pz = PROJROW(t) + C_MZ + hd * 64; ss[cj] = 0.f;
#pragma unroll
        for (int ip = 0; ip < 4; ++ip) { acc[cj][ip] = unpack4(*(const u32x2*)(YI + co_off(jc, 4, ip, lane)));
#pragma unroll
            for (int k = 0; k < 4; ++k) acc[cj][ip] = mfma16(frag_fo(S, 4, ip, k, lane), frag_fo(QH, 4, jc, k, lane), acc[cj][ip]);
            const f32x4 zv = unpack4(*(const u32x2*)(pz + 16 * ip + 4 * g));
#pragma unroll
            for (int e = 0; e < 4; ++e) { acc[cj][ip][e] *= silu_f(zv[e]); ss[cj] += acc[cj][ip][e] * acc[cj][ip][e]; } }
        ss[cj] += __shfl_xor(ss[cj], 16); ss[cj] += __shfl_xor(ss[cj], 32);
        if (g == 0) xs[w * 32 + cj * 16 + r] = ss[cj]; }
    WG_SYNC();
#pragma unroll
    for (int cj = 0; cj < 2; ++cj) { const int jc = 2 * (w & 1) + cj, c = 16 * jc + r, t = n * 64 + c;
        const float tot = xs[((w & 1) + 0) * 32 + cj * 16 + r] + xs[((w & 1) + 2) * 32 + cj * 16 + r] + xs[((w & 1) + 4) * 32 + cj * 16 + r] + xs[((w & 1) + 6) * 32 + cj * 16 + r];
        const float rs = 1.0f / sqrtf(tot * (1.0f / 256.0f) + 1e-6f);
        const float* nw = LP(I_MNORM, 512) + hd * 64; bf16_t* O = (bf16_t*)(a.ws + WS_O) + (size_t)t * D + 1024 + hd * 64;
#pragma unroll
        for (int ip = 0; ip < 4; ++ip) { const f32x4 wv = *(const f32x4*)(nw + 16 * ip + 4 * g); f32x4 y;
#pragma unroll
            for (int e = 0; e < 4; ++e) y[e] = acc[cj][ip][e] * rs * wv[e];
            *(u32x2*)(O + 16 * ip + 4 * g) = pack4(y); } }
    WG_SYNC();
}

constexpr int GD_LD = 136;
constexpr int GDO_K = 0, GDO_V = 17408, GDO_KT = 34816, GDO_QG = 52224, GDO_Q = 69632, GDO_AI = 87040, GDO_AMD = 96256, GDO_DI = 100352, GDO_AQ = 104448, GDO_XI = 113664, GDO_QF = 87040, GDO_KF = 119808, GDO_SM = 152576, GDO_UI = 153600;
__device__ __forceinline__ void gd_stage1(CArgs& a, int l, int n, int h, LAS unsigned char* lds, int tid, const int stop = 99) {
    const int w = __builtin_amdgcn_readfirstlane(tid >> 6), tk = n * 4 + h, t0 = n * 64;
    int lane, r, g, c, q8;
#define GD_IDX() do { int tl_ = tid; asm volatile("" : "+v"(tl_)); lane = tl_ & 63; r = lane & 15; g = lane >> 4; c = tl_ >> 3; q8 = tl_ & 7; } while (0)
    LAS bf16_t* Ki = (LAS bf16_t*)(lds + GDO_K); LAS bf16_t* Vi = (LAS bf16_t*)(lds + GDO_V); LAS bf16_t* KTi = (LAS bf16_t*)(lds + GDO_KT); LAS bf16_t* QGi = (LAS bf16_t*)(lds + GDO_QG); LAS bf16_t* Qi = (LAS bf16_t*)(lds + GDO_Q);
    LAS bf16_t* AI = (LAS bf16_t*)(lds + GDO_AI);
    LAS float* AMD = (LAS float*)(lds + GDO_AMD);
    LAS bf16_t* DI = (LAS bf16_t*)(lds + GDO_DI);
    LAS bf16_t* AQ = (LAS bf16_t*)(lds + GDO_AQ);
    LAS bf16_t* XI = (LAS bf16_t*)(lds + GDO_XI);
    LAS bf16_t* UI = (LAS bf16_t*)(lds + GDO_UI);
    LAS float* QF = (LAS float*)(lds + GDO_QF); LAS float* KF = (LAS float*)(lds + GDO_KF);
    LAS float* BETA = (LAS float*)(lds + GDO_SM); LAS float* GC = BETA + 64; LAS float* BG = GC + 64;
    LAS bf16_t* RAW = (LAS bf16_t*)(lds + GDO_KT);
    { v4u sv[7];
#pragma unroll
      for (int i = 0; i < 7; ++i) { const int idx = tid + 512 * i, row = idx / 48, ch = idx % 48, which = ch >> 4, t = t0 - 3 + row; sv[i] = (v4u){0u, 0u, 0u, 0u};
          if (idx < 67 * 48 && t >= 0) sv[i] = *(const v4u*)(PROJROW(t) + C_GQ + which * 512 + h * 128 + 8 * (ch & 15)); }
#pragma unroll
      for (int i = 0; i < 7; ++i) { const int idx = tid + 512 * i; if (idx < 67 * 48) *(LAS v4u*)(RAW + (idx / 48) * 384 + 8 * (idx % 48)) = sv[i]; } }
    WG_SYNC();
    for (int it = tid; it < 384 * 4; it += 512) { const int col = it % 384, seg = it / 384, which = col >> 7, dcol = col & 127, cwi = which * 512 + h * 128 + dcol;
        const float* cw = LP(I_GCONV, 4 * 1536) + cwi; const float w0 = cw[0], w1 = cw[1536], w2 = cw[3072], w3 = cw[4608];
        const LAS bf16_t* src = RAW + (16 * seg) * 384 + col;
        float x0 = bf2f(src[0]), x1 = bf2f(src[384]), x2 = bf2f(src[768]);
#pragma unroll
        for (int cc = 0; cc < 16; ++cc) { const float x3 = bf2f(src[(cc + 3) * 384]); const float y = silu_f(w0 * x0 + w1 * x1 + w2 * x2 + w3 * x3); const int tok = 16 * seg + cc;
            if (which == 2) Vi[tok * GD_LD + dcol] = (bf16_t)f2bf(y); else (which == 0 ? QF : KF)[tok * 128 + dcol] = y;
            x0 = x1; x1 = x2; x2 = x3; } }
    if (tid >= 384 && tid < 448) { const int cc = tid - 384; const bf16_t* pr = PROJROW(t0 + cc);
        const float beta = sigmoid_f(bf2f(pr[C_GB + h])); float cu = -fexp(LP(I_GALOG, 4)[h]) * softplus_f(bf2f(pr[C_GA + h]) + LP(I_GDTB, 4)[h]);
#pragma unroll
        for (int o = 1; o < 64; o <<= 1) { const float up = __shfl_up(cu, o); if (cc >= o) cu += up; }
        BETA[cc] = beta; GC[cc] = cu; BG[cc] = beta * fexp(cu); }
    WG_SYNC();
    GD_IDX();
    if (stop <= 0) return;
    { float qv[16], kv[16]; float sq = 0.f, sk = 0.f;
#pragma unroll
      for (int u = 0; u < 4; ++u) { const f32x4 a4 = *(const LAS f32x4*)(QF + c * 128 + 16 * q8 + 4 * u), b4 = *(const LAS f32x4*)(KF + c * 128 + 16 * q8 + 4 * u);
#pragma unroll
          for (int e = 0; e < 4; ++e) { qv[4 * u + e] = a4[e]; kv[4 * u + e] = b4[e]; sq += a4[e] * a4[e]; sk += b4[e] * b4[e]; } }
      sq += __shfl_xor(sq, 1); sq += __shfl_xor(sq, 2); sq += __shfl_xor(sq, 4); sk += __shfl_xor(sk, 1); sk += __shfl_xor(sk, 2); sk += __shfl_xor(sk, 4);
      const float gc = GC[c], iq = (1.0f / sqrtf(sq + 1e-6f)) * 0.08838834764831845f, ik = 1.0f / sqrtf(sk + 1e-6f), et = fexp(GC[63] - gc), eg = fexp(gc);
      v4u oK[2], oQ[2], oKT[2], oQG[2];
#pragma unroll
      for (int u = 0; u < 8; ++u) { const float k0 = kv[2 * u] * ik, k1 = kv[2 * u + 1] * ik, q0 = qv[2 * u] * iq, q1 = qv[2 * u + 1] * iq;
          oK[u >> 2][u & 3] = pk2(k0, k1); oQ[u >> 2][u & 3] = pk2(q0, q1); oKT[u >> 2][u & 3] = pk2(k0 * et, k1 * et); oQG[u >> 2][u & 3] = pk2(q0 * eg, q1 * eg); }
      const int o = c * GD_LD + 16 * q8;
      *(LAS v4u*)(Ki + o) = oK[0]; *(LAS v4u*)(Ki + o + 8) = oK[1]; *(LAS v4u*)(Qi + o) = oQ[0]; *(LAS v4u*)(Qi + o + 8) = oQ[1];
      *(LAS v4u*)(KTi + o) = oKT[0]; *(LAS v4u*)(KTi + o + 8) = oKT[1]; *(LAS v4u*)(QGi + o) = oQG[0]; *(LAS v4u*)(QGi + o + 8) = oQG[1]; }
    WG_SYNC();
    GD_IDX();
    if (stop <= 1) return;
#pragma unroll
    for (int tt = 0; tt < 2; ++tt) { const int tile = 2 * w + tt, im = tile >> 2, jc = tile & 3; f32x4 c1 = {0.f, 0.f, 0.f, 0.f}, c2 = c1;
        if (jc >= im) {
#pragma unroll
            for (int k0 = 0; k0 < 128; k0 += 32) { const bf16x8 fa = frag_row(Ki, GD_LD, 16 * im, k0, lane); c1 = mfma16(fa, frag_row(Ki, GD_LD, 16 * jc, k0, lane), c1); c2 = mfma16(fa, frag_row(Qi, GD_LD, 16 * jc, k0, lane), c2); }
            const int cq = 16 * jc + r; const float gc = GC[cq], bc = BETA[cq];
#pragma unroll
            for (int e = 0; e < 4; ++e) { const int m = 16 * im + 4 * g + e; const float dc = fexp(gc - GC[m]); c1[e] = m < cq ? c1[e] * dc * bc : 0.f; c2[e] = m <= cq ? c2[e] * dc : 0.f; } }
        const int cq = 16 * jc + r; *(LAS u32x2*)(AI + cq * 72 + 16 * im + 4 * g) = pack4(-c1); *(LAS u32x2*)(AQ + cq * 72 + 16 * im + 4 * g) = pack4(c2);
        if (im == jc) *(LAS f32x4*)(AMD + (im * 16 + r) * 16 + 4 * g) = c1; }
    WG_SYNC();
    GD_IDX();
    if (stop <= 2) return;
    { const int q = c * 8 + q8;
      if (q < 64) { const int b = q >> 4, j = q & 15; float d[16], av[16][16];
#pragma unroll
          for (int tq = 1; tq < 16; ++tq)
#pragma unroll
              for (int i = 0; i < tq; ++i) av[tq][i] = AMD[(b * 16 + tq) * 16 + i];
#pragma unroll
          for (int tq = 0; tq < 16; ++tq) d[tq] = tq == j ? 1.f : 0.f;
#pragma unroll
          for (int i = 0; i < 15; ++i)
#pragma unroll
              for (int tq = i + 1; tq < 16; ++tq) d[tq] -= av[tq][i] * d[i];
#pragma unroll
          for (int tq = 0; tq < 16; ++tq) { DI[(b * 16 + tq) * 32 + j] = (bf16_t)f2bf(d[tq]); DI[(b * 16 + tq) * 32 + 16 + j] = (bf16_t)0; } }
      for (int i = q; i < 256 * 72 / 8; i += 512) *(LAS v4u*)(XI + 8 * i) = (v4u){0u, 0u, 0u, 0u};
      *(LAS v4u*)(UI + w * 512 + lane * 8) = (v4u){0u, 0u, 0u, 0u}; }
    WG_SYNC();
    GD_IDX();
    if (stop <= 3) return;
    { LAS bf16_t* Uw = UI + w * 512;
#pragma unroll
      for (int tt = 0; tt < 2; ++tt) { const int nt = 2 * w + tt; LAS bf16_t* Xw = XI + (16 * nt) * 72;
          const LAS bf16_t* src = nt < 8 ? Vi + 16 * nt + r : Ki + 16 * (nt - 8) + r; const LAS float* scl = nt < 8 ? BETA : BG;
#pragma unroll
          for (int b = 0; b < 4; ++b) { const f32x4 sc = *(const LAS f32x4*)(scl + 16 * b + 4 * g); f32x4 acc;
#pragma unroll
              for (int e = 0; e < 4; ++e) acc[e] = bf2f(src[(16 * b + 4 * g + e) * GD_LD]) * sc[e];
#pragma unroll
              for (int k0 = 0; k0 < 16 * b; k0 += 32) acc = mfma16(frag_row(AI, 72, 16 * b, k0, lane), frag_row(Xw, 72, 0, k0, lane), acc);
              *(LAS u32x2*)(Uw + r * 32 + 4 * g) = pack4(acc);
              asm volatile("s_waitcnt lgkmcnt(0)" ::: "memory");
              f32x4 x = {0.f, 0.f, 0.f, 0.f}; x = mfma16(frag_row(DI + b * 512, 32, 0, 0, lane), frag_row(Uw, 32, 0, 0, lane), x);
              *(LAS u32x2*)(Xw + r * 72 + 16 * b + 4 * g) = pack4(x);
              asm volatile("s_waitcnt lgkmcnt(0)" ::: "memory"); } } }
    WG_SYNC();
    GD_IDX();
    if (stop <= 4) return;
    { const int jc = w & 3, wh = w >> 2; const int cq = 16 * jc + r;
      bf16_t* QT = (bf16_t*)(a.ws + WS_GD_QT) + (size_t)tk * 8192; bf16_t* YI = (bf16_t*)(a.ws + WS_GD_YI) + (size_t)tk * 8192; bf16_t* GG = (bf16_t*)(a.ws + WS_GD_G) + (size_t)tk * 16384; bf16_t* Z = (bf16_t*)(a.ws + WS_GD_Z) + (size_t)tk * 16384;
#pragma unroll
      for (int tt = 0; tt < 4; ++tt) { const int id = 4 * wh + tt; f32x4 c1 = {0.f, 0.f, 0.f, 0.f}, c2 = c1;
#pragma unroll
          for (int k0 = 0; k0 < 64; k0 += 32) { const bf16x8 fb = frag_row(AQ, 72, 16 * jc, k0, lane); c1 = mfma16(frag_row(XI + 128 * 72, 72, 16 * id, k0, lane), fb, c1); c2 = mfma16(frag_row(XI, 72, 16 * id, k0, lane), fb, c2); }
          const f32x4 qg = unpack4(*(const LAS u32x2*)(QGi + cq * GD_LD + 16 * id + 4 * g));
          *(u32x2*)(QT + fo_st(jc, 4, 16 * id, g, r)) = pack4(qg - c1); *(u32x2*)(YI + co_off(jc, 8, id, lane)) = pack4(c2); }
      const float e63 = fexp(GC[63]);
#pragma unroll
      for (int ti = 0; ti < 8; ++ti) { f32x4 c1 = {0.f, 0.f, 0.f, 0.f}, c2 = c1;
#pragma unroll
          for (int k0 = 0; k0 < 64; k0 += 32) { c1 = mfma16(frag_row(XI + 128 * 72, 72, 16 * ti, k0, lane), frag_tr(KTi, GD_LD, 16 * w, k0, lane), c1); c2 = mfma16(frag_tr(KTi, GD_LD, 16 * ti, k0, lane), frag_row(XI, 72, 16 * w, k0, lane), c2); }
          const int dq = 16 * w + r; f32x4 gv;
#pragma unroll
          for (int e = 0; e < 4; ++e) gv[e] = ((16 * ti + 4 * g + e) == dq ? e63 : 0.f) - c1[e];
          *(u32x2*)(GG + fo_st(w, 4, 16 * ti, g, r)) = pack4(gv); *(u32x2*)(Z + co_off(w, 8, ti, lane)) = pack4(c2); } }
    WG_SYNC();
#undef GD_IDX
}
__device__ __forceinline__ void gd_stage2(CArgs& a, int h, int es, LAS unsigned char* lds, int tid, const int var = 0) {
    const int lane = tid & 63, w = __builtin_amdgcn_readfirstlane(tid >> 6), r = lane & 15, g = lane >> 4;
    LAS bf16_t* Si = (LAS bf16_t*)lds;
    const bf16_t* G = (const bf16_t*)(a.ws + WS_GD_G); const bf16_t* Z = (const bf16_t*)(a.ws + WS_GD_Z); bf16_t* S = (bf16_t*)(a.ws + WS_GD_S);
    const int so = fo_st(es, 4, 16 * w, g, r), zo = co_off(es, 8, w, lane);
    *(LAS u32x2*)(Si + r * GD_LD + 16 * w + 4 * g) = (u32x2){0u, 0u}; *(u32x2*)(S + (size_t)h * 16384 + so) = (u32x2){0u, 0u};
    WG_SYNC();
    constexpr int PD = 8;
    bf16x8 gf[PD][4]; u32x2 zf[PD];
#pragma unroll
    for (int u = 0; u < PD; ++u) { const size_t tk = (size_t)u * 4 + h; zf[u] = *(const u32x2*)(Z + tk * 16384 + zo);
#pragma unroll
        for (int k = 0; k < 4; ++k) gf[u][k] = frag_fo(G + tk * 16384, 4, w, k, lane); }
#define GD_STEP(n_, u_, REFILL) do { const int n = (n_); const size_t tk = (size_t)n * 4 + h; const int cur = n & 1; \
            f32x4 acc = unpack4(zf[u_]), acc2 = {0.f, 0.f, 0.f, 0.f}; \
            acc = mfma16(gf[u_][0], frag_row(Si + cur * 16 * GD_LD, GD_LD, 0, 0, lane), acc); acc2 = mfma16(gf[u_][1], frag_row(Si + cur * 16 * GD_LD, GD_LD, 0, 32, lane), acc2); \
            acc = mfma16(gf[u_][2], frag_row(Si + cur * 16 * GD_LD, GD_LD, 0, 64, lane), acc); acc2 = mfma16(gf[u_][3], frag_row(Si + cur * 16 * GD_LD, GD_LD, 0, 96, lane), acc2); \
            if (REFILL && !(var & 2)) { const int nn = n + PD < NCH - 1 ? n + PD : NCH - 2; const size_t tn = (size_t)nn * 4 + h; zf[u_] = *(const u32x2*)(Z + tn * 16384 + zo); \
                _Pragma("unroll") for (int k = 0; k < 4; ++k) gf[u_][k] = frag_fo(G + tn * 16384, 4, w, k, lane); } \
            const u32x2 pv = pack4(acc + acc2); \
            if (!(var & 4)) *(LAS u32x2*)(Si + (cur ^ 1) * 16 * GD_LD + r * GD_LD + 16 * w + 4 * g) = pv; if (!(var & 1)) *(u32x2*)(S + (tk + 4) * 16384 + so) = pv; \
            if (!(var & 4)) { asm volatile("s_waitcnt lgkmcnt(0)" ::: "memory"); __builtin_amdgcn_s_barrier(); } asm volatile("" ::: "memory"); } while (0)
#pragma unroll
    for (int nq = 0; nq < NCH - 1; ++nq) GD_STEP(nq, nq % PD, nq + PD < NCH - 1);
#undef GD_STEP
}
__device__ __forceinline__ void gd_stage3(CArgs& a, int l, int n, int h, LAS unsigned char* lds, int tid) {
    const int lane = tid & 63, w = __builtin_amdgcn_readfirstlane(tid >> 6), r = lane & 15, g = lane >> 4, jc = w & 3, wh = w >> 2;
    const size_t tk = (size_t)n * 4 + h; const int c = 16 * jc + r, t = n * 64 + c;
    const bf16_t* S = (const bf16_t*)(a.ws + WS_GD_S) + tk * 16384; const bf16_t* QT = (const bf16_t*)(a.ws + WS_GD_QT) + tk * 8192; const bf16_t* YI = (const bf16_t*)(a.ws + WS_GD_YI) + tk * 8192;
    LAS float* xs = (LAS float*)lds;
    f32x4 acc[4]; float ss = 0.f;
#pragma unroll
    for (int tt = 0; tt < 4; ++tt) { const int ie = 4 * wh + tt; acc[tt] = unpack4(*(const u32x2*)(YI + co_off(jc, 8, ie, lane)));
#pragma unroll
        for (int k = 0; k < 4; ++k) acc[tt] = mfma16(frag_fo(S, 4, ie, k, lane), frag_fo(QT, 4, jc, k, lane), acc[tt]);
#pragma unroll
        for (int e = 0; e < 4; ++e) ss += acc[tt][e] * acc[tt][e]; }
    ss += __shfl_xor(ss, 16); ss += __shfl_xor(ss, 32);
    if (g == 0) xs[w * 16 + r] = ss;
    WG_SYNC();
    const float rs = 1.0f / sqrtf((ss + xs[(w ^ 4) * 16 + r]) * (1.0f / 128.0f) + 1e-6f);
    const float* nw = LP(I_GNORM, 128); const bf16_t* pz = PROJROW(t) + C_GZ + h * 128; bf16_t* O = (bf16_t*)(a.ws + WS_O) + (size_t)t * D + h * 128;
#pragma unroll
    for (int tt = 0; tt < 4; ++tt) { const int e0 = 16 * (4 * wh + tt) + 4 * g; const f32x4 zv = unpack4(*(const u32x2*)(pz + e0)), wv = *(const f32x4*)(nw + e0); f32x4 y;
#pragma unroll
        for (int e = 0; e < 4; ++e) y[e] = acc[tt][e] * rs * wv[e] * silu_f(zv[e]);
        *(u32x2*)(O + e0) = pack4(y); }
    WG_SYNC();
}

#define XB_TMO      128
#define XB_XCNT(j)  (256  + 64 * (j))
#define XB_XSUB(j)  (1280 + 64 * (j))
#define XB_XGEN(j)  (2304 + 64 * (j))
#define XB_TOP      3328
#define XB_TOPGEN   3392
#define XCD_BAR_WORDS 3456
#define XB_SPIN_CAP (1u << 20)
__device__ __forceinline__ unsigned xb_ld(unsigned* p)              { return __hip_atomic_load(p, __ATOMIC_RELAXED, __HIP_MEMORY_SCOPE_AGENT); }
__device__ __forceinline__ unsigned xb_add(unsigned* p, unsigned v) { return __hip_atomic_fetch_add(p, v, __ATOMIC_RELAXED, __HIP_MEMORY_SCOPE_AGENT); }
__device__ __forceinline__ unsigned xb_xcc_id() { return (unsigned)__builtin_amdgcn_s_getreg((3 << 11) | 20) & 0xFu; }
#define XB_SPIN(cond, bar) do { unsigned _sp = 0; while (cond) { __builtin_amdgcn_s_sleep(1); \
    if ((++_sp & 255u) == 0u) { if (xb_ld(&(bar)[XB_TMO])) break; if (_sp > XB_SPIN_CAP) { atomicAdd(&(bar)[XB_TMO], 1u); break; } } } } while (0)
struct XcdBarrier { unsigned* bar; unsigned x; volatile LAS unsigned* st; };
__device__ __forceinline__ XcdBarrier xcd_barrier_post(unsigned* bar, volatile LAS unsigned* st) {
    XcdBarrier b; b.bar = bar; b.x = xb_xcc_id(); b.st = st;
    if (threadIdx.x == 0) (void)xb_add(&bar[XB_XCNT(b.x)], 1u);
    return b;
}
__device__ __forceinline__ void xcd_barrier_complete(unsigned* bar, unsigned x, unsigned& nloc, unsigned& nx) {
    const unsigned G = gridDim.x * gridDim.y * gridDim.z;
    unsigned sum, cnt, mine, sp = 0u;
    for (;;) {
        sum = 0u; cnt = 0u; mine = 0u;
#pragma unroll
        for (unsigned j = 0; j < 16; ++j) { const unsigned c = xb_ld(&bar[XB_XCNT(j)]); sum += c; cnt += (c > 0u) ? 1u : 0u; mine = (j == x) ? c : mine; }
        if (sum == G) break;
        __builtin_amdgcn_s_sleep(1);
        if ((++sp & 255u) == 0u) { if (xb_ld(&bar[XB_TMO])) break; if (sp > XB_SPIN_CAP) { atomicAdd(&bar[XB_TMO], 1u); break; } }
    }
    nloc = mine > 0u ? mine : 1u; nx = cnt > 0u ? cnt : 1u;
}
__device__ __forceinline__ void xcd_barrier(const XcdBarrier& b) {
    asm volatile("s_waitcnt vmcnt(0)" ::: "memory");
    __syncthreads();
    if (threadIdx.x == 0) {
        unsigned* bar = b.bar;
        __builtin_amdgcn_s_waitcnt(0);
        unsigned nloc = b.st[0], nx = b.st[1];
        if (nloc == 0u) { xcd_barrier_complete(bar, b.x, nloc, nx); b.st[0] = nloc; b.st[1] = nx; }
        const unsigned old = xb_add(&bar[XB_XSUB(b.x)], 1u);
        const unsigned gen = old / nloc;
        if (old + 1u == (gen + 1u) * nloc) {
            __builtin_amdgcn_fence(__ATOMIC_RELEASE, "agent");
            asm volatile("s_waitcnt vmcnt(0)" ::: "memory");
            const unsigned og = xb_add(&bar[XB_TOP], 1u);
            const unsigned tg = og / nx;
            if (og + 1u == (tg + 1u) * nx) xb_add(&bar[XB_TOPGEN], 1u);
            else XB_SPIN(xb_ld(&bar[XB_TOPGEN]) == tg, bar);
            __builtin_amdgcn_fence(__ATOMIC_ACQUIRE, "agent");
            xb_add(&bar[XB_XGEN(b.x)], 1u);
            asm volatile("s_waitcnt vmcnt(0)" ::: "memory");
        } else {
            XB_SPIN(xb_ld(&bar[XB_XGEN(b.x)]) == gen, bar);
            __builtin_amdgcn_fence(__ATOMIC_ACQUIRE, "agent");
            asm volatile("s_waitcnt vmcnt(0)" ::: "memory");
        }
    }
    __syncthreads();
}

constexpr int CV_IN = (D / 64) * (PTP / 32), CV_OUT = (D / 64) * (D / 32), CV_UP = (D / 64) * (FF / 32), CV_DN = (FF / 64) * (D / 32), CV_ALL = CV_IN + CV_OUT + CV_UP + CV_DN;
__device__ __forceinline__ void cvt_items(CArgs& a, int l, int lo, int hi, int gwv, int ngwv, LAS float* scr, int lane) {
#pragma unroll 1
    for (int it = lo + gwv; it < hi; it += ngwv) {
        int r = it;
        if (r < CV_IN) { transpose_item(LP(I_WIN, (size_t)D * PT), D, PT, PTP, (bf16_t*)(a.ws + WS_WIN), scr, r, lane, LP(I_N1, D)); continue; } r -= CV_IN;
        if (r < CV_OUT) { transpose_item(LP(I_WOUT, (size_t)D * D), D, D, D, (bf16_t*)(a.ws + WS_WOUT), scr, r, lane); continue; } r -= CV_OUT;
        if (r < CV_UP) { transpose_item(LP(I_WUP, (size_t)D * FF), D, FF, FF, (bf16_t*)(a.ws + WS_WUP), scr, r, lane, LP(I_N2, D)); continue; } r -= CV_UP;
        transpose_item(LP(I_WDN, (size_t)FF * D), FF, D, D, (bf16_t*)(a.ws + WS_WDN), scr, r, lane);
    }
}

constexpr int CW_SUB = 8192;
__device__ __forceinline__ void cnt_arrive(unsigned* cnt) {
    asm volatile("s_waitcnt vmcnt(0)" ::: "memory"); __syncthreads();
    if (threadIdx.x == 0) { __builtin_amdgcn_fence(__ATOMIC_RELEASE, "agent"); asm volatile("s_waitcnt vmcnt(0)" ::: "memory"); (void)xb_add(cnt, 1u); }
}
__device__ __forceinline__ void cnt_wait(unsigned* cnt, unsigned want, unsigned* tmo) {
    if (threadIdx.x == 0) { unsigned sp = 0; while (xb_ld(cnt) < want) { __builtin_amdgcn_s_sleep(2); if ((++sp & 255u) == 0u) { if (xb_ld(tmo)) break; if (sp > XB_SPIN_CAP) { atomicAdd(tmo, 1u); break; } } }
        __builtin_amdgcn_fence(__ATOMIC_ACQUIRE, "agent"); asm volatile("s_waitcnt vmcnt(0)" ::: "memory"); }
    __syncthreads();
}

constexpr int N_PHASES = 1 + 9 * NL;

__device__ __forceinline__ void run_phase(CArgs& a, int ph, LAS unsigned char* lds, const int tid, const int bid, const int mask = 15) {
    const int lane = tid & 63, wave = __builtin_amdgcn_readfirstlane(tid >> 6);
    const int G = gridDim.x, gw = bid * NWAVES + wave, NGW = G * NWAVES;
    ss_t* SSb = (ss_t*)(a.ws + WS_SS);
    if (ph == N_PHASES - 1) {
        for (int t = gw; t < T; t += NGW) final_row((const bf16_t*)(a.ws + WS_HB) + (size_t)t * D, a.in[I_NF], (float)SSb[2 * NL * T + t] * SS_INV, a.out + (size_t)t * D, lane);
        return;
    }
    const int l = ph / 9, sp = ph % 9;
    bf16_t* HB = (bf16_t*)(a.ws + WS_HB);
    switch (sp) {
    case 0: {
        if (mask & 1) cvt_items(a, l, 0, CV_IN, gw, NGW, (LAS float*)(lds + wave * 16384), lane);
        if (mask & 2) for (int t = gw; t < T; t += NGW) hb_row(a.in[I_X] + (size_t)t * D, HB + (size_t)t * D, SSb + t, lane);
    } break;
    case 1: { pg8::Gemm g{HB, (const bf16_t*)(a.ws + WS_WIN)}; pg8::StaticOrder<T, PTP> S; S.init(G, bid);
              pg8::EpiBf16<false> E{(bf16_t*)(a.ws + WS_PROJ), PTP, SSb + l * T}; pg8::gemm_phase<D, pg8::EpiBf16<false>, pg8::StaticOrder<T, PTP>, true>(lds, g, S, E, tid);
              constexpr int NFULL = (T / 256) * (PTP / 256) % 256; if (bid >= NFULL) cvt_items(a, l, CV_IN, CV_IN + CV_OUT + CV_UP, (bid - NFULL) * NWAVES + wave, (G - NFULL) * NWAVES, (LAS float*)(lds + wave * 16384), lane); } break;
    case 2: {
#pragma unroll 1
              for (int it = bid; (mask & 1) && it < NCH * 4; it += G) gd_stage1(a, l, it >> 2, it & 3, lds, tid, mask >> 8 ? (mask >> 8) - 1 : 99);
#pragma unroll 1
              for (int it = bid; (mask & 4) && it < NCH * 8; it += G) rw_stage1(a, l, it >> 3, it & 7, lds, tid, mask >> 8 ? (mask >> 8) - 1 : 99);
#pragma unroll 1
              for (int it = bid; (mask & 8) && it < NCH * 2; it += G) m2_stage1(a, l, it >> 1, it & 1, lds, tid);
#pragma unroll 1
              for (int it = bid; (mask & 2) && it < NCH * 4; it += G) ret_stage1(a, it >> 2, it & 3, lds, tid); } break;
    case 3: { const int b = bid;
              unsigned* ctl = (unsigned*)(a.ws + WS_CTL); unsigned* sub = ctl + CW_SUB + 128 * l; unsigned* ddone = sub + 32; unsigned* gdone = sub + 64;
              if (b < 64) { const int x = b & 7, j = b >> 3;
                  if (x < 4) { if (mask & 1) gd_stage2(a, x, j, lds, tid, mask >> 8); if (mask == 15) cnt_arrive(gdone); }
                  else { if (mask & 4) rw_stage2(a, (x - 4) * 2 + (j >> 2), j & 3, lds, tid); if (mask == 15) cnt_arrive(ddone); } }
              else { if (b < 128) { if (mask & 2) ret_stage2(a, b - 64, tid); } else if (mask & 8) m2_stage2(a, b - 128, tid);
                  if (mask == 15) { const int hb = b - 64, NH = G - 64;
                      cnt_arrive(sub); cnt_wait(sub, (unsigned)NH, ctl + XB_TMO);
#pragma unroll 1
                      for (int it = hb; it < NCH * 4; it += NH) ret_stage3(a, l, it >> 2, it & 3, lds, tid);
#pragma unroll 1
                      for (int it = hb; it < NCH * 2; it += NH) m2_stage3(a, l, it >> 1, it & 1, lds, tid); } }
              if (mask == 15) { LAS float* scr = (LAS float*)(lds + wave * 16384);
                  __syncthreads();
                  cvt_items(a, l, CV_IN + CV_OUT + CV_UP, CV_ALL, gw, NGW, scr, lane);
                  if (l + 1 < NL) cvt_items(a, l + 1, 0, CV_IN, gw, NGW, scr, lane);
                  __syncthreads();
                  cnt_wait(ddone, 32u, ctl + XB_TMO);
#pragma unroll 1
                  for (int it = bid; it < NCH * 8; it += G) rw_stage3(a, l, it >> 3, it & 7, lds, tid);
                  cnt_wait(gdone, 32u, ctl + XB_TMO);
#pragma unroll 1
                  for (int it = bid; it < NCH * 4; it += G) gd_stage3(a, l, it >> 2, it & 3, lds, tid); } } break;
    case 4: break;
    case 5: { pg8::Gemm g{(const bf16_t*)(a.ws + WS_O), (const bf16_t*)(a.ws + WS_WOUT)}; pg8::StaticOrder<T, D> S; S.init(G, bid);
              if (l == 0) { pg8::EpiRes<true> E{a.in[I_X], HB, D, SSb + (NL + l) * T}; pg8::gemm_phase<D, pg8::EpiRes<true>, pg8::StaticOrder<T, D>, false>(lds, g, S, E, tid); }
              else { pg8::EpiRes<false> E{HB, HB, D, SSb + (NL + l) * T}; pg8::gemm_phase<D, pg8::EpiRes<false>, pg8::StaticOrder<T, D>, false>(lds, g, S, E, tid); } } break;
    case 6: break;
    case 7: { pg8::Gemm g{HB, (const bf16_t*)(a.ws + WS_WUP)}; pg8::StaticOrder<T, FF> S; S.init(G, bid);
              pg8::EpiBf16<true> E{(bf16_t*)(a.ws + WS_HID), FF, SSb + (NL + l) * T}; pg8::gemm_phase<D, pg8::EpiBf16<true>, pg8::StaticOrder<T, FF>, true>(lds, g, S, E, tid); } break;
    case 8: { pg8::Gemm g{(const bf16_t*)(a.ws + WS_HID), (const bf16_t*)(a.ws + WS_WDN)}; pg8::StaticOrder<T, D> S; S.init(G, bid);
              pg8::EpiRes<false> E{HB, HB, D, SSb + (l + 1 < NL ? (l + 1) : 2 * NL) * T}; pg8::gemm_phase<FF, pg8::EpiRes<false>, pg8::StaticOrder<T, D>, false>(lds, g, S, E, tid); } break;
    }
}

__global__ void __launch_bounds__(NWAVES * 64, 2) fwd_kernel(Args a) {
    extern __shared__ __attribute__((aligned(16))) unsigned char lds_raw[];
    LAS unsigned char* lds = (LAS unsigned char*)lds_raw;
    const int ph_lo = a.ph_lo, ph_hi = a.ph_hi;
    volatile LAS unsigned* MISC = (volatile LAS unsigned*)(lds + MISC_OFF);
    if (threadIdx.x < 64) MISC[threadIdx.x] = 0u;
    __syncthreads();
    const XcdBarrier bar = xcd_barrier_post((unsigned*)(a.ws + WS_CTL), MISC + 8);
    for (int ph = ph_lo; ph < ph_hi; ++ph) {
        if (ph != N_PHASES - 1 && (ph % 9 == 6 || ph % 9 == 4 || (ph % 9 == 0 && ph > 0))) continue;
        CArgs* ap = (CArgs*)__builtin_amdgcn_kernarg_segment_ptr();
        asm volatile("" : "+s"(ap));
        int tid = threadIdx.x, bid = blockIdx.x;
        asm volatile("" : "+v"(tid)); asm volatile("" : "+s"(bid));
        run_phase(*ap, ph, lds, tid, bid);
#ifdef DUP_PHASE
#ifndef DUP_MASK
#define DUP_MASK 15
#endif
        if (ph == DUP_PHASE) { xcd_barrier(bar); asm volatile("" : "+s"(ap)); asm volatile("" : "+v"(tid)); asm volatile("" : "+s"(bid)); run_phase(*ap, ph, lds, tid, bid, DUP_MASK); }
#endif
        if (ph + 1 < ph_hi) xcd_barrier(bar);
    }
}

extern "C" void kernel_launch(void* const* d_in, const int* in_sizes, int n_in, void* d_out, int out_size, void* d_ws, size_t ws_size, hipStream_t stream) {
    static int grid = 0;
    if (grid == 0) {
        if (n_in != N_IN || in_sizes[0] != T * D || out_size != T * D || ws_size < WS_END) {
            fprintf(stderr, "kernel_launch: shape/workspace mismatch: n_in %d in0 %d out %d ws %zu (need %zu); nothing launched\n", n_in, n_in > 0 ? in_sizes[0] : -1, out_size, ws_size, (size_t)WS_END); grid = -1; return; }
        int dev = 0, cus = 0, per_cu = 0;
        if (hipGetDevice(&dev) != hipSuccess || hipDeviceGetAttribute(&cus, hipDeviceAttributeMultiprocessorCount, dev) != hipSuccess) { grid = -1; return; }
        if (hipFuncSetAttribute((const void*)fwd_kernel, hipFuncAttributeMaxDynamicSharedMemorySize, LDS_BYTES) != hipSuccess) { fprintf(stderr, "kernel_launch: hipFuncSetAttribute failed\n"); grid = -1; return; }
        if (hipOccupancyMaxActiveBlocksPerMultiprocessor(&per_cu, (const void*)fwd_kernel, NWAVES * 64, LDS_BYTES) != hipSuccess || per_cu < 1) { fprintf(stderr, "kernel_launch: occupancy query says %d blocks per CU\n", per_cu); per_cu = 1; }
        (void)hipGetLastError();
        grid = cus;
    }
    if (grid < 0) return;
    Args a{};
    for (int i = 0; i < N_IN; ++i) a.in[i] = (const float*)d_in[i];
    a.out = (float*)d_out; a.ws = (unsigned char*)d_ws;
#if N_LAUNCH_MODE == 1
    a.ph_lo = 0; a.ph_hi = N_PHASES;
    (void)hipMemsetAsync((char*)d_ws + WS_CTL, 0, CTL_ZERO_BYTES, stream);
    hipLaunchKernelGGL(fwd_kernel, dim3(grid), dim3(NWAVES * 64), LDS_BYTES, stream, a);
#else
#ifndef DBG_MAXPH
#define DBG_MAXPH N_PHASES
#endif
    for (int ph = 0; ph < N_PHASES; ++ph) {
        if (ph >= DBG_MAXPH && ph != N_PHASES - 1) continue;
#ifdef DBG_SKIP_FINAL
        if (ph == N_PHASES - 1) continue;
#endif
        (void)hipMemsetAsync((char*)d_ws + WS_CTL, 0, CTL_ZERO_BYTES, stream);
        a.ph_lo = ph; a.ph_hi = ph + 1;
        hipLaunchKernelGGL(fwd_kernel, dim3(grid), dim3(NWAVES * 64), LDS_BYTES, stream, a);
    }
#endif
}
#endif
```

```cpp
#ifndef HOST_TEST
#include <hip/hip_runtime.h>
#endif
#include <cstdio>
#include <cstdint>
#include <cmath>
#include <cstddef>

#ifndef SEQ_T
#define SEQ_T 8192
#endif
#ifndef N_LAUNCH_MODE
#define N_LAUNCH_MODE 1
#endif

constexpr int T = SEQ_T, D = 2048, NL = 2, FF = 8192, PT = 6832, PTP = 6912;
constexpr int C_GQ = 0, C_GK = 512, C_GV = 1024, C_GZ = 1536, C_GB = 2048, C_GA = 2052;
constexpr int C_RQ = 2056, C_RK = 2312, C_RV = 2568, C_RG = 3080;
constexpr int C_MZ = 3592, C_MXBC = 4104, C_MDT = 5128;
constexpr int C_RW = 5136;
enum { I_X = 0, I_N1, I_WIN, I_GCONV, I_GALOG, I_GDTB, I_GNORM, I_RNORM, I_MCONV, I_MCONVB, I_MALOG, I_MDTB, I_MD, I_MNORM, I_RWMU, I_RWW0, I_RWWUP, I_RWA0, I_RWAUP,
       I_RWGUP, I_RWKK, I_RWKA, I_RWRK, I_RWLNW, I_RWLNB, I_WOUT, I_N2, I_WUP, I_WDN, I_NF, N_IN };

constexpr size_t MiB = 1u << 20;
constexpr size_t SZ_WIN = (size_t)PTP * D * 2, SZ_WOUT = (size_t)D * D * 2, SZ_WUP = (size_t)FF * D * 2, SZ_WDN = (size_t)D * FF * 2;
constexpr size_t WS_CTL = 0, CTL_BYTES = 1 * MiB;
typedef unsigned long long ss_t;
constexpr float SS_FIX = 16777216.0f, SS_INV = 1.0f / 16777216.0f;
constexpr size_t WS_SS = 64 * 1024, SS_STRIDE = (size_t)SEQ_T * 8;
constexpr size_t CTL_ZERO_BYTES = WS_SS + (2 * 2 + 1) * SS_STRIDE;
constexpr size_t WS_WIN = WS_CTL + CTL_BYTES;
constexpr size_t WS_WOUT = WS_WIN + SZ_WIN;
constexpr size_t WS_WUP = WS_WOUT + SZ_WOUT;
constexpr size_t WS_WDN = WS_WUP + SZ_WUP;
constexpr size_t WS_O = WS_WDN + SZ_WDN;
constexpr size_t WS_HB = WS_O + (size_t)T * D * 2;
constexpr size_t WS_PROJ = WS_HB + (size_t)T * D * 2;
constexpr size_t WS_HID = WS_PROJ;
constexpr size_t GDN_ = (size_t)(T / 64) * 4 * 16384;
constexpr size_t WS_GD_G = WS_PROJ + (size_t)T * PTP * 2;
constexpr size_t WS_GD_Z = WS_GD_G + GDN_ * 2;
constexpr size_t WS_GD_QT = WS_GD_Z + GDN_ * 2;
constexpr size_t WS_GD_YI = WS_GD_QT + GDN_;
constexpr size_t WS_GD_S = WS_GD_YI + GDN_;
constexpr size_t WS_GAB = WS_GD_S + GDN_ * 2;
constexpr int NCH = T / 64;
constexpr size_t WS_RET_Z = WS_GAB;
constexpr size_t WS_RET_YI = WS_RET_Z + (size_t)NCH * 4 * 8192 * 2;
constexpr size_t WS_RET_QH = WS_RET_YI + (size_t)NCH * 4 * 8192 * 2;
constexpr size_t WS_RET_S = WS_RET_QH + (size_t)NCH * 4 * 4096 * 2;
constexpr size_t M2N = (size_t)NCH * 8 * 8192;
constexpr size_t WS_M2_Z = WS_RET_S + (size_t)NCH * 4 * 8192 * 2;
constexpr size_t WS_M2_YI = WS_M2_Z + M2N * 2;
constexpr size_t WS_M2_QH = WS_M2_YI + M2N;
constexpr size_t WS_M2_S = WS_M2_QH + M2N * 2;
constexpr size_t WS_M2_DEC = WS_M2_S + M2N * 2;
constexpr size_t WS_MDT = WS_M2_DEC + (size_t)NCH * 8 * 4;
constexpr size_t RWN = (size_t)NCH * 8 * 4096;
constexpr size_t WS_RW_G = WS_MDT;
constexpr size_t WS_RW_Z = WS_RW_G + RWN * 2;
constexpr size_t WS_RW_QT = WS_RW_Z + RWN * 2;
constexpr size_t WS_RW_YI = WS_RW_QT + RWN * 2;
constexpr size_t WS_RW_E = WS_RW_YI + RWN * 2;
constexpr size_t WS_RW_GT = WS_RW_E + RWN * 2;
constexpr size_t WS_RW_S = WS_RW_GT + RWN * 2;
constexpr size_t WS_END = WS_RW_S + RWN * 2;
static_assert(WS_HID + (size_t)T * FF * 2 <= WS_END, "HID overlay");
static_assert(CTL_ZERO_BYTES <= CTL_BYTES, "CTL");
static_assert(SEQ_T != 8192 || WS_END <= 512 * MiB, "d_ws budget (512 MiB)");

typedef unsigned short bf16_t;
#ifdef HOST_TEST
#define DEV static inline
#define HD static inline
typedef float f32x4 __attribute__((vector_size(16)));
constexpr int WAVE = 1, LPC = 1;
static inline float wave_sum(float v) { return v; }
static inline float group_sum(float v) { return v; }
#else
#define DEV __device__ __forceinline__
#define HD __host__ __device__ __forceinline__
typedef float f32x4 __attribute__((ext_vector_type(4)));
constexpr int WAVE = 64, LPC = 16;
DEV float wave_sum(float v) {
#pragma unroll
    for (int o = 1; o < 64; o <<= 1) v += __shfl_xor(v, o);
    return v;
}
DEV float group_sum(float v) {
#pragma unroll
    for (int o = 1; o < 16; o <<= 1) v += __shfl_xor(v, o);
    return v;
}
#endif
constexpr int CPW = WAVE / LPC;

HD unsigned f2bf(float f) { unsigned u; __builtin_memcpy(&u, &f, 4); return (u + 0x7fffu + ((u >> 16) & 1u)) >> 16; }
HD unsigned pk2(float lo, float hi) { return f2bf(lo) | (f2bf(hi) << 16); }
HD float bf2f(bf16_t b) { unsigned u = (unsigned)b << 16; float f; __builtin_memcpy(&f, &u, 4); return f; }
#ifdef HOST_TEST
DEV float sigmoid_f(float x) { return 1.0f / (1.0f + expf(-x)); }
DEV float silu_f(float x) { return x / (1.0f + expf(-x)); }
#else
DEV float fexp(float x) { return __builtin_amdgcn_exp2f(x * 1.4426950408889634f); }
DEV float sigmoid_f(float x) { return __builtin_amdgcn_rcpf(1.0f + fexp(-x)); }
DEV float silu_f(float x) { return x * __builtin_amdgcn_rcpf(1.0f + fexp(-x)); }
#endif
DEV float softplus_f(float x) { return x > 20.f ? x : log1pf(expf(x)); }

struct Args { const float* in[N_IN]; float* out; unsigned char* ws; int ph_lo, ph_hi; };
#ifdef HOST_TEST
typedef const Args CArgs;
#else
typedef const __attribute__((address_space(4))) Args CArgs;
#endif
#define WSF(off) ((float*)(a.ws + (off)))
#define PROJROW(t) ((const bf16_t*)(a.ws + WS_PROJ) + (size_t)(t) * PTP)
#define LP(idx, per) (a.in[idx] + (size_t)l * (per))

DEV void hb_row(const float* x, bf16_t* o, ss_t* ss_out, int lane) {
    float ss = 0.f;
    for (int i = lane * 4; i < D; i += WAVE * 4) { const f32x4 v = *(const f32x4*)(x + i); ss += (v[0] * v[0] + v[1] * v[1]) + (v[2] * v[2] + v[3] * v[3]);
        unsigned* op = (unsigned*)(o + i); op[0] = pk2(v[0], v[1]); op[1] = pk2(v[2], v[3]); }
    ss = wave_sum(ss); if (lane == 0) *ss_out = (ss_t)(ss * SS_FIX);
}
DEV void final_row(const bf16_t* h, const float* w, float ss  , float* o, int lane) {
    const float r = 1.0f / sqrtf(ss * (1.0f / D) + 1e-6f);
    for (int i = lane * 4; i < D; i += WAVE * 4) { const unsigned* hp = (const unsigned*)(h + i); const unsigned h0 = hp[0], h1 = hp[1]; const f32x4 g = *(const f32x4*)(w + i); f32x4 y;
        unsigned u0 = h0 << 16, u1 = h0 & 0xffff0000u, u2 = h1 << 16, u3 = h1 & 0xffff0000u; float f0, f1, f2, f3; __builtin_memcpy(&f0, &u0, 4); __builtin_memcpy(&f1, &u1, 4); __builtin_memcpy(&f2, &u2, 4); __builtin_memcpy(&f3, &u3, 4);
        y[0] = f0 * r * g[0]; y[1] = f1 * r * g[1]; y[2] = f2 * r * g[2]; y[3] = f3 * r * g[3]; *(f32x4*)(o + i) = y; }
}
DEV void rms_row_bf16(const float* x, const float* w, bf16_t* o, int lane) {
    float ss = 0.f;
    for (int i = lane * 4; i < D; i += WAVE * 4) { const f32x4 v = *(const f32x4*)(x + i); ss += (v[0] * v[0] + v[1] * v[1]) + (v[2] * v[2] + v[3] * v[3]); }
    const float r = 1.0f / sqrtf(wave_sum(ss) * (1.0f / D) + 1e-6f);
    for (int i = lane * 4; i < D; i += WAVE * 4) { const f32x4 v = *(const f32x4*)(x + i), g = *(const f32x4*)(w + i);
        unsigned* op = (unsigned*)(o + i); op[0] = pk2(v[0] * r * g[0], v[1] * r * g[1]); op[1] = pk2(v[2] * r * g[2], v[3] * r * g[3]); }
}
DEV void rms_row_f32(const float* x, const float* w, float* o, int lane) {
    float ss = 0.f;
    for (int i = lane * 4; i < D; i += WAVE * 4) { const f32x4 v = *(const f32x4*)(x + i); ss += (v[0] * v[0] + v[1] * v[1]) + (v[2] * v[2] + v[3] * v[3]); }
    const float r = 1.0f / sqrtf(wave_sum(ss) * (1.0f / D) + 1e-6f);
    for (int i = lane * 4; i < D; i += WAVE * 4) { const f32x4 v = *(const f32x4*)(x + i), g = *(const f32x4*)(w + i);
        f32x4 y; y[0] = v[0] * r * g[0]; y[1] = v[1] * r * g[1]; y[2] = v[2] * r * g[2]; y[3] = v[3] * r * g[3]; *(f32x4*)(o + i) = y; }
}

DEV float conv4(const bf16_t* projrow_t, int col, const float* w, int c, int wstride, int t) {
    float acc = 0.f;
#pragma unroll
    for (int j = 0; j < 4; ++j) { const int tt = t - 3 + j; if (tt >= 0) acc += w[j * wstride + c] * bf2f(projrow_t[(ptrdiff_t)(j - 3) * PTP + col]); }
    return acc;
}

#ifdef HOST_TEST
static const float THETA[32] = {
#else
__device__ const float THETA[32] = {
#endif
    1.000000000e+00f, 7.429639101e-01f, 5.519954562e-01f, 4.101127088e-01f, 3.046989739e-01f, 2.263803482e-01f, 1.681924462e-01f, 1.249609292e-01f, 9.284145385e-02f, 6.897785515e-02f,
    5.124806613e-02f, 3.807546571e-02f, 2.828869782e-02f, 2.101748064e-02f, 1.561523322e-02f, 1.160155423e-02f, 8.619536646e-03f, 6.404003594e-03f, 4.757945426e-03f, 3.534980817e-03f,
    2.626363887e-03f, 1.951293205e-03f, 1.449740841e-03f, 1.077104942e-03f, 8.002503891e-04f, 5.945570301e-04f, 4.417345626e-04f, 3.281927784e-04f, 2.438354713e-04f, 1.811609109e-04f,
    1.345960627e-04f, 9.999999747e-05f };

#ifndef HOST_TEST
namespace pg8 {
#define PG8_LAS __attribute__((address_space(3)))
typedef short bf16x8 __attribute__((ext_vector_type(8)));
typedef unsigned u32x4 __attribute__((ext_vector_type(4)));
constexpr int BM = 256, BK = 64, HALF = 128, HTB = HALF * BK * 2, STAGE_BYTES = 8 * HTB, NXCD = 8, WGM = 8;
__host__ __device__ __forceinline__ int lds_byte(int r, int c) { const int st = (r >> 4) * 2 + (c >> 5), rr = r & 15, cc = c & 31, ob = rr * 64 + cc * 2; return st * 1024 + (ob ^ (((ob >> 9) & 1) << 5)); }
__host__ __device__ __forceinline__ void stage_rc(int b, int& R, int& C) { const int st = b / 1024, sb = b % 1024, swz = sb ^ (((sb >> 9) & 1) << 5); R = (st >> 1) * 16 + swz / 64; C = (st & 1) * 32 + (swz % 64) / 2; }
__host__ __device__ __forceinline__ int perm32(int rho) { const int n = rho >> 4, i = rho & 15; return 8 * (i >> 2) + 4 * n + (i & 3); }
struct Unit { int pm, pn; };
struct Gemm { const bf16_t* A; const bf16_t* Bt; };
template <int M, int N> struct StaticOrder {
    static constexpr int nM = M / BM, nN = N / BM, nwg = nM * nN; int G, c;
    __device__ void init(int G_, int c_) { G = G_; c = c_; }
    __device__ bool next(int i, Unit& u) const {
        const long L = (long)i * G + c; if (L >= nwg) return false;
        int wgid = (int)L; { const int q = nwg / NXCD, r = nwg % NXCD, xcd = wgid % NXCD, off = wgid / NXCD; wgid = (xcd < r ? xcd * (q + 1) : r * (q + 1) + (xcd - r) * q) + off; }
        const int nig = WGM * nN, gid = wgid / nig, fm = gid * WGM, gsz = (nM - fm) < WGM ? (nM - fm) : WGM;
        u.pm = fm + ((wgid % nig) % gsz); u.pn = (wgid % nig) / gsz; return true;
    }
    __device__ __forceinline__ void a_ready(const Unit&) const {}
    __device__ __forceinline__ void done(const Unit&) const {}
};
__device__ __forceinline__ unsigned cvt_pk_bf16(float lo, float hi) { unsigned r; asm volatile("v_cvt_pk_bf16_f32 %0, %1, %2" : "=v"(r) : "v"(lo), "v"(hi)); return r; }
struct EpiStoreF32 {
    static constexpr bool PERM = false, AFTER_DRAIN = false; float* O; int ldc;
    __device__ __forceinline__ void operator()(const f32x4 (&acc)[2][2][4][2], const Unit& u, int wr, int wc, int fr, int fq) const {
        const int row0 = u.pm * BM + wr * 64 + fr, col0 = u.pn * BM + wc * 32 + 4 * fq;
#pragma unroll
        for (int ai = 0; ai < 2; ++ai)
#pragma unroll
            for (int m = 0; m < 4; ++m) { float* rowp = O + (size_t)(row0 + ai * HALF + m * 16) * ldc + col0;
#pragma unroll
                for (int bj = 0; bj < 2; ++bj)
#pragma unroll
                    for (int n = 0; n < 2; ++n) *(f32x4*)(rowp + bj * HALF + n * 16) = acc[ai][bj][m][n]; }
    }
};
template <bool BASE_F32> struct EpiRes {
    static constexpr bool PERM = true, AFTER_DRAIN = false; const void* B; bf16_t* O; int ldc; ss_t* SS;
    __device__ __forceinline__ void operator()(const f32x4 (&acc)[2][2][4][2], const Unit& u, int wr, int wc, int fr, int fq) const {
        const int row0 = u.pm * BM + wr * 64 + fr, col0 = u.pn * BM + wc * 32 + 8 * fq;
#pragma unroll
        for (int ai = 0; ai < 2; ++ai)
#pragma unroll
            for (int mp = 0; mp < 4; mp += 2) {
                f32x4 b[2][2][2];
#pragma unroll
                for (int mm = 0; mm < 2; ++mm) { const size_t ro = (size_t)(row0 + ai * HALF + (mp + mm) * 16) * ldc + col0;
#pragma unroll
                    for (int bj = 0; bj < 2; ++bj) {
                        if (BASE_F32) { const float* bp = (const float*)B + ro + bj * HALF; b[mm][bj][0] = *(const f32x4*)bp; b[mm][bj][1] = *(const f32x4*)(bp + 4); }
                        else { const u32x4 w = *(const u32x4*)((const bf16_t*)B + ro + bj * HALF);
                            b[mm][bj][0] = (f32x4){__uint_as_float(w.x << 16), __uint_as_float(w.x & 0xffff0000u), __uint_as_float(w.y << 16), __uint_as_float(w.y & 0xffff0000u)};
                            b[mm][bj][1] = (f32x4){__uint_as_float(w.z << 16), __uint_as_float(w.z & 0xffff0000u), __uint_as_float(w.w << 16), __uint_as_float(w.w & 0xffff0000u)}; } } }
#pragma unroll
                for (int mm = 0; mm < 2; ++mm) { const int m = mp + mm; bf16_t* rowp = O + (size_t)(row0 + ai * HALF + m * 16) * ldc + col0; float ss = 0.f;
#pragma unroll
                    for (int bj = 0; bj < 2; ++bj) { const f32x4 h0 = b[mm][bj][0] + acc[ai][bj][m][0], h1 = b[mm][bj][1] + acc[ai][bj][m][1];
                        ss += ((h0[0] * h0[0] + h0[1] * h0[1]) + (h0[2] * h0[2] + h0[3] * h0[3])) + ((h1[0] * h1[0] + h1[1] * h1[1]) + (h1[2] * h1[2] + h1[3] * h1[3]));
                        u32x4 w; w.x = cvt_pk_bf16(h0[0], h0[1]); w.y = cvt_pk_bf16(h0[2], h0[3]); w.z = cvt_pk_bf16(h1[0], h1[1]); w.w = cvt_pk_bf16(h1[2], h1[3]); *(u32x4*)(rowp + bj * HALF) = w; }
                    ss += __shfl_xor(ss, 16); ss += __shfl_xor(ss, 32);
                    if (fq == 0) atomicAdd(SS + row0 + ai * HALF + m * 16, (ss_t)(ss * SS_FIX)); } }
    }
};
template <bool SQRELU> struct EpiBf16 {
    static constexpr bool PERM = true, AFTER_DRAIN = false; bf16_t* O; int ldc; const ss_t* SS;
    __device__ __forceinline__ void operator()(const f32x4 (&acc)[2][2][4][2], const Unit& u, int wr, int wc, int fr, int fq) const {
        const int row0 = u.pm * BM + wr * 64 + fr, col0 = u.pn * BM + wc * 32 + 8 * fq;
#pragma unroll
        for (int ai = 0; ai < 2; ++ai)
#pragma unroll
            for (int m = 0; m < 4; ++m) { bf16_t* rowp = O + (size_t)(row0 + ai * HALF + m * 16) * ldc + col0; const float rs = __builtin_amdgcn_rsqf((float)SS[row0 + ai * HALF + m * 16] * (SS_INV / D) + 1e-6f);
#pragma unroll
                for (int bj = 0; bj < 2; ++bj) { f32x4 v0 = acc[ai][bj][m][0] * rs, v1 = acc[ai][bj][m][1] * rs;
                    if (SQRELU) {
#pragma unroll
                        for (int j = 0; j < 4; ++j) { const float p0 = fmaxf(v0[j], 0.f), p1 = fmaxf(v1[j], 0.f); v0[j] = p0 * p0; v1[j] = p1 * p1; } }
                    u32x4 w; w.x = cvt_pk_bf16(v0[0], v0[1]); w.y = cvt_pk_bf16(v0[2], v0[3]); w.z = cvt_pk_bf16(v1[0], v1[1]); w.w = cvt_pk_bf16(v1[2], v1[3]);
                    *(u32x4*)(rowp + bj * HALF) = w; } }
    }
};

template <int K, class Epi, class Sched, bool ALIGN_EPI = false>
__device__ __forceinline__ void gemm_phase(PG8_LAS unsigned char* lds, const Gemm g, const Sched& S, const Epi& E, const int tid) {
    const int wid = __builtin_amdgcn_readfirstlane(tid >> 6), lane = tid & 63, wr = wid >> 2, wc = wid & 3, fr = lane & 15, fq = lane >> 4;
    constexpr int nt = K / BK;
    unsigned voffA[2], voffB[2];
#pragma unroll
    for (int i = 0; i < 2; ++i) { int R, C; stage_rc(tid * 16 + i * 8192, R, C); const int Rb = Epi::PERM ? ((R & ~31) + perm32(R & 31)) : R;
        voffA[i] = (unsigned)(R * K + C) * 2u; voffB[i] = (unsigned)(Rb * K + C) * 2u; }
    const size_t kstep = (size_t)(BK * 2);
    const size_t hstep = (size_t)HALF * K * 2;
    const size_t tstep = 2 * hstep;
    const unsigned ldsw = (unsigned)wid * 1024u;
    const int aoff = lds_byte(wr * 64 + fr, fq * 8), boff = lds_byte(wc * 32 + fr, fq * 8);
#define PG8_SA(b, h) (((b) * 2 + (h)) * HTB)
#define PG8_SB(b, h) ((4 + (b) * 2 + (h)) * HTB)
#define PG8_STAGE(bufoff, gbase, voff) do { _Pragma("unroll") for (int _i = 0; _i < 2; ++_i) \
        __builtin_amdgcn_global_load_lds((const unsigned*)((const char*)(gbase) + (voff)[_i]), (PG8_LAS unsigned*)(lds + (bufoff) + ldsw + _i * 8192), 16, 0, 0); } while (0)
#define PG8_LDA(dst, b, h) do { _Pragma("unroll") for (int m = 0; m < 4; ++m) _Pragma("unroll") for (int k = 0; k < 2; ++k) dst[m][k] = *(const PG8_LAS bf16x8*)(lds + PG8_SA(b, h) + aoff + m * 2048 + k * 1024); } while (0)
#define PG8_LDB(dst, b, h) do { _Pragma("unroll") for (int n = 0; n < 2; ++n) _Pragma("unroll") for (int k = 0; k < 2; ++k) dst[n][k] = *(const PG8_LAS bf16x8*)(lds + PG8_SB(b, h) + boff + n * 2048 + k * 1024); } while (0)
#define PG8_MMA(ai, bj, At, Bt) do { __builtin_amdgcn_s_setprio(1); _Pragma("unroll") for (int m = 0; m < 4; ++m) _Pragma("unroll") for (int n = 0; n < 2; ++n) _Pragma("unroll") for (int k = 0; k < 2; ++k) \
        acc[ai][bj][m][n] = __builtin_amdgcn_mfma_f32_16x16x32_bf16(Bt[n][k], At[m][k], acc[ai][bj][m][n], 0, 0, 0); __builtin_amdgcn_s_setprio(0); } while (0)
#define PG8_WAIT_V(n) asm volatile("s_waitcnt vmcnt(" #n ")" ::: "memory")
#define PG8_WAIT_L(n) asm volatile("s_waitcnt lgkmcnt(" #n ")" ::: "memory")
#define PG8_BAR __builtin_amdgcn_s_barrier()
#define PG8_SCHED __builtin_amdgcn_sched_barrier(0)
    Unit cur, nxt; int ui = 0;
    if (!S.next(0, cur)) return;
    f32x4 acc[2][2][4][2];
#pragma unroll
    for (int a = 0; a < 2; ++a)
#pragma unroll
        for (int b = 0; b < 2; ++b)
#pragma unroll
            for (int m = 0; m < 4; ++m)
#pragma unroll
                for (int n = 0; n < 2; ++n) acc[a][b][m][n] = (f32x4){0.f, 0.f, 0.f, 0.f};
    bf16x8 At[4][2], B0[2][2], B1[2][2];
    const char* cA = (const char*)g.A + (size_t)cur.pm * tstep; const char* cB = (const char*)g.Bt + (size_t)cur.pn * tstep;
    S.a_ready(cur);
    PG8_STAGE(PG8_SB(0, 0), cB, voffB); PG8_STAGE(PG8_SB(0, 1), cB + hstep, voffB); PG8_STAGE(PG8_SA(0, 0), cA, voffA); PG8_STAGE(PG8_SA(0, 1), cA + hstep, voffA);
    if (wr == 1) PG8_BAR;
    PG8_WAIT_V(2); PG8_BAR;
    PG8_STAGE(PG8_SB(1, 0), cB + kstep, voffB); PG8_STAGE(PG8_SA(1, 0), cA + kstep, voffA); PG8_STAGE(PG8_SB(1, 1), cB + hstep + kstep, voffB);
    PG8_WAIT_V(6); PG8_BAR;
    for (;;) {
        const bool has_next = S.next(ui + 1, nxt);
        const char* nA = has_next ? (const char*)g.A + (size_t)nxt.pm * tstep : cA; const char* nB = has_next ? (const char*)g.Bt + (size_t)nxt.pn * tstep : cB;
        for (int t = 0; t < nt; t += 2) {
            const bool last = (t == nt - 2);
            const char* a1 = cA + (size_t)(t + 1) * kstep;
            const char* a2 = last ? nA : cA + (size_t)(t + 2) * kstep; const char* b2 = last ? nB : cB + (size_t)(t + 2) * kstep;
            const char* a3 = a2 + kstep; const char* b3 = b2 + kstep;
            if (last && has_next) S.a_ready(nxt);
            PG8_LDB(B0, 0, 0); PG8_LDB(B1, 0, 1); PG8_SCHED; PG8_LDA(At, 0, 0); PG8_STAGE(PG8_SA(1, 1), a1 + hstep, voffA);
            PG8_WAIT_V(8); PG8_WAIT_L(0); PG8_BAR; PG8_MMA(0, 0, At, B0); PG8_MMA(0, 1, At, B1); PG8_BAR; PG8_SCHED;
            PG8_LDA(At, 0, 1); PG8_STAGE(PG8_SB(0, 0), b2, voffB); PG8_STAGE(PG8_SB(0, 1), b2 + hstep, voffB); PG8_STAGE(PG8_SA(0, 0), a2, voffA);
            PG8_WAIT_V(8); PG8_WAIT_L(0); PG8_BAR; PG8_MMA(1, 0, At, B0); PG8_MMA(1, 1, At, B1); PG8_BAR; PG8_SCHED;
            PG8_LDB(B0, 1, 0); PG8_LDB(B1, 1, 1); PG8_SCHED; PG8_LDA(At, 1, 0); PG8_STAGE(PG8_SA(0, 1), a2 + hstep, voffA);
            PG8_WAIT_V(8); PG8_WAIT_L(0); PG8_BAR; PG8_MMA(0, 0, At, B0); PG8_MMA(0, 1, At, B1); PG8_BAR; PG8_SCHED;
            PG8_LDA(At, 1, 1); PG8_STAGE(PG8_SB(1, 0), b3, voffB); PG8_STAGE(PG8_SB(1, 1), b3 + hstep, voffB); PG8_STAGE(PG8_SA(1, 0), a3, voffA);
            PG8_WAIT_V(8); PG8_WAIT_L(0); PG8_BAR; PG8_MMA(1, 0, At, B0); PG8_MMA(1, 1, At, B1); PG8_BAR; PG8_SCHED;
        }
        if constexpr (ALIGN_EPI) { if (wr == 0) PG8_BAR; }
        E(acc, cur, wr, wc, fr, fq); S.done(cur);
        if (!has_next) break;
#pragma unroll
        for (int a = 0; a < 2; ++a)
#pragma unroll
            for (int b = 0; b < 2; ++b)
#pragma unroll
                for (int m = 0; m < 4; ++m)
#pragma unroll
                    for (int n = 0; n < 2; ++n) acc[a][b][m][n] = (f32x4){0.f, 0.f, 0.f, 0.f};
        cur = nxt; cA = nA; cB = nB; ++ui;
        if constexpr (ALIGN_EPI) { if (wr == 1) PG8_BAR; }
    }
    PG8_WAIT_V(0);
    if constexpr (!ALIGN_EPI) { if (wr == 0) PG8_BAR; }
    PG8_BAR;
#undef PG8_SA
#undef PG8_SB
#undef PG8_STAGE
#undef PG8_LDA
#undef PG8_LDB
#undef PG8_MMA
#undef PG8_WAIT_V
#undef PG8_WAIT_L
#undef PG8_BAR
#undef PG8_SCHED
}
}

#define LAS __attribute__((address_space(3)))
#define GAS __attribute__((address_space(1)))
typedef unsigned v4u __attribute__((ext_vector_type(4)));
constexpr int NWAVES = 8, LDS_BYTES = 163840, MISC_OFF = LDS_BYTES - 512;
#define LDS_WAIT() asm volatile("s_waitcnt lgkmcnt(0)" ::: "memory")

__device__ __forceinline__ void transpose_item(const float* W, int K, int N, int Npad, bf16_t* WT, LAS float* scr, int item, int lane, const float* kscale = nullptr) {
    const int nblk = Npad / 32, kb = item / nblk, nb = item % nblk, k0 = 64 * kb, n0 = 32 * nb;
    const int n = n0 + (lane & 31); const bool ok = n < N;
    float v[32];
    const float* src = W + (size_t)(k0 + (lane >> 5)) * N + n;
#pragma unroll
    for (int i = 0; i < 32; ++i) v[i] = ok ? src[(size_t)(2 * i) * N] : 0.f;
    if (kscale) {
#pragma unroll
        for (int i = 0; i < 32; ++i) v[i] *= kscale[k0 + 2 * i + (lane >> 5)]; }
#pragma unroll
    for (int i = 0; i < 32; ++i) scr[(2 * i + (lane >> 5)) * 33 + (lane & 31)] = v[i];
    LDS_WAIT(); asm volatile("" ::: "memory");
    const int c = lane & 7;
#pragma unroll
    for (int j = 0; j < 4; ++j) { const int nn = (lane >> 3) + 8 * j; const LAS float* s = scr + (8 * c) * 33 + nn;
        v4u o; o.x = pk2(s[0 * 33], s[1 * 33]); o.y = pk2(s[2 * 33], s[3 * 33]); o.z = pk2(s[4 * 33], s[5 * 33]); o.w = pk2(s[6 * 33], s[7 * 33]);
        *(GAS v4u*)(WT + (size_t)(n0 + nn) * K + k0 + 8 * c) = o; }
    LDS_WAIT(); asm volatile("" ::: "memory");
}


typedef short bf16x8 __attribute__((ext_vector_type(8)));
typedef short s16x4 __attribute__((ext_vector_type(4)));
typedef unsigned u32x2 __attribute__((ext_vector_type(2)));
__device__ __forceinline__ s16x4 tr16(const LAS bf16_t* p) { return __builtin_bit_cast(s16x4, __builtin_amdgcn_ds_read_tr16_b64_v4i16((LAS s16x4*)p)); }
__device__ __forceinline__ bf16x8 frag_row(const LAS bf16_t* img, int ld, int nc0, int k0, int lane) { return *(const LAS bf16x8*)(img + (nc0 + (lane & 15)) * ld + k0 + 8 * (lane >> 4)); }
__device__ __forceinline__ bf16x8 frag_tr(const LAS bf16_t* img, int ld, int nc0, int k0, int lane) {
    const int g = lane >> 4, q = (lane & 15) >> 2, p = lane & 3;
    const LAS bf16_t* ad = img + (k0 + 8 * g + q) * ld + nc0 + 4 * p;
    const s16x4 lo = tr16(ad), hi = tr16(ad + 4 * ld);
    return (bf16x8){lo[0], lo[1], lo[2], lo[3], hi[0], hi[1], hi[2], hi[3]};
}
__device__ __forceinline__ bf16x8 frag_row_g(const bf16_t* img, int ld, int nc0, int k0, int lane) { return *(const bf16x8*)(img + (size_t)(nc0 + (lane & 15)) * ld + k0 + 8 * (lane >> 4)); }
__device__ __forceinline__ bf16x8 frag_fo(const bf16_t* img, int KS, int tile, int ks, int lane) { return *(const bf16x8*)(img + ((size_t)(tile * KS + ks) * 64 + lane) * 8); }
__device__ __forceinline__ int fo_st(int tile, int KS, int k0, int g, int r) { const int k = k0 + 4 * g; return ((tile * KS + (k >> 5)) * 64 + ((k >> 3) & 3) * 16 + r) * 8 + (k & 7); }
__device__ __forceinline__ int co_off(int tj, int NI, int ti, int lane) { return ((tj * NI + ti) * 64 + lane) * 4; }
__device__ __forceinline__ f32x4 mfma16(bf16x8 a, bf16x8 b, f32x4 c) { return __builtin_amdgcn_mfma_f32_16x16x32_bf16(a, b, c, 0, 0, 0); }
__device__ __forceinline__ u32x2 pack4(f32x4 v) { u32x2 w; w.x = pk2(v[0], v[1]); w.y = pk2(v[2], v[3]); return w; }
__device__ __forceinline__ f32x4 unpack4(u32x2 w) { f32x4 v; v[0] = __uint_as_float(w.x << 16); v[1] = __uint_as_float(w.x & 0xffff0000u); v[2] = __uint_as_float(w.y << 16); v[3] = __uint_as_float(w.y & 0xffff0000u); return v; }
#define WG_SYNC() do { asm volatile("s_waitcnt lgkmcnt(0)" ::: "memory"); __builtin_amdgcn_s_barrier(); asm volatile("" ::: "memory"); } while (0)

__device__ __forceinline__ void ret_stage1(CArgs& a, int n, int h, LAS unsigned char* lds, int tid) {
    const int lane = tid & 63, w = __builtin_amdgcn_readfirstlane(tid >> 6), r = lane & 15, g = lane >> 4;
    constexpr int LD = 72, LDV = 136;
    LAS bf16_t* Qi = (LAS bf16_t*)lds; LAS bf16_t* Ki = Qi + 64 * LD; LAS bf16_t* Kdi = Ki + 64 * LD; LAS bf16_t* Vi = Kdi + 64 * LD; LAS bf16_t* Si = Vi + 64 * LDV;
    const int tk = n * 4 + h; const float lg2 = log2f(1.0f - exp2f(-5.0f - (float)h));
    bf16_t* QH = (bf16_t*)(a.ws + WS_RET_QH) + (size_t)tk * 4096;
    unsigned rqq[4], rkk[4]; v4u rvv[2];
#pragma unroll
    for (int ii = 0; ii < 4; ++ii) { const int idx = tid + 512 * ii, c = idx >> 5, i = idx & 31; const bf16_t* pr = PROJROW(n * 64 + c); rqq[ii] = *(const unsigned*)(pr + C_RQ + 64 * h + 2 * i); rkk[ii] = *(const unsigned*)(pr + C_RK + 64 * h + 2 * i); }
#pragma unroll
    for (int ii = 0; ii < 2; ++ii) { const int idx = tid + 512 * ii, c = idx >> 4, ch = idx & 15; rvv[ii] = *(const v4u*)(PROJROW(n * 64 + c) + C_RV + 128 * h + 8 * ch); }
#pragma unroll
    for (int ii = 0; ii < 4; ++ii) { const int idx = tid + 512 * ii;
        const int c = idx >> 5, i = idx & 31, t = n * 64 + c; float sn, cs; sincosf((float)t * THETA[i], &sn, &cs);
        const unsigned qq = rqq[ii], kk = rkk[ii];
        const float q0 = __uint_as_float(qq << 16), q1 = __uint_as_float(qq & 0xffff0000u), k0 = __uint_as_float(kk << 16), k1 = __uint_as_float(kk & 0xffff0000u);
        const float rq0 = q0 * cs - q1 * sn, rq1 = q1 * cs + q0 * sn, rk0 = (k0 * cs - k1 * sn) * 0.125f, rk1 = (k1 * cs + k0 * sn) * 0.125f;
        const float dk = exp2f(lg2 * (float)(63 - c)), dq = exp2f(lg2 * (float)(c + 1));
        *(LAS unsigned*)(Qi + c * LD + 2 * i) = pk2(rq0, rq1); *(LAS unsigned*)(Ki + c * LD + 2 * i) = pk2(rk0, rk1); *(LAS unsigned*)(Kdi + c * LD + 2 * i) = pk2(rk0 * dk, rk1 * dk);
        { const int d = 2 * i; *(unsigned*)(QH + (((c >> 4) * 2 + (d >> 5)) * 64 + ((d >> 3) & 3) * 16 + (c & 15)) * 8 + (d & 7)) = pk2(rq0 * dq, rq1 * dq); }
    }
#pragma unroll
    for (int ii = 0; ii < 2; ++ii) { const int idx = tid + 512 * ii, c = idx >> 4, ch = idx & 15; *(LAS v4u*)(Vi + c * LDV + 8 * ch) = rvv[ii]; }
    WG_SYNC();
#pragma unroll
    for (int tt = 0; tt < 2; ++tt) { const int tile = 2 * w + tt, im = tile >> 2, jc = tile & 3; f32x4 acc = {0.f, 0.f, 0.f, 0.f};
        if (jc >= im) {
#pragma unroll
            for (int k0 = 0; k0 < 64; k0 += 32) acc = mfma16(frag_row(Ki, LD, 16 * im, k0, lane), frag_row(Qi, LD, 16 * jc, k0, lane), acc);
#pragma unroll
            for (int e = 0; e < 4; ++e) { const int i = 16 * im + 4 * g + e, j = 16 * jc + r; acc[e] = j >= i ? acc[e] * exp2f(lg2 * (float)(j - i)) : 0.f; } }
        *(LAS u32x2*)(Si + (16 * jc + r) * LD + 16 * im + 4 * g) = pack4(acc); }
    WG_SYNC();
    bf16_t* YI = (bf16_t*)(a.ws + WS_RET_YI) + (size_t)tk * 8192; bf16_t* Z = (bf16_t*)(a.ws + WS_RET_Z) + (size_t)tk * 8192;
#pragma unroll
    for (int tt = 0; tt < 4; ++tt) { const int jc = w & 3, ie = 4 * (w >> 2) + tt; f32x4 acc = {0.f, 0.f, 0.f, 0.f};
#pragma unroll
        for (int k0 = 0; k0 < 64; k0 += 32) acc = mfma16(frag_tr(Vi, LDV, 16 * ie, k0, lane), frag_row(Si, LD, 16 * jc, k0, lane), acc);
        *(u32x2*)(YI + co_off(jc, 8, ie, lane)) = pack4(acc); }
#pragma unroll
    for (int tt = 0; tt < 4; ++tt) { const int id = w & 3, je = 4 * (w >> 2) + tt; f32x4 acc = {0.f, 0.f, 0.f, 0.f};
#pragma unroll
        for (int k0 = 0; k0 < 64; k0 += 32) acc = mfma16(frag_tr(Kdi, LD, 16 * id, k0, lane), frag_tr(Vi, LDV, 16 * je, k0, lane), acc);
        *(u32x2*)(Z + fo_st(je, 2, 16 * id, g, r)) = pack4(acc); }
    WG_SYNC();
}
template <class DEC> __device__ __forceinline__ void ew_stage2(const bf16_t* Z, bf16_t* S, size_t step_stride, const DEC& dec, LAS unsigned char* lds, int tid) {
    LAS bf16_t* ZL = (LAS bf16_t*)lds; LAS bf16_t* SL = ZL + 8 * 512;
    const int sq = tid >> 6, ev = (tid & 63) * 8;
    v4u zin[NCH / 8];
#pragma unroll
    for (int gq = 0; gq < NCH / 8; ++gq) zin[gq] = *(const v4u*)(Z + (size_t)(8 * gq + sq) * step_stride + ev);
    float st = 0.f;
#pragma unroll
    for (int gq = 0; gq < NCH / 8; ++gq) {
        *(LAS v4u*)(ZL + sq * 512 + ev) = zin[gq];
        WG_SYNC();
#pragma unroll
        for (int j = 0; j < 8; ++j) { const float z = bf2f(ZL[j * 512 + tid]); SL[j * 512 + tid] = (bf16_t)f2bf(st); st = dec(8 * gq + j) * st + z; }
        WG_SYNC();
        *(v4u*)(S + (size_t)(8 * gq + sq) * step_stride + ev) = *(const LAS v4u*)(SL + sq * 512 + ev);
    }
    WG_SYNC();
}
struct DecConst { float d; __device__ __forceinline__ float operator()(int) const { return d; } };
struct DecTable { const float* p; int stride; __device__ __forceinline__ float operator()(int n) const { return p[n * stride]; } };
__device__ __forceinline__ void ret_stage2(CArgs& a, int b, LAS unsigned char* lds, int tid) {
    const int h = b >> 4, rem0 = (b & 15) * 512; const DecConst dc{exp2f(64.0f * log2f(1.0f - exp2f(-5.0f - (float)h)))};
    ew_stage2((const bf16_t*)(a.ws + WS_RET_Z) + (size_t)h * 8192 + rem0, (bf16_t*)(a.ws + WS_RET_S) + (size_t)h * 8192 + rem0, (size_t)4 * 8192, dc, lds, tid);
}
__device__ __forceinline__ void ret_stage3(CArgs& a, int l, int n, int h, LAS unsigned char* lds, int tid) {
    const int lane = tid & 63, w = __builtin_amdgcn_readfirstlane(tid >> 6), r = lane & 15, g = lane >> 4, jc = w & 3, wh = w >> 2;
    const int tk = n * 4 + h; const int c = 16 * jc + r, t = n * 64 + c;
    const bf16_t* S = (const bf16_t*)(a.ws + WS_RET_S) + (size_t)tk * 8192; const bf16_t* QH = (const bf16_t*)(a.ws + WS_RET_QH) + (size_t)tk * 4096; const bf16_t* YI = (const bf16_t*)(a.ws + WS_RET_YI) + (size_t)tk * 8192;
    LAS float* xs = (LAS float*)lds;
    f32x4 acc[4];
#pragma unroll
    for (int tt = 0; tt < 4; ++tt) { const int ie = 4 * wh + tt; acc[tt] = unpack4(*(const u32x2*)(YI + co_off(jc, 8, ie, lane)));
#pragma unroll
        for (int k = 0; k < 2; ++k) acc[tt] = mfma16(frag_fo(S, 2, ie, k, lane), frag_fo(QH, 2, jc, k, lane), acc[tt]); }
    float s1 = 0.f;
#pragma unroll
    for (int tt = 0; tt < 4; ++tt) s1 += (acc[tt][0] + acc[tt][1]) + (acc[tt][2] + acc[tt][3]);
    s1 += __shfl_xor(s1, 16); s1 += __shfl_xor(s1, 32);
    if (g == 0) xs[w * 16 + r] = s1;
    WG_SYNC();
    const float mu = (s1 + xs[(w ^ 4) * 16 + r]) * (1.0f / 128.0f); float s2 = 0.f;
#pragma unroll
    for (int tt = 0; tt < 4; ++tt)
#pragma unroll
        for (int e = 0; e < 4; ++e) { acc[tt][e] -= mu; s2 += acc[tt][e] * acc[tt][e]; }
    s2 += __shfl_xor(s2, 16); s2 += __shfl_xor(s2, 32);
    if (g == 0) xs[128 + w * 16 + r] = s2;
    WG_SYNC();
    const float rs = 1.0f / sqrtf((s2 + xs[128 + (w ^ 4) * 16 + r]) * (1.0f / 128.0f) + 1e-6f);
    const float* nw = LP(I_RNORM, 512) + h * 128; const bf16_t* pr = PROJROW(t) + C_RG + h * 128; bf16_t* O = (bf16_t*)(a.ws + WS_O) + (size_t)t * D + 512 + h * 128;
#pragma unroll
    for (int tt = 0; tt < 4; ++tt) { const int e0 = 16 * (4 * wh + tt) + 4 * g; const f32x4 gt = unpack4(*(const u32x2*)(pr + e0)); const f32x4 wv = *(const f32x4*)(nw + e0); f32x4 y;
#pragma unroll
        for (int e = 0; e < 4; ++e) y[e] = acc[tt][e] * rs * wv[e] * silu_f(gt[e]);
        *(u32x2*)(O + e0) = pack4(y); }
    WG_SYNC();
}

constexpr int RW_LD = 72;
constexpr int RWO_V = 0, RWO_IMG = 9216  , RWO_XI = 36864  , RWO_UI = 55296, RWO_CUMC = 64512, RWO_WT = 65536  , RWO_AM = 65536, RWO_TRI = 82944,
              RWO_RHST = 110592, RWO_AI = 143360, RWO_DI = 152576;
constexpr int RWO_LW = 9216, RWO_LIN = 82944;
__device__ __forceinline__ float ftanh(float x) { return 1.0f - 2.0f * __builtin_amdgcn_rcpf(1.0f + fexp(2.0f * x)); }
__device__ __forceinline__ float fsoftplus(float x) { return x > 20.f ? x : __builtin_amdgcn_logf(1.0f + fexp(x)) * 0.6931471805599453f; }
__device__ __forceinline__ void rw_stage1(CArgs& a, int l, int n, int h, LAS unsigned char* lds, int tid, const int stop = 99) {
    const int w = __builtin_amdgcn_readfirstlane(tid >> 6), tk = n * 8 + h;
    int lane, r, g, c, kg, t;
#define RW_IDX() do { int tl_ = tid; asm volatile("" : "+v"(tl_)); lane = tl_ & 63; r = lane & 15; g = lane >> 4; c = tl_ >> 3; kg = tl_ & 7; t = n * 64 + c; } while (0)
    RW_IDX();
    LAS bf16_t* Vi = (LAS bf16_t*)(lds + RWO_V);
    LAS bf16_t* RHi = (LAS bf16_t*)(lds + RWO_IMG); LAS bf16_t* BTi = RHi + 64 * RW_LD; LAS bf16_t* KTi = BTi + 64 * RW_LD; LAS bf16_t* KHi = KTi + 64 * RW_LD; LAS bf16_t* BMi = KHi + 64 * RW_LD; LAS bf16_t* KMi = BMi + 64 * RW_LD;
    LAS bf16_t* XI = (LAS bf16_t*)(lds + RWO_XI);
    LAS bf16_t* UI = (LAS bf16_t*)(lds + RWO_UI);
    LAS float* CUMC = (LAS float*)(lds + RWO_CUMC); LAS float* WT = (LAS float*)(lds + RWO_WT); LAS float* AM = (LAS float*)(lds + RWO_AM);
    LAS bf16_t* BMI = (LAS bf16_t*)(lds + RWO_TRI); LAS bf16_t* PBI = BMI + 64 * RW_LD; LAS bf16_t* PKI = PBI + 64 * RW_LD;
    LAS float* RHST = (LAS float*)(lds + RWO_RHST);
    LAS bf16_t* AI = (LAS bf16_t*)(lds + RWO_AI);
    LAS bf16_t* DI = (LAS bf16_t*)(lds + RWO_DI);
    LAS float* LW = (LAS float*)(lds + RWO_LW); LAS float* LA = LW + 4096; LAS float* LG = LA + 4096;
    LAS bf16_t* WLi = (LAS bf16_t*)(lds + RWO_LIN); LAS bf16_t* ALi = WLi + 64 * 40; LAS bf16_t* GLi = ALi + 64 * 40; LAS bf16_t* WUPi = GLi + 64 * 104; LAS bf16_t* AUPi = WUPi + 32 * RW_LD; LAS bf16_t* GUPi = AUPi + 32 * RW_LD;
    const float* mu = LP(I_RWMU, 1696); const bf16_t* p1 = PROJROW(t) + C_RW; const bf16_t* p0 = p1 - PTP; bool hp = t > 0;
    float vv[8];
    { const v4u cu = *(const v4u*)(p1 + 1024 + 64 * h + 8 * kg); v4u pv = {0u, 0u, 0u, 0u};
      const float* m = mu + 1024 + 64 * h + 8 * kg; const f32x4 m0 = *(const f32x4*)m, m1 = *(const f32x4*)(m + 4);
      u32x2 cw = *(const u32x2*)(p1 + 1536 + 4 * kg), ca = *(const u32x2*)(p1 + 1568 + 4 * kg), pw = {0u, 0u}, pa = {0u, 0u};
      u32x2 cg[3], pg[3] = {{0u, 0u}, {0u, 0u}, {0u, 0u}}; f32x4 mg[3];
#pragma unroll
      for (int q = 0; q < 3; ++q) { cg[q] = *(const u32x2*)(p1 + 1600 + 12 * kg + 4 * q); mg[q] = *(const f32x4*)(mu + 1600 + 12 * kg + 4 * q); }
      if (hp) { pv = *(const v4u*)(p0 + 1024 + 64 * h + 8 * kg); pw = *(const u32x2*)(p0 + 1536 + 4 * kg); pa = *(const u32x2*)(p0 + 1568 + 4 * kg);
#pragma unroll
          for (int q = 0; q < 3; ++q) pg[q] = *(const u32x2*)(p0 + 1600 + 12 * kg + 4 * q); }
      const f32x4 mw = *(const f32x4*)(mu + 1536 + 4 * kg), ma = *(const f32x4*)(mu + 1568 + 4 * kg);
      const int j = tid >> 4, k4 = (tid & 15) * 4;
      const f32x4 lwv = *(const f32x4*)(LP(I_RWWUP, 32 * 512) + j * 512 + 64 * h + k4), lav = *(const f32x4*)(LP(I_RWAUP, 32 * 512) + j * 512 + 64 * h + k4); f32x4 lgv[3];
#pragma unroll
      for (int q = 0; q < 3; ++q) lgv[q] = *(const f32x4*)(LP(I_RWGUP, 96 * 512) + (32 * q + j) * 512 + 64 * h + k4);
      asm volatile("" ::: "memory");
      { v4u o;
#pragma unroll
        for (int u = 0; u < 4; ++u) { const unsigned cww = cu[u], pww = pv[u]; const float c0 = __uint_as_float(cww << 16), c1 = __uint_as_float(cww & 0xffff0000u), q0 = __uint_as_float(pww << 16), q1 = __uint_as_float(pww & 0xffff0000u);
            const float mA = u < 2 ? m0[2 * u] : m1[2 * u - 4], mB = u < 2 ? m0[2 * u + 1] : m1[2 * u - 3];
            vv[2 * u] = c0 + (q0 - c0) * mA; vv[2 * u + 1] = c1 + (q1 - c1) * mB; o[u] = pk2(vv[2 * u], vv[2 * u + 1]); }
        *(LAS v4u*)(Vi + c * RW_LD + 8 * kg) = o; }
      { const f32x4 cv = unpack4(cw), pvv = unpack4(pw); f32x4 x;
#pragma unroll
        for (int u = 0; u < 4; ++u) x[u] = ftanh(cv[u] + (pvv[u] - cv[u]) * mw[u]);
        *(LAS u32x2*)(WLi + c * 40 + 4 * kg) = pack4(x); }
      { const f32x4 cv = unpack4(ca), pvv = unpack4(pa); f32x4 x;
#pragma unroll
        for (int u = 0; u < 4; ++u) x[u] = cv[u] + (pvv[u] - cv[u]) * ma[u];
        *(LAS u32x2*)(ALi + c * 40 + 4 * kg) = pack4(x); }
#pragma unroll
      for (int q = 0; q < 3; ++q) { const f32x4 cv = unpack4(cg[q]), pvv = unpack4(pg[q]); f32x4 x;
#pragma unroll
          for (int u = 0; u < 4; ++u) x[u] = sigmoid_f(cv[u] + (pvv[u] - cv[u]) * mg[q][u]);
          *(LAS u32x2*)(GLi + c * 104 + 12 * kg + 4 * q) = pack4(x); }
      *(LAS u32x2*)(WUPi + j * RW_LD + k4) = pack4(lwv); *(LAS u32x2*)(AUPi + j * RW_LD + k4) = pack4(lav);
#pragma unroll
      for (int q = 0; q < 3; ++q) *(LAS u32x2*)(GUPi + (32 * q + j) * RW_LD + k4) = pack4(lgv[q]); }
    WG_SYNC();
    if (stop <= 0) return;
    RW_IDX();
#pragma unroll
    for (int tt = 0; tt < 2; ++tt) { const int tile = 2 * w + tt, ik = tile >> 2, jc = tile & 3;
        f32x4 aw = {0.f, 0.f, 0.f, 0.f}, aa = aw, ag = aw;
        aw = mfma16(frag_tr(WUPi, RW_LD, 16 * ik, 0, lane), frag_row(WLi, 40, 16 * jc, 0, lane), aw);
        aa = mfma16(frag_tr(AUPi, RW_LD, 16 * ik, 0, lane), frag_row(ALi, 40, 16 * jc, 0, lane), aa);
#pragma unroll
        for (int k0 = 0; k0 < 96; k0 += 32) ag = mfma16(frag_tr(GUPi, RW_LD, 16 * ik, k0, lane), frag_row(GLi, 104, 16 * jc, k0, lane), ag);
        const int o = (16 * jc + r) * 64 + 16 * ik + 4 * g; *(LAS f32x4*)(LW + o) = aw; *(LAS f32x4*)(LA + o) = aa; *(LAS f32x4*)(LG + o) = ag; }
    WG_SYNC();
    if (stop <= 1) return;
    RW_IDX();
    p1 = PROJROW(t) + C_RW; p0 = p1 - PTP; hp = t > 0;
    float rr[8], kk[8], bb[8], kt[8], lwd[8], cum[8];
    { const int ch0 = 64 * h + 8 * kg; float ss = 0.f, rk = 0.f; float gt[8];
      const v4u cr = *(const v4u*)(p1 + ch0), ck = *(const v4u*)(p1 + 512 + ch0); v4u qr = {0u, 0u, 0u, 0u}, qk = qr; if (hp) { qr = *(const v4u*)(p0 + ch0); qk = *(const v4u*)(p0 + 512 + ch0); }
      float pw0[8], pa0[8], pkk[8], pka[8], prk[8], pmr[8], pmk[8];
#pragma unroll
      for (int q = 0; q < 2; ++q) { const f32x4 x0 = *(const f32x4*)(LP(I_RWW0, 512) + ch0 + 4 * q), x1 = *(const f32x4*)(LP(I_RWA0, 512) + ch0 + 4 * q), x2 = *(const f32x4*)(LP(I_RWKK, 512) + ch0 + 4 * q), x3 = *(const f32x4*)(LP(I_RWKA, 512) + ch0 + 4 * q),
                                                 x4 = *(const f32x4*)(LP(I_RWRK, 512) + ch0 + 4 * q), x5 = *(const f32x4*)(mu + ch0 + 4 * q), x6 = *(const f32x4*)(mu + 512 + ch0 + 4 * q);
#pragma unroll
          for (int e = 0; e < 4; ++e) { pw0[4 * q + e] = x0[e]; pa0[4 * q + e] = x1[e]; pkk[4 * q + e] = x2[e]; pka[4 * q + e] = x3[e]; prk[4 * q + e] = x4[e]; pmr[4 * q + e] = x5[e]; pmk[4 * q + e] = x6[e]; } }
#pragma unroll
      for (int u = 0; u < 8; ++u) { const unsigned crw = cr[u >> 1], ckw = ck[u >> 1], qrw = qr[u >> 1], qkw = qk[u >> 1];
          const float curR = (u & 1) ? __uint_as_float(crw & 0xffff0000u) : __uint_as_float(crw << 16), curK = (u & 1) ? __uint_as_float(ckw & 0xffff0000u) : __uint_as_float(ckw << 16);
          const float prvR = (u & 1) ? __uint_as_float(qrw & 0xffff0000u) : __uint_as_float(qrw << 16), prvK = (u & 1) ? __uint_as_float(qkw & 0xffff0000u) : __uint_as_float(qkw << 16);
          const float rv = curR + (prvR - curR) * pmr[u], kr = curK + (prvK - curK) * pmk[u];
          const float lw = LW[c * 64 + 8 * kg + u], la = LA[c * 64 + 8 * kg + u]; gt[u] = LG[c * 64 + 8 * kg + u];
          const float wraw = -fsoftplus(-(pw0[u] + lw)) - 0.5f; lwd[u] = -fexp(wraw);
          const float av = sigmoid_f(pa0[u] + la); const float kkr = kr * pkk[u]; kt[u] = kr * (1.0f + (av - 1.0f) * pka[u]);
          rr[u] = rv; kk[u] = kkr; bb[u] = av; ss += kkr * kkr; rk += rv * kt[u] * prk[u]; }
      ss += __shfl_xor(ss, 1); ss += __shfl_xor(ss, 2); ss += __shfl_xor(ss, 4); rk += __shfl_xor(rk, 1); rk += __shfl_xor(rk, 2); rk += __shfl_xor(rk, 4);
      const float inv = __builtin_amdgcn_rsqf(ss + 1e-6f);
#pragma unroll
      for (int u = 0; u < 8; ++u) { kk[u] *= inv; bb[u] *= kk[u]; }
#pragma unroll
      for (int u = 0; u < 8; ++u) { float x = lwd[u];
#pragma unroll
          for (int o = 8; o < 64; o <<= 1) { const float up = __shfl_up(x, o); if (lane >= o) x += up; }
          cum[u] = x; }
      if (lane >= 56) { *(LAS f32x4*)(WT + w * 64 + 8 * kg) = (f32x4){cum[0], cum[1], cum[2], cum[3]}; *(LAS f32x4*)(WT + w * 64 + 8 * kg + 4) = (f32x4){cum[4], cum[5], cum[6], cum[7]}; }
      v4u eo, go;
#pragma unroll
      for (int u = 0; u < 4; ++u) { eo[u] = pk2(rk * vv[2 * u], rk * vv[2 * u + 1]); go[u] = pk2(gt[2 * u], gt[2 * u + 1]); }
      bf16_t* Eo = (bf16_t*)(a.ws + WS_RW_E) + (size_t)tk * 4096; bf16_t* Go = (bf16_t*)(a.ws + WS_RW_GT) + (size_t)tk * 4096;
#pragma unroll
      for (int hf = 0; hf < 2; ++hf) { const int o = (((c >> 4) * 4 + (kg >> 1)) * 64 + ((2 * kg + hf) & 3) * 16 + (c & 15)) * 4;
          *(u32x2*)(Eo + o) = (u32x2){eo[2 * hf], eo[2 * hf + 1]}; *(u32x2*)(Go + o) = (u32x2){go[2 * hf], go[2 * hf + 1]}; } }
    WG_SYNC();
    if (stop <= 3) return;
    RW_IDX();
    { float cc[8];
#pragma unroll
      for (int u = 0; u < 8; ++u) cc[u] = 0.f;
#pragma unroll
      for (int ww = 0; ww < 8; ++ww) { const f32x4 t0 = *(const LAS f32x4*)(WT + ww * 64 + 8 * kg), t1 = *(const LAS f32x4*)(WT + ww * 64 + 8 * kg + 4);
#pragma unroll
          for (int e = 0; e < 4; ++e) { if (ww < w) { cum[e] += t0[e]; cum[4 + e] += t1[e]; } cc[e] += t0[e]; cc[4 + e] += t1[e]; } }
      if (c == 0) { *(LAS f32x4*)(CUMC + 8 * kg) = (f32x4){cc[0], cc[1], cc[2], cc[3]}; *(LAS f32x4*)(CUMC + 8 * kg + 4) = (f32x4){cc[4], cc[5], cc[6], cc[7]}; }
      v4u oRH, oBT, oKT, oKH, oBM, oKM;
#pragma unroll
      for (int u = 0; u < 8; u += 2) { float x[6][2];
#pragma unroll
          for (int e = 0; e < 2; ++e) { const float cu = cum[u + e]; const float ep = fexp(cu), em = fexp(-cu), et = fexp(cc[u + e] - cu), ex = fexp(cu - lwd[u + e]);
              x[0][e] = rr[u + e] * ep; x[1][e] = bb[u + e] * et; x[2][e] = kt[u + e] * et; x[3][e] = kk[u + e] * ex; x[4][e] = bb[u + e] * em; x[5][e] = kt[u + e] * em;
              RHST[(8 * kg + u + e) * 64 + c] = x[3][e]; }
          oRH[u >> 1] = pk2(x[0][0], x[0][1]); oBT[u >> 1] = pk2(x[1][0], x[1][1]); oKT[u >> 1] = pk2(x[2][0], x[2][1]); oKH[u >> 1] = pk2(x[3][0], x[3][1]); oBM[u >> 1] = pk2(x[4][0], x[4][1]); oKM[u >> 1] = pk2(x[5][0], x[5][1]); }
      const int o = c * RW_LD + 8 * kg;
      *(LAS v4u*)(RHi + o) = oRH; *(LAS v4u*)(BTi + o) = oBT; *(LAS v4u*)(KTi + o) = oKT; *(LAS v4u*)(KHi + o) = oKH; *(LAS v4u*)(BMi + o) = oBM; *(LAS v4u*)(KMi + o) = oKM; }
    WG_SYNC();
    if (stop <= 4) return;
    RW_IDX();
#pragma unroll
    for (int tt = 0; tt < 2; ++tt) { const int tile = 2 * w + tt, ii = tile >> 2, jt = tile & 3;
        f32x4 cA = {0.f, 0.f, 0.f, 0.f}, cB = cA, cPb = cA, cPk = cA;
        if (ii <= jt) {
#pragma unroll
            for (int k0 = 0; k0 < 64; k0 += 32) { const bf16x8 fbm = frag_row(BMi, RW_LD, 16 * ii, k0, lane), fkm = frag_row(KMi, RW_LD, 16 * ii, k0, lane), fkh = frag_row(KHi, RW_LD, 16 * jt, k0, lane), frh = frag_row(RHi, RW_LD, 16 * jt, k0, lane);
                cA = mfma16(fbm, fkh, cA); cB = mfma16(fkm, fkh, cB); cPb = mfma16(fbm, frh, cPb); cPk = mfma16(fkm, frh, cPk); }
#pragma unroll
            for (int e = 0; e < 4; ++e) { const int i = 16 * ii + 4 * g + e, tq = 16 * jt + r; if (!(i < tq)) { cA[e] = 0.f; cB[e] = 0.f; } if (!(i <= tq)) { cPb[e] = 0.f; cPk[e] = 0.f; } } }
        const int tq = 16 * jt + r, i0 = 16 * ii + 4 * g;
        *(LAS f32x4*)(AM + tq * 68 + i0) = cA; *(LAS u32x2*)(AI + tq * RW_LD + i0) = pack4(-cA); *(LAS u32x2*)(BMI + tq * RW_LD + i0) = pack4(cB); *(LAS u32x2*)(PBI + tq * RW_LD + i0) = pack4(cPb); *(LAS u32x2*)(PKI + tq * RW_LD + i0) = pack4(cPk); }
    WG_SYNC();
    if (stop <= 5) return;
    RW_IDX();
#pragma unroll
    for (int tt = 0; tt < 2; ++tt) { const int tile = 2 * w + tt, it = tile >> 2, jv = tile & 3; f32x4 acc = {0.f, 0.f, 0.f, 0.f};
#pragma unroll
        for (int k0 = 0; k0 < 64; k0 += 32) acc = mfma16(frag_row(BMI, RW_LD, 16 * it, k0, lane), frag_tr(Vi, RW_LD, 16 * jv, k0, lane), acc);
        *(LAS f32x4*)(RHST + (64 + 16 * jv + r) * 64 + 16 * it + 4 * g) = acc; }
    { const int q = c * 8 + kg;
      if (q < 64) { const int b = q >> 4, j = q & 15; float d[16], av[16][16];
#pragma unroll
          for (int tq = 1; tq < 16; ++tq)
#pragma unroll
              for (int i = 0; i < tq; ++i) av[tq][i] = AM[(16 * b + tq) * 68 + 16 * b + i];
#pragma unroll
          for (int tq = 0; tq < 16; ++tq) d[tq] = tq == j ? 1.f : 0.f;
#pragma unroll
          for (int i = 0; i < 15; ++i)
#pragma unroll
              for (int tq = i + 1; tq < 16; ++tq) d[tq] -= av[tq][i] * d[i];
#pragma unroll
          for (int tq = 0; tq < 16; ++tq) { DI[(b * 16 + tq) * 32 + j] = (bf16_t)f2bf(d[tq]); DI[(b * 16 + tq) * 32 + 16 + j] = (bf16_t)0; } }
      for (int i = q; i < 128 * RW_LD / 8; i += 512) *(LAS v4u*)(XI + 8 * i) = (v4u){0u, 0u, 0u, 0u};
      *(LAS v4u*)(UI + w * 512 + lane * 8) = (v4u){0u, 0u, 0u, 0u}; }
    WG_SYNC();
    if (stop <= 6) return;
    RW_IDX();
    { LAS bf16_t* Uw = UI + w * 512; LAS bf16_t* Xw = XI + (16 * w) * RW_LD;
#pragma unroll
      for (int b = 0; b < 4; ++b) { f32x4 acc = *(const LAS f32x4*)(RHST + (16 * w + r) * 64 + 16 * b + 4 * g);
#pragma unroll
          for (int k0 = 0; k0 < 16 * b; k0 += 32) acc = mfma16(frag_row(AI, RW_LD, 16 * b, k0, lane), frag_row(Xw, RW_LD, 0, k0, lane), acc);
          *(LAS u32x2*)(Uw + r * 32 + 4 * g) = pack4(acc);
          asm volatile("s_waitcnt lgkmcnt(0)" ::: "memory");
          f32x4 x = {0.f, 0.f, 0.f, 0.f}; x = mfma16(frag_row(DI + b * 512, 32, 0, 0, lane), frag_row(Uw, 32, 0, 0, lane), x);
          *(LAS u32x2*)(Xw + r * RW_LD + 16 * b + 4 * g) = pack4(x);
          asm volatile("s_waitcnt lgkmcnt(0)" ::: "memory"); } }
    WG_SYNC();
    if (stop <= 7) return;
    RW_IDX();
    { const int o = w >> 1; const LAS bf16_t* WHt = XI; const LAS bf16_t* XTt = XI + 64 * RW_LD;
#pragma unroll
      for (int tt = 0; tt < 8; ++tt) { const int tile = (w & 1) * 8 + tt, ti = tile >> 2, tj = tile & 3; f32x4 c1 = {0.f, 0.f, 0.f, 0.f}, c2 = c1;
          if (o == 0) {
#pragma unroll
              for (int k0 = 0; k0 < 64; k0 += 32) c1 = mfma16(frag_row(WHt, RW_LD, 16 * ti, k0, lane), frag_tr(BTi, RW_LD, 16 * tj, k0, lane), c1);
              const int kq = 16 * tj + r; const float dg = fexp(CUMC[kq]); f32x4 gv;
#pragma unroll
              for (int e = 0; e < 4; ++e) gv[e] = ((16 * ti + 4 * g + e) == kq ? dg : 0.f) - c1[e];
              *(u32x2*)((bf16_t*)(a.ws + WS_RW_G) + (size_t)tk * 4096 + fo_st(tj, 2, 16 * ti, g, r)) = pack4(gv);
          } else if (o == 1) {
#pragma unroll
              for (int k0 = 0; k0 < 64; k0 += 32) { c1 = mfma16(frag_tr(KTi, RW_LD, 16 * ti, k0, lane), frag_tr(Vi, RW_LD, 16 * tj, k0, lane), c1); c2 = mfma16(frag_tr(BTi, RW_LD, 16 * ti, k0, lane), frag_row(XTt, RW_LD, 16 * tj, k0, lane), c2); }
              *(u32x2*)((bf16_t*)(a.ws + WS_RW_Z) + (size_t)tk * 4096 + co_off(tj, 4, ti, lane)) = pack4(c1 - c2);
          } else if (o == 2) {
#pragma unroll
              for (int k0 = 0; k0 < 64; k0 += 32) c1 = mfma16(frag_row(WHt, RW_LD, 16 * ti, k0, lane), frag_row(PBI, RW_LD, 16 * tj, k0, lane), c1);
              const int tq = 16 * tj + r; const f32x4 rh = unpack4(*(const LAS u32x2*)(RHi + tq * RW_LD + 16 * ti + 4 * g));
              *(u32x2*)((bf16_t*)(a.ws + WS_RW_QT) + (size_t)tk * 4096 + fo_st(tj, 2, 16 * ti, g, r)) = pack4(rh - c1);
          } else {
#pragma unroll
              for (int k0 = 0; k0 < 64; k0 += 32) { c1 = mfma16(frag_tr(Vi, RW_LD, 16 * ti, k0, lane), frag_row(PKI, RW_LD, 16 * tj, k0, lane), c1); c2 = mfma16(frag_row(XTt, RW_LD, 16 * ti, k0, lane), frag_row(PBI, RW_LD, 16 * tj, k0, lane), c2); }
              *(u32x2*)((bf16_t*)(a.ws + WS_RW_YI) + (size_t)tk * 4096 + co_off(tj, 4, ti, lane)) = pack4(c1 - c2);
          } } }
    WG_SYNC();
#undef RW_IDX
}
__device__ __forceinline__ void rw_stage2(CArgs& a, int h, int vs, LAS unsigned char* lds, int tid) {
    const int lane = tid & 63, w = __builtin_amdgcn_readfirstlane(tid >> 6), r = lane & 15, g = lane >> 4;
    LAS bf16_t* Si = (LAS bf16_t*)lds;
    const bf16_t* G = (const bf16_t*)(a.ws + WS_RW_G); const bf16_t* Z = (const bf16_t*)(a.ws + WS_RW_Z); bf16_t* S = (bf16_t*)(a.ws + WS_RW_S);
    if (w < 4) { *(LAS u32x2*)(Si + r * RW_LD + 16 * w + 4 * g) = (u32x2){0u, 0u}; *(u32x2*)(S + (size_t)h * 4096 + fo_st(vs, 2, 16 * w, g, r)) = (u32x2){0u, 0u}; }
    WG_SYNC();
    constexpr int PD = 8; const int wq = w & 3; const int so = fo_st(vs, 2, 16 * wq, g, r), zo = co_off(vs, 4, wq, lane);
    bf16x8 gf[PD][2]; u32x2 zf[PD];
#pragma unroll
    for (int u = 0; u < PD; ++u) { const size_t tk = (size_t)u * 8 + h; zf[u] = *(const u32x2*)(Z + tk * 4096 + zo); gf[u][0] = frag_fo(G + tk * 4096, 2, wq, 0, lane); gf[u][1] = frag_fo(G + tk * 4096, 2, wq, 1, lane); }
#define RW_STEP(n_, u_, REFILL) do { const int n = (n_); const size_t tk = (size_t)n * 8 + h; const int cur = n & 1; \
            f32x4 acc = unpack4(zf[u_]), acc2 = {0.f, 0.f, 0.f, 0.f}; \
            acc = mfma16(gf[u_][0], frag_row(Si + cur * 16 * RW_LD, RW_LD, 0, 0, lane), acc); acc2 = mfma16(gf[u_][1], frag_row(Si + cur * 16 * RW_LD, RW_LD, 0, 32, lane), acc2); \
            if (REFILL) { const int nn = n + PD < NCH - 1 ? n + PD : NCH - 2; const size_t tn = (size_t)nn * 8 + h; zf[u_] = *(const u32x2*)(Z + tn * 4096 + zo); gf[u_][0] = frag_fo(G + tn * 4096, 2, wq, 0, lane); gf[u_][1] = frag_fo(G + tn * 4096, 2, wq, 1, lane); } \
            const u32x2 pv = pack4(acc + acc2); \
            if (w < 4) { *(LAS u32x2*)(Si + (cur ^ 1) * 16 * RW_LD + r * RW_LD + 16 * wq + 4 * g) = pv; *(u32x2*)(S + (tk + 8) * 4096 + so) = pv; } \
            asm volatile("s_waitcnt lgkmcnt(0)" ::: "memory"); __builtin_amdgcn_s_barrier(); asm volatile("" ::: "memory"); } while (0)
#pragma unroll
    for (int nq = 0; nq < NCH - 1; ++nq) RW_STEP(nq, nq % PD, nq + PD < NCH - 1);
#undef RW_STEP
}
__device__ __forceinline__ void rw_stage3(CArgs& a, int l, int n, int h, LAS unsigned char* lds, int tid) {
    const int lane = tid & 63, w = __builtin_amdgcn_readfirstlane(tid >> 6), r = lane & 15, g = lane >> 4, jc = w & 3, wh = w >> 2;
    const size_t tk = (size_t)n * 8 + h; const int c = 16 * jc + r, t = n * 64 + c;
    const bf16_t* S = (const bf16_t*)(a.ws + WS_RW_S) + tk * 4096; const bf16_t* QT = (const bf16_t*)(a.ws + WS_RW_QT) + tk * 4096; const bf16_t* YI = (const bf16_t*)(a.ws + WS_RW_YI) + tk * 4096;
    LAS float* xs = (LAS float*)lds;
    f32x4 acc[2];
#pragma unroll
    for (int tt = 0; tt < 2; ++tt) { const int iv = 2 * wh + tt; acc[tt] = unpack4(*(const u32x2*)(YI + co_off(jc, 4, iv, lane)));
#pragma unroll
        for (int k = 0; k < 2; ++k) acc[tt] = mfma16(frag_fo(S, 2, iv, k, lane), frag_fo(QT, 2, jc, k, lane), acc[tt]); }
    float s1 = (acc[0][0] + acc[0][1]) + (acc[0][2] + acc[0][3]) + (acc[1][0] + acc[1][1]) + (acc[1][2] + acc[1][3]);
    s1 += __shfl_xor(s1, 16); s1 += __shfl_xor(s1, 32);
    if (g == 0) xs[w * 16 + r] = s1;
    WG_SYNC();
    const float mu = (s1 + xs[(w ^ 4) * 16 + r]) * (1.0f / 64.0f); float s2 = 0.f;
#pragma unroll
    for (int tt = 0; tt < 2; ++tt)
#pragma unroll
        for (int e = 0; e < 4; ++e) { acc[tt][e] -= mu; s2 += acc[tt][e] * acc[tt][e]; }
    s2 += __shfl_xor(s2, 16); s2 += __shfl_xor(s2, 32);
    if (g == 0) xs[128 + w * 16 + r] = s2;
    WG_SYNC();
    const float rs = 1.0f / sqrtf((s2 + xs[128 + (w ^ 4) * 16 + r]) * (1.0f / 64.0f) + 64e-5f);
    const bf16_t* E = (const bf16_t*)(a.ws + WS_RW_E) + tk * 4096; const bf16_t* GT = (const bf16_t*)(a.ws + WS_RW_GT) + tk * 4096;
    bf16_t* O = (bf16_t*)(a.ws + WS_O) + (size_t)t * D + 1536 + h * 64;
#pragma unroll
    for (int tt = 0; tt < 2; ++tt) { const int v0 = 16 * (2 * wh + tt) + 4 * g; const int eo_ = co_off(jc, 4, 2 * wh + tt, lane); const f32x4 ev = unpack4(*(const u32x2*)(E + eo_)), gv = unpack4(*(const u32x2*)(GT + eo_));
        const f32x4 lw = *(const f32x4*)(LP(I_RWLNW, 512) + h * 64 + v0), lb = *(const f32x4*)(LP(I_RWLNB, 512) + h * 64 + v0); f32x4 y;
#pragma unroll
        for (int e = 0; e < 4; ++e) y[e] = (acc[tt][e] * rs * lw[e] + lb[e] + ev[e]) * gv[e];
        *(u32x2*)(O + v0) = pack4(y); }
    WG_SYNC();
}

constexpr int M2_LDS = 136, M2_LDX = 264, M2O_B = 0, M2O_C = 17408, M2O_X = 34816, M2O_XW = 68608, M2O_M = 102400, M2O_DT = 139264, M2O_G = 140288, M2O_GL = 141312;
__device__ __forceinline__ void m2_stage1(CArgs& a, int l, int n, int gr, LAS unsigned char* lds, int tid) {
    const int lane = tid & 63, w = __builtin_amdgcn_readfirstlane(tid >> 6), r = lane & 15, g = lane >> 4;
    LAS bf16_t* Bi = (LAS bf16_t*)(lds + M2O_B); LAS bf16_t* Ci = (LAS bf16_t*)(lds + M2O_C); LAS bf16_t* Xi = (LAS bf16_t*)(lds + M2O_X); LAS bf16_t* XWi = (LAS bf16_t*)(lds + M2O_XW); LAS bf16_t* Mi = (LAS bf16_t*)(lds + M2O_M);
    LAS float* DT = (LAS float*)(lds + M2O_DT); LAS float* GC = (LAS float*)(lds + M2O_G); LAS float* GLAST = (LAS float*)(lds + M2O_GL);
    const int t0 = n * 64;
    LAS bf16_t* RAW = (LAS bf16_t*)(lds + M2O_XW);
    { v4u sv[9];
#pragma unroll
      for (int i = 0; i < 9; ++i) { const int idx = tid + 512 * i, row = idx >> 6, ch = idx & 63, t = t0 - 3 + row; sv[i] = (v4u){0u, 0u, 0u, 0u};
          const int col = ch < 32 ? gr * 256 + 8 * ch : (ch < 48 ? 512 + gr * 128 + 8 * (ch - 32) : 768 + gr * 128 + 8 * (ch - 48));
          if (idx < 67 * 64 && t >= 0) sv[i] = *(const v4u*)(PROJROW(t) + C_MXBC + col); }
#pragma unroll
      for (int i = 0; i < 9; ++i) { const int idx = tid + 512 * i; if (idx < 67 * 64) *(LAS v4u*)(RAW + (idx >> 6) * 512 + 8 * (idx & 63)) = sv[i]; } }
    WG_SYNC();
    for (int it = tid; it < 512 * 4; it += 512) { const int lc = it & 511, seg = it >> 9; int col; LAS bf16_t* dst; int dld;
      if (lc < 256) { col = gr * 256 + lc; dst = Xi + lc; dld = M2_LDX; } else if (lc < 384) { col = 512 + gr * 128 + (lc - 256); dst = Bi + (lc - 256); dld = M2_LDS; } else { col = 768 + gr * 128 + (lc - 384); dst = Ci + (lc - 384); dld = M2_LDS; }
      const float* cw = LP(I_MCONV, 4 * 1024) + col; const float w0 = cw[0], w1 = cw[1024], w2 = cw[2048], w3 = cw[3072], cb = LP(I_MCONVB, 1024)[col];
      const LAS bf16_t* src = RAW + (16 * seg) * 512 + lc;
      float x0 = bf2f(src[0]), x1 = bf2f(src[512]), x2 = bf2f(src[1024]);
#pragma unroll
      for (int cc = 0; cc < 16; ++cc) { const float x3 = bf2f(src[(cc + 3) * 512]); const float y = silu_f(w0 * x0 + w1 * x1 + w2 * x2 + w3 * x3 + cb); dst[(16 * seg + cc) * dld] = (bf16_t)f2bf(y); x0 = x1; x1 = x2; x2 = x3; } }
    if (tid < 256) { const int c = tid >> 2, hh = tid & 3, hd = gr * 4 + hh; const float dt = softplus_f(bf2f(PROJROW(t0 + c)[C_MDT + hd]) + LP(I_MDTB, 8)[hd]); DT[c * 4 + hh] = dt; GC[c * 4 + hh] = -fexp(LP(I_MALOG, 8)[hd]) * dt; }
    WG_SYNC();
    if (tid < 4) { float cu = 0.f; for (int c = 0; c < 64; ++c) { cu += GC[c * 4 + tid]; GC[c * 4 + tid] = cu; } GLAST[tid] = cu; WSF(WS_M2_DEC)[n * 8 + gr * 4 + tid] = fexp(cu); }
    WG_SYNC();
    { const int c = tid >> 3, q = tid & 7;
      const int hh = q >> 1; const float sc = DT[c * 4 + hh] * fexp(GLAST[hh] - GC[c * 4 + hh]);
#pragma unroll
      for (int u = 0; u < 4; ++u) { const v4u xv = *(const LAS v4u*)(Xi + c * M2_LDX + 32 * q + 8 * u); v4u o;
#pragma unroll
          for (int e = 0; e < 4; ++e) o[e] = pk2(__uint_as_float(xv[e] << 16) * sc, __uint_as_float(xv[e] & 0xffff0000u) * sc);
          *(LAS v4u*)(XWi + c * M2_LDX + 32 * q + 8 * u) = o; }
      const float eg = fexp(GC[c * 4 + hh]); bf16_t* QH = (bf16_t*)(a.ws + WS_M2_QH) + (size_t)(n * 8 + gr * 4 + hh) * 8192;
#pragma unroll
      for (int u = 0; u < 8; ++u) { const v4u cv = *(const LAS v4u*)(Ci + c * M2_LDS + 64 * (q & 1) + 8 * u); v4u o;
#pragma unroll
          for (int e = 0; e < 4; ++e) o[e] = pk2(__uint_as_float(cv[e] << 16) * eg, __uint_as_float(cv[e] & 0xffff0000u) * eg);
          { const int s0 = 64 * (q & 1) + 8 * u; *(v4u*)(QH + (((c >> 4) * 4 + (s0 >> 5)) * 64 + ((s0 >> 3) & 3) * 16 + (c & 15)) * 8) = o; } } }
#pragma unroll
    for (int tt = 0; tt < 2; ++tt) { const int tile = 2 * w + tt, im = tile >> 2, jc = tile & 3; f32x4 acc = {0.f, 0.f, 0.f, 0.f};
        if (jc >= im) {
#pragma unroll
            for (int k0 = 0; k0 < 128; k0 += 32) acc = mfma16(frag_row(Bi, M2_LDS, 16 * im, k0, lane), frag_row(Ci, M2_LDS, 16 * jc, k0, lane), acc); }
        const int cq = 16 * jc + r;
#pragma unroll
        for (int hh = 0; hh < 4; ++hh) { f32x4 mv; const float gc = GC[cq * 4 + hh];
#pragma unroll
            for (int e = 0; e < 4; ++e) { const int m = 16 * im + 4 * g + e; mv[e] = cq >= m ? acc[e] * fexp(gc - GC[m * 4 + hh]) * DT[m * 4 + hh] : 0.f; }
            *(LAS u32x2*)(Mi + hh * 64 * 72 + cq * 72 + 16 * im + 4 * g) = pack4(mv); } }
    WG_SYNC();
    { const int hh = w >> 1, hd = gr * 4 + hh; const size_t tk = (size_t)n * 8 + hd; const float Dh = LP(I_MD, 8)[hd];
      bf16_t* YI = (bf16_t*)(a.ws + WS_M2_YI) + tk * 4096; bf16_t* Z = (bf16_t*)(a.ws + WS_M2_Z) + tk * 8192;
#pragma unroll
      for (int tt = 0; tt < 8; ++tt) { const int tile = (w & 1) * 8 + tt, ip = tile >> 2, jc = tile & 3; f32x4 acc = {0.f, 0.f, 0.f, 0.f};
#pragma unroll
          for (int k0 = 0; k0 < 64; k0 += 32) acc = mfma16(frag_tr(Xi, M2_LDX, 64 * hh + 16 * ip, k0, lane), frag_row(Mi + hh * 64 * 72, 72, 16 * jc, k0, lane), acc);
          const int cq = 16 * jc + r; const f32x4 xv = unpack4(*(const LAS u32x2*)(Xi + cq * M2_LDX + 64 * hh + 16 * ip + 4 * g));
          *(u32x2*)(YI + co_off(jc, 4, ip, lane)) = pack4(acc + xv * Dh); }
#pragma unroll
      for (int tt = 0; tt < 16; ++tt) { const int tile = (w & 1) * 16 + tt, is = tile >> 2, jp = tile & 3; f32x4 acc = {0.f, 0.f, 0.f, 0.f};
#pragma unroll
          for (int k0 = 0; k0 < 64; k0 += 32) acc = mfma16(frag_tr(Bi, M2_LDS, 16 * is, k0, lane), frag_tr(XWi, M2_LDX, 64 * hh + 16 * jp, k0, lane), acc);
          *(u32x2*)(Z + fo_st(jp, 4, 16 * is, g, r)) = pack4(acc); } }
    WG_SYNC();
}
__device__ __forceinline__ void m2_stage2(CArgs& a, int b, LAS unsigned char* lds, int tid) {
    const int hd = b >> 4, rem0 = (b & 15) * 512; const DecTable dc{WSF(WS_M2_DEC) + hd, 8};
    ew_stage2((const bf16_t*)(a.ws + WS_M2_Z) + (size_t)hd * 8192 + rem0, (bf16_t*)(a.ws + WS_M2_S) + (size_t)hd * 8192 + rem0, (size_t)8 * 8192, dc, lds, tid);
}
__device__ __forceinline__ void m2_stage3(CArgs& a, int l, int n, int gr, LAS unsigned char* lds, int tid) {
    const int lane = tid & 63, w = __builtin_amdgcn_readfirstlane(tid >> 6), r = lane & 15, g = lane >> 4, hh = w >> 1, hd = gr * 4 + hh;
    const size_t tk = (size_t)n * 8 + hd;
    const bf16_t* S = (const bf16_t*)(a.ws + WS_M2_S) + tk * 8192; const bf16_t* QH = (const bf16_t*)(a.ws + WS_M2_QH) + tk * 8192; const bf16_t* YI = (const bf16_t*)(a.ws + WS_M2_YI) + tk * 4096;
    LAS float* xs = (LAS float*)lds;
    f32x4 acc[2][4]; float ss[2];
#pragma unroll
    for (int cj = 0; cj < 2; ++cj) { const int jc = 2 * (w & 1) + cj, c = 16 * jc + r, t = n * 64 + c; const bf16_t* pz = PROJROW(t) + C_MZ + hd * 64; ss[cj] = 0.f;
#pragma unroll
        for (int ip = 0; ip < 4; ++ip) { acc[cj][ip] = unpack4(*(const u32x2*)(YI + co_off(jc, 4, ip, lane)));
#pragma unroll
            for (int k = 0; k < 4; ++k) acc[cj][ip] = mfma16(frag_fo(S, 4, ip, k, lane), frag_fo(QH, 4, jc, k, lane), acc[cj][ip]);
            const f32x4 zv = unpack4(*(const u32x2*)(pz + 16 * ip + 4 * g));
#pragma unroll
            for (int e = 0; e < 4; ++e) { acc[cj][ip][e] *= silu_f(zv[e]); ss[cj] += acc[cj][ip][e] * acc[cj][ip][e]; } }
        ss[cj] += __shfl_xor(ss[cj], 16); ss[cj] += __shfl_xor(ss[cj], 32);
        if (g == 0) xs[w * 32 + cj * 16 + r] = ss[cj]; }
    WG_SYNC();
#pragma unroll
    for (int cj = 0; cj < 2; ++cj) { const int jc = 2 * (w & 1) + cj, c = 16 * jc + r, t = n * 64 + c;
        const float tot = xs[((w & 1) + 0) * 32 + cj * 16 + r] + xs[((w & 1) + 2) * 32 + cj * 16 + r] + xs[((w & 1) + 4) * 32 + cj * 16 + r] + xs[((w & 1) + 6) * 32 + cj * 16 + r];
        const float rs = 1.0f / sqrtf(tot * (1.0f / 256.0f) + 1e-6f);
        const float* nw = LP(I_MNORM, 512) + hd * 64; bf16_t* O = (bf16_t*)(a.ws + WS_O) + (size_t)t * D + 1024 + hd * 64;
#pragma unroll
        for (int ip = 0; ip < 4; ++ip) { const f32x4 wv = *(const f32x4*)(nw + 16 * ip + 4 * g); f32x4 y;
#pragma unroll
            for (int e = 0; e < 4; ++e) y[e] = acc[cj][ip][e] * rs * wv[e];
            *(u32x2*)(O + 16 * ip + 4 * g) = pack4(y); } }
    WG_SYNC();
}

constexpr int GD_LD = 136;
constexpr int GDO_K = 0, GDO_V = 17408, GDO_KT = 34816, GDO_QG = 52224, GDO_Q = 69632, GDO_AI = 87040, GDO_AMD = 96256, GDO_DI = 100352, GDO_AQ = 104448, GDO_XI = 113664, GDO_QF = 87040, GDO_KF = 119808, GDO_SM = 152576, GDO_UI = 153600;
__device__ __forceinline__ void gd_stage1(CArgs& a, int l, int n, int h, LAS unsigned char* lds, int tid, const int stop = 99) {
    const int w = __builtin_amdgcn_readfirstlane(tid >> 6), tk = n * 4 + h, t0 = n * 64;
    int lane, r, g, c, q8;
#define GD_IDX() do { int tl_ = tid; asm volatile("" : "+v"(tl_)); lane = tl_ & 63; r = lane & 15; g = lane >> 4; c = tl_ >> 3; q8 = tl_ & 7; } while (0)
    LAS bf16_t* Ki = (LAS bf16_t*)(lds + GDO_K); LAS bf16_t* Vi = (LAS bf16_t*)(lds + GDO_V); LAS bf16_t* KTi = (LAS bf16_t*)(lds + GDO_KT); LAS bf16_t* QGi = (LAS bf16_t*)(lds + GDO_QG); LAS bf16_t* Qi = (LAS bf16_t*)(lds + GDO_Q);
    LAS bf16_t* AI = (LAS bf16_t*)(lds + GDO_AI);
    LAS float* AMD = (LAS float*)(lds + GDO_AMD);
    LAS bf16_t* DI = (LAS bf16_t*)(lds + GDO_DI);
    LAS bf16_t* AQ = (LAS bf16_t*)(lds + GDO_AQ);
    LAS bf16_t* XI = (LAS bf16_t*)(lds + GDO_XI);
    LAS bf16_t* UI = (LAS bf16_t*)(lds + GDO_UI);
    LAS float* QF = (LAS float*)(lds + GDO_QF); LAS float* KF = (LAS float*)(lds + GDO_KF);
    LAS float* BETA = (LAS float*)(lds + GDO_SM); LAS float* GC = BETA + 64; LAS float* BG = GC + 64;
    LAS bf16_t* RAW = (LAS bf16_t*)(lds + GDO_KT);
    { v4u sv[7];
#pragma unroll
      for (int i = 0; i < 7; ++i) { const int idx = tid + 512 * i, row = idx / 48, ch = idx % 48, which = ch >> 4, t = t0 - 3 + row; sv[i] = (v4u){0u, 0u, 0u, 0u};
          if (idx < 67 * 48 && t >= 0) sv[i] = *(const v4u*)(PROJROW(t) + C_GQ + which * 512 + h * 128 + 8 * (ch & 15)); }
#pragma unroll
      for (int i = 0; i < 7; ++i) { const int idx = tid + 512 * i; if (idx < 67 * 48) *(LAS v4u*)(RAW + (idx / 48) * 384 + 8 * (idx % 48)) = sv[i]; } }
    WG_SYNC();
    for (int it = tid; it < 384 * 4; it += 512) { const int col = it % 384, seg = it / 384, which = col >> 7, dcol = col & 127, cwi = which * 512 + h * 128 + dcol;
        const float* cw = LP(I_GCONV, 4 * 1536) + cwi; const float w0 = cw[0], w1 = cw[1536], w2 = cw[3072], w3 = cw[4608];
        const LAS bf16_t* src = RAW + (16 * seg) * 384 + col;
        float x0 = bf2f(src[0]), x1 = bf2f(src[384]), x2 = bf2f(src[768]);
#pragma unroll
        for (int cc = 0; cc < 16; ++cc) { const float x3 = bf2f(src[(cc + 3) * 384]); const float y = silu_f(w0 * x0 + w1 * x1 + w2 * x2 + w3 * x3); const int tok = 16 * seg + cc;
            if (which == 2) Vi[tok * GD_LD + dcol] = (bf16_t)f2bf(y); else (which == 0 ? QF : KF)[tok * 128 + dcol] = y;
            x0 = x1; x1 = x2; x2 = x3; } }
    if (tid >= 384 && tid < 448) { const int cc = tid - 384; const bf16_t* pr = PROJROW(t0 + cc);
        const float beta = sigmoid_f(bf2f(pr[C_GB + h])); float cu = -fexp(LP(I_GALOG, 4)[h]) * softplus_f(bf2f(pr[C_GA + h]) + LP(I_GDTB, 4)[h]);
#pragma unroll
        for (int o = 1; o < 64; o <<= 1) { const float up = __shfl_up(cu, o); if (cc >= o) cu += up; }
        BETA[cc] = beta; GC[cc] = cu; BG[cc] = beta * fexp(cu); }
    WG_SYNC();
    GD_IDX();
    if (stop <= 0) return;
    { float qv[16], kv[16]; float sq = 0.f, sk = 0.f;
#pragma unroll
      for (int u = 0; u < 4; ++u) { const f32x4 a4 = *(const LAS f32x4*)(QF + c * 128 + 16 * q8 + 4 * u), b4 = *(const LAS f32x4*)(KF + c * 128 + 16 * q8 + 4 * u);
#pragma unroll
          for (int e = 0; e < 4; ++e) { qv[4 * u + e] = a4[e]; kv[4 * u + e] = b4[e]; sq += a4[e] * a4[e]; sk += b4[e] * b4[e]; } }
      sq += __shfl_xor(sq, 1); sq += __shfl_xor(sq, 2); sq += __shfl_xor(sq, 4); sk += __shfl_xor(sk, 1); sk += __shfl_xor(sk, 2); sk += __shfl_xor(sk, 4);
      const float gc = GC[c], iq = (1.0f / sqrtf(sq + 1e-6f)) * 0.08838834764831845f, ik = 1.0f / sqrtf(sk + 1e-6f), et = fexp(GC[63] - gc), eg = fexp(gc);
      v4u oK[2], oQ[2], oKT[2], oQG[2];
#pragma unroll
      for (int u = 0; u < 8; ++u) { const float k0 = kv[2 * u] * ik, k1 = kv[2 * u + 1] * ik, q0 = qv[2 * u] * iq, q1 = qv[2 * u + 1] * iq;
          oK[u >> 2][u & 3] = pk2(k0, k1); oQ[u >> 2][u & 3] = pk2(q0, q1); oKT[u >> 2][u & 3] = pk2(k0 * et, k1 * et); oQG[u >> 2][u & 3] = pk2(q0 * eg, q1 * eg); }
      const int o = c * GD_LD + 16 * q8;
      *(LAS v4u*)(Ki + o) = oK[0]; *(LAS v4u*)(Ki + o + 8) = oK[1]; *(LAS v4u*)(Qi + o) = oQ[0]; *(LAS v4u*)(Qi + o + 8) = oQ[1];
      *(LAS v4u*)(KTi + o) = oKT[0]; *(LAS v4u*)(KTi + o + 8) = oKT[1]; *(LAS v4u*)(QGi + o) = oQG[0]; *(LAS v4u*)(QGi + o + 8) = oQG[1]; }
    WG_SYNC();
    GD_IDX();
    if (stop <= 1) return;
#pragma unroll
    for (int tt = 0; tt < 2; ++tt) { const int tile = 2 * w + tt, im = tile >> 2, jc = tile & 3; f32x4 c1 = {0.f, 0.f, 0.f, 0.f}, c2 = c1;
        if (jc >= im) {
#pragma unroll
            for (int k0 = 0; k0 < 128; k0 += 32) { const bf16x8 fa = frag_row(Ki, GD_LD, 16 * im, k0, lane); c1 = mfma16(fa, frag_row(Ki, GD_LD, 16 * jc, k0, lane), c1); c2 = mfma16(fa, frag_row(Qi, GD_LD, 16 * jc, k0, lane), c2); }
            const int cq = 16 * jc + r; const float gc = GC[cq], bc = BETA[cq];
#pragma unroll
            for (int e = 0; e < 4; ++e) { const int m = 16 * im + 4 * g + e; const float dc = fexp(gc - GC[m]); c1[e] = m < cq ? c1[e] * dc * bc : 0.f; c2[e] = m <= cq ? c2[e] * dc : 0.f; } }
        const int cq = 16 * jc + r; *(LAS u32x2*)(AI + cq * 72 + 16 * im + 4 * g) = pack4(-c1); *(LAS u32x2*)(AQ + cq * 72 + 16 * im + 4 * g) = pack4(c2);
        if (im == jc) *(LAS f32x4*)(AMD + (im * 16 + r) * 16 + 4 * g) = c1; }
    WG_SYNC();
    GD_IDX();
    if (stop <= 2) return;
    { const int q = c * 8 + q8;
      if (q < 64) { const int b = q >> 4, j = q & 15; float d[16], av[16][16];
#pragma unroll
          for (int tq = 1; tq < 16; ++tq)
#pragma unroll
              for (int i = 0; i < tq; ++i) av[tq][i] = AMD[(b * 16 + tq) * 16 + i];
#pragma unroll
          for (int tq = 0; tq < 16; ++tq) d[tq] = tq == j ? 1.f : 0.f;
#pragma unroll
          for (int i = 0; i < 15; ++i)
#pragma unroll
              for (int tq = i + 1; tq < 16; ++tq) d[tq] -= av[tq][i] * d[i];
#pragma unroll
          for (int tq = 0; tq < 16; ++tq) { DI[(b * 16 + tq) * 32 + j] = (bf16_t)f2bf(d[tq]); DI[(b * 16 + tq) * 32 + 16 + j] = (bf16_t)0; } }
      for (int i = q; i < 256 * 72 / 8; i += 512) *(LAS v4u*)(XI + 8 * i) = (v4u){0u, 0u, 0u, 0u};
      *(LAS v4u*)(UI + w * 512 + lane * 8) = (v4u){0u, 0u, 0u, 0u}; }
    WG_SYNC();
    GD_IDX();
    if (stop <= 3) return;
    { LAS bf16_t* Uw = UI + w * 512;
#pragma unroll
      for (int tt = 0; tt < 2; ++tt) { const int nt = 2 * w + tt; LAS bf16_t* Xw = XI + (16 * nt) * 72;
          const LAS bf16_t* src = nt < 8 ? Vi + 16 * nt + r : Ki + 16 * (nt - 8) + r; const LAS float* scl = nt < 8 ? BETA : BG;
#pragma unroll
          for (int b = 0; b < 4; ++b) { const f32x4 sc = *(const LAS f32x4*)(scl + 16 * b + 4 * g); f32x4 acc;
#pragma unroll
              for (int e = 0; e < 4; ++e) acc[e] = bf2f(src[(16 * b + 4 * g + e) * GD_LD]) * sc[e];
#pragma unroll
              for (int k0 = 0; k0 < 16 * b; k0 += 32) acc = mfma16(frag_row(AI, 72, 16 * b, k0, lane), frag_row(Xw, 72, 0, k0, lane), acc);
              *(LAS u32x2*)(Uw + r * 32 + 4 * g) = pack4(acc);
              asm volatile("s_waitcnt lgkmcnt(0)" ::: "memory");
              f32x4 x = {0.f, 0.f, 0.f, 0.f}; x = mfma16(frag_row(DI + b * 512, 32, 0, 0, lane), frag_row(Uw, 32, 0, 0, lane), x);
              *(LAS u32x2*)(Xw + r * 72 + 16 * b + 4 * g) = pack4(x);
              asm volatile("s_waitcnt lgkmcnt(0)" ::: "memory"); } } }
    WG_SYNC();
    GD_IDX();
    if (stop <= 4) return;
    { const int jc = w & 3, wh = w >> 2; const int cq = 16 * jc + r;
      bf16_t* QT = (bf16_t*)(a.ws + WS_GD_QT) + (size_t)tk * 8192; bf16_t* YI = (bf16_t*)(a.ws + WS_GD_YI) + (size_t)tk * 8192; bf16_t* GG = (bf16_t*)(a.ws + WS_GD_G) + (size_t)tk * 16384; bf16_t* Z = (bf16_t*)(a.ws + WS_GD_Z) + (size_t)tk * 16384;
#pragma unroll
      for (int tt = 0; tt < 4; ++tt) { const int id = 4 * wh + tt; f32x4 c1 = {0.f, 0.f, 0.f, 0.f}, c2 = c1;
#pragma unroll
          for (int k0 = 0; k0 < 64; k0 += 32) { const bf16x8 fb = frag_row(AQ, 72, 16 * jc, k0, lane); c1 = mfma16(frag_row(XI + 128 * 72, 72, 16 * id, k0, lane), fb, c1); c2 = mfma16(frag_row(XI, 72, 16 * id, k0, lane), fb, c2); }
          const f32x4 qg = unpack4(*(const LAS u32x2*)(QGi + cq * GD_LD + 16 * id + 4 * g));
          *(u32x2*)(QT + fo_st(jc, 4, 16 * id, g, r)) = pack4(qg - c1); *(u32x2*)(YI + co_off(jc, 8, id, lane)) = pack4(c2); }
      const float e63 = fexp(GC[63]);
#pragma unroll
      for (int ti = 0; ti < 8; ++ti) { f32x4 c1 = {0.f, 0.f, 0.f, 0.f}, c2 = c1;
#pragma unroll
          for (int k0 = 0; k0 < 64; k0 += 32) { c1 = mfma16(frag_row(XI + 128 * 72, 72, 16 * ti, k0, lane), frag_tr(KTi, GD_LD, 16 * w, k0, lane), c1); c2 = mfma16(frag_tr(KTi, GD_LD, 16 * ti, k0, lane), frag_row(XI, 72, 16 * w, k0, lane), c2); }
          const int dq = 16 * w + r; f32x4 gv;
#pragma unroll
          for (int e = 0; e < 4; ++e) gv[e] = ((16 * ti + 4 * g + e) == dq ? e63 : 0.f) - c1[e];
          *(u32x2*)(GG + fo_st(w, 4, 16 * ti, g, r)) = pack4(gv); *(u32x2*)(Z + co_off(w, 8, ti, lane)) = pack4(c2); } }
    WG_SYNC();
#undef GD_IDX
}
__device__ __forceinline__ void gd_stage2(CArgs& a, int h, int es, LAS unsigned char* lds, int tid, const int var = 0) {
    const int lane = tid & 63, w = __builtin_amdgcn_readfirstlane(tid >> 6), r = lane & 15, g = lane >> 4;
    LAS bf16_t* Si = (LAS bf16_t*)lds;
    const bf16_t* G = (const bf16_t*)(a.ws + WS_GD_G); const bf16_t* Z = (const bf16_t*)(a.ws + WS_GD_Z); bf16_t* S = (bf16_t*)(a.ws + WS_GD_S);
    const int so = fo_st(es, 4, 16 * w, g, r), zo = co_off(es, 8, w, lane);
    *(LAS u32x2*)(Si + r * GD_LD + 16 * w + 4 * g) = (u32x2){0u, 0u}; *(u32x2*)(S + (size_t)h * 16384 + so) = (u32x2){0u, 0u};
    WG_SYNC();
    constexpr int PD = 8;
    bf16x8 gf[PD][4]; u32x2 zf[PD];
#pragma unroll
    for (int u = 0; u < PD; ++u) { const size_t tk = (size_t)u * 4 + h; zf[u] = *(const u32x2*)(Z + tk * 16384 + zo);
#pragma unroll
        for (int k = 0; k < 4; ++k) gf[u][k] = frag_fo(G + tk * 16384, 4, w, k, lane); }
#define GD_STEP(n_, u_, REFILL) do { const int n = (n_); const size_t tk = (size_t)n * 4 + h; const int cur = n & 1; \
            f32x4 acc = unpack4(zf[u_]), acc2 = {0.f, 0.f, 0.f, 0.f}; \
            acc = mfma16(gf[u_][0], frag_row(Si + cur * 16 * GD_LD, GD_LD, 0, 0, lane), acc); acc2 = mfma16(gf[u_][1], frag_row(Si + cur * 16 * GD_LD, GD_LD, 0, 32, lane), acc2); \
            acc = mfma16(gf[u_][2], frag_row(Si + cur * 16 * GD_LD, GD_LD, 0, 64, lane), acc); acc2 = mfma16(gf[u_][3], frag_row(Si + cur * 16 * GD_LD, GD_LD, 0, 96, lane), acc2); \
            if (REFILL && !(var & 2)) { const int nn = n + PD < NCH - 1 ? n + PD : NCH - 2; const size_t tn = (size_t)nn * 4 + h; zf[u_] = *(const u32x2*)(Z + tn * 16384 + zo); \
                _Pragma("unroll") for (int k = 0; k < 4; ++k) gf[u_][k] = frag_fo(G + tn * 16384, 4, w, k, lane); } \
            const u32x2 pv = pack4(acc + acc2); \
            if (!(var & 4)) *(LAS u32x2*)(Si + (cur ^ 1) * 16 * GD_LD + r * GD_LD + 16 * w + 4 * g) = pv; if (!(var & 1)) *(u32x2*)(S + (tk + 4) * 16384 + so) = pv; \
            if (!(var & 4)) { asm volatile("s_waitcnt lgkmcnt(0)" ::: "memory"); __builtin_amdgcn_s_barrier(); } asm volatile("" ::: "memory"); } while (0)
#pragma unroll
    for (int nq = 0; nq < NCH - 1; ++nq) GD_STEP(nq, nq % PD, nq + PD < NCH - 1);
#undef GD_STEP
}
__device__ __forceinline__ void gd_stage3(CArgs& a, int l, int n, int h, LAS unsigned char* lds, int tid) {
    const int lane = tid & 63, w = __builtin_amdgcn_readfirstlane(tid >> 6), r = lane & 15, g = lane >> 4, jc = w & 3, wh = w >> 2;
    const size_t tk = (size_t)n * 4 + h; const int c = 16 * jc + r, t = n * 64 + c;
    const bf16_t* S = (const bf16_t*)(a.ws + WS_GD_S) + tk * 16384; const bf16_t* QT = (const bf16_t*)(a.ws + WS_GD_QT) + tk * 8192; const bf16_t* YI = (const bf16_t*)(a.ws + WS_GD_YI) + tk * 8192;
    LAS float* xs = (LAS float*)lds;
    f32x4 acc[4]; float ss = 0.f;
#pragma unroll
    for (int tt = 0; tt < 4; ++tt) { const int ie = 4 * wh + tt; acc[tt] = unpack4(*(const u32x2*)(YI + co_off(jc, 8, ie, lane)));
#pragma unroll
        for (int k = 0; k < 4; ++k) acc[tt] = mfma16(frag_fo(S, 4, ie, k, lane), frag_fo(QT, 4, jc, k, lane), acc[tt]);
#pragma unroll
        for (int e = 0; e < 4; ++e) ss += acc[tt][e] * acc[tt][e]; }
    ss += __shfl_xor(ss, 16); ss += __shfl_xor(ss, 32);
    if (g == 0) xs[w * 16 + r] = ss;
    WG_SYNC();
    const float rs = 1.0f / sqrtf((ss + xs[(w ^ 4) * 16 + r]) * (1.0f / 128.0f) + 1e-6f);
    const float* nw = LP(I_GNORM, 128); const bf16_t* pz = PROJROW(t) + C_GZ + h * 128; bf16_t* O = (bf16_t*)(a.ws + WS_O) + (size_t)t * D + h * 128;
#pragma unroll
    for (int tt = 0; tt < 4; ++tt) { const int e0 = 16 * (4 * wh + tt) + 4 * g; const f32x4 zv = unpack4(*(const u32x2*)(pz + e0)), wv = *(const f32x4*)(nw + e0); f32x4 y;
#pragma unroll
        for (int e = 0; e < 4; ++e) y[e] = acc[tt][e] * rs * wv[e] * silu_f(zv[e]);
        *(u32x2*)(O + e0) = pack4(y); }
    WG_SYNC();
}

#define XB_TMO      128
#define XB_XCNT(j)  (256  + 64 * (j))
#define XB_XSUB(j)  (1280 + 64 * (j))
#define XB_XGEN(j)  (2304 + 64 * (j))
#define XB_TOP      3328
#define XB_TOPGEN   3392
#define XCD_BAR_WORDS 3456
#define XB_SPIN_CAP (1u << 20)
__device__ __forceinline__ unsigned xb_ld(unsigned* p)              { return __hip_atomic_load(p, __ATOMIC_RELAXED, __HIP_MEMORY_SCOPE_AGENT); }
__device__ __forceinline__ unsigned xb_add(unsigned* p, unsigned v) { return __hip_atomic_fetch_add(p, v, __ATOMIC_RELAXED, __HIP_MEMORY_SCOPE_AGENT); }
__device__ __forceinline__ unsigned xb_xcc_id() { return (unsigned)__builtin_amdgcn_s_getreg((3 << 11) | 20) & 0xFu; }
#define XB_SPIN(cond, bar) do { unsigned _sp = 0; while (cond) { __builtin_amdgcn_s_sleep(1); \
    if ((++_sp & 255u) == 0u) { if (xb_ld(&(bar)[XB_TMO])) break; if (_sp > XB_SPIN_CAP) { atomicAdd(&(bar)[XB_TMO], 1u); break; } } } } while (0)
struct XcdBarrier { unsigned* bar; unsigned x; volatile LAS unsigned* st; };
__device__ __forceinline__ XcdBarrier xcd_barrier_post(unsigned* bar, volatile LAS unsigned* st) {
    XcdBarrier b; b.bar = bar; b.x = xb_xcc_id(); b.st = st;
    if (threadIdx.x == 0) (void)xb_add(&bar[XB_XCNT(b.x)], 1u);
    return b;
}
__device__ __forceinline__ void xcd_barrier_complete(unsigned* bar, unsigned x, unsigned& nloc, unsigned& nx) {
    const unsigned G = gridDim.x * gridDim.y * gridDim.z;
    unsigned sum, cnt, mine, sp = 0u;
    for (;;) {
        sum = 0u; cnt = 0u; mine = 0u;
#pragma unroll
        for (unsigned j = 0; j < 16; ++j) { const unsigned c = xb_ld(&bar[XB_XCNT(j)]); sum += c; cnt += (c > 0u) ? 1u : 0u; mine = (j == x) ? c : mine; }
        if (sum == G) break;
        __builtin_amdgcn_s_sleep(1);
        if ((++sp & 255u) == 0u) { if (xb_ld(&bar[XB_TMO])) break; if (sp > XB_SPIN_CAP) { atomicAdd(&bar[XB_TMO], 1u); break; } }
    }
    nloc = mine > 0u ? mine : 1u; nx = cnt > 0u ? cnt : 1u;
}
__device__ __forceinline__ void xcd_barrier(const XcdBarrier& b) {
    asm volatile("s_waitcnt vmcnt(0)" ::: "memory");
    __syncthreads();
    if (threadIdx.x == 0) {
        unsigned* bar = b.bar;
        __builtin_amdgcn_s_waitcnt(0);
        unsigned nloc = b.st[0], nx = b.st[1];
        if (nloc == 0u) { xcd_barrier_complete(bar, b.x, nloc, nx); b.st[0] = nloc; b.st[1] = nx; }
        const unsigned old = xb_add(&bar[XB_XSUB(b.x)], 1u);
        const unsigned gen = old / nloc;
        if (old + 1u == (gen + 1u) * nloc) {
            __builtin_amdgcn_fence(__ATOMIC_RELEASE, "agent");
            asm volatile("s_waitcnt vmcnt(0)" ::: "memory");
            const unsigned og = xb_add(&bar[XB_TOP], 1u);
            const unsigned tg = og / nx;
            if (og + 1u == (tg + 1u) * nx) xb_add(&bar[XB_TOPGEN], 1u);
            else XB_SPIN(xb_ld(&bar[XB_TOPGEN]) == tg, bar);
            __builtin_amdgcn_fence(__ATOMIC_ACQUIRE, "agent");
            xb_add(&bar[XB_XGEN(b.x)], 1u);
            asm volatile("s_waitcnt vmcnt(0)" ::: "memory");
        } else {
            XB_SPIN(xb_ld(&bar[XB_XGEN(b.x)]) == gen, bar);
            __builtin_amdgcn_fence(__ATOMIC_ACQUIRE, "agent");
            asm volatile("s_waitcnt vmcnt(0)" ::: "memory");
        }
    }
    __syncthreads();
}

constexpr int CV_IN = (D / 64) * (PTP / 32), CV_OUT = (D / 64) * (D / 32), CV_UP = (D / 64) * (FF / 32), CV_DN = (FF / 64) * (D / 32), CV_ALL = CV_IN + CV_OUT + CV_UP + CV_DN;
__device__ __forceinline__ void cvt_items(CArgs& a, int l, int lo, int hi, int gwv, int ngwv, LAS float* scr, int lane) {
#pragma unroll 1
    for (int it = lo + gwv; it < hi; it += ngwv) {
        int r = it;
        if (r < CV_IN) { transpose_item(LP(I_WIN, (size_t)D * PT), D, PT, PTP, (bf16_t*)(a.ws + WS_WIN), scr, r, lane, LP(I_N1, D)); continue; } r -= CV_IN;
        if (r < CV_OUT) { transpose_item(LP(I_WOUT, (size_t)D * D), D, D, D, (bf16_t*)(a.ws + WS_WOUT), scr, r, lane); continue; } r -= CV_OUT;
        if (r < CV_UP) { transpose_item(LP(I_WUP, (size_t)D * FF), D, FF, FF, (bf16_t*)(a.ws + WS_WUP), scr, r, lane, LP(I_N2, D)); continue; } r -= CV_UP;
        transpose_item(LP(I_WDN, (size_t)FF * D), FF, D, D, (bf16_t*)(a.ws + WS_WDN), scr, r, lane);
    }
}

constexpr int CW_SUB = 8192;
__device__ __forceinline__ void cnt_arrive(unsigned* cnt) {
    asm volatile("s_waitcnt vmcnt(0)" ::: "memory"); __syncthreads();
    if (threadIdx.x == 0) { __builtin_amdgcn_fence(__ATOMIC_RELEASE, "agent"); asm volatile("s_waitcnt vmcnt(0)" ::: "memory"); (void)xb_add(cnt, 1u); }
}
__device__ __forceinline__ void cnt_wait(unsigned* cnt, unsigned want, unsigned* tmo) {
    if (threadIdx.x == 0) { unsigned sp = 0; while (xb_ld(cnt) < want) { __builtin_amdgcn_s_sleep(2); if ((++sp & 255u) == 0u) { if (xb_ld(tmo)) break; if (sp > XB_SPIN_CAP) { atomicAdd(tmo, 1u); break; } } }
        __builtin_amdgcn_fence(__ATOMIC_ACQUIRE, "agent"); asm volatile("s_waitcnt vmcnt(0)" ::: "memory"); }
    __syncthreads();
}

constexpr int N_PHASES = 1 + 9 * NL;

__device__ __forceinline__ void run_phase(CArgs& a, int ph, LAS unsigned char* lds, const int tid, const int bid, const int mask = 15) {
    const int lane = tid & 63, wave = __builtin_amdgcn_readfirstlane(tid >> 6);
    const int G = gridDim.x, gw = bid * NWAVES + wave, NGW = G * NWAVES;
    ss_t* SSb = (ss_t*)(a.ws + WS_SS);
    if (ph == N_PHASES - 1) {
        for (int t = gw; t < T; t += NGW) final_row((const bf16_t*)(a.ws + WS_HB) + (size_t)t * D, a.in[I_NF], (float)SSb[2 * NL * T + t] * SS_INV, a.out + (size_t)t * D, lane);
        return;
    }
    const int l = ph / 9, sp = ph % 9;
    bf16_t* HB = (bf16_t*)(a.ws + WS_HB);
    switch (sp) {
    case 0: {
        if (mask & 1) cvt_items(a, l, 0, CV_IN, gw, NGW, (LAS float*)(lds + wave * 16384), lane);
        if (mask & 2) for (int t = gw; t < T; t += NGW) hb_row(a.in[I_X] + (size_t)t * D, HB + (size_t)t * D, SSb + t, lane);
    } break;
    case 1: { pg8::Gemm g{HB, (const bf16_t*)(a.ws + WS_WIN)}; pg8::StaticOrder<T, PTP> S; S.init(G, bid);
              pg8::EpiBf16<false> E{(bf16_t*)(a.ws + WS_PROJ), PTP, SSb + l * T}; pg8::gemm_phase<D, pg8::EpiBf16<false>, pg8::StaticOrder<T, PTP>, true>(lds, g, S, E, tid);
              constexpr int NFULL = (T / 256) * (PTP / 256) % 256; if (bid >= NFULL) cvt_items(a, l, CV_IN, CV_ALL, (bid - NFULL) * NWAVES + wave, (G - NFULL) * NWAVES, (LAS float*)(lds + wave * 16384), lane); } break;
    case 2: {
#pragma unroll 1
              for (int it = bid; (mask & 1) && it < NCH * 4; it += G) gd_stage1(a, l, it >> 2, it & 3, lds, tid, mask >> 8 ? (mask >> 8) - 1 : 99);
#pragma unroll 1
              for (int it = bid; (mask & 4) && it < NCH * 8; it += G) rw_stage1(a, l, it >> 3, it & 7, lds, tid, mask >> 8 ? (mask >> 8) - 1 : 99);
#pragma unroll 1
              for (int it = bid; (mask & 8) && it < NCH * 2; it += G) m2_stage1(a, l, it >> 1, it & 1, lds, tid);
#pragma unroll 1
              for (int it = bid; (mask & 2) && it < NCH * 4; it += G) ret_stage1(a, it >> 2, it & 3, lds, tid); } break;
    case 3: { const int b = bid;
              unsigned* ctl = (unsigned*)(a.ws + WS_CTL); unsigned* sub = ctl + CW_SUB + 128 * l; unsigned* ddone = sub + 32; unsigned* gdone = sub + 64;
              if (b < 64) { const int x = b & 7, j = b >> 3;
                  if (x < 4) { if (mask & 1) gd_stage2(a, x, j, lds, tid, mask >> 8); if (mask == 15) cnt_arrive(gdone); }
                  else { if (mask & 4) rw_stage2(a, (x - 4) * 2 + (j >> 2), j & 3, lds, tid); if (mask == 15) cnt_arrive(ddone); } }
              else { if (b < 128) { if (mask & 2) ret_stage2(a, b - 64, lds, tid); } else if (mask & 8) m2_stage2(a, b - 128, lds, tid);
                  if (mask == 15) { const int hb = b - 64, NH = G - 64;
                      cnt_arrive(sub); cnt_wait(sub, (unsigned)NH, ctl + XB_TMO);
#pragma unroll 1
                      for (int it = hb; it < NCH * 4; it += NH) ret_stage3(a, l, it >> 2, it & 3, lds, tid);
#pragma unroll 1
                      for (int it = hb; it < NCH * 2; it += NH) m2_stage3(a, l, it >> 1, it & 1, lds, tid); } }
              if (mask == 15) { LAS float* scr = (LAS float*)(lds + wave * 16384);
                  __syncthreads();
                  if (l + 1 < NL) cvt_items(a, l + 1, 0, CV_IN, gw, NGW, scr, lane);
                  __syncthreads();
                  cnt_wait(ddone, 32u, ctl + XB_TMO);
#pragma unroll 1
                  for (int it = bid; it < NCH * 8; it += G) rw_stage3(a, l, it >> 3, it & 7, lds, tid);
                  cnt_wait(gdone, 32u, ctl + XB_TMO);
#pragma unroll 1
                  for (int it = bid; it < NCH * 4; it += G) gd_stage3(a, l, it >> 2, it & 3, lds, tid); } } break;
    case 4: break;
    case 5: { pg8::Gemm g{(const bf16_t*)(a.ws + WS_O), (const bf16_t*)(a.ws + WS_WOUT)}; pg8::StaticOrder<T, D> S; S.init(G, bid);
              if (l == 0) { pg8::EpiRes<true> E{a.in[I_X], HB, D, SSb + (NL + l) * T}; pg8::gemm_phase<D, pg8::EpiRes<true>, pg8::StaticOrder<T, D>, false>(lds, g, S, E, tid); }
              else { pg8::EpiRes<false> E{HB, HB, D, SSb + (NL + l) * T}; pg8::gemm_phase<D, pg8::EpiRes<false>, pg8::StaticOrder<T, D>, false>(lds, g, S, E, tid); } } break;
    case 6: break;
    case 7: { pg8::Gemm g{HB, (const bf16_t*)(a.ws + WS_WUP)}; pg8::StaticOrder<T, FF> S; S.init(G, bid);
              pg8::EpiBf16<true> E{(bf16_t*)(a.ws + WS_HID), FF, SSb + (NL + l) * T}; pg8::gemm_phase<D, pg8::EpiBf16<true>, pg8::StaticOrder<T, FF>, true>(lds, g, S, E, tid); } break;
    case 8: { pg8::Gemm g{(const bf16_t*)(a.ws + WS_HID), (const bf16_t*)(a.ws + WS_WDN)}; pg8::StaticOrder<T, D> S; S.init(G, bid);
              pg8::EpiRes<false> E{HB, HB, D, SSb + (l + 1 < NL ? (l + 1) : 2 * NL) * T}; pg8::gemm_phase<FF, pg8::EpiRes<false>, pg8::StaticOrder<T, D>, false>(lds, g, S, E, tid); } break;
    }
}

__global__ void __launch_bounds__(NWAVES * 64, 2) fwd_kernel(Args a) {
    extern __shared__ __attribute__((aligned(16))) unsigned char lds_raw[];
    LAS unsigned char* lds = (LAS unsigned char*)lds_raw;
    const int ph_lo = a.ph_lo, ph_hi = a.ph_hi;
    volatile LAS unsigned* MISC = (volatile LAS unsigned*)(lds + MISC_OFF);
    if (threadIdx.x < 64) MISC[threadIdx.x] = 0u;
    __syncthreads();
    const XcdBarrier bar = xcd_barrier_post((unsigned*)(a.ws + WS_CTL), MISC + 8);
    for (int ph = ph_lo; ph < ph_hi; ++ph) {
        if (ph != N_PHASES - 1 && (ph % 9 == 6 || ph % 9 == 4 || (ph % 9 == 0 && ph > 0))) continue;
        CArgs* ap = (CArgs*)__builtin_amdgcn_kernarg_segment_ptr();
        asm volatile("" : "+s"(ap));
        int tid = threadIdx.x, bid = blockIdx.x;
        asm volatile("" : "+v"(tid)); asm volatile("" : "+s"(bid));
        run_phase(*ap, ph, lds, tid, bid);
#ifdef DUP_PHASE
#ifndef DUP_MASK
#define DUP_MASK 15
#endif
        if (ph == DUP_PHASE) { xcd_barrier(bar); asm volatile("" : "+s"(ap)); asm volatile("" : "+v"(tid)); asm volatile("" : "+s"(bid)); run_phase(*ap, ph, lds, tid, bid, DUP_MASK); }
#endif
        if (ph + 1 < ph_hi) xcd_barrier(bar);
    }
}

extern "C" void kernel_launch(void* const* d_in, const int* in_sizes, int n_in, void* d_out, int out_size, void* d_ws, size_t ws_size, hipStream_t stream) {
    static int grid = 0;
    if (grid == 0) {
        if (n_in != N_IN || in_sizes[0] != T * D || out_size != T * D || ws_size < WS_END) {
            fprintf(stderr, "kernel_launch: shape/workspace mismatch: n_in %d in0 %d out %d ws %zu (need %zu); nothing launched\n", n_in, n_in > 0 ? in_sizes[0] : -1, out_size, ws_size, (size_t)WS_END); grid = -1; return; }
        int dev = 0, cus = 0, per_cu = 0;
        if (hipGetDevice(&dev) != hipSuccess || hipDeviceGetAttribute(&cus, hipDeviceAttributeMultiprocessorCount, dev) != hipSuccess) { grid = -1; return; }
        if (hipFuncSetAttribute((const void*)fwd_kernel, hipFuncAttributeMaxDynamicSharedMemorySize, LDS_BYTES) != hipSuccess) { fprintf(stderr, "kernel_launch: hipFuncSetAttribute failed\n"); grid = -1; return; }
        if (hipOccupancyMaxActiveBlocksPerMultiprocessor(&per_cu, (const void*)fwd_kernel, NWAVES * 64, LDS_BYTES) != hipSuccess || per_cu < 1) { fprintf(stderr, "kernel_launch: occupancy query says %d blocks per CU\n", per_cu); per_cu = 1; }
        (void)hipGetLastError();
        grid = cus;
    }
    if (grid < 0) return;
    Args a{};
    for (int i = 0; i < N_IN; ++i) a.in[i] = (const float*)d_in[i];
    a.out = (float*)d_out; a.ws = (unsigned char*)d_ws;
#if N_LAUNCH_MODE == 1
    a.ph_lo = 0; a.ph_hi = N_PHASES;
    (void)hipMemsetAsync((char*)d_ws + WS_CTL, 0, CTL_ZERO_BYTES, stream);
    hipLaunchKernelGGL(fwd_kernel, dim3(grid), dim3(NWAVES * 64), LDS_BYTES, stream, a);
#else
#ifndef DBG_MAXPH
#define DBG_MAXPH N_PHASES
#endif
    for (int ph = 0; ph < N_PHASES; ++ph) {
        if (ph >= DBG_MAXPH && ph != N_PHASES - 1) continue;
#ifdef DBG_SKIP_FINAL
        if (ph == N_PHASES - 1) continue;
#endif
        (void)hipMemsetAsync((char*)d_ws + WS_CTL, 0, CTL_ZERO_BYTES, stream);
        a.ph_lo = ph; a.ph_hi = ph + 1;
        hipLaunchKernelGGL(fwd_kernel, dim3(grid), dim3(NWAVES * 64), LDS_BYTES, stream, a);
    }
#endif
}
#endif
```

```cpp
#ifndef HOST_TEST
#include <hip/hip_runtime.h>
#endif
#include <cstdio>
#include <cstdint>
#include <cmath>
#include <cstddef>

#ifndef SEQ_T
#define SEQ_T 8192
#endif
#ifndef N_LAUNCH_MODE
#define N_LAUNCH_MODE 1
#endif

constexpr int T = SEQ_T, D = 2048, NL = 2, FF = 8192, PT = 6832, PTP = 6912;
constexpr int C_GQ = 0, C_GK = 512, C_GV = 1024, C_GZ = 1536, C_GB = 2048, C_GA = 2052;
constexpr int C_RQ = 2056, C_RK = 2312, C_RV = 2568, C_RG = 3080;
constexpr int C_MZ = 3592, C_MXBC = 4104, C_MDT = 5128;
constexpr int C_RW = 5136;
enum { I_X = 0, I_N1, I_WIN, I_GCONV, I_GALOG, I_GDTB, I_GNORM, I_RNORM, I_MCONV, I_MCONVB, I_MALOG, I_MDTB, I_MD, I_MNORM, I_RWMU, I_RWW0, I_RWWUP, I_RWA0, I_RWAUP,
       I_RWGUP, I_RWKK, I_RWKA, I_RWRK, I_RWLNW, I_RWLNB, I_WOUT, I_N2, I_WUP, I_WDN, I_NF, N_IN };

constexpr size_t MiB = 1u << 20;
constexpr size_t SZ_WIN = (size_t)PTP * D * 2, SZ_WOUT = (size_t)D * D * 2, SZ_WUP = (size_t)FF * D * 2, SZ_WDN = (size_t)D * FF * 2;
constexpr size_t WS_CTL = 0, CTL_BYTES = 1 * MiB;
typedef unsigned long long ss_t;
constexpr float SS_FIX = 16777216.0f, SS_INV = 1.0f / 16777216.0f;
constexpr size_t WS_SS = 64 * 1024, SS_STRIDE = (size_t)SEQ_T * 8;
constexpr size_t CTL_ZERO_BYTES = WS_SS + (2 * 2 + 1) * SS_STRIDE;
constexpr size_t WS_WIN = WS_CTL + CTL_BYTES;
constexpr size_t WS_WOUT = WS_WIN + SZ_WIN;
constexpr size_t WS_WUP = WS_WOUT + SZ_WOUT;
constexpr size_t WS_WDN = WS_WUP + SZ_WUP;
constexpr size_t WS_O = WS_WDN + SZ_WDN;
constexpr size_t WS_HB = WS_O + (size_t)T * D * 2;
constexpr size_t WS_PROJ = WS_HB + (size_t)T * D * 2;
constexpr size_t WS_HID = WS_PROJ;
constexpr size_t GDN_ = (size_t)(T / 64) * 4 * 16384;
constexpr size_t WS_GD_G = WS_PROJ + (size_t)T * PTP * 2;
constexpr size_t WS_GD_Z = WS_GD_G + GDN_ * 2;
constexpr size_t WS_GD_QT = WS_GD_Z + GDN_ * 2;
constexpr size_t WS_GD_YI = WS_GD_QT + GDN_;
constexpr size_t WS_GD_S = WS_GD_YI + GDN_;
constexpr size_t WS_GAB = WS_GD_S + GDN_ * 2;
constexpr int NCH = T / 64;
constexpr size_t WS_RET_Z = WS_GAB;
constexpr size_t WS_RET_YI = WS_RET_Z + (size_t)NCH * 4 * 8192 * 2;
constexpr size_t WS_RET_QH = WS_RET_YI + (size_t)NCH * 4 * 8192 * 2;
constexpr size_t WS_RET_S = WS_RET_QH + (size_t)NCH * 4 * 4096 * 2;
constexpr size_t M2N = (size_t)NCH * 8 * 8192;
constexpr size_t WS_M2_Z = WS_RET_S + (size_t)NCH * 4 * 8192 * 2;
constexpr size_t WS_M2_YI = WS_M2_Z + M2N * 2;
constexpr size_t WS_M2_QH = WS_M2_YI + M2N;
constexpr size_t WS_M2_S = WS_M2_QH + M2N * 2;
constexpr size_t WS_M2_DEC = WS_M2_S + M2N * 2;
constexpr size_t WS_MDT = WS_M2_DEC + (size_t)NCH * 8 * 4;
constexpr size_t RWN = (size_t)NCH * 8 * 4096;
constexpr size_t WS_RW_G = WS_MDT;
constexpr size_t WS_RW_Z = WS_RW_G + RWN * 2;
constexpr size_t WS_RW_QT = WS_RW_Z + RWN * 2;
constexpr size_t WS_RW_YI = WS_RW_QT + RWN * 2;
constexpr size_t WS_RW_E = WS_RW_YI + RWN * 2;
constexpr size_t WS_RW_GT = WS_RW_E + RWN * 2;
constexpr size_t WS_RW_S = WS_RW_GT + RWN * 2;
constexpr size_t WS_END = WS_RW_S + RWN * 2;
static_assert(WS_HID + (size_t)T * FF * 2 <= WS_END, "HID overlay");
static_assert(CTL_ZERO_BYTES <= CTL_BYTES, "CTL");
static_assert(SEQ_T != 8192 || WS_END <= 512 * MiB, "d_ws budget (512 MiB)");

typedef unsigned short bf16_t;
#ifdef HOST_TEST
#define DEV static inline
#define HD static inline
typedef float f32x4 __attribute__((vector_size(16)));
constexpr int WAVE = 1, LPC = 1;
static inline float wave_sum(float v) { return v; }
static inline float group_sum(float v) { return v; }
#else
#define DEV __device__ __forceinline__
#define HD __host__ __device__ __forceinline__
typedef float f32x4 __attribute__((ext_vector_type(4)));
constexpr int WAVE = 64, LPC = 16;
DEV float wave_sum(float v) {
#pragma unroll
    for (int o = 1; o < 64; o <<= 1) v += __shfl_xor(v, o);
    return v;
}
DEV float group_sum(float v) {
#pragma unroll
    for (int o = 1; o < 16; o <<= 1) v += __shfl_xor(v, o);
    return v;
}
#endif
constexpr int CPW = WAVE / LPC;

HD unsigned f2bf(float f) { unsigned u; __builtin_memcpy(&u, &f, 4); return (u + 0x7fffu + ((u >> 16) & 1u)) >> 16; }
HD unsigned pk2(float lo, float hi) { return f2bf(lo) | (f2bf(hi) << 16); }
HD float bf2f(bf16_t b) { unsigned u = (unsigned)b << 16; float f; __builtin_memcpy(&f, &u, 4); return f; }
#ifdef HOST_TEST
DEV float sigmoid_f(float x) { return 1.0f / (1.0f + expf(-x)); }
DEV float silu_f(float x) { return x / (1.0f + expf(-x)); }
#else
DEV float fexp(float x) { return __builtin_amdgcn_exp2f(x * 1.4426950408889634f); }
DEV float sigmoid_f(float x) { return __builtin_amdgcn_rcpf(1.0f + fexp(-x)); }
DEV float silu_f(float x) { return x * __builtin_amdgcn_rcpf(1.0f + fexp(-x)); }
#endif
DEV float softplus_f(float x) { return x > 20.f ? x : log1pf(expf(x)); }

struct Args { const float* in[N_IN]; float* out; unsigned char* ws; int ph_lo, ph_hi; };
#ifdef HOST_TEST
typedef const Args CArgs;
#else
typedef const __attribute__((address_space(4))) Args CArgs;
#endif
#define WSF(off) ((float*)(a.ws + (off)))
#define PROJROW(t) ((const bf16_t*)(a.ws + WS_PROJ) + (size_t)(t) * PTP)
#define LP(idx, per) (a.in[idx] + (size_t)l * (per))

DEV void hb_row(const float* x, bf16_t* o, ss_t* ss_out, int lane) {
    float ss = 0.f;
    for (int i = lane * 4; i < D; i += WAVE * 4) { const f32x4 v = *(const f32x4*)(x + i); ss += (v[0] * v[0] + v[1] * v[1]) + (v[2] * v[2] + v[3] * v[3]);
        unsigned* op = (unsigned*)(o + i); op[0] = pk2(v[0], v[1]); op[1] = pk2(v[2], v[3]); }
    ss = wave_sum(ss); if (lane == 0) *ss_out = (ss_t)(ss * SS_FIX);
}
DEV void final_row(const bf16_t* h, const float* w, float ss  , float* o, int lane) {
    const float r = 1.0f / sqrtf(ss * (1.0f / D) + 1e-6f);
    for (int i = lane * 4; i < D; i += WAVE * 4) { const unsigned* hp = (const unsigned*)(h + i); const unsigned h0 = hp[0], h1 = hp[1]; const f32x4 g = *(const f32x4*)(w + i); f32x4 y;
        unsigned u0 = h0 << 16, u1 = h0 & 0xffff0000u, u2 = h1 << 16, u3 = h1 & 0xffff0000u; float f0, f1, f2, f3; __builtin_memcpy(&f0, &u0, 4); __builtin_memcpy(&f1, &u1, 4); __builtin_memcpy(&f2, &u2, 4); __builtin_memcpy(&f3, &u3, 4);
        y[0] = f0 * r * g[0]; y[1] = f1 * r * g[1]; y[2] = f2 * r * g[2]; y[3] = f3 * r * g[3]; *(f32x4*)(o + i) = y; }
}
DEV void rms_row_bf16(const float* x, const float* w, bf16_t* o, int lane) {
    float ss = 0.f;
    for (int i = lane * 4; i < D; i += WAVE * 4) { const f32x4 v = *(const f32x4*)(x + i); ss += (v[0] * v[0] + v[1] * v[1]) + (v[2] * v[2] + v[3] * v[3]); }
    const float r = 1.0f / sqrtf(wave_sum(ss) * (1.0f / D) + 1e-6f);
    for (int i = lane * 4; i < D; i += WAVE * 4) { const f32x4 v = *(const f32x4*)(x + i), g = *(const f32x4*)(w + i);
        unsigned* op = (unsigned*)(o + i); op[0] = pk2(v[0] * r * g[0], v[1] * r * g[1]); op[1] = pk2(v[2] * r * g[2], v[3] * r * g[3]); }
}
DEV void rms_row_f32(const float* x, const float* w, float* o, int lane) {
    float ss = 0.f;
    for (int i = lane * 4; i < D; i += WAVE * 4) { const f32x4 v = *(const f32x4*)(x + i); ss += (v[0] * v[0] + v[1] * v[1]) + (v[2] * v[2] + v[3] * v[3]); }
    const float r = 1.0f / sqrtf(wave_sum(ss) * (1.0f / D) + 1e-6f);
    for (int i = lane * 4; i < D; i += WAVE * 4) { const f32x4 v = *(const f32x4*)(x + i), g = *(const f32x4*)(w + i);
        f32x4 y; y[0] = v[0] * r * g[0]; y[1] = v[1] * r * g[1]; y[2] = v[2] * r * g[2]; y[3] = v[3] * r * g[3]; *(f32x4*)(o + i) = y; }
}

DEV float conv4(const bf16_t* projrow_t, int col, const float* w, int c, int wstride, int t) {
    float acc = 0.f;
#pragma unroll
    for (int j = 0; j < 4; ++j) { const int tt = t - 3 + j; if (tt >= 0) acc += w[j * wstride + c] * bf2f(projrow_t[(ptrdiff_t)(j - 3) * PTP + col]); }
    return acc;
}

#ifdef HOST_TEST
static const float THETA[32] = {
#else
__device__ const float THETA[32] = {
#endif
    1.000000000e+00f, 7.429639101e-01f, 5.519954562e-01f, 4.101127088e-01f, 3.046989739e-01f, 2.263803482e-01f, 1.681924462e-01f, 1.249609292e-01f, 9.284145385e-02f, 6.897785515e-02f,
    5.124806613e-02f, 3.807546571e-02f, 2.828869782e-02f, 2.101748064e-02f, 1.561523322e-02f, 1.160155423e-02f, 8.619536646e-03f, 6.404003594e-03f, 4.757945426e-03f, 3.534980817e-03f,
    2.626363887e-03f, 1.951293205e-03f, 1.449740841e-03f, 1.077104942e-03f, 8.002503891e-04f, 5.945570301e-04f, 4.417345626e-04f, 3.281927784e-04f, 2.438354713e-04f, 1.811609109e-04f,
    1.345960627e-04f, 9.999999747e-05f };

#ifndef HOST_TEST
namespace pg8 {
#define PG8_LAS __attribute__((address_space(3)))
typedef short bf16x8 __attribute__((ext_vector_type(8)));
typedef unsigned u32x4 __attribute__((ext_vector_type(4)));
constexpr int BM = 256, BK = 64, HALF = 128, HTB = HALF * BK * 2, STAGE_BYTES = 8 * HTB, NXCD = 8, WGM = 8;
__host__ __device__ __forceinline__ int lds_byte(int r, int c) { const int st = (r >> 4) * 2 + (c >> 5), rr = r & 15, cc = c & 31, ob = rr * 64 + cc * 2; return st * 1024 + (ob ^ (((ob >> 9) & 1) << 5)); }
__host__ __device__ __forceinline__ void stage_rc(int b, int& R, int& C) { const int st = b / 1024, sb = b % 1024, swz = sb ^ (((sb >> 9) & 1) << 5); R = (st >> 1) * 16 + swz / 64; C = (st & 1) * 32 + (swz % 64) / 2; }
__host__ __device__ __forceinline__ int perm32(int rho) { const int n = rho >> 4, i = rho & 15; return 8 * (i >> 2) + 4 * n + (i & 3); }
struct Unit { int pm, pn; };
struct Gemm { const bf16_t* A; const bf16_t* Bt; };
template <int M, int N> struct StaticOrder {
    static constexpr int nM = M / BM, nN = N / BM, nwg = nM * nN; int G, c;
    __device__ void init(int G_, int c_) { G = G_; c = c_; }
    __device__ bool next(int i, Unit& u) const {
        const long L = (long)i * G + c; if (L >= nwg) return false;
        int wgid = (int)L; { const int q = nwg / NXCD, r = nwg % NXCD, xcd = wgid % NXCD, off = wgid / NXCD; wgid = (xcd < r ? xcd * (q + 1) : r * (q + 1) + (xcd - r) * q) + off; }
        const int nig = WGM * nN, gid = wgid / nig, fm = gid * WGM, gsz = (nM - fm) < WGM ? (nM - fm) : WGM;
        u.pm = fm + ((wgid % nig) % gsz); u.pn = (wgid % nig) / gsz; return true;
    }
    __device__ __forceinline__ void a_ready(const Unit&) const {}
    __device__ __forceinline__ void done(const Unit&) const {}
};
__device__ __forceinline__ unsigned cvt_pk_bf16(float lo, float hi) { unsigned r; asm volatile("v_cvt_pk_bf16_f32 %0, %1, %2" : "=v"(r) : "v"(lo), "v"(hi)); return r; }
struct EpiStoreF32 {
    static constexpr bool PERM = false, AFTER_DRAIN = false; float* O; int ldc;
    __device__ __forceinline__ void operator()(const f32x4 (&acc)[2][2][4][2], const Unit& u, int wr, int wc, int fr, int fq) const {
        const int row0 = u.pm * BM + wr * 64 + fr, col0 = u.pn * BM + wc * 32 + 4 * fq;
#pragma unroll
        for (int ai = 0; ai < 2; ++ai)
#pragma unroll
            for (int m = 0; m < 4; ++m) { float* rowp = O + (size_t)(row0 + ai * HALF + m * 16) * ldc + col0;
#pragma unroll
                for (int bj = 0; bj < 2; ++bj)
#pragma unroll
                    for (int n = 0; n < 2; ++n) *(f32x4*)(rowp + bj * HALF + n * 16) = acc[ai][bj][m][n]; }
    }
};
template <bool BASE_F32> struct EpiRes {
    static constexpr bool PERM = true, AFTER_DRAIN = false; const void* B; bf16_t* O; int ldc; ss_t* SS;
    __device__ __forceinline__ void operator()(const f32x4 (&acc)[2][2][4][2], const Unit& u, int wr, int wc, int fr, int fq) const {
        const int row0 = u.pm * BM + wr * 64 + fr, col0 = u.pn * BM + wc * 32 + 8 * fq;
#pragma unroll
        for (int ai = 0; ai < 2; ++ai)
#pragma unroll
            for (int mp = 0; mp < 4; mp += 2) {
                f32x4 b[2][2][2];
#pragma unroll
                for (int mm = 0; mm < 2; ++mm) { const size_t ro = (size_t)(row0 + ai * HALF + (mp + mm) * 16) * ldc + col0;
#pragma unroll
                    for (int bj = 0; bj < 2; ++bj) {
                        if (BASE_F32) { const float* bp = (const float*)B + ro + bj * HALF; b[mm][bj][0] = *(const f32x4*)bp; b[mm][bj][1] = *(const f32x4*)(bp + 4); }
                        else { const u32x4 w = *(const u32x4*)((const bf16_t*)B + ro + bj * HALF);
                            b[mm][bj][0] = (f32x4){__uint_as_float(w.x << 16), __uint_as_float(w.x & 0xffff0000u), __uint_as_float(w.y << 16), __uint_as_float(w.y & 0xffff0000u)};
                            b[mm][bj][1] = (f32x4){__uint_as_float(w.z << 16), __uint_as_float(w.z & 0xffff0000u), __uint_as_float(w.w << 16), __uint_as_float(w.w & 0xffff0000u)}; } } }
#pragma unroll
                for (int mm = 0; mm < 2; ++mm) { const int m = mp + mm; bf16_t* rowp = O + (size_t)(row0 + ai * HALF + m * 16) * ldc + col0; float ss = 0.f;
#pragma unroll
                    for (int bj = 0; bj < 2; ++bj) { const f32x4 h0 = b[mm][bj][0] + acc[ai][bj][m][0], h1 = b[mm][bj][1] + acc[ai][bj][m][1];
                        ss += ((h0[0] * h0[0] + h0[1] * h0[1]) + (h0[2] * h0[2] + h0[3] * h0[3])) + ((h1[0] * h1[0] + h1[1] * h1[1]) + (h1[2] * h1[2] + h1[3] * h1[3]));
                        u32x4 w; w.x = cvt_pk_bf16(h0[0], h0[1]); w.y = cvt_pk_bf16(h0[2], h0[3]); w.z = cvt_pk_bf16(h1[0], h1[1]); w.w = cvt_pk_bf16(h1[2], h1[3]); *(u32x4*)(rowp + bj * HALF) = w; }
                    ss += __shfl_xor(ss, 16); ss += __shfl_xor(ss, 32);
                    if (fq == 0) atomicAdd(SS + row0 + ai * HALF + m * 16, (ss_t)(ss * SS_FIX)); } }
    }
};
template <bool SQRELU> struct EpiBf16 {
    static constexpr bool PERM = true, AFTER_DRAIN = false; bf16_t* O; int ldc; const ss_t* SS;
    __device__ __forceinline__ void operator()(const f32x4 (&acc)[2][2][4][2], const Unit& u, int wr, int wc, int fr, int fq) const {
        const int row0 = u.pm * BM + wr * 64 + fr, col0 = u.pn * BM + wc * 32 + 8 * fq;
#pragma unroll
        for (int ai = 0; ai < 2; ++ai)
#pragma unroll
            for (int m = 0; m < 4; ++m) { bf16_t* rowp = O + (size_t)(row0 + ai * HALF + m * 16) * ldc + col0; const float rs = __builtin_amdgcn_rsqf((float)SS[row0 + ai * HALF + m * 16] * (SS_INV / D) + 1e-6f);
#pragma unroll
                for (int bj = 0; bj < 2; ++bj) { f32x4 v0 = acc[ai][bj][m][0] * rs, v1 = acc[ai][bj][m][1] * rs;
                    if (SQRELU) {
#pragma unroll
                        for (int j = 0; j < 4; ++j) { const float p0 = fmaxf(v0[j], 0.f), p1 = fmaxf(v1[j], 0.f); v0[j] = p0 * p0; v1[j] = p1 * p1; } }
                    u32x4 w; w.x = cvt_pk_bf16(v0[0], v0[1]); w.y = cvt_pk_bf16(v0[2], v0[3]); w.z = cvt_pk_bf16(v1[0], v1[1]); w.w = cvt_pk_bf16(v1[2], v1[3]);
                    *(u32x4*)(rowp + bj * HALF) = w; } }
    }
};

template <int K, class Epi, class Sched, bool ALIGN_EPI = false>
__device__ __forceinline__ void gemm_phase(PG8_LAS unsigned char* lds, const Gemm g, const Sched& S, const Epi& E, const int tid) {
    const int wid = __builtin_amdgcn_readfirstlane(tid >> 6), lane = tid & 63, wr = wid >> 2, wc = wid & 3, fr = lane & 15, fq = lane >> 4;
    constexpr int nt = K / BK;
    unsigned voffA[2], voffB[2];
#pragma unroll
    for (int i = 0; i < 2; ++i) { int R, C; stage_rc(tid * 16 + i * 8192, R, C); const int Rb = Epi::PERM ? ((R & ~31) + perm32(R & 31)) : R;
        voffA[i] = (unsigned)(R * K + C) * 2u; voffB[i] = (unsigned)(Rb * K + C) * 2u; }
    const size_t kstep = (size_t)(BK * 2);
    const size_t hstep = (size_t)HALF * K * 2;
    const size_t tstep = 2 * hstep;
    const unsigned ldsw = (unsigned)wid * 1024u;
    const int aoff = lds_byte(wr * 64 + fr, fq * 8), boff = lds_byte(wc * 32 + fr, fq * 8);
#define PG8_SA(b, h) (((b) * 2 + (h)) * HTB)
#define PG8_SB(b, h) ((4 + (b) * 2 + (h)) * HTB)
#define PG8_STAGE(bufoff, gbase, voff) do { _Pragma("unroll") for (int _i = 0; _i < 2; ++_i) \
        __builtin_amdgcn_global_load_lds((const unsigned*)((const char*)(gbase) + (voff)[_i]), (PG8_LAS unsigned*)(lds + (bufoff) + ldsw + _i * 8192), 16, 0, 0); } while (0)
#define PG8_LDA(dst, b, h) do { _Pragma("unroll") for (int m = 0; m < 4; ++m) _Pragma("unroll") for (int k = 0; k < 2; ++k) dst[m][k] = *(const PG8_LAS bf16x8*)(lds + PG8_SA(b, h) + aoff + m * 2048 + k * 1024); } while (0)
#define PG8_LDB(dst, b, h) do { _Pragma("unroll") for (int n = 0; n < 2; ++n) _Pragma("unroll") for (int k = 0; k < 2; ++k) dst[n][k] = *(const PG8_LAS bf16x8*)(lds + PG8_SB(b, h) + boff + n * 2048 + k * 1024); } while (0)
#define PG8_MMA(ai, bj, At, Bt) do { __builtin_amdgcn_s_setprio(1); _Pragma("unroll") for (int m = 0; m < 4; ++m) _Pragma("unroll") for (int n = 0; n < 2; ++n) _Pragma("unroll") for (int k = 0; k < 2; ++k) \
        acc[ai][bj][m][n] = __builtin_amdgcn_mfma_f32_16x16x32_bf16(Bt[n][k], At[m][k], acc[ai][bj][m][n], 0, 0, 0); __builtin_amdgcn_s_setprio(0); } while (0)
#define PG8_WAIT_V(n) asm volatile("s_waitcnt vmcnt(" #n ")" ::: "memory")
#define PG8_WAIT_L(n) asm volatile("s_waitcnt lgkmcnt(" #n ")" ::: "memory")
#define PG8_BAR __builtin_amdgcn_s_barrier()
#define PG8_SCHED __builtin_amdgcn_sched_barrier(0)
    Unit cur, nxt; int ui = 0;
    if (!S.next(0, cur)) return;
    f32x4 acc[2][2][4][2];
#pragma unroll
    for (int a = 0; a < 2; ++a)
#pragma unroll
        for (int b = 0; b < 2; ++b)
#pragma unroll
            for (int m = 0; m < 4; ++m)
#pragma unroll
                for (int n = 0; n < 2; ++n) acc[a][b][m][n] = (f32x4){0.f, 0.f, 0.f, 0.f};
    bf16x8 At[4][2], B0[2][2], B1[2][2];
    const char* cA = (const char*)g.A + (size_t)cur.pm * tstep; const char* cB = (const char*)g.Bt + (size_t)cur.pn * tstep;
    S.a_ready(cur);
    PG8_STAGE(PG8_SB(0, 0), cB, voffB); PG8_STAGE(PG8_SB(0, 1), cB + hstep, voffB); PG8_STAGE(PG8_SA(0, 0), cA, voffA); PG8_STAGE(PG8_SA(0, 1), cA + hstep, voffA);
    if (wr == 1) PG8_BAR;
    PG8_WAIT_V(2); PG8_BAR;
    PG8_STAGE(PG8_SB(1, 0), cB + kstep, voffB); PG8_STAGE(PG8_SA(1, 0), cA + kstep, voffA); PG8_STAGE(PG8_SB(1, 1), cB + hstep + kstep, voffB);
    PG8_WAIT_V(6); PG8_BAR;
    for (;;) {
        const bool has_next = S.next(ui + 1, nxt);
        const char* nA = has_next ? (const char*)g.A + (size_t)nxt.pm * tstep : cA; const char* nB = has_next ? (const char*)g.Bt + (size_t)nxt.pn * tstep : cB;
        for (int t = 0; t < nt; t += 2) {
            const bool last = (t == nt - 2);
            const char* a1 = cA + (size_t)(t + 1) * kstep;
            const char* a2 = last ? nA : cA + (size_t)(t + 2) * kstep; const char* b2 = last ? nB : cB + (size_t)(t + 2) * kstep;
            const char* a3 = a2 + kstep; const char* b3 = b2 + kstep;
            if (last && has_next) S.a_ready(nxt);
            PG8_LDB(B0, 0, 0); PG8_LDB(B1, 0, 1); PG8_SCHED; PG8_LDA(At, 0, 0); PG8_STAGE(PG8_SA(1, 1), a1 + hstep, voffA);
            PG8_WAIT_V(8); PG8_WAIT_L(0); PG8_BAR; PG8_MMA(0, 0, At, B0); PG8_MMA(0, 1, At, B1); PG8_BAR; PG8_SCHED;
            PG8_LDA(At, 0, 1); PG8_STAGE(PG8_SB(0, 0), b2, voffB); PG8_STAGE(PG8_SB(0, 1), b2 + hstep, voffB); PG8_STAGE(PG8_SA(0, 0), a2, voffA);
            PG8_WAIT_V(8); PG8_WAIT_L(0); PG8_BAR; PG8_MMA(1, 0, At, B0); PG8_MMA(1, 1, At, B1); PG8_BAR; PG8_SCHED;
            PG8_LDB(B0, 1, 0); PG8_LDB(B1, 1, 1); PG8_SCHED; PG8_LDA(At, 1, 0); PG8_STAGE(PG8_SA(0, 1), a2 + hstep, voffA);
            PG8_WAIT_V(8); PG8_WAIT_L(0); PG8_BAR; PG8_MMA(0, 0, At, B0); PG8_MMA(0, 1, At, B1); PG8_BAR; PG8_SCHED;
            PG8_LDA(At, 1, 1); PG8_STAGE(PG8_SB(1, 0), b3, voffB); PG8_STAGE(PG8_SB(1, 1), b3 + hstep, voffB); PG8_STAGE(PG8_SA(1, 0), a3, voffA);
            PG8_WAIT_V(8); PG8_WAIT_L(0); PG8_BAR; PG8_MMA(1, 0, At, B0); PG8_MMA(1, 1, At, B1); PG8_BAR; PG8_SCHED;
        }
        if constexpr (ALIGN_EPI) { if (wr == 0) PG8_BAR; }
        E(acc, cur, wr, wc, fr, fq); S.done(cur);
        if (!has_next) break;
#pragma unroll
        for (int a = 0; a < 2; ++a)
#pragma unroll
            for (int b = 0; b < 2; ++b)
#pragma unroll
                for (int m = 0; m < 4; ++m)
#pragma unroll
                    for (int n = 0; n < 2; ++n) acc[a][b][m][n] = (f32x4){0.f, 0.f, 0.f, 0.f};
        cur = nxt; cA = nA; cB = nB; ++ui;
        if constexpr (ALIGN_EPI) { if (wr == 1) PG8_BAR; }
    }
    PG8_WAIT_V(0);
    if constexpr (!ALIGN_EPI) { if (wr == 0) PG8_BAR; }
    PG8_BAR;
#undef PG8_SA
#undef PG8_SB
#undef PG8_STAGE
#undef PG8_LDA
#undef PG8_LDB
#undef PG8_MMA
#undef PG8_WAIT_V
#undef PG8_WAIT_L
#undef PG8_BAR
#undef PG8_SCHED
}
}

#define LAS __attribute__((address_space(3)))
#define GAS __attribute__((address_space(1)))
typedef unsigned v4u __attribute__((ext_vector_type(4)));
constexpr int NWAVES = 8, LDS_BYTES = 163840, MISC_OFF = LDS_BYTES - 512;
#define LDS_WAIT() asm volatile("s_waitcnt lgkmcnt(0)" ::: "memory")

__device__ __forceinline__ void transpose_item(const float* W, int K, int N, int Npad, bf16_t* WT, LAS float* scr, int item, int lane, const float* kscale = nullptr) {
    const int nblk = Npad / 32, kb = item / nblk, nb = item % nblk, k0 = 64 * kb, n0 = 32 * nb;
    const int n = n0 + (lane & 31); const bool ok = n < N;
    float v[32];
    const float* src = W + (size_t)(k0 + (lane >> 5)) * N + n;
#pragma unroll
    for (int i = 0; i < 32; ++i) v[i] = ok ? src[(size_t)(2 * i) * N] : 0.f;
    if (kscale) {
#pragma unroll
        for (int i = 0; i < 32; ++i) v[i] *= kscale[k0 + 2 * i + (lane >> 5)]; }
#pragma unroll
    for (int i = 0; i < 32; ++i) scr[(2 * i + (lane >> 5)) * 33 + (lane & 31)] = v[i];
    LDS_WAIT(); asm volatile("" ::: "memory");
    const int c = lane & 7;
#pragma unroll
    for (int j = 0; j < 4; ++j) { const int nn = (lane >> 3) + 8 * j; const LAS float* s = scr + (8 * c) * 33 + nn;
        v4u o; o.x = pk2(s[0 * 33], s[1 * 33]); o.y = pk2(s[2 * 33], s[3 * 33]); o.z = pk2(s[4 * 33], s[5 * 33]); o.w = pk2(s[6 * 33], s[7 * 33]);
        *(GAS v4u*)(WT + (size_t)(n0 + nn) * K + k0 + 8 * c) = o; }
    LDS_WAIT(); asm volatile("" ::: "memory");
}


typedef short bf16x8 __attribute__((ext_vector_type(8)));
typedef short s16x4 __attribute__((ext_vector_type(4)));
typedef unsigned u32x2 __attribute__((ext_vector_type(2)));
__device__ __forceinline__ s16x4 tr16(const LAS bf16_t* p) { return __builtin_bit_cast(s16x4, __builtin_amdgcn_ds_read_tr16_b64_v4i16((LAS s16x4*)p)); }
__device__ __forceinline__ bf16x8 frag_row(const LAS bf16_t* img, int ld, int nc0, int k0, int lane) { return *(const LAS bf16x8*)(img + (nc0 + (lane & 15)) * ld + k0 + 8 * (lane >> 4)); }
__device__ __forceinline__ bf16x8 frag_tr(const LAS bf16_t* img, int ld, int nc0, int k0, int lane) {
    const int g = lane >> 4, q = (lane & 15) >> 2, p = lane & 3;
    const LAS bf16_t* ad = img + (k0 + 8 * g + q) * ld + nc0 + 4 * p;
    const s16x4 lo = tr16(ad), hi = tr16(ad + 4 * ld);
    return (bf16x8){lo[0], lo[1], lo[2], lo[3], hi[0], hi[1], hi[2], hi[3]};
}
__device__ __forceinline__ bf16x8 frag_row_g(const bf16_t* img, int ld, int nc0, int k0, int lane) { return *(const bf16x8*)(img + (size_t)(nc0 + (lane & 15)) * ld + k0 + 8 * (lane >> 4)); }
__device__ __forceinline__ bf16x8 frag_fo(const bf16_t* img, int KS, int tile, int ks, int lane) { return *(const bf16x8*)(img + ((size_t)(tile * KS + ks) * 64 + lane) * 8); }
__device__ __forceinline__ int fo_st(int tile, int KS, int k0, int g, int r) { const int k = k0 + 4 * g; return ((tile * KS + (k >> 5)) * 64 + ((k >> 3) & 3) * 16 + r) * 8 + (k & 7); }
__device__ __forceinline__ int co_off(int tj, int NI, int ti, int lane) { return ((tj * NI + ti) * 64 + lane) * 4; }
__device__ __forceinline__ f32x4 mfma16(bf16x8 a, bf16x8 b, f32x4 c) { return __builtin_amdgcn_mfma_f32_16x16x32_bf16(a, b, c, 0, 0, 0); }
__device__ __forceinline__ u32x2 pack4(f32x4 v) { u32x2 w; w.x = pk2(v[0], v[1]); w.y = pk2(v[2], v[3]); return w; }
__device__ __forceinline__ f32x4 unpack4(u32x2 w) { f32x4 v; v[0] = __uint_as_float(w.x << 16); v[1] = __uint_as_float(w.x & 0xffff0000u); v[2] = __uint_as_float(w.y << 16); v[3] = __uint_as_float(w.y & 0xffff0000u); return v; }
#define WG_SYNC() do { asm volatile("s_waitcnt lgkmcnt(0)" ::: "memory"); __builtin_amdgcn_s_barrier(); asm volatile("" ::: "memory"); } while (0)

__device__ __forceinline__ void ret_stage1(CArgs& a, int n, int h, LAS unsigned char* lds, int tid) {
    const int lane = tid & 63, w = __builtin_amdgcn_readfirstlane(tid >> 6), r = lane & 15, g = lane >> 4;
    constexpr int LD = 72, LDV = 136;
    LAS bf16_t* Qi = (LAS bf16_t*)lds; LAS bf16_t* Ki = Qi + 64 * LD; LAS bf16_t* Kdi = Ki + 64 * LD; LAS bf16_t* Vi = Kdi + 64 * LD; LAS bf16_t* Si = Vi + 64 * LDV;
    const int tk = n * 4 + h; const float lg2 = log2f(1.0f - exp2f(-5.0f - (float)h));
    bf16_t* QH = (bf16_t*)(a.ws + WS_RET_QH) + (size_t)tk * 4096;
    unsigned rqq[4], rkk[4]; v4u rvv[2];
#pragma unroll
    for (int ii = 0; ii < 4; ++ii) { const int idx = tid + 512 * ii, c = idx >> 5, i = idx & 31; const bf16_t* pr = PROJROW(n * 64 + c); rqq[ii] = *(const unsigned*)(pr + C_RQ + 64 * h + 2 * i); rkk[ii] = *(const unsigned*)(pr + C_RK + 64 * h + 2 * i); }
#pragma unroll
    for (int ii = 0; ii < 2; ++ii) { const int idx = tid + 512 * ii, c = idx >> 4, ch = idx & 15; rvv[ii] = *(const v4u*)(PROJROW(n * 64 + c) + C_RV + 128 * h + 8 * ch); }
#pragma unroll
    for (int ii = 0; ii < 4; ++ii) { const int idx = tid + 512 * ii;
        const int c = idx >> 5, i = idx & 31, t = n * 64 + c; float sn, cs; sincosf((float)t * THETA[i], &sn, &cs);
        const unsigned qq = rqq[ii], kk = rkk[ii];
        const float q0 = __uint_as_float(qq << 16), q1 = __uint_as_float(qq & 0xffff0000u), k0 = __uint_as_float(kk << 16), k1 = __uint_as_float(kk & 0xffff0000u);
        const float rq0 = q0 * cs - q1 * sn, rq1 = q1 * cs + q0 * sn, rk0 = (k0 * cs - k1 * sn) * 0.125f, rk1 = (k1 * cs + k0 * sn) * 0.125f;
        const float dk = exp2f(lg2 * (float)(63 - c)), dq = exp2f(lg2 * (float)(c + 1));
        *(LAS unsigned*)(Qi + c * LD + 2 * i) = pk2(rq0, rq1); *(LAS unsigned*)(Ki + c * LD + 2 * i) = pk2(rk0, rk1); *(LAS unsigned*)(Kdi + c * LD + 2 * i) = pk2(rk0 * dk, rk1 * dk);
        { const int d = 2 * i; *(unsigned*)(QH + (((c >> 4) * 2 + (d >> 5)) * 64 + ((d >> 3) & 3) * 16 + (c & 15)) * 8 + (d & 7)) = pk2(rq0 * dq, rq1 * dq); }
    }
#pragma unroll
    for (int ii = 0; ii < 2; ++ii) { const int idx = tid + 512 * ii, c = idx >> 4, ch = idx & 15; *(LAS v4u*)(Vi + c * LDV + 8 * ch) = rvv[ii]; }
    WG_SYNC();
#pragma unroll
    for (int tt = 0; tt < 2; ++tt) { const int tile = 2 * w + tt, im = tile >> 2, jc = tile & 3; f32x4 acc = {0.f, 0.f, 0.f, 0.f};
        if (jc >= im) {
#pragma unroll
            for (int k0 = 0; k0 < 64; k0 += 32) acc = mfma16(frag_row(Ki, LD, 16 * im, k0, lane), frag_row(Qi, LD, 16 * jc, k0, lane), acc);
#pragma unroll
            for (int e = 0; e < 4; ++e) { const int i = 16 * im + 4 * g + e, j = 16 * jc + r; acc[e] = j >= i ? acc[e] * exp2f(lg2 * (float)(j - i)) : 0.f; } }
        *(LAS u32x2*)(Si + (16 * jc + r) * LD + 16 * im + 4 * g) = pack4(acc); }
    WG_SYNC();
    bf16_t* YI = (bf16_t*)(a.ws + WS_RET_YI) + (size_t)tk * 8192; bf16_t* Z = (bf16_t*)(a.ws + WS_RET_Z) + (size_t)tk * 8192;
#pragma unroll
    for (int tt = 0; tt < 4; ++tt) { const int jc = w & 3, ie = 4 * (w >> 2) + tt; f32x4 acc = {0.f, 0.f, 0.f, 0.f};
#pragma unroll
        for (int k0 = 0; k0 < 64; k0 += 32) acc = mfma16(frag_tr(Vi, LDV, 16 * ie, k0, lane), frag_row(Si, LD, 16 * jc, k0, lane), acc);
        *(u32x2*)(YI + co_off(jc, 8, ie, lane)) = pack4(acc); }
#pragma unroll
    for (int tt = 0; tt < 4; ++tt) { const int id = w & 3, je = 4 * (w >> 2) + tt; f32x4 acc = {0.f, 0.f, 0.f, 0.f};
#pragma unroll
        for (int k0 = 0; k0 < 64; k0 += 32) acc = mfma16(frag_tr(Kdi, LD, 16 * id, k0, lane), frag_tr(Vi, LDV, 16 * je, k0, lane), acc);
        *(u32x2*)(Z + fo_st(je, 2, 16 * id, g, r)) = pack4(acc); }
    WG_SYNC();
}
template <class DEC> __device__ __forceinline__ void ew_stage2(const bf16_t* Z, bf16_t* S, size_t step_stride, const DEC& dec, LAS unsigned char* lds, int tid) {
    LAS bf16_t* ZL = (LAS bf16_t*)lds; LAS bf16_t* SL = ZL + 8 * 512;
    const int sq = tid >> 6, ev = (tid & 63) * 8;
    v4u zin[NCH / 8];
#pragma unroll
    for (int gq = 0; gq < NCH / 8; ++gq) zin[gq] = *(const v4u*)(Z + (size_t)(8 * gq + sq) * step_stride + ev);
    float st = 0.f;
#pragma unroll
    for (int gq = 0; gq < NCH / 8; ++gq) {
        *(LAS v4u*)(ZL + sq * 512 + ev) = zin[gq];
        WG_SYNC();
#pragma unroll
        for (int j = 0; j < 8; ++j) { const float z = bf2f(ZL[j * 512 + tid]); SL[j * 512 + tid] = (bf16_t)f2bf(st); st = dec(8 * gq + j) * st + z; }
        WG_SYNC();
        *(v4u*)(S + (size_t)(8 * gq + sq) * step_stride + ev) = *(const LAS v4u*)(SL + sq * 512 + ev);
    }
    WG_SYNC();
}
struct DecConst { float d; __device__ __forceinline__ float operator()(int) const { return d; } };
struct DecTable { const float* p; int stride; __device__ __forceinline__ float operator()(int n) const { return p[n * stride]; } };
__device__ __forceinline__ void ret_stage2(CArgs& a, int b, LAS unsigned char* lds, int tid) {
    const int h = b >> 4, rem0 = (b & 15) * 512; const DecConst dc{exp2f(64.0f * log2f(1.0f - exp2f(-5.0f - (float)h)))};
    ew_stage2((const bf16_t*)(a.ws + WS_RET_Z) + (size_t)h * 8192 + rem0, (bf16_t*)(a.ws + WS_RET_S) + (size_t)h * 8192 + rem0, (size_t)4 * 8192, dc, lds, tid);
}
__device__ __forceinline__ void ret_stage3(CArgs& a, int l, int n, int h, LAS unsigned char* lds, int tid) {
    const int lane = tid & 63, w = __builtin_amdgcn_readfirstlane(tid >> 6), r = lane & 15, g = lane >> 4, jc = w & 3, wh = w >> 2;
    const int tk = n * 4 + h; const int c = 16 * jc + r, t = n * 64 + c;
    const bf16_t* S = (const bf16_t*)(a.ws + WS_RET_S) + (size_t)tk * 8192; const bf16_t* QH = (const bf16_t*)(a.ws + WS_RET_QH) + (size_t)tk * 4096; const bf16_t* YI = (const bf16_t*)(a.ws + WS_RET_YI) + (size_t)tk * 8192;
    LAS float* xs = (LAS float*)lds;
    f32x4 acc[4];
#pragma unroll
    for (int tt = 0; tt < 4; ++tt) { const int ie = 4 * wh + tt; acc[tt] = unpack4(*(const u32x2*)(YI + co_off(jc, 8, ie, lane)));
#pragma unroll
        for (int k = 0; k < 2; ++k) acc[tt] = mfma16(frag_fo(S, 2, ie, k, lane), frag_fo(QH, 2, jc, k, lane), acc[tt]); }
    float s1 = 0.f;
#pragma unroll
    for (int tt = 0; tt < 4; ++tt) s1 += (acc[tt][0] + acc[tt][1]) + (acc[tt][2] + acc[tt][3]);
    s1 += __shfl_xor(s1, 16); s1 += __shfl_xor(s1, 32);
    if (g == 0) xs[w * 16 + r] = s1;
    WG_SYNC();
    const float mu = (s1 + xs[(w ^ 4) * 16 + r]) * (1.0f / 128.0f); float s2 = 0.f;
#pragma unroll
    for (int tt = 0; tt < 4; ++tt)
#pragma unroll
        for (int e = 0; e < 4; ++e) { acc[tt][e] -= mu; s2 += acc[tt][e] * acc[tt][e]; }
    s2 += __shfl_xor(s2, 16); s2 += __shfl_xor(s2, 32);
    if (g == 0) xs[128 + w * 16 + r] = s2;
    WG_SYNC();
    const float rs = 1.0f / sqrtf((s2 + xs[128 + (w ^ 4) * 16 + r]) * (1.0f / 128.0f) + 1e-6f);
    const float* nw = LP(I_RNORM, 512) + h * 128; const bf16_t* pr = PROJROW(t) + C_RG + h * 128; bf16_t* O = (bf16_t*)(a.ws + WS_O) + (size_t)t * D + 512 + h * 128;
#pragma unroll
    for (int tt = 0; tt < 4; ++tt) { const int e0 = 16 * (4 * wh + tt) + 4 * g; const f32x4 gt = unpack4(*(const u32x2*)(pr + e0)); const f32x4 wv = *(const f32x4*)(nw + e0); f32x4 y;
#pragma unroll
        for (int e = 0; e < 4; ++e) y[e] = acc[tt][e] * rs * wv[e] * silu_f(gt[e]);
        *(u32x2*)(O + e0) = pack4(y); }
    WG_SYNC();
}

constexpr int RW_LD = 72;
constexpr int RWO_V = 0, RWO_IMG = 9216  , RWO_XI = 36864  , RWO_UI = 55296, RWO_CUMC = 64512, RWO_WT = 65536  , RWO_AM = 65536, RWO_TRI = 82944,
              RWO_RHST = 110592, RWO_AI = 143360, RWO_DI = 152576;
constexpr int RWO_LW = 9216, RWO_LIN = 82944;
__device__ __forceinline__ float ftanh(float x) { return 1.0f - 2.0f * __builtin_amdgcn_rcpf(1.0f + fexp(2.0f * x)); }
__device__ __forceinline__ float fsoftplus(float x) { return x > 20.f ? x : __builtin_amdgcn_logf(1.0f + fexp(x)) * 0.6931471805599453f; }
__device__ __forceinline__ void rw_stage1(CArgs& a, int l, int n, int h, LAS unsigned char* lds, int tid, const int stop = 99) {
    const int w = __builtin_amdgcn_readfirstlane(tid >> 6), tk = n * 8 + h;
    int lane, r, g, c, kg, t;
#define RW_IDX() do { int tl_ = tid; asm volatile("" : "+v"(tl_)); lane = tl_ & 63; r = lane & 15; g = lane >> 4; c = tl_ >> 3; kg = tl_ & 7; t = n * 64 + c; } while (0)
    RW_IDX();
    LAS bf16_t* Vi = (LAS bf16_t*)(lds + RWO_V);
    LAS bf16_t* RHi = (LAS bf16_t*)(lds + RWO_IMG); LAS bf16_t* BTi = RHi + 64 * RW_LD; LAS bf16_t* KTi = BTi + 64 * RW_LD; LAS bf16_t* KHi = KTi + 64 * RW_LD; LAS bf16_t* BMi = KHi + 64 * RW_LD; LAS bf16_t* KMi = BMi + 64 * RW_LD;
    LAS bf16_t* XI = (LAS bf16_t*)(lds + RWO_XI);
    LAS bf16_t* UI = (LAS bf16_t*)(lds + RWO_UI);
    LAS float* CUMC = (LAS float*)(lds + RWO_CUMC); LAS float* WT = (LAS float*)(lds + RWO_WT); LAS float* AM = (LAS float*)(lds + RWO_AM);
    LAS bf16_t* BMI = (LAS bf16_t*)(lds + RWO_TRI); LAS bf16_t* PBI = BMI + 64 * RW_LD; LAS bf16_t* PKI = PBI + 64 * RW_LD;
    LAS float* RHST = (LAS float*)(lds + RWO_RHST);
    LAS bf16_t* AI = (LAS bf16_t*)(lds + RWO_AI);
    LAS bf16_t* DI = (LAS bf16_t*)(lds + RWO_DI);
    LAS float* LW = (LAS float*)(lds + RWO_LW); LAS float* LA = LW + 4096; LAS float* LG = LA + 4096;
    LAS bf16_t* WLi = (LAS bf16_t*)(lds + RWO_LIN); LAS bf16_t* ALi = WLi + 64 * 40; LAS bf16_t* GLi = ALi + 64 * 40; LAS bf16_t* WUPi = GLi + 64 * 104; LAS bf16_t* AUPi = WUPi + 32 * RW_LD; LAS bf16_t* GUPi = AUPi + 32 * RW_LD;
    const float* mu = LP(I_RWMU, 1696); const bf16_t* p1 = PROJROW(t) + C_RW; const bf16_t* p0 = p1 - PTP; bool hp = t > 0;
    float vv[8];
    { const v4u cu = *(const v4u*)(p1 + 1024 + 64 * h + 8 * kg); v4u pv = {0u, 0u, 0u, 0u};
      const float* m = mu + 1024 + 64 * h + 8 * kg; const f32x4 m0 = *(const f32x4*)m, m1 = *(const f32x4*)(m + 4);
      u32x2 cw = *(const u32x2*)(p1 + 1536 + 4 * kg), ca = *(const u32x2*)(p1 + 1568 + 4 * kg), pw = {0u, 0u}, pa = {0u, 0u};
      u32x2 cg[3], pg[3] = {{0u, 0u}, {0u, 0u}, {0u, 0u}}; f32x4 mg[3];
#pragma unroll
      for (int q = 0; q < 3; ++q) { cg[q] = *(const u32x2*)(p1 + 1600 + 12 * kg + 4 * q); mg[q] = *(const f32x4*)(mu + 1600 + 12 * kg + 4 * q); }
      if (hp) { pv = *(const v4u*)(p0 + 1024 + 64 * h + 8 * kg); pw = *(const u32x2*)(p0 + 1536 + 4 * kg); pa = *(const u32x2*)(p0 + 1568 + 4 * kg);
#pragma unroll
          for (int q = 0; q < 3; ++q) pg[q] = *(const u32x2*)(p0 + 1600 + 12 * kg + 4 * q); }
      const f32x4 mw = *(const f32x4*)(mu + 1536 + 4 * kg), ma = *(const f32x4*)(mu + 1568 + 4 * kg);
      const int j = tid >> 4, k4 = (tid & 15) * 4;
      const f32x4 lwv = *(const f32x4*)(LP(I_RWWUP, 32 * 512) + j * 512 + 64 * h + k4), lav = *(const f32x4*)(LP(I_RWAUP, 32 * 512) + j * 512 + 64 * h + k4); f32x4 lgv[3];
#pragma unroll
      for (int q = 0; q < 3; ++q) lgv[q] = *(const f32x4*)(LP(I_RWGUP, 96 * 512) + (32 * q + j) * 512 + 64 * h + k4);
      asm volatile("" ::: "memory");
      { v4u o;
#pragma unroll
        for (int u = 0; u < 4; ++u) { const unsigned cww = cu[u], pww = pv[u]; const float c0 = __uint_as_float(cww << 16), c1 = __uint_as_float(cww & 0xffff0000u), q0 = __uint_as_float(pww << 16), q1 = __uint_as_float(pww & 0xffff0000u);
            const float mA = u < 2 ? m0[2 * u] : m1[2 * u - 4], mB = u < 2 ? m0[2 * u + 1] : m1[2 * u - 3];
            vv[2 * u] = c0 + (q0 - c0) * mA; vv[2 * u + 1] = c1 + (q1 - c1) * mB; o[u] = pk2(vv[2 * u], vv[2 * u + 1]); }
        *(LAS v4u*)(Vi + c * RW_LD + 8 * kg) = o; }
      { const f32x4 cv = unpack4(cw), pvv = unpack4(pw); f32x4 x;
#pragma unroll
        for (int u = 0; u < 4; ++u) x[u] = ftanh(cv[u] + (pvv[u] - cv[u]) * mw[u]);
        *(LAS u32x2*)(WLi + c * 40 + 4 * kg) = pack4(x); }
      { const f32x4 cv = unpack4(ca), pvv = unpack4(pa); f32x4 x;
#pragma unroll
        for (int u = 0; u < 4; ++u) x[u] = cv[u] + (pvv[u] - cv[u]) * ma[u];
        *(LAS u32x2*)(ALi + c * 40 + 4 * kg) = pack4(x); }
#pragma unroll
      for (int q = 0; q < 3; ++q) { const f32x4 cv = unpack4(cg[q]), pvv = unpack4(pg[q]); f32x4 x;
#pragma unroll
          for (int u = 0; u < 4; ++u) x[u] = sigmoid_f(cv[u] + (pvv[u] - cv[u]) * mg[q][u]);
          *(LAS u32x2*)(GLi + c * 104 + 12 * kg + 4 * q) = pack4(x); }
      *(LAS u32x2*)(WUPi + j * RW_LD + k4) = pack4(lwv); *(LAS u32x2*)(AUPi + j * RW_LD + k4) = pack4(lav);
#pragma unroll
      for (int q = 0; q < 3; ++q) *(LAS u32x2*)(GUPi + (32 * q + j) * RW_LD + k4) = pack4(lgv[q]); }
    WG_SYNC();
    if (stop <= 0) return;
    RW_IDX();
#pragma unroll
    for (int tt = 0; tt < 2; ++tt) { const int tile = 2 * w + tt, ik = tile >> 2, jc = tile & 3;
        f32x4 aw = {0.f, 0.f, 0.f, 0.f}, aa = aw, ag = aw;
        aw = mfma16(frag_tr(WUPi, RW_LD, 16 * ik, 0, lane), frag_row(WLi, 40, 16 * jc, 0, lane), aw);
        aa = mfma16(frag_tr(AUPi, RW_LD, 16 * ik, 0, lane), frag_row(ALi, 40, 16 * jc, 0, lane), aa);
#pragma unroll
        for (int k0 = 0; k0 < 96; k0 += 32) ag = mfma16(frag_tr(GUPi, RW_LD, 16 * ik, k0, lane), frag_row(GLi, 104, 16 * jc, k0, lane), ag);
        const int o = (16 * jc + r) * 64 + 16 * ik + 4 * g; *(LAS f32x4*)(LW + o) = aw; *(LAS f32x4*)(LA + o) = aa; *(LAS f32x4*)(LG + o) = ag; }
    WG_SYNC();
    if (stop <= 1) return;
    RW_IDX();
    p1 = PROJROW(t) + C_RW; p0 = p1 - PTP; hp = t > 0;
    float rr[8], kk[8], bb[8], kt[8], lwd[8], cum[8];
    { const int ch0 = 64 * h + 8 * kg; float ss = 0.f, rk = 0.f; float gt[8];
      const v4u cr = *(const v4u*)(p1 + ch0), ck = *(const v4u*)(p1 + 512 + ch0); v4u qr = {0u, 0u, 0u, 0u}, qk = qr; if (hp) { qr = *(const v4u*)(p0 + ch0); qk = *(const v4u*)(p0 + 512 + ch0); }
      float pw0[8], pa0[8], pkk[8], pka[8], prk[8], pmr[8], pmk[8];
#pragma unroll
      for (int q = 0; q < 2; ++q) { const f32x4 x0 = *(const f32x4*)(LP(I_RWW0, 512) + ch0 + 4 * q), x1 = *(const f32x4*)(LP(I_RWA0, 512) + ch0 + 4 * q), x2 = *(const f32x4*)(LP(I_RWKK, 512) + ch0 + 4 * q), x3 = *(const f32x4*)(LP(I_RWKA, 512) + ch0 + 4 * q),
                                                 x4 = *(const f32x4*)(LP(I_RWRK, 512) + ch0 + 4 * q), x5 = *(const f32x4*)(mu + ch0 + 4 * q), x6 = *(const f32x4*)(mu + 512 + ch0 + 4 * q);
#pragma unroll
          for (int e = 0; e < 4; ++e) { pw0[4 * q + e] = x0[e]; pa0[4 * q + e] = x1[e]; pkk[4 * q + e] = x2[e]; pka[4 * q + e] = x3[e]; prk[4 * q + e] = x4[e]; pmr[4 * q + e] = x5[e]; pmk[4 * q + e] = x6[e]; } }
#pragma unroll
      for (int u = 0; u < 8; ++u) { const unsigned crw = cr[u >> 1], ckw = ck[u >> 1], qrw = qr[u >> 1], qkw = qk[u >> 1];
          const float curR = (u & 1) ? __uint_as_float(crw & 0xffff0000u) : __uint_as_float(crw << 16), curK = (u & 1) ? __uint_as_float(ckw & 0xffff0000u) : __uint_as_float(ckw << 16);
          const float prvR = (u & 1) ? __uint_as_float(qrw & 0xffff0000u) : __uint_as_float(qrw << 16), prvK = (u & 1) ? __uint_as_float(qkw & 0xffff0000u) : __uint_as_float(qkw << 16);
          const float rv = curR + (prvR - curR) * pmr[u], kr = curK + (prvK - curK) * pmk[u];
          const float lw = LW[c * 64 + 8 * kg + u], la = LA[c * 64 + 8 * kg + u]; gt[u] = LG[c * 64 + 8 * kg + u];
          const float wraw = -fsoftplus(-(pw0[u] + lw)) - 0.5f; lwd[u] = -fexp(wraw);
          const float av = sigmoid_f(pa0[u] + la); const float kkr = kr * pkk[u]; kt[u] = kr * (1.0f + (av - 1.0f) * pka[u]);
          rr[u] = rv; kk[u] = kkr; bb[u] = av; ss += kkr * kkr; rk += rv * kt[u] * prk[u]; }
      ss += __shfl_xor(ss, 1); ss += __shfl_xor(ss, 2); ss += __shfl_xor(ss, 4); rk += __shfl_xor(rk, 1); rk += __shfl_xor(rk, 2); rk += __shfl_xor(rk, 4);
      const float inv = __builtin_amdgcn_rsqf(ss + 1e-6f);
#pragma unroll
      for (int u = 0; u < 8; ++u) { kk[u] *= inv; bb[u] *= kk[u]; }
#pragma unroll
      for (int u = 0; u < 8; ++u) { float x = lwd[u];
#pragma unroll
          for (int o = 8; o < 64; o <<= 1) { const float up = __shfl_up(x, o); if (lane >= o) x += up; }
          cum[u] = x; }
      if (lane >= 56) { *(LAS f32x4*)(WT + w * 64 + 8 * kg) = (f32x4){cum[0], cum[1], cum[2], cum[3]}; *(LAS f32x4*)(WT + w * 64 + 8 * kg + 4) = (f32x4){cum[4], cum[5], cum[6], cum[7]}; }
      v4u eo, go;
#pragma unroll
      for (int u = 0; u < 4; ++u) { eo[u] = pk2(rk * vv[2 * u], rk * vv[2 * u + 1]); go[u] = pk2(gt[2 * u], gt[2 * u + 1]); }
      bf16_t* Eo = (bf16_t*)(a.ws + WS_RW_E) + (size_t)tk * 4096; bf16_t* Go = (bf16_t*)(a.ws + WS_RW_GT) + (size_t)tk * 4096;
#pragma unroll
      for (int hf = 0; hf < 2; ++hf) { const int o = (((c >> 4) * 4 + (kg >> 1)) * 64 + ((2 * kg + hf) & 3) * 16 + (c & 15)) * 4;
          *(u32x2*)(Eo + o) = (u32x2){eo[2 * hf], eo[2 * hf + 1]}; *(u32x2*)(Go + o) = (u32x2){go[2 * hf], go[2 * hf + 1]}; } }
    WG_SYNC();
    if (stop <= 3) return;
    RW_IDX();
    { float cc[8];
#pragma unroll
      for (int u = 0; u < 8; ++u) cc[u] = 0.f;
#pragma unroll
      for (int ww = 0; ww < 8; ++ww) { const f32x4 t0 = *(const LAS f32x4*)(WT + ww * 64 + 8 * kg), t1 = *(const LAS f32x4*)(WT + ww * 64 + 8 * kg + 4);
#pragma unroll
          for (int e = 0; e < 4; ++e) { if (ww < w) { cum[e] += t0[e]; cum[4 + e] += t1[e]; } cc[e] += t0[e]; cc[4 + e] += t1[e]; } }
      if (c == 0) { *(LAS f32x4*)(CUMC + 8 * kg) = (f32x4){cc[0], cc[1], cc[2], cc[3]}; *(LAS f32x4*)(CUMC + 8 * kg + 4) = (f32x4){cc[4], cc[5], cc[6], cc[7]}; }
      v4u oRH, oBT, oKT, oKH, oBM, oKM;
#pragma unroll
      for (int u = 0; u < 8; u += 2) { float x[6][2];
#pragma unroll
          for (int e = 0; e < 2; ++e) { const float cu = cum[u + e]; const float ep = fexp(cu), em = fexp(-cu), et = fexp(cc[u + e] - cu), ex = fexp(cu - lwd[u + e]);
              x[0][e] = rr[u + e] * ep; x[1][e] = bb[u + e] * et; x[2][e] = kt[u + e] * et; x[3][e] = kk[u + e] * ex; x[4][e] = bb[u + e] * em; x[5][e] = kt[u + e] * em;
              RHST[(8 * kg + u + e) * 64 + c] = x[3][e]; }
          oRH[u >> 1] = pk2(x[0][0], x[0][1]); oBT[u >> 1] = pk2(x[1][0], x[1][1]); oKT[u >> 1] = pk2(x[2][0], x[2][1]); oKH[u >> 1] = pk2(x[3][0], x[3][1]); oBM[u >> 1] = pk2(x[4][0], x[4][1]); oKM[u >> 1] = pk2(x[5][0], x[5][1]); }
      const int o = c * RW_LD + 8 * kg;
      *(LAS v4u*)(RHi + o) = oRH; *(LAS v4u*)(BTi + o) = oBT; *(LAS v4u*)(KTi + o) = oKT; *(LAS v4u*)(KHi + o) = oKH; *(LAS v4u*)(BMi + o) = oBM; *(LAS v4u*)(KMi + o) = oKM; }
    WG_SYNC();
    if (stop <= 4) return;
    RW_IDX();
#pragma unroll
    for (int tt = 0; tt < 2; ++tt) { const int tile = 2 * w + tt, ii = tile >> 2, jt = tile & 3;
        f32x4 cA = {0.f, 0.f, 0.f, 0.f}, cB = cA, cPb = cA, cPk = cA;
        if (ii <= jt) {
#pragma unroll
            for (int k0 = 0; k0 < 64; k0 += 32) { const bf16x8 fbm = frag_row(BMi, RW_LD, 16 * ii, k0, lane), fkm = frag_row(KMi, RW_LD, 16 * ii, k0, lane), fkh = frag_row(KHi, RW_LD, 16 * jt, k0, lane), frh = frag_row(RHi, RW_LD, 16 * jt, k0, lane);
                cA = mfma16(fbm, fkh, cA); cB = mfma16(fkm, fkh, cB); cPb = mfma16(fbm, frh, cPb); cPk = mfma16(fkm, frh, cPk); }
#pragma unroll
            for (int e = 0; e < 4; ++e) { const int i = 16 * ii + 4 * g + e, tq = 16 * jt + r; if (!(i < tq)) { cA[e] = 0.f; cB[e] = 0.f; } if (!(i <= tq)) { cPb[e] = 0.f; cPk[e] = 0.f; } } }
        const int tq = 16 * jt + r, i0 = 16 * ii + 4 * g;
        *(LAS f32x4*)(AM + tq * 68 + i0) = cA; *(LAS u32x2*)(AI + tq * RW_LD + i0) = pack4(-cA); *(LAS u32x2*)(BMI + tq * RW_LD + i0) = pack4(cB); *(LAS u32x2*)(PBI + tq * RW_LD + i0) = pack4(cPb); *(LAS u32x2*)(PKI + tq * RW_LD + i0) = pack4(cPk); }
    WG_SYNC();
    if (stop <= 5) return;
    RW_IDX();
#pragma unroll
    for (int tt = 0; tt < 2; ++tt) { const int tile = 2 * w + tt, it = tile >> 2, jv = tile & 3; f32x4 acc = {0.f, 0.f, 0.f, 0.f};
#pragma unroll
        for (int k0 = 0; k0 < 64; k0 += 32) acc = mfma16(frag_row(BMI, RW_LD, 16 * it, k0, lane), frag_tr(Vi, RW_LD, 16 * jv, k0, lane), acc);
        *(LAS f32x4*)(RHST + (64 + 16 * jv + r) * 64 + 16 * it + 4 * g) = acc; }
    { const int q = c * 8 + kg;
      if (q < 64) { const int b = q >> 4, j = q & 15; float d[16], av[16][16];
#pragma unroll
          for (int tq = 1; tq < 16; ++tq)
#pragma unroll
              for (int i = 0; i < tq; ++i) av[tq][i] = AM[(16 * b + tq) * 68 + 16 * b + i];
#pragma unroll
          for (int tq = 0; tq < 16; ++tq) d[tq] = tq == j ? 1.f : 0.f;
#pragma unroll
          for (int i = 0; i < 15; ++i)
#pragma unroll
              for (int tq = i + 1; tq < 16; ++tq) d[tq] -= av[tq][i] * d[i];
#pragma unroll
          for (int tq = 0; tq < 16; ++tq) { DI[(b * 16 + tq) * 32 + j] = (bf16_t)f2bf(d[tq]); DI[(b * 16 + tq) * 32 + 16 + j] = (bf16_t)0; } }
      for (int i = q; i < 128 * RW_LD / 8; i += 512) *(LAS v4u*)(XI + 8 * i) = (v4u){0u, 0u, 0u, 0u};
      *(LAS v4u*)(UI + w * 512 + lane * 8) = (v4u){0u, 0u, 0u, 0u}; }
    WG_SYNC();
    if (stop <= 6) return;
    RW_IDX();
    { LAS bf16_t* Uw = UI + w * 512; LAS bf16_t* Xw = XI + (16 * w) * RW_LD;
#pragma unroll
      for (int b = 0; b < 4; ++b) { f32x4 acc = *(const LAS f32x4*)(RHST + (16 * w + r) * 64 + 16 * b + 4 * g);
#pragma unroll
          for (int k0 = 0; k0 < 16 * b; k0 += 32) acc = mfma16(frag_row(AI, RW_LD, 16 * b, k0, lane), frag_row(Xw, RW_LD, 0, k0, lane), acc);
          *(LAS u32x2*)(Uw + r * 32 + 4 * g) = pack4(acc);
          asm volatile("s_waitcnt lgkmcnt(0)" ::: "memory");
          f32x4 x = {0.f, 0.f, 0.f, 0.f}; x = mfma16(frag_row(DI + b * 512, 32, 0, 0, lane), frag_row(Uw, 32, 0, 0, lane), x);
          *(LAS u32x2*)(Xw + r * RW_LD + 16 * b + 4 * g) = pack4(x);
          asm volatile("s_waitcnt lgkmcnt(0)" ::: "memory"); } }
    WG_SYNC();
    if (stop <= 7) return;
    RW_IDX();
    { const int o = w >> 1; const LAS bf16_t* WHt = XI; const LAS bf16_t* XTt = XI + 64 * RW_LD;
#pragma unroll
      for (int tt = 0; tt < 8; ++tt) { const int tile = (w & 1) * 8 + tt, ti = tile >> 2, tj = tile & 3; f32x4 c1 = {0.f, 0.f, 0.f, 0.f}, c2 = c1;
          if (o == 0) {
#pragma unroll
              for (int k0 = 0; k0 < 64; k0 += 32) c1 = mfma16(frag_row(WHt, RW_LD, 16 * ti, k0, lane), frag_tr(BTi, RW_LD, 16 * tj, k0, lane), c1);
              const int kq = 16 * tj + r; const float dg = fexp(CUMC[kq]); f32x4 gv;
#pragma unroll
              for (int e = 0; e < 4; ++e) gv[e] = ((16 * ti + 4 * g + e) == kq ? dg : 0.f) - c1[e];
              *(u32x2*)((bf16_t*)(a.ws + WS_RW_G) + (size_t)tk * 4096 + fo_st(tj, 2, 16 * ti, g, r)) = pack4(gv);
          } else if (o == 1) {
#pragma unroll
              for (int k0 = 0; k0 < 64; k0 += 32) { c1 = mfma16(frag_tr(KTi, RW_LD, 16 * ti, k0, lane), frag_tr(Vi, RW_LD, 16 * tj, k0, lane), c1); c2 = mfma16(frag_tr(BTi, RW_LD, 16 * ti, k0, lane), frag_row(XTt, RW_LD, 16 * tj, k0, lane), c2); }
              *(u32x2*)((bf16_t*)(a.ws + WS_RW_Z) + (size_t)tk * 4096 + co_off(tj, 4, ti, lane)) = pack4(c1 - c2);
          } else if (o == 2) {
#pragma unroll
              for (int k0 = 0; k0 < 64; k0 += 32) c1 = mfma16(frag_row(WHt, RW_LD, 16 * ti, k0, lane), frag_row(PBI, RW_LD, 16 * tj, k0, lane), c1);
              const int tq = 16 * tj + r; const f32x4 rh = unpack4(*(const LAS u32x2*)(RHi + tq * RW_LD + 16 * ti + 4 * g));
              *(u32x2*)((bf16_t*)(a.ws + WS_RW_QT) + (size_t)tk * 4096 + fo_st(tj, 2, 16 * ti, g, r)) = pack4(rh - c1);
          } else {
#pragma unroll
              for (int k0 = 0; k0 < 64; k0 += 32) { c1 = mfma16(frag_tr(Vi, RW_LD, 16 * ti, k0, lane), frag_row(PKI, RW_LD, 16 * tj, k0, lane), c1); c2 = mfma16(frag_row(XTt, RW_LD, 16 * ti, k0, lane), frag_row(PBI, RW_LD, 16 * tj, k0, lane), c2); }
              *(u32x2*)((bf16_t*)(a.ws + WS_RW_YI) + (size_t)tk * 4096 + co_off(tj, 4, ti, lane)) = pack4(c1 - c2);
          } } }
    WG_SYNC();
#undef RW_IDX
}
__device__ __forceinline__ void rw_stage2(CArgs& a, int h, int vs, LAS unsigned char* lds, int tid) {
    const int lane = tid & 63, w = __builtin_amdgcn_readfirstlane(tid >> 6), r = lane & 15, g = lane >> 4;
    LAS bf16_t* Si = (LAS bf16_t*)lds;
    const bf16_t* G = (const bf16_t*)(a.ws + WS_RW_G); const bf16_t* Z = (const bf16_t*)(a.ws + WS_RW_Z); bf16_t* S = (bf16_t*)(a.ws + WS_RW_S);
    if (w < 4) { *(LAS u32x2*)(Si + r * RW_LD + 16 * w + 4 * g) = (u32x2){0u, 0u}; *(u32x2*)(S + (size_t)h * 4096 + fo_st(vs, 2, 16 * w, g, r)) = (u32x2){0u, 0u}; }
    WG_SYNC();
    constexpr int PD = 8; const int wq = w & 3; const int so = fo_st(vs, 2, 16 * wq, g, r), zo = co_off(vs, 4, wq, lane);
    bf16x8 gf[PD][2]; u32x2 zf[PD];
#pragma unroll
    for (int u = 0; u < PD; ++u) { const size_t tk = (size_t)u * 8 + h; zf[u] = *(const u32x2*)(Z + tk * 4096 + zo); gf[u][0] = frag_fo(G + tk * 4096, 2, wq, 0, lane); gf[u][1] = frag_fo(G + tk * 4096, 2, wq, 1, lane); }
#define RW_STEP(n_, u_, REFILL) do { const int n = (n_); const size_t tk = (size_t)n * 8 + h; const int cur = n & 1; \
            f32x4 acc = unpack4(zf[u_]), acc2 = {0.f, 0.f, 0.f, 0.f}; \
            acc = mfma16(gf[u_][0], frag_row(Si + cur * 16 * RW_LD, RW_LD, 0, 0, lane), acc); acc2 = mfma16(gf[u_][1], frag_row(Si + cur * 16 * RW_LD, RW_LD, 0, 32, lane), acc2); \
            if (REFILL) { const int nn = n + PD < NCH - 1 ? n + PD : NCH - 2; const size_t tn = (size_t)nn * 8 + h; zf[u_] = *(const u32x2*)(Z + tn * 4096 + zo); gf[u_][0] = frag_fo(G + tn * 4096, 2, wq, 0, lane); gf[u_][1] = frag_fo(G + tn * 4096, 2, wq, 1, lane); } \
            const u32x2 pv = pack4(acc + acc2); \
            if (w < 4) { *(LAS u32x2*)(Si + (cur ^ 1) * 16 * RW_LD + r * RW_LD + 16 * wq + 4 * g) = pv; *(u32x2*)(S + (tk + 8) * 4096 + so) = pv; } \
            asm volatile("s_waitcnt lgkmcnt(0)" ::: "memory"); __builtin_amdgcn_s_barrier(); asm volatile("" ::: "memory"); } while (0)
#pragma unroll
    for (int nq = 0; nq < NCH - 1; ++nq) RW_STEP(nq, nq % PD, nq + PD < NCH - 1);
#undef RW_STEP
}
__device__ __forceinline__ void rw_stage3(CArgs& a, int l, int n, int h, LAS unsigned char* lds, int tid) {
    const int lane = tid & 63, w = __builtin_amdgcn_readfirstlane(tid >> 6), r = lane & 15, g = lane >> 4, jc = w & 3, wh = w >> 2;
    const size_t tk = (size_t)n * 8 + h; const int c = 16 * jc + r, t = n * 64 + c;
    const bf16_t* S = (const bf16_t*)(a.ws + WS_RW_S) + tk * 4096; const bf16_t* QT = (const bf16_t*)(a.ws + WS_RW_QT) + tk * 4096; const bf16_t* YI = (const bf16_t*)(a.ws + WS_RW_YI) + tk * 4096;
    LAS float* xs = (LAS float*)lds;
    f32x4 acc[2];
#pragma unroll
    for (int tt = 0; tt < 2; ++tt) { const int iv = 2 * wh + tt; acc[tt] = unpack4(*(const u32x2*)(YI + co_off(jc, 4, iv, lane)));
#pragma unroll
        for (int k = 0; k < 2; ++k) acc[tt] = mfma16(frag_fo(S, 2, iv, k, lane), frag_fo(QT, 2, jc, k, lane), acc[tt]); }
    float s1 = (acc[0][0] + acc[0][1]) + (acc[0][2] + acc[0][3]) + (acc[1][0] + acc[1][1]) + (acc[1][2] + acc[1][3]);
    s1 += __shfl_xor(s1, 16); s1 += __shfl_xor(s1, 32);
    if (g == 0) xs[w * 16 + r] = s1;
    WG_SYNC();
    const float mu = (s1 + xs[(w ^ 4) * 16 + r]) * (1.0f / 64.0f); float s2 = 0.f;
#pragma unroll
    for (int tt = 0; tt < 2; ++tt)
#pragma unroll
        for (int e = 0; e < 4; ++e) { acc[tt][e] -= mu; s2 += acc[tt][e] * acc[tt][e]; }
    s2 += __shfl_xor(s2, 16); s2 += __shfl_xor(s2, 32);
    if (g == 0) xs[128 + w * 16 + r] = s2;
    WG_SYNC();
    const float rs = 1.0f / sqrtf((s2 + xs[128 + (w ^ 4) * 16 + r]) * (1.0f / 64.0f) + 64e-5f);
    const bf16_t* E = (const bf16_t*)(a.ws + WS_RW_E) + tk * 4096; const bf16_t* GT = (const bf16_t*)(a.ws + WS_RW_GT) + tk * 4096;
    bf16_t* O = (bf16_t*)(a.ws + WS_O) + (size_t)t * D + 1536 + h * 64;
#pragma unroll
    for (int tt = 0; tt < 2; ++tt) { const int v0 = 16 * (2 * wh + tt) + 4 * g; const int eo_ = co_off(jc, 4, 2 * wh + tt, lane); const f32x4 ev = unpack4(*(const u32x2*)(E + eo_)), gv = unpack4(*(const u32x2*)(GT + eo_));
        const f32x4 lw = *(const f32x4*)(LP(I_RWLNW, 512) + h * 64 + v0), lb = *(const f32x4*)(LP(I_RWLNB, 512) + h * 64 + v0); f32x4 y;
#pragma unroll
        for (int e = 0; e < 4; ++e) y[e] = (acc[tt][e] * rs * lw[e] + lb[e] + ev[e]) * gv[e];
        *(u32x2*)(O + v0) = pack4(y); }
    WG_SYNC();
}

constexpr int M2_LDS = 136, M2_LDX = 264, M2O_B = 0, M2O_C = 17408, M2O_X = 34816, M2O_XW = 68608, M2O_M = 102400, M2O_DT = 139264, M2O_G = 140288, M2O_GL = 141312;
__device__ __forceinline__ void m2_stage1(CArgs& a, int l, int n, int gr, LAS unsigned char* lds, int tid) {
    const int lane = tid & 63, w = __builtin_amdgcn_readfirstlane(tid >> 6), r = lane & 15, g = lane >> 4;
    LAS bf16_t* Bi = (LAS bf16_t*)(lds + M2O_B); LAS bf16_t* Ci = (LAS bf16_t*)(lds + M2O_C); LAS bf16_t* Xi = (LAS bf16_t*)(lds + M2O_X); LAS bf16_t* XWi = (LAS bf16_t*)(lds + M2O_XW); LAS bf16_t* Mi = (LAS bf16_t*)(lds + M2O_M);
    LAS float* DT = (LAS float*)(lds + M2O_DT); LAS float* GC = (LAS float*)(lds + M2O_G); LAS float* GLAST = (LAS float*)(lds + M2O_GL);
    const int t0 = n * 64;
    LAS bf16_t* RAW = (LAS bf16_t*)(lds + M2O_XW);
    { v4u sv[9];
#pragma unroll
      for (int i = 0; i < 9; ++i) { const int idx = tid + 512 * i, row = idx >> 6, ch = idx & 63, t = t0 - 3 + row; sv[i] = (v4u){0u, 0u, 0u, 0u};
          const int col = ch < 32 ? gr * 256 + 8 * ch : (ch < 48 ? 512 + gr * 128 + 8 * (ch - 32) : 768 + gr * 128 + 8 * (ch - 48));
          if (idx < 67 * 64 && t >= 0) sv[i] = *(const v4u*)(PROJROW(t) + C_MXBC + col); }
#pragma unroll
      for (int i = 0; i < 9; ++i) { const int idx = tid + 512 * i; if (idx < 67 * 64) *(LAS v4u*)(RAW + (idx >> 6) * 512 + 8 * (idx & 63)) = sv[i]; } }
    WG_SYNC();
    for (int it = tid; it < 512 * 4; it += 512) { const int lc = it & 511, seg = it >> 9; int col; LAS bf16_t* dst; int dld;
      if (lc < 256) { col = gr * 256 + lc; dst = Xi + lc; dld = M2_LDX; } else if (lc < 384) { col = 512 + gr * 128 + (lc - 256); dst = Bi + (lc - 256); dld = M2_LDS; } else { col = 768 + gr * 128 + (lc - 384); dst = Ci + (lc - 384); dld = M2_LDS; }
      const float* cw = LP(I_MCONV, 4 * 1024) + col; const float w0 = cw[0], w1 = cw[1024], w2 = cw[2048], w3 = cw[3072], cb = LP(I_MCONVB, 1024)[col];
      const LAS bf16_t* src = RAW + (16 * seg) * 512 + lc;
      float x0 = bf2f(src[0]), x1 = bf2f(src[512]), x2 = bf2f(src[1024]);
#pragma unroll
      for (int cc = 0; cc < 16; ++cc) { const float x3 = bf2f(src[(cc + 3) * 512]); const float y = silu_f(w0 * x0 + w1 * x1 + w2 * x2 + w3 * x3 + cb); dst[(16 * seg + cc) * dld] = (bf16_t)f2bf(y); x0 = x1; x1 = x2; x2 = x3; } }
    if (tid < 256) { const int c = tid >> 2, hh = tid & 3, hd = gr * 4 + hh; const float dt = softplus_f(bf2f(PROJROW(t0 + c)[C_MDT + hd]) + LP(I_MDTB, 8)[hd]); DT[c * 4 + hh] = dt; GC[c * 4 + hh] = -fexp(LP(I_MALOG, 8)[hd]) * dt; }
    WG_SYNC();
    if (tid < 4) { float cu = 0.f; for (int c = 0; c < 64; ++c) { cu += GC[c * 4 + tid]; GC[c * 4 + tid] = cu; } GLAST[tid] = cu; WSF(WS_M2_DEC)[n * 8 + gr * 4 + tid] = fexp(cu); }
    WG_SYNC();
    { const int c = tid >> 3, q = tid & 7;
      const int hh = q >> 1; const float sc = DT[c * 4 + hh] * fexp(GLAST[hh] - GC[c * 4 + hh]);
#pragma unroll
      for (int u = 0; u < 4; ++u) { const v4u xv = *(const LAS v4u*)(Xi + c * M2_LDX + 32 * q + 8 * u); v4u o;
#pragma unroll
          for (int e = 0; e < 4; ++e) o[e] = pk2(__uint_as_float(xv[e] << 16) * sc, __uint_as_float(xv[e] & 0xffff0000u) * sc);
          *(LAS v4u*)(XWi + c * M2_LDX + 32 * q + 8 * u) = o; }
      const float eg = fexp(GC[c * 4 + hh]); bf16_t* QH = (bf16_t*)(a.ws + WS_M2_QH) + (size_t)(n * 8 + gr * 4 + hh) * 8192;
#pragma unroll
      for (int u = 0; u < 8; ++u) { const v4u cv = *(const LAS v4u*)(Ci + c * M2_LDS + 64 * (q & 1) + 8 * u); v4u o;
#pragma unroll
          for (int e = 0; e < 4; ++e) o[e] = pk2(__uint_as_float(cv[e] << 16) * eg, __uint_as_float(cv[e] & 0xffff0000u) * eg);
          { const int s0 = 64 * (q & 1) + 8 * u; *(v4u*)(QH + (((c >> 4) * 4 + (s0 >> 5)) * 64 + ((s0 >> 3) & 3) * 16 + (c & 15)) * 8) = o; } } }
#pragma unroll
    for (int tt = 0; tt < 2; ++tt) { const int tile = 2 * w + tt, im = tile >> 2, jc = tile & 3; f32x4 acc = {0.f, 0.f, 0.f, 0.f};
        if (jc >= im) {
#pragma unroll
            for (int k0 = 0; k0 < 128; k0 += 32) acc = mfma16(frag_row(Bi, M2_LDS, 16 * im, k0, lane), frag_row(Ci, M2_LDS, 16 * jc, k0, lane), acc); }
        const int cq = 16 * jc + r;
#pragma unroll
        for (int hh = 0; hh < 4; ++hh) { f32x4 mv; const float gc = GC[cq * 4 + hh];
#pragma unroll
            for (int e = 0; e < 4; ++e) { const int m = 16 * im + 4 * g + e; mv[e] = cq >= m ? acc[e] * fexp(gc - GC[m * 4 + hh]) * DT[m * 4 + hh] : 0.f; }
            *(LAS u32x2*)(Mi + hh * 64 * 72 + cq * 72 + 16 * im + 4 * g) = pack4(mv); } }
    WG_SYNC();
    { const int hh = w >> 1, hd = gr * 4 + hh; const size_t tk = (size_t)n * 8 + hd; const float Dh = LP(I_MD, 8)[hd];
      bf16_t* YI = (bf16_t*)(a.ws + WS_M2_YI) + tk * 4096; bf16_t* Z = (bf16_t*)(a.ws + WS_M2_Z) + tk * 8192;
#pragma unroll
      for (int tt = 0; tt < 8; ++tt) { const int tile = (w & 1) * 8 + tt, ip = tile >> 2, jc = tile & 3; f32x4 acc = {0.f, 0.f, 0.f, 0.f};
#pragma unroll
          for (int k0 = 0; k0 < 64; k0 += 32) acc = mfma16(frag_tr(Xi, M2_LDX, 64 * hh + 16 * ip, k0, lane), frag_row(Mi + hh * 64 * 72, 72, 16 * jc, k0, lane), acc);
          const int cq = 16 * jc + r; const f32x4 xv = unpack4(*(const LAS u32x2*)(Xi + cq * M2_LDX + 64 * hh + 16 * ip + 4 * g));
          *(u32x2*)(YI + co_off(jc, 4, ip, lane)) = pack4(acc + xv * Dh); }
#pragma unroll
      for (int tt = 0; tt < 16; ++tt) { const int tile = (w & 1) * 16 + tt, is = tile >> 2, jp = tile & 3; f32x4 acc = {0.f, 0.f, 0.f, 0.f};
#pragma unroll
          for (int k0 = 0; k0 < 64; k0 += 32) acc = mfma16(frag_tr(Bi, M2_LDS, 16 * is, k0, lane), frag_tr(XWi, M2_LDX, 64 * hh + 16 * jp, k0, lane), acc);
          *(u32x2*)(Z + fo_st(jp, 4, 16 * is, g, r)) = pack4(acc); } }
    WG_SYNC();
}
__device__ __forceinline__ void m2_stage2(CArgs& a, int b, LAS unsigned char* lds, int tid) {
    const int hd = b >> 4, rem0 = (b & 15) * 512; const DecTable dc{WSF(WS_M2_DEC) + hd, 8};
    ew_stage2((const bf16_t*)(a.ws + WS_M2_Z) + (size_t)hd * 8192 + rem0, (bf16_t*)(a.ws + WS_M2_S) + (size_t)hd * 8192 + rem0, (size_t)8 * 8192, dc, lds, tid);
}
__device__ __forceinline__ void m2_stage3(CArgs& a, int l, int n, int gr, LAS unsigned char* lds, int tid) {
    const int lane = tid & 63, w = __builtin_amdgcn_readfirstlane(tid >> 6), r = lane & 15, g = lane >> 4, hh = w >> 1, hd = gr * 4 + hh;
    const size_t tk = (size_t)n * 8 + hd;
    const bf16_t* S = (const bf16_t*)(a.ws + WS_M2_S) + tk * 8192; const bf16_t* QH = (const bf16_t*)(a.ws + WS_M2_QH) + tk * 8192; const bf16_t* YI = (const bf16_t*)(a.ws + WS_M2_YI) + tk * 4096;
    LAS float* xs = (LAS float*)lds;
    f32x4 acc[2][4]; float ss[2];
#pragma unroll
    for (int cj = 0; cj < 2; ++cj) { const int jc = 2 * (w & 1) + cj, c = 16 * jc + r, t = n * 64 + c; const bf16_t* pz = PROJROW(t) + C_MZ + hd * 64; ss[cj] = 0.f;
#pragma unroll
        for (int ip = 0; ip < 4; ++ip) { acc[cj][ip] = unpack4(*(const u32x2*)(YI + co_off(jc, 4, ip, lane)));
#pragma unroll
            for (int k = 0; k < 4; ++k) acc[cj][ip] = mfma16(frag_fo(S, 4, ip, k, lane), frag_fo(QH, 4, jc, k, lane), acc[cj][ip]);
            const f32x4 zv = unpack4(*(const u32x2*)(pz + 16 * ip + 4 * g));
#pragma unroll
            for (int e = 0; e < 4; ++e) { acc[cj][ip][e] *= silu_f(zv[e]); ss[cj] += acc[cj][ip][e] * acc[cj][ip][e]; } }
        ss[cj] += __shfl_xor(ss[cj], 16); ss[cj] += __shfl_xor(ss[cj], 32);
        if (g == 0) xs[w * 32 + cj * 16 + r] = ss[cj]; }
    WG_SYNC();
#pragma unroll
    for (int cj = 0; cj < 2; ++cj) { const int jc = 2 * (w & 1) + cj, c = 16 * jc + r, t = n * 64 + c;
        const float tot = xs[((w & 1) + 0) * 32 + cj * 16 + r] + xs[((w & 1) + 2) * 32 + cj * 16 + r] + xs[((w & 1) + 4) * 32 + cj * 16 + r] + xs[((w & 1) + 6) * 32 + cj * 16 + r];
        const float rs = 1.0f / sqrtf(tot * (1.0f / 256.0f) + 1e-6f);
        const float* nw = LP(I_MNORM, 512) + hd * 64; bf16_t* O = (bf16_t*)(a.ws + WS_O) + (size_t)t * D + 1024 + hd * 64;
#pragma unroll
        for (int ip = 0; ip < 4; ++ip) { const f32x4 wv = *(const f32x4*)(nw + 16 * ip + 4 * g); f32x4 y;
#pragma unroll
            for (int e = 0; e < 4; ++e) y[e] = acc[cj][ip][e] * rs * wv[e];
            *(u32x2*)(O + 16 * ip + 4 * g) = pack4(y); } }
    WG_SYNC();
}

constexpr int GD_LD = 136;
constexpr int GDO_K = 0, GDO_V = 17408, GDO_KT = 34816, GDO_QG = 52224, GDO_Q = 69632, GDO_AI = 87040, GDO_AMD = 96256, GDO_DI = 100352, GDO_AQ = 104448, GDO_XI = 113664, GDO_QF = 87040, GDO_KF = 119808, GDO_SM = 152576, GDO_UI = 153600;
__device__ __forceinline__ void gd_stage1(CArgs& a, int l, int n, int h, LAS unsigned char* lds, int tid, const int stop = 99) {
    const int w = __builtin_amdgcn_readfirstlane(tid >> 6), tk = n * 4 + h, t0 = n * 64;
    int lane, r, g, c, q8;
#define GD_IDX() do { int tl_ = tid; asm volatile("" : "+v"(tl_)); lane = tl_ & 63; r = lane & 15; g = lane >> 4; c = tl_ >> 3; q8 = tl_ & 7; } while (0)
    LAS bf16_t* Ki = (LAS bf16_t*)(lds + GDO_K); LAS bf16_t* Vi = (LAS bf16_t*)(lds + GDO_V); LAS bf16_t* KTi = (LAS bf16_t*)(lds + GDO_KT); LAS bf16_t* QGi = (LAS bf16_t*)(lds + GDO_QG); LAS bf16_t* Qi = (LAS bf16_t*)(lds + GDO_Q);
    LAS bf16_t* AI = (LAS bf16_t*)(lds + GDO_AI);
    LAS float* AMD = (LAS float*)(lds + GDO_AMD);
    LAS bf16_t* DI = (LAS bf16_t*)(lds + GDO_DI);
    LAS bf16_t* AQ = (LAS bf16_t*)(lds + GDO_AQ);
    LAS bf16_t* XI = (LAS bf16_t*)(lds + GDO_XI);
    LAS bf16_t* UI = (LAS bf16_t*)(lds + GDO_UI);
    LAS float* QF = (LAS float*)(lds + GDO_QF); LAS float* KF = (LAS float*)(lds + GDO_KF);
    LAS float* BETA = (LAS float*)(lds + GDO_SM); LAS float* GC = BETA + 64; LAS float* BG = GC + 64;
    LAS bf16_t* RAW = (LAS bf16_t*)(lds + GDO_KT);
    { v4u sv[7];
#pragma unroll
      for (int i = 0; i < 7; ++i) { const int idx = tid + 512 * i, row = idx / 48, ch = idx % 48, which = ch >> 4, t = t0 - 3 + row; sv[i] = (v4u){0u, 0u, 0u, 0u};
          if (idx < 67 * 48 && t >= 0) sv[i] = *(const v4u*)(PROJROW(t) + C_GQ + which * 512 + h * 128 + 8 * (ch & 15)); }
#pragma unroll
      for (int i = 0; i < 7; ++i) { const int idx = tid + 512 * i; if (idx < 67 * 48) *(LAS v4u*)(RAW + (idx / 48) * 384 + 8 * (idx % 48)) = sv[i]; } }
    WG_SYNC();
    for (int it = tid; it < 384 * 4; it += 512) { const int col = it % 384, seg = it / 384, which = col >> 7, dcol = col & 127, cwi = which * 512 + h * 128 + dcol;
        const float* cw = LP(I_GCONV, 4 * 1536) + cwi; const float w0 = cw[0], w1 = cw[1536], w2 = cw[3072], w3 = cw[4608];
        const LAS bf16_t* src = RAW + (16 * seg) * 384 + col;
        float x0 = bf2f(src[0]), x1 = bf2f(src[384]), x2 = bf2f(src[768]);
#pragma unroll
        for (int cc = 0; cc < 16; ++cc) { const float x3 = bf2f(src[(cc + 3) * 384]); const float y = silu_f(w0 * x0 + w1 * x1 + w2 * x2 + w3 * x3); const int tok = 16 * seg + cc;
            if (which == 2) Vi[tok * GD_LD + dcol] = (bf16_t)f2bf(y); else (which == 0 ? QF : KF)[tok * 128 + dcol] = y;
            x0 = x1; x1 = x2; x2 = x3; } }
    if (tid >= 384 && tid < 448) { const int cc = tid - 384; const bf16_t* pr = PROJROW(t0 + cc);
        const float beta = sigmoid_f(bf2f(pr[C_GB + h])); float cu = -fexp(LP(I_GALOG, 4)[h]) * softplus_f(bf2f(pr[C_GA + h]) + LP(I_GDTB, 4)[h]);
#pragma unroll
        for (int o = 1; o < 64; o <<= 1) { const float up = __shfl_up(cu, o); if (cc >= o) cu += up; }
        BETA[cc] = beta; GC[cc] = cu; BG[cc] = beta * fexp(cu); }
    WG_SYNC();
    GD_IDX();
    if (stop <= 0) return;
    { float qv[16], kv[16]; float sq = 0.f, sk = 0.f;
#pragma unroll
      for (int u = 0; u < 4; ++u) { const f32x4 a4 = *(const LAS f32x4*)(QF + c * 128 + 16 * q8 + 4 * u), b4 = *(const LAS f32x4*)(KF + c * 128 + 16 * q8 + 4 * u);
#pragma unroll
          for (int e = 0; e < 4; ++e) { qv[4 * u + e] = a4[e]; kv[4 * u + e] = b4[e]; sq += a4[e] * a4[e]; sk += b4[e] * b4[e]; } }
      sq += __shfl_xor(sq, 1); sq += __shfl_xor(sq, 2); sq += __shfl_xor(sq, 4); sk += __shfl_xor(sk, 1); sk += __shfl_xor(sk, 2); sk += __shfl_xor(sk, 4);
      const float gc = GC[c], iq = (1.0f / sqrtf(sq + 1e-6f)) * 0.08838834764831845f, ik = 1.0f / sqrtf(sk + 1e-6f), et = fexp(GC[63] - gc), eg = fexp(gc);
      v4u oK[2], oQ[2], oKT[2], oQG[2];
#pragma unroll
      for (int u = 0; u < 8; ++u) { const float k0 = kv[2 * u] * ik, k1 = kv[2 * u + 1] * ik, q0 = qv[2 * u] * iq, q1 = qv[2 * u + 1] * iq;
          oK[u >> 2][u & 3] = pk2(k0, k1); oQ[u >> 2][u & 3] = pk2(q0, q1); oKT[u >> 2][u & 3] = pk2(k0 * et, k1 * et); oQG[u >> 2][u & 3] = pk2(q0 * eg, q1 * eg); }
      const int o = c * GD_LD + 16 * q8;
      *(LAS v4u*)(Ki + o) = oK[0]; *(LAS v4u*)(Ki + o + 8) = oK[1]; *(LAS v4u*)(Qi + o) = oQ[0]; *(LAS v4u*)(Qi + o + 8) = oQ[1];
      *(LAS v4u*)(KTi + o) = oKT[0]; *(LAS v4u*)(KTi + o + 8) = oKT[1]; *(LAS v4u*)(QGi + o) = oQG[0]; *(LAS v4u*)(QGi + o + 8) = oQG[1]; }
    WG_SYNC();
    GD_IDX();
    if (stop <= 1) return;
#pragma unroll
    for (int tt = 0; tt < 2; ++tt) { const int tile = 2 * w + tt, im = tile >> 2, jc = tile & 3; f32x4 c1 = {0.f, 0.f, 0.f, 0.f}, c2 = c1;
        if (jc >= im) {
#pragma unroll
            for (int k0 = 0; k0 < 128; k0 += 32) { const bf16x8 fa = frag_row(Ki, GD_LD, 16 * im, k0, lane); c1 = mfma16(fa, frag_row(Ki, GD_LD, 16 * jc, k0, lane), c1); c2 = mfma16(fa, frag_row(Qi, GD_LD, 16 * jc, k0, lane), c2); }
            const int cq = 16 * jc + r; const float gc = GC[cq], bc = BETA[cq];
#pragma unroll
            for (int e = 0; e < 4; ++e) { const int m = 16 * im + 4 * g + e; const float dc = fexp(gc - GC[m]); c1[e] = m < cq ? c1[e] * dc * bc : 0.f; c2[e] = m <= cq ? c2[e] * dc : 0.f; } }
        const int cq = 16 * jc + r; *(LAS u32x2*)(AI + cq * 72 + 16 * im + 4 * g) = pack4(-c1); *(LAS u32x2*)(AQ + cq * 72 + 16 * im + 4 * g) = pack4(c2);
        if (im == jc) *(LAS f32x4*)(AMD + (im * 16 + r) * 16 + 4 * g) = c1; }
    WG_SYNC();
    GD_IDX();
    if (stop <= 2) return;
    { const int q = c * 8 + q8;
      if (q < 64) { const int b = q >> 4, j = q & 15; float d[16], av[16][16];
#pragma unroll
          for (int tq = 1; tq < 16; ++tq)
#pragma unroll
              for (int i = 0; i < tq; ++i) av[tq][i] = AMD[(b * 16 + tq) * 16 + i];
#pragma unroll
          for (int tq = 0; tq < 16; ++tq) d[tq] = tq == j ? 1.f : 0.f;
#pragma unroll
          for (int i = 0; i < 15; ++i)
#pragma unroll
              for (int tq = i + 1; tq < 16; ++tq) d[tq] -= av[tq][i] * d[i];
#pragma unroll
          for (int tq = 0; tq < 16; ++tq) { DI[(b * 16 + tq) * 32 + j] = (bf16_t)f2bf(d[tq]); DI[(b * 16 + tq) * 32 + 16 + j] = (bf16_t)0; } }
      for (int i = q; i < 256 * 72 / 8; i += 512) *(LAS v4u*)(XI + 8 * i) = (v4u){0u, 0u, 0u, 0u};
      *(LAS v4u*)(UI + w * 512 + lane * 8) = (v4u){0u, 0u, 0u, 0u}; }
    WG_SYNC();
    GD_IDX();
    if (stop <= 3) return;
    { LAS bf16_t* Uw = UI + w * 512;
#pragma unroll
      for (int tt = 0; tt < 2; ++tt) { const int nt = 2 * w + tt; LAS bf16_t* Xw = XI + (16 * nt) * 72;
          const LAS bf16_t* src = nt < 8 ? Vi + 16 * nt + r : Ki + 16 * (nt - 8) + r; const LAS float* scl = nt < 8 ? BETA : BG;
#pragma unroll
          for (int b = 0; b < 4; ++b) { const f32x4 sc = *(const LAS f32x4*)(scl + 16 * b + 4 * g); f32x4 acc;
#pragma unroll
              for (int e = 0; e < 4; ++e) acc[e] = bf2f(src[(16 * b + 4 * g + e) * GD_LD]) * sc[e];
#pragma unroll
              for (int k0 = 0; k0 < 16 * b; k0 += 32) acc = mfma16(frag_row(AI, 72, 16 * b, k0, lane), frag_row(Xw, 72, 0, k0, lane), acc);
              *(LAS u32x2*)(Uw + r * 32 + 4 * g) = pack4(acc);
              asm volatile("s_waitcnt lgkmcnt(0)" ::: "memory");
              f32x4 x = {0.f, 0.f, 0.f, 0.f}; x = mfma16(frag_row(DI + b * 512, 32, 0, 0, lane), frag_row(Uw, 32, 0, 0, lane), x);
              *(LAS u32x2*)(Xw + r * 72 + 16 * b + 4 * g) = pack4(x);
              asm volatile("s_waitcnt lgkmcnt(0)" ::: "memory"); } } }
    WG_SYNC();
    GD_IDX();
    if (stop <= 4) return;
    { const int jc = w & 3, wh = w >> 2; const int cq = 16 * jc + r;
      bf16_t* QT = (bf16_t*)(a.ws + WS_GD_QT) + (size_t)tk * 8192; bf16_t* YI = (bf16_t*)(a.ws + WS_GD_YI) + (size_t)tk * 8192; bf16_t* GG = (bf16_t*)(a.ws + WS_GD_G) + (size_t)tk * 16384; bf16_t* Z = (bf16_t*)(a.ws + WS_GD_Z) + (size_t)tk * 16384;
#pragma unroll
      for (int tt = 0; tt < 4; ++tt) { const int id = 4 * wh + tt; f32x4 c1 = {0.f, 0.f, 0.f, 0.f}, c2 = c1;
#pragma unroll
          for (int k0 = 0; k0 < 64; k0 += 32) { const bf16x8 fb = frag_row(AQ, 72, 16 * jc, k0, lane); c1 = mfma16(frag_row(XI + 128 * 72, 72, 16 * id, k0, lane), fb, c1); c2 = mfma16(frag_row(XI, 72, 16 * id, k0, lane), fb, c2); }
          const f32x4 qg = unpack4(*(const LAS u32x2*)(QGi + cq * GD_LD + 16 * id + 4 * g));
          *(u32x2*)(QT + fo_st(jc, 4, 16 * id, g, r)) = pack4(qg - c1); *(u32x2*)(YI + co_off(jc, 8, id, lane)) = pack4(c2); }
      const float e63 = fexp(GC[63]);
#pragma unroll
      for (int ti = 0; ti < 8; ++ti) { f32x4 c1 = {0.f, 0.f, 0.f, 0.f}, c2 = c1;
#pragma unroll
          for (int k0 = 0; k0 < 64; k0 += 32) { c1 = mfma16(frag_row(XI + 128 * 72, 72, 16 * ti, k0, lane), frag_tr(KTi, GD_LD, 16 * w, k0, lane), c1); c2 = mfma16(frag_tr(KTi, GD_LD, 16 * ti, k0, lane), frag_row(XI, 72, 16 * w, k0, lane), c2); }
          const int dq = 16 * w + r; f32x4 gv;
#pragma unroll
          for (int e = 0; e < 4; ++e) gv[e] = ((16 * ti + 4 * g + e) == dq ? e63 : 0.f) - c1[e];
          *(u32x2*)(GG + fo_st(w, 4, 16 * ti, g, r)) = pack4(gv); *(u32x2*)(Z + co_off(w, 8, ti, lane)) = pack4(c2); } }
    WG_SYNC();
#undef GD_IDX
}
__device__ __forceinline__ void gd_stage2(CArgs& a, int h, int es, LAS unsigned char* lds, int tid, const int var = 0) {
    const int lane = tid & 63, w = __builtin_amdgcn_readfirstlane(tid >> 6), r = lane & 15, g = lane >> 4;
    LAS bf16_t* Si = (LAS bf16_t*)lds;
    const bf16_t* G = (const bf16_t*)(a.ws + WS_GD_G); const bf16_t* Z = (const bf16_t*)(a.ws + WS_GD_Z); bf16_t* S = (bf16_t*)(a.ws + WS_GD_S);
    const int so = fo_st(es, 4, 16 * w, g, r), zo = co_off(es, 8, w, lane);
    *(LAS u32x2*)(Si + r * GD_LD + 16 * w + 4 * g) = (u32x2){0u, 0u}; *(u32x2*)(S + (size_t)h * 16384 + so) = (u32x2){0u, 0u};
    WG_SYNC();
    constexpr int PD = 8;
    bf16x8 gf[PD][4]; u32x2 zf[PD];
#pragma unroll
    for (int u = 0; u < PD; ++u) { const size_t tk = (size_t)u * 4 + h; zf[u] = *(const u32x2*)(Z + tk * 16384 + zo);
#pragma unroll
        for (int k = 0; k < 4; ++k) gf[u][k] = frag_fo(G + tk * 16384, 4, w, k, lane); }
#define GD_STEP(n_, u_, REFILL) do { const int n = (n_); const size_t tk = (size_t)n * 4 + h; const int cur = n & 1; \
            f32x4 acc = unpack4(zf[u_]), acc2 = {0.f, 0.f, 0.f, 0.f}; \
            acc = mfma16(gf[u_][0], frag_row(Si + cur * 16 * GD_LD, GD_LD, 0, 0, lane), acc); acc2 = mfma16(gf[u_][1], frag_row(Si + cur * 16 * GD_LD, GD_LD, 0, 32, lane), acc2); \
            acc = mfma16(gf[u_][2], frag_row(Si + cur * 16 * GD_LD, GD_LD, 0, 64, lane), acc); acc2 = mfma16(gf[u_][3], frag_row(Si + cur * 16 * GD_LD, GD_LD, 0, 96, lane), acc2); \
            if (REFILL && !(var & 2)) { const int nn = n + PD < NCH - 1 ? n + PD : NCH - 2; const size_t tn = (size_t)nn * 4 + h; zf[u_] = *(const u32x2*)(Z + tn * 16384 + zo); \
                _Pragma("unroll") for (int k = 0; k < 4; ++k) gf[u_][k] = frag_fo(G + tn * 16384, 4, w, k, lane); } \
            const u32x2 pv = pack4(acc + acc2); \
            if (!(var & 4)) *(LAS u32x2*)(Si + (cur ^ 1) * 16 * GD_LD + r * GD_LD + 16 * w + 4 * g) = pv; if (!(var & 1)) *(u32x2*)(S + (tk + 4) * 16384 + so) = pv; \
            if (!(var & 4)) { asm volatile("s_waitcnt lgkmcnt(0)" ::: "memory"); __builtin_amdgcn_s_barrier(); } asm volatile("" ::: "memory"); } while (0)
#pragma unroll
    for (int nq = 0; nq < NCH - 1; ++nq) GD_STEP(nq, nq % PD, nq + PD < NCH - 1);
#undef GD_STEP
}
__device__ __forceinline__ void gd_stage3(CArgs& a, int l, int n, int h, LAS unsigned char* lds, int tid) {
    const int lane = tid & 63, w = __builtin_amdgcn_readfirstlane(tid >> 6), r = lane & 15, g = lane >> 4, jc = w & 3, wh = w >> 2;
    const size_t tk = (size_t)n * 4 + h; const int c = 16 * jc + r, t = n * 64 + c;
    const bf16_t* S = (const bf16_t*)(a.ws + WS_GD_S) + tk * 16384; const bf16_t* QT = (const bf16_t*)(a.ws + WS_GD_QT) + tk * 8192; const bf16_t* YI = (const bf16_t*)(a.ws + WS_GD_YI) + tk * 8192;
    LAS float* xs = (LAS float*)lds;
    f32x4 acc[4]; float ss = 0.f;
#pragma unroll
    for (int tt = 0; tt < 4; ++tt) { const int ie = 4 * wh + tt; acc[tt] = unpack4(*(const u32x2*)(YI + co_off(jc, 8, ie, lane)));
#pragma unroll
        for (int k = 0; k < 4; ++k) acc[tt] = mfma16(frag_fo(S, 4, ie, k, lane), frag_fo(QT, 4, jc, k, lane), acc[tt]);
#pragma unroll
        for (int e = 0; e < 4; ++e) ss += acc[tt][e] * acc[tt][e]; }
    ss += __shfl_xor(ss, 16); ss += __shfl_xor(ss, 32);
    if (g == 0) xs[w * 16 + r] = ss;
    WG_SYNC();
    const float rs = 1.0f / sqrtf((ss + xs[(w ^ 4) * 16 + r]) * (1.0f / 128.0f) + 1e-6f);
    const float* nw = LP(I_GNORM, 128); const bf16_t* pz = PROJROW(t) + C_GZ + h * 128; bf16_t* O = (bf16_t*)(a.ws + WS_O) + (size_t)t * D + h * 128;
#pragma unroll
    for (int tt = 0; tt < 4; ++tt) { const int e0 = 16 * (4 * wh + tt) + 4 * g; const f32x4 zv = unpack4(*(const u32x2*)(pz + e0)), wv = *(const f32x4*)(nw + e0); f32x4 y;
#pragma unroll
        for (int e = 0; e < 4; ++e) y[e] = acc[tt][e] * rs * wv[e] * silu_f(zv[e]);
        *(u32x2*)(O + e0) = pack4(y); }
    WG_SYNC();
}

#define XB_TMO      128
#define XB_XCNT(j)  (256  + 64 * (j))
#define XB_XSUB(j)  (1280 + 64 * (j))
#define XB_XGEN(j)  (2304 + 64 * (j))
#define XB_TOP      3328
#define XB_TOPGEN   3392
#define XCD_BAR_WORDS 3456
#define XB_SPIN_CAP (1u << 20)
__device__ __forceinline__ unsigned xb_ld(unsigned* p)              { return __hip_atomic_load(p, __ATOMIC_RELAXED, __HIP_MEMORY_SCOPE_AGENT); }
__device__ __forceinline__ unsigned xb_add(unsigned* p, unsigned v) { return __hip_atomic_fetch_add(p, v, __ATOMIC_RELAXED, __HIP_MEMORY_SCOPE_AGENT); }
__device__ __forceinline__ unsigned xb_xcc_id() { return (unsigned)__builtin_amdgcn_s_getreg((3 << 11) | 20) & 0xFu; }
#define XB_SPIN(cond, bar) do { unsigned _sp = 0; while (cond) { __builtin_amdgcn_s_sleep(1); \
    if ((++_sp & 255u) == 0u) { if (xb_ld(&(bar)[XB_TMO])) break; if (_sp > XB_SPIN_CAP) { atomicAdd(&(bar)[XB_TMO], 1u); break; } } } } while (0)
struct XcdBarrier { unsigned* bar; unsigned x; volatile LAS unsigned* st; };
__device__ __forceinline__ XcdBarrier xcd_barrier_post(unsigned* bar, volatile LAS unsigned* st) {
    XcdBarrier b; b.bar = bar; b.x = xb_xcc_id(); b.st = st;
    if (threadIdx.x == 0) (void)xb_add(&bar[XB_XCNT(b.x)], 1u);
    return b;
}
__device__ __forceinline__ void xcd_barrier_complete(unsigned* bar, unsigned x, unsigned& nloc, unsigned& nx) {
    const unsigned G = gridDim.x * gridDim.y * gridDim.z;
    unsigned sum, cnt, mine, sp = 0u;
    for (;;) {
        sum = 0u; cnt = 0u; mine = 0u;
#pragma unroll
        for (unsigned j = 0; j < 16; ++j) { const unsigned c = xb_ld(&bar[XB_XCNT(j)]); sum += c; cnt += (c > 0u) ? 1u : 0u; mine = (j == x) ? c : mine; }
        if (sum == G) break;
        __builtin_amdgcn_s_sleep(1);
        if ((++sp & 255u) == 0u) { if (xb_ld(&bar[XB_TMO])) break; if (sp > XB_SPIN_CAP) { atomicAdd(&bar[XB_TMO], 1u); break; } }
    }
    nloc = mine > 0u ? mine : 1u; nx = cnt > 0u ? cnt : 1u;
}
__device__ __forceinline__ void xcd_barrier(const XcdBarrier& b) {
    asm volatile("s_waitcnt vmcnt(0)" ::: "memory");
    __syncthreads();
    if (threadIdx.x == 0) {
        unsigned* bar = b.bar;
        __builtin_amdgcn_s_waitcnt(0);
        unsigned nloc = b.st[0], nx = b.st[1];
        if (nloc == 0u) { xcd_barrier_complete(bar, b.x, nloc, nx); b.st[0] = nloc; b.st[1] = nx; }
        const unsigned old = xb_add(&bar[XB_XSUB(b.x)], 1u);
        const unsigned gen = old / nloc;
        if (old + 1u == (gen + 1u) * nloc) {
            __builtin_amdgcn_fence(__ATOMIC_RELEASE, "agent");
            asm volatile("s_waitcnt vmcnt(0)" ::: "memory");
            const unsigned og = xb_add(&bar[XB_TOP], 1u);
            const unsigned tg = og / nx;
            if (og + 1u == (tg + 1u) * nx) xb_add(&bar[XB_TOPGEN], 1u);
            else XB_SPIN(xb_ld(&bar[XB_TOPGEN]) == tg, bar);
            __builtin_amdgcn_fence(__ATOMIC_ACQUIRE, "agent");
            xb_add(&bar[XB_XGEN(b.x)], 1u);
            asm volatile("s_waitcnt vmcnt(0)" ::: "memory");
        } else {
            XB_SPIN(xb_ld(&bar[XB_XGEN(b.x)]) == gen, bar);
            __builtin_amdgcn_fence(__ATOMIC_ACQUIRE, "agent");
            asm volatile("s_waitcnt vmcnt(0)" ::: "memory");
        }
    }
    __syncthreads();
}

constexpr int CV_IN = (D / 64) * (PTP / 32), CV_OUT = (D / 64) * (D / 32), CV_UP = (D / 64) * (FF / 32), CV_DN = (FF / 64) * (D / 32), CV_ALL = CV_IN + CV_OUT + CV_UP + CV_DN;
__device__ __forceinline__ void cvt_items(CArgs& a, int l, int lo, int hi, int gwv, int ngwv, LAS float* scr, int lane) {
#pragma unroll 1
    for (int it = lo + gwv; it < hi; it += ngwv) {
        int r = it;
        if (r < CV_IN) { transpose_item(LP(I_WIN, (size_t)D * PT), D, PT, PTP, (bf16_t*)(a.ws + WS_WIN), scr, r, lane, LP(I_N1, D)); continue; } r -= CV_IN;
        if (r < CV_OUT) { transpose_item(LP(I_WOUT, (size_t)D * D), D, D, D, (bf16_t*)(a.ws + WS_WOUT), scr, r, lane); continue; } r -= CV_OUT;
        if (r < CV_UP) { transpose_item(LP(I_WUP, (size_t)D * FF), D, FF, FF, (bf16_t*)(a.ws + WS_WUP), scr, r, lane, LP(I_N2, D)); continue; } r -= CV_UP;
        transpose_item(LP(I_WDN, (size_t)FF * D), FF, D, D, (bf16_t*)(a.ws + WS_WDN), scr, r, lane);
    }
}

constexpr int CW_SUB = 8192;
__device__ __forceinline__ void cnt_arrive(unsigned* cnt) {
    asm volatile("s_waitcnt vmcnt(0)" ::: "memory"); __syncthreads();
    if (threadIdx.x == 0) { __builtin_amdgcn_fence(__ATOMIC_RELEASE, "agent"); asm volatile("s_waitcnt vmcnt(0)" ::: "memory"); (void)xb_add(cnt, 1u); }
}
__device__ __forceinline__ void cnt_wait(unsigned* cnt, unsigned want, unsigned* tmo) {
    if (threadIdx.x == 0) { unsigned sp = 0; while (xb_ld(cnt) < want) { __builtin_amdgcn_s_sleep(2); if ((++sp & 255u) == 0u) { if (xb_ld(tmo)) break; if (sp > XB_SPIN_CAP) { atomicAdd(tmo, 1u); break; } } }
        __builtin_amdgcn_fence(__ATOMIC_ACQUIRE, "agent"); asm volatile("s_waitcnt vmcnt(0)" ::: "memory"); }
    __syncthreads();
}

constexpr int N_PHASES = 1 + 9 * NL;

__device__ __forceinline__ void run_phase(CArgs& a, int ph, LAS unsigned char* lds, const int tid, const int bid, const int mask = 15) {
    const int lane = tid & 63, wave = __builtin_amdgcn_readfirstlane(tid >> 6);
    const int G = gridDim.x, gw = bid * NWAVES + wave, NGW = G * NWAVES;
    ss_t* SSb = (ss_t*)(a.ws + WS_SS);
    if (ph == N_PHASES - 1) {
        for (int t = gw; t < T; t += NGW) final_row((const bf16_t*)(a.ws + WS_HB) + (size_t)t * D, a.in[I_NF], (float)SSb[2 * NL * T + t] * SS_INV, a.out + (size_t)t * D, lane);
        return;
    }
    const int l = ph / 9, sp = ph % 9;
    bf16_t* HB = (bf16_t*)(a.ws + WS_HB);
    switch (sp) {
    case 0: {
        if (mask & 1) cvt_items(a, l, 0, CV_IN, gw, NGW, (LAS float*)(lds + wave * 16384), lane);
        if (mask & 2) for (int t = gw; t < T; t += NGW) hb_row(a.in[I_X] + (size_t)t * D, HB + (size_t)t * D, SSb + t, lane);
    } break;
    case 1: { pg8::Gemm g{HB, (const bf16_t*)(a.ws + WS_WIN)}; pg8::StaticOrder<T, PTP> S; S.init(G, bid);
              pg8::EpiBf16<false> E{(bf16_t*)(a.ws + WS_PROJ), PTP, SSb + l * T}; pg8::gemm_phase<D, pg8::EpiBf16<false>, pg8::StaticOrder<T, PTP>, true>(lds, g, S, E, tid);
              constexpr int NFULL = (T / 256) * (PTP / 256) % 256; if (bid >= NFULL) cvt_items(a, l, CV_IN, CV_ALL, (bid - NFULL) * NWAVES + wave, (G - NFULL) * NWAVES, (LAS float*)(lds + wave * 16384), lane); } break;
    case 2: {
#pragma unroll 1
              for (int it = bid; (mask & 1) && it < NCH * 4; it += G) gd_stage1(a, l, it >> 2, it & 3, lds, tid, mask >> 8 ? (mask >> 8) - 1 : 99);
#pragma unroll 1
              for (int it = bid; (mask & 4) && it < NCH * 8; it += G) rw_stage1(a, l, it >> 3, it & 7, lds, tid, mask >> 8 ? (mask >> 8) - 1 : 99);
#pragma unroll 1
              for (int it = bid; (mask & 8) && it < NCH * 2; it += G) m2_stage1(a, l, it >> 1, it & 1, lds, tid);
#pragma unroll 1
              for (int it = bid; (mask & 2) && it < NCH * 4; it += G) ret_stage1(a, it >> 2, it & 3, lds, tid); } break;
    case 3: { const int b = bid;
              unsigned* ctl = (unsigned*)(a.ws + WS_CTL); unsigned* sub = ctl + CW_SUB + 128 * l; unsigned* ddone = sub + 32; unsigned* gdone = sub + 64;
              if (b < 64) { const int x = b & 7, j = b >> 3;
                  if (x < 4) { if (mask & 1) gd_stage2(a, x, j, lds, tid, mask >> 12); if ((mask & 15) == 15) cnt_arrive(gdone); }
                  else { if (mask & 4) rw_stage2(a, (x - 4) * 2 + (j >> 2), j & 3, lds, tid); if ((mask & 15) == 15) cnt_arrive(ddone); } }
              else { if (b < 128) { if (mask & 2) ret_stage2(a, b - 64, lds, tid); } else if (mask & 8) m2_stage2(a, b - 128, lds, tid);
                  if ((mask & 15) == 15) { const int hb = b - 64, NH = G - 64;
                      cnt_arrive(sub); cnt_wait(sub, (unsigned)NH, ctl + XB_TMO);
#pragma unroll 1
                      for (int it = hb; !(mask & 32) && it < NCH * 4; it += NH) ret_stage3(a, l, it >> 2, it & 3, lds, tid);
#pragma unroll 1
                      for (int it = hb; !(mask & 32) && it < NCH * 2; it += NH) m2_stage3(a, l, it >> 1, it & 1, lds, tid); } }
              if ((mask & 15) == 15 && !(b < 64 && (b & 7) < 4)) { LAS float* scr = (LAS float*)(lds + wave * 16384);
                  const int sidx = b < 64 ? (b >> 3) * 4 + (b & 7) - 4 : 32 + (b - 64), NS = G - 32;
                  __syncthreads();
                  if (l + 1 < NL && !(mask & 16)) cvt_items(a, l + 1, 0, CV_IN, sidx * NWAVES + wave, NS * NWAVES, scr, lane);
                  __syncthreads();
                  cnt_wait(ddone, 32u, ctl + XB_TMO);
#pragma unroll 1
                  for (int it = sidx; !(mask & 64) && it < NCH * 8; it += NS) rw_stage3(a, l, it >> 3, it & 7, lds, tid);
                  cnt_wait(gdone, 32u, ctl + XB_TMO);
#pragma unroll 1
                  for (int it = sidx; !(mask & 128) && it < NCH * 4; it += NS) gd_stage3(a, l, it >> 2, it & 3, lds, tid); } } break;
    case 4: break;
    case 5: { pg8::Gemm g{(const bf16_t*)(a.ws + WS_O), (const bf16_t*)(a.ws + WS_WOUT)}; pg8::StaticOrder<T, D> S; S.init(G, bid);
              if (l == 0) { pg8::EpiRes<true> E{a.in[I_X], HB, D, SSb + (NL + l) * T}; pg8::gemm_phase<D, pg8::EpiRes<true>, pg8::StaticOrder<T, D>, false>(lds, g, S, E, tid); }
              else { pg8::EpiRes<false> E{HB, HB, D, SSb + (NL + l) * T}; pg8::gemm_phase<D, pg8::EpiRes<false>, pg8::StaticOrder<T, D>, false>(lds, g, S, E, tid); } } break;
    case 6: break;
    case 7: { pg8::Gemm g{HB, (const bf16_t*)(a.ws + WS_WUP)}; pg8::StaticOrder<T, FF> S; S.init(G, bid);
              pg8::EpiBf16<true> E{(bf16_t*)(a.ws + WS_HID), FF, SSb + (NL + l) * T}; pg8::gemm_phase<D, pg8::EpiBf16<true>, pg8::StaticOrder<T, FF>, true>(lds, g, S, E, tid); } break;
    case 8: { pg8::Gemm g{(const bf16_t*)(a.ws + WS_HID), (const bf16_t*)(a.ws + WS_WDN)}; pg8::StaticOrder<T, D> S; S.init(G, bid);
              pg8::EpiRes<false> E{HB, HB, D, SSb + (l + 1 < NL ? (l + 1) : 2 * NL) * T}; pg8::gemm_phase<FF, pg8::EpiRes<false>, pg8::StaticOrder<T, D>, false>(lds, g, S, E, tid); } break;
    }
}

__global__ void __launch_bounds__(NWAVES * 64, 2) fwd_kernel(Args a) {
    extern __shared__ __attribute__((aligned(16))) unsigned char lds_raw[];
    LAS unsigned char* lds = (LAS unsigned char*)lds_raw;
    const int ph_lo = a.ph_lo, ph_hi = a.ph_hi;
    volatile LAS unsigned* MISC = (volatile LAS unsigned*)(lds + MISC_OFF);
    if (threadIdx.x < 64) MISC[threadIdx.x] = 0u;
    __syncthreads();
    const XcdBarrier bar = xcd_barrier_post((unsigned*)(a.ws + WS_CTL), MISC + 8);
    for (int ph = ph_lo; ph < ph_hi; ++ph) {
        if (ph != N_PHASES - 1 && (ph % 9 == 6 || ph % 9 == 4 || (ph % 9 == 0 && ph > 0))) continue;
        CArgs* ap = (CArgs*)__builtin_amdgcn_kernarg_segment_ptr();
        asm volatile("" : "+s"(ap));
        int tid = threadIdx.x, bid = blockIdx.x;
        asm volatile("" : "+v"(tid)); asm volatile("" : "+s"(bid));
        run_phase(*ap, ph, lds, tid, bid);
#ifdef DUP_PHASE
#ifndef DUP_MASK
#define DUP_MASK 15
#endif
        if (ph == DUP_PHASE) { xcd_barrier(bar); asm volatile("" : "+s"(ap)); asm volatile("" : "+v"(tid)); asm volatile("" : "+s"(bid)); run_phase(*ap, ph, lds, tid, bid, DUP_MASK); }
#endif
        if (ph + 1 < ph_hi) xcd_barrier(bar);
    }
}

extern "C" void kernel_launch(void* const* d_in, const int* in_sizes, int n_in, void* d_out, int out_size, void* d_ws, size_t ws_size, hipStream_t stream) {
    static int grid = 0;
    if (grid == 0) {
        if (n_in != N_IN || in_sizes[0] != T * D || out_size != T * D || ws_size < WS_END) {
            fprintf(stderr, "kernel_launch: shape/workspace mismatch: n_in %d in0 %d out %d ws %zu (need %zu); nothing launched\n", n_in, n_in > 0 ? in_sizes[0] : -1, out_size, ws_size, (size_t)WS_END); grid = -1; return; }
        int dev = 0, cus = 0, per_cu = 0;
        if (hipGetDevice(&dev) != hipSuccess || hipDeviceGetAttribute(&cus, hipDeviceAttributeMultiprocessorCount, dev) != hipSuccess) { grid = -1; return; }
        if (hipFuncSetAttribute((const void*)fwd_kernel, hipFuncAttributeMaxDynamicSharedMemorySize, LDS_BYTES) != hipSuccess) { fprintf(stderr, "kernel_launch: hipFuncSetAttribute failed\n"); grid = -1; return; }
        if (hipOccupancyMaxActiveBlocksPerMultiprocessor(&per_cu, (const void*)fwd_kernel, NWAVES * 64, LDS_BYTES) != hipSuccess || per_cu < 1) { fprintf(stderr, "kernel_launch: occupancy query says %d blocks per CU\n", per_cu); per_cu = 1; }
        (void)hipGetLastError();
        grid = cus;
    }
    if (grid < 0) return;
    Args a{};
    for (int i = 0; i < N_IN; ++i) a.in[i] = (const float*)d_in[i];
    a.out = (float*)d_out; a.ws = (unsigned char*)d_ws;
#if N_LAUNCH_MODE == 1
    a.ph_lo = 0; a.ph_hi = N_PHASES;
    (void)hipMemsetAsync((char*)d_ws + WS_CTL, 0, CTL_ZERO_BYTES, stream);
    hipLaunchKernelGGL(fwd_kernel, dim3(grid), dim3(NWAVES * 64), LDS_BYTES, stream, a);
#else
#ifndef DBG_MAXPH
#define DBG_MAXPH N_PHASES
#endif
    for (int ph = 0; ph < N_PHASES; ++ph) {
        if (ph >= DBG_MAXPH && ph != N_PHASES - 1) continue;
#ifdef DBG_SKIP_FINAL
        if (ph == N_PHASES - 1) continue;
#endif
        (void)hipMemsetAsync((char*)d_ws + WS_CTL, 0, CTL_ZERO_BYTES, stream);
        a.ph_lo = ph; a.ph_hi = ph + 1;
        hipLaunchKernelGGL(fwd_kernel, dim3(grid), dim3(NWAVES * 64), LDS_BYTES, stream, a);
    }
#endif
}
#endif
```

```cpp
#ifndef HOST_TEST
#include <hip/hip_runtime.h>
#endif
#include <cstdio>
#include <cstdint>
#include <cmath>
#include <cstddef>

#ifndef SEQ_T
#define SEQ_T 8192
#endif
#ifndef N_LAUNCH_MODE
#define N_LAUNCH_MODE 1
#endif

constexpr int T = SEQ_T, D = 2048, NL = 2, FF = 8192, PT = 6832, PTP = 6912;
constexpr int C_GQ = 0, C_GK = 512, C_GV = 1024, C_GZ = 1536, C_GB = 2048, C_GA = 2052;
constexpr int C_RQ = 2056, C_RK = 2312, C_RV = 2568, C_RG = 3080;
constexpr int C_MZ = 3592, C_MXBC = 4104, C_MDT = 5128;
constexpr int C_RW = 5136;
enum { I_X = 0, I_N1, I_WIN, I_GCONV, I_GALOG, I_GDTB, I_GNORM, I_RNORM, I_MCONV, I_MCONVB, I_MALOG, I_MDTB, I_MD, I_MNORM, I_RWMU, I_RWW0, I_RWWUP, I_RWA0, I_RWAUP,
       I_RWGUP, I_RWKK, I_RWKA, I_RWRK, I_RWLNW, I_RWLNB, I_WOUT, I_N2, I_WUP, I_WDN, I_NF, N_IN };

constexpr size_t MiB = 1u << 20;
constexpr size_t SZ_WIN = (size_t)PTP * D * 2, SZ_WOUT = (size_t)D * D * 2, SZ_WUP = (size_t)FF * D * 2, SZ_WDN = (size_t)D * FF * 2;
constexpr size_t WS_CTL = 0, CTL_BYTES = 1 * MiB;
typedef unsigned long long ss_t;
constexpr float SS_FIX = 16777216.0f, SS_INV = 1.0f / 16777216.0f;
constexpr size_t WS_SS = 64 * 1024, SS_STRIDE = (size_t)SEQ_T * 8;
constexpr size_t CTL_ZERO_BYTES = WS_SS + (2 * 2 + 1) * SS_STRIDE;
constexpr size_t WS_WIN = WS_CTL + CTL_BYTES;
constexpr size_t WS_WOUT = WS_WIN + SZ_WIN;
constexpr size_t WS_WUP = WS_WOUT + SZ_WOUT;
constexpr size_t WS_WDN = WS_WUP + SZ_WUP;
constexpr size_t WS_O = WS_WDN + SZ_WDN;
constexpr size_t WS_HB = WS_O + (size_t)T * D * 2;
constexpr size_t WS_PROJ = WS_HB + (size_t)T * D * 2;
constexpr size_t WS_HID = WS_PROJ;
constexpr size_t GDN_ = (size_t)(T / 64) * 4 * 16384;
constexpr size_t WS_GD_G = WS_PROJ + (size_t)T * PTP * 2;
constexpr size_t WS_GD_Z = WS_GD_G + GDN_ * 2;
constexpr size_t WS_GD_QT = WS_GD_Z + GDN_ * 2;
constexpr size_t WS_GD_YI = WS_GD_QT + GDN_;
constexpr size_t WS_GD_S = WS_GD_YI + GDN_;
constexpr size_t WS_GAB = WS_GD_S + GDN_ * 2;
constexpr int NCH = T / 64;
constexpr size_t WS_RET_Z = WS_GAB;
constexpr size_t WS_RET_YI = WS_RET_Z + (size_t)NCH * 4 * 8192 * 2;
constexpr size_t WS_RET_QH = WS_RET_YI + (size_t)NCH * 4 * 8192 * 2;
constexpr size_t WS_RET_S = WS_RET_QH + (size_t)NCH * 4 * 4096 * 2;
constexpr size_t M2N = (size_t)NCH * 8 * 8192;
constexpr size_t WS_M2_Z = WS_RET_S + (size_t)NCH * 4 * 8192 * 2;
constexpr size_t WS_M2_YI = WS_M2_Z + M2N * 2;
constexpr size_t WS_M2_QH = WS_M2_YI + M2N;
constexpr size_t WS_M2_S = WS_M2_QH + M2N * 2;
constexpr size_t WS_M2_DEC = WS_M2_S + M2N * 2;
constexpr size_t WS_MDT = WS_M2_DEC + (size_t)NCH * 8 * 4;
constexpr size_t RWN = (size_t)NCH * 8 * 4096;
constexpr size_t WS_RW_G = WS_MDT;
constexpr size_t WS_RW_Z = WS_RW_G + RWN * 2;
constexpr size_t WS_RW_QT = WS_RW_Z + RWN * 2;
constexpr size_t WS_RW_YI = WS_RW_QT + RWN * 2;
constexpr size_t WS_RW_E = WS_RW_YI + RWN * 2;
constexpr size_t WS_RW_GT = WS_RW_E + RWN * 2;
constexpr size_t WS_RW_S = WS_RW_GT + RWN * 2;
constexpr size_t WS_END = WS_RW_S + RWN * 2;
static_assert(WS_HID + (size_t)T * FF * 2 <= WS_END, "HID overlay");
static_assert(CTL_ZERO_BYTES <= CTL_BYTES, "CTL");
static_assert(SEQ_T != 8192 || WS_END <= 512 * MiB, "d_ws budget (512 MiB)");

typedef unsigned short bf16_t;
#ifdef HOST_TEST
#define DEV static inline
#define HD static inline
typedef float f32x4 __attribute__((vector_size(16)));
constexpr int WAVE = 1, LPC = 1;
static inline float wave_sum(float v) { return v; }
static inline float group_sum(float v) { return v; }
#else
#define DEV __device__ __forceinline__
#define HD __host__ __device__ __forceinline__
typedef float f32x4 __attribute__((ext_vector_type(4)));
constexpr int WAVE = 64, LPC = 16;
DEV float wave_sum(float v) {
#pragma unroll
    for (int o = 1; o < 64; o <<= 1) v += __shfl_xor(v, o);
    return v;
}
DEV float group_sum(float v) {
#pragma unroll
    for (int o = 1; o < 16; o <<= 1) v += __shfl_xor(v, o);
    return v;
}
#endif
constexpr int CPW = WAVE / LPC;

#ifdef HOST_TEST
HD unsigned f2bf(float f) { unsigned u; __builtin_memcpy(&u, &f, 4); return (u + 0x7fffu + ((u >> 16) & 1u)) >> 16; }
#else
HD unsigned f2bf(float f) { return (unsigned)__builtin_bit_cast(unsigned short, (__bf16)f); }
#endif
#ifdef HOST_TEST
HD unsigned pk2(float lo, float hi) { return f2bf(lo) | (f2bf(hi) << 16); }
#else
typedef __bf16 hwbf16x2 __attribute__((ext_vector_type(2)));
typedef float hwf32x2 __attribute__((ext_vector_type(2)));
HD unsigned pk2(float lo, float hi) { return __builtin_bit_cast(unsigned, __builtin_convertvector((hwf32x2){lo, hi}, hwbf16x2)); }
#endif
HD float bf2f(bf16_t b) { unsigned u = (unsigned)b << 16; float f; __builtin_memcpy(&f, &u, 4); return f; }
#ifdef HOST_TEST
DEV float sigmoid_f(float x) { return 1.0f / (1.0f + expf(-x)); }
DEV float silu_f(float x) { return x / (1.0f + expf(-x)); }
#else
DEV float fexp(float x) { return __builtin_amdgcn_exp2f(x * 1.4426950408889634f); }
DEV float sigmoid_f(float x) { return __builtin_amdgcn_rcpf(1.0f + fexp(-x)); }
DEV float silu_f(float x) { return x * __builtin_amdgcn_rcpf(1.0f + fexp(-x)); }
#endif
DEV float softplus_f(float x) { return x > 20.f ? x : log1pf(expf(x)); }

struct Args { const float* in[N_IN]; float* out; unsigned char* ws; int ph_lo, ph_hi; };
#ifdef HOST_TEST
typedef const Args CArgs;
#else
typedef const __attribute__((address_space(4))) Args CArgs;
#endif
#define WSF(off) ((float*)(a.ws + (off)))
#define PROJROW(t) ((const bf16_t*)(a.ws + WS_PROJ) + (size_t)(t) * PTP)
#define LP(idx, per) (a.in[idx] + (size_t)l * (per))

DEV void hb_row(const float* x, bf16_t* o, ss_t* ss_out, int lane) {
    float ss = 0.f;
    for (int i = lane * 4; i < D; i += WAVE * 4) { const f32x4 v = *(const f32x4*)(x + i); ss += (v[0] * v[0] + v[1] * v[1]) + (v[2] * v[2] + v[3] * v[3]);
        unsigned* op = (unsigned*)(o + i); op[0] = pk2(v[0], v[1]); op[1] = pk2(v[2], v[3]); }
    ss = wave_sum(ss); if (lane == 0) *ss_out = (ss_t)(ss * SS_FIX);
}
DEV void final_row(const bf16_t* h, const float* w, float ss  , float* o, int lane) {
    const float r = 1.0f / sqrtf(ss * (1.0f / D) + 1e-6f);
    for (int i = lane * 4; i < D; i += WAVE * 4) { const unsigned* hp = (const unsigned*)(h + i); const unsigned h0 = hp[0], h1 = hp[1]; const f32x4 g = *(const f32x4*)(w + i); f32x4 y;
        unsigned u0 = h0 << 16, u1 = h0 & 0xffff0000u, u2 = h1 << 16, u3 = h1 & 0xffff0000u; float f0, f1, f2, f3; __builtin_memcpy(&f0, &u0, 4); __builtin_memcpy(&f1, &u1, 4); __builtin_memcpy(&f2, &u2, 4); __builtin_memcpy(&f3, &u3, 4);
        y[0] = f0 * r * g[0]; y[1] = f1 * r * g[1]; y[2] = f2 * r * g[2]; y[3] = f3 * r * g[3]; *(f32x4*)(o + i) = y; }
}
DEV void rms_row_bf16(const float* x, const float* w, bf16_t* o, int lane) {
    float ss = 0.f;
    for (int i = lane * 4; i < D; i += WAVE * 4) { const f32x4 v = *(const f32x4*)(x + i); ss += (v[0] * v[0] + v[1] * v[1]) + (v[2] * v[2] + v[3] * v[3]); }
    const float r = 1.0f / sqrtf(wave_sum(ss) * (1.0f / D) + 1e-6f);
    for (int i = lane * 4; i < D; i += WAVE * 4) { const f32x4 v = *(const f32x4*)(x + i), g = *(const f32x4*)(w + i);
        unsigned* op = (unsigned*)(o + i); op[0] = pk2(v[0] * r * g[0], v[1] * r * g[1]); op[1] = pk2(v[2] * r * g[2], v[3] * r * g[3]); }
}
DEV void rms_row_f32(const float* x, const float* w, float* o, int lane) {
    float ss = 0.f;
    for (int i = lane * 4; i < D; i += WAVE * 4) { const f32x4 v = *(const f32x4*)(x + i); ss += (v[0] * v[0] + v[1] * v[1]) + (v[2] * v[2] + v[3] * v[3]); }
    const float r = 1.0f / sqrtf(wave_sum(ss) * (1.0f / D) + 1e-6f);
    for (int i = lane * 4; i < D; i += WAVE * 4) { const f32x4 v = *(const f32x4*)(x + i), g = *(const f32x4*)(w + i);
        f32x4 y; y[0] = v[0] * r * g[0]; y[1] = v[1] * r * g[1]; y[2] = v[2] * r * g[2]; y[3] = v[3] * r * g[3]; *(f32x4*)(o + i) = y; }
}

DEV float conv4(const bf16_t* projrow_t, int col, const float* w, int c, int wstride, int t) {
    float acc = 0.f;
#pragma unroll
    for (int j = 0; j < 4; ++j) { const int tt = t - 3 + j; if (tt >= 0) acc += w[j * wstride + c] * bf2f(projrow_t[(ptrdiff_t)(j - 3) * PTP + col]); }
    return acc;
}

#ifdef HOST_TEST
static const float THETA[32] = {
#else
__device__ const float THETA[32] = {
#endif
    1.000000000e+00f, 7.429639101e-01f, 5.519954562e-01f, 4.101127088e-01f, 3.046989739e-01f, 2.263803482e-01f, 1.681924462e-01f, 1.249609292e-01f, 9.284145385e-02f, 6.897785515e-02f,
    5.124806613e-02f, 3.807546571e-02f, 2.828869782e-02f, 2.101748064e-02f, 1.561523322e-02f, 1.160155423e-02f, 8.619536646e-03f, 6.404003594e-03f, 4.757945426e-03f, 3.534980817e-03f,
    2.626363887e-03f, 1.951293205e-03f, 1.449740841e-03f, 1.077104942e-03f, 8.002503891e-04f, 5.945570301e-04f, 4.417345626e-04f, 3.281927784e-04f, 2.438354713e-04f, 1.811609109e-04f,
    1.345960627e-04f, 9.999999747e-05f };

#ifndef HOST_TEST
namespace pg8 {
#define PG8_LAS __attribute__((address_space(3)))
typedef short bf16x8 __attribute__((ext_vector_type(8)));
typedef unsigned u32x4 __attribute__((ext_vector_type(4)));
constexpr int BM = 256, BK = 64, HALF = 128, HTB = HALF * BK * 2, STAGE_BYTES = 8 * HTB, NXCD = 8, WGM = 8;
__host__ __device__ __forceinline__ int lds_byte(int r, int c) { const int st = (r >> 4) * 2 + (c >> 5), rr = r & 15, cc = c & 31, ob = rr * 64 + cc * 2; return st * 1024 + (ob ^ (((ob >> 9) & 1) << 5)); }
__host__ __device__ __forceinline__ void stage_rc(int b, int& R, int& C) { const int st = b / 1024, sb = b % 1024, swz = sb ^ (((sb >> 9) & 1) << 5); R = (st >> 1) * 16 + swz / 64; C = (st & 1) * 32 + (swz % 64) / 2; }
__host__ __device__ __forceinline__ int perm32(int rho) { const int n = rho >> 4, i = rho & 15; return 8 * (i >> 2) + 4 * n + (i & 3); }
struct Unit { int pm, pn; };
struct Gemm { const bf16_t* A; const bf16_t* Bt; };
template <int M, int N> struct StaticOrder {
    static constexpr int nM = M / BM, nN = N / BM, nwg = nM * nN; int G, c;
    __device__ void init(int G_, int c_) { G = G_; c = c_; }
    __device__ bool next(int i, Unit& u) const {
        const long L = (long)i * G + c; if (L >= nwg) return false;
        int wgid = (int)L; { const int q = nwg / NXCD, r = nwg % NXCD, xcd = wgid % NXCD, off = wgid / NXCD; wgid = (xcd < r ? xcd * (q + 1) : r * (q + 1) + (xcd - r) * q) + off; }
        const int nig = WGM * nN, gid = wgid / nig, fm = gid * WGM, gsz = (nM - fm) < WGM ? (nM - fm) : WGM;
        u.pm = fm + ((wgid % nig) % gsz); u.pn = (wgid % nig) / gsz; return true;
    }
    __device__ __forceinline__ void a_ready(const Unit&) const {}
    __device__ __forceinline__ void done(const Unit&) const {}
};
__device__ __forceinline__ unsigned cvt_pk_bf16(float lo, float hi) { unsigned r; asm volatile("v_cvt_pk_bf16_f32 %0, %1, %2" : "=v"(r) : "v"(lo), "v"(hi)); return r; }
struct EpiStoreF32 {
    static constexpr bool PERM = false, AFTER_DRAIN = false; float* O; int ldc;
    __device__ __forceinline__ void operator()(const f32x4 (&acc)[2][2][4][2], const Unit& u, int wr, int wc, int fr, int fq) const {
        const int row0 = u.pm * BM + wr * 64 + fr, col0 = u.pn * BM + wc * 32 + 4 * fq;
#pragma unroll
        for (int ai = 0; ai < 2; ++ai)
#pragma unroll
            for (int m = 0; m < 4; ++m) { float* rowp = O + (size_t)(row0 + ai * HALF + m * 16) * ldc + col0;
#pragma unroll
                for (int bj = 0; bj < 2; ++bj)
#pragma unroll
                    for (int n = 0; n < 2; ++n) *(f32x4*)(rowp + bj * HALF + n * 16) = acc[ai][bj][m][n]; }
    }
};
template <bool BASE_F32> struct EpiRes {
    static constexpr bool PERM = true, AFTER_DRAIN = false; const void* B; bf16_t* O; int ldc; ss_t* SS;
    __device__ __forceinline__ void operator()(const f32x4 (&acc)[2][2][4][2], const Unit& u, int wr, int wc, int fr, int fq) const {
        const int row0 = u.pm * BM + wr * 64 + fr, col0 = u.pn * BM + wc * 32 + 8 * fq;
#pragma unroll
        for (int ai = 0; ai < 2; ++ai)
#pragma unroll
            for (int mp = 0; mp < 4; mp += 2) {
                f32x4 b[2][2][2];
#pragma unroll
                for (int mm = 0; mm < 2; ++mm) { const size_t ro = (size_t)(row0 + ai * HALF + (mp + mm) * 16) * ldc + col0;
#pragma unroll
                    for (int bj = 0; bj < 2; ++bj) {
                        if (BASE_F32) { const float* bp = (const float*)B + ro + bj * HALF; b[mm][bj][0] = *(const f32x4*)bp; b[mm][bj][1] = *(const f32x4*)(bp + 4); }
                        else { const u32x4 w = *(const u32x4*)((const bf16_t*)B + ro + bj * HALF);
                            b[mm][bj][0] = (f32x4){__uint_as_float(w.x << 16), __uint_as_float(w.x & 0xffff0000u), __uint_as_float(w.y << 16), __uint_as_float(w.y & 0xffff0000u)};
                            b[mm][bj][1] = (f32x4){__uint_as_float(w.z << 16), __uint_as_float(w.z & 0xffff0000u), __uint_as_float(w.w << 16), __uint_as_float(w.w & 0xffff0000u)}; } } }
#pragma unroll
                for (int mm = 0; mm < 2; ++mm) { const int m = mp + mm; bf16_t* rowp = O + (size_t)(row0 + ai * HALF + m * 16) * ldc + col0; float ss = 0.f;
#pragma unroll
                    for (int bj = 0; bj < 2; ++bj) { const f32x4 h0 = b[mm][bj][0] + acc[ai][bj][m][0], h1 = b[mm][bj][1] + acc[ai][bj][m][1];
                        ss += ((h0[0] * h0[0] + h0[1] * h0[1]) + (h0[2] * h0[2] + h0[3] * h0[3])) + ((h1[0] * h1[0] + h1[1] * h1[1]) + (h1[2] * h1[2] + h1[3] * h1[3]));
                        u32x4 w; w.x = cvt_pk_bf16(h0[0], h0[1]); w.y = cvt_pk_bf16(h0[2], h0[3]); w.z = cvt_pk_bf16(h1[0], h1[1]); w.w = cvt_pk_bf16(h1[2], h1[3]); *(u32x4*)(rowp + bj * HALF) = w; }
                    ss += __shfl_xor(ss, 16); ss += __shfl_xor(ss, 32);
                    if (fq == 0) atomicAdd(SS + row0 + ai * HALF + m * 16, (ss_t)(ss * SS_FIX)); } }
    }
};
template <bool SQRELU> struct EpiBf16 {
    static constexpr bool PERM = true, AFTER_DRAIN = false; bf16_t* O; int ldc; const ss_t* SS;
    __device__ __forceinline__ void operator()(const f32x4 (&acc)[2][2][4][2], const Unit& u, int wr, int wc, int fr, int fq) const {
        const int row0 = u.pm * BM + wr * 64 + fr, col0 = u.pn * BM + wc * 32 + 8 * fq;
        ss_t ssv[2][4];
#pragma unroll
        for (int ai = 0; ai < 2; ++ai)
#pragma unroll
            for (int m = 0; m < 4; ++m) ssv[ai][m] = SS[row0 + ai * HALF + m * 16];
        asm volatile("" ::: "memory");
#pragma unroll
        for (int ai = 0; ai < 2; ++ai)
#pragma unroll
            for (int m = 0; m < 4; ++m) { bf16_t* rowp = O + (size_t)(row0 + ai * HALF + m * 16) * ldc + col0; const float rs = __builtin_amdgcn_rsqf((float)ssv[ai][m] * (SS_INV / D) + 1e-6f);
#pragma unroll
                for (int bj = 0; bj < 2; ++bj) { f32x4 v0 = acc[ai][bj][m][0] * rs, v1 = acc[ai][bj][m][1] * rs;
                    if (SQRELU) {
#pragma unroll
                        for (int j = 0; j < 4; ++j) { const float p0 = fmaxf(v0[j], 0.f), p1 = fmaxf(v1[j], 0.f); v0[j] = p0 * p0; v1[j] = p1 * p1; } }
                    u32x4 w; w.x = cvt_pk_bf16(v0[0], v0[1]); w.y = cvt_pk_bf16(v0[2], v0[3]); w.z = cvt_pk_bf16(v1[0], v1[1]); w.w = cvt_pk_bf16(v1[2], v1[3]);
                    *(u32x4*)(rowp + bj * HALF) = w; } }
    }
};

template <int K, class Epi, class Sched, bool ALIGN_EPI = false>
__device__ __forceinline__ void gemm_phase(PG8_LAS unsigned char* lds, const Gemm g, const Sched& S, const Epi& E, const int tid) {
    const int wid = __builtin_amdgcn_readfirstlane(tid >> 6), lane = tid & 63, wr = wid >> 2, wc = wid & 3, fr = lane & 15, fq = lane >> 4;
    constexpr int nt = K / BK;
    unsigned voffA[2], voffB[2];
#pragma unroll
    for (int i = 0; i < 2; ++i) { int R, C; stage_rc(tid * 16 + i * 8192, R, C); const int Rb = Epi::PERM ? ((R & ~31) + perm32(R & 31)) : R;
        voffA[i] = (unsigned)(R * K + C) * 2u; voffB[i] = (unsigned)(Rb * K + C) * 2u; }
    const size_t kstep = (size_t)(BK * 2);
    const size_t hstep = (size_t)HALF * K * 2;
    const size_t tstep = 2 * hstep;
    const unsigned ldsw = (unsigned)wid * 1024u;
    const int aoff = lds_byte(wr * 64 + fr, fq * 8), boff = lds_byte(wc * 32 + fr, fq * 8);
#define PG8_SA(b, h) (((b) * 2 + (h)) * HTB)
#define PG8_SB(b, h) ((4 + (b) * 2 + (h)) * HTB)
#define PG8_STAGE(bufoff, gbase, voff) do { _Pragma("unroll") for (int _i = 0; _i < 2; ++_i) \
        __builtin_amdgcn_global_load_lds((const unsigned*)((const char*)(gbase) + (voff)[_i]), (PG8_LAS unsigned*)(lds + (bufoff) + ldsw + _i * 8192), 16, 0, 0); } while (0)
#define PG8_LDA(dst, b, h) do { _Pragma("unroll") for (int m = 0; m < 4; ++m) _Pragma("unroll") for (int k = 0; k < 2; ++k) dst[m][k] = *(const PG8_LAS bf16x8*)(lds + PG8_SA(b, h) + aoff + m * 2048 + k * 1024); } while (0)
#define PG8_LDB(dst, b, h) do { _Pragma("unroll") for (int n = 0; n < 2; ++n) _Pragma("unroll") for (int k = 0; k < 2; ++k) dst[n][k] = *(const PG8_LAS bf16x8*)(lds + PG8_SB(b, h) + boff + n * 2048 + k * 1024); } while (0)
#define PG8_MMA(ai, bj, At, Bt) do { __builtin_amdgcn_s_setprio(1); _Pragma("unroll") for (int m = 0; m < 4; ++m) _Pragma("unroll") for (int n = 0; n < 2; ++n) _Pragma("unroll") for (int k = 0; k < 2; ++k) \
        acc[ai][bj][m][n] = __builtin_amdgcn_mfma_f32_16x16x32_bf16(Bt[n][k], At[m][k], acc[ai][bj][m][n], 0, 0, 0); __builtin_amdgcn_s_setprio(0); } while (0)
#define PG8_WAIT_V(n) asm volatile("s_waitcnt vmcnt(" #n ")" ::: "memory")
#define PG8_WAIT_L(n) asm volatile("s_waitcnt lgkmcnt(" #n ")" ::: "memory")
#define PG8_BAR __builtin_amdgcn_s_barrier()
#define PG8_SCHED __builtin_amdgcn_sched_barrier(0)
    Unit cur, nxt; int ui = 0;
    if (!S.next(0, cur)) return;
    f32x4 acc[2][2][4][2];
#pragma unroll
    for (int a = 0; a < 2; ++a)
#pragma unroll
        for (int b = 0; b < 2; ++b)
#pragma unroll
            for (int m = 0; m < 4; ++m)
#pragma unroll
                for (int n = 0; n < 2; ++n) acc[a][b][m][n] = (f32x4){0.f, 0.f, 0.f, 0.f};
    bf16x8 At[4][2], B0[2][2], B1[2][2];
    const char* cA = (const char*)g.A + (size_t)cur.pm * tstep; const char* cB = (const char*)g.Bt + (size_t)cur.pn * tstep;
    S.a_ready(cur);
    PG8_STAGE(PG8_SB(0, 0), cB, voffB); PG8_STAGE(PG8_SB(0, 1), cB + hstep, voffB); PG8_STAGE(PG8_SA(0, 0), cA, voffA); PG8_STAGE(PG8_SA(0, 1), cA + hstep, voffA);
    if (wr == 1) PG8_BAR;
    PG8_WAIT_V(2); PG8_BAR;
    PG8_STAGE(PG8_SB(1, 0), cB + kstep, voffB); PG8_STAGE(PG8_SA(1, 0), cA + kstep, voffA); PG8_STAGE(PG8_SB(1, 1), cB + hstep + kstep, voffB);
    PG8_WAIT_V(6); PG8_BAR;
    for (;;) {
        const bool has_next = S.next(ui + 1, nxt);
        const char* nA = has_next ? (const char*)g.A + (size_t)nxt.pm * tstep : cA; const char* nB = has_next ? (const char*)g.Bt + (size_t)nxt.pn * tstep : cB;
        for (int t = 0; t < nt; t += 2) {
            const bool last = (t == nt - 2);
            const char* a1 = cA + (size_t)(t + 1) * kstep;
            const char* a2 = last ? nA : cA + (size_t)(t + 2) * kstep; const char* b2 = last ? nB : cB + (size_t)(t + 2) * kstep;
            const char* a3 = a2 + kstep; const char* b3 = b2 + kstep;
            if (last && has_next) S.a_ready(nxt);
            PG8_LDB(B0, 0, 0); PG8_LDB(B1, 0, 1); PG8_SCHED; PG8_LDA(At, 0, 0); PG8_STAGE(PG8_SA(1, 1), a1 + hstep, voffA);
            PG8_WAIT_V(8); PG8_WAIT_L(0); PG8_BAR; PG8_MMA(0, 0, At, B0); PG8_MMA(0, 1, At, B1); PG8_BAR; PG8_SCHED;
            PG8_LDA(At, 0, 1); PG8_STAGE(PG8_SB(0, 0), b2, voffB); PG8_STAGE(PG8_SB(0, 1), b2 + hstep, voffB); PG8_STAGE(PG8_SA(0, 0), a2, voffA);
            PG8_WAIT_V(8); PG8_WAIT_L(0); PG8_BAR; PG8_MMA(1, 0, At, B0); PG8_MMA(1, 1, At, B1); PG8_BAR; PG8_SCHED;
            PG8_LDB(B0, 1, 0); PG8_LDB(B1, 1, 1); PG8_SCHED; PG8_LDA(At, 1, 0); PG8_STAGE(PG8_SA(0, 1), a2 + hstep, voffA);
            PG8_WAIT_V(8); PG8_WAIT_L(0); PG8_BAR; PG8_MMA(0, 0, At, B0); PG8_MMA(0, 1, At, B1); PG8_BAR; PG8_SCHED;
            PG8_LDA(At, 1, 1); PG8_STAGE(PG8_SB(1, 0), b3, voffB); PG8_STAGE(PG8_SB(1, 1), b3 + hstep, voffB); PG8_STAGE(PG8_SA(1, 0), a3, voffA);
            PG8_WAIT_V(8); PG8_WAIT_L(0); PG8_BAR; PG8_MMA(1, 0, At, B0); PG8_MMA(1, 1, At, B1); PG8_BAR; PG8_SCHED;
        }
        if constexpr (ALIGN_EPI) { if (wr == 0) PG8_BAR; }
        E(acc, cur, wr, wc, fr, fq); S.done(cur);
        if (!has_next) break;
#pragma unroll
        for (int a = 0; a < 2; ++a)
#pragma unroll
            for (int b = 0; b < 2; ++b)
#pragma unroll
                for (int m = 0; m < 4; ++m)
#pragma unroll
                    for (int n = 0; n < 2; ++n) acc[a][b][m][n] = (f32x4){0.f, 0.f, 0.f, 0.f};
        cur = nxt; cA = nA; cB = nB; ++ui;
        if constexpr (ALIGN_EPI) { if (wr == 1) PG8_BAR; }
    }
    PG8_WAIT_V(0);
    if constexpr (!ALIGN_EPI) { if (wr == 0) PG8_BAR; }
    PG8_BAR;
#undef PG8_SA
#undef PG8_SB
#undef PG8_STAGE
#undef PG8_LDA
#undef PG8_LDB
#undef PG8_MMA
#undef PG8_WAIT_V
#undef PG8_WAIT_L
#undef PG8_BAR
#undef PG8_SCHED
}
}

#define LAS __attribute__((address_space(3)))
#define GAS __attribute__((address_space(1)))
typedef unsigned v4u __attribute__((ext_vector_type(4)));
constexpr int NWAVES = 8, LDS_BYTES = 163840, MISC_OFF = LDS_BYTES - 512;
#define LDS_WAIT() asm volatile("s_waitcnt lgkmcnt(0)" ::: "memory")

__device__ __forceinline__ void transpose_item(const float* W, int K, int N, int Npad, bf16_t* WT, LAS float* scr, int item, int lane, const float* kscale = nullptr) {
    const int nblk = Npad / 32, kb = item / nblk, nb = item % nblk, k0 = 64 * kb, n0 = 32 * nb;
    const int n = n0 + (lane & 31); const bool ok = n < N;
    float v[32];
    const float* src = W + (size_t)(k0 + (lane >> 5)) * N + n;
#pragma unroll
    for (int i = 0; i < 32; ++i) v[i] = ok ? src[(size_t)(2 * i) * N] : 0.f;
    if (kscale) {
#pragma unroll
        for (int i = 0; i < 32; ++i) v[i] *= kscale[k0 + 2 * i + (lane >> 5)]; }
#pragma unroll
    for (int i = 0; i < 32; ++i) scr[(2 * i + (lane >> 5)) * 33 + (lane & 31)] = v[i];
    LDS_WAIT(); asm volatile("" ::: "memory");
    const int c = lane & 7;
#pragma unroll
    for (int j = 0; j < 4; ++j) { const int nn = (lane >> 3) + 8 * j; const LAS float* s = scr + (8 * c) * 33 + nn;
        v4u o; o.x = pk2(s[0 * 33], s[1 * 33]); o.y = pk2(s[2 * 33], s[3 * 33]); o.z = pk2(s[4 * 33], s[5 * 33]); o.w = pk2(s[6 * 33], s[7 * 33]);
        *(GAS v4u*)(WT + (size_t)(n0 + nn) * K + k0 + 8 * c) = o; }
    LDS_WAIT(); asm volatile("" ::: "memory");
}


typedef short bf16x8 __attribute__((ext_vector_type(8)));
typedef short s16x4 __attribute__((ext_vector_type(4)));
typedef unsigned u32x2 __attribute__((ext_vector_type(2)));
__device__ __forceinline__ s16x4 tr16(const LAS bf16_t* p) { return __builtin_bit_cast(s16x4, __builtin_amdgcn_ds_read_tr16_b64_v4i16((LAS s16x4*)p)); }
__device__ __forceinline__ bf16x8 frag_row(const LAS bf16_t* img, int ld, int nc0, int k0, int lane) { return *(const LAS bf16x8*)(img + (nc0 + (lane & 15)) * ld + k0 + 8 * (lane >> 4)); }
__device__ __forceinline__ bf16x8 frag_tr(const LAS bf16_t* img, int ld, int nc0, int k0, int lane) {
    const int g = lane >> 4, q = (lane & 15) >> 2, p = lane & 3;
    const LAS bf16_t* ad = img + (k0 + 8 * g + q) * ld + nc0 + 4 * p;
    const s16x4 lo = tr16(ad), hi = tr16(ad + 4 * ld);
    return (bf16x8){lo[0], lo[1], lo[2], lo[3], hi[0], hi[1], hi[2], hi[3]};
}
__device__ __forceinline__ bf16x8 frag_row_g(const bf16_t* img, int ld, int nc0, int k0, int lane) { return *(const bf16x8*)(img + (size_t)(nc0 + (lane & 15)) * ld + k0 + 8 * (lane >> 4)); }
__device__ __forceinline__ bf16x8 frag_fo(const bf16_t* img, int KS, int tile, int ks, int lane) { return *(const bf16x8*)(img + ((size_t)(tile * KS + ks) * 64 + lane) * 8); }
__device__ __forceinline__ int fo_st(int tile, int KS, int k0, int g, int r) { const int k = k0 + 4 * g; return ((tile * KS + (k >> 5)) * 64 + ((k >> 3) & 3) * 16 + r) * 8 + (k & 7); }
__device__ __forceinline__ int co_off(int tj, int NI, int ti, int lane) { return ((tj * NI + ti) * 64 + lane) * 4; }
__device__ __forceinline__ int co2_off(int tj, int NP, int p, int lane) { return ((tj * NP + p) * 64 + lane) * 8; }
__device__ __forceinline__ f32x4 mfma16(bf16x8 a, bf16x8 b, f32x4 c) { return __builtin_amdgcn_mfma_f32_16x16x32_bf16(a, b, c, 0, 0, 0); }
__device__ __forceinline__ u32x2 pack4(f32x4 v) { u32x2 w; w.x = pk2(v[0], v[1]); w.y = pk2(v[2], v[3]); return w; }
__device__ __forceinline__ f32x4 unpack4(u32x2 w) { f32x4 v; v[0] = __uint_as_float(w.x << 16); v[1] = __uint_as_float(w.x & 0xffff0000u); v[2] = __uint_as_float(w.y << 16); v[3] = __uint_as_float(w.y & 0xffff0000u); return v; }
__device__ __forceinline__ void fo_st2(bf16_t* img, int tile, int KS, int ti, u32x2 a, u32x2 b, int g, int r) {
    const auto rx = __builtin_amdgcn_permlane16_swap(a.x, b.x, false, false); const auto ry = __builtin_amdgcn_permlane16_swap(a.y, b.y, false, false);
    const int k = (g & 1) ? 16 * (ti + 1) + 4 * (g - 1) : 16 * ti + 4 * g;
    *(v4u*)(img + ((tile * KS + (k >> 5)) * 64 + ((k >> 3) & 3) * 16 + r) * 8) = (v4u){rx[0], ry[0], rx[1], ry[1]};
}
__device__ __forceinline__ v4u cat2(u32x2 a, u32x2 b) { return (v4u){a.x, a.y, b.x, b.y}; }
__device__ __forceinline__ v4u fo_pair(u32x2 a, u32x2 b) { const auto rx = __builtin_amdgcn_permlane16_swap(a.x, b.x, false, false); const auto ry = __builtin_amdgcn_permlane16_swap(a.y, b.y, false, false); return (v4u){rx[0], ry[0], rx[1], ry[1]}; }
__device__ __forceinline__ int fo_off2(int tile, int KS, int ti, int g, int r) { const int k = (g & 1) ? 16 * (ti + 1) + 4 * (g - 1) : 16 * ti + 4 * g; return ((tile * KS + (k >> 5)) * 64 + ((k >> 3) & 3) * 16 + r) * 8; }
#define WG_SYNC() do { asm volatile("s_waitcnt lgkmcnt(0)" ::: "memory"); __builtin_amdgcn_s_barrier(); asm volatile("" ::: "memory"); } while (0)

__device__ __forceinline__ void ret_stage1(CArgs& a, int n, int h, LAS unsigned char* lds, int tid) {
    const int lane = tid & 63, w = __builtin_amdgcn_readfirstlane(tid >> 6), r = lane & 15, g = lane >> 4;
    constexpr int LD = 72, LDV = 136;
    LAS bf16_t* Qi = (LAS bf16_t*)lds; LAS bf16_t* Ki = Qi + 64 * LD; LAS bf16_t* Kdi = Ki + 64 * LD; LAS bf16_t* Vi = Kdi + 64 * LD; LAS bf16_t* Si = Vi + 64 * LDV;
    const int tk = n * 4 + h; const float lg2 = log2f(1.0f - exp2f(-5.0f - (float)h));
    bf16_t* QH = (bf16_t*)(a.ws + WS_RET_QH) + (size_t)tk * 4096;
    unsigned rqq[4], rkk[4]; v4u rvv[2];
#pragma unroll
    for (int ii = 0; ii < 4; ++ii) { const int idx = tid + 512 * ii, c = idx >> 5, i = idx & 31; const bf16_t* pr = PROJROW(n * 64 + c); rqq[ii] = *(const unsigned*)(pr + C_RQ + 64 * h + 2 * i); rkk[ii] = *(const unsigned*)(pr + C_RK + 64 * h + 2 * i); }
#pragma unroll
    for (int ii = 0; ii < 2; ++ii) { const int idx = tid + 512 * ii, c = idx >> 4, ch = idx & 15; rvv[ii] = *(const v4u*)(PROJROW(n * 64 + c) + C_RV + 128 * h + 8 * ch); }
#pragma unroll
    for (int ii = 0; ii < 4; ++ii) { const int idx = tid + 512 * ii;
        const int c = idx >> 5, i = idx & 31, t = n * 64 + c; float sn, cs; sincosf((float)t * THETA[i], &sn, &cs);
        const unsigned qq = rqq[ii], kk = rkk[ii];
        const float q0 = __uint_as_float(qq << 16), q1 = __uint_as_float(qq & 0xffff0000u), k0 = __uint_as_float(kk << 16), k1 = __uint_as_float(kk & 0xffff0000u);
        const float rq0 = q0 * cs - q1 * sn, rq1 = q1 * cs + q0 * sn, rk0 = (k0 * cs - k1 * sn) * 0.125f, rk1 = (k1 * cs + k0 * sn) * 0.125f;
        const float dk = exp2f(lg2 * (float)(63 - c)), dq = exp2f(lg2 * (float)(c + 1));
        *(LAS unsigned*)(Qi + c * LD + 2 * i) = pk2(rq0, rq1); *(LAS unsigned*)(Ki + c * LD + 2 * i) = pk2(rk0, rk1); *(LAS unsigned*)(Kdi + c * LD + 2 * i) = pk2(rk0 * dk, rk1 * dk);
        { const int d = 2 * i; *(unsigned*)(QH + (((c >> 4) * 2 + (d >> 5)) * 64 + ((d >> 3) & 3) * 16 + (c & 15)) * 8 + (d & 7)) = pk2(rq0 * dq, rq1 * dq); }
    }
#pragma unroll
    for (int ii = 0; ii < 2; ++ii) { const int idx = tid + 512 * ii, c = idx >> 4, ch = idx & 15; *(LAS v4u*)(Vi + c * LDV + 8 * ch) = rvv[ii]; }
    WG_SYNC();
#pragma unroll
    for (int tt = 0; tt < 2; ++tt) { const int tile = 2 * w + tt, im = tile >> 2, jc = tile & 3; f32x4 acc = {0.f, 0.f, 0.f, 0.f};
        if (jc >= im) {
#pragma unroll
            for (int k0 = 0; k0 < 64; k0 += 32) acc = mfma16(frag_row(Ki, LD, 16 * im, k0, lane), frag_row(Qi, LD, 16 * jc, k0, lane), acc);
#pragma unroll
            for (int e = 0; e < 4; ++e) { const int i = 16 * im + 4 * g + e, j = 16 * jc + r; acc[e] = j >= i ? acc[e] * exp2f(lg2 * (float)(j - i)) : 0.f; } }
        *(LAS u32x2*)(Si + (16 * jc + r) * LD + 16 * im + 4 * g) = pack4(acc); }
    WG_SYNC();
    bf16_t* YI = (bf16_t*)(a.ws + WS_RET_YI) + (size_t)tk * 8192; bf16_t* Z = (bf16_t*)(a.ws + WS_RET_Z) + (size_t)tk * 8192;
#pragma unroll
    for (int tp = 0; tp < 2; ++tp) { const int jc = w & 3; u32x2 pa[2];
#pragma unroll
        for (int t2 = 0; t2 < 2; ++t2) { const int ie = 4 * (w >> 2) + 2 * tp + t2; f32x4 acc = {0.f, 0.f, 0.f, 0.f};
#pragma unroll
            for (int k0 = 0; k0 < 64; k0 += 32) acc = mfma16(frag_tr(Vi, LDV, 16 * ie, k0, lane), frag_row(Si, LD, 16 * jc, k0, lane), acc);
            pa[t2] = pack4(acc); }
        *(v4u*)(YI + co2_off(jc, 4, 2 * (w >> 2) + tp, lane)) = cat2(pa[0], pa[1]); }
#pragma unroll
    for (int jj = 0; jj < 2; ++jj) { const int je = 2 * (w >> 1) + jj; u32x2 pa[2];
#pragma unroll
        for (int t2 = 0; t2 < 2; ++t2) { const int id = 2 * (w & 1) + t2; f32x4 acc = {0.f, 0.f, 0.f, 0.f};
#pragma unroll
            for (int k0 = 0; k0 < 64; k0 += 32) acc = mfma16(frag_tr(Kdi, LD, 16 * id, k0, lane), frag_tr(Vi, LDV, 16 * je, k0, lane), acc);
            pa[t2] = pack4(acc); }
        fo_st2(Z, je, 2, 2 * (w & 1), pa[0], pa[1], g, r); }
    WG_SYNC();
}
template <class DEC> __device__ __forceinline__ void ew_stage2(const bf16_t* Z, bf16_t* S, size_t step_stride, const DEC& dec, LAS unsigned char* lds, int tid) {
    if (tid < 64) { LAS float* DL = (LAS float*)lds; DL[tid] = dec(tid); DL[tid + 64] = dec(tid + 64);
        const int ev = tid * 8; constexpr int RD = 24;
        v4u zr[RD];
#pragma unroll
        for (int u = 0; u < RD; ++u) zr[u] = *(const v4u*)(Z + (size_t)u * step_stride + ev);
        float st[8];
#pragma unroll
        for (int e = 0; e < 8; ++e) st[e] = 0.f;
        asm volatile("s_waitcnt lgkmcnt(0)" ::: "memory");
#pragma unroll
        for (int n = 0; n < NCH; ++n) { v4u o;
#pragma unroll
            for (int e = 0; e < 4; ++e) o[e] = pk2(st[2 * e], st[2 * e + 1]);
            *(v4u*)(S + (size_t)n * step_stride + ev) = o;
            const v4u z = zr[n % RD]; const float d = DL[n];
#pragma unroll
            for (int e = 0; e < 4; ++e) { st[2 * e] = d * st[2 * e] + __uint_as_float(z[e] << 16); st[2 * e + 1] = d * st[2 * e + 1] + __uint_as_float(z[e] & 0xffff0000u); }
            if (n + RD < NCH) zr[n % RD] = *(const v4u*)(Z + (size_t)(n + RD) * step_stride + ev); } }
    WG_SYNC();
}
struct DecConst { float d; __device__ __forceinline__ float operator()(int) const { return d; } };
struct DecTable { const float* p; int stride; __device__ __forceinline__ float operator()(int n) const { return p[n * stride]; } };
__device__ __forceinline__ void ret_stage2(CArgs& a, int b, LAS unsigned char* lds, int tid) {
    const int h = b >> 4, rem0 = (b & 15) * 512; const DecConst dc{exp2f(64.0f * log2f(1.0f - exp2f(-5.0f - (float)h)))};
    ew_stage2((const bf16_t*)(a.ws + WS_RET_Z) + (size_t)h * 8192 + rem0, (bf16_t*)(a.ws + WS_RET_S) + (size_t)h * 8192 + rem0, (size_t)4 * 8192, dc, lds, tid);
}
struct Ret3In { v4u yi[2]; bf16x8 s[4][2]; bf16x8 q[2]; u32x2 gt[4]; f32x4 w[4]; };
__device__ __forceinline__ void ret3_load(CArgs& a, int l, int n, int h, int tid, Ret3In& in) {
    const int lane = tid & 63, w = __builtin_amdgcn_readfirstlane(tid >> 6), r = lane & 15, g = lane >> 4, jc = w & 3, wh = w >> 2;
    const int tk = n * 4 + h; const int t = n * 64 + 16 * jc + r;
    const bf16_t* S = (const bf16_t*)(a.ws + WS_RET_S) + (size_t)tk * 8192; const bf16_t* QH = (const bf16_t*)(a.ws + WS_RET_QH) + (size_t)tk * 4096; const bf16_t* YI = (const bf16_t*)(a.ws + WS_RET_YI) + (size_t)tk * 8192;
    const float* nw = LP(I_RNORM, 512) + h * 128; const bf16_t* pr = PROJROW(t) + C_RG + h * 128;
#pragma unroll
    for (int k = 0; k < 2; ++k) in.q[k] = frag_fo(QH, 2, jc, k, lane);
#pragma unroll
    for (int tp = 0; tp < 2; ++tp) in.yi[tp] = *(const v4u*)(YI + co2_off(jc, 4, 2 * wh + tp, lane));
#pragma unroll
    for (int tt = 0; tt < 4; ++tt) {
#pragma unroll
        for (int k = 0; k < 2; ++k) in.s[tt][k] = frag_fo(S, 2, 4 * wh + tt, k, lane);
        const int e0 = 16 * (4 * wh + tt) + 4 * g; in.gt[tt] = *(const u32x2*)(pr + e0); in.w[tt] = *(const f32x4*)(nw + e0); }
    asm volatile("" ::: "memory");
}
__device__ __forceinline__ void ret_stage3(CArgs& a, int l, int n, int h, LAS unsigned char* lds, int tid, const Ret3In& in) {
    const int lane = tid & 63, w = __builtin_amdgcn_readfirstlane(tid >> 6), r = lane & 15, g = lane >> 4, jc = w & 3, wh = w >> 2;
    const int c = 16 * jc + r, t = n * 64 + c;
    LAS float* xs = (LAS float*)lds;
    bf16_t* O = (bf16_t*)(a.ws + WS_O) + (size_t)t * D + 512 + h * 128;
    f32x4 acc[4];
#pragma unroll
    for (int tt = 0; tt < 4; ++tt) { const v4u yv = in.yi[tt >> 1]; acc[tt] = unpack4((tt & 1) ? (u32x2){yv.z, yv.w} : (u32x2){yv.x, yv.y});
#pragma unroll
        for (int k = 0; k < 2; ++k) acc[tt] = mfma16(in.s[tt][k], in.q[k], acc[tt]); }
    float s1 = 0.f;
#pragma unroll
    for (int tt = 0; tt < 4; ++tt) s1 += (acc[tt][0] + acc[tt][1]) + (acc[tt][2] + acc[tt][3]);
    s1 += __shfl_xor(s1, 16); s1 += __shfl_xor(s1, 32);
    if (g == 0) xs[w * 16 + r] = s1;
    WG_SYNC();
    const float mu = (s1 + xs[(w ^ 4) * 16 + r]) * (1.0f / 128.0f); float s2 = 0.f;
#pragma unroll
    for (int tt = 0; tt < 4; ++tt)
#pragma unroll
        for (int e = 0; e < 4; ++e) { acc[tt][e] -= mu; s2 += acc[tt][e] * acc[tt][e]; }
    s2 += __shfl_xor(s2, 16); s2 += __shfl_xor(s2, 32);
    if (g == 0) xs[128 + w * 16 + r] = s2;
    WG_SYNC();
    const float rs = 1.0f / sqrtf((s2 + xs[128 + (w ^ 4) * 16 + r]) * (1.0f / 128.0f) + 1e-6f);
#pragma unroll
    for (int tt = 0; tt < 4; ++tt) { const int e0 = 16 * (4 * wh + tt) + 4 * g; const f32x4 gt = unpack4(in.gt[tt]); const f32x4 wv = in.w[tt]; f32x4 y;
#pragma unroll
        for (int e = 0; e < 4; ++e) y[e] = acc[tt][e] * rs * wv[e] * silu_f(gt[e]);
        *(u32x2*)(O + e0) = pack4(y); }
    WG_SYNC();
}

constexpr int RW_LD = 72;
constexpr int RWO_V = 0, RWO_IMG = 9216  , RWO_XI = 36864  , RWO_UI = 55296, RWO_CUMC = 64512, RWO_WT = 65536  , RWO_AM = 65536, RWO_TRI = 82944,
              RWO_RHST = 110592, RWO_AI = 143360, RWO_DI = 152576;
constexpr int RWO_LW = 9216, RWO_LIN = 82944;
__device__ __forceinline__ float ftanh(float x) { return 1.0f - 2.0f * __builtin_amdgcn_rcpf(1.0f + fexp(2.0f * x)); }
__device__ __forceinline__ float fsoftplus(float x) { return x > 20.f ? x : __builtin_amdgcn_logf(1.0f + fexp(x)) * 0.6931471805599453f; }
struct Rw1In { v4u cu, pv; u32x2 cw, ca, pw, pa; u32x2 cg[3], pg[3]; };
__device__ __forceinline__ void rw1_load(CArgs& a, int n, int h, int tid, Rw1In& in) {
    asm volatile("" : "+v"(tid));
    const int c = tid >> 3, kg = tid & 7, t = n * 64 + c, ch0 = 64 * h + 8 * kg;
    const bf16_t* p1 = PROJROW(t) + C_RW; const bf16_t* p0 = p1 - PTP; const bool hp = t > 0;
    in.cu = *(const v4u*)(p1 + 1024 + ch0); in.cw = *(const u32x2*)(p1 + 1536 + 4 * kg); in.ca = *(const u32x2*)(p1 + 1568 + 4 * kg);
#pragma unroll
    for (int q = 0; q < 3; ++q) in.cg[q] = *(const u32x2*)(p1 + 1600 + 12 * kg + 4 * q);
    in.pv = (v4u){0u, 0u, 0u, 0u}; in.pw = (u32x2){0u, 0u}; in.pa = in.pw; in.pg[0] = in.pw; in.pg[1] = in.pw; in.pg[2] = in.pw;
    if (hp) { in.pv = *(const v4u*)(p0 + 1024 + ch0); in.pw = *(const u32x2*)(p0 + 1536 + 4 * kg); in.pa = *(const u32x2*)(p0 + 1568 + 4 * kg);
#pragma unroll
        for (int q = 0; q < 3; ++q) in.pg[q] = *(const u32x2*)(p0 + 1600 + 12 * kg + 4 * q); }
    asm volatile("" ::: "memory");
}
struct Rw1Par { f32x4 m0, m1, mg[3], mw, ma, lwv, lav, lgv[3]; };
__device__ __forceinline__ void rw1_par(CArgs& a, int l, int h, int tid, Rw1Par& in) {
    asm volatile("" : "+v"(tid));
    const int kg = tid & 7; const float* mu = LP(I_RWMU, 1696); const float* m = mu + 1024 + 64 * h + 8 * kg; in.m0 = *(const f32x4*)m; in.m1 = *(const f32x4*)(m + 4);
#pragma unroll
    for (int q = 0; q < 3; ++q) in.mg[q] = *(const f32x4*)(mu + 1600 + 12 * kg + 4 * q);
    in.mw = *(const f32x4*)(mu + 1536 + 4 * kg); in.ma = *(const f32x4*)(mu + 1568 + 4 * kg);
    const int j = tid >> 4, k4 = (tid & 15) * 4;
    in.lwv = *(const f32x4*)(LP(I_RWWUP, 32 * 512) + j * 512 + 64 * h + k4); in.lav = *(const f32x4*)(LP(I_RWAUP, 32 * 512) + j * 512 + 64 * h + k4);
#pragma unroll
    for (int q = 0; q < 3; ++q) in.lgv[q] = *(const f32x4*)(LP(I_RWGUP, 96 * 512) + (32 * q + j) * 512 + 64 * h + k4);
    asm volatile("" ::: "memory");
}
__device__ __forceinline__ void rw_stage1(CArgs& a, int l, int n, int h, LAS unsigned char* lds, int tid, Rw1In& pre, Rw1Par& par, const int nxt, const int stop = 99) {
    const int w = __builtin_amdgcn_readfirstlane(tid >> 6), tk = n * 8 + h;
    int lane, r, g, c, kg, t;
#define RW_IDX() do { int tl_ = tid; asm volatile("" : "+v"(tl_)); lane = tl_ & 63; r = lane & 15; g = lane >> 4; c = tl_ >> 3; kg = tl_ & 7; t = n * 64 + c; } while (0)
    RW_IDX();
    LAS bf16_t* Vi = (LAS bf16_t*)(lds + RWO_V);
    LAS bf16_t* RHi = (LAS bf16_t*)(lds + RWO_IMG); LAS bf16_t* BTi = RHi + 64 * RW_LD; LAS bf16_t* KTi = BTi + 64 * RW_LD; LAS bf16_t* KHi = KTi + 64 * RW_LD; LAS bf16_t* BMi = KHi + 64 * RW_LD; LAS bf16_t* KMi = BMi + 64 * RW_LD;
    LAS bf16_t* XI = (LAS bf16_t*)(lds + RWO_XI);
    LAS bf16_t* UI = (LAS bf16_t*)(lds + RWO_UI);
    LAS float* CUMC = (LAS float*)(lds + RWO_CUMC); LAS float* WT = (LAS float*)(lds + RWO_WT); LAS float* AM = (LAS float*)(lds + RWO_AM);
    LAS bf16_t* BMI = (LAS bf16_t*)(lds + RWO_TRI); LAS bf16_t* PBI = BMI + 64 * RW_LD; LAS bf16_t* PKI = PBI + 64 * RW_LD;
    LAS float* RHST = (LAS float*)(lds + RWO_RHST);
    LAS bf16_t* AI = (LAS bf16_t*)(lds + RWO_AI);
    LAS bf16_t* DI = (LAS bf16_t*)(lds + RWO_DI);
    LAS float* LW = (LAS float*)(lds + RWO_LW); LAS float* LA = LW + 4096; LAS float* LG = LA + 4096;
    LAS bf16_t* WLi = (LAS bf16_t*)(lds + RWO_LIN); LAS bf16_t* ALi = WLi + 64 * 40; LAS bf16_t* GLi = ALi + 64 * 40; LAS bf16_t* WUPi = GLi + 64 * 104; LAS bf16_t* AUPi = WUPi + 32 * RW_LD; LAS bf16_t* GUPi = AUPi + 32 * RW_LD;
    const float* mu = LP(I_RWMU, 1696); const bf16_t* p1 = PROJROW(t) + C_RW; const bf16_t* p0 = p1 - PTP; bool hp = t > 0;
    float vv[8];
    { const v4u cu = pre.cu, pv = pre.pv;
      const f32x4 m0 = par.m0, m1 = par.m1;
      const u32x2 cw = pre.cw, ca = pre.ca, pw = pre.pw, pa = pre.pa;
      u32x2 cg[3], pg[3]; f32x4 mg[3];
#pragma unroll
      for (int q = 0; q < 3; ++q) { cg[q] = pre.cg[q]; pg[q] = pre.pg[q]; mg[q] = par.mg[q]; }
      const f32x4 mw = par.mw, ma = par.ma;
      const int j = tid >> 4, k4 = (tid & 15) * 4;
      const f32x4 lwv = par.lwv, lav = par.lav; f32x4 lgv[3];
#pragma unroll
      for (int q = 0; q < 3; ++q) lgv[q] = par.lgv[q];
      { v4u o;
#pragma unroll
        for (int u = 0; u < 4; ++u) { const unsigned cww = cu[u], pww = pv[u]; const float c0 = __uint_as_float(cww << 16), c1 = __uint_as_float(cww & 0xffff0000u), q0 = __uint_as_float(pww << 16), q1 = __uint_as_float(pww & 0xffff0000u);
            const float mA = u < 2 ? m0[2 * u] : m1[2 * u - 4], mB = u < 2 ? m0[2 * u + 1] : m1[2 * u - 3];
            vv[2 * u] = c0 + (q0 - c0) * mA; vv[2 * u + 1] = c1 + (q1 - c1) * mB; o[u] = pk2(vv[2 * u], vv[2 * u + 1]); }
        *(LAS v4u*)(Vi + c * RW_LD + 8 * kg) = o; }
      { const f32x4 cv = unpack4(cw), pvv = unpack4(pw); f32x4 x;
#pragma unroll
        for (int u = 0; u < 4; ++u) x[u] = ftanh(cv[u] + (pvv[u] - cv[u]) * mw[u]);
        *(LAS u32x2*)(WLi + c * 40 + 4 * kg) = pack4(x); }
      { const f32x4 cv = unpack4(ca), pvv = unpack4(pa); f32x4 x;
#pragma unroll
        for (int u = 0; u < 4; ++u) x[u] = cv[u] + (pvv[u] - cv[u]) * ma[u];
        *(LAS u32x2*)(ALi + c * 40 + 4 * kg) = pack4(x); }
#pragma unroll
      for (int q = 0; q < 3; ++q) { const f32x4 cv = unpack4(cg[q]), pvv = unpack4(pg[q]); f32x4 x;
#pragma unroll
          for (int u = 0; u < 4; ++u) x[u] = sigmoid_f(cv[u] + (pvv[u] - cv[u]) * mg[q][u]);
          *(LAS u32x2*)(GLi + c * 104 + 12 * kg + 4 * q) = pack4(x); }
      *(LAS u32x2*)(WUPi + j * RW_LD + k4) = pack4(lwv); *(LAS u32x2*)(AUPi + j * RW_LD + k4) = pack4(lav);
#pragma unroll
      for (int q = 0; q < 3; ++q) *(LAS u32x2*)(GUPi + (32 * q + j) * RW_LD + k4) = pack4(lgv[q]); }
    WG_SYNC();
    if (stop <= 0) return;
    RW_IDX();
#pragma unroll
    for (int tt = 0; tt < 2; ++tt) { const int tile = 2 * w + tt, ik = tile >> 2, jc = tile & 3;
        f32x4 aw = {0.f, 0.f, 0.f, 0.f}, aa = aw, ag = aw;
        aw = mfma16(frag_tr(WUPi, RW_LD, 16 * ik, 0, lane), frag_row(WLi, 40, 16 * jc, 0, lane), aw);
        aa = mfma16(frag_tr(AUPi, RW_LD, 16 * ik, 0, lane), frag_row(ALi, 40, 16 * jc, 0, lane), aa);
#pragma unroll
        for (int k0 = 0; k0 < 96; k0 += 32) ag = mfma16(frag_tr(GUPi, RW_LD, 16 * ik, k0, lane), frag_row(GLi, 104, 16 * jc, k0, lane), ag);
        const int o = (16 * jc + r) * 64 + 16 * ik + 4 * g; *(LAS f32x4*)(LW + o) = aw; *(LAS f32x4*)(LA + o) = aa; *(LAS f32x4*)(LG + o) = ag; }
    WG_SYNC();
    if (stop <= 1) return;
    RW_IDX();
    p1 = PROJROW(t) + C_RW; p0 = p1 - PTP; hp = t > 0;
    float rr[8], kk[8], bb[8], kt[8], lwd[8], cum[8];
    { const int ch0 = 64 * h + 8 * kg; float ss = 0.f, rk = 0.f; float gt[8];
      const v4u cr = *(const v4u*)(p1 + ch0), ck = *(const v4u*)(p1 + 512 + ch0); v4u qr = {0u, 0u, 0u, 0u}, qk = qr; if (hp) { qr = *(const v4u*)(p0 + ch0); qk = *(const v4u*)(p0 + 512 + ch0); }
      float pw0[8], pa0[8], pkk[8], pka[8], prk[8], pmr[8], pmk[8];
#pragma unroll
      for (int q = 0; q < 2; ++q) { const f32x4 x0 = *(const f32x4*)(LP(I_RWW0, 512) + ch0 + 4 * q), x1 = *(const f32x4*)(LP(I_RWA0, 512) + ch0 + 4 * q), x2 = *(const f32x4*)(LP(I_RWKK, 512) + ch0 + 4 * q), x3 = *(const f32x4*)(LP(I_RWKA, 512) + ch0 + 4 * q),
                                                 x4 = *(const f32x4*)(LP(I_RWRK, 512) + ch0 + 4 * q), x5 = *(const f32x4*)(mu + ch0 + 4 * q), x6 = *(const f32x4*)(mu + 512 + ch0 + 4 * q);
#pragma unroll
          for (int e = 0; e < 4; ++e) { pw0[4 * q + e] = x0[e]; pa0[4 * q + e] = x1[e]; pkk[4 * q + e] = x2[e]; pka[4 * q + e] = x3[e]; prk[4 * q + e] = x4[e]; pmr[4 * q + e] = x5[e]; pmk[4 * q + e] = x6[e]; } }
#pragma unroll
      for (int u = 0; u < 8; ++u) { const unsigned crw = cr[u >> 1], ckw = ck[u >> 1], qrw = qr[u >> 1], qkw = qk[u >> 1];
          const float curR = (u & 1) ? __uint_as_float(crw & 0xffff0000u) : __uint_as_float(crw << 16), curK = (u & 1) ? __uint_as_float(ckw & 0xffff0000u) : __uint_as_float(ckw << 16);
          const float prvR = (u & 1) ? __uint_as_float(qrw & 0xffff0000u) : __uint_as_float(qrw << 16), prvK = (u & 1) ? __uint_as_float(qkw & 0xffff0000u) : __uint_as_float(qkw << 16);
          const float rv = curR + (prvR - curR) * pmr[u], kr = curK + (prvK - curK) * pmk[u];
          const float lw = LW[c * 64 + 8 * kg + u], la = LA[c * 64 + 8 * kg + u]; gt[u] = LG[c * 64 + 8 * kg + u];
          const float wraw = -fsoftplus(-(pw0[u] + lw)) - 0.5f; lwd[u] = -fexp(wraw);
          const float av = sigmoid_f(pa0[u] + la); const float kkr = kr * pkk[u]; kt[u] = kr * (1.0f + (av - 1.0f) * pka[u]);
          rr[u] = rv; kk[u] = kkr; bb[u] = av; ss += kkr * kkr; rk += rv * kt[u] * prk[u]; }
      ss += __shfl_xor(ss, 1); ss += __shfl_xor(ss, 2); ss += __shfl_xor(ss, 4); rk += __shfl_xor(rk, 1); rk += __shfl_xor(rk, 2); rk += __shfl_xor(rk, 4);
      const float inv = __builtin_amdgcn_rsqf(ss + 1e-6f);
#pragma unroll
      for (int u = 0; u < 8; ++u) { kk[u] *= inv; bb[u] *= kk[u]; }
#pragma unroll
      for (int u = 0; u < 8; ++u) { float x = lwd[u];
#pragma unroll
          for (int o = 8; o < 64; o <<= 1) { const float up = __shfl_up(x, o); if (lane >= o) x += up; }
          cum[u] = x; }
      if (lane >= 56) { *(LAS f32x4*)(WT + w * 64 + 8 * kg) = (f32x4){cum[0], cum[1], cum[2], cum[3]}; *(LAS f32x4*)(WT + w * 64 + 8 * kg + 4) = (f32x4){cum[4], cum[5], cum[6], cum[7]}; }
      v4u eo, go;
#pragma unroll
      for (int u = 0; u < 4; ++u) { eo[u] = pk2(rk * vv[2 * u], rk * vv[2 * u + 1]); go[u] = pk2(gt[2 * u], gt[2 * u + 1]); }
      bf16_t* Eo = (bf16_t*)(a.ws + WS_RW_E) + (size_t)tk * 4096; bf16_t* Go = (bf16_t*)(a.ws + WS_RW_GT) + (size_t)tk * 4096;
#pragma unroll
      for (int hf = 0; hf < 2; ++hf) { const int o = (((c >> 4) * 4 + (kg >> 1)) * 64 + ((2 * kg + hf) & 3) * 16 + (c & 15)) * 4;
          *(u32x2*)(Eo + o) = (u32x2){eo[2 * hf], eo[2 * hf + 1]}; *(u32x2*)(Go + o) = (u32x2){go[2 * hf], go[2 * hf + 1]}; } }
    WG_SYNC();
    if (stop <= 3) return;
    RW_IDX();
    if (nxt >= 0) rw1_load(a, nxt >> 3, nxt & 7, tid, pre);
    { float cc[8];
#pragma unroll
      for (int u = 0; u < 8; ++u) cc[u] = 0.f;
#pragma unroll
      for (int ww = 0; ww < 8; ++ww) { const f32x4 t0 = *(const LAS f32x4*)(WT + ww * 64 + 8 * kg), t1 = *(const LAS f32x4*)(WT + ww * 64 + 8 * kg + 4);
#pragma unroll
          for (int e = 0; e < 4; ++e) { if (ww < w) { cum[e] += t0[e]; cum[4 + e] += t1[e]; } cc[e] += t0[e]; cc[4 + e] += t1[e]; } }
      if (c == 0) { *(LAS f32x4*)(CUMC + 8 * kg) = (f32x4){cc[0], cc[1], cc[2], cc[3]}; *(LAS f32x4*)(CUMC + 8 * kg + 4) = (f32x4){cc[4], cc[5], cc[6], cc[7]}; }
      v4u oRH, oBT, oKT, oKH, oBM, oKM;
#pragma unroll
      for (int u = 0; u < 8; u += 2) { float x[6][2];
#pragma unroll
          for (int e = 0; e < 2; ++e) { const float cu = cum[u + e]; const float ep = fexp(cu), em = fexp(-cu), et = fexp(cc[u + e] - cu), ex = fexp(cu - lwd[u + e]);
              x[0][e] = rr[u + e] * ep; x[1][e] = bb[u + e] * et; x[2][e] = kt[u + e] * et; x[3][e] = kk[u + e] * ex; x[4][e] = bb[u + e] * em; x[5][e] = kt[u + e] * em;
              RHST[(8 * kg + u + e) * 64 + c] = x[3][e]; }
          oRH[u >> 1] = pk2(x[0][0], x[0][1]); oBT[u >> 1] = pk2(x[1][0], x[1][1]); oKT[u >> 1] = pk2(x[2][0], x[2][1]); oKH[u >> 1] = pk2(x[3][0], x[3][1]); oBM[u >> 1] = pk2(x[4][0], x[4][1]); oKM[u >> 1] = pk2(x[5][0], x[5][1]); }
      const int o = c * RW_LD + 8 * kg;
      *(LAS v4u*)(RHi + o) = oRH; *(LAS v4u*)(BTi + o) = oBT; *(LAS v4u*)(KTi + o) = oKT; *(LAS v4u*)(KHi + o) = oKH; *(LAS v4u*)(BMi + o) = oBM; *(LAS v4u*)(KMi + o) = oKM; }
    WG_SYNC();
    if (stop <= 4) return;
    RW_IDX();
#pragma unroll
    for (int tt = 0; tt < 2; ++tt) { const int tile = 2 * w + tt, ii = tile >> 2, jt = tile & 3;
        f32x4 cA = {0.f, 0.f, 0.f, 0.f}, cB = cA, cPb = cA, cPk = cA;
        if (ii <= jt) {
#pragma unroll
            for (int k0 = 0; k0 < 64; k0 += 32) { const bf16x8 fbm = frag_row(BMi, RW_LD, 16 * ii, k0, lane), fkm = frag_row(KMi, RW_LD, 16 * ii, k0, lane), fkh = frag_row(KHi, RW_LD, 16 * jt, k0, lane), frh = frag_row(RHi, RW_LD, 16 * jt, k0, lane);
                cA = mfma16(fbm, fkh, cA); cB = mfma16(fkm, fkh, cB); cPb = mfma16(fbm, frh, cPb); cPk = mfma16(fkm, frh, cPk); }
#pragma unroll
            for (int e = 0; e < 4; ++e) { const int i = 16 * ii + 4 * g + e, tq = 16 * jt + r; if (!(i < tq)) { cA[e] = 0.f; cB[e] = 0.f; } if (!(i <= tq)) { cPb[e] = 0.f; cPk[e] = 0.f; } } }
        const int tq = 16 * jt + r, i0 = 16 * ii + 4 * g;
        *(LAS f32x4*)(AM + tq * 68 + i0) = cA; *(LAS u32x2*)(AI + tq * RW_LD + i0) = pack4(-cA); *(LAS u32x2*)(BMI + tq * RW_LD + i0) = pack4(cB); *(LAS u32x2*)(PBI + tq * RW_LD + i0) = pack4(cPb); *(LAS u32x2*)(PKI + tq * RW_LD + i0) = pack4(cPk); }
    WG_SYNC();
    if (stop <= 5) return;
    RW_IDX();
#pragma unroll
    for (int tt = 0; tt < 2; ++tt) { const int tile = 2 * w + tt, it = tile >> 2, jv = tile & 3; f32x4 acc = {0.f, 0.f, 0.f, 0.f};
#pragma unroll
        for (int k0 = 0; k0 < 64; k0 += 32) acc = mfma16(frag_row(BMI, RW_LD, 16 * it, k0, lane), frag_tr(Vi, RW_LD, 16 * jv, k0, lane), acc);
        *(LAS f32x4*)(RHST + (64 + 16 * jv + r) * 64 + 16 * it + 4 * g) = acc; }
    { const int q = c * 8 + kg;
      if (q < 64) { const int b = q >> 4, j = q & 15; float d[16], av[16][16];
#pragma unroll
          for (int tq = 1; tq < 16; ++tq)
#pragma unroll
              for (int i = 0; i < tq; ++i) av[tq][i] = AM[(16 * b + tq) * 68 + 16 * b + i];
#pragma unroll
          for (int tq = 0; tq < 16; ++tq) d[tq] = tq == j ? 1.f : 0.f;
#pragma unroll
          for (int i = 0; i < 15; ++i)
#pragma unroll
              for (int tq = i + 1; tq < 16; ++tq) d[tq] -= av[tq][i] * d[i];
#pragma unroll
          for (int tq = 0; tq < 16; ++tq) { DI[(b * 16 + tq) * 32 + j] = (bf16_t)f2bf(d[tq]); DI[(b * 16 + tq) * 32 + 16 + j] = (bf16_t)0; } }
      for (int i = q; i < 128 * RW_LD / 8; i += 512) *(LAS v4u*)(XI + 8 * i) = (v4u){0u, 0u, 0u, 0u};
      *(LAS v4u*)(UI + w * 512 + lane * 8) = (v4u){0u, 0u, 0u, 0u}; }
    WG_SYNC();
    if (stop <= 6) return;
    RW_IDX();
    { LAS bf16_t* Uw = UI + w * 512; LAS bf16_t* Xw = XI + (16 * w) * RW_LD;
#pragma unroll
      for (int b = 0; b < 4; ++b) { f32x4 acc = *(const LAS f32x4*)(RHST + (16 * w + r) * 64 + 16 * b + 4 * g);
#pragma unroll
          for (int k0 = 0; k0 < 16 * b; k0 += 32) acc = mfma16(frag_row(AI, RW_LD, 16 * b, k0, lane), frag_row(Xw, RW_LD, 0, k0, lane), acc);
          *(LAS u32x2*)(Uw + r * 32 + 4 * g) = pack4(acc);
          asm volatile("s_waitcnt lgkmcnt(0)" ::: "memory");
          f32x4 x = {0.f, 0.f, 0.f, 0.f}; x = mfma16(frag_row(DI + b * 512, 32, 0, 0, lane), frag_row(Uw, 32, 0, 0, lane), x);
          *(LAS u32x2*)(Xw + r * RW_LD + 16 * b + 4 * g) = pack4(x);
          asm volatile("s_waitcnt lgkmcnt(0)" ::: "memory"); } }
    WG_SYNC();
    if (stop <= 7) return;
    RW_IDX();
    { const int o = w >> 1; const LAS bf16_t* WHt = XI; const LAS bf16_t* XTt = XI + 64 * RW_LD;
      v4u outv[4];
#pragma unroll
      for (int tj = 0; tj < 4; ++tj) { u32x2 pa[2];
#pragma unroll
          for (int t2 = 0; t2 < 2; ++t2) { const int ti = 2 * (w & 1) + t2; f32x4 c1 = {0.f, 0.f, 0.f, 0.f}, c2 = c1;
              if (o == 0) {
#pragma unroll
                  for (int k0 = 0; k0 < 64; k0 += 32) c1 = mfma16(frag_row(WHt, RW_LD, 16 * ti, k0, lane), frag_tr(BTi, RW_LD, 16 * tj, k0, lane), c1);
                  const int kq = 16 * tj + r; const float dg = fexp(CUMC[kq]); f32x4 gv;
#pragma unroll
                  for (int e = 0; e < 4; ++e) gv[e] = ((16 * ti + 4 * g + e) == kq ? dg : 0.f) - c1[e];
                  pa[t2] = pack4(gv);
              } else if (o == 1) {
#pragma unroll
                  for (int k0 = 0; k0 < 64; k0 += 32) { c1 = mfma16(frag_tr(KTi, RW_LD, 16 * ti, k0, lane), frag_tr(Vi, RW_LD, 16 * tj, k0, lane), c1); c2 = mfma16(frag_tr(BTi, RW_LD, 16 * ti, k0, lane), frag_row(XTt, RW_LD, 16 * tj, k0, lane), c2); }
                  pa[t2] = pack4(c1 - c2);
              } else if (o == 2) {
#pragma unroll
                  for (int k0 = 0; k0 < 64; k0 += 32) c1 = mfma16(frag_row(WHt, RW_LD, 16 * ti, k0, lane), frag_row(PBI, RW_LD, 16 * tj, k0, lane), c1);
                  const int tq = 16 * tj + r; const f32x4 rh = unpack4(*(const LAS u32x2*)(RHi + tq * RW_LD + 16 * ti + 4 * g));
                  pa[t2] = pack4(rh - c1);
              } else {
#pragma unroll
                  for (int k0 = 0; k0 < 64; k0 += 32) { c1 = mfma16(frag_tr(Vi, RW_LD, 16 * ti, k0, lane), frag_row(PKI, RW_LD, 16 * tj, k0, lane), c1); c2 = mfma16(frag_row(XTt, RW_LD, 16 * ti, k0, lane), frag_row(PBI, RW_LD, 16 * tj, k0, lane), c2); }
                  pa[t2] = pack4(c1 - c2);
              } }
          outv[tj] = (o & 1) ? cat2(pa[0], pa[1]) : fo_pair(pa[0], pa[1]); }
      if (nxt >= 0) rw1_par(a, l, nxt & 7, tid, par);
      bf16_t* ob = (bf16_t*)(a.ws + (o == 0 ? WS_RW_G : o == 1 ? WS_RW_Z : o == 2 ? WS_RW_QT : WS_RW_YI)) + (size_t)tk * 4096;
#pragma unroll
      for (int tj = 0; tj < 4; ++tj) *(v4u*)(ob + ((o & 1) ? co2_off(tj, 2, w & 1, lane) : fo_off2(tj, 2, 2 * (w & 1), g, r))) = outv[tj]; }
    WG_SYNC();
#undef RW_IDX
}
__device__ __forceinline__ void cnt_arrive(unsigned* cnt);
__device__ __forceinline__ void rw_stage2(CArgs& a, int h, int vs, LAS unsigned char* lds, int tid, unsigned* half) {
    const int lane = tid & 63, w = __builtin_amdgcn_readfirstlane(tid >> 6), r = lane & 15, g = lane >> 4;
    LAS bf16_t* Si = (LAS bf16_t*)lds;
    const bf16_t* G = (const bf16_t*)(a.ws + WS_RW_G); const bf16_t* Z = (const bf16_t*)(a.ws + WS_RW_Z); bf16_t* S = (bf16_t*)(a.ws + WS_RW_S);
    if (w < 4) { *(LAS u32x2*)(Si + r * RW_LD + 16 * w + 4 * g) = (u32x2){0u, 0u}; *(u32x2*)(S + (size_t)h * 4096 + fo_st(vs, 2, 16 * w, g, r)) = (u32x2){0u, 0u}; }
    WG_SYNC();
    constexpr int PD = 8; const int wq = w & 3; const int so = fo_st(vs, 2, 16 * wq, g, r), zo = co2_off(vs, 2, wq >> 1, lane) + 4 * (wq & 1);
    bf16x8 gf[PD][2]; u32x2 zf[PD];
#pragma unroll
    for (int u = 0; u < PD; ++u) { const size_t tk = (size_t)u * 8 + h; zf[u] = *(const u32x2*)(Z + tk * 4096 + zo); gf[u][0] = frag_fo(G + tk * 4096, 2, wq, 0, lane); gf[u][1] = frag_fo(G + tk * 4096, 2, wq, 1, lane); }
#define RW_STEP(n_, u_, REFILL) do { const int n = (n_); const size_t tk = (size_t)n * 8 + h; const int cur = n & 1; \
            f32x4 acc = unpack4(zf[u_]), acc2 = {0.f, 0.f, 0.f, 0.f}; \
            acc = mfma16(gf[u_][0], frag_row(Si + cur * 16 * RW_LD, RW_LD, 0, 0, lane), acc); acc2 = mfma16(gf[u_][1], frag_row(Si + cur * 16 * RW_LD, RW_LD, 0, 32, lane), acc2); \
            if (REFILL) { const int nn = n + PD < NCH - 1 ? n + PD : NCH - 2; const size_t tn = (size_t)nn * 8 + h; zf[u_] = *(const u32x2*)(Z + tn * 4096 + zo); gf[u_][0] = frag_fo(G + tn * 4096, 2, wq, 0, lane); gf[u_][1] = frag_fo(G + tn * 4096, 2, wq, 1, lane); } \
            const u32x2 pv = pack4(acc + acc2); \
            if (w < 4) { *(LAS u32x2*)(Si + (cur ^ 1) * 16 * RW_LD + r * RW_LD + 16 * wq + 4 * g) = pv; *(u32x2*)(S + (tk + 8) * 4096 + so) = pv; } \
            asm volatile("s_waitcnt lgkmcnt(0)" ::: "memory"); __builtin_amdgcn_s_barrier(); asm volatile("" ::: "memory"); } while (0)
#pragma unroll
    for (int nq = 0; nq < NCH - 1; ++nq) { RW_STEP(nq, nq % PD, nq + PD < NCH - 1); if (nq == NCH / 2 - 2) cnt_arrive(half); }
#undef RW_STEP
}
struct Rw3In { v4u yi; bf16x8 s[2][2]; bf16x8 q[2]; u32x2 e[2], gt[2]; f32x4 lw[2], lb[2]; };
__device__ __forceinline__ void rw3_load(CArgs& a, int l, int n, int h, int tid, Rw3In& in) {
    const int lane = tid & 63, w = __builtin_amdgcn_readfirstlane(tid >> 6), g = lane >> 4, jc = w & 3, wh = w >> 2;
    const size_t tk = (size_t)n * 8 + h;
    const bf16_t* S = (const bf16_t*)(a.ws + WS_RW_S) + tk * 4096; const bf16_t* QT = (const bf16_t*)(a.ws + WS_RW_QT) + tk * 4096; const bf16_t* YI = (const bf16_t*)(a.ws + WS_RW_YI) + tk * 4096;
    const bf16_t* E = (const bf16_t*)(a.ws + WS_RW_E) + tk * 4096; const bf16_t* GT = (const bf16_t*)(a.ws + WS_RW_GT) + tk * 4096;
    in.yi = *(const v4u*)(YI + co2_off(jc, 2, wh, lane));
#pragma unroll
    for (int k = 0; k < 2; ++k) { in.q[k] = frag_fo(QT, 2, jc, k, lane); in.s[0][k] = frag_fo(S, 2, 2 * wh, k, lane); in.s[1][k] = frag_fo(S, 2, 2 * wh + 1, k, lane); }
#pragma unroll
    for (int tt = 0; tt < 2; ++tt) { const int v0 = 16 * (2 * wh + tt) + 4 * g; const int eo_ = co_off(jc, 4, 2 * wh + tt, lane); in.e[tt] = *(const u32x2*)(E + eo_); in.gt[tt] = *(const u32x2*)(GT + eo_);
        in.lw[tt] = *(const f32x4*)(LP(I_RWLNW, 512) + h * 64 + v0); in.lb[tt] = *(const f32x4*)(LP(I_RWLNB, 512) + h * 64 + v0); }
    asm volatile("" ::: "memory");
}
__device__ __forceinline__ void rw_stage3(CArgs& a, int l, int n, int h, LAS unsigned char* lds, int tid, const Rw3In& in) {
    const int lane = tid & 63, w = __builtin_amdgcn_readfirstlane(tid >> 6), r = lane & 15, g = lane >> 4, jc = w & 3, wh = w >> 2;
    const int c = 16 * jc + r, t = n * 64 + c;
    LAS float* xs = (LAS float*)lds;
    f32x4 acc[2];
#pragma unroll
    for (int tt = 0; tt < 2; ++tt) { acc[tt] = unpack4(tt ? (u32x2){in.yi.z, in.yi.w} : (u32x2){in.yi.x, in.yi.y});
#pragma unroll
        for (int k = 0; k < 2; ++k) acc[tt] = mfma16(in.s[tt][k], in.q[k], acc[tt]); }
    float s1 = (acc[0][0] + acc[0][1]) + (acc[0][2] + acc[0][3]) + (acc[1][0] + acc[1][1]) + (acc[1][2] + acc[1][3]);
    s1 += __shfl_xor(s1, 16); s1 += __shfl_xor(s1, 32);
    if (g == 0) xs[w * 16 + r] = s1;
    WG_SYNC();
    const float mu = (s1 + xs[(w ^ 4) * 16 + r]) * (1.0f / 64.0f); float s2 = 0.f;
#pragma unroll
    for (int tt = 0; tt < 2; ++tt)
#pragma unroll
        for (int e = 0; e < 4; ++e) { acc[tt][e] -= mu; s2 += acc[tt][e] * acc[tt][e]; }
    s2 += __shfl_xor(s2, 16); s2 += __shfl_xor(s2, 32);
    if (g == 0) xs[128 + w * 16 + r] = s2;
    WG_SYNC();
    const float rs = 1.0f / sqrtf((s2 + xs[128 + (w ^ 4) * 16 + r]) * (1.0f / 64.0f) + 64e-5f);
    bf16_t* O = (bf16_t*)(a.ws + WS_O) + (size_t)t * D + 1536 + h * 64;
#pragma unroll
    for (int tt = 0; tt < 2; ++tt) { const int v0 = 16 * (2 * wh + tt) + 4 * g; const f32x4 ev = unpack4(in.e[tt]), gv = unpack4(in.gt[tt]);
        const f32x4 lw = in.lw[tt], lb = in.lb[tt]; f32x4 y;
#pragma unroll
        for (int e = 0; e < 4; ++e) y[e] = (acc[tt][e] * rs * lw[e] + lb[e] + ev[e]) * gv[e];
        *(u32x2*)(O + v0) = pack4(y); }
    WG_SYNC();
}

constexpr int M2_LDS = 136, M2_LDX = 264, M2O_B = 0, M2O_C = 17408, M2O_X = 34816, M2O_XW = 68608, M2O_M = 102400, M2O_DT = 139264, M2O_G = 140288, M2O_GL = 141312;
__device__ __forceinline__ void m2_stage1(CArgs& a, int l, int n, int gr, LAS unsigned char* lds, int tid) {
    const int lane = tid & 63, w = __builtin_amdgcn_readfirstlane(tid >> 6), r = lane & 15, g = lane >> 4;
    LAS bf16_t* Bi = (LAS bf16_t*)(lds + M2O_B); LAS bf16_t* Ci = (LAS bf16_t*)(lds + M2O_C); LAS bf16_t* Xi = (LAS bf16_t*)(lds + M2O_X); LAS bf16_t* XWi = (LAS bf16_t*)(lds + M2O_XW); LAS bf16_t* Mi = (LAS bf16_t*)(lds + M2O_M);
    LAS float* DT = (LAS float*)(lds + M2O_DT); LAS float* GC = (LAS float*)(lds + M2O_G); LAS float* GLAST = (LAS float*)(lds + M2O_GL);
    const int t0 = n * 64;
    LAS bf16_t* RAW = (LAS bf16_t*)(lds + M2O_XW);
    { v4u sv[9];
#pragma unroll
      for (int i = 0; i < 9; ++i) { const int idx = tid + 512 * i, row = idx >> 6, ch = idx & 63, t = t0 - 3 + row; sv[i] = (v4u){0u, 0u, 0u, 0u};
          const int col = ch < 32 ? gr * 256 + 8 * ch : (ch < 48 ? 512 + gr * 128 + 8 * (ch - 32) : 768 + gr * 128 + 8 * (ch - 48));
          if (idx < 67 * 64 && t >= 0) sv[i] = *(const v4u*)(PROJROW(t) + C_MXBC + col); }
#pragma unroll
      for (int i = 0; i < 9; ++i) { const int idx = tid + 512 * i; if (idx < 67 * 64) *(LAS v4u*)(RAW + (idx >> 6) * 512 + 8 * (idx & 63)) = sv[i]; } }
    WG_SYNC();
    { const int lc = tid; int col; LAS bf16_t* dst; int dld;
      if (lc < 256) { col = gr * 256 + lc; dst = Xi + lc; dld = M2_LDX; } else if (lc < 384) { col = 512 + gr * 128 + (lc - 256); dst = Bi + (lc - 256); dld = M2_LDS; } else { col = 768 + gr * 128 + (lc - 384); dst = Ci + (lc - 384); dld = M2_LDS; }
      const float* cw = LP(I_MCONV, 4 * 1024) + col; const float w0 = cw[0], w1 = cw[1024], w2 = cw[2048], w3 = cw[3072], cb = LP(I_MCONVB, 1024)[col];
#pragma unroll 1
      for (int seg = 0; seg < 4; ++seg) { const LAS bf16_t* src = RAW + (16 * seg) * 512 + lc;
        float xw[19];
#pragma unroll
        for (int i = 0; i < 19; ++i) xw[i] = bf2f(src[i * 512]);
#pragma unroll
        for (int cc = 0; cc < 16; ++cc) { const float y = silu_f(w0 * xw[cc] + w1 * xw[cc + 1] + w2 * xw[cc + 2] + w3 * xw[cc + 3] + cb); dst[(16 * seg + cc) * dld] = (bf16_t)f2bf(y); } } }
    if (tid < 256) { const int c = tid >> 2, hh = tid & 3, hd = gr * 4 + hh; const float dt = softplus_f(bf2f(PROJROW(t0 + c)[C_MDT + hd]) + LP(I_MDTB, 8)[hd]); DT[c * 4 + hh] = dt; GC[c * 4 + hh] = -fexp(LP(I_MALOG, 8)[hd]) * dt; }
    WG_SYNC();
    if (tid < 64) {
        const f32x4 gv = *(const LAS f32x4*)(GC + tid * 4); float cu[4] = {gv[0], gv[1], gv[2], gv[3]};
#pragma unroll
        for (int o = 1; o < 64; o <<= 1) {
#pragma unroll
            for (int hh = 0; hh < 4; ++hh) { const float up = __shfl_up(cu[hh], o); if (tid >= o) cu[hh] += up; } }
        *(LAS f32x4*)(GC + tid * 4) = (f32x4){cu[0], cu[1], cu[2], cu[3]};
        if (tid == 63) {
#pragma unroll
            for (int hh = 0; hh < 4; ++hh) { GLAST[hh] = cu[hh]; WSF(WS_M2_DEC)[n * 8 + gr * 4 + hh] = fexp(cu[hh]); } } }
    WG_SYNC();
    { const int c = tid >> 3, q = tid & 7;
      const int hh = q >> 1; const float sc = DT[c * 4 + hh] * fexp(GLAST[hh] - GC[c * 4 + hh]);
#pragma unroll
      for (int u = 0; u < 4; ++u) { const v4u xv = *(const LAS v4u*)(Xi + c * M2_LDX + 32 * q + 8 * u); v4u o;
#pragma unroll
          for (int e = 0; e < 4; ++e) o[e] = pk2(__uint_as_float(xv[e] << 16) * sc, __uint_as_float(xv[e] & 0xffff0000u) * sc);
          *(LAS v4u*)(XWi + c * M2_LDX + 32 * q + 8 * u) = o; }
    }
    {
      const int qh = w >> 1; bf16_t* QH = (bf16_t*)(a.ws + WS_M2_QH) + (size_t)(n * 8 + gr * 4 + qh) * 8192;
#pragma unroll
      for (int cj = 0; cj < 2; ++cj) { const int jc = 2 * (w & 1) + cj, c = 16 * jc + r; const float eg = fexp(GC[c * 4 + qh]);
#pragma unroll
          for (int ks = 0; ks < 4; ++ks) { const v4u cv = *(const LAS v4u*)(Ci + c * M2_LDS + 32 * ks + 8 * g); v4u o;
#pragma unroll
              for (int e = 0; e < 4; ++e) o[e] = pk2(__uint_as_float(cv[e] << 16) * eg, __uint_as_float(cv[e] & 0xffff0000u) * eg);
              *(v4u*)(QH + ((jc * 4 + ks) * 64 + lane) * 8) = o; } } }
#pragma unroll
    for (int tt = 0; tt < 2; ++tt) { const int tile = 2 * w + tt, im = tile >> 2, jc = tile & 3; f32x4 acc = {0.f, 0.f, 0.f, 0.f};
        if (jc >= im) {
#pragma unroll
            for (int k0 = 0; k0 < 128; k0 += 32) acc = mfma16(frag_row(Bi, M2_LDS, 16 * im, k0, lane), frag_row(Ci, M2_LDS, 16 * jc, k0, lane), acc); }
        const int cq = 16 * jc + r;
#pragma unroll
        for (int hh = 0; hh < 4; ++hh) { f32x4 mv; const float gc = GC[cq * 4 + hh];
#pragma unroll
            for (int e = 0; e < 4; ++e) { const int m = 16 * im + 4 * g + e; mv[e] = cq >= m ? acc[e] * fexp(gc - GC[m * 4 + hh]) * DT[m * 4 + hh] : 0.f; }
            *(LAS u32x2*)(Mi + hh * 64 * 72 + cq * 72 + 16 * im + 4 * g) = pack4(mv); } }
    WG_SYNC();
    { const int hh = w >> 1, hd = gr * 4 + hh; const size_t tk = (size_t)n * 8 + hd; const float Dh = LP(I_MD, 8)[hd];
      bf16_t* YI = (bf16_t*)(a.ws + WS_M2_YI) + tk * 4096; bf16_t* Z = (bf16_t*)(a.ws + WS_M2_Z) + tk * 8192;
#pragma unroll
      for (int jc = 0; jc < 4; ++jc) { u32x2 pa[2];
#pragma unroll
          for (int t2 = 0; t2 < 2; ++t2) { const int ip = 2 * (w & 1) + t2; f32x4 acc = {0.f, 0.f, 0.f, 0.f};
#pragma unroll
              for (int k0 = 0; k0 < 64; k0 += 32) acc = mfma16(frag_tr(Xi, M2_LDX, 64 * hh + 16 * ip, k0, lane), frag_row(Mi + hh * 64 * 72, 72, 16 * jc, k0, lane), acc);
              const int cq = 16 * jc + r; const f32x4 xv = unpack4(*(const LAS u32x2*)(Xi + cq * M2_LDX + 64 * hh + 16 * ip + 4 * g));
              pa[t2] = pack4(acc + xv * Dh); }
          *(v4u*)(YI + co2_off(jc, 2, w & 1, lane)) = cat2(pa[0], pa[1]); }
#pragma unroll
      for (int tt = 0; tt < 8; ++tt) { const int jp = tt & 3, is0 = 4 * (w & 1) + 2 * (tt >> 2); u32x2 pa[2];
#pragma unroll
          for (int t2 = 0; t2 < 2; ++t2) { const int is = is0 + t2; f32x4 acc = {0.f, 0.f, 0.f, 0.f};
#pragma unroll
              for (int k0 = 0; k0 < 64; k0 += 32) acc = mfma16(frag_tr(Bi, M2_LDS, 16 * is, k0, lane), frag_tr(XWi, M2_LDX, 64 * hh + 16 * jp, k0, lane), acc);
              pa[t2] = pack4(acc); }
          fo_st2(Z, jp, 4, is0, pa[0], pa[1], g, r); } }
    WG_SYNC();
}
__device__ __forceinline__ void m2_stage2(CArgs& a, int b, LAS unsigned char* lds, int tid) {
    const int hd = b >> 4, rem0 = (b & 15) * 512; const DecTable dc{WSF(WS_M2_DEC) + hd, 8};
    ew_stage2((const bf16_t*)(a.ws + WS_M2_Z) + (size_t)hd * 8192 + rem0, (bf16_t*)(a.ws + WS_M2_S) + (size_t)hd * 8192 + rem0, (size_t)8 * 8192, dc, lds, tid);
}
__device__ __forceinline__ void m2_stage3(CArgs& a, int l, int n, int gr, LAS unsigned char* lds, int tid) {
    const int lane = tid & 63, w = __builtin_amdgcn_readfirstlane(tid >> 6), r = lane & 15, g = lane >> 4, hh = w >> 1, hd = gr * 4 + hh;
    const size_t tk = (size_t)n * 8 + hd;
    const bf16_t* S = (const bf16_t*)(a.ws + WS_M2_S) + tk * 8192; const bf16_t* QH = (const bf16_t*)(a.ws + WS_M2_QH) + tk * 8192; const bf16_t* YI = (const bf16_t*)(a.ws + WS_M2_YI) + tk * 4096;
    LAS float* xs = (LAS float*)lds;
    f32x4 nwv[4]; bf16x8 sf[4][4], qf[2][4]; v4u yiv[2][2]; u32x2 zvv[2][4];
#pragma unroll
    for (int cj = 0; cj < 2; ++cj) { const int jc = 2 * (w & 1) + cj, t = n * 64 + 16 * jc + r; const bf16_t* pz = PROJROW(t) + C_MZ + hd * 64;
#pragma unroll
        for (int k = 0; k < 4; ++k) qf[cj][k] = frag_fo(QH, 4, jc, k, lane);
#pragma unroll
        for (int pp = 0; pp < 2; ++pp) yiv[cj][pp] = *(const v4u*)(YI + co2_off(jc, 2, pp, lane));
#pragma unroll
        for (int ip = 0; ip < 4; ++ip) zvv[cj][ip] = *(const u32x2*)(pz + 16 * ip + 4 * g); }
#pragma unroll
    for (int ip = 0; ip < 4; ++ip) { nwv[ip] = *(const f32x4*)(LP(I_MNORM, 512) + hd * 64 + 16 * ip + 4 * g);
#pragma unroll
        for (int k = 0; k < 4; ++k) sf[ip][k] = frag_fo(S, 4, ip, k, lane); }
    asm volatile("" ::: "memory");
    f32x4 acc[2][4]; float ss[2];
#pragma unroll
    for (int cj = 0; cj < 2; ++cj) { ss[cj] = 0.f;
#pragma unroll
        for (int ip = 0; ip < 4; ++ip) { const v4u yv = yiv[cj][ip >> 1]; acc[cj][ip] = unpack4((ip & 1) ? (u32x2){yv.z, yv.w} : (u32x2){yv.x, yv.y});
#pragma unroll
            for (int k = 0; k < 4; ++k) acc[cj][ip] = mfma16(sf[ip][k], qf[cj][k], acc[cj][ip]);
            const f32x4 zv = unpack4(zvv[cj][ip]);
#pragma unroll
            for (int e = 0; e < 4; ++e) { acc[cj][ip][e] *= silu_f(zv[e]); ss[cj] += acc[cj][ip][e] * acc[cj][ip][e]; } }
        ss[cj] += __shfl_xor(ss[cj], 16); ss[cj] += __shfl_xor(ss[cj], 32);
        if (g == 0) xs[w * 32 + cj * 16 + r] = ss[cj]; }
    WG_SYNC();
#pragma unroll
    for (int cj = 0; cj < 2; ++cj) { const int jc = 2 * (w & 1) + cj, c = 16 * jc + r, t = n * 64 + c;
        const float tot = xs[((w & 1) + 0) * 32 + cj * 16 + r] + xs[((w & 1) + 2) * 32 + cj * 16 + r] + xs[((w & 1) + 4) * 32 + cj * 16 + r] + xs[((w & 1) + 6) * 32 + cj * 16 + r];
        const float rs = 1.0f / sqrtf(tot * (1.0f / 256.0f) + 1e-6f);
        bf16_t* O = (bf16_t*)(a.ws + WS_O) + (size_t)t * D + 1024 + hd * 64;
#pragma unroll
        for (int ip = 0; ip < 4; ++ip) { const f32x4 wv = nwv[ip]; f32x4 y;
#pragma unroll
            for (int e = 0; e < 4; ++e) y[e] = acc[cj][ip][e] * rs * wv[e];
            *(u32x2*)(O + 16 * ip + 4 * g) = pack4(y); } }
    WG_SYNC();
}

constexpr int GD_LD = 136;
constexpr int GDO_K = 0, GDO_V = 17408, GDO_KT = 34816, GDO_QG = 52224, GDO_Q = 69632, GDO_AI = 87040, GDO_AMD = 96256, GDO_DI = 100352, GDO_AQ = 104448, GDO_XI = 113664, GDO_QF = 87040, GDO_KF = 119808, GDO_SM = 152576, GDO_UI = 153600;
__device__ __forceinline__ void gd_stage1(CArgs& a, int l, int n, int h, LAS unsigned char* lds, int tid, const int stop = 99) {
    const int w = __builtin_amdgcn_readfirstlane(tid >> 6), tk = n * 4 + h, t0 = n * 64;
    int lane, r, g, c, q8;
#define GD_IDX() do { int tl_ = tid; asm volatile("" : "+v"(tl_)); lane = tl_ & 63; r = lane & 15; g = lane >> 4; c = tl_ >> 3; q8 = tl_ & 7; } while (0)
    LAS bf16_t* Ki = (LAS bf16_t*)(lds + GDO_K); LAS bf16_t* Vi = (LAS bf16_t*)(lds + GDO_V); LAS bf16_t* KTi = (LAS bf16_t*)(lds + GDO_KT); LAS bf16_t* QGi = (LAS bf16_t*)(lds + GDO_QG); LAS bf16_t* Qi = (LAS bf16_t*)(lds + GDO_Q);
    LAS bf16_t* AI = (LAS bf16_t*)(lds + GDO_AI);
    LAS float* AMD = (LAS float*)(lds + GDO_AMD);
    LAS bf16_t* DI = (LAS bf16_t*)(lds + GDO_DI);
    LAS bf16_t* AQ = (LAS bf16_t*)(lds + GDO_AQ);
    LAS bf16_t* XI = (LAS bf16_t*)(lds + GDO_XI);
    LAS bf16_t* UI = (LAS bf16_t*)(lds + GDO_UI);
    LAS float* QF = (LAS float*)(lds + GDO_QF); LAS float* KF = (LAS float*)(lds + GDO_KF);
    LAS float* BETA = (LAS float*)(lds + GDO_SM); LAS float* GC = BETA + 64; LAS float* BG = GC + 64;
    LAS bf16_t* RAW = (LAS bf16_t*)(lds + GDO_KT);
    { v4u sv[7];
#pragma unroll
      for (int i = 0; i < 7; ++i) { const int idx = tid + 512 * i, row = idx / 48, ch = idx % 48, which = ch >> 4, t = t0 - 3 + row; sv[i] = (v4u){0u, 0u, 0u, 0u};
          if (idx < 67 * 48 && t >= 0) sv[i] = *(const v4u*)(PROJROW(t) + C_GQ + which * 512 + h * 128 + 8 * (ch & 15)); }
#pragma unroll
      for (int i = 0; i < 7; ++i) { const int idx = tid + 512 * i; if (idx < 67 * 48) *(LAS v4u*)(RAW + (idx / 48) * 384 + 8 * (idx % 48)) = sv[i]; } }
    WG_SYNC();
    { float wn[4];
      { const int col = tid % 384; const float* cw = LP(I_GCONV, 4 * 1536) + (col >> 7) * 512 + h * 128 + (col & 127); wn[0] = cw[0]; wn[1] = cw[1536]; wn[2] = cw[3072]; wn[3] = cw[4608]; }
#pragma unroll 1
      for (int it = tid; it < 384 * 4; it += 512) { const int col = it % 384, seg = it / 384, which = col >> 7, dcol = col & 127;
        const float w0 = wn[0], w1 = wn[1], w2 = wn[2], w3 = wn[3];
        if (it + 512 < 384 * 4) { const int c2 = (it + 512) % 384; const float* cw = LP(I_GCONV, 4 * 1536) + (c2 >> 7) * 512 + h * 128 + (c2 & 127); wn[0] = cw[0]; wn[1] = cw[1536]; wn[2] = cw[3072]; wn[3] = cw[4608]; }
        const LAS bf16_t* src = RAW + (16 * seg) * 384 + col;
        float xw[19];
#pragma unroll
        for (int i = 0; i < 19; ++i) xw[i] = bf2f(src[i * 384]);
#pragma unroll
        for (int cc = 0; cc < 16; ++cc) { const float y = silu_f(w0 * xw[cc] + w1 * xw[cc + 1] + w2 * xw[cc + 2] + w3 * xw[cc + 3]); const int tok = 16 * seg + cc;
            if (which == 2) Vi[tok * GD_LD + dcol] = (bf16_t)f2bf(y); else (which == 0 ? QF : KF)[tok * 128 + dcol] = y; } } }
    if (tid >= 384 && tid < 448) { const int cc = tid - 384; const bf16_t* pr = PROJROW(t0 + cc);
        const float beta = sigmoid_f(bf2f(pr[C_GB + h])); float cu = -fexp(LP(I_GALOG, 4)[h]) * softplus_f(bf2f(pr[C_GA + h]) + LP(I_GDTB, 4)[h]);
#pragma unroll
        for (int o = 1; o < 64; o <<= 1) { const float up = __shfl_up(cu, o); if (cc >= o) cu += up; }
        BETA[cc] = beta; GC[cc] = cu; BG[cc] = beta * fexp(cu); }
    WG_SYNC();
    GD_IDX();
    if (stop <= 0) return;
    { float qv[16], kv[16]; float sq = 0.f, sk = 0.f;
#pragma unroll
      for (int u = 0; u < 4; ++u) { const f32x4 a4 = *(const LAS f32x4*)(QF + c * 128 + 16 * q8 + 4 * u), b4 = *(const LAS f32x4*)(KF + c * 128 + 16 * q8 + 4 * u);
#pragma unroll
          for (int e = 0; e < 4; ++e) { qv[4 * u + e] = a4[e]; kv[4 * u + e] = b4[e]; sq += a4[e] * a4[e]; sk += b4[e] * b4[e]; } }
      sq += __shfl_xor(sq, 1); sq += __shfl_xor(sq, 2); sq += __shfl_xor(sq, 4); sk += __shfl_xor(sk, 1); sk += __shfl_xor(sk, 2); sk += __shfl_xor(sk, 4);
      const float gc = GC[c], iq = (1.0f / sqrtf(sq + 1e-6f)) * 0.08838834764831845f, ik = 1.0f / sqrtf(sk + 1e-6f), et = fexp(GC[63] - gc), eg = fexp(gc);
      v4u oK[2], oQ[2], oKT[2], oQG[2];
#pragma unroll
      for (int u = 0; u < 8; ++u) { const float k0 = kv[2 * u] * ik, k1 = kv[2 * u + 1] * ik, q0 = qv[2 * u] * iq, q1 = qv[2 * u + 1] * iq;
          oK[u >> 2][u & 3] = pk2(k0, k1); oQ[u >> 2][u & 3] = pk2(q0, q1); oKT[u >> 2][u & 3] = pk2(k0 * et, k1 * et); oQG[u >> 2][u & 3] = pk2(q0 * eg, q1 * eg); }
      const int o = c * GD_LD + 16 * q8;
      *(LAS v4u*)(Ki + o) = oK[0]; *(LAS v4u*)(Ki + o + 8) = oK[1]; *(LAS v4u*)(Qi + o) = oQ[0]; *(LAS v4u*)(Qi + o + 8) = oQ[1];
      *(LAS v4u*)(KTi + o) = oKT[0]; *(LAS v4u*)(KTi + o + 8) = oKT[1]; *(LAS v4u*)(QGi + o) = oQG[0]; *(LAS v4u*)(QGi + o + 8) = oQG[1]; }
    WG_SYNC();
    GD_IDX();
    if (stop <= 1) return;
#pragma unroll
    for (int tt = 0; tt < 2; ++tt) { const int tile = 2 * w + tt, im = tile >> 2, jc = tile & 3; f32x4 c1 = {0.f, 0.f, 0.f, 0.f}, c2 = c1;
        if (jc >= im) {
#pragma unroll
            for (int k0 = 0; k0 < 128; k0 += 32) { const bf16x8 fa = frag_row(Ki, GD_LD, 16 * im, k0, lane); c1 = mfma16(fa, frag_row(Ki, GD_LD, 16 * jc, k0, lane), c1); c2 = mfma16(fa, frag_row(Qi, GD_LD, 16 * jc, k0, lane), c2); }
            const int cq = 16 * jc + r; const float gc = GC[cq], bc = BETA[cq];
#pragma unroll
            for (int e = 0; e < 4; ++e) { const int m = 16 * im + 4 * g + e; const float dc = fexp(gc - GC[m]); c1[e] = m < cq ? c1[e] * dc * bc : 0.f; c2[e] = m <= cq ? c2[e] * dc : 0.f; } }
        const int cq = 16 * jc + r; *(LAS u32x2*)(AI + cq * 72 + 16 * im + 4 * g) = pack4(-c1); *(LAS u32x2*)(AQ + cq * 72 + 16 * im + 4 * g) = pack4(c2);
        if (im == jc) *(LAS f32x4*)(AMD + (im * 16 + r) * 16 + 4 * g) = c1; }
    WG_SYNC();
    GD_IDX();
    if (stop <= 2) return;
    { const int q = c * 8 + q8;
      if (q < 64) { const int b = q >> 4, j = q & 15; float d[16], av[16][16];
#pragma unroll
          for (int tq = 1; tq < 16; ++tq)
#pragma unroll
              for (int i = 0; i < tq; ++i) av[tq][i] = AMD[(b * 16 + tq) * 16 + i];
#pragma unroll
          for (int tq = 0; tq < 16; ++tq) d[tq] = tq == j ? 1.f : 0.f;
#pragma unroll
          for (int i = 0; i < 15; ++i)
#pragma unroll
              for (int tq = i + 1; tq < 16; ++tq) d[tq] -= av[tq][i] * d[i];
#pragma unroll
          for (int tq = 0; tq < 16; ++tq) { DI[(b * 16 + tq) * 32 + j] = (bf16_t)f2bf(d[tq]); DI[(b * 16 + tq) * 32 + 16 + j] = (bf16_t)0; } }
      for (int i = q; i < 256 * 72 / 8; i += 512) *(LAS v4u*)(XI + 8 * i) = (v4u){0u, 0u, 0u, 0u};
      *(LAS v4u*)(UI + w * 512 + lane * 8) = (v4u){0u, 0u, 0u, 0u}; }
    WG_SYNC();
    GD_IDX();
    if (stop <= 3) return;
    { LAS bf16_t* Uw = UI + w * 512;
#pragma unroll
      for (int tt = 0; tt < 2; ++tt) { const int nt = 2 * w + tt; LAS bf16_t* Xw = XI + (16 * nt) * 72;
          const LAS bf16_t* src = nt < 8 ? Vi + 16 * nt + r : Ki + 16 * (nt - 8) + r; const LAS float* scl = nt < 8 ? BETA : BG;
#pragma unroll
          for (int b = 0; b < 4; ++b) { const f32x4 sc = *(const LAS f32x4*)(scl + 16 * b + 4 * g); f32x4 acc;
#pragma unroll
              for (int e = 0; e < 4; ++e) acc[e] = bf2f(src[(16 * b + 4 * g + e) * GD_LD]) * sc[e];
#pragma unroll
              for (int k0 = 0; k0 < 16 * b; k0 += 32) acc = mfma16(frag_row(AI, 72, 16 * b, k0, lane), frag_row(Xw, 72, 0, k0, lane), acc);
              *(LAS u32x2*)(Uw + r * 32 + 4 * g) = pack4(acc);
              asm volatile("s_waitcnt lgkmcnt(0)" ::: "memory");
              f32x4 x = {0.f, 0.f, 0.f, 0.f}; x = mfma16(frag_row(DI + b * 512, 32, 0, 0, lane), frag_row(Uw, 32, 0, 0, lane), x);
              *(LAS u32x2*)(Xw + r * 72 + 16 * b + 4 * g) = pack4(x);
              asm volatile("s_waitcnt lgkmcnt(0)" ::: "memory"); } } }
    WG_SYNC();
    GD_IDX();
    if (stop <= 4) return;
    { const int jc = w & 3, wh = w >> 2; const int cq = 16 * jc + r;
      bf16_t* QT = (bf16_t*)(a.ws + WS_GD_QT) + (size_t)tk * 8192; bf16_t* YI = (bf16_t*)(a.ws + WS_GD_YI) + (size_t)tk * 8192; bf16_t* GG = (bf16_t*)(a.ws + WS_GD_G) + (size_t)tk * 16384; bf16_t* Z = (bf16_t*)(a.ws + WS_GD_Z) + (size_t)tk * 16384;
#pragma unroll
      for (int tp = 0; tp < 2; ++tp) { u32x2 qa[2], ya[2];
#pragma unroll
          for (int t2 = 0; t2 < 2; ++t2) { const int id = 4 * wh + 2 * tp + t2; f32x4 c1 = {0.f, 0.f, 0.f, 0.f}, c2 = c1;
#pragma unroll
              for (int k0 = 0; k0 < 64; k0 += 32) { const bf16x8 fb = frag_row(AQ, 72, 16 * jc, k0, lane); c1 = mfma16(frag_row(XI + 128 * 72, 72, 16 * id, k0, lane), fb, c1); c2 = mfma16(frag_row(XI, 72, 16 * id, k0, lane), fb, c2); }
              const f32x4 qg = unpack4(*(const LAS u32x2*)(QGi + cq * GD_LD + 16 * id + 4 * g));
              qa[t2] = pack4(qg - c1); ya[t2] = pack4(c2); }
          fo_st2(QT, jc, 4, 4 * wh + 2 * tp, qa[0], qa[1], g, r); *(v4u*)(YI + co2_off(jc, 4, 2 * wh + tp, lane)) = cat2(ya[0], ya[1]); }
      const float e63 = fexp(GC[63]);
#pragma unroll
      for (int tp = 0; tp < 4; ++tp) { u32x2 ga[2], za[2];
#pragma unroll
          for (int t2 = 0; t2 < 2; ++t2) { const int ti = 2 * tp + t2; f32x4 c1 = {0.f, 0.f, 0.f, 0.f}, c2 = c1;
#pragma unroll
              for (int k0 = 0; k0 < 64; k0 += 32) { c1 = mfma16(frag_row(XI + 128 * 72, 72, 16 * ti, k0, lane), frag_tr(KTi, GD_LD, 16 * w, k0, lane), c1); c2 = mfma16(frag_tr(KTi, GD_LD, 16 * ti, k0, lane), frag_row(XI, 72, 16 * w, k0, lane), c2); }
              const int dq = 16 * w + r; f32x4 gv;
#pragma unroll
              for (int e = 0; e < 4; ++e) gv[e] = ((16 * ti + 4 * g + e) == dq ? e63 : 0.f) - c1[e];
              ga[t2] = pack4(gv); za[t2] = pack4(c2); }
          fo_st2(GG, w, 4, 2 * tp, ga[0], ga[1], g, r); *(v4u*)(Z + co2_off(w, 4, tp, lane)) = cat2(za[0], za[1]); } }
    WG_SYNC();
#undef GD_IDX
}
__device__ __forceinline__ void gd_pair(CArgs& a, int i, int h, LAS unsigned char* lds, int tid) {
    const int lane = tid & 63, w = __builtin_amdgcn_readfirstlane(tid >> 6), r = lane & 15, g = lane >> 4, jc = w & 3, wh = w >> 2;
    const size_t t0 = (size_t)(2 * i) * 4 + h, t1 = t0 + 4;
    const bf16_t* G0 = (const bf16_t*)(a.ws + WS_GD_G) + t0 * 16384; const bf16_t* Z0 = (const bf16_t*)(a.ws + WS_GD_Z) + t0 * 16384;
    bf16_t* G1 = (bf16_t*)(a.ws + WS_GD_G) + t1 * 16384; bf16_t* Z1 = (bf16_t*)(a.ws + WS_GD_Z) + t1 * 16384; bf16_t* Q1 = (bf16_t*)(a.ws + WS_GD_QT) + t1 * 8192; bf16_t* Y1 = (bf16_t*)(a.ws + WS_GD_YI) + t1 * 8192;
    LAS bf16_t* GI = (LAS bf16_t*)lds;
    LAS bf16_t* ZI = GI + 128 * GD_LD;
    bf16x8 g0v[4]; v4u z0v[4]; bf16x8 g1f[4], q1f[4]; u32x2 z1v[8]; v4u y1v[2];
#pragma unroll
    for (int q = 0; q < 4; ++q) { g0v[q] = frag_fo(G0, 4, w, q, lane); z0v[q] = *(const v4u*)(Z0 + co2_off(w, 4, q, lane)); }
#pragma unroll
    for (int k = 0; k < 4; ++k) { g1f[k] = frag_fo(G1, 4, w, k, lane); q1f[k] = frag_fo(Q1, 4, jc, k, lane); }
#pragma unroll
    for (int te = 0; te < 8; ++te) z1v[te] = *(const u32x2*)(Z1 + co2_off(te, 4, w >> 1, lane) + 4 * (w & 1));
#pragma unroll
    for (int tp = 0; tp < 2; ++tp) y1v[tp] = *(const v4u*)(Y1 + co2_off(jc, 4, 2 * wh + tp, lane));
    asm volatile("" ::: "memory");
#pragma unroll
    for (int q = 0; q < 4; ++q) { *(LAS bf16x8*)(GI + (16 * w + r) * GD_LD + 32 * q + 8 * g) = g0v[q];
        *(LAS u32x2*)(ZI + (16 * w + r) * GD_LD + 32 * q + 4 * g) = (u32x2){z0v[q].x, z0v[q].y}; *(LAS u32x2*)(ZI + (16 * w + r) * GD_LD + 32 * q + 16 + 4 * g) = (u32x2){z0v[q].z, z0v[q].w}; }
    __syncthreads();
#pragma unroll
    for (int tp = 0; tp < 4; ++tp) { u32x2 ga[2];
#pragma unroll
        for (int t2 = 0; t2 < 2; ++t2) { const int ti = 2 * tp + t2; f32x4 c1 = {0.f, 0.f, 0.f, 0.f};
#pragma unroll
            for (int k = 0; k < 4; ++k) c1 = mfma16(frag_tr(GI, GD_LD, 16 * ti, 32 * k, lane), g1f[k], c1);
            ga[t2] = pack4(c1); }
        fo_st2(G1, w, 4, 2 * tp, ga[0], ga[1], g, r); }
#pragma unroll
    for (int te = 0; te < 8; ++te) { bf16_t* zp = Z1 + co2_off(te, 4, w >> 1, lane) + 4 * (w & 1); f32x4 c2 = unpack4(z1v[te]);
#pragma unroll
        for (int k = 0; k < 4; ++k) c2 = mfma16(g1f[k], frag_row(ZI, GD_LD, 16 * te, 32 * k, lane), c2);
        *(u32x2*)zp = pack4(c2); }
#pragma unroll
    for (int tp = 0; tp < 2; ++tp) { u32x2 qa[2]; const v4u yv = y1v[tp]; u32x2 ya[2];
#pragma unroll
        for (int t2 = 0; t2 < 2; ++t2) { const int ti = 4 * wh + 2 * tp + t2; f32x4 c1 = {0.f, 0.f, 0.f, 0.f}, c2 = unpack4(t2 ? (u32x2){yv.z, yv.w} : (u32x2){yv.x, yv.y});
#pragma unroll
            for (int k = 0; k < 4; ++k) { c1 = mfma16(frag_tr(GI, GD_LD, 16 * ti, 32 * k, lane), q1f[k], c1); c2 = mfma16(frag_row(ZI, GD_LD, 16 * ti, 32 * k, lane), q1f[k], c2); }
            qa[t2] = pack4(c1); ya[t2] = pack4(c2); }
        fo_st2(Q1, jc, 4, 4 * wh + 2 * tp, qa[0], qa[1], g, r); *(v4u*)(Y1 + co2_off(jc, 4, 2 * wh + tp, lane)) = cat2(ya[0], ya[1]); }
}
__device__ __forceinline__ void cnt_arrive(unsigned* cnt);
__device__ __forceinline__ void gd_stage2(CArgs& a, int h, int es, LAS unsigned char* lds, int tid, unsigned* half, const int var = 0) {
    const int lane = tid & 63, w = __builtin_amdgcn_readfirstlane(tid >> 6), r = lane & 15, g = lane >> 4;
    LAS bf16_t* Si = (LAS bf16_t*)lds;
    const bf16_t* G = (const bf16_t*)(a.ws + WS_GD_G); const bf16_t* Z = (const bf16_t*)(a.ws + WS_GD_Z); bf16_t* S = (bf16_t*)(a.ws + WS_GD_S);
    const int so = fo_st(es, 4, 16 * w, g, r), zo = co2_off(es, 4, w >> 1, lane) + 4 * (w & 1);
    *(LAS u32x2*)(Si + r * GD_LD + 16 * w + 4 * g) = (u32x2){0u, 0u}; *(u32x2*)(S + (size_t)h * 16384 + so) = (u32x2){0u, 0u};
    WG_SYNC();
    constexpr int NPR = NCH / 2;
    constexpr int PD = 8;
    bf16x8 gf[PD][4]; u32x2 zf[PD];
#pragma unroll
    for (int u = 0; u < PD; ++u) { const size_t tk = (size_t)(2 * u + 1) * 4 + h; zf[u] = *(const u32x2*)(Z + tk * 16384 + zo);
#pragma unroll
        for (int k = 0; k < 4; ++k) gf[u][k] = frag_fo(G + tk * 16384, 4, w, k, lane); }
#define GD_STEP(n_, u_, REFILL) do { const int n = (n_); const size_t tk = (size_t)(2 * n) * 4 + h; const int cur = n & 1; \
            f32x4 acc = unpack4(zf[u_]), acc2 = {0.f, 0.f, 0.f, 0.f}; \
            acc = mfma16(gf[u_][0], frag_row(Si + cur * 16 * GD_LD, GD_LD, 0, 0, lane), acc); acc2 = mfma16(gf[u_][1], frag_row(Si + cur * 16 * GD_LD, GD_LD, 0, 32, lane), acc2); \
            acc = mfma16(gf[u_][2], frag_row(Si + cur * 16 * GD_LD, GD_LD, 0, 64, lane), acc); acc2 = mfma16(gf[u_][3], frag_row(Si + cur * 16 * GD_LD, GD_LD, 0, 96, lane), acc2); \
            if (REFILL && !(var & 2)) { const int nn = n + PD < NPR - 1 ? n + PD : NPR - 2; const size_t tn = (size_t)(2 * nn + 1) * 4 + h; zf[u_] = *(const u32x2*)(Z + tn * 16384 + zo); \
                _Pragma("unroll") for (int k = 0; k < 4; ++k) gf[u_][k] = frag_fo(G + tn * 16384, 4, w, k, lane); } \
            const u32x2 pv = pack4(acc + acc2); \
            if (!(var & 4)) *(LAS u32x2*)(Si + (cur ^ 1) * 16 * GD_LD + r * GD_LD + 16 * w + 4 * g) = pv; if (!(var & 1)) *(u32x2*)(S + (tk + 8) * 16384 + so) = pv; \
            if (!(var & 4)) { asm volatile("s_waitcnt lgkmcnt(0)" ::: "memory"); __builtin_amdgcn_s_barrier(); } asm volatile("" ::: "memory"); } while (0)
#pragma unroll
    for (int nq = 0; nq < NPR - 1; ++nq) { GD_STEP(nq, nq % PD, nq + PD < NPR - 1); if (nq == NPR / 2 - 2) cnt_arrive(half); }
#undef GD_STEP
}
struct Gd3In { v4u yi[2]; bf16x8 s[4][4]; bf16x8 q[4]; u32x2 z[4]; f32x4 w[4]; };
__device__ __forceinline__ void gd3_load(CArgs& a, int l, int n, int h, int tid, Gd3In& in) {
    const int lane = tid & 63, w = __builtin_amdgcn_readfirstlane(tid >> 6), r = lane & 15, g = lane >> 4, jc = w & 3, wh = w >> 2;
    const size_t tk = (size_t)n * 4 + h; const int t = n * 64 + 16 * jc + r;
    const bf16_t* S = (const bf16_t*)(a.ws + WS_GD_S) + ((size_t)(n & ~1) * 4 + h) * 16384;
    const bf16_t* QT = (const bf16_t*)(a.ws + WS_GD_QT) + tk * 8192; const bf16_t* YI = (const bf16_t*)(a.ws + WS_GD_YI) + tk * 8192;
    const float* nw = LP(I_GNORM, 128); const bf16_t* pz = PROJROW(t) + C_GZ + h * 128;
#pragma unroll
    for (int k = 0; k < 4; ++k) in.q[k] = frag_fo(QT, 4, jc, k, lane);
#pragma unroll
    for (int tp = 0; tp < 2; ++tp) in.yi[tp] = *(const v4u*)(YI + co2_off(jc, 4, 2 * wh + tp, lane));
#pragma unroll
    for (int tt = 0; tt < 4; ++tt) {
#pragma unroll
        for (int k = 0; k < 4; ++k) in.s[tt][k] = frag_fo(S, 4, 4 * wh + tt, k, lane);
        const int e0 = 16 * (4 * wh + tt) + 4 * g; in.z[tt] = *(const u32x2*)(pz + e0); in.w[tt] = *(const f32x4*)(nw + e0); }
    asm volatile("" ::: "memory");
}
__device__ __forceinline__ void gd_stage3(CArgs& a, int l, int n, int h, LAS unsigned char* lds, int tid, const Gd3In& in) {
    const int lane = tid & 63, w = __builtin_amdgcn_readfirstlane(tid >> 6), r = lane & 15, g = lane >> 4, jc = w & 3, wh = w >> 2;
    const int c = 16 * jc + r, t = n * 64 + c;
    LAS float* xs = (LAS float*)lds;
    bf16_t* O = (bf16_t*)(a.ws + WS_O) + (size_t)t * D + h * 128;
    f32x4 acc[4]; float ss = 0.f;
#pragma unroll
    for (int tt = 0; tt < 4; ++tt) { const v4u yv = in.yi[tt >> 1]; acc[tt] = unpack4((tt & 1) ? (u32x2){yv.z, yv.w} : (u32x2){yv.x, yv.y});
#pragma unroll
        for (int k = 0; k < 4; ++k) acc[tt] = mfma16(in.s[tt][k], in.q[k], acc[tt]);
#pragma unroll
        for (int e = 0; e < 4; ++e) ss += acc[tt][e] * acc[tt][e]; }
    ss += __shfl_xor(ss, 16); ss += __shfl_xor(ss, 32);
    if (g == 0) xs[w * 16 + r] = ss;
    WG_SYNC();
    const float rs = 1.0f / sqrtf((ss + xs[(w ^ 4) * 16 + r]) * (1.0f / 128.0f) + 1e-6f);
#pragma unroll
    for (int tt = 0; tt < 4; ++tt) { const int e0 = 16 * (4 * wh + tt) + 4 * g; const f32x4 zv = unpack4(in.z[tt]), wv = in.w[tt]; f32x4 y;
#pragma unroll
        for (int e = 0; e < 4; ++e) y[e] = acc[tt][e] * rs * wv[e] * silu_f(zv[e]);
        *(u32x2*)(O + e0) = pack4(y); }
    WG_SYNC();
}

#define XB_TMO      128
#define XB_XCNT(j)  (256  + 64 * (j))
#define XB_XSUB(j)  (1280 + 64 * (j))
#define XB_XGEN(j)  (2304 + 64 * (j))
#define XB_TOP      3328
#define XB_TOPGEN   3392
#define XCD_BAR_WORDS 3456
#define XB_SPIN_CAP (1u << 20)
__device__ __forceinline__ unsigned xb_ld(unsigned* p)              { return __hip_atomic_load(p, __ATOMIC_RELAXED, __HIP_MEMORY_SCOPE_AGENT); }
__device__ __forceinline__ unsigned xb_add(unsigned* p, unsigned v) { return __hip_atomic_fetch_add(p, v, __ATOMIC_RELAXED, __HIP_MEMORY_SCOPE_AGENT); }
__device__ __forceinline__ unsigned xb_xcc_id() { return (unsigned)__builtin_amdgcn_s_getreg((3 << 11) | 20) & 0xFu; }
#define XB_SPIN(cond, bar) do { unsigned _sp = 0; while (cond) { __builtin_amdgcn_s_sleep(1); \
    if ((++_sp & 255u) == 0u) { if (xb_ld(&(bar)[XB_TMO])) break; if (_sp > XB_SPIN_CAP) { atomicAdd(&(bar)[XB_TMO], 1u); break; } } } } while (0)
struct XcdBarrier { unsigned* bar; unsigned x; volatile LAS unsigned* st; };
__device__ __forceinline__ XcdBarrier xcd_barrier_post(unsigned* bar, volatile LAS unsigned* st) {
    XcdBarrier b; b.bar = bar; b.x = xb_xcc_id(); b.st = st;
    if (threadIdx.x == 0) (void)xb_add(&bar[XB_XCNT(b.x)], 1u);
    return b;
}
__device__ __forceinline__ void xcd_barrier_complete(unsigned* bar, unsigned x, unsigned& nloc, unsigned& nx) {
    const unsigned G = gridDim.x * gridDim.y * gridDim.z;
    unsigned sum, cnt, mine, sp = 0u;
    for (;;) {
        sum = 0u; cnt = 0u; mine = 0u;
#pragma unroll
        for (unsigned j = 0; j < 16; ++j) { const unsigned c = xb_ld(&bar[XB_XCNT(j)]); sum += c; cnt += (c > 0u) ? 1u : 0u; mine = (j == x) ? c : mine; }
        if (sum == G) break;
        __builtin_amdgcn_s_sleep(1);
        if ((++sp & 255u) == 0u) { if (xb_ld(&bar[XB_TMO])) break; if (sp > XB_SPIN_CAP) { atomicAdd(&bar[XB_TMO], 1u); break; } }
    }
    nloc = mine > 0u ? mine : 1u; nx = cnt > 0u ? cnt : 1u;
}
__device__ __forceinline__ void xcd_barrier(const XcdBarrier& b) {
    asm volatile("s_waitcnt vmcnt(0)" ::: "memory");
    __syncthreads();
    if (threadIdx.x == 0) {
        unsigned* bar = b.bar;
        __builtin_amdgcn_s_waitcnt(0);
        unsigned nloc = b.st[0], nx = b.st[1];
        if (nloc == 0u) { xcd_barrier_complete(bar, b.x, nloc, nx); b.st[0] = nloc; b.st[1] = nx; }
        const unsigned old = xb_add(&bar[XB_XSUB(b.x)], 1u);
        const unsigned gen = old / nloc;
        if (old + 1u == (gen + 1u) * nloc) {
            __builtin_amdgcn_fence(__ATOMIC_RELEASE, "agent");
            asm volatile("s_waitcnt vmcnt(0)" ::: "memory");
            const unsigned og = xb_add(&bar[XB_TOP], 1u);
            const unsigned tg = og / nx;
            if (og + 1u == (tg + 1u) * nx) xb_add(&bar[XB_TOPGEN], 1u);
            else XB_SPIN(xb_ld(&bar[XB_TOPGEN]) == tg, bar);
            __builtin_amdgcn_fence(__ATOMIC_ACQUIRE, "agent");
            xb_add(&bar[XB_XGEN(b.x)], 1u);
            asm volatile("s_waitcnt vmcnt(0)" ::: "memory");
        } else {
            XB_SPIN(xb_ld(&bar[XB_XGEN(b.x)]) == gen, bar);
            __builtin_amdgcn_fence(__ATOMIC_ACQUIRE, "agent");
            asm volatile("s_waitcnt vmcnt(0)" ::: "memory");
        }
    }
    __syncthreads();
}

constexpr int CV_IN = (D / 64) * (PTP / 32), CV_OUT = (D / 64) * (D / 32), CV_UP = (D / 64) * (FF / 32), CV_DN = (FF / 64) * (D / 32), CV_ALL = CV_IN + CV_OUT + CV_UP + CV_DN;
__device__ __forceinline__ void cvt_items(CArgs& a, int l, int lo, int hi, int gwv, int ngwv, LAS float* scr, int lane) {
#pragma unroll 1
    for (int it = lo + gwv; it < hi; it += ngwv) {
        int r = it;
        if (r < CV_IN) { transpose_item(LP(I_WIN, (size_t)D * PT), D, PT, PTP, (bf16_t*)(a.ws + WS_WIN), scr, r, lane, LP(I_N1, D)); continue; } r -= CV_IN;
        if (r < CV_OUT) { transpose_item(LP(I_WOUT, (size_t)D * D), D, D, D, (bf16_t*)(a.ws + WS_WOUT), scr, r, lane); continue; } r -= CV_OUT;
        if (r < CV_UP) { transpose_item(LP(I_WUP, (size_t)D * FF), D, FF, FF, (bf16_t*)(a.ws + WS_WUP), scr, r, lane, LP(I_N2, D)); continue; } r -= CV_UP;
        transpose_item(LP(I_WDN, (size_t)FF * D), FF, D, D, (bf16_t*)(a.ws + WS_WDN), scr, r, lane);
    }
}

constexpr int CW_SUB = 8192;
__device__ __forceinline__ void cnt_arrive(unsigned* cnt) {
    asm volatile("s_waitcnt vmcnt(0)" ::: "memory"); __syncthreads();
    if (threadIdx.x == 0) { __builtin_amdgcn_fence(__ATOMIC_RELEASE, "agent"); asm volatile("s_waitcnt vmcnt(0)" ::: "memory"); (void)xb_add(cnt, 1u); }
}
__device__ __forceinline__ void cnt_arrive2(unsigned* grp, unsigned gsize, unsigned* top) {
    asm volatile("s_waitcnt vmcnt(0)" ::: "memory"); __syncthreads();
    if (threadIdx.x == 0) { __builtin_amdgcn_fence(__ATOMIC_RELEASE, "agent"); asm volatile("s_waitcnt vmcnt(0)" ::: "memory");
        if (xb_add(grp, 1u) == gsize - 1u) { __builtin_amdgcn_fence(__ATOMIC_ACQ_REL, "agent"); asm volatile("s_waitcnt vmcnt(0)" ::: "memory"); (void)xb_add(top, 1u); } }
}
__device__ __forceinline__ void cnt_wait(unsigned* cnt, unsigned want, unsigned* tmo) {
    if (threadIdx.x == 0) { unsigned sp = 0; while (xb_ld(cnt) < want) { __builtin_amdgcn_s_sleep(2); if ((++sp & 255u) == 0u) { if (xb_ld(tmo)) break; if (sp > XB_SPIN_CAP) { atomicAdd(tmo, 1u); break; } } }
        __builtin_amdgcn_fence(__ATOMIC_ACQUIRE, "agent"); asm volatile("s_waitcnt vmcnt(0)" ::: "memory"); }
    __syncthreads();
}

constexpr int N_PHASES = 1 + 9 * NL;

__device__ __forceinline__ void run_phase(CArgs& a, int ph, LAS unsigned char* lds, const int tid, const int bid, const int mask = 15) {
    const int lane = tid & 63, wave = __builtin_amdgcn_readfirstlane(tid >> 6);
    const int G = gridDim.x, gw = bid * NWAVES + wave, NGW = G * NWAVES;
    ss_t* SSb = (ss_t*)(a.ws + WS_SS);
    if (ph == N_PHASES - 1) {
        for (int t = gw; t < T; t += NGW) final_row((const bf16_t*)(a.ws + WS_HB) + (size_t)t * D, a.in[I_NF], (float)SSb[2 * NL * T + t] * SS_INV, a.out + (size_t)t * D, lane);
        return;
    }
    const int l = ph / 9, sp = ph % 9;
    bf16_t* HB = (bf16_t*)(a.ws + WS_HB);
    switch (sp) {
    case 0: {
        if (mask & 1) cvt_items(a, l, 0, CV_IN, gw, NGW, (LAS float*)(lds + wave * 16384), lane);
        if (mask & 2) for (int t = gw; t < T; t += NGW) hb_row(a.in[I_X] + (size_t)t * D, HB + (size_t)t * D, SSb + t, lane);
    } break;
    case 1: { pg8::Gemm g{HB, (const bf16_t*)(a.ws + WS_WIN)}; pg8::StaticOrder<T, PTP> S; S.init(G, bid);
              pg8::EpiBf16<false> E{(bf16_t*)(a.ws + WS_PROJ), PTP, SSb + l * T}; pg8::gemm_phase<D, pg8::EpiBf16<false>, pg8::StaticOrder<T, PTP>, true>(lds, g, S, E, tid);
              constexpr int NFULL = (T / 256) * (PTP / 256) % 256; if (bid >= NFULL) cvt_items(a, l, CV_IN, CV_ALL, (bid - NFULL) * NWAVES + wave, (G - NFULL) * NWAVES, (LAS float*)(lds + wave * 16384), lane); } break;
    case 2: {
#pragma unroll 1
              for (int pp = bid; (mask & 1) && pp < (NCH / 2) * 4; pp += G) {
#pragma unroll 1
                  for (int q = 0; q < 2; ++q) gd_stage1(a, l, 2 * (pp >> 2) + q, pp & 3, lds, tid, mask >> 8 ? (mask >> 8) - 1 : 99);
                  if (!(mask >> 8)) { asm volatile("s_waitcnt vmcnt(0)" ::: "memory"); __syncthreads();
                      gd_pair(a, pp >> 2, pp & 3, lds, tid); __syncthreads(); } }
              if (mask & 4) { Rw1In pre; Rw1Par par; if (bid < NCH * 8) { rw1_load(a, bid >> 3, bid & 7, tid, pre); rw1_par(a, l, bid & 7, tid, par); }
#pragma unroll 1
                  for (int it = bid; it < NCH * 8; it += G) rw_stage1(a, l, it >> 3, it & 7, lds, tid, pre, par, it + G < NCH * 8 ? it + G : -1, mask >> 8 ? (mask >> 8) - 1 : 99); }
#pragma unroll 1
              for (int it = bid; (mask & 8) && it < NCH * 2; it += G) m2_stage1(a, l, it >> 1, it & 1, lds, tid);
#pragma unroll 1
              for (int it = bid; (mask & 2) && it < NCH * 4; it += G) ret_stage1(a, it >> 2, it & 3, lds, tid); } break;
    case 3: { const int b = bid;
              unsigned* ctl = (unsigned*)(a.ws + WS_CTL); unsigned* sub = ctl + CW_SUB + 128 * l; unsigned* ddone = sub + 32; unsigned* gdone = sub + 64; unsigned* ghalf = sub + 96; unsigned* dhalf = sub + 112;
              if (b < 64) { const int x = b & 7, j = b >> 3;
                  if (x < 4) { if (mask & 1) gd_stage2(a, x, j, lds, tid, ghalf, mask >> 12); if ((mask & 15) == 15) cnt_arrive(gdone); }
                  else { if (mask & 4) rw_stage2(a, (x - 4) * 2 + (j >> 2), j & 3, lds, tid, dhalf); if ((mask & 15) == 15) cnt_arrive(ddone); } }
              else { if (b < 128) { if (mask & 2) ret_stage2(a, b - 64, lds, tid); } else if (mask & 8) m2_stage2(a, b - 128, lds, tid);
                  if ((mask & 15) == 15) { const int hb = b - 64, NH = G - 64;
                      cnt_arrive2(ctl + CW_SUB + 128 * NL + (l * 8 + (b & 7)) * 16, (unsigned)(NH / 8), sub); cnt_wait(sub, 8u, ctl + XB_TMO);
#pragma unroll 1
                      for (int it = hb; !(mask & 32) && it < NCH * 4; it += NH) { Ret3In in; ret3_load(a, l, it >> 2, it & 3, tid, in); ret_stage3(a, l, it >> 2, it & 3, lds, tid, in); }
#pragma unroll 1
                      for (int it = NH - 1 - hb; !(mask & 32) && it < NCH * 2; it += NH) m2_stage3(a, l, it >> 1, it & 1, lds, tid); } }
              if ((mask & 15) == 15) { LAS float* scr = (LAS float*)(lds + wave * 16384);
                  const int sidx = b, NS = G;
                  __syncthreads();
                  if (l + 1 < NL && !(mask & 16)) cvt_items(a, l + 1, 0, CV_IN, sidx * NWAVES + wave, NS * NWAVES, scr, lane);
                  __syncthreads();
#pragma unroll 1
                  for (int hf = 0; hf < 2; ++hf) { int tid2 = tid; asm volatile("" : "+v"(tid2));
                      cnt_wait(hf ? ddone : dhalf, 32u, ctl + XB_TMO);
                      if (!(mask & 64)) { Rw3In pa, pb;
                          int it, st, NT;
                          if (hf) { it = sidx; while (it < NCH * 4) it += NS; st = NS; NT = NCH * 8; }
                          else if (b >= 64) { it = b - 64; st = G - 64; NT = NCH * 4 - 64; }
                          else { it = NCH * 4 - 64 + b; st = G; NT = NCH * 4; }
                          if (it < NT) rw3_load(a, l, it >> 3, it & 7, tid2, pa);
#pragma unroll 1
                          for (; it < NT; it += 2 * st) { const int i1 = it + st, i2 = it + 2 * st;
                              if (i1 < NT) rw3_load(a, l, i1 >> 3, i1 & 7, tid2, pb);
                              rw_stage3(a, l, it >> 3, it & 7, lds, tid2, pa);
                              if (i2 < NT) rw3_load(a, l, i2 >> 3, i2 & 7, tid2, pa);
                              if (i1 < NT) rw_stage3(a, l, i1 >> 3, i1 & 7, lds, tid2, pb); } }
                      cnt_wait(hf ? gdone : ghalf, 32u, ctl + XB_TMO);
                      if (!(mask & 128)) { const int NT = hf ? NCH * 4 : NCH * 2; int it = sidx; if (hf) { while (it < NCH * 2) it += NS; }
#pragma unroll 1
                          for (; it < NT; it += NS) { Gd3In in; gd3_load(a, l, it >> 2, it & 3, tid2, in); gd_stage3(a, l, it >> 2, it & 3, lds, tid2, in); } } } } } break;
    case 4: break;
    case 5: { pg8::Gemm g{(const bf16_t*)(a.ws + WS_O), (const bf16_t*)(a.ws + WS_WOUT)}; pg8::StaticOrder<T, D> S; S.init(G, bid);
              if (l == 0) { pg8::EpiRes<true> E{a.in[I_X], HB, D, SSb + (NL + l) * T}; pg8::gemm_phase<D, pg8::EpiRes<true>, pg8::StaticOrder<T, D>, false>(lds, g, S, E, tid); }
              else { pg8::EpiRes<false> E{HB, HB, D, SSb + (NL + l) * T}; pg8::gemm_phase<D, pg8::EpiRes<false>, pg8::StaticOrder<T, D>, false>(lds, g, S, E, tid); } } break;
    case 6: break;
    case 7: { pg8::Gemm g{HB, (const bf16_t*)(a.ws + WS_WUP)}; pg8::StaticOrder<T, FF> S; S.init(G, bid);
              pg8::EpiBf16<true> E{(bf16_t*)(a.ws + WS_HID), FF, SSb + (NL + l) * T}; pg8::gemm_phase<D, pg8::EpiBf16<true>, pg8::StaticOrder<T, FF>, true>(lds, g, S, E, tid); } break;
    case 8: { pg8::Gemm g{(const bf16_t*)(a.ws + WS_HID), (const bf16_t*)(a.ws + WS_WDN)}; pg8::StaticOrder<T, D> S; S.init(G, bid);
              pg8::EpiRes<false> E{HB, HB, D, SSb + (l + 1 < NL ? (l + 1) : 2 * NL) * T}; pg8::gemm_phase<FF, pg8::EpiRes<false>, pg8::StaticOrder<T, D>, false>(lds, g, S, E, tid); } break;
    }
}

__global__ void __launch_bounds__(NWAVES * 64, 2) fwd_kernel(Args a) {
    extern __shared__ __attribute__((aligned(16))) unsigned char lds_raw[];
    LAS unsigned char* lds = (LAS unsigned char*)lds_raw;
    const int ph_lo = a.ph_lo, ph_hi = a.ph_hi;
    volatile LAS unsigned* MISC = (volatile LAS unsigned*)(lds + MISC_OFF);
    if (threadIdx.x < 64) MISC[threadIdx.x] = 0u;
    __syncthreads();
    const XcdBarrier bar = xcd_barrier_post((unsigned*)(a.ws + WS_CTL), MISC + 8);
    for (int ph = ph_lo; ph < ph_hi; ++ph) {
        if (ph != N_PHASES - 1 && (ph % 9 == 6 || ph % 9 == 4 || (ph % 9 == 0 && ph > 0))) continue;
        CArgs* ap = (CArgs*)__builtin_amdgcn_kernarg_segment_ptr();
        asm volatile("" : "+s"(ap));
        int tid = threadIdx.x, bid = blockIdx.x;
        asm volatile("" : "+v"(tid)); asm volatile("" : "+s"(bid));
        run_phase(*ap, ph, lds, tid, bid);
#ifdef DUP_PHASE
#ifndef DUP_MASK
#define DUP_MASK 15
#endif
        if (ph == DUP_PHASE) { xcd_barrier(bar); asm volatile("" : "+s"(ap)); asm volatile("" : "+v"(tid)); asm volatile("" : "+s"(bid)); run_phase(*ap, ph, lds, tid, bid, DUP_MASK); }
#endif
        if (ph + 1 < ph_hi) xcd_barrier(bar);
    }
}

extern "C" void kernel_launch(void* const* d_in, const int* in_sizes, int n_in, void* d_out, int out_size, void* d_ws, size_t ws_size, hipStream_t stream) {
    static int grid = 0;
    if (grid == 0) {
        if (n_in != N_IN || in_sizes[0] != T * D || out_size != T * D || ws_size < WS_END) {
            fprintf(stderr, "kernel_launch: shape/workspace mismatch: n_in %d in0 %d out %d ws %zu (need %zu); nothing launched\n", n_in, n_in > 0 ? in_sizes[0] : -1, out_size, ws_size, (size_t)WS_END); grid = -1; return; }
        int dev = 0, cus = 0, per_cu = 0;
        if (hipGetDevice(&dev) != hipSuccess || hipDeviceGetAttribute(&cus, hipDeviceAttributeMultiprocessorCount, dev) != hipSuccess) { grid = -1; return; }
        if (hipFuncSetAttribute((const void*)fwd_kernel, hipFuncAttributeMaxDynamicSharedMemorySize, LDS_BYTES) != hipSuccess) { fprintf(stderr, "kernel_launch: hipFuncSetAttribute failed\n"); grid = -1; return; }
        if (hipOccupancyMaxActiveBlocksPerMultiprocessor(&per_cu, (const void*)fwd_kernel, NWAVES * 64, LDS_BYTES) != hipSuccess || per_cu < 1) { fprintf(stderr, "kernel_launch: occupancy query says %d blocks per CU\n", per_cu); per_cu = 1; }
        (void)hipGetLastError();
        grid = cus;
    }
    if (grid < 0) return;
    Args a{};
    for (int i = 0; i < N_IN; ++i) a.in[i] = (const float*)d_in[i];
    a.out = (float*)d_out; a.ws = (unsigned char*)d_ws;
#if N_LAUNCH_MODE == 1
    a.ph_lo = 0; a.ph_hi = N_PHASES;
    (void)hipMemsetAsync((char*)d_ws + WS_CTL, 0, CTL_ZERO_BYTES, stream);
    hipLaunchKernelGGL(fwd_kernel, dim3(grid), dim3(NWAVES * 64), LDS_BYTES, stream, a);
#else
#ifndef DBG_MAXPH
#define DBG_MAXPH N_PHASES
#endif
    for (int ph = 0; ph < N_PHASES; ++ph) {
        if (ph >= DBG_MAXPH && ph != N_PHASES - 1) continue;
#ifdef DBG_SKIP_FINAL
        if (ph == N_PHASES - 1) continue;
#endif
        (void)hipMemsetAsync((char*)d_ws + WS_CTL, 0, CTL_ZERO_BYTES, stream);
        a.ph_lo = ph; a.ph_hi = ph + 1;
        hipLaunchKernelGGL(fwd_kernel, dim3(grid), dim3(NWAVES * 64), LDS_BYTES, stream, a);
    }
#endif
}
#endif
```
